# Optimizing an MI355X kernel written in HIP

```python
import math
import jax
import jax.numpy as jnp
from jax import lax
import numpy as np

D_MODEL = 1024
BATCH = 16
SEQ = 4096
DEPTH = 2

SSM_GROUP = 16
SSM_GROUPS = 32
SSM_WIDTH = SSM_GROUP * SSM_GROUPS
SSM_STATE = 64
N_HEADS = 8
HEAD_DIM = 64
V_DIM = 2 * HEAD_DIM
QK_WIDTH = N_HEADS * 2 * HEAD_DIM
ATTN_WIDTH = N_HEADS * V_DIM
Q_BLOCK = 128
ROPE_THETA = 10000.0
IN_COLS = SSM_WIDTH + 2 * QK_WIDTH + ATTN_WIDTH + 2 * D_MODEL
SPLITS = [SSM_WIDTH,
          SSM_WIDTH + QK_WIDTH,
          SSM_WIDTH + 2 * QK_WIDTH,
          SSM_WIDTH + 2 * QK_WIDTH + ATTN_WIDTH,
          SSM_WIDTH + 2 * QK_WIDTH + ATTN_WIDTH + D_MODEL]
D_FF = 2816
N_EXPERTS = 8
TOP_K = 2
N_DENSE = (DEPTH + 1) // 2
N_MOE = DEPTH // 2
EPS = 1e-6
SUBLN_EPS = 1e-5

kernel_name = 'hybrid_s5_diffattn_moe_trunk'


def rms_norm(x, g, eps=EPS):
    x32 = x.astype(jnp.float32)
    y = x32 * lax.rsqrt(jnp.mean(x32 * x32, axis=-1, keepdims=True) + eps)
    return (y * g.astype(jnp.float32)).astype(x.dtype)


def apply_rope(t, cos, sin):
    t32 = t.astype(jnp.float32)
    t1, t2 = jnp.split(t32, 2, axis=-1)
    rot = jnp.concatenate([-t2, t1], axis=-1)
    return (t32 * cos + rot * sin).astype(t.dtype)


def _complex_affine_combine(c1, c2):
    a1r, a1i, b1r, b1i = c1
    a2r, a2i, b2r, b2i = c2
    ar = a2r * a1r - a2i * a1i
    ai = a2r * a1i + a2i * a1r
    br = a2r * b1r - a2i * b1i + b2r
    bi = a2r * b1i + a2i * b1r + b2i
    return (ar, ai, br, bi)


def s5_branch(u, lam_re, lam_im, log_dt, b_re, b_im, c_re, c_im, d):
    f32 = jnp.float32
    bsz, s, _ = u.shape
    u32 = u.astype(f32).reshape(bsz, s, SSM_GROUPS, SSM_GROUP)
    lr = lam_re.astype(f32)
    li = lam_im.astype(f32)
    dt = jnp.exp(log_dt.astype(f32))[:, None]
    mag = jnp.exp(lr * dt)
    ar = mag * jnp.cos(li * dt)
    ai = mag * jnp.sin(li * dt)
    den = lr * lr + li * li
    nr = ar - 1.0
    ni = ai
    fr = (nr * lr + ni * li) / den
    fi = (ni * lr - nr * li) / den
    br = b_re.astype(f32)
    bi = b_im.astype(f32)
    bbr = fr[..., None] * br - fi[..., None] * bi
    bbi = fr[..., None] * bi + fi[..., None] * br
    bu_r = jnp.einsum('gpj,bsgj->bsgp', bbr, u32)
    bu_i = jnp.einsum('gpj,bsgj->bsgp', bbi, u32)
    a_r = jnp.broadcast_to(ar, (1, s) + ar.shape)
    a_i = jnp.broadcast_to(ai, (1, s) + ai.shape)
    _, _, st_r, st_i = lax.associative_scan(_complex_affine_combine, (a_r, a_i, bu_r, bu_i), axis=1)
    y = (jnp.einsum('gjp,bsgp->bsgj', c_re.astype(f32), st_r)
         - jnp.einsum('gjp,bsgp->bsgj', c_im.astype(f32), st_i)
         + d.astype(f32) * u32)
    return y.reshape(bsz, s, SSM_WIDTH).astype(u.dtype)


def diff_attention(q, k, v, lam):
    bsz, s = q.shape[0], q.shape[1]
    n_blk = s // Q_BLOCK
    scale = HEAD_DIM ** -0.5
    kpos = jnp.arange(s)
    neg = jnp.finfo(jnp.float32).min

    def one_block(i):
        qs = lax.dynamic_slice_in_dim(q, i * Q_BLOCK, Q_BLOCK, axis=1)
        sc = jnp.einsum('bqhcd,bkhcd->bhcqk', qs, k).astype(jnp.float32) * scale
        qpos = i * Q_BLOCK + jnp.arange(Q_BLOCK)
        mask = qpos[:, None] >= kpos[None, :]
        p = jax.nn.softmax(jnp.where(mask, sc, neg), axis=-1)
        w = p[:, :, 0] - lam * p[:, :, 1]
        return jnp.einsum('bhqk,bkhd->bqhd', w.astype(v.dtype), v)

    out = lax.map(one_block, jnp.arange(n_blk))
    return jnp.moveaxis(out, 0, 1).reshape(bsz, s, N_HEADS, V_DIM)


def swiglu(h, wg, wu, wd):
    return (jax.nn.silu(h @ wg) * (h @ wu)) @ wd


def moe_swiglu(h, router_w, wg, wu, wd):
    bsz, s, dm = h.shape
    hf = h.reshape(-1, dm)
    logits = hf.astype(jnp.float32) @ router_w.astype(jnp.float32)
    top_vals, top_idx = lax.top_k(logits, TOP_K)
    top_w = jax.nn.softmax(top_vals, axis=-1)
    gates = jnp.sum(jax.nn.one_hot(top_idx, N_EXPERTS, dtype=jnp.float32) * top_w[..., None], axis=1)
    gates = gates.astype(h.dtype)
    y = jnp.zeros_like(hf)
    for e in range(N_EXPERTS):
        y = y + gates[:, e:e + 1] * swiglu(hf, wg[e], wu[e], wd[e])
    return y.reshape(bsz, s, dm)


def setup_inputs(seed: int = 0) -> dict:
    key = jax.random.key(seed)
    ks = jax.random.split(key, 32)
    f32 = jnp.float32
    L, D, G, P, J = DEPTH, D_MODEL, SSM_GROUPS, SSM_STATE, SSM_GROUP

    def nrm(k, shape, std):
        return jax.random.normal(k, shape, f32) * std

    x = jax.random.normal(ks[0], (BATCH, SEQ, D), f32)
    positions = jnp.broadcast_to(jnp.arange(SEQ, dtype=jnp.int32), (BATCH, SEQ))
    mix_norm = 1.0 + nrm(ks[1], (L, D), 0.02)
    w_in = nrm(ks[2], (L, D, IN_COLS), D ** -0.5)
    ssm_lambda_re = -0.5 + nrm(ks[3], (L, G, P), 0.01)
    ssm_lambda_im = math.pi * jnp.arange(P, dtype=f32)[None, None, :] + nrm(ks[4], (L, G, P), 0.01)
    ssm_log_dt = jax.random.uniform(ks[5], (L, G), f32, math.log(1e-3), math.log(1e-1))
    ssm_b_re = nrm(ks[6], (L, G, P, J), (2.0 * J) ** -0.5)
    ssm_b_im = nrm(ks[7], (L, G, P, J), (2.0 * J) ** -0.5)
    ssm_c_re = nrm(ks[8], (L, G, J, P), (2.0 * P) ** -0.5 * 4.0)
    ssm_c_im = nrm(ks[9], (L, G, J, P), (2.0 * P) ** -0.5 * 4.0)
    ssm_d = nrm(ks[10], (L, G, J), 1.0)
    w_glu = nrm(ks[11], (L, SSM_WIDTH, SSM_WIDTH), SSM_WIDTH ** -0.5)
    b_glu = nrm(ks[12], (L, SSM_WIDTH), 0.01)
    lambda_q1 = nrm(ks[13], (L, HEAD_DIM), 0.1)
    lambda_k1 = nrm(ks[14], (L, HEAD_DIM), 0.1)
    lambda_q2 = nrm(ks[15], (L, HEAD_DIM), 0.1)
    lambda_k2 = nrm(ks[16], (L, HEAD_DIM), 0.1)
    subln = 1.0 + nrm(ks[17], (L, V_DIM), 0.02)
    w_proj_ssm = nrm(ks[18], (L, SSM_WIDTH, D), SSM_WIDTH ** -0.5)
    w_proj_attn = nrm(ks[19], (L, ATTN_WIDTH, D), ATTN_WIDTH ** -0.5)
    w_out = nrm(ks[20], (L, D, D), D ** -0.5)
    ffn_norm = 1.0 + nrm(ks[21], (L, D), 0.02)
    dense_w_gate = nrm(ks[22], (N_DENSE, D, D_FF), D ** -0.5)
    dense_w_up = nrm(ks[23], (N_DENSE, D, D_FF), D ** -0.5)
    dense_w_down = nrm(ks[24], (N_DENSE, D_FF, D), D_FF ** -0.5)
    router_w = nrm(ks[25], (N_MOE, D, N_EXPERTS), D ** -0.5)
    moe_w_gate = nrm(ks[26], (N_MOE, N_EXPERTS, D, D_FF), D ** -0.5)
    moe_w_up = nrm(ks[27], (N_MOE, N_EXPERTS, D, D_FF), D ** -0.5)
    moe_w_down = nrm(ks[28], (N_MOE, N_EXPERTS, D_FF, D), D_FF ** -0.5)
    final_norm = 1.0 + nrm(ks[29], (D,), 0.02)
    return {'x': x, 'positions': positions, 'mix_norm': mix_norm, 'w_in': w_in,
            'ssm_lambda_re': ssm_lambda_re, 'ssm_lambda_im': ssm_lambda_im, 'ssm_log_dt': ssm_log_dt,
            'ssm_b_re': ssm_b_re, 'ssm_b_im': ssm_b_im, 'ssm_c_re': ssm_c_re, 'ssm_c_im': ssm_c_im,
            'ssm_d': ssm_d, 'w_glu': w_glu, 'b_glu': b_glu,
            'lambda_q1': lambda_q1, 'lambda_k1': lambda_k1, 'lambda_q2': lambda_q2, 'lambda_k2': lambda_k2,
            'subln': subln, 'w_proj_ssm': w_proj_ssm, 'w_proj_attn': w_proj_attn, 'w_out': w_out,
            'ffn_norm': ffn_norm, 'dense_w_gate': dense_w_gate, 'dense_w_up': dense_w_up,
            'dense_w_down': dense_w_down, 'router_w': router_w, 'moe_w_gate': moe_w_gate,
            'moe_w_up': moe_w_up, 'moe_w_down': moe_w_down, 'final_norm': final_norm}


def reference(x, positions, mix_norm, w_in, ssm_lambda_re, ssm_lambda_im, ssm_log_dt,
              ssm_b_re, ssm_b_im, ssm_c_re, ssm_c_im, ssm_d, w_glu, b_glu,
              lambda_q1, lambda_k1, lambda_q2, lambda_k2, subln, w_proj_ssm, w_proj_attn, w_out,
              ffn_norm, dense_w_gate, dense_w_up, dense_w_down, router_w, moe_w_gate,
              moe_w_up, moe_w_down, final_norm):
    bsz, s, _ = x.shape
    f32 = jnp.float32
    inv_freq = ROPE_THETA ** (-jnp.arange(0, HEAD_DIM, 2, dtype=f32) / HEAD_DIM)
    ang = positions.astype(f32)[..., None] * inv_freq
    emb = jnp.concatenate([ang, ang], axis=-1)[:, :, None, None, :]
    cos = jnp.cos(emb)
    sin = jnp.sin(emb)

    for l in range(DEPTH):
        h = rms_norm(x, mix_norm[l])
        z = h @ w_in[l]
        u, q, k, v, g_ssm, g_attn = jnp.split(z, SPLITS, axis=-1)

        y_a = s5_branch(u, ssm_lambda_re[l], ssm_lambda_im[l], ssm_log_dt[l], ssm_b_re[l], ssm_b_im[l],
                        ssm_c_re[l], ssm_c_im[l], ssm_d[l])
        y_a = jax.nn.gelu(y_a)
        y_a = y_a * jax.nn.sigmoid(y_a @ w_glu[l] + b_glu[l])

        q = apply_rope(q.reshape(bsz, s, N_HEADS, 2, HEAD_DIM), cos, sin)
        k = apply_rope(k.reshape(bsz, s, N_HEADS, 2, HEAD_DIM), cos, sin)
        v = v.reshape(bsz, s, N_HEADS, V_DIM)
        lam_init = 0.8 - 0.6 * math.exp(-0.3 * l)
        lam = (jnp.exp(jnp.sum(lambda_q1[l].astype(f32) * lambda_k1[l].astype(f32)))
               - jnp.exp(jnp.sum(lambda_q2[l].astype(f32) * lambda_k2[l].astype(f32))) + lam_init)
        o = diff_attention(q, k, v, lam)
        o = rms_norm(o, subln[l], SUBLN_EPS) * (1.0 - lam_init)
        y_b = o.reshape(bsz, s, ATTN_WIDTH)

        m = jax.nn.sigmoid(g_ssm) * (y_a @ w_proj_ssm[l]) + jax.nn.sigmoid(g_attn) * (y_b @ w_proj_attn[l])
        x = x + m @ w_out[l]

        h = rms_norm(x, ffn_norm[l])
        if l % 2 == 0:
            i = l // 2
            f = swiglu(h, dense_w_gate[i], dense_w_up[i], dense_w_down[i])
        else:
            i = l // 2
            f = moe_swiglu(h, router_w[i], moe_w_gate[i], moe_w_up[i], moe_w_down[i])
        x = x + f

    return rms_norm(x, final_norm)
```

```cpp
#include <hip/hip_runtime.h>
#include <hip/hip_bf16.h>
#include <cstdio>
#include <cstdint>
#include <cmath>
namespace pg8 {
#define PG8_LAS __attribute__((address_space(3)))
typedef unsigned short bf16_t;
typedef short bf16x8 __attribute__((ext_vector_type(8)));
typedef float f32x4 __attribute__((ext_vector_type(4)));
typedef unsigned u32x4 __attribute__((ext_vector_type(4)));
constexpr int BM = 256, BK = 64, HALF = 128, HTB = HALF * BK * 2  , STAGE_BYTES = 8 * HTB, NXCD = 8, WGM = 8;

__host__ __device__ __forceinline__ int lds_byte(int r, int c) { const int st = (r >> 4) * 2 + (c >> 5), rr = r & 15, cc = c & 31, ob = rr * 64 + cc * 2; return st * 1024 + (ob ^ (((ob >> 9) & 1) << 5)); }
__host__ __device__ __forceinline__ void stage_rc(int b, int& R, int& C) { const int st = b / 1024, sb = b % 1024, swz = sb ^ (((sb >> 9) & 1) << 5); R = (st >> 1) * 16 + swz / 64; C = (st & 1) * 32 + (swz % 64) / 2; }
__host__ __device__ __forceinline__ int perm32(int rho) { const int n = rho >> 4, i = rho & 15; return 8 * (i >> 2) + 4 * n + (i & 3); }

struct Unit { int pm, pn; };
struct Gemm { const bf16_t* A; const bf16_t* Bt; int lda, ldb, K; };

struct StaticOrder {
    int nM, nN, nwg, G, c;
    __host__ __device__ void init(int nM_, int nN_, int G_, int c_) { nM = nM_; nN = nN_; nwg = nM * nN; G = G_; c = c_; }
    __host__ __device__ bool next(int i, Unit& u) const {
        const long L = (long)i * G + c; if (L >= nwg) return false;
        int wgid = (int)L; { const int q = nwg / NXCD, r = nwg % NXCD, xcd = wgid % NXCD, off = wgid / NXCD; wgid = (xcd < r ? xcd * (q + 1) : r * (q + 1) + (xcd - r) * q) + off; }
        const int nig = WGM * nN, gid = wgid / nig, fm = gid * WGM, gsz = (nM - fm) < WGM ? (nM - fm) : WGM;
        u.pm = fm + ((wgid % nig) % gsz); u.pn = (wgid % nig) / gsz; return true;
    }
    __device__ __forceinline__ void a_ready(const Unit&) const {}
    __device__ __forceinline__ void done(const Unit&) const {}
};


struct SchedPlain {
    StaticOrder so;
    __device__ __forceinline__ void init(int nM, int nN, int G, int c) { so.init(nM, nN, G, c); }
    __device__ __forceinline__ bool next(int i, Unit& u) const { return so.next(i, u); }
    __device__ __forceinline__ void a_ready(const Unit&) const {}
    __device__ __forceinline__ void done(const Unit&) const {}
};
struct SchedS5 {
    StaticOrder so; int nng;
    __device__ __forceinline__ void init(int nng_, int G, int c) { nng = nng_; so.init(128, nng_, G, c); }
    __device__ __forceinline__ bool next(int i, Unit& u) const { if (!so.next(i, u)) return false; u.pn = (u.pm >> 2) * nng + u.pn; return true; }
    __device__ __forceinline__ void a_ready(const Unit&) const {}
    __device__ __forceinline__ void done(const Unit&) const {}
};
struct SchedMoe {
    StaticOrder so; int nn; int sp1, sp2, sp3, sp4, sp5, sp6, sp7;
    __device__ __forceinline__ bool next(int i, Unit& u) const {
        if (!so.next(i, u)) return false;
        const int pm = u.pm; const int e = (pm >= sp1) + (pm >= sp2) + (pm >= sp3) + (pm >= sp4) + (pm >= sp5) + (pm >= sp6) + (pm >= sp7);
        u.pn = e * nn + u.pn; return true;
    }
    __device__ __forceinline__ void a_ready(const Unit&) const {}
    __device__ __forceinline__ void done(const Unit&) const {}
};

typedef float f32x2c_t __attribute__((ext_vector_type(2))); typedef __bf16 bf16x2c_t __attribute__((ext_vector_type(2)));
__device__ __forceinline__ unsigned cvt_pk_bf16(float lo, float hi) { f32x2c_t v = {lo, hi}; bf16x2c_t b = __builtin_convertvector(v, bf16x2c_t); return __builtin_bit_cast(unsigned, b); }
__device__ __forceinline__ u32x4 pack8(const f32x4 a, const f32x4 b) { u32x4 w; w.x = cvt_pk_bf16(a[0], a[1]); w.y = cvt_pk_bf16(a[2], a[3]); w.z = cvt_pk_bf16(b[0], b[1]); w.w = cvt_pk_bf16(b[2], b[3]); return w; }
__device__ __forceinline__ void unpack8(const u32x4 w, f32x4& a, f32x4& b) {
    a[0] = __uint_as_float(w.x << 16); a[1] = __uint_as_float(w.x & 0xffff0000u); a[2] = __uint_as_float(w.y << 16); a[3] = __uint_as_float(w.y & 0xffff0000u);
    b[0] = __uint_as_float(w.z << 16); b[1] = __uint_as_float(w.z & 0xffff0000u); b[2] = __uint_as_float(w.w << 16); b[3] = __uint_as_float(w.w & 0xffff0000u); }
__device__ __forceinline__ float sigm(float z) { return __builtin_amdgcn_rcpf(1.0f + __builtin_amdgcn_exp2f(-1.4426950408889634f * z)); }
__device__ __forceinline__ f32x4 sigm4(const f32x4 z) { f32x4 r; r[0] = sigm(z[0]); r[1] = sigm(z[1]); r[2] = sigm(z[2]); r[3] = sigm(z[3]); return r; }
__device__ __forceinline__ float gelu_t(float x) { const float u = 1.5957691216057308f * (x + 0.044715f * x * x * x); return x * sigm(u); }
__device__ __forceinline__ f32x4 gelu4(const f32x4 z) { f32x4 r; r[0] = gelu_t(z[0]); r[1] = gelu_t(z[1]); r[2] = gelu_t(z[2]); r[3] = gelu_t(z[3]); return r; }
constexpr size_t EA_U = (size_t)64 << 20, EA_Q = (size_t)120 << 20, EA_K = (size_t)184 << 20, EA_V = (size_t)248 << 20, EA_SGS = (size_t)312 << 20, EA_SGA = (size_t)376 << 20;
constexpr float QSCALE = 0.125f * 1.4426950408889634f;

struct EpiIn {
    static constexpr bool PERM = true, AFTER_DRAIN = false;
    unsigned char* act; const float* rope; int tokbase;
    __device__ __forceinline__ void operator()(const f32x4 (&acc)[2][2][4][2], const Unit& u, int wr, int wc, int fr_in, int fq_in) const {
        int fr = fr_in, fq = fq_in; asm volatile("" : "+v"(fr), "+v"(fq));
        const int pn = u.pn, rowb = u.pm * BM + wr * 64 + fr, cow = wc * 32 + fq * 8;
        if (pn < 2) {
#pragma unroll
            for (int ai = 0; ai < 2; ++ai)
#pragma unroll
                for (int m = 0; m < 4; ++m) { const int row = rowb + ai * HALF + m * 16;
#pragma unroll
                    for (int bj = 0; bj < 2; ++bj) { const int c = pn * 256 + bj * HALF + cow; const int g = c >> 4, jj = c & 15;
                        bf16_t* dst = (bf16_t*)(act + EA_U) + ((size_t)(g * 1024 + (row >> 5)) * 640 + (row & 31) * 16 + jj);
                        *(u32x4*)dst = pack8(acc[ai][bj][m][0], acc[ai][bj][m][1]); } }
        } else if (pn < 10) {
            const bool isq = pn < 6; bf16_t* base = (bf16_t*)(act + (isq ? EA_Q : EA_K)); const int colt = (isq ? pn - 2 : pn - 6) * 256; const float sc = isq ? QSCALE : 1.0f;
            const int dlo = 16 * (wc & 1) + 4 * fq;
#pragma unroll
            for (int ai = 0; ai < 2; ++ai)
#pragma unroll
                for (int m = 0; m < 4; ++m) { const int row = rowb + ai * HALF + m * 16;
                    const float* tr = rope + (size_t)(tokbase + row) * 64 + dlo; const f32x4 cs = *(const f32x4*)tr, sn = *(const f32x4*)(tr + 32);
#pragma unroll
                    for (int bj = 0; bj < 2; ++bj) { const f32x4 v0 = acc[ai][bj][m][0], v1 = acc[ai][bj][m][1];
                        const f32x4 o0 = (v0 * cs - v1 * sn) * sc, o1 = (v1 * cs + v0 * sn) * sc;
                        *(u32x4*)(base + (size_t)row * 1024 + colt + bj * HALF + cow) = pack8(o0, o1); } }
        } else if (pn < 14) {
            const int colt = (pn - 10) * 256;
#pragma unroll
            for (int ai = 0; ai < 2; ++ai)
#pragma unroll
                for (int m = 0; m < 4; ++m) { const int row = rowb + ai * HALF + m * 16;
#pragma unroll
                    for (int bj = 0; bj < 2; ++bj) *(u32x4*)((bf16_t*)(act + EA_V) + (size_t)row * 1024 + colt + bj * HALF + cow) = pack8(acc[ai][bj][m][0], acc[ai][bj][m][1]); }
        } else {
            bf16_t* base = (bf16_t*)(act + (pn < 18 ? EA_SGS : EA_SGA)); const int colt = (pn < 18 ? pn - 14 : pn - 18) * 256;
#pragma unroll
            for (int ai = 0; ai < 2; ++ai)
#pragma unroll
                for (int m = 0; m < 4; ++m) { const int row = rowb + ai * HALF + m * 16;
#pragma unroll
                    for (int bj = 0; bj < 2; ++bj) *(u32x4*)(base + (size_t)row * 1024 + colt + bj * HALF + cow) = pack8(sigm4(acc[ai][bj][m][0]), sigm4(acc[ai][bj][m][1])); }
        }
    }
};
struct EpiSloc {
    static constexpr bool PERM = false, AFTER_DRAIN = false;
    float* S;
    __device__ __forceinline__ void operator()(const f32x4 (&acc)[2][2][4][2], const Unit& u, int wr, int wc, int fr_in, int fq_in) const {
        int fr = fr_in, fq = fq_in; asm volatile("" : "+v"(fr), "+v"(fq));
        const int rowb = u.pm * BM + wr * 64 + fr, col0 = wc * 32 + 4 * fq;
#pragma unroll
        for (int ai = 0; ai < 2; ++ai)
#pragma unroll
            for (int m = 0; m < 4; ++m) { float* rowp = S + (size_t)(rowb + ai * HALF + m * 16) * 128 + col0;
#pragma unroll
                for (int n = 0; n < 2; ++n) *(f32x4*)(rowp + n * 16) = acc[ai][0][m][n]; }
    }
};
struct EpiYa {
    static constexpr bool PERM = true, AFTER_DRAIN = false;
    bf16_t* YA;
    __device__ __forceinline__ void operator()(const f32x4 (&acc)[2][2][4][2], const Unit& u, int wr, int wc, int fr_in, int fq_in) const {
        int fr = fr_in, fq = fq_in; asm volatile("" : "+v"(fr), "+v"(fq));
        const int g = u.pm >> 2, pni = u.pn & 1; const int rowb = (u.pm & 3) * BM + wr * 64 + fr; const int jj = 8 * (fq & 1);
#pragma unroll
        for (int ai = 0; ai < 2; ++ai)
#pragma unroll
            for (int m = 0; m < 4; ++m) { const int R = rowb + ai * HALF + m * 16;
#pragma unroll
                for (int bj = 0; bj < 2; ++bj) { const int t = pni * 16 + bj * 8 + wc * 2 + (fq >> 1);
                    *(u32x4*)(YA + (size_t)(R * 32 + t) * 512 + g * 16 + jj) = pack8(gelu4(acc[ai][bj][m][0]), gelu4(acc[ai][bj][m][1])); } }
    }
};
struct EpiGlu {
    static constexpr bool PERM = true, AFTER_DRAIN = false;
    const bf16_t* YA; bf16_t* O; const float* bias;
    __device__ __forceinline__ void operator()(const f32x4 (&acc)[2][2][4][2], const Unit& u, int wr, int wc, int fr_in, int fq_in) const {
        int fr = fr_in, fq = fq_in; asm volatile("" : "+v"(fr), "+v"(fq));
        const int rowb = u.pm * BM + wr * 64 + fr, col0 = u.pn * BM + wc * 32 + 8 * fq;
        f32x4 bv[2][2];
#pragma unroll
        for (int bj = 0; bj < 2; ++bj)
#pragma unroll
            for (int n = 0; n < 2; ++n) bv[bj][n] = *(const f32x4*)(bias + col0 + bj * HALF + 4 * n);
#pragma unroll
        for (int ai = 0; ai < 2; ++ai)
#pragma unroll
            for (int m = 0; m < 4; ++m) { const size_t off = (size_t)(rowb + ai * HALF + m * 16) * 512 + col0;
#pragma unroll
                for (int bj = 0; bj < 2; ++bj) { f32x4 y0, y1; unpack8(*(const u32x4*)(YA + off + bj * HALF), y0, y1);
                    *(u32x4*)(O + off + bj * HALF) = pack8(y0 * sigm4(acc[ai][bj][m][0] + bv[bj][0]), y1 * sigm4(acc[ai][bj][m][1] + bv[bj][1])); } }
    }
};
template <int MODE> struct EpiGate {
    static constexpr bool PERM = true, AFTER_DRAIN = false;
    bf16_t* G; const bf16_t* T0;
    __device__ __forceinline__ void operator()(const f32x4 (&acc)[2][2][4][2], const Unit& u, int wr, int wc, int fr_in, int fq_in) const {
        int fr = fr_in, fq = fq_in; asm volatile("" : "+v"(fr), "+v"(fq));
        const int rowb = u.pm * BM + wr * 64 + fr, col0 = u.pn * BM + wc * 32 + 8 * fq;
#pragma unroll
        for (int ai = 0; ai < 2; ++ai)
#pragma unroll
            for (int m = 0; m < 4; ++m) { const size_t off = (size_t)(rowb + ai * HALF + m * 16) * 1024 + col0;
#pragma unroll
                for (int bj = 0; bj < 2; ++bj) { f32x4 g0, g1; unpack8(*(const u32x4*)(G + off + bj * HALF), g0, g1);
                    f32x4 o0 = g0 * acc[ai][bj][m][0], o1 = g1 * acc[ai][bj][m][1];
                    if (MODE == 1) { f32x4 t0, t1; unpack8(*(const u32x4*)(T0 + off + bj * HALF), t0, t1); o0 += t0; o1 += t1; }
                    *(u32x4*)(G + off + bj * HALF) = pack8(o0, o1); } }
    }
};
struct EpiRes {
    static constexpr bool PERM = false, AFTER_DRAIN = false;
    const float* xin; float* xout; int tokbase;
    __device__ __forceinline__ void operator()(const f32x4 (&acc)[2][2][4][2], const Unit& u, int wr, int wc, int fr_in, int fq_in) const {
        int fr = fr_in, fq = fq_in; asm volatile("" : "+v"(fr), "+v"(fq));
        const int rowb = tokbase + u.pm * BM + wr * 64 + fr, col0 = u.pn * BM + wc * 32 + 4 * fq;
#pragma unroll
        for (int ai = 0; ai < 2; ++ai)
#pragma unroll
            for (int m = 0; m < 4; ++m) { const size_t off = (size_t)(rowb + ai * HALF + m * 16) * 1024 + col0;
#pragma unroll
                for (int bj = 0; bj < 2; ++bj)
#pragma unroll
                    for (int n = 0; n < 2; ++n) { const f32x4 xi = *(const f32x4*)(xin + off + bj * HALF + n * 16); *(f32x4*)(xout + off + bj * HALF + n * 16) = xi + acc[ai][bj][m][n]; } }
    }
};
struct EpiSwi {
    static constexpr bool PERM = true, AFTER_DRAIN = false;
    bf16_t* O;
    __device__ __forceinline__ void operator()(const f32x4 (&acc)[2][2][4][2], const Unit& u, int wr, int wc, int fr_in, int fq_in) const {
        int fr = fr_in, fq = fq_in; asm volatile("" : "+v"(fr), "+v"(fq));
        const int rowb = u.pm * BM + wr * 64 + fr, col0 = (u.pn % 22) * HALF + wc * 32 + 8 * fq;
#pragma unroll
        for (int ai = 0; ai < 2; ++ai)
#pragma unroll
            for (int m = 0; m < 4; ++m) { const f32x4 g0 = acc[ai][0][m][0], g1 = acc[ai][0][m][1];
                *(u32x4*)(O + (size_t)(rowb + ai * HALF + m * 16) * 2816 + col0) = pack8(g0 * sigm4(g0) * acc[ai][1][m][0], g1 * sigm4(g1) * acc[ai][1][m][1]); }
    }
};
struct EpiBf {
    static constexpr bool PERM = true, AFTER_DRAIN = false;
    bf16_t* O;
    __device__ __forceinline__ void operator()(const f32x4 (&acc)[2][2][4][2], const Unit& u, int wr, int wc, int fr_in, int fq_in) const {
        int fr = fr_in, fq = fq_in; asm volatile("" : "+v"(fr), "+v"(fq));
        const int rowb = u.pm * BM + wr * 64 + fr, col0 = (u.pn & 3) * BM + wc * 32 + 8 * fq;
#pragma unroll
        for (int ai = 0; ai < 2; ++ai)
#pragma unroll
            for (int m = 0; m < 4; ++m)
#pragma unroll
                for (int bj = 0; bj < 2; ++bj) *(u32x4*)(O + (size_t)(rowb + ai * HALF + m * 16) * 1024 + col0 + bj * HALF) = pack8(acc[ai][bj][m][0], acc[ai][bj][m][1]);
    }
};

template <class Epi, class Sched, bool ALIGN_EPI = false, bool SP2 = false>
__device__ __forceinline__ void gemm_phase(PG8_LAS unsigned char* lds, const Gemm g, const Sched& S, const Epi& E, const int tid_in) {
    const int tid = tid_in, wid = __builtin_amdgcn_readfirstlane(tid >> 6), lane = tid & 63, wr = wid >> 2, wc = wid & 3, fr = lane & 15, fq = lane >> 4;
    const int K = g.K, nt = K / BK;
    unsigned voffA[2], voffB[2];
#pragma unroll
    for (int i = 0; i < 2; ++i) { int R, C; stage_rc(tid * 16 + i * 8192, R, C); const int Rb = Epi::PERM ? ((R & ~31) + perm32(R & 31)) : R;
        voffA[i] = (unsigned)(R * g.lda + C) * 2u; voffB[i] = (unsigned)(Rb * g.ldb + C) * 2u; }
    const size_t kstep = (size_t)(BK * 2);
    const size_t hstepA = (size_t)HALF * g.lda * 2, hstepB = (size_t)HALF * g.ldb * 2;
    const size_t tstepA = 2 * hstepA, tstepB = 2 * hstepB;
    const unsigned ldsw = (unsigned)wid * 1024u;
    const int aoff = lds_byte(wr * 64 + fr, fq * 8), boff = lds_byte(wc * 32 + fr, fq * 8);
#define PG8_SA(b, h) (((b) * 2 + (h)) * HTB)
#define PG8_SB(b, h) ((4 + (b) * 2 + (h)) * HTB)
#define PG8_STAGE(bufoff, gbase, voff) do { _Pragma("unroll") for (int _i = 0; _i < 2; ++_i) \
        __builtin_amdgcn_global_load_lds((const unsigned*)((const char*)(gbase) + (voff)[_i]), (PG8_LAS unsigned*)(lds + (bufoff) + ldsw + _i * 8192), 16, 0, 0); } while (0)
#define PG8_LDA(dst, b, h) do { _Pragma("unroll") for (int m = 0; m < 4; ++m) _Pragma("unroll") for (int k = 0; k < 2; ++k) dst[m][k] = *(const PG8_LAS bf16x8*)(lds + PG8_SA(b, h) + aoff + m * 2048 + k * 1024); } while (0)
#define PG8_LDB(dst, b, h) do { _Pragma("unroll") for (int n = 0; n < 2; ++n) _Pragma("unroll") for (int k = 0; k < 2; ++k) dst[n][k] = *(const PG8_LAS bf16x8*)(lds + PG8_SB(b, h) + boff + n * 2048 + k * 1024); } while (0)
#define PG8_MMA(ai, bj, At, Bt) do { __builtin_amdgcn_s_setprio(1); _Pragma("unroll") for (int m = 0; m < 4; ++m) _Pragma("unroll") for (int n = 0; n < 2; ++n) _Pragma("unroll") for (int k = 0; k < 2; ++k) \
        acc[ai][bj][m][n] = __builtin_amdgcn_mfma_f32_16x16x32_bf16(Bt[n][k], At[m][k], acc[ai][bj][m][n], 0, 0, 0); __builtin_amdgcn_s_setprio(0); } while (0)
#define PG8_WAIT_V(n) asm volatile("s_waitcnt vmcnt(" #n ")" ::: "memory")
#define PG8_WAIT_L(n) asm volatile("s_waitcnt lgkmcnt(" #n ")" ::: "memory")
#define PG8_BAR __builtin_amdgcn_s_barrier()
#define PG8_SCHED __builtin_amdgcn_sched_barrier(0)
    Unit cur, nxt; int ui = 0;
    if (!S.next(0, cur)) return;
    f32x4 acc[2][2][4][2];
#pragma unroll
    for (int a = 0; a < 2; ++a)
#pragma unroll
        for (int b = 0; b < 2; ++b)
#pragma unroll
            for (int m = 0; m < 4; ++m)
#pragma unroll
                for (int n = 0; n < 2; ++n) acc[a][b][m][n] = (f32x4){0.f, 0.f, 0.f, 0.f};
    bf16x8 At[4][2], B0[2][2], B1[2][2];
    const char* cA = (const char*)g.A + (size_t)cur.pm * tstepA; const char* cB = (const char*)g.Bt + (size_t)cur.pn * tstepB;
    S.a_ready(cur);
    if constexpr (SP2) {
        PG8_STAGE(PG8_SB(0, 0), cB, voffB); PG8_STAGE(PG8_SB(0, 1), cB + hstepB, voffB); PG8_STAGE(PG8_SA(0, 0), cA, voffA); PG8_STAGE(PG8_SA(0, 1), cA + hstepA, voffA);
        if (wr == 1) PG8_BAR;
        PG8_WAIT_V(2); PG8_BAR;
        PG8_STAGE(PG8_SB(1, 0), cB + kstep, voffB); PG8_STAGE(PG8_SA(1, 0), cA + kstep, voffA); PG8_STAGE(PG8_SB(1, 1), cB + hstepB + kstep, voffB);
        PG8_WAIT_V(6); PG8_BAR;
    } else {
        PG8_STAGE(PG8_SB(0, 0), cB, voffB); PG8_STAGE(PG8_SA(0, 0), cA, voffA); PG8_STAGE(PG8_SB(0, 1), cB + hstepB, voffB); PG8_STAGE(PG8_SA(0, 1), cA + hstepA, voffA);
        if (wr == 1) PG8_BAR;
        PG8_WAIT_V(4); PG8_BAR;
        PG8_STAGE(PG8_SB(1, 0), cB + kstep, voffB); PG8_STAGE(PG8_SA(1, 0), cA + kstep, voffA); PG8_STAGE(PG8_SB(1, 1), cB + hstepB + kstep, voffB);
        PG8_WAIT_V(6); PG8_BAR;
    }
    for (;;) {
        const bool has_next = S.next(ui + 1, nxt);
        const char* nA = has_next ? (const char*)g.A + (size_t)nxt.pm * tstepA : cA; const char* nB = has_next ? (const char*)g.Bt + (size_t)nxt.pn * tstepB : cB;
        for (int t = 0; t < nt; t += 2) {
            const bool last = (t == nt - 2);
            const char* a1 = cA + (size_t)(t + 1) * kstep;
            const char* a2 = last ? nA : cA + (size_t)(t + 2) * kstep; const char* b2 = last ? nB : cB + (size_t)(t + 2) * kstep;
            const char* a3 = a2 + kstep; const char* b3 = b2 + kstep;
            if (last && has_next) S.a_ready(nxt);
            if constexpr (SP2) {
            PG8_LDB(B0, 0, 0); PG8_LDB(B1, 0, 1); PG8_SCHED; PG8_LDA(At, 0, 0); PG8_STAGE(PG8_SA(1, 1), a1 + hstepA, voffA);
            PG8_WAIT_V(8); PG8_WAIT_L(0); PG8_BAR; PG8_MMA(0, 0, At, B0); PG8_MMA(0, 1, At, B1); PG8_BAR; PG8_SCHED;
            PG8_LDA(At, 0, 1); PG8_STAGE(PG8_SB(0, 0), b2, voffB); PG8_STAGE(PG8_SB(0, 1), b2 + hstepB, voffB); PG8_STAGE(PG8_SA(0, 0), a2, voffA);
            PG8_WAIT_V(8); PG8_WAIT_L(0); PG8_BAR; PG8_MMA(1, 0, At, B0); PG8_MMA(1, 1, At, B1); PG8_BAR; PG8_SCHED;
            PG8_LDB(B0, 1, 0); PG8_LDB(B1, 1, 1); PG8_SCHED; PG8_LDA(At, 1, 0); PG8_STAGE(PG8_SA(0, 1), a2 + hstepA, voffA);
            PG8_WAIT_V(8); PG8_WAIT_L(0); PG8_BAR; PG8_MMA(0, 0, At, B0); PG8_MMA(0, 1, At, B1); PG8_BAR; PG8_SCHED;
            PG8_LDA(At, 1, 1); PG8_STAGE(PG8_SB(1, 0), b3, voffB); PG8_STAGE(PG8_SB(1, 1), b3 + hstepB, voffB); PG8_STAGE(PG8_SA(1, 0), a3, voffA);
            PG8_WAIT_V(8); PG8_WAIT_L(0); PG8_BAR; PG8_MMA(1, 0, At, B0); PG8_MMA(1, 1, At, B1); PG8_BAR; PG8_SCHED;
            } else {
            PG8_LDB(B0, 0, 0); PG8_SCHED; PG8_LDA(At, 0, 0); PG8_STAGE(PG8_SA(1, 1), a1 + hstepA, voffA);
            PG8_WAIT_L(8); PG8_BAR; PG8_WAIT_L(0); PG8_MMA(0, 0, At, B0); PG8_BAR; PG8_SCHED;
            PG8_LDB(B1, 0, 1); PG8_STAGE(PG8_SB(0, 0), b2, voffB);
            PG8_BAR; PG8_WAIT_L(0); PG8_MMA(0, 1, At, B1); PG8_BAR;
            PG8_LDA(At, 0, 1); PG8_STAGE(PG8_SA(0, 0), a2, voffA);
            PG8_BAR; PG8_WAIT_L(0); PG8_MMA(1, 0, At, B0); PG8_BAR; PG8_SCHED;
            PG8_STAGE(PG8_SB(0, 1), b2 + hstepB, voffB);
            PG8_WAIT_V(6); PG8_BAR; PG8_MMA(1, 1, At, B1); PG8_BAR;
            PG8_LDB(B0, 1, 0); PG8_SCHED; PG8_LDA(At, 1, 0); PG8_STAGE(PG8_SA(0, 1), a2 + hstepA, voffA);
            PG8_WAIT_L(8); PG8_BAR; PG8_WAIT_L(0); PG8_MMA(0, 0, At, B0); PG8_BAR; PG8_SCHED;
            PG8_LDB(B1, 1, 1); PG8_STAGE(PG8_SB(1, 0), b3, voffB);
            PG8_BAR; PG8_WAIT_L(0); PG8_MMA(0, 1, At, B1); PG8_BAR;
            PG8_LDA(At, 1, 1); PG8_STAGE(PG8_SA(1, 0), a3, voffA);
            PG8_BAR; PG8_WAIT_L(0); PG8_MMA(1, 0, At, B0); PG8_BAR; PG8_SCHED;
            PG8_STAGE(PG8_SB(1, 1), b3 + hstepB, voffB);
            PG8_WAIT_V(6); PG8_BAR; PG8_MMA(1, 1, At, B1); PG8_BAR;
            }
        }
        if constexpr (ALIGN_EPI) { if (wr == 0) PG8_BAR; }
        if constexpr (!Epi::AFTER_DRAIN) { E(acc, cur, wr, wc, fr, fq); S.done(cur); }
        if (!has_next) break;
#pragma unroll
        for (int a = 0; a < 2; ++a)
#pragma unroll
            for (int b = 0; b < 2; ++b)
#pragma unroll
                for (int m = 0; m < 4; ++m)
#pragma unroll
                    for (int n = 0; n < 2; ++n) acc[a][b][m][n] = (f32x4){0.f, 0.f, 0.f, 0.f};
        cur = nxt; cA = nA; cB = nB; ++ui;
        if constexpr (ALIGN_EPI) { if (wr == 1) PG8_BAR; }
    }
    PG8_WAIT_V(0);
    if constexpr (!ALIGN_EPI) { if (wr == 0) PG8_BAR; }
    PG8_BAR;
    if constexpr (Epi::AFTER_DRAIN) { E.fused(acc, cur, wr, wc, fr, fq, lds, wid, lane); S.done(cur); }
#undef PG8_SA
#undef PG8_SB
#undef PG8_STAGE
#undef PG8_LDA
#undef PG8_LDB
#undef PG8_MMA
#undef PG8_WAIT_V
#undef PG8_WAIT_L
#undef PG8_BAR
#undef PG8_SCHED
}
}

#include <hip/hip_bf16.h>
#include <cmath>
namespace attn_body {
using bf16=__hip_bfloat16;
using bf16x8=__attribute__((ext_vector_type(8)))short;
using s16x4=__attribute__((ext_vector_type(4)))short;
using f32x16=__attribute__((ext_vector_type(16)))float;
using u32x4=__attribute__((ext_vector_type(4)))unsigned;
constexpr int SEQ=4096,D=64,DM=1024,OPITCH=2048;
constexpr int NW=8,QBLK=32,QB=QBLK*NW,KVBLK=64,NQB=SEQ/QB;
constexpr int ATTN_PITCH=DM, ATTN_UNIT_ROWS=QB;
__device__ __forceinline__ int crow(int r,int hi){return (r&3)+8*(r>>2)+4*hi;}
#define SBAR() __builtin_amdgcn_sched_barrier(0)
__device__ __forceinline__ void cmask(f32x16&p0,f32x16&p1,int jb,int qrel,int hi){
  const float NEG=-INFINITY; int kb=64*jb+4*hi;
  #pragma unroll
  for(int r=0;r<16;++r){int kv=kb+(r&3)+8*(r>>2); if(kv>qrel)p0[r]=NEG; if(kv+32>qrel)p1[r]=NEG;}
}

constexpr int NSLOT=3, SLOTB=8192;
constexpr int LDS_K=0, LDS_V=NSLOT*SLOTB, LDS_WS=2*NSLOT*SLOTB, LDS_OST=LDS_WS+NW*64*4, LDS_BYTES=LDS_OST+NW*4096;
constexpr float C2=0.125f*1.4426950408889634f;
__device__ __forceinline__ void glds16(const void*gsrc,unsigned lds_dst){unsigned keep;
  asm volatile("s_mov_b32 %0, m0\n\ts_mov_b32 m0, %2\n\ts_nop 0\n\tglobal_load_lds_dwordx4 %1, off\n\ts_mov_b32 m0, %0":"=&s"(keep):"v"(gsrc),"s"(lds_dst):"memory");}
__device__ __forceinline__ float max3f(float a,float b,float c){float r;asm("v_max3_f32 %0, %1, %2, %3":"=v"(r):"v"(a),"v"(b),"v"(c));return r;}
__device__ __forceinline__ float max2f(float a,float b){float r;asm("v_max_f32_e32 %0, %1, %2":"=v"(r):"v"(a),"v"(b));return r;}
__device__ __forceinline__ float fadd_s(float a,float b){float r;asm("v_add_f32_e32 %0, %1, %2":"=v"(r):"v"(a),"v"(b));return r;}
__device__ __forceinline__ float fsub_s(float a,float b){float r;asm("v_sub_f32_e32 %0, %1, %2":"=v"(r):"v"(a),"v"(b));return r;}
typedef float f32x2_t __attribute__((ext_vector_type(2))); typedef __bf16 bf16x2_t __attribute__((ext_vector_type(2)));
__device__ __forceinline__ unsigned cvtpk_s(float lo,float hi){f32x2_t v={lo,hi};bf16x2_t b=__builtin_convertvector(v,bf16x2_t);return __builtin_bit_cast(unsigned,b);}
#define WAIT_BAR(N) asm volatile("s_waitcnt vmcnt(" #N ") lgkmcnt(0)\n\ts_barrier":::"memory")

__device__ __forceinline__ void qkt(f32x16&p0,f32x16&p1,const char*Kslot,const bf16x8*qr,int r32,int hi){
  const char*kb=Kslot+hi*1024+r32*16;
  #pragma unroll
  for(int d0=0;d0<4;++d0){
    const bf16x8 b0=*reinterpret_cast<const bf16x8*>(kb+d0*2048);
    const bf16x8 b1=*reinterpret_cast<const bf16x8*>(kb+d0*2048+512);
    if(d0==0){f32x16 z0=f32x16{},z1=f32x16{};asm volatile("":"+v"(z0),"+v"(z1));
      p0=__builtin_amdgcn_mfma_f32_32x32x16_bf16(b0,qr[0],z0,0,0,0);p1=__builtin_amdgcn_mfma_f32_32x32x16_bf16(b1,qr[0],z1,0,0,0);}
    else{p0=__builtin_amdgcn_mfma_f32_32x32x16_bf16(b0,qr[d0],p0,0,0,0);p1=__builtin_amdgcn_mfma_f32_32x32x16_bf16(b1,qr[d0],p1,0,0,0);}}
}
typedef __attribute__((address_space(3))) const char* lds_cptr;
typedef short v4i16_t __attribute__((ext_vector_type(4)));
__device__ __forceinline__ void kload8(bf16x8*kf,lds_cptr kp){
  kf[0]=*(const __attribute__((address_space(3))) bf16x8*)(kp);      kf[1]=*(const __attribute__((address_space(3))) bf16x8*)(kp+512);
  kf[2]=*(const __attribute__((address_space(3))) bf16x8*)(kp+2048); kf[3]=*(const __attribute__((address_space(3))) bf16x8*)(kp+2560);
  kf[4]=*(const __attribute__((address_space(3))) bf16x8*)(kp+4096); kf[5]=*(const __attribute__((address_space(3))) bf16x8*)(kp+4608);
  kf[6]=*(const __attribute__((address_space(3))) bf16x8*)(kp+6144); kf[7]=*(const __attribute__((address_space(3))) bf16x8*)(kp+6656);
}
__device__ __forceinline__ void kload2(bf16x8*kf,lds_cptr kp,int j){ kf[2*j]=*(const __attribute__((address_space(3))) bf16x8*)(kp+j*2048); kf[2*j+1]=*(const __attribute__((address_space(3))) bf16x8*)(kp+j*2048+512); }
__device__ __forceinline__ s16x4 vtr(lds_cptr p){ return __builtin_bit_cast(s16x4,__builtin_amdgcn_ds_read_tr16_b64_v4i16((__attribute__((address_space(3))) v4i16_t*)p)); }
__device__ __forceinline__ float rowmax(const f32x16&p0,const f32x16&p1){
  float a=max3f(p0[0],p0[1],p1[0]),b=max3f(p0[2],p0[3],p1[1]);a=max3f(a,p1[2],p1[3]);
  #pragma unroll
  for(int r=4;r<16;r+=4){a=max3f(a,p0[r],p0[r+1]);b=max3f(b,p0[r+2],p0[r+3]);a=max3f(a,p1[r],p1[r+1]);b=max3f(b,p1[r+2],p1[r+3]);}
  const float m=max2f(a,b);
  auto rr=__builtin_amdgcn_permlane32_swap(__float_as_uint(m),__float_as_uint(m),false,false);
  return max2f(__uint_as_float(rr[0]),__uint_as_float(rr[1]));
}
__device__ __forceinline__ void pv(f32x16*o,int vb,bf16x8 pa0,bf16x8 pa1,bf16x8 pa2,bf16x8 pa3){
  #pragma unroll
  for(int d0=0;d0<2;++d0){s16x4 lo[4],hi[4];
    #pragma unroll
    for(int ks=0;ks<4;++ks){
      asm volatile("ds_read_b64_tr_b16 %0,%1 offset:%c2":"=&v"(lo[ks]):"v"(vb),"i"(d0*4096+ks*1024):"memory");
      asm volatile("ds_read_b64_tr_b16 %0,%1 offset:%c2":"=&v"(hi[ks]):"v"(vb),"i"(d0*4096+ks*1024+512):"memory");}
    asm volatile("s_waitcnt lgkmcnt(0)":::"memory");SBAR();
    #define PK(k) (bf16x8){lo[k][0],lo[k][1],lo[k][2],lo[k][3],hi[k][0],hi[k][1],hi[k][2],hi[k][3]}
    o[d0]=__builtin_amdgcn_mfma_f32_32x32x16_bf16(pa0,PK(0),o[d0],0,0,0);
    o[d0]=__builtin_amdgcn_mfma_f32_32x32x16_bf16(pa1,PK(1),o[d0],0,0,0);
    o[d0]=__builtin_amdgcn_mfma_f32_32x32x16_bf16(pa2,PK(2),o[d0],0,0,0);
    o[d0]=__builtin_amdgcn_mfma_f32_32x32x16_bf16(pa3,PK(3),o[d0],0,0,0);
    #undef PK
  }
}

#ifndef ATTN_STORE16
#define ATTN_STORE16(p,v) (*(u32x4*)(p)=(v))
#endif
template<int THRL> __device__ __forceinline__ void attn_unit(int qb,const bf16*Qh,const bf16*__restrict__ Kh,const bf16*__restrict__ Vh,bf16*Oh,char*shm){
  int tid_=threadIdx.x; asm volatile("":"+v"(tid_)); const int tid=tid_,lane=tid&63,r32=lane&31,hi=lane>>5; const int wid=__builtin_amdgcn_readfirstlane(tid>>6);
  const int q0=qb*QB;
  const bf16*Qw=Qh+(long)(q0+wid*QBLK)*DM;
  const unsigned lds0=(unsigned)(uintptr_t)shm;
  float*wsf=(float*)(shm+LDS_WS)+wid*64;
  const bf16*ksrc=Kh+(long)lane*DM+wid*8;
  const bf16*vsrc=Vh+(long)(16*(wid&3)+(lane>>2))*DM+(wid>>2)*32+(lane&3)*8;
  const unsigned kdst=lds0+LDS_K+wid*1024, vdst=lds0+LDS_V+wid*1024;
  #define DMA_K(t,slot) glds16(ksrc+(long)(t)*KVBLK*DM,(unsigned)__builtin_amdgcn_readfirstlane(kdst+(slot)))
  #define DMA_V(t,slot) glds16(vsrc+(long)(t)*KVBLK*DM,(unsigned)__builtin_amdgcn_readfirstlane(vdst+(slot)))
  const int vb0=(int)(lds0+LDS_V)+((lane>>4)&1)*32+(lane&3)*8+(4*hi+((lane&15)>>2))*64;
  const char*Kbase=shm+LDS_K; bf16x8 kf[8];
  const lds_cptr shm3=(lds_cptr)shm; const lds_cptr kp0=shm3+LDS_K+hi*1024+r32*16; const lds_cptr vp0=shm3+LDS_V+((lane>>4)&1)*32+(lane&3)*8+(4*hi+((lane&15)>>2))*64;
  const int NT=(q0+QB)/KVBLK;
  DMA_K(0,0);DMA_V(0,0);DMA_K(1,SLOTB);
  bf16x8 qr[4];
  #pragma unroll
  for(int d0=0;d0<4;++d0)qr[d0]=*reinterpret_cast<const bf16x8*>(&Qw[(long)r32*DM+d0*16+hi*8]);
  float mhat=0.f,l_reg=0.f;f32x16 o[2];o[0]=f32x16{};o[1]=f32x16{};
  const int qrel=wid*QBLK+r32;
  #define CMASK(P0,P1,t) do{int jb_=(t)-(NT-4); if(jb_>=0)cmask(P0,P1,jb_,qrel,hi);}while(0)
  bool resc=false;
  #define START(P0,P1) do{ const float rm=rowmax(P0,P1); resc=false; \
    { const float dl=rm; mhat=fadd_s(mhat,dl); \
      _Pragma("unroll") for(int r=0;r<16;++r){P0[r]=fsub_s(P0[r],dl);P1[r]=fsub_s(P1[r],dl);} \
      } \
    _Pragma("unroll") for(int r=0;r<16;++r)P0[r]=__builtin_amdgcn_exp2f(P0[r]); }while(0)
  #define RESC() do{ if(resc){ asm volatile("s_waitcnt lgkmcnt(0)":::"memory"); \
      _Pragma("unroll") for(int d_=0;d_<2;++d_) _Pragma("unroll") for(int r=0;r<16;++r)o[d_][r]*=wsf[crow(r,hi)]; } }while(0)
  f32x16 pA0,pA1,pB0,pB1;
  int sl_prev=0,sl_cur=0,sl_next=SLOTB;
  #define ROT() do{sl_prev=sl_cur;sl_cur=sl_next;sl_next=(sl_next==(NSLOT-1)*SLOTB)?0:sl_next+SLOTB;}while(0)
  DMA_K(2,2*SLOTB);
  WAIT_BAR(3);
  qkt(pA0,pA1,Kbase,qr,r32,hi);asm volatile("s_nop 15\n\ts_nop 7":"+v"(pA0),"+v"(pA1));CMASK(pA0,pA1,0);
  START(pA0,pA1);
  _Pragma("unroll") for(int r=0;r<16;++r)pA1[r]=__builtin_amdgcn_exp2f(pA1[r]);
  WAIT_BAR(0);
  DMA_K(3,0);DMA_V(1,SLOTB);
  ROT();
  kload8(kf,kp0+sl_cur);
  WAIT_BAR(2);
  s16x4 vlo[8],vhi[8]; u32x4 pw0,pw1,pw2,pw3;
  #define PKW(P,B) cvtpk_s(P[B],P[B+1])
  #define PAF(k) __builtin_bit_cast(bf16x8,pw##k)
  #define VFR(i) (bf16x8){vlo[i][0],vlo[i][1],vlo[i][2],vlo[i][3],vhi[i][0],vhi[i][1],vhi[i][2],vhi[i][3]}
  #define PIN(x) asm volatile("":"+v"(x))
  #define MX3(a,b,c) __builtin_fmaxf(__builtin_fmaxf((a),(b)),(c))
  #define GAPA(MF,A0,A1,A2,A3,W0,W1,PW) do{ MF; sacc+=A0; sacc+=A1; sacc+=A2; sacc+=A3; PIN(sacc); W0; W1; PIN(PW); SBAR(); }while(0)
  #define EX(v) __builtin_amdgcn_exp2f(v)
  #define GAPB(MF,X,B) do{ MF; X[B]=EX(fsub_s(X[B],mhat)); X[B+1]=EX(fsub_s(X[B+1],mhat)); X[B+2]=EX(fsub_s(X[B+2],mhat)); X[B+3]=EX(fsub_s(X[B+3],mhat)); PIN(X); SBAR(); }while(0)
  #define VRD(i) do{ vlo[i]=vtr(vp_+(((i)>>2)*4096+((i)&3)*1024)); vhi[i]=vtr(vp_+(((i)>>2)*4096+((i)&3)*1024+512)); }while(0)
  #define KRD(G,j) do{ if(G){ kload2(kf,kp0+sl_next,j); SBAR(); } }while(0)
  #define STEP(C0,C1,P0,P1,t,GK,GV,GL) do{ SBAR(); \
    const lds_cptr vp_=vp0+sl_prev; \
    VRD(0); SBAR(); float sacc=(P0[0]+P0[1]); \
    GAPA(C0=__builtin_amdgcn_mfma_f32_32x32x16_bf16(kf[0],qr[0],f32x16{},0,0,0), P0[2],P0[3],P0[4],P0[5],     pw0[0]=PKW(P0,0), pw0[1]=PKW(P0,2), pw0); \
    VRD(4); SBAR(); GAPA(C1=__builtin_amdgcn_mfma_f32_32x32x16_bf16(kf[1],qr[0],f32x16{},0,0,0), P0[6],P0[7],P0[8],P0[9],     pw0[2]=PKW(P0,4), pw0[3]=PKW(P0,6), pw0); \
    VRD(1); SBAR(); GAPA(C0=__builtin_amdgcn_mfma_f32_32x32x16_bf16(kf[2],qr[1],C0,0,0,0),   P0[10],P0[11],P0[12],P0[13], pw1[0]=PKW(P0,8), pw1[1]=PKW(P0,10), pw1); \
    VRD(5); SBAR(); GAPA(C1=__builtin_amdgcn_mfma_f32_32x32x16_bf16(kf[3],qr[1],C1,0,0,0),   P0[14],P0[15],P1[0],P1[1],   pw1[2]=PKW(P0,12),pw1[3]=PKW(P0,14), pw1); \
    VRD(2); SBAR(); GAPA(C0=__builtin_amdgcn_mfma_f32_32x32x16_bf16(kf[4],qr[2],C0,0,0,0),   P1[2],P1[3],P1[4],P1[5],     pw2[0]=PKW(P1,0), pw2[1]=PKW(P1,2), pw2); \
    VRD(6); SBAR(); GAPA(C1=__builtin_amdgcn_mfma_f32_32x32x16_bf16(kf[5],qr[2],C1,0,0,0),   P1[6],P1[7],P1[8],P1[9],     pw2[2]=PKW(P1,4), pw2[3]=PKW(P1,6), pw2); \
    VRD(3); SBAR(); GAPA(C0=__builtin_amdgcn_mfma_f32_32x32x16_bf16(kf[6],qr[3],C0,0,0,0),   P1[10],P1[11],P1[12],P1[13], pw3[0]=PKW(P1,8), pw3[1]=PKW(P1,10), pw3); \
    VRD(7); SBAR(); GAPA(C1=__builtin_amdgcn_mfma_f32_32x32x16_bf16(kf[7],qr[3],C1,0,0,0),   P1[14],P1[15],0.f,0.f,       pw3[2]=PKW(P1,12),pw3[3]=PKW(P1,14), pw3); \
    l_reg+=sacc; \
    if(GK){DMA_K((t)+3,sl_cur);} if(GV){DMA_V((t)+1,sl_next);} \
    CMASK(C0,C1,t); \
    { float a=MX3(C0[0],C0[1],C1[0]),b=MX3(C0[2],C0[3],C1[1]); a=MX3(a,C1[2],C1[3]); \
      _Pragma("unroll") for(int r=4;r<16;r+=4){a=MX3(a,C0[r],C0[r+1]);b=MX3(b,C0[r+2],C0[r+3]);a=MX3(a,C1[r],C1[r+1]);b=MX3(b,C1[r+2],C1[r+3]);} \
      float rm=__builtin_fmaxf(a,b); { auto rr=__builtin_amdgcn_permlane32_swap(__float_as_uint(rm),__float_as_uint(rm),false,false); rm=__builtin_fmaxf(__uint_as_float(rr[0]),__uint_as_float(rr[1])); } \
      resc=false; \
      const float rel=rm-mhat; \
      if(__builtin_expect(__any(rel>(float)THRL),0)){ const float dl=__builtin_fmaxf(rel,0.f); mhat+=dl; \
        const float f=__builtin_amdgcn_exp2f(-dl); l_reg*=f; if(hi==0)wsf[r32]=f; resc=true; } } \
    SBAR(); \
    GAPB(o[0]=__builtin_amdgcn_mfma_f32_32x32x16_bf16(PAF(0),VFR(0),o[0],0,0,0), C0,0); \
    GAPB(o[1]=__builtin_amdgcn_mfma_f32_32x32x16_bf16(PAF(0),VFR(4),o[1],0,0,0), C0,4); \
    KRD(GL,0); GAPB(o[0]=__builtin_amdgcn_mfma_f32_32x32x16_bf16(PAF(1),VFR(1),o[0],0,0,0), C0,8); \
    KRD(GL,1); GAPB(o[1]=__builtin_amdgcn_mfma_f32_32x32x16_bf16(PAF(1),VFR(5),o[1],0,0,0), C0,12); \
    KRD(GL,2); GAPB(o[0]=__builtin_amdgcn_mfma_f32_32x32x16_bf16(PAF(2),VFR(2),o[0],0,0,0), C1,0); \
    KRD(GL,3); GAPB(o[1]=__builtin_amdgcn_mfma_f32_32x32x16_bf16(PAF(2),VFR(6),o[1],0,0,0), C1,4); \
    GAPB(o[0]=__builtin_amdgcn_mfma_f32_32x32x16_bf16(PAF(3),VFR(3),o[0],0,0,0), C1,8); \
    GAPB(o[1]=__builtin_amdgcn_mfma_f32_32x32x16_bf16(PAF(3),VFR(7),o[1],0,0,0), C1,12); \
    }while(0)
  int t=1;
  #undef CMASK
  #define CMASK(P0,P1,t) do{}while(0)
  for(;t+5<NT;t+=2){
    STEP(pB0,pB1,pA0,pA1,t,true,true,true);     WAIT_BAR(2); RESC(); ROT();
    STEP(pA0,pA1,pB0,pB1,t+1,true,true,true);   WAIT_BAR(2); RESC(); ROT();
  }
  #undef CMASK
  #define CMASK(P0,P1,t) do{int jb_=(t)-(NT-4); if(jb_>=0)cmask(P0,P1,jb_,qrel,hi);}while(0)
  #define ENDW(tt) do{ if((tt)+3<NT){WAIT_BAR(2);} else if((tt)+2<NT){WAIT_BAR(1);} else {WAIT_BAR(0);} }while(0)
  for(;t+1<NT;t+=2){
    STEP(pB0,pB1,pA0,pA1,t,(t+3<NT),(t+1<NT),(t+1<NT));       ENDW(t);   RESC(); ROT();
    STEP(pA0,pA1,pB0,pB1,t+1,(t+4<NT),(t+2<NT),(t+2<NT));     ENDW(t+1); RESC(); ROT();
  }
  STEP(pB0,pB1,pA0,pA1,NT-1,false,false,false); RESC();
  { float sacc=pB0[0]+pB0[1]; _Pragma("unroll") for(int r=2;r<16;++r)sacc+=pB0[r]; _Pragma("unroll") for(int r=0;r<16;++r)sacc+=pB1[r]; l_reg+=sacc;
    pw0=(u32x4){PKW(pB0,0),PKW(pB0,2),PKW(pB0,4),PKW(pB0,6)};pw1=(u32x4){PKW(pB0,8),PKW(pB0,10),PKW(pB0,12),PKW(pB0,14)};pw2=(u32x4){PKW(pB1,0),PKW(pB1,2),PKW(pB1,4),PKW(pB1,6)};pw3=(u32x4){PKW(pB1,8),PKW(pB1,10),PKW(pB1,12),PKW(pB1,14)};
    SBAR(); pv(o,vb0+sl_cur,PAF(0),PAF(1),PAF(2),PAF(3)); }
  #undef PKW
  #undef PAF
  #undef VFR
  #undef PIN
  #undef MX3
  #undef GAPA
  #undef GAPB
  #undef EX
  #undef VRD
  #undef KRD
  #undef STEP
  #undef ENDW
  {auto rr=__builtin_amdgcn_permlane32_swap(__float_as_uint(l_reg),__float_as_uint(l_reg),false,false);l_reg=__uint_as_float(rr[0])+__uint_as_float(rr[1]);}
  if(hi==0)wsf[32+r32]=l_reg;asm volatile("s_waitcnt lgkmcnt(0)":::"memory");
  float rli[16];
  #pragma unroll
  for(int r=0;r<16;++r)rli[r]=__builtin_amdgcn_rcpf(wsf[32+crow(r,hi)]);
  bf16*Ow=Oh+(long)(q0+wid*QBLK)*OPITCH;
  { bf16*stg=(bf16*)(shm+LDS_OST)+wid*2048;
    #pragma unroll
    for(int r=0;r<16;++r){const int orow=crow(r,hi);
      #pragma unroll
      for(int d0=0;d0<2;++d0)stg[orow*64+d0*32+r32]=__float2bfloat16(o[d0][r]*rli[r]);}
    asm volatile("s_waitcnt lgkmcnt(0)":::"memory");
    #pragma unroll
    for(int i=0;i<4;++i){const int row=i*8+(lane>>3),ch=lane&7; const u32x4 v=*(const u32x4*)(stg+row*64+ch*8); ATTN_STORE16(Ow+(long)row*OPITCH+ch*8,v);} }
  asm volatile("s_waitcnt lgkmcnt(0)\n\ts_barrier":::"memory");
  #undef DMA_K
  #undef DMA_V
  #undef CMASK
  #undef START
  #undef RESC
  #undef ROT
}

__device__ __forceinline__ float rowmax_cv(const f32x16&p0,const f32x16&p1){
  float a=__builtin_fmaxf(p0[0],p1[0]);
  #pragma unroll
  for(int r=1;r<16;++r){a=__builtin_fmaxf(a,p0[r]);a=__builtin_fmaxf(a,p1[r]);}
  auto rr=__builtin_amdgcn_permlane32_swap(__float_as_uint(a),__float_as_uint(a),false,false);
  return __builtin_fmaxf(__uint_as_float(rr[0]),__uint_as_float(rr[1]));
}
__device__ __forceinline__ void attn_unit_simple(int qb,const bf16*Qh,const bf16*__restrict__ Kh,const bf16*__restrict__ Vh,bf16*Oh,char*shm,const int tid_in){
  const int tid=tid_in,lane=tid&63,r32=lane&31,hi=lane>>5; const int wid=__builtin_amdgcn_readfirstlane(tid>>6);
  const int q0=qb*QB;
  const bf16*Qw=Qh+(long)(q0+wid*QBLK)*DM;
  const unsigned lds0=(unsigned)(uintptr_t)shm;
  float*wsf=(float*)(shm+LDS_WS)+wid*64;
  const bf16*ksrc=Kh+(long)lane*DM+wid*8;
  const bf16*vsrc=Vh+(long)(16*(wid&3)+(lane>>2))*DM+(wid>>2)*32+(lane&3)*8;
  u32x4*kdstp=(u32x4*)(shm+LDS_K+wid*1024+lane*16); u32x4*vdstp=(u32x4*)(shm+LDS_V+wid*1024+lane*16);
  const int vb0=(int)(lds0+LDS_V)+((lane>>4)&1)*32+(lane&3)*8+(4*hi+((lane&15)>>2))*64;
  const char*Kbase=shm+LDS_K;
  const int NT=(q0+QB)/KVBLK;
  bf16x8 qr[4];
  #pragma unroll
  for(int d0=0;d0<4;++d0)qr[d0]=*reinterpret_cast<const bf16x8*>(&Qw[(long)r32*DM+d0*16+hi*8]);
  float m_run=-1e30f,l_reg=0.f; f32x16 o[2]; o[0]=f32x16{}; o[1]=f32x16{};
  const int qrel=wid*QBLK+r32;
  u32x4 kreg=*(const u32x4*)ksrc, vreg=*(const u32x4*)vsrc;
  for(int t=0;t<NT;++t){
    *kdstp=kreg; *vdstp=vreg;
    if(t+1<NT){ kreg=*(const u32x4*)(ksrc+(long)(t+1)*KVBLK*DM); vreg=*(const u32x4*)(vsrc+(long)(t+1)*KVBLK*DM); }
    __syncthreads();
    f32x16 p0,p1;
    qkt(p0,p1,Kbase,qr,r32,hi);
    { const int jb=t-(NT-4); if(jb>=0){ const float NEG=-INFINITY; const int kb=64*jb+4*hi;
        #pragma unroll
        for(int r=0;r<16;++r){const int kv=kb+(r&3)+8*(r>>2); if(kv>qrel)p0[r]=NEG; if(kv+32>qrel)p1[r]=NEG;} } }
    const float rm=rowmax_cv(p0,p1);
    const float mn=__builtin_fmaxf(m_run,rm); const float alpha=__builtin_amdgcn_exp2f(m_run-mn); m_run=mn;
    float sacc=0.f;
    #pragma unroll
    for(int r=0;r<16;++r){p0[r]=__builtin_amdgcn_exp2f(p0[r]-mn);p1[r]=__builtin_amdgcn_exp2f(p1[r]-mn);sacc+=p0[r]+p1[r];}
    l_reg=l_reg*alpha+sacc;
    if(hi==0)wsf[r32]=alpha;
    asm volatile("s_waitcnt lgkmcnt(0)":::"memory");
    #pragma unroll
    for(int d_=0;d_<2;++d_)
      #pragma unroll
      for(int r=0;r<16;++r)o[d_][r]*=wsf[crow(r,hi)];
    u32x4 pw0,pw1,pw2,pw3;
    #define PKW2(P,B) cvtpk_s(P[B],P[B+1])
    pw0=(u32x4){PKW2(p0,0),PKW2(p0,2),PKW2(p0,4),PKW2(p0,6)};pw1=(u32x4){PKW2(p0,8),PKW2(p0,10),PKW2(p0,12),PKW2(p0,14)};
    pw2=(u32x4){PKW2(p1,0),PKW2(p1,2),PKW2(p1,4),PKW2(p1,6)};pw3=(u32x4){PKW2(p1,8),PKW2(p1,10),PKW2(p1,12),PKW2(p1,14)};
    #undef PKW2
    pv(o,vb0,__builtin_bit_cast(bf16x8,pw0),__builtin_bit_cast(bf16x8,pw1),__builtin_bit_cast(bf16x8,pw2),__builtin_bit_cast(bf16x8,pw3));
    asm volatile("s_waitcnt lgkmcnt(0)":::"memory");
    __syncthreads();
  }
  l_reg+=__uint_as_float((unsigned)__builtin_amdgcn_ds_bpermute((lane^32)<<2,(int)__float_as_uint(l_reg)));
  if(hi==0)wsf[32+r32]=l_reg;asm volatile("s_waitcnt lgkmcnt(0)":::"memory");
  float rli[16];
  #pragma unroll
  for(int r=0;r<16;++r)rli[r]=__builtin_amdgcn_rcpf(wsf[32+crow(r,hi)]);
  bf16*Ow=Oh+(long)(q0+wid*QBLK)*OPITCH;
  { bf16*stg=(bf16*)(shm+LDS_OST)+wid*2048;
    #pragma unroll
    for(int r=0;r<16;++r){const int orow=crow(r,hi);
      #pragma unroll
      for(int d0=0;d0<2;++d0)stg[orow*64+d0*32+r32]=__float2bfloat16(o[d0][r]*rli[r]);}
    asm volatile("s_waitcnt lgkmcnt(0)":::"memory");
    #pragma unroll
    for(int i=0;i<4;++i){const int row=i*8+(lane>>3),ch=lane&7; const u32x4 v=*(const u32x4*)(stg+row*64+ch*8); ATTN_STORE16(Ow+(long)row*OPITCH+ch*8,v);} }
  asm volatile("s_waitcnt vmcnt(0) lgkmcnt(0)":::"memory");
  __syncthreads();
}
constexpr int ATTN_LDS_BYTES=LDS_BYTES;
#undef SBAR
#undef WAIT_BAR
}

#define GAS __attribute__((address_space(1)))
#define LAS __attribute__((address_space(3)))
typedef unsigned short bf16;
typedef unsigned v4u __attribute__((ext_vector_type(4)));
typedef float f32x4 __attribute__((ext_vector_type(4)));
typedef short bf16x8 __attribute__((ext_vector_type(8)));
typedef GAS unsigned gu32;
typedef GAS unsigned long long gu64;
#define RLX_AGENT __ATOMIC_RELAXED, __HIP_MEMORY_SCOPE_AGENT
#define LDS_WAIT() asm volatile("s_waitcnt lgkmcnt(0)" ::: "memory")
#define VM_WAIT() asm volatile("s_waitcnt vmcnt(0)" ::: "memory")
__device__ __forceinline__ unsigned long long rt() { return __builtin_amdgcn_s_memrealtime(); }
__device__ __forceinline__ unsigned f2bf(float f) { unsigned u = __builtin_bit_cast(unsigned, f); return (u + 0x7fffu + ((u >> 16) & 1u)) >> 16; }
__device__ __forceinline__ unsigned pk2(float lo, float hi) { return f2bf(lo) | (f2bf(hi) << 16); }

#define XB_TMO      128
#define XB_XCNT(j)  (256  + 64 * (j))
#define XB_XSUB(j)  (1280 + 64 * (j))
#define XB_XGEN(j)  (2304 + 64 * (j))
#define XB_TOP      3328
#define XB_TOPGEN   3392
#define XCD_BAR_WORDS 3456
#define XB_SPIN_CAP (1u << 26)

__device__ __forceinline__ unsigned xb_ld(unsigned* p)              { return __hip_atomic_load(p, __ATOMIC_RELAXED, __HIP_MEMORY_SCOPE_AGENT); }
__device__ __forceinline__ unsigned xb_add(unsigned* p, unsigned v) { return __hip_atomic_fetch_add(p, v, __ATOMIC_RELAXED, __HIP_MEMORY_SCOPE_AGENT); }
__device__ __forceinline__ unsigned xb_xcc_id() { return (unsigned)__builtin_amdgcn_s_getreg((3 << 11) | 20) & 0xFu; }
#define XB_SPIN(cond, bar) do { unsigned _sp = 0; while (cond) { __builtin_amdgcn_s_sleep(1); \
    if ((++_sp & 255u) == 0u) { if (xb_ld(&(bar)[XB_TMO])) break; if (_sp > XB_SPIN_CAP) { atomicAdd(&(bar)[XB_TMO], 1u); break; } } } } while (0)

struct XcdBarrier {
    unsigned* bar; unsigned x;
    volatile LAS unsigned* st;
};

__device__ __forceinline__ XcdBarrier xcd_barrier_post(unsigned* bar, volatile LAS unsigned* st, const int tid) {
    XcdBarrier b; b.bar = bar; b.x = xb_xcc_id(); b.st = st;
    if (tid == 0) (void)xb_add(&bar[XB_XCNT(b.x)], 1u);
    return b;
}
__device__ __forceinline__ void xcd_barrier_complete(unsigned* bar, unsigned x, unsigned& nloc, unsigned& nx) {
    const unsigned G = gridDim.x * gridDim.y * gridDim.z;
    unsigned sum, cnt, mine, sp = 0u;
    for (;;) {
        sum = 0u; cnt = 0u; mine = 0u;
#pragma unroll
        for (unsigned j = 0; j < 16; ++j) { const unsigned c = xb_ld(&bar[XB_XCNT(j)]); sum += c; cnt += (c > 0u) ? 1u : 0u; mine = (j == x) ? c : mine; }
        if (sum == G) break;
        __builtin_amdgcn_s_sleep(1);
        if ((++sp & 255u) == 0u) { if (xb_ld(&bar[XB_TMO])) break; if (sp > XB_SPIN_CAP) { atomicAdd(&bar[XB_TMO], 1u); break; } }
    }
    nloc = mine > 0u ? mine : 1u; nx = cnt > 0u ? cnt : 1u;
}

__device__ __forceinline__ void xcd_barrier(const XcdBarrier& b, const int tid) {
    asm volatile("s_waitcnt vmcnt(0)" ::: "memory");
    __syncthreads();
    if (tid == 0) {
        unsigned* bar = b.bar;
        __builtin_amdgcn_s_waitcnt(0);
        unsigned nloc = b.st[0], nx = b.st[1];
        if (nloc == 0u) { xcd_barrier_complete(bar, b.x, nloc, nx); b.st[0] = nloc; b.st[1] = nx; }
        const unsigned old = xb_add(&bar[XB_XSUB(b.x)], 1u);
        const unsigned gen = old / nloc;
        if (old + 1u == (gen + 1u) * nloc) {
            __builtin_amdgcn_fence(__ATOMIC_RELEASE, "agent");
            asm volatile("s_waitcnt vmcnt(0)" ::: "memory");
            const unsigned og = xb_add(&bar[XB_TOP], 1u);
            const unsigned tg = og / nx;
            if (og + 1u == (tg + 1u) * nx) xb_add(&bar[XB_TOPGEN], 1u);
            else XB_SPIN(xb_ld(&bar[XB_TOPGEN]) == tg, bar);
            __builtin_amdgcn_fence(__ATOMIC_ACQUIRE, "agent");
            xb_add(&bar[XB_XGEN(b.x)], 1u);
            asm volatile("s_waitcnt vmcnt(0)" ::: "memory");
        } else {
            XB_SPIN(xb_ld(&bar[XB_XGEN(b.x)]) == gen, bar);
            __builtin_amdgcn_fence(__ATOMIC_ACQUIRE, "agent");
            asm volatile("s_waitcnt vmcnt(0)" ::: "memory");
        }
    }
    __syncthreads();
}

constexpr int NWAVES = 8;
constexpr int NTOK = 65536, NH = 32768, DMODEL = 1024, SEQLEN = 4096, INCOLS = 5632, DFF = 2816, NEXP = 8;
constexpr int MOE_PANELS_MAX = 264;
constexpr float EPS_NORM = 1e-6f, EPS_SUBLN = 1e-5f;

constexpr size_t MiB = 1u << 20;
constexpr size_t WS_CTL = 0, CTL_ZERO_BYTES = 1 * MiB;
constexpr size_t WS_WIN = 1 * MiB;
constexpr size_t WS_WGLU = 23 * MiB;
constexpr size_t WS_WPS = 24 * MiB;
constexpr size_t WS_WPA = 26 * MiB;
constexpr size_t WS_WOUT = 30 * MiB;
constexpr size_t WS_WDGU = 34 * MiB;
constexpr size_t WS_WDD = 45 * MiB;
constexpr size_t WS_WMGU = 51 * MiB;
constexpr size_t WS_WMD = 139 * MiB;
constexpr size_t WS_TZF = 183 * MiB;
constexpr size_t WS_EM = 223 * MiB;
constexpr size_t WS_ROPE = 239 * MiB;
constexpr size_t WS_ROUTE = 255 * MiB;
constexpr size_t WS_ACT = 260 * MiB;
constexpr size_t WS_END = 960 * MiB;
constexpr size_t A_HB = 0, A_UBUF = 64 * MiB, A_SLOC = 104 * MiB, A_Q = 120 * MiB, A_K = 184 * MiB, A_V = 248 * MiB, A_SGS = 312 * MiB, A_SGA = 376 * MiB, A_YA = 440 * MiB, A_YA2 = 472 * MiB, A_OV = 504 * MiB, A_YB = 632 * MiB;
constexpr size_t A_H2 = 0, A_FA = 64 * MiB;
constexpr size_t A_H2G = 64 * MiB, A_AG = 196 * MiB, A_YG = 559 * MiB;
static_assert(A_UBUF == pg8::EA_U && A_Q == pg8::EA_Q && A_K == pg8::EA_K && A_V == pg8::EA_V && A_SGS == pg8::EA_SGS && A_SGA == pg8::EA_SGA, "EpiIn offsets");
static_assert(A_YB + 64 * MiB <= WS_END - WS_ACT && A_OV + 128 * MiB <= WS_END - WS_ACT && A_YG + 132 * MiB <= WS_END - WS_ACT, "act map");
constexpr size_t R_E = 0, R_W = 256 * 1024, R_S = 512 * 1024, R_CNT = 768 * 1024;
constexpr int CW_BAR = 4096;

constexpr int RING_OFF = 0, RING_BYTES = 131072;
constexpr int LDSCTL_OFF = RING_BYTES, MISC_OFF = LDSCTL_OFF + 320;
constexpr int LDS_BYTES = 147456;

constexpr int PTR_OFF = LDSCTL_OFF + 1024;
struct Args { const void* in[31]; float* out; unsigned char* ws; };
__device__ __forceinline__ unsigned long long ldp64(LAS unsigned char* L, int slot) {
    const unsigned long long v = ((volatile LAS unsigned long long*)(L + PTR_OFF))[slot];
    const unsigned lo = __builtin_amdgcn_readfirstlane((unsigned)v), hi = __builtin_amdgcn_readfirstlane((unsigned)(v >> 32));
    return ((unsigned long long)hi << 32) | lo;
}
#define LDP(T, slot) ((T*)(GAS T*)(uintptr_t)ldp64(L, (slot)))

#define SWZ_XOR(k) (((k) << 10) | 0x1f)
#define swz_xor(v, pat) __builtin_bit_cast(float, __builtin_amdgcn_ds_swizzle(__builtin_bit_cast(int, (float)(v)), (pat)))
__device__ __forceinline__ float wave_sum(float v) {
    v += swz_xor(v, SWZ_XOR(1)); v += swz_xor(v, SWZ_XOR(2)); v += swz_xor(v, SWZ_XOR(4)); v += swz_xor(v, SWZ_XOR(8)); v += swz_xor(v, SWZ_XOR(16));
    const float lo = __builtin_bit_cast(float, __builtin_amdgcn_readlane(__builtin_bit_cast(int, v), 0));
    const float hi = __builtin_bit_cast(float, __builtin_amdgcn_readlane(__builtin_bit_cast(int, v), 32));
    return lo + hi;
}
__device__ __forceinline__ void tr_item(const float* W, int ldw, int K, bf16* WTn0, int k0, int srccol, LAS float* scr, int lane) {
#pragma unroll 8
    for (int i = 0; i < 32; ++i) { const int kk = 2 * i + (lane >> 5); scr[kk * 33 + (lane & 31)] = W[(size_t)(k0 + kk) * ldw + srccol]; }
    LDS_WAIT(); asm volatile("" ::: "memory");
    const int c = lane & 7;
#pragma unroll
    for (int j = 0; j < 4; ++j) { const int n = (lane >> 3) + 8 * j; const LAS float* s = scr + (8 * c) * 33 + n;
        v4u o; o.x = pk2(s[0 * 33], s[1 * 33]); o.y = pk2(s[2 * 33], s[3 * 33]); o.z = pk2(s[4 * 33], s[5 * 33]); o.w = pk2(s[6 * 33], s[7 * 33]);
        *(GAS v4u*)(WTn0 + (size_t)n * K + k0 + 8 * c) = o; }
    LDS_WAIT(); asm volatile("" ::: "memory");
}
__device__ __forceinline__ int win_orig(int n) { if (n < 512 || n >= 2560) return n; const int i = n & 63; return (n & ~63) + 16 * ((i >> 5) & 1) + 4 * ((i >> 3) & 3) + (i & 3) + 32 * ((i >> 2) & 1); }
__device__ __forceinline__ void tr_plain(const float* W, int K, int N, bf16* WT, int item, LAS float* scr, int lane) {
    const int nblk = N / 32, kb = item / nblk, nb = item % nblk;
    tr_item(W, N, K, WT + (size_t)(32 * nb) * K, 64 * kb, 32 * nb + (lane & 31), scr, lane);
}
__device__ __forceinline__ void tr_win(const float* W, bf16* WT, int item, LAS float* scr, int lane) {
    const int nblk = INCOLS / 32, kb = item / nblk, nb = item % nblk;
    tr_item(W, INCOLS, DMODEL, WT + (size_t)(32 * nb) * DMODEL, 64 * kb, win_orig(32 * nb + (lane & 31)), scr, lane);
}
__device__ __forceinline__ void tr_gu(const float* Wg, const float* Wu, bf16* WT, int item, LAS float* scr, int lane) {
    const int nblk = INCOLS / 32, kb = item / nblk, nb = item % nblk; const int n0 = 32 * nb, pn = n0 >> 8, r = n0 & 255;
    const float* W = r < 128 ? Wg : Wu; const int col = pn * 128 + (r & 127) + (lane & 31);
    tr_item(W, DFF, DMODEL, WT + (size_t)n0 * DMODEL, 64 * kb, col, scr, lane);
}
struct S5In { const float *lam_re, *lam_im, *log_dt, *b_re, *b_im, *c_re, *c_im, *dd; };
__device__ __forceinline__ v4u pack8f(const float* v) { v4u o; o.x = pk2(v[0], v[1]); o.y = pk2(v[2], v[3]); o.z = pk2(v[4], v[5]); o.w = pk2(v[6], v[7]); return o; }
__device__ __forceinline__ void s5_item(LAS unsigned char* L, int tid, const S5In& P, int lg, int d, bf16* TZF, bf16* EM) {
    LAS float* sm = (LAS float*)(L);
    LAS float *s_fr = sm, *s_fi = sm + 64, *s_apr = sm + 128, *s_api = sm + 192, *BBr = sm + 256, *BBi = sm + 1280, *CAr = sm + 2304, *CAi = sm + 3328, *Kd = sm + 4352;
    if (tid < 64) {
        const int p = tid;
        const float dt = expf(P.log_dt[lg]);
        const float lr = P.lam_re[lg * 64 + p], li = P.lam_im[lg * 64 + p];
        const float mag = expf(lr * dt); float sn, cs; sincosf(li * dt, &sn, &cs);
        const float ar = mag * cs, ai = mag * sn;
        const float den = lr * lr + li * li, nr = ar - 1.0f, ni = ai;
        s_fr[p] = (nr * lr + ni * li) / den; s_fi[p] = (ni * lr - nr * li) / den;
        const float fd = (float)d; const float magd = expf(fd * lr * dt); float snd, csd; sincosf(fd * li * dt, &snd, &csd);
        s_apr[p] = magd * csd; s_api[p] = magd * snd;
    }
    __syncthreads();
    for (int idx = tid; idx < 1024; idx += 512) {
        { const int p = idx >> 4; const float br = P.b_re[(size_t)lg * 1024 + idx], bi = P.b_im[(size_t)lg * 1024 + idx]; const float fr_ = s_fr[p], fi_ = s_fi[p];
          BBr[idx] = fr_ * br - fi_ * bi; BBi[idx] = fr_ * bi + fi_ * br; }
        { const int p = idx & 63; const float cr = P.c_re[(size_t)lg * 1024 + idx], ci = P.c_im[(size_t)lg * 1024 + idx]; const float ar_ = s_apr[p], ai_ = s_api[p];
          CAr[idx] = cr * ar_ - ci * ai_; CAi[idx] = cr * ai_ + ci * ar_; }
    }
    __syncthreads();
    if (d <= 31 && tid < 256) { const int j = tid >> 4, jp = tid & 15; float acc = 0.f;
        for (int p = 0; p < 64; ++p) acc += CAr[j * 64 + p] * BBr[p * 16 + jp] - CAi[j * 64 + p] * BBi[p * 16 + jp];
        if (d == 0 && j == jp) acc += P.dd[lg * 16 + j];
        Kd[tid] = acc; }
    __syncthreads();
    bf16* TZ = TZF + (size_t)lg * 512 * 640; bf16* EE = EM + (size_t)lg * 256 * 512;
    if (d <= 31) {
        const int cnt = (32 - d) * 16;
        for (int idx = tid; idx < cnt; idx += 512) { const int tt = idx >> 4, j = idx & 15; float v[16];
#pragma unroll
            for (int q = 0; q < 16; ++q) v[q] = Kd[j * 16 + q];
            bf16* dst = TZ + (size_t)((d + tt) * 16 + j) * 640 + tt * 16;
            *(GAS v4u*)dst = pack8f(v); *(GAS v4u*)(dst + 8) = pack8f(v + 8);
            if (d >= 1) { bf16* dz = TZ + (size_t)(tt * 16 + j) * 640 + (d + tt) * 16; const v4u z = {0u, 0u, 0u, 0u}; *(GAS v4u*)dz = z; *(GAS v4u*)(dz + 8) = z; } }
        if (tid < 128) { const int ri = tid >> 6, p = tid & 63; const float ar_ = s_apr[p], ai_ = s_api[p]; float v[16];
#pragma unroll
            for (int q = 0; q < 16; ++q) { const float br = BBr[p * 16 + q], bi = BBi[p * 16 + q]; v[q] = ri == 0 ? (ar_ * br - ai_ * bi) : (ar_ * bi + ai_ * br); }
            bf16* dst = EE + (size_t)tid * 512 + (31 - d) * 16; *(GAS v4u*)dst = pack8f(v); *(GAS v4u*)(dst + 8) = pack8f(v + 8);
        } else if (tid < 256) { bf16* dz = EE + (size_t)tid * 512 + (31 - d) * 16; const v4u z = {0u, 0u, 0u, 0u}; *(GAS v4u*)dz = z; *(GAS v4u*)(dz + 8) = z; }
    }
    if (d >= 1 && tid < 256) { const int j = tid >> 4, ri = (tid >> 3) & 1, pc = tid & 7; float v[8];
#pragma unroll
        for (int q = 0; q < 8; ++q) v[q] = ri == 0 ? CAr[j * 64 + pc * 8 + q] : -CAi[j * 64 + pc * 8 + q];
        *(GAS v4u*)(TZ + (size_t)((d - 1) * 16 + j) * 640 + 512 + ri * 64 + pc * 8) = pack8f(v); }
    __syncthreads();
}
__device__ __forceinline__ void norm_row(const float* xrow, const float* gain, bf16* orow, int lane, f32x4 (&hn)[4]) {
    const GAS f32x4* xr = (const GAS f32x4*)xrow + lane; const GAS f32x4* gr = (const GAS f32x4*)gain + lane;
    float s2 = 0.f;
#pragma unroll
    for (int j = 0; j < 4; ++j) { hn[j] = xr[64 * j]; s2 += (hn[j].x * hn[j].x + hn[j].y * hn[j].y) + (hn[j].z * hn[j].z + hn[j].w * hn[j].w); }
    const float rs = 1.0f / sqrtf(wave_sum(s2) * (1.0f / DMODEL) + EPS_NORM);
    GAS unsigned long long* o8 = (GAS unsigned long long*)orow + lane;
#pragma unroll
    for (int j = 0; j < 4; ++j) { const f32x4 g = gr[64 * j]; hn[j] = hn[j] * rs * g;
        o8[64 * j] = (unsigned long long)pk2(hn[j].x, hn[j].y) | ((unsigned long long)pk2(hn[j].z, hn[j].w) << 32); }
}

__global__ void __launch_bounds__(NWAVES * 64, 2) trunk_fwd(Args args) {
    extern __shared__ __attribute__((aligned(16))) unsigned char lds[];
    const int WAVE = __builtin_amdgcn_readfirstlane((int)threadIdx.x >> 6);
#define MYTID() ({ int l_; asm volatile("v_mbcnt_lo_u32_b32 %0, -1, 0\n\tv_mbcnt_hi_u32_b32 %0, -1, %0" : "=v"(l_)); WAVE * 64 + l_; })
    LAS unsigned char* const L0 = (LAS unsigned char*)lds;
#define OPQ LAS unsigned char* L = L0; asm volatile("" : "+s"(L))
    OPQ;
    {
        const int tid0 = MYTID();
        for (int u = tid0; u < (LDS_BYTES - LDSCTL_OFF) / 4; u += NWAVES * 64) ((LAS unsigned*)(L + LDSCTL_OFF))[u] = 0u;
        __syncthreads();
        if (tid0 == 0) {
#pragma unroll
            for (int k = 0; k < 31; ++k) ((LAS unsigned long long*)(L + PTR_OFF))[k] = (unsigned long long)(uintptr_t)args.in[k];
            ((LAS unsigned long long*)(L + PTR_OFF))[31] = (unsigned long long)(uintptr_t)args.out;
            ((LAS unsigned long long*)(L + PTR_OFF))[32] = (unsigned long long)(uintptr_t)args.ws; }
        __syncthreads();
    }
    { XcdBarrier b0 = xcd_barrier_post((unsigned*)(LDP(unsigned char, 32) + WS_CTL) + CW_BAR, (volatile LAS unsigned*)(L + MISC_OFF) + 8, MYTID()); (void)b0; }
#define GRID_BAR() do { OPQ; XcdBarrier b_; b_.bar = (unsigned*)(LDP(unsigned char, 32) + WS_CTL) + CW_BAR; b_.x = xb_xcc_id(); b_.st = (volatile LAS unsigned*)(L + MISC_OFF) + 8; xcd_barrier(b_, MYTID()); \
      { const int t2_ = MYTID(); if (t2_ == 0) { volatile LAS unsigned* kc_ = (volatile LAS unsigned*)(L + MISC_OFF) + 12; const unsigned k_ = kc_[0] + 1u; kc_[0] = k_; \
          unsigned* c2_ = (unsigned*)(LDP(unsigned char, 32) + WS_CTL) + 2048; __threadfence(); __hip_atomic_fetch_add(c2_, 1u, __ATOMIC_RELAXED, __HIP_MEMORY_SCOPE_AGENT); \
          while (__hip_atomic_load(c2_, __ATOMIC_RELAXED, __HIP_MEMORY_SCOPE_AGENT) < k_ * (unsigned)gridDim.x) __builtin_amdgcn_s_sleep(2); \
          __threadfence(); asm volatile("s_waitcnt vmcnt(0)" ::: "memory"); } __syncthreads(); } } while (0)
#define LQ() ({ int l_ = l; asm volatile("" : "+s"(l_)); l_; })
#define TID_SETUP OPQ; int wave_ = WAVE; asm volatile("" : "+s"(wave_)); const int wave = wave_; const int tid = MYTID(), lane = tid & 63; const int G = gridDim.x; const int vcu = ((int)blockIdx.x % 8) * (G / 8) + (int)blockIdx.x / 8; const int gw = vcu * NWAVES + wave, NGW = G * NWAVES; (void)lane; (void)gw; (void)NGW; (void)tid
#define WSP(T, off) ((T*)(LDP(unsigned char, 32) + (off)))
#define ACTP(T, off) ((T*)(LDP(unsigned char, 32) + WS_ACT + (off)))

    {
        TID_SETUP;
        LAS float* scr = (LAS float*)(L + RING_OFF + wave * 16384);
        constexpr int I_WIN = 16 * 176, I_GLU = 8 * 16, I_PS = 8 * 32, I_PA = 16 * 32, I_OUT = 16 * 32, I_GU = 16 * 176, I_DN = 44 * 32;
        constexpr int I_LAYER = I_WIN + I_GLU + I_PS + I_PA + I_OUT;
        constexpr int NITEMS = 2 * I_LAYER + I_GU + I_DN + 8 * I_GU + 8 * I_DN;
        for (int it = gw; it < NITEMS; it += NGW) {
            int r = it;
            if (r < 2 * I_LAYER) { const int l = r / I_LAYER; r -= l * I_LAYER;
                if (r < I_WIN) { tr_win(LDP(const float, 3) + (size_t)l * DMODEL * INCOLS, WSP(bf16, WS_WIN) + (size_t)l * INCOLS * DMODEL, r, scr, lane); continue; } r -= I_WIN;
                if (r < I_GLU) { tr_plain(LDP(const float, 12) + (size_t)l * 512 * 512, 512, 512, WSP(bf16, WS_WGLU) + (size_t)l * 512 * 512, r, scr, lane); continue; } r -= I_GLU;
                if (r < I_PS) { tr_plain(LDP(const float, 19) + (size_t)l * 512 * 1024, 512, 1024, WSP(bf16, WS_WPS) + (size_t)l * 1024 * 512, r, scr, lane); continue; } r -= I_PS;
                if (r < I_PA) { tr_plain(LDP(const float, 20) + (size_t)l * 1024 * 1024, 1024, 1024, WSP(bf16, WS_WPA) + (size_t)l * 1024 * 1024, r, scr, lane); continue; } r -= I_PA;
                tr_plain(LDP(const float, 21) + (size_t)l * 1024 * 1024, 1024, 1024, WSP(bf16, WS_WOUT) + (size_t)l * 1024 * 1024, r, scr, lane); continue; }
            r -= 2 * I_LAYER;
            if (r < I_GU) { tr_gu(LDP(const float, 23), LDP(const float, 24), WSP(bf16, WS_WDGU), r, scr, lane); continue; } r -= I_GU;
            if (r < I_DN) { tr_plain(LDP(const float, 25), DFF, DMODEL, WSP(bf16, WS_WDD), r, scr, lane); continue; } r -= I_DN;
            if (r < 8 * I_GU) { const int e = r / I_GU; r -= e * I_GU; tr_gu(LDP(const float, 27) + (size_t)e * DMODEL * DFF, LDP(const float, 28) + (size_t)e * DMODEL * DFF, WSP(bf16, WS_WMGU) + (size_t)e * INCOLS * DMODEL, r, scr, lane); continue; } r -= 8 * I_GU;
            { const int e = r / I_DN; r -= e * I_DN; tr_plain(LDP(const float, 29) + (size_t)e * DFF * DMODEL, DFF, DMODEL, WSP(bf16, WS_WMD) + (size_t)e * DMODEL * DFF, r, scr, lane); }
        }
        __syncthreads();
        { S5In s5p; s5p.lam_re = LDP(const float, 4); s5p.lam_im = LDP(const float, 5); s5p.log_dt = LDP(const float, 6); s5p.b_re = LDP(const float, 7); s5p.b_im = LDP(const float, 8);
          s5p.c_re = LDP(const float, 9); s5p.c_im = LDP(const float, 10); s5p.dd = LDP(const float, 11);
          for (int it = vcu; it < 2 * 32 * 33; it += G) s5_item(L, tid, s5p, it / 33, it % 33, WSP(bf16, WS_TZF), WSP(bf16, WS_EM)); }
        { const int* positions = LDP(const int, 1); float* ROPE = WSP(float, WS_ROPE);
          for (int idx = vcu * (NWAVES * 64) + tid; idx < NTOK * 32; idx += G * NWAVES * 64) { const int n = idx >> 5, fi = idx & 31;
            const float invf = powf(10000.0f, -(float)(2 * fi) / 64.0f); const float ang = (float)positions[n] * invf; float sn, cs; sincosf(ang, &sn, &cs);
            ROPE[(size_t)n * 64 + fi] = cs; ROPE[(size_t)n * 64 + 32 + fi] = sn; } }
    }
    GRID_BAR();

    for (int l = 0; l < 2; ++l) {
        for (int half = 0; half < 2; ++half) {
            const int tokbase = half * NH;
            { TID_SETUP; const float* xsrc = LDP(const float, (LQ() == 0) ? 0 : 31); const float* gain = LDP(const float, 2) + l * DMODEL; bf16* HB = ACTP(bf16, A_HB);
              for (int m = gw; m < NH; m += NGW) { f32x4 hn[4]; norm_row(xsrc + (size_t)(tokbase + m) * DMODEL, gain, HB + (size_t)m * DMODEL, lane, hn); } }
            GRID_BAR();
            { OPQ; pg8::Gemm g{ACTP(bf16, A_HB), WSP(bf16, WS_WIN) + (size_t)l * INCOLS * DMODEL, DMODEL, DMODEL, DMODEL}; pg8::SchedPlain S; S.init(NH / 256, INCOLS / 256, gridDim.x, (int)blockIdx.x);
              pg8::EpiIn E{ACTP(unsigned char, 0), WSP(const float, WS_ROPE), tokbase};
              pg8::gemm_phase<pg8::EpiIn, pg8::SchedPlain, true, true>(L0 + RING_OFF, g, S, E, MYTID()); }
            GRID_BAR();
            { OPQ; pg8::Gemm g{ACTP(bf16, A_UBUF), WSP(bf16, WS_EM) + (size_t)l * 32 * 256 * 512, 640, 512, 512}; pg8::SchedS5 S; S.init(1, gridDim.x, (int)blockIdx.x);
              pg8::EpiSloc E{ACTP(float, A_SLOC)};
              pg8::gemm_phase<pg8::EpiSloc, pg8::SchedS5, true, true>(L0 + RING_OFF, g, S, E, MYTID()); }
            GRID_BAR();
            { TID_SETUP;
              if (wave == 0) {
                const int id = vcu * 64 + lane;
                if (id < 8 * 32 * 64) { const int bl = id >> 11, g = (id >> 6) & 31, p = id & 63; const int lg = l * 32 + g;
                    const float dt = expf(LDP(const float, 6)[lg]); const float lr = LDP(const float, 4)[lg * 64 + p], li = LDP(const float, 5)[lg * 64 + p];
                    const float magT = expf(32.0f * lr * dt); float snT, csT; sincosf(32.0f * li * dt, &snT, &csT); const float aTr = magT * csT, aTi = magT * snT;
                    float sr = 0.f, si = 0.f; const size_t row0 = (size_t)g * 1024 + (size_t)bl * 128;
                    const float* sl = ACTP(const float, A_SLOC) + row0 * 128 + p; bf16* ub = ACTP(bf16, A_UBUF) + row0 * 640 + 512 + p;
                    for (int c0 = 0; c0 < 128; c0 += 8) { float lr_[8], li_[8];
#pragma unroll
                        for (int q = 0; q < 8; ++q) { lr_[q] = sl[(size_t)(c0 + q) * 128]; li_[q] = sl[(size_t)(c0 + q) * 128 + 64]; }
#pragma unroll
                        for (int q = 0; q < 8; ++q) { ub[(size_t)(c0 + q) * 640] = (bf16)f2bf(sr); ub[(size_t)(c0 + q) * 640 + 64] = (bf16)f2bf(si);
                            const float nr_ = aTr * sr - aTi * si + lr_[q], ni_ = aTr * si + aTi * sr + li_[q]; sr = nr_; si = ni_; } } }
              } }
            GRID_BAR();
            { OPQ; pg8::Gemm g{ACTP(bf16, A_UBUF), WSP(bf16, WS_TZF) + (size_t)l * 32 * 512 * 640, 640, 640, 640}; pg8::SchedS5 S; S.init(2, gridDim.x, (int)blockIdx.x);
              pg8::EpiYa E{ACTP(bf16, A_YA)};
              pg8::gemm_phase<pg8::EpiYa, pg8::SchedS5, true, true>(L0 + RING_OFF, g, S, E, MYTID()); }
            GRID_BAR();
            { OPQ; pg8::Gemm g{ACTP(bf16, A_YA), WSP(bf16, WS_WGLU) + (size_t)l * 512 * 512, 512, 512, 512}; pg8::SchedPlain S; S.init(NH / 256, 2, gridDim.x, (int)blockIdx.x);
              pg8::EpiGlu E{ACTP(bf16, A_YA), ACTP(bf16, A_YA2), LDP(const float, 13) + l * 512};
              pg8::gemm_phase<pg8::EpiGlu, pg8::SchedPlain, true, true>(L0 + RING_OFF, g, S, E, MYTID()); }
            GRID_BAR();
            {
                const int G = gridDim.x; const int vcu = ((int)blockIdx.x % 8) * (G / 8) + (int)blockIdx.x / 8;
                for (int i = 0; i < 16; ++i) {
                    OPQ; const int s = vcu & 7; const int bvh = (i >> 1) * 32 + (vcu >> 3); const int qb = (i & 1) ? 15 - s : s;
                    const int b = bvh >> 5, vh = bvh & 31, h = vh >> 2, c = (vh >> 1) & 1, vhalf = vh & 1;
                    const size_t rb = (size_t)b * SEQLEN;
                    attn_body::attn_unit_simple(qb, (const attn_body::bf16*)(ACTP(bf16, A_Q) + rb * 1024 + h * 128 + c * 64), (const attn_body::bf16*)(ACTP(bf16, A_K) + rb * 1024 + h * 128 + c * 64),
                                            (const attn_body::bf16*)(ACTP(bf16, A_V) + rb * 1024 + h * 128 + vhalf * 64), (attn_body::bf16*)(ACTP(bf16, A_OV) + rb * 2048 + h * 256 + c * 128 + vhalf * 64), (char*)lds + RING_OFF, MYTID());
                }
            }
            GRID_BAR();
            {
                TID_SETUP;
                int lq = l; asm volatile("" : "+s"(lq));
                const float lam_init = 0.8f - 0.6f * expf(-0.3f * (float)lq);
                const float p1 = wave_sum(LDP(const float, 14)[lq * 64 + lane] * LDP(const float, 15)[lq * 64 + lane]), p2 = wave_sum(LDP(const float, 16)[lq * 64 + lane] * LDP(const float, 17)[lq * 64 + lane]);
                const float lam = expf(p1) - expf(p2) + lam_init;
                const int head = lane >> 3, dch = lane & 7;
                const float* subln = LDP(const float, 18) + lq * 128 + dch * 16;
                pg8::f32x4 g0 = *(const GAS pg8::f32x4*)subln, g1 = *(const GAS pg8::f32x4*)(subln + 4), g2 = *(const GAS pg8::f32x4*)(subln + 8), g3 = *(const GAS pg8::f32x4*)(subln + 12);
                g0 *= (1.0f - lam_init); g1 *= (1.0f - lam_init); g2 *= (1.0f - lam_init); g3 *= (1.0f - lam_init);
                const bf16* OV = ACTP(const bf16, A_OV); bf16* YB = ACTP(bf16, A_YB);
                for (int m = gw; m < NH; m += NGW) {
                    const bf16* o1p = OV + (size_t)m * 2048 + head * 256 + dch * 16; const bf16* o2p = o1p + 128;
                    pg8::f32x4 a0, a1, a2, a3, b0, b1, b2, b3;
                    pg8::unpack8(*(const GAS pg8::u32x4*)o1p, a0, a1); pg8::unpack8(*(const GAS pg8::u32x4*)(o1p + 8), a2, a3);
                    pg8::unpack8(*(const GAS pg8::u32x4*)o2p, b0, b1); pg8::unpack8(*(const GAS pg8::u32x4*)(o2p + 8), b2, b3);
                    a0 -= lam * b0; a1 -= lam * b1; a2 -= lam * b2; a3 -= lam * b3;
                    float ss = (a0.x * a0.x + a0.y * a0.y + a0.z * a0.z + a0.w * a0.w) + (a1.x * a1.x + a1.y * a1.y + a1.z * a1.z + a1.w * a1.w)
                             + (a2.x * a2.x + a2.y * a2.y + a2.z * a2.z + a2.w * a2.w) + (a3.x * a3.x + a3.y * a3.y + a3.z * a3.z + a3.w * a3.w);
                    ss += swz_xor(ss, SWZ_XOR(1)); ss += swz_xor(ss, SWZ_XOR(2)); ss += swz_xor(ss, SWZ_XOR(4));
                    const float r = 1.0f / sqrtf(ss * (1.0f / 128.0f) + EPS_SUBLN);
                    bf16* dst = YB + (size_t)m * 1024 + head * 128 + dch * 16;
                    *(GAS pg8::u32x4*)dst = pg8::pack8(a0 * r * g0, a1 * r * g1); *(GAS pg8::u32x4*)(dst + 8) = pg8::pack8(a2 * r * g2, a3 * r * g3);
                }
            }
            GRID_BAR();
            { OPQ; pg8::Gemm g{ACTP(bf16, A_YA2), WSP(bf16, WS_WPS) + (size_t)l * 1024 * 512, 512, 512, 512}; pg8::SchedPlain S; S.init(NH / 256, 4, gridDim.x, (int)blockIdx.x);
              pg8::EpiGate<0> E{ACTP(bf16, A_SGS), nullptr};
              pg8::gemm_phase<pg8::EpiGate<0>, pg8::SchedPlain, true, true>(L0 + RING_OFF, g, S, E, MYTID()); }
            GRID_BAR();
            { OPQ; pg8::Gemm g{ACTP(bf16, A_YB), WSP(bf16, WS_WPA) + (size_t)l * 1024 * 1024, 1024, 1024, 1024}; pg8::SchedPlain S; S.init(NH / 256, 4, gridDim.x, (int)blockIdx.x);
              pg8::EpiGate<1> E{ACTP(bf16, A_SGA), ACTP(bf16, A_SGS)};
              pg8::gemm_phase<pg8::EpiGate<1>, pg8::SchedPlain, true, true>(L0 + RING_OFF, g, S, E, MYTID()); }
            GRID_BAR();
            { OPQ; pg8::Gemm g{ACTP(bf16, A_SGA), WSP(bf16, WS_WOUT) + (size_t)l * 1024 * 1024, 1024, 1024, 1024}; pg8::SchedPlain S; S.init(NH / 256, 4, gridDim.x, (int)blockIdx.x);
              pg8::EpiRes E{LDP(const float, (LQ() == 0) ? 0 : 31), LDP(float, 31), tokbase};
              pg8::gemm_phase<pg8::EpiRes, pg8::SchedPlain, true, true>(L0 + RING_OFF, g, S, E, MYTID()); }
            GRID_BAR();
            if (LQ() == 0) {
                { TID_SETUP; const float* xs = LDP(const float, 31); const float* gain = LDP(const float, 22); bf16* H2 = ACTP(bf16, A_H2);
                  for (int m = gw; m < NH; m += NGW) { f32x4 hn[4]; norm_row(xs + (size_t)(tokbase + m) * DMODEL, gain, H2 + (size_t)m * DMODEL, lane, hn); } }
                GRID_BAR();
                { OPQ; pg8::Gemm g{ACTP(bf16, A_H2), WSP(bf16, WS_WDGU), 1024, 1024, 1024}; pg8::SchedPlain S; S.init(NH / 256, 22, gridDim.x, (int)blockIdx.x);
                  pg8::EpiSwi E{ACTP(bf16, A_FA)};
                  pg8::gemm_phase<pg8::EpiSwi, pg8::SchedPlain, true, true>(L0 + RING_OFF, g, S, E, MYTID()); }
                GRID_BAR();
                { OPQ; pg8::Gemm g{ACTP(bf16, A_FA), WSP(bf16, WS_WDD), 2816, 2816, 2816}; pg8::SchedPlain S; S.init(NH / 256, 4, gridDim.x, (int)blockIdx.x);
                  pg8::EpiRes E{LDP(const float, 31), LDP(float, 31), tokbase};
                  pg8::gemm_phase<pg8::EpiRes, pg8::SchedPlain, true, true>(L0 + RING_OFF, g, S, E, MYTID()); }
                GRID_BAR();
            } else {
                {
                    TID_SETUP;
                    LAS float* rwT = (LAS float*)(L);
                    LAS unsigned* cntL = (LAS unsigned*)(L + 32768);
                    { const float* router_w = LDP(const float, 26); for (int idx = tid; idx < 8192; idx += NWAVES * 64) { const int k = idx >> 3, e = idx & 7; rwT[e * 1024 + k] = router_w[idx]; } }
                    if (tid < 8) cntL[tid] = 0u;
                    __syncthreads();
                    const float* xs = LDP(const float, 31); const float* gain = LDP(const float, 22) + DMODEL; bf16* H2 = ACTP(bf16, A_H2);
                    unsigned* RT_E = WSP(unsigned, WS_ROUTE + R_E); float* RT_W = WSP(float, WS_ROUTE + R_W);
                    for (int i = 0; i < 16; ++i) { const int row = vcu * 128 + wave * 16 + i;
                        f32x4 hn[4]; norm_row(xs + (size_t)(tokbase + row) * DMODEL, gain, H2 + (size_t)row * DMODEL, lane, hn);
                        float lg[8];
#pragma unroll
                        for (int e = 0; e < 8; ++e) { float a = 0.f;
#pragma unroll
                            for (int j = 0; j < 4; ++j) { const f32x4 w = *(const LAS f32x4*)(rwT + e * 1024 + 4 * lane + 256 * j); a += (hn[j].x * w.x + hn[j].y * w.y) + (hn[j].z * w.z + hn[j].w * w.w); }
                            lg[e] = wave_sum(a); }
                        if (lane == 0) { int e1 = 0; float v1 = lg[0];
#pragma unroll
                            for (int e = 1; e < 8; ++e) if (lg[e] > v1) { v1 = lg[e]; e1 = e; }
                            int e2 = -1; float v2 = -INFINITY;
#pragma unroll
                            for (int e = 0; e < 8; ++e) if (e != e1 && lg[e] > v2) { v2 = lg[e]; e2 = e; }
                            if (e2 < 0) e2 = (e1 == 0) ? 1 : 0;
                            const float ex = expf(v2 - v1); const float w1 = 1.0f / (1.0f + ex), w2 = ex / (1.0f + ex);
                            RT_E[row] = (unsigned)e1 | ((unsigned)e2 << 8); RT_W[2 * row] = w1; RT_W[2 * row + 1] = w2;
                            __hip_atomic_fetch_add(cntL + e1, 1u, __ATOMIC_RELAXED, __HIP_MEMORY_SCOPE_WORKGROUP); __hip_atomic_fetch_add(cntL + e2, 1u, __ATOMIC_RELAXED, __HIP_MEMORY_SCOPE_WORKGROUP); }
                    }
                    __syncthreads();
                    if (tid < 8) WSP(unsigned, WS_ROUTE + R_CNT)[vcu * 8 + tid] = cntL[tid];
                }
                GRID_BAR();
                {
                    TID_SETUP;
                    volatile LAS unsigned* MISC = (volatile LAS unsigned*)(L + MISC_OFF);
                    LAS unsigned* tab = (LAS unsigned*)(L);
                    LAS unsigned* tot = (LAS unsigned*)(L + 8192);
                    LAS unsigned* off = (LAS unsigned*)(L + 8192 + 64);
                    LAS unsigned* wcn = (LAS unsigned*)(L + 8192 + 128);
                    LAS unsigned* slt = (LAS unsigned*)(L + 8192 + 512);
                    const unsigned* RT_CNT = WSP(const unsigned, WS_ROUTE + R_CNT); const unsigned* RT_E = WSP(const unsigned, WS_ROUTE + R_E); int* RT_S = WSP(int, WS_ROUTE + R_S);
                    const bf16* H2 = ACTP(const bf16, A_H2); bf16* H2G = ACTP(bf16, A_H2G);
                    if (tid < 256) { const GAS v4u* src = (const GAS v4u*)(RT_CNT + tid * 8); const v4u a = src[0], b = src[1];
                        tab[tid * 8 + 0] = a.x; tab[tid * 8 + 1] = a.y; tab[tid * 8 + 2] = a.z; tab[tid * 8 + 3] = a.w; tab[tid * 8 + 4] = b.x; tab[tid * 8 + 5] = b.y; tab[tid * 8 + 6] = b.z; tab[tid * 8 + 7] = b.w; }
                    __syncthreads();
                    if (tid < 8) { unsigned t = 0, o = 0; for (int blk = 0; blk < 256; ++blk) { const unsigned c = tab[blk * 8 + tid]; if (blk < vcu) o += c; t += c; } tot[tid] = t; off[tid] = o; }
                    __syncthreads();
                    if (tid == 0) { unsigned sp = 0; for (int e = 0; e < 8; ++e) { MISC[16 + e] = sp; sp += (tot[e] + 255u) >> 8; } MISC[24] = sp; }
                    __syncthreads();
                    int my_e = 0, my_rank = 0;
                    if (tid < 256) { const int row = vcu * 128 + (tid >> 1); const unsigned ee = RT_E[row]; my_e = (tid & 1) ? (int)((ee >> 8) & 255u) : (int)(ee & 255u);
#pragma unroll
                        for (int e = 0; e < 8; ++e) { const unsigned long long mask = __ballot(my_e == e); if (my_e == e) my_rank = __popcll(mask & ((1ull << lane) - 1ull)); if (lane == 0) wcn[wave * 8 + e] = (unsigned)__popcll(mask); } }
                    __syncthreads();
                    if (tid < 256) { unsigned pre = 0; for (int w = 0; w < wave; ++w) pre += wcn[w * 8 + my_e];
                        const unsigned slot = MISC[16 + my_e] * 256u + off[my_e] + pre + (unsigned)my_rank;
                        RT_S[(vcu * 128 + (tid >> 1)) * 2 + (tid & 1)] = (int)slot; slt[tid] = slot; }
                    __syncthreads();
                    for (int i = 0; i < 32; ++i) { const int id = wave * 32 + i; const unsigned slot = slt[id];
                        const GAS v4u* src = (const GAS v4u*)(H2 + (size_t)(vcu * 128 + (id >> 1)) * DMODEL) + lane * 2; GAS v4u* dst = (GAS v4u*)(H2G + (size_t)slot * DMODEL) + lane * 2;
                        const v4u a = src[0], b = src[1]; dst[0] = a; dst[1] = b; }
                    if (vcu < 8) { const unsigned e = (unsigned)vcu; const unsigned r0 = MISC[16 + e] * 256u + tot[e], r1 = MISC[17 + e] * 256u; const v4u z = {0u, 0u, 0u, 0u};
                        for (unsigned r = r0 + (unsigned)wave; r < r1; r += NWAVES) { GAS v4u* dst = (GAS v4u*)(H2G + (size_t)r * DMODEL) + lane * 2; dst[0] = z; dst[1] = z; } }
                }
                GRID_BAR();
#define MOE_SCHED(S, NN) do { volatile LAS unsigned* MISC = (volatile LAS unsigned*)(L + MISC_OFF); S.nn = (NN); \
        S.sp1 = __builtin_amdgcn_readfirstlane((int)MISC[17]); S.sp2 = __builtin_amdgcn_readfirstlane((int)MISC[18]); S.sp3 = __builtin_amdgcn_readfirstlane((int)MISC[19]); S.sp4 = __builtin_amdgcn_readfirstlane((int)MISC[20]); \
        S.sp5 = __builtin_amdgcn_readfirstlane((int)MISC[21]); S.sp6 = __builtin_amdgcn_readfirstlane((int)MISC[22]); S.sp7 = __builtin_amdgcn_readfirstlane((int)MISC[23]); \
        S.so.init(__builtin_amdgcn_readfirstlane((int)MISC[24]), (NN), gridDim.x, (int)blockIdx.x); } while (0)
                { OPQ; pg8::SchedMoe S; MOE_SCHED(S, 22);
                  pg8::Gemm g{ACTP(bf16, A_H2G), WSP(bf16, WS_WMGU), 1024, 1024, 1024}; pg8::EpiSwi E{ACTP(bf16, A_AG)};
                  pg8::gemm_phase<pg8::EpiSwi, pg8::SchedMoe, true, true>(L0 + RING_OFF, g, S, E, MYTID()); }
                GRID_BAR();
                { OPQ; pg8::SchedMoe S; MOE_SCHED(S, 4);
                  pg8::Gemm g{ACTP(bf16, A_AG), WSP(bf16, WS_WMD), 2816, 2816, 2816}; pg8::EpiBf E{ACTP(bf16, A_YG)};
                  pg8::gemm_phase<pg8::EpiBf, pg8::SchedMoe, true, true>(L0 + RING_OFF, g, S, E, MYTID()); }
                GRID_BAR();
                {
                    TID_SETUP;
                    const int* RT_S = WSP(const int, WS_ROUTE + R_S); const float* RT_W = WSP(const float, WS_ROUTE + R_W); float* xo = LDP(float, 31); const bf16* YG = ACTP(const bf16, A_YG);
                    const GAS f32x4* gr = (const GAS f32x4*)LDP(const float, 30) + lane;
                    for (int m = gw; m < NH; m += NGW) {
                        const int s1 = RT_S[2 * m], s2 = RT_S[2 * m + 1]; const float w1 = RT_W[2 * m], w2 = RT_W[2 * m + 1];
                        GAS f32x4* xr = (GAS f32x4*)(xo + (size_t)(tokbase + m) * DMODEL) + lane;
                        const GAS unsigned long long* y1 = (const GAS unsigned long long*)(YG + (size_t)s1 * DMODEL) + lane; const GAS unsigned long long* y2 = (const GAS unsigned long long*)(YG + (size_t)s2 * DMODEL) + lane;
                        f32x4 v[4]; float sq = 0.f;
#pragma unroll
                        for (int j = 0; j < 4; ++j) { const unsigned long long a = y1[64 * j], b = y2[64 * j]; f32x4 xa = xr[64 * j];
                            const unsigned alo = (unsigned)a, ahi = (unsigned)(a >> 32), blo = (unsigned)b, bhi = (unsigned)(b >> 32);
                            xa.x += w1 * __uint_as_float(alo << 16) + w2 * __uint_as_float(blo << 16); xa.y += w1 * __uint_as_float(alo & 0xffff0000u) + w2 * __uint_as_float(blo & 0xffff0000u);
                            xa.z += w1 * __uint_as_float(ahi << 16) + w2 * __uint_as_float(bhi << 16); xa.w += w1 * __uint_as_float(ahi & 0xffff0000u) + w2 * __uint_as_float(bhi & 0xffff0000u);
                            v[j] = xa; sq += (xa.x * xa.x + xa.y * xa.y) + (xa.z * xa.z + xa.w * xa.w); }
                        const float rs = 1.0f / sqrtf(wave_sum(sq) * (1.0f / DMODEL) + EPS_NORM);
#pragma unroll
                        for (int j = 0; j < 4; ++j) xr[64 * j] = v[j] * rs * gr[64 * j];
                    }
                }
                GRID_BAR();
            }
        }
    }
#undef GRID_BAR
#undef TID_SETUP
#undef LQ
#undef MYTID
#undef OPQ
#undef WSP
#undef ACTP
#undef MOE_SCHED
}

extern "C" void kernel_launch(void* const* d_in, const int* in_sizes, int n_in, void* d_out, int out_size, void* d_ws, size_t ws_size, hipStream_t stream) {
    static int grid = 0;
    if (grid == 0) {
        if (n_in != 31 || in_sizes[0] != NTOK * DMODEL || out_size != NTOK * DMODEL || ws_size < WS_END) {
            fprintf(stderr, "kernel_launch: unexpected shapes: n_in %d in0 %d out %d ws %zu (need %zu); nothing launched\n", n_in, n_in > 0 ? in_sizes[0] : -1, out_size, ws_size, (size_t)WS_END); grid = -1; return; }
        int dev = 0, cus = 0, per_cu = 0;
        if (hipGetDevice(&dev) != hipSuccess || hipDeviceGetAttribute(&cus, hipDeviceAttributeMultiprocessorCount, dev) != hipSuccess) { grid = -1; return; }
        if (hipFuncSetAttribute((const void*)trunk_fwd, hipFuncAttributeMaxDynamicSharedMemorySize, LDS_BYTES) != hipSuccess) { fprintf(stderr, "kernel_launch: hipFuncSetAttribute failed\n"); grid = -1; return; }
        if (hipOccupancyMaxActiveBlocksPerMultiprocessor(&per_cu, (const void*)trunk_fwd, NWAVES * 64, LDS_BYTES) != hipSuccess || per_cu < 1)
            fprintf(stderr, "kernel_launch: note: occupancy query reports %d workgroups per CU\n", per_cu);
        (void)hipGetLastError();
        grid = 256;
        if (cus < 256) { fprintf(stderr, "kernel_launch: device has %d CUs, need 256; nothing launched\n", cus); grid = -1; return; }
    }
    if (grid < 0) return;
    if (hipMemsetAsync((char*)d_ws + WS_CTL, 0, CTL_ZERO_BYTES, stream) != hipSuccess) return;
    Args a{};
    for (int i = 0; i < 31; ++i) a.in[i] = d_in[i];
    a.out = (float*)d_out; a.ws = (unsigned char*)d_ws;
    hipLaunchKernelGGL(trunk_fwd, dim3(grid), dim3(NWAVES * 64), LDS_BYTES, stream, a);
}
```

```cpp
#include <hip/hip_runtime.h>
#include <hip/hip_bf16.h>
#include <cstdio>
#include <cstdint>
#include <cmath>
namespace pg8 {
#define PG8_LAS __attribute__((address_space(3)))
typedef unsigned short bf16_t;
typedef short bf16x8 __attribute__((ext_vector_type(8)));
typedef float f32x4 __attribute__((ext_vector_type(4)));
typedef unsigned u32x4 __attribute__((ext_vector_type(4)));
constexpr int BM = 256, BK = 64, HALF = 128, HTB = HALF * BK * 2  , STAGE_BYTES = 8 * HTB, NXCD = 8, WGM = 8;

__host__ __device__ __forceinline__ int lds_byte(int r, int c) { const int st = (r >> 4) * 2 + (c >> 5), rr = r & 15, cc = c & 31, ob = rr * 64 + cc * 2; return st * 1024 + (ob ^ (((ob >> 9) & 1) << 5)); }
__host__ __device__ __forceinline__ void stage_rc(int b, int& R, int& C) { const int st = b / 1024, sb = b % 1024, swz = sb ^ (((sb >> 9) & 1) << 5); R = (st >> 1) * 16 + swz / 64; C = (st & 1) * 32 + (swz % 64) / 2; }
__host__ __device__ __forceinline__ int perm32(int rho) { const int n = rho >> 4, i = rho & 15; return 8 * (i >> 2) + 4 * n + (i & 3); }

struct Unit { int pm, pn; };
struct Gemm { const bf16_t* A; const bf16_t* Bt; int lda, ldb, K; };

struct StaticOrder {
    int nM, nN, nwg, G, c;
    __host__ __device__ void init(int nM_, int nN_, int G_, int c_) { nM = nM_; nN = nN_; nwg = nM * nN; G = G_; c = c_; }
    __host__ __device__ bool next(int i, Unit& u) const {
        const long L = (long)i * G + c; if (L >= nwg) return false;
        int wgid = (int)L; { const int q = nwg / NXCD, r = nwg % NXCD, xcd = wgid % NXCD, off = wgid / NXCD; wgid = (xcd < r ? xcd * (q + 1) : r * (q + 1) + (xcd - r) * q) + off; }
        const int nig = WGM * nN, gid = wgid / nig, fm = gid * WGM, gsz = (nM - fm) < WGM ? (nM - fm) : WGM;
        u.pm = fm + ((wgid % nig) % gsz); u.pn = (wgid % nig) / gsz; return true;
    }
    __device__ __forceinline__ void a_ready(const Unit&) const {}
    __device__ __forceinline__ void done(const Unit&) const {}
};


struct SchedPlain {
    StaticOrder so;
    __device__ __forceinline__ void init(int nM, int nN, int G, int c) { so.init(nM, nN, G, c); }
    __device__ __forceinline__ bool next(int i, Unit& u) const { return so.next(i, u); }
    __device__ __forceinline__ void a_ready(const Unit&) const {}
    __device__ __forceinline__ void done(const Unit&) const {}
};
struct SchedS5 {
    StaticOrder so; int nng;
    __device__ __forceinline__ void init(int nng_, int G, int c) { nng = nng_; so.init(128, nng_, G, c); }
    __device__ __forceinline__ bool next(int i, Unit& u) const { if (!so.next(i, u)) return false; u.pn = (u.pm >> 2) * nng + u.pn; return true; }
    __device__ __forceinline__ void a_ready(const Unit&) const {}
    __device__ __forceinline__ void done(const Unit&) const {}
};
struct SchedMoe {
    StaticOrder so; int nn; int sp1, sp2, sp3, sp4, sp5, sp6, sp7;
    __device__ __forceinline__ bool next(int i, Unit& u) const {
        if (!so.next(i, u)) return false;
        const int pm = u.pm; const int e = (pm >= sp1) + (pm >= sp2) + (pm >= sp3) + (pm >= sp4) + (pm >= sp5) + (pm >= sp6) + (pm >= sp7);
        u.pn = e * nn + u.pn; return true;
    }
    __device__ __forceinline__ void a_ready(const Unit&) const {}
    __device__ __forceinline__ void done(const Unit&) const {}
};

typedef float f32x2c_t __attribute__((ext_vector_type(2))); typedef __bf16 bf16x2c_t __attribute__((ext_vector_type(2)));
__device__ __forceinline__ unsigned cvt_pk_bf16(float lo, float hi) { f32x2c_t v = {lo, hi}; bf16x2c_t b = __builtin_convertvector(v, bf16x2c_t); return __builtin_bit_cast(unsigned, b); }
__device__ __forceinline__ u32x4 pack8(const f32x4 a, const f32x4 b) { u32x4 w; w.x = cvt_pk_bf16(a[0], a[1]); w.y = cvt_pk_bf16(a[2], a[3]); w.z = cvt_pk_bf16(b[0], b[1]); w.w = cvt_pk_bf16(b[2], b[3]); return w; }
__device__ __forceinline__ void unpack8(const u32x4 w, f32x4& a, f32x4& b) {
    a[0] = __uint_as_float(w.x << 16); a[1] = __uint_as_float(w.x & 0xffff0000u); a[2] = __uint_as_float(w.y << 16); a[3] = __uint_as_float(w.y & 0xffff0000u);
    b[0] = __uint_as_float(w.z << 16); b[1] = __uint_as_float(w.z & 0xffff0000u); b[2] = __uint_as_float(w.w << 16); b[3] = __uint_as_float(w.w & 0xffff0000u); }
__device__ __forceinline__ float sigm(float z) { return __builtin_amdgcn_rcpf(1.0f + __builtin_amdgcn_exp2f(-1.4426950408889634f * z)); }
__device__ __forceinline__ f32x4 sigm4(const f32x4 z) { f32x4 r; r[0] = sigm(z[0]); r[1] = sigm(z[1]); r[2] = sigm(z[2]); r[3] = sigm(z[3]); return r; }
__device__ __forceinline__ float gelu_t(float x) { const float u = 1.5957691216057308f * (x + 0.044715f * x * x * x); return x * sigm(u); }
__device__ __forceinline__ f32x4 gelu4(const f32x4 z) { f32x4 r; r[0] = gelu_t(z[0]); r[1] = gelu_t(z[1]); r[2] = gelu_t(z[2]); r[3] = gelu_t(z[3]); return r; }
constexpr size_t EA_U = (size_t)64 << 20, EA_Q = (size_t)120 << 20, EA_K = (size_t)184 << 20, EA_V = (size_t)248 << 20, EA_SGS = (size_t)312 << 20, EA_SGA = (size_t)376 << 20;
constexpr float QSCALE = 0.125f * 1.4426950408889634f;

struct EpiIn {
    static constexpr bool PERM = true, AFTER_DRAIN = false;
    unsigned char* act; const float* rope; int tokbase;
    __device__ __forceinline__ void operator()(const f32x4 (&acc)[2][2][4][2], const Unit& u, int wr, int wc, int fr_in, int fq_in) const {
        int fr = fr_in, fq = fq_in; asm volatile("" : "+v"(fr), "+v"(fq));
        const int pn = u.pn, rowb = u.pm * BM + wr * 64 + fr, cow = wc * 32 + fq * 8;
        if (pn < 2) {
#pragma unroll
            for (int ai = 0; ai < 2; ++ai)
#pragma unroll
                for (int m = 0; m < 4; ++m) { const int row = rowb + ai * HALF + m * 16;
#pragma unroll
                    for (int bj = 0; bj < 2; ++bj) { const int c = pn * 256 + bj * HALF + cow; const int g = c >> 4, jj = c & 15;
                        bf16_t* dst = (bf16_t*)(act + EA_U) + ((size_t)(g * 1024 + (row >> 5)) * 640 + (row & 31) * 16 + jj);
                        *(u32x4*)dst = pack8(acc[ai][bj][m][0], acc[ai][bj][m][1]); } }
        } else if (pn < 10) {
            const bool isq = pn < 6; bf16_t* base = (bf16_t*)(act + (isq ? EA_Q : EA_K)); const int colt = (isq ? pn - 2 : pn - 6) * 256; const float sc = isq ? QSCALE : 1.0f;
            const int dlo = 16 * (wc & 1) + 4 * fq;
#pragma unroll
            for (int ai = 0; ai < 2; ++ai)
#pragma unroll
                for (int m = 0; m < 4; ++m) { const int row = rowb + ai * HALF + m * 16;
                    const float* tr = rope + (size_t)(tokbase + row) * 64 + dlo; const f32x4 cs = *(const f32x4*)tr, sn = *(const f32x4*)(tr + 32);
#pragma unroll
                    for (int bj = 0; bj < 2; ++bj) { const f32x4 v0 = acc[ai][bj][m][0], v1 = acc[ai][bj][m][1];
                        const f32x4 o0 = (v0 * cs - v1 * sn) * sc, o1 = (v1 * cs + v0 * sn) * sc;
                        *(u32x4*)(base + (size_t)row * 1024 + colt + bj * HALF + cow) = pack8(o0, o1); } }
        } else if (pn < 14) {
            const int colt = (pn - 10) * 256;
#pragma unroll
            for (int ai = 0; ai < 2; ++ai)
#pragma unroll
                for (int m = 0; m < 4; ++m) { const int row = rowb + ai * HALF + m * 16;
#pragma unroll
                    for (int bj = 0; bj < 2; ++bj) *(u32x4*)((bf16_t*)(act + EA_V) + (size_t)row * 1024 + colt + bj * HALF + cow) = pack8(acc[ai][bj][m][0], acc[ai][bj][m][1]); }
        } else {
            bf16_t* base = (bf16_t*)(act + (pn < 18 ? EA_SGS : EA_SGA)); const int colt = (pn < 18 ? pn - 14 : pn - 18) * 256;
#pragma unroll
            for (int ai = 0; ai < 2; ++ai)
#pragma unroll
                for (int m = 0; m < 4; ++m) { const int row = rowb + ai * HALF + m * 16;
#pragma unroll
                    for (int bj = 0; bj < 2; ++bj) *(u32x4*)(base + (size_t)row * 1024 + colt + bj * HALF + cow) = pack8(sigm4(acc[ai][bj][m][0]), sigm4(acc[ai][bj][m][1])); }
        }
    }
};
struct EpiSloc {
    static constexpr bool PERM = false, AFTER_DRAIN = false;
    float* S;
    __device__ __forceinline__ void operator()(const f32x4 (&acc)[2][2][4][2], const Unit& u, int wr, int wc, int fr_in, int fq_in) const {
        int fr = fr_in, fq = fq_in; asm volatile("" : "+v"(fr), "+v"(fq));
        const int rowb = u.pm * BM + wr * 64 + fr, col0 = wc * 32 + 4 * fq;
#pragma unroll
        for (int ai = 0; ai < 2; ++ai)
#pragma unroll
            for (int m = 0; m < 4; ++m) { float* rowp = S + (size_t)(rowb + ai * HALF + m * 16) * 128 + col0;
#pragma unroll
                for (int n = 0; n < 2; ++n) *(f32x4*)(rowp + n * 16) = acc[ai][0][m][n]; }
    }
};
struct EpiYa {
    static constexpr bool PERM = true, AFTER_DRAIN = false;
    bf16_t* YA;
    __device__ __forceinline__ void operator()(const f32x4 (&acc)[2][2][4][2], const Unit& u, int wr, int wc, int fr_in, int fq_in) const {
        int fr = fr_in, fq = fq_in; asm volatile("" : "+v"(fr), "+v"(fq));
        const int g = u.pm >> 2, pni = u.pn & 1; const int rowb = (u.pm & 3) * BM + wr * 64 + fr; const int jj = 8 * (fq & 1);
#pragma unroll
        for (int ai = 0; ai < 2; ++ai)
#pragma unroll
            for (int m = 0; m < 4; ++m) { const int R = rowb + ai * HALF + m * 16;
#pragma unroll
                for (int bj = 0; bj < 2; ++bj) { const int t = pni * 16 + bj * 8 + wc * 2 + (fq >> 1);
                    *(u32x4*)(YA + (size_t)(R * 32 + t) * 512 + g * 16 + jj) = pack8(gelu4(acc[ai][bj][m][0]), gelu4(acc[ai][bj][m][1])); } }
    }
};
struct EpiGlu {
    static constexpr bool PERM = true, AFTER_DRAIN = false;
    const bf16_t* YA; bf16_t* O; const float* bias;
    __device__ __forceinline__ void operator()(const f32x4 (&acc)[2][2][4][2], const Unit& u, int wr, int wc, int fr_in, int fq_in) const {
        int fr = fr_in, fq = fq_in; asm volatile("" : "+v"(fr), "+v"(fq));
        const int rowb = u.pm * BM + wr * 64 + fr, col0 = u.pn * BM + wc * 32 + 8 * fq;
        f32x4 bv[2][2];
#pragma unroll
        for (int bj = 0; bj < 2; ++bj)
#pragma unroll
            for (int n = 0; n < 2; ++n) bv[bj][n] = *(const f32x4*)(bias + col0 + bj * HALF + 4 * n);
#pragma unroll
        for (int ai = 0; ai < 2; ++ai)
#pragma unroll
            for (int m = 0; m < 4; ++m) { const size_t off = (size_t)(rowb + ai * HALF + m * 16) * 512 + col0;
#pragma unroll
                for (int bj = 0; bj < 2; ++bj) { f32x4 y0, y1; unpack8(*(const u32x4*)(YA + off + bj * HALF), y0, y1);
                    *(u32x4*)(O + off + bj * HALF) = pack8(y0 * sigm4(acc[ai][bj][m][0] + bv[bj][0]), y1 * sigm4(acc[ai][bj][m][1] + bv[bj][1])); } }
    }
};
template <int MODE> struct EpiGate {
    static constexpr bool PERM = true, AFTER_DRAIN = false;
    bf16_t* G; const bf16_t* T0;
    __device__ __forceinline__ void operator()(const f32x4 (&acc)[2][2][4][2], const Unit& u, int wr, int wc, int fr_in, int fq_in) const {
        int fr = fr_in, fq = fq_in; asm volatile("" : "+v"(fr), "+v"(fq));
        const int rowb = u.pm * BM + wr * 64 + fr, col0 = u.pn * BM + wc * 32 + 8 * fq;
#pragma unroll
        for (int ai = 0; ai < 2; ++ai)
#pragma unroll
            for (int m = 0; m < 4; ++m) { const size_t off = (size_t)(rowb + ai * HALF + m * 16) * 1024 + col0;
#pragma unroll
                for (int bj = 0; bj < 2; ++bj) { f32x4 g0, g1; unpack8(*(const u32x4*)(G + off + bj * HALF), g0, g1);
                    f32x4 o0 = g0 * acc[ai][bj][m][0], o1 = g1 * acc[ai][bj][m][1];
                    if (MODE == 1) { f32x4 t0, t1; unpack8(*(const u32x4*)(T0 + off + bj * HALF), t0, t1); o0 += t0; o1 += t1; }
                    *(u32x4*)(G + off + bj * HALF) = pack8(o0, o1); } }
    }
};
struct EpiRes {
    static constexpr bool PERM = false, AFTER_DRAIN = false;
    const float* xin; float* xout; int tokbase;
    __device__ __forceinline__ void operator()(const f32x4 (&acc)[2][2][4][2], const Unit& u, int wr, int wc, int fr_in, int fq_in) const {
        int fr = fr_in, fq = fq_in; asm volatile("" : "+v"(fr), "+v"(fq));
        const int rowb = tokbase + u.pm * BM + wr * 64 + fr, col0 = u.pn * BM + wc * 32 + 4 * fq;
#pragma unroll
        for (int ai = 0; ai < 2; ++ai)
#pragma unroll
            for (int m = 0; m < 4; ++m) { const size_t off = (size_t)(rowb + ai * HALF + m * 16) * 1024 + col0;
#pragma unroll
                for (int bj = 0; bj < 2; ++bj)
#pragma unroll
                    for (int n = 0; n < 2; ++n) { const f32x4 xi = *(const f32x4*)(xin + off + bj * HALF + n * 16); *(f32x4*)(xout + off + bj * HALF + n * 16) = xi + acc[ai][bj][m][n]; } }
    }
};
struct EpiSwi {
    static constexpr bool PERM = true, AFTER_DRAIN = false;
    bf16_t* O;
    __device__ __forceinline__ void operator()(const f32x4 (&acc)[2][2][4][2], const Unit& u, int wr, int wc, int fr_in, int fq_in) const {
        int fr = fr_in, fq = fq_in; asm volatile("" : "+v"(fr), "+v"(fq));
        const int rowb = u.pm * BM + wr * 64 + fr, col0 = (u.pn % 22) * HALF + wc * 32 + 8 * fq;
#pragma unroll
        for (int ai = 0; ai < 2; ++ai)
#pragma unroll
            for (int m = 0; m < 4; ++m) { const f32x4 g0 = acc[ai][0][m][0], g1 = acc[ai][0][m][1];
                *(u32x4*)(O + (size_t)(rowb + ai * HALF + m * 16) * 2816 + col0) = pack8(g0 * sigm4(g0) * acc[ai][1][m][0], g1 * sigm4(g1) * acc[ai][1][m][1]); }
    }
};
struct EpiBf {
    static constexpr bool PERM = true, AFTER_DRAIN = false;
    bf16_t* O;
    __device__ __forceinline__ void operator()(const f32x4 (&acc)[2][2][4][2], const Unit& u, int wr, int wc, int fr_in, int fq_in) const {
        int fr = fr_in, fq = fq_in; asm volatile("" : "+v"(fr), "+v"(fq));
        const int rowb = u.pm * BM + wr * 64 + fr, col0 = (u.pn & 3) * BM + wc * 32 + 8 * fq;
#pragma unroll
        for (int ai = 0; ai < 2; ++ai)
#pragma unroll
            for (int m = 0; m < 4; ++m)
#pragma unroll
                for (int bj = 0; bj < 2; ++bj) *(u32x4*)(O + (size_t)(rowb + ai * HALF + m * 16) * 1024 + col0 + bj * HALF) = pack8(acc[ai][bj][m][0], acc[ai][bj][m][1]);
    }
};

template <class Epi, class Sched, bool ALIGN_EPI = false, bool SP2 = false>
__device__ __forceinline__ void gemm_phase(PG8_LAS unsigned char* lds, const Gemm g, const Sched& S, const Epi& E, const int tid_in) {
    const int tid = tid_in, wid = __builtin_amdgcn_readfirstlane(tid >> 6), lane = tid & 63, wr = wid >> 2, wc = wid & 3, fr = lane & 15, fq = lane >> 4;
    const int K = g.K, nt = K / BK;
    unsigned voffA[2], voffB[2];
#pragma unroll
    for (int i = 0; i < 2; ++i) { int R, C; stage_rc(tid * 16 + i * 8192, R, C); const int Rb = Epi::PERM ? ((R & ~31) + perm32(R & 31)) : R;
        voffA[i] = (unsigned)(R * g.lda + C) * 2u; voffB[i] = (unsigned)(Rb * g.ldb + C) * 2u; }
    const size_t kstep = (size_t)(BK * 2);
    const size_t hstepA = (size_t)HALF * g.lda * 2, hstepB = (size_t)HALF * g.ldb * 2;
    const size_t tstepA = 2 * hstepA, tstepB = 2 * hstepB;
    const unsigned ldsw = (unsigned)wid * 1024u;
    const int aoff = lds_byte(wr * 64 + fr, fq * 8), boff = lds_byte(wc * 32 + fr, fq * 8);
#define PG8_SA(b, h) (((b) * 2 + (h)) * HTB)
#define PG8_SB(b, h) ((4 + (b) * 2 + (h)) * HTB)
#define PG8_STAGE(bufoff, gbase, voff) do { _Pragma("unroll") for (int _i = 0; _i < 2; ++_i) \
        __builtin_amdgcn_global_load_lds((const unsigned*)((const char*)(gbase) + (voff)[_i]), (PG8_LAS unsigned*)(lds + (bufoff) + ldsw + _i * 8192), 16, 0, 0); } while (0)
#define PG8_LDA(dst, b, h) do { _Pragma("unroll") for (int m = 0; m < 4; ++m) _Pragma("unroll") for (int k = 0; k < 2; ++k) dst[m][k] = *(const PG8_LAS bf16x8*)(lds + PG8_SA(b, h) + aoff + m * 2048 + k * 1024); } while (0)
#define PG8_LDB(dst, b, h) do { _Pragma("unroll") for (int n = 0; n < 2; ++n) _Pragma("unroll") for (int k = 0; k < 2; ++k) dst[n][k] = *(const PG8_LAS bf16x8*)(lds + PG8_SB(b, h) + boff + n * 2048 + k * 1024); } while (0)
#define PG8_MMA(ai, bj, At, Bt) do { __builtin_amdgcn_s_setprio(1); _Pragma("unroll") for (int m = 0; m < 4; ++m) _Pragma("unroll") for (int n = 0; n < 2; ++n) _Pragma("unroll") for (int k = 0; k < 2; ++k) \
        acc[ai][bj][m][n] = __builtin_amdgcn_mfma_f32_16x16x32_bf16(Bt[n][k], At[m][k], acc[ai][bj][m][n], 0, 0, 0); __builtin_amdgcn_s_setprio(0); } while (0)
#define PG8_WAIT_V(n) asm volatile("s_waitcnt vmcnt(" #n ")" ::: "memory")
#define PG8_WAIT_L(n) asm volatile("s_waitcnt lgkmcnt(" #n ")" ::: "memory")
#define PG8_BAR __builtin_amdgcn_s_barrier()
#define PG8_SCHED __builtin_amdgcn_sched_barrier(0)
    Unit cur, nxt; int ui = 0;
    if (!S.next(0, cur)) return;
    f32x4 acc[2][2][4][2];
#pragma unroll
    for (int a = 0; a < 2; ++a)
#pragma unroll
        for (int b = 0; b < 2; ++b)
#pragma unroll
            for (int m = 0; m < 4; ++m)
#pragma unroll
                for (int n = 0; n < 2; ++n) acc[a][b][m][n] = (f32x4){0.f, 0.f, 0.f, 0.f};
    bf16x8 At[4][2], B0[2][2], B1[2][2];
    const char* cA = (const char*)g.A + (size_t)cur.pm * tstepA; const char* cB = (const char*)g.Bt + (size_t)cur.pn * tstepB;
    S.a_ready(cur);
    if constexpr (SP2) {
        PG8_STAGE(PG8_SB(0, 0), cB, voffB); PG8_STAGE(PG8_SB(0, 1), cB + hstepB, voffB); PG8_STAGE(PG8_SA(0, 0), cA, voffA); PG8_STAGE(PG8_SA(0, 1), cA + hstepA, voffA);
        if (wr == 1) PG8_BAR;
        PG8_WAIT_V(2); PG8_BAR;
        PG8_STAGE(PG8_SB(1, 0), cB + kstep, voffB); PG8_STAGE(PG8_SA(1, 0), cA + kstep, voffA); PG8_STAGE(PG8_SB(1, 1), cB + hstepB + kstep, voffB);
        PG8_WAIT_V(6); PG8_BAR;
    } else {
        PG8_STAGE(PG8_SB(0, 0), cB, voffB); PG8_STAGE(PG8_SA(0, 0), cA, voffA); PG8_STAGE(PG8_SB(0, 1), cB + hstepB, voffB); PG8_STAGE(PG8_SA(0, 1), cA + hstepA, voffA);
        if (wr == 1) PG8_BAR;
        PG8_WAIT_V(4); PG8_BAR;
        PG8_STAGE(PG8_SB(1, 0), cB + kstep, voffB); PG8_STAGE(PG8_SA(1, 0), cA + kstep, voffA); PG8_STAGE(PG8_SB(1, 1), cB + hstepB + kstep, voffB);
        PG8_WAIT_V(6); PG8_BAR;
    }
    for (;;) {
        const bool has_next = S.next(ui + 1, nxt);
        const char* nA = has_next ? (const char*)g.A + (size_t)nxt.pm * tstepA : cA; const char* nB = has_next ? (const char*)g.Bt + (size_t)nxt.pn * tstepB : cB;
        for (int t = 0; t < nt; t += 2) {
            const bool last = (t == nt - 2);
            const char* a1 = cA + (size_t)(t + 1) * kstep;
            const char* a2 = last ? nA : cA + (size_t)(t + 2) * kstep; const char* b2 = last ? nB : cB + (size_t)(t + 2) * kstep;
            const char* a3 = a2 + kstep; const char* b3 = b2 + kstep;
            if (last && has_next) S.a_ready(nxt);
            if constexpr (SP2) {
            PG8_LDB(B0, 0, 0); PG8_LDB(B1, 0, 1); PG8_SCHED; PG8_LDA(At, 0, 0); PG8_STAGE(PG8_SA(1, 1), a1 + hstepA, voffA);
            PG8_WAIT_V(8); PG8_WAIT_L(0); PG8_BAR; PG8_MMA(0, 0, At, B0); PG8_MMA(0, 1, At, B1); PG8_BAR; PG8_SCHED;
            PG8_LDA(At, 0, 1); PG8_STAGE(PG8_SB(0, 0), b2, voffB); PG8_STAGE(PG8_SB(0, 1), b2 + hstepB, voffB); PG8_STAGE(PG8_SA(0, 0), a2, voffA);
            PG8_WAIT_V(8); PG8_WAIT_L(0); PG8_BAR; PG8_MMA(1, 0, At, B0); PG8_MMA(1, 1, At, B1); PG8_BAR; PG8_SCHED;
            PG8_LDB(B0, 1, 0); PG8_LDB(B1, 1, 1); PG8_SCHED; PG8_LDA(At, 1, 0); PG8_STAGE(PG8_SA(0, 1), a2 + hstepA, voffA);
            PG8_WAIT_V(8); PG8_WAIT_L(0); PG8_BAR; PG8_MMA(0, 0, At, B0); PG8_MMA(0, 1, At, B1); PG8_BAR; PG8_SCHED;
            PG8_LDA(At, 1, 1); PG8_STAGE(PG8_SB(1, 0), b3, voffB); PG8_STAGE(PG8_SB(1, 1), b3 + hstepB, voffB); PG8_STAGE(PG8_SA(1, 0), a3, voffA);
            PG8_WAIT_V(8); PG8_WAIT_L(0); PG8_BAR; PG8_MMA(1, 0, At, B0); PG8_MMA(1, 1, At, B1); PG8_BAR; PG8_SCHED;
            } else {
            PG8_LDB(B0, 0, 0); PG8_SCHED; PG8_LDA(At, 0, 0); PG8_STAGE(PG8_SA(1, 1), a1 + hstepA, voffA);
            PG8_WAIT_L(8); PG8_BAR; PG8_WAIT_L(0); PG8_MMA(0, 0, At, B0); PG8_BAR; PG8_SCHED;
            PG8_LDB(B1, 0, 1); PG8_STAGE(PG8_SB(0, 0), b2, voffB);
            PG8_BAR; PG8_WAIT_L(0); PG8_MMA(0, 1, At, B1); PG8_BAR;
            PG8_LDA(At, 0, 1); PG8_STAGE(PG8_SA(0, 0), a2, voffA);
            PG8_BAR; PG8_WAIT_L(0); PG8_MMA(1, 0, At, B0); PG8_BAR; PG8_SCHED;
            PG8_STAGE(PG8_SB(0, 1), b2 + hstepB, voffB);
            PG8_WAIT_V(6); PG8_BAR; PG8_MMA(1, 1, At, B1); PG8_BAR;
            PG8_LDB(B0, 1, 0); PG8_SCHED; PG8_LDA(At, 1, 0); PG8_STAGE(PG8_SA(0, 1), a2 + hstepA, voffA);
            PG8_WAIT_L(8); PG8_BAR; PG8_WAIT_L(0); PG8_MMA(0, 0, At, B0); PG8_BAR; PG8_SCHED;
            PG8_LDB(B1, 1, 1); PG8_STAGE(PG8_SB(1, 0), b3, voffB);
            PG8_BAR; PG8_WAIT_L(0); PG8_MMA(0, 1, At, B1); PG8_BAR;
            PG8_LDA(At, 1, 1); PG8_STAGE(PG8_SA(1, 0), a3, voffA);
            PG8_BAR; PG8_WAIT_L(0); PG8_MMA(1, 0, At, B0); PG8_BAR; PG8_SCHED;
            PG8_STAGE(PG8_SB(1, 1), b3 + hstepB, voffB);
            PG8_WAIT_V(6); PG8_BAR; PG8_MMA(1, 1, At, B1); PG8_BAR;
            }
        }
        if constexpr (ALIGN_EPI) { if (wr == 0) PG8_BAR; }
        if constexpr (!Epi::AFTER_DRAIN) { E(acc, cur, wr, wc, fr, fq); S.done(cur); }
        if (!has_next) break;
#pragma unroll
        for (int a = 0; a < 2; ++a)
#pragma unroll
            for (int b = 0; b < 2; ++b)
#pragma unroll
                for (int m = 0; m < 4; ++m)
#pragma unroll
                    for (int n = 0; n < 2; ++n) acc[a][b][m][n] = (f32x4){0.f, 0.f, 0.f, 0.f};
        cur = nxt; cA = nA; cB = nB; ++ui;
        if constexpr (ALIGN_EPI) { if (wr == 1) PG8_BAR; }
    }
    PG8_WAIT_V(0);
    if constexpr (!ALIGN_EPI) { if (wr == 0) PG8_BAR; }
    PG8_BAR;
    if constexpr (Epi::AFTER_DRAIN) { E.fused(acc, cur, wr, wc, fr, fq, lds, wid, lane); S.done(cur); }
#undef PG8_SA
#undef PG8_SB
#undef PG8_STAGE
#undef PG8_LDA
#undef PG8_LDB
#undef PG8_MMA
#undef PG8_WAIT_V
#undef PG8_WAIT_L
#undef PG8_BAR
#undef PG8_SCHED
}
}

#include <hip/hip_bf16.h>
#include <cmath>
namespace attn_body {
using bf16=__hip_bfloat16;
using bf16x8=__attribute__((ext_vector_type(8)))short;
using s16x4=__attribute__((ext_vector_type(4)))short;
using f32x16=__attribute__((ext_vector_type(16)))float;
using u32x4=__attribute__((ext_vector_type(4)))unsigned;
constexpr int SEQ=4096,D=64,DM=1024,OPITCH=2048;
constexpr int NW=8,QBLK=32,QB=QBLK*NW,KVBLK=64,NQB=SEQ/QB;
constexpr int ATTN_PITCH=DM, ATTN_UNIT_ROWS=QB;
__device__ __forceinline__ int crow(int r,int hi){return (r&3)+8*(r>>2)+4*hi;}
#define SBAR() __builtin_amdgcn_sched_barrier(0)
__device__ __forceinline__ void cmask(f32x16&p0,f32x16&p1,int jb,int qrel,int hi){
  const float NEG=-INFINITY; int kb=64*jb+4*hi;
  #pragma unroll
  for(int r=0;r<16;++r){int kv=kb+(r&3)+8*(r>>2); if(kv>qrel)p0[r]=NEG; if(kv+32>qrel)p1[r]=NEG;}
}

constexpr int NSLOT=3, SLOTB=8192;
constexpr int LDS_K=0, LDS_V=NSLOT*SLOTB, LDS_WS=2*NSLOT*SLOTB, LDS_OST=LDS_WS+NW*64*4, LDS_BYTES=LDS_OST+NW*4096;
constexpr float C2=0.125f*1.4426950408889634f;
__device__ __forceinline__ void glds16(const void*gsrc,unsigned lds_dst){unsigned keep;
  asm volatile("s_mov_b32 %0, m0\n\ts_mov_b32 m0, %2\n\ts_nop 0\n\tglobal_load_lds_dwordx4 %1, off\n\ts_mov_b32 m0, %0":"=&s"(keep):"v"(gsrc),"s"(lds_dst):"memory");}
__device__ __forceinline__ float max3f(float a,float b,float c){float r;asm("v_max3_f32 %0, %1, %2, %3":"=v"(r):"v"(a),"v"(b),"v"(c));return r;}
__device__ __forceinline__ float max2f(float a,float b){float r;asm("v_max_f32_e32 %0, %1, %2":"=v"(r):"v"(a),"v"(b));return r;}
__device__ __forceinline__ float fadd_s(float a,float b){float r;asm("v_add_f32_e32 %0, %1, %2":"=v"(r):"v"(a),"v"(b));return r;}
__device__ __forceinline__ float fsub_s(float a,float b){float r;asm("v_sub_f32_e32 %0, %1, %2":"=v"(r):"v"(a),"v"(b));return r;}
typedef float f32x2_t __attribute__((ext_vector_type(2))); typedef __bf16 bf16x2_t __attribute__((ext_vector_type(2)));
__device__ __forceinline__ unsigned cvtpk_s(float lo,float hi){f32x2_t v={lo,hi};bf16x2_t b=__builtin_convertvector(v,bf16x2_t);return __builtin_bit_cast(unsigned,b);}
#define WAIT_BAR(N) asm volatile("s_waitcnt vmcnt(" #N ") lgkmcnt(0)\n\ts_barrier":::"memory")

__device__ __forceinline__ f32x16 mfma_z(bf16x8 a_,bf16x8 b_){ f32x16 d_; asm volatile("s_nop 1\n\tv_mfma_f32_32x32x16_bf16 %0, %1, %2, 0":"=&v"(d_):"v"(a_),"v"(b_)); return d_; }
__device__ __forceinline__ void qkt(f32x16&p0,f32x16&p1,const char*Kslot,const bf16x8*qr,int r32,int hi){
  const char*kb=Kslot+hi*1024+r32*16;
  #pragma unroll
  for(int d0=0;d0<4;++d0){
    const bf16x8 b0=*reinterpret_cast<const bf16x8*>(kb+d0*2048);
    const bf16x8 b1=*reinterpret_cast<const bf16x8*>(kb+d0*2048+512);
    if(d0==0){f32x16 z0=f32x16{},z1=f32x16{};asm volatile("":"+v"(z0),"+v"(z1));
      p0=__builtin_amdgcn_mfma_f32_32x32x16_bf16(b0,qr[0],z0,0,0,0);p1=__builtin_amdgcn_mfma_f32_32x32x16_bf16(b1,qr[0],z1,0,0,0);}
    else{p0=__builtin_amdgcn_mfma_f32_32x32x16_bf16(b0,qr[d0],p0,0,0,0);p1=__builtin_amdgcn_mfma_f32_32x32x16_bf16(b1,qr[d0],p1,0,0,0);}}
}
typedef __attribute__((address_space(3))) const char* lds_cptr;
typedef short v4i16_t __attribute__((ext_vector_type(4)));
__device__ __forceinline__ void kload8(bf16x8*kf,lds_cptr kp){
  kf[0]=*(const __attribute__((address_space(3))) bf16x8*)(kp);      kf[1]=*(const __attribute__((address_space(3))) bf16x8*)(kp+512);
  kf[2]=*(const __attribute__((address_space(3))) bf16x8*)(kp+2048); kf[3]=*(const __attribute__((address_space(3))) bf16x8*)(kp+2560);
  kf[4]=*(const __attribute__((address_space(3))) bf16x8*)(kp+4096); kf[5]=*(const __attribute__((address_space(3))) bf16x8*)(kp+4608);
  kf[6]=*(const __attribute__((address_space(3))) bf16x8*)(kp+6144); kf[7]=*(const __attribute__((address_space(3))) bf16x8*)(kp+6656);
}
__device__ __forceinline__ void kload2(bf16x8*kf,lds_cptr kp,int j){ kf[2*j]=*(const __attribute__((address_space(3))) bf16x8*)(kp+j*2048); kf[2*j+1]=*(const __attribute__((address_space(3))) bf16x8*)(kp+j*2048+512); }
__device__ __forceinline__ s16x4 vtr(lds_cptr p){ return __builtin_bit_cast(s16x4,__builtin_amdgcn_ds_read_tr16_b64_v4i16((__attribute__((address_space(3))) v4i16_t*)p)); }
__device__ __forceinline__ float rowmax(const f32x16&p0,const f32x16&p1){
  float a=max3f(p0[0],p0[1],p1[0]),b=max3f(p0[2],p0[3],p1[1]);a=max3f(a,p1[2],p1[3]);
  #pragma unroll
  for(int r=4;r<16;r+=4){a=max3f(a,p0[r],p0[r+1]);b=max3f(b,p0[r+2],p0[r+3]);a=max3f(a,p1[r],p1[r+1]);b=max3f(b,p1[r+2],p1[r+3]);}
  const float m=max2f(a,b);
  auto rr=__builtin_amdgcn_permlane32_swap(__float_as_uint(m),__float_as_uint(m),false,false);
  return max2f(__uint_as_float(rr[0]),__uint_as_float(rr[1]));
}
__device__ __forceinline__ void pv(f32x16*o,int vb,bf16x8 pa0,bf16x8 pa1,bf16x8 pa2,bf16x8 pa3){
  #pragma unroll
  for(int d0=0;d0<2;++d0){s16x4 lo[4],hi[4];
    #pragma unroll
    for(int ks=0;ks<4;++ks){
      asm volatile("ds_read_b64_tr_b16 %0,%1 offset:%c2":"=&v"(lo[ks]):"v"(vb),"i"(d0*4096+ks*1024):"memory");
      asm volatile("ds_read_b64_tr_b16 %0,%1 offset:%c2":"=&v"(hi[ks]):"v"(vb),"i"(d0*4096+ks*1024+512):"memory");}
    asm volatile("s_waitcnt lgkmcnt(0)":::"memory");SBAR();
    #define PK(k) (bf16x8){lo[k][0],lo[k][1],lo[k][2],lo[k][3],hi[k][0],hi[k][1],hi[k][2],hi[k][3]}
    o[d0]=__builtin_amdgcn_mfma_f32_32x32x16_bf16(pa0,PK(0),o[d0],0,0,0);
    o[d0]=__builtin_amdgcn_mfma_f32_32x32x16_bf16(pa1,PK(1),o[d0],0,0,0);
    o[d0]=__builtin_amdgcn_mfma_f32_32x32x16_bf16(pa2,PK(2),o[d0],0,0,0);
    o[d0]=__builtin_amdgcn_mfma_f32_32x32x16_bf16(pa3,PK(3),o[d0],0,0,0);
    #undef PK
  }
}

#ifndef ATTN_STORE16
#define ATTN_STORE16(p,v) (*(u32x4*)(p)=(v))
#endif
template<int THRL> __device__ __forceinline__ void attn_unit(int qb,const bf16*Qh,const bf16*__restrict__ Kh,const bf16*__restrict__ Vh,bf16*Oh,char*shm,const int tid_in){
  const int tid=tid_in,lane=tid&63,r32=lane&31,hi=lane>>5; const int wid=__builtin_amdgcn_readfirstlane(tid>>6);
  const int q0=qb*QB;
  const bf16*Qw=Qh+(long)(q0+wid*QBLK)*DM;
  const unsigned lds0=(unsigned)(uintptr_t)shm;
  float*wsf=(float*)(shm+LDS_WS)+wid*64;
  const bf16*ksrc=Kh+(long)lane*DM+wid*8;
  const bf16*vsrc=Vh+(long)(16*(wid&3)+(lane>>2))*DM+(wid>>2)*32+(lane&3)*8;
  const unsigned kdst=lds0+LDS_K+wid*1024, vdst=lds0+LDS_V+wid*1024;
  #define DMA_K(t,slot) glds16(ksrc+(long)(t)*KVBLK*DM,(unsigned)__builtin_amdgcn_readfirstlane(kdst+(slot)))
  #define DMA_V(t,slot) glds16(vsrc+(long)(t)*KVBLK*DM,(unsigned)__builtin_amdgcn_readfirstlane(vdst+(slot)))
  const int vb0=(int)(lds0+LDS_V)+((lane>>4)&1)*32+(lane&3)*8+(4*hi+((lane&15)>>2))*64;
  const char*Kbase=shm+LDS_K; bf16x8 kf[8];
  const lds_cptr shm3=(lds_cptr)shm; const lds_cptr kp0=shm3+LDS_K+hi*1024+r32*16; const lds_cptr vp0=shm3+LDS_V+((lane>>4)&1)*32+(lane&3)*8+(4*hi+((lane&15)>>2))*64;
  const int NT=(q0+QB)/KVBLK;
  DMA_K(0,0);DMA_V(0,0);DMA_K(1,SLOTB);
  bf16x8 qr[4];
  #pragma unroll
  for(int d0=0;d0<4;++d0)qr[d0]=*reinterpret_cast<const bf16x8*>(&Qw[(long)r32*DM+d0*16+hi*8]);
  float mhat=0.f,l_reg=0.f;f32x16 o[2];o[0]=f32x16{};o[1]=f32x16{};
  const int qrel=wid*QBLK+r32;
  #define CMASK(P0,P1,t) do{int jb_=(t)-(NT-4); if(jb_>=0)cmask(P0,P1,jb_,qrel,hi);}while(0)
  bool resc=false;
  #define START(P0,P1) do{ const float rm=rowmax(P0,P1); resc=false; \
    { const float dl=rm; mhat=fadd_s(mhat,dl); \
      _Pragma("unroll") for(int r=0;r<16;++r){P0[r]=fsub_s(P0[r],dl);P1[r]=fsub_s(P1[r],dl);} \
      } \
    _Pragma("unroll") for(int r=0;r<16;++r)P0[r]=__builtin_amdgcn_exp2f(P0[r]); }while(0)
  #define RESC() do{ if(resc){ asm volatile("s_waitcnt lgkmcnt(0)":::"memory"); \
      _Pragma("unroll") for(int d_=0;d_<2;++d_) _Pragma("unroll") for(int r=0;r<16;++r)o[d_][r]*=wsf[crow(r,hi)]; } }while(0)
  f32x16 pA0,pA1,pB0,pB1;
  int sl_prev=0,sl_cur=0,sl_next=SLOTB;
  #define ROT() do{sl_prev=sl_cur;sl_cur=sl_next;sl_next=(sl_next==(NSLOT-1)*SLOTB)?0:sl_next+SLOTB;}while(0)
  DMA_K(2,2*SLOTB);
  WAIT_BAR(3);
  qkt(pA0,pA1,Kbase,qr,r32,hi);asm volatile("s_nop 15\n\ts_nop 7":"+v"(pA0),"+v"(pA1));CMASK(pA0,pA1,0);
  START(pA0,pA1);
  _Pragma("unroll") for(int r=0;r<16;++r)pA1[r]=__builtin_amdgcn_exp2f(pA1[r]);
  WAIT_BAR(0);
  DMA_K(3,0);DMA_V(1,SLOTB);
  ROT();
  kload8(kf,kp0+sl_cur);
  WAIT_BAR(2);
  s16x4 vlo[8],vhi[8]; u32x4 pw0,pw1,pw2,pw3;
  #define PKW(P,B) cvtpk_s(P[B],P[B+1])
  #define PAF(k) __builtin_bit_cast(bf16x8,pw##k)
  #define VFR(i) (bf16x8){vlo[i][0],vlo[i][1],vlo[i][2],vlo[i][3],vhi[i][0],vhi[i][1],vhi[i][2],vhi[i][3]}
  #define PIN(x) asm volatile("":"+v"(x))
  #define MX3(a,b,c) __builtin_fmaxf(__builtin_fmaxf((a),(b)),(c))
  #define GAPA(MF,A0,A1,A2,A3,W0,W1,PW) do{ MF; sacc+=A0; sacc+=A1; sacc+=A2; sacc+=A3; PIN(sacc); W0; W1; PIN(PW); SBAR(); }while(0)
  #define EX(v) __builtin_amdgcn_exp2f(v)
  #define GAPB(MF,X,B) do{ MF; X[B]=EX(fsub_s(X[B],mhat)); X[B+1]=EX(fsub_s(X[B+1],mhat)); X[B+2]=EX(fsub_s(X[B+2],mhat)); X[B+3]=EX(fsub_s(X[B+3],mhat)); PIN(X); SBAR(); }while(0)
  #define VRD(i) do{ vlo[i]=vtr(vp_+(((i)>>2)*4096+((i)&3)*1024)); vhi[i]=vtr(vp_+(((i)>>2)*4096+((i)&3)*1024+512)); }while(0)
  #define KRD(G,j) do{ if(G){ kload2(kf,kp0+sl_next,j); SBAR(); } }while(0)
  #define STEP(C0,C1,P0,P1,t,GK,GV,GL) do{ SBAR(); \
    const lds_cptr vp_=vp0+sl_prev; \
    VRD(0); SBAR(); float sacc=(P0[0]+P0[1]); \
    GAPA(C0=mfma_z(kf[0],qr[0]), P0[2],P0[3],P0[4],P0[5],     pw0[0]=PKW(P0,0), pw0[1]=PKW(P0,2), pw0); \
    VRD(4); SBAR(); GAPA(C1=mfma_z(kf[1],qr[0]), P0[6],P0[7],P0[8],P0[9],     pw0[2]=PKW(P0,4), pw0[3]=PKW(P0,6), pw0); \
    VRD(1); SBAR(); GAPA(C0=__builtin_amdgcn_mfma_f32_32x32x16_bf16(kf[2],qr[1],C0,0,0,0),   P0[10],P0[11],P0[12],P0[13], pw1[0]=PKW(P0,8), pw1[1]=PKW(P0,10), pw1); \
    VRD(5); SBAR(); GAPA(C1=__builtin_amdgcn_mfma_f32_32x32x16_bf16(kf[3],qr[1],C1,0,0,0),   P0[14],P0[15],P1[0],P1[1],   pw1[2]=PKW(P0,12),pw1[3]=PKW(P0,14), pw1); \
    VRD(2); SBAR(); GAPA(C0=__builtin_amdgcn_mfma_f32_32x32x16_bf16(kf[4],qr[2],C0,0,0,0),   P1[2],P1[3],P1[4],P1[5],     pw2[0]=PKW(P1,0), pw2[1]=PKW(P1,2), pw2); \
    VRD(6); SBAR(); GAPA(C1=__builtin_amdgcn_mfma_f32_32x32x16_bf16(kf[5],qr[2],C1,0,0,0),   P1[6],P1[7],P1[8],P1[9],     pw2[2]=PKW(P1,4), pw2[3]=PKW(P1,6), pw2); \
    VRD(3); SBAR(); GAPA(C0=__builtin_amdgcn_mfma_f32_32x32x16_bf16(kf[6],qr[3],C0,0,0,0),   P1[10],P1[11],P1[12],P1[13], pw3[0]=PKW(P1,8), pw3[1]=PKW(P1,10), pw3); \
    VRD(7); SBAR(); GAPA(C1=__builtin_amdgcn_mfma_f32_32x32x16_bf16(kf[7],qr[3],C1,0,0,0),   P1[14],P1[15],0.f,0.f,       pw3[2]=PKW(P1,12),pw3[3]=PKW(P1,14), pw3); \
    l_reg+=sacc; \
    if(GK){DMA_K((t)+3,sl_cur);} if(GV){DMA_V((t)+1,sl_next);} \
    CMASK(C0,C1,t); \
    { float a=MX3(C0[0],C0[1],C1[0]),b=MX3(C0[2],C0[3],C1[1]); a=MX3(a,C1[2],C1[3]); \
      _Pragma("unroll") for(int r=4;r<16;r+=4){a=MX3(a,C0[r],C0[r+1]);b=MX3(b,C0[r+2],C0[r+3]);a=MX3(a,C1[r],C1[r+1]);b=MX3(b,C1[r+2],C1[r+3]);} \
      float rm=__builtin_fmaxf(a,b); { auto rr=__builtin_amdgcn_permlane32_swap(__float_as_uint(rm),__float_as_uint(rm),false,false); rm=__builtin_fmaxf(__uint_as_float(rr[0]),__uint_as_float(rr[1])); } \
      resc=false; \
      const float rel=rm-mhat; \
      if(__builtin_expect(__any(rel>(float)THRL),0)){ const float dl=__builtin_fmaxf(rel,0.f); mhat+=dl; \
        const float f=__builtin_amdgcn_exp2f(-dl); l_reg*=f; if(hi==0)wsf[r32]=f; resc=true; } } \
    SBAR(); \
    GAPB(o[0]=__builtin_amdgcn_mfma_f32_32x32x16_bf16(PAF(0),VFR(0),o[0],0,0,0), C0,0); \
    GAPB(o[1]=__builtin_amdgcn_mfma_f32_32x32x16_bf16(PAF(0),VFR(4),o[1],0,0,0), C0,4); \
    KRD(GL,0); GAPB(o[0]=__builtin_amdgcn_mfma_f32_32x32x16_bf16(PAF(1),VFR(1),o[0],0,0,0), C0,8); \
    KRD(GL,1); GAPB(o[1]=__builtin_amdgcn_mfma_f32_32x32x16_bf16(PAF(1),VFR(5),o[1],0,0,0), C0,12); \
    KRD(GL,2); GAPB(o[0]=__builtin_amdgcn_mfma_f32_32x32x16_bf16(PAF(2),VFR(2),o[0],0,0,0), C1,0); \
    KRD(GL,3); GAPB(o[1]=__builtin_amdgcn_mfma_f32_32x32x16_bf16(PAF(2),VFR(6),o[1],0,0,0), C1,4); \
    GAPB(o[0]=__builtin_amdgcn_mfma_f32_32x32x16_bf16(PAF(3),VFR(3),o[0],0,0,0), C1,8); \
    GAPB(o[1]=__builtin_amdgcn_mfma_f32_32x32x16_bf16(PAF(3),VFR(7),o[1],0,0,0), C1,12); \
    }while(0)
  int t=1;
  #undef CMASK
  #define CMASK(P0,P1,t) do{}while(0)
  for(;t+5<NT;t+=2){
    STEP(pB0,pB1,pA0,pA1,t,true,true,true);     WAIT_BAR(2); RESC(); ROT();
    STEP(pA0,pA1,pB0,pB1,t+1,true,true,true);   WAIT_BAR(2); RESC(); ROT();
  }
  #undef CMASK
  #define CMASK(P0,P1,t) do{int jb_=(t)-(NT-4); if(jb_>=0)cmask(P0,P1,jb_,qrel,hi);}while(0)
  #define ENDW(tt) do{ if((tt)+3<NT){WAIT_BAR(2);} else if((tt)+2<NT){WAIT_BAR(1);} else {WAIT_BAR(0);} }while(0)
  for(;t+1<NT;t+=2){
    STEP(pB0,pB1,pA0,pA1,t,(t+3<NT),(t+1<NT),(t+1<NT));       ENDW(t);   RESC(); ROT();
    STEP(pA0,pA1,pB0,pB1,t+1,(t+4<NT),(t+2<NT),(t+2<NT));     ENDW(t+1); RESC(); ROT();
  }
  STEP(pB0,pB1,pA0,pA1,NT-1,false,false,false); RESC();
  { float sacc=pB0[0]+pB0[1]; _Pragma("unroll") for(int r=2;r<16;++r)sacc+=pB0[r]; _Pragma("unroll") for(int r=0;r<16;++r)sacc+=pB1[r]; l_reg+=sacc;
    pw0=(u32x4){PKW(pB0,0),PKW(pB0,2),PKW(pB0,4),PKW(pB0,6)};pw1=(u32x4){PKW(pB0,8),PKW(pB0,10),PKW(pB0,12),PKW(pB0,14)};pw2=(u32x4){PKW(pB1,0),PKW(pB1,2),PKW(pB1,4),PKW(pB1,6)};pw3=(u32x4){PKW(pB1,8),PKW(pB1,10),PKW(pB1,12),PKW(pB1,14)};
    SBAR(); pv(o,vb0+sl_cur,PAF(0),PAF(1),PAF(2),PAF(3)); }
  #undef PKW
  #undef PAF
  #undef VFR
  #undef PIN
  #undef MX3
  #undef GAPA
  #undef GAPB
  #undef EX
  #undef VRD
  #undef KRD
  #undef STEP
  #undef ENDW
  l_reg+=__uint_as_float((unsigned)__builtin_amdgcn_ds_bpermute((lane^32)<<2,(int)__float_as_uint(l_reg)));
  if(hi==0)wsf[32+r32]=l_reg;asm volatile("s_waitcnt lgkmcnt(0)":::"memory");
  float rli[16];
  #pragma unroll
  for(int r=0;r<16;++r)rli[r]=__builtin_amdgcn_rcpf(wsf[32+crow(r,hi)]);
  bf16*Ow=Oh+(long)(q0+wid*QBLK)*OPITCH;
  { bf16*stg=(bf16*)(shm+LDS_OST)+wid*2048;
    #pragma unroll
    for(int r=0;r<16;++r){const int orow=crow(r,hi);
      #pragma unroll
      for(int d0=0;d0<2;++d0)stg[orow*64+d0*32+r32]=__float2bfloat16(o[d0][r]*rli[r]);}
    asm volatile("s_waitcnt lgkmcnt(0)":::"memory");
    #pragma unroll
    for(int i=0;i<4;++i){const int row=i*8+(lane>>3),ch=lane&7; const u32x4 v=*(const u32x4*)(stg+row*64+ch*8); ATTN_STORE16(Ow+(long)row*OPITCH+ch*8,v);} }
  asm volatile("s_waitcnt lgkmcnt(0)\n\ts_barrier":::"memory");
  #undef DMA_K
  #undef DMA_V
  #undef CMASK
  #undef START
  #undef RESC
  #undef ROT
}

__device__ __forceinline__ float rowmax_cv(const f32x16&p0,const f32x16&p1){
  float a=__builtin_fmaxf(p0[0],p1[0]);
  #pragma unroll
  for(int r=1;r<16;++r){a=__builtin_fmaxf(a,p0[r]);a=__builtin_fmaxf(a,p1[r]);}
  auto rr=__builtin_amdgcn_permlane32_swap(__float_as_uint(a),__float_as_uint(a),false,false);
  return __builtin_fmaxf(__uint_as_float(rr[0]),__uint_as_float(rr[1]));
}
__device__ __forceinline__ void attn_unit_simple(int qb,const bf16*Qh,const bf16*__restrict__ Kh,const bf16*__restrict__ Vh,bf16*Oh,char*shm,const int tid_in){
  const int tid=tid_in,lane=tid&63,r32=lane&31,hi=lane>>5; const int wid=__builtin_amdgcn_readfirstlane(tid>>6);
  const int q0=qb*QB;
  const bf16*Qw=Qh+(long)(q0+wid*QBLK)*DM;
  const unsigned lds0=(unsigned)(uintptr_t)shm;
  float*wsf=(float*)(shm+LDS_WS)+wid*64;
  const bf16*ksrc=Kh+(long)lane*DM+wid*8;
  const bf16*vsrc=Vh+(long)(16*(wid&3)+(lane>>2))*DM+(wid>>2)*32+(lane&3)*8;
  u32x4*kdstp=(u32x4*)(shm+LDS_K+wid*1024+lane*16); u32x4*vdstp=(u32x4*)(shm+LDS_V+wid*1024+lane*16);
  const int vb0=(int)(lds0+LDS_V)+((lane>>4)&1)*32+(lane&3)*8+(4*hi+((lane&15)>>2))*64;
  const char*Kbase=shm+LDS_K;
  const int NT=(q0+QB)/KVBLK;
  bf16x8 qr[4];
  #pragma unroll
  for(int d0=0;d0<4;++d0)qr[d0]=*reinterpret_cast<const bf16x8*>(&Qw[(long)r32*DM+d0*16+hi*8]);
  float m_run=-1e30f,l_reg=0.f; f32x16 o[2]; o[0]=f32x16{}; o[1]=f32x16{};
  const int qrel=wid*QBLK+r32;
  u32x4 kreg=*(const u32x4*)ksrc, vreg=*(const u32x4*)vsrc;
  for(int t=0;t<NT;++t){
    *kdstp=kreg; *vdstp=vreg;
    if(t+1<NT){ kreg=*(const u32x4*)(ksrc+(long)(t+1)*KVBLK*DM); vreg=*(const u32x4*)(vsrc+(long)(t+1)*KVBLK*DM); }
    __syncthreads();
    f32x16 p0,p1;
    qkt(p0,p1,Kbase,qr,r32,hi);
    { const int jb=t-(NT-4); if(jb>=0){ const float NEG=-INFINITY; const int kb=64*jb+4*hi;
        #pragma unroll
        for(int r=0;r<16;++r){const int kv=kb+(r&3)+8*(r>>2); if(kv>qrel)p0[r]=NEG; if(kv+32>qrel)p1[r]=NEG;} } }
    const float rm=rowmax_cv(p0,p1);
    const float mn=__builtin_fmaxf(m_run,rm); const float alpha=__builtin_amdgcn_exp2f(m_run-mn); m_run=mn;
    float sacc=0.f;
    #pragma unroll
    for(int r=0;r<16;++r){p0[r]=__builtin_amdgcn_exp2f(p0[r]-mn);p1[r]=__builtin_amdgcn_exp2f(p1[r]-mn);sacc+=p0[r]+p1[r];}
    l_reg=l_reg*alpha+sacc;
    if(hi==0)wsf[r32]=alpha;
    asm volatile("s_waitcnt lgkmcnt(0)":::"memory");
    #pragma unroll
    for(int d_=0;d_<2;++d_)
      #pragma unroll
      for(int r=0;r<16;++r)o[d_][r]*=wsf[crow(r,hi)];
    u32x4 pw0,pw1,pw2,pw3;
    #define PKW2(P,B) cvtpk_s(P[B],P[B+1])
    pw0=(u32x4){PKW2(p0,0),PKW2(p0,2),PKW2(p0,4),PKW2(p0,6)};pw1=(u32x4){PKW2(p0,8),PKW2(p0,10),PKW2(p0,12),PKW2(p0,14)};
    pw2=(u32x4){PKW2(p1,0),PKW2(p1,2),PKW2(p1,4),PKW2(p1,6)};pw3=(u32x4){PKW2(p1,8),PKW2(p1,10),PKW2(p1,12),PKW2(p1,14)};
    #undef PKW2
    pv(o,vb0,__builtin_bit_cast(bf16x8,pw0),__builtin_bit_cast(bf16x8,pw1),__builtin_bit_cast(bf16x8,pw2),__builtin_bit_cast(bf16x8,pw3));
    asm volatile("s_waitcnt lgkmcnt(0)":::"memory");
    __syncthreads();
  }
  l_reg+=__uint_as_float((unsigned)__builtin_amdgcn_ds_bpermute((lane^32)<<2,(int)__float_as_uint(l_reg)));
  if(hi==0)wsf[32+r32]=l_reg;asm volatile("s_waitcnt lgkmcnt(0)":::"memory");
  float rli[16];
  #pragma unroll
  for(int r=0;r<16;++r)rli[r]=__builtin_amdgcn_rcpf(wsf[32+crow(r,hi)]);
  bf16*Ow=Oh+(long)(q0+wid*QBLK)*OPITCH;
  { bf16*stg=(bf16*)(shm+LDS_OST)+wid*2048;
    #pragma unroll
    for(int r=0;r<16;++r){const int orow=crow(r,hi);
      #pragma unroll
      for(int d0=0;d0<2;++d0)stg[orow*64+d0*32+r32]=__float2bfloat16(o[d0][r]*rli[r]);}
    asm volatile("s_waitcnt lgkmcnt(0)":::"memory");
    #pragma unroll
    for(int i=0;i<4;++i){const int row=i*8+(lane>>3),ch=lane&7; const u32x4 v=*(const u32x4*)(stg+row*64+ch*8); ATTN_STORE16(Ow+(long)row*OPITCH+ch*8,v);} }
  asm volatile("s_waitcnt vmcnt(0) lgkmcnt(0)":::"memory");
  __syncthreads();
}
constexpr int ATTN_LDS_BYTES=LDS_BYTES;
#undef SBAR
#undef WAIT_BAR
}

#define GAS __attribute__((address_space(1)))
#define LAS __attribute__((address_space(3)))
typedef unsigned short bf16;
typedef unsigned v4u __attribute__((ext_vector_type(4)));
typedef float f32x4 __attribute__((ext_vector_type(4)));
typedef short bf16x8 __attribute__((ext_vector_type(8)));
typedef GAS unsigned gu32;
typedef GAS unsigned long long gu64;
#define RLX_AGENT __ATOMIC_RELAXED, __HIP_MEMORY_SCOPE_AGENT
#define LDS_WAIT() asm volatile("s_waitcnt lgkmcnt(0)" ::: "memory")
#define VM_WAIT() asm volatile("s_waitcnt vmcnt(0)" ::: "memory")
__device__ __forceinline__ unsigned long long rt() { return __builtin_amdgcn_s_memrealtime(); }
__device__ __forceinline__ unsigned f2bf(float f) { unsigned u = __builtin_bit_cast(unsigned, f); return (u + 0x7fffu + ((u >> 16) & 1u)) >> 16; }
__device__ __forceinline__ unsigned pk2(float lo, float hi) { return f2bf(lo) | (f2bf(hi) << 16); }

#define XB_TMO      128
#define XB_XCNT(j)  (256  + 64 * (j))
#define XB_XSUB(j)  (1280 + 64 * (j))
#define XB_XGEN(j)  (2304 + 64 * (j))
#define XB_TOP      3328
#define XB_TOPGEN   3392
#define XCD_BAR_WORDS 3456
#define XB_SPIN_CAP (1u << 26)

__device__ __forceinline__ unsigned xb_ld(unsigned* p)              { return __hip_atomic_load(p, __ATOMIC_RELAXED, __HIP_MEMORY_SCOPE_AGENT); }
__device__ __forceinline__ unsigned xb_add(unsigned* p, unsigned v) { return __hip_atomic_fetch_add(p, v, __ATOMIC_RELAXED, __HIP_MEMORY_SCOPE_AGENT); }
__device__ __forceinline__ unsigned xb_xcc_id() { return (unsigned)__builtin_amdgcn_s_getreg((3 << 11) | 20) & 0xFu; }
#define XB_SPIN(cond, bar) do { unsigned _sp = 0; while (cond) { __builtin_amdgcn_s_sleep(1); \
    if ((++_sp & 255u) == 0u) { if (xb_ld(&(bar)[XB_TMO])) break; if (_sp > XB_SPIN_CAP) { atomicAdd(&(bar)[XB_TMO], 1u); break; } } } } while (0)

struct XcdBarrier {
    unsigned* bar; unsigned x;
    volatile LAS unsigned* st;
};

__device__ __forceinline__ XcdBarrier xcd_barrier_post(unsigned* bar, volatile LAS unsigned* st, const int tid) {
    XcdBarrier b; b.bar = bar; b.x = xb_xcc_id(); b.st = st;
    if (tid == 0) (void)xb_add(&bar[XB_XCNT(b.x)], 1u);
    return b;
}
__device__ __forceinline__ void xcd_barrier_complete(unsigned* bar, unsigned x, unsigned& nloc, unsigned& nx) {
    const unsigned G = gridDim.x * gridDim.y * gridDim.z;
    unsigned sum, cnt, mine, sp = 0u;
    for (;;) {
        sum = 0u; cnt = 0u; mine = 0u;
#pragma unroll
        for (unsigned j = 0; j < 16; ++j) { const unsigned c = xb_ld(&bar[XB_XCNT(j)]); sum += c; cnt += (c > 0u) ? 1u : 0u; mine = (j == x) ? c : mine; }
        if (sum == G) break;
        __builtin_amdgcn_s_sleep(1);
        if ((++sp & 255u) == 0u) { if (xb_ld(&bar[XB_TMO])) break; if (sp > XB_SPIN_CAP) { atomicAdd(&bar[XB_TMO], 1u); break; } }
    }
    nloc = mine > 0u ? mine : 1u; nx = cnt > 0u ? cnt : 1u;
}

__device__ __forceinline__ void xcd_barrier(const XcdBarrier& b, const int tid) {
    asm volatile("s_waitcnt vmcnt(0)" ::: "memory");
    __syncthreads();
    if (tid == 0) {
        unsigned* bar = b.bar;
        __builtin_amdgcn_s_waitcnt(0);
        unsigned nloc = b.st[0], nx = b.st[1];
        if (nloc == 0u) { xcd_barrier_complete(bar, b.x, nloc, nx); b.st[0] = nloc; b.st[1] = nx; }
        const unsigned old = xb_add(&bar[XB_XSUB(b.x)], 1u);
        const unsigned gen = old / nloc;
        if (old + 1u == (gen + 1u) * nloc) {
            __builtin_amdgcn_fence(__ATOMIC_RELEASE, "agent");
            asm volatile("s_waitcnt vmcnt(0)" ::: "memory");
            const unsigned og = xb_add(&bar[XB_TOP], 1u);
            const unsigned tg = og / nx;
            if (og + 1u == (tg + 1u) * nx) xb_add(&bar[XB_TOPGEN], 1u);
            else XB_SPIN(xb_ld(&bar[XB_TOPGEN]) == tg, bar);
            __builtin_amdgcn_fence(__ATOMIC_ACQUIRE, "agent");
            xb_add(&bar[XB_XGEN(b.x)], 1u);
            asm volatile("s_waitcnt vmcnt(0)" ::: "memory");
        } else {
            XB_SPIN(xb_ld(&bar[XB_XGEN(b.x)]) == gen, bar);
            __builtin_amdgcn_fence(__ATOMIC_ACQUIRE, "agent");
            asm volatile("s_waitcnt vmcnt(0)" ::: "memory");
        }
    }
    __syncthreads();
}

constexpr int NWAVES = 8;
constexpr int NTOK = 65536, NH = 32768, DMODEL = 1024, SEQLEN = 4096, INCOLS = 5632, DFF = 2816, NEXP = 8;
constexpr int MOE_PANELS_MAX = 264;
constexpr float EPS_NORM = 1e-6f, EPS_SUBLN = 1e-5f;

constexpr size_t MiB = 1u << 20;
constexpr size_t WS_CTL = 0, CTL_ZERO_BYTES = 1 * MiB;
constexpr size_t WS_WIN = 1 * MiB;
constexpr size_t WS_WGLU = 23 * MiB;
constexpr size_t WS_WPS = 24 * MiB;
constexpr size_t WS_WPA = 26 * MiB;
constexpr size_t WS_WOUT = 30 * MiB;
constexpr size_t WS_WDGU = 34 * MiB;
constexpr size_t WS_WDD = 45 * MiB;
constexpr size_t WS_WMGU = 51 * MiB;
constexpr size_t WS_WMD = 139 * MiB;
constexpr size_t WS_TZF = 183 * MiB;
constexpr size_t WS_EM = 223 * MiB;
constexpr size_t WS_ROPE = 239 * MiB;
constexpr size_t WS_ROUTE = 255 * MiB;
constexpr size_t WS_ACT = 260 * MiB;
constexpr size_t WS_END = 960 * MiB;
constexpr size_t A_HB = 0, A_UBUF = 64 * MiB, A_SLOC = 104 * MiB, A_Q = 120 * MiB, A_K = 184 * MiB, A_V = 248 * MiB, A_SGS = 312 * MiB, A_SGA = 376 * MiB, A_YA = 440 * MiB, A_YA2 = 472 * MiB, A_OV = 504 * MiB, A_YB = 632 * MiB;
constexpr size_t A_H2 = 0, A_FA = 64 * MiB;
constexpr size_t A_H2G = 64 * MiB, A_AG = 196 * MiB, A_YG = 559 * MiB;
static_assert(A_UBUF == pg8::EA_U && A_Q == pg8::EA_Q && A_K == pg8::EA_K && A_V == pg8::EA_V && A_SGS == pg8::EA_SGS && A_SGA == pg8::EA_SGA, "EpiIn offsets");
static_assert(A_YB + 64 * MiB <= WS_END - WS_ACT && A_OV + 128 * MiB <= WS_END - WS_ACT && A_YG + 132 * MiB <= WS_END - WS_ACT, "act map");
constexpr size_t R_E = 0, R_W = 256 * 1024, R_S = 512 * 1024, R_CNT = 768 * 1024;
constexpr int CW_BAR = 4096;

constexpr int RING_OFF = 0, RING_BYTES = 131072;
constexpr int LDSCTL_OFF = RING_BYTES, MISC_OFF = LDSCTL_OFF + 320;
constexpr int LDS_BYTES = 147456;

constexpr int PTR_OFF = LDSCTL_OFF + 1024;
struct Args { const void* in[31]; float* out; unsigned char* ws; };
__device__ __forceinline__ unsigned long long ldp64(LAS unsigned char* L, int slot) {
    const unsigned long long v = ((volatile LAS unsigned long long*)(L + PTR_OFF))[slot];
    const unsigned lo = __builtin_amdgcn_readfirstlane((unsigned)v), hi = __builtin_amdgcn_readfirstlane((unsigned)(v >> 32));
    return ((unsigned long long)hi << 32) | lo;
}
#define LDP(T, slot) ((T*)(GAS T*)(uintptr_t)ldp64(L, (slot)))

#define SWZ_XOR(k) (((k) << 10) | 0x1f)
#define swz_xor(v, pat) __builtin_bit_cast(float, __builtin_amdgcn_ds_swizzle(__builtin_bit_cast(int, (float)(v)), (pat)))
__device__ __forceinline__ float wave_sum(float v) {
    v += swz_xor(v, SWZ_XOR(1)); v += swz_xor(v, SWZ_XOR(2)); v += swz_xor(v, SWZ_XOR(4)); v += swz_xor(v, SWZ_XOR(8)); v += swz_xor(v, SWZ_XOR(16));
    const float lo = __builtin_bit_cast(float, __builtin_amdgcn_readlane(__builtin_bit_cast(int, v), 0));
    const float hi = __builtin_bit_cast(float, __builtin_amdgcn_readlane(__builtin_bit_cast(int, v), 32));
    return lo + hi;
}
__device__ __forceinline__ void tr_item(const float* W, int ldw, int K, bf16* WTn0, int k0, int srccol, LAS float* scr, int lane) {
#pragma unroll 8
    for (int i = 0; i < 32; ++i) { const int kk = 2 * i + (lane >> 5); scr[kk * 33 + (lane & 31)] = W[(size_t)(k0 + kk) * ldw + srccol]; }
    LDS_WAIT(); asm volatile("" ::: "memory");
    const int c = lane & 7;
#pragma unroll
    for (int j = 0; j < 4; ++j) { const int n = (lane >> 3) + 8 * j; const LAS float* s = scr + (8 * c) * 33 + n;
        v4u o; o.x = pk2(s[0 * 33], s[1 * 33]); o.y = pk2(s[2 * 33], s[3 * 33]); o.z = pk2(s[4 * 33], s[5 * 33]); o.w = pk2(s[6 * 33], s[7 * 33]);
        *(GAS v4u*)(WTn0 + (size_t)n * K + k0 + 8 * c) = o; }
    LDS_WAIT(); asm volatile("" ::: "memory");
}
__device__ __forceinline__ int win_orig(int n) { if (n < 512 || n >= 2560) return n; const int i = n & 63; return (n & ~63) + 16 * ((i >> 5) & 1) + 4 * ((i >> 3) & 3) + (i & 3) + 32 * ((i >> 2) & 1); }
__device__ __forceinline__ void tr_plain(const float* W, int K, int N, bf16* WT, int item, LAS float* scr, int lane) {
    const int nblk = N / 32, kb = item / nblk, nb = item % nblk;
    tr_item(W, N, K, WT + (size_t)(32 * nb) * K, 64 * kb, 32 * nb + (lane & 31), scr, lane);
}
__device__ __forceinline__ void tr_win(const float* W, bf16* WT, int item, LAS float* scr, int lane) {
    const int nblk = INCOLS / 32, kb = item / nblk, nb = item % nblk;
    tr_item(W, INCOLS, DMODEL, WT + (size_t)(32 * nb) * DMODEL, 64 * kb, win_orig(32 * nb + (lane & 31)), scr, lane);
}
__device__ __forceinline__ void tr_gu(const float* Wg, const float* Wu, bf16* WT, int item, LAS float* scr, int lane) {
    const int nblk = INCOLS / 32, kb = item / nblk, nb = item % nblk; const int n0 = 32 * nb, pn = n0 >> 8, r = n0 & 255;
    const float* W = r < 128 ? Wg : Wu; const int col = pn * 128 + (r & 127) + (lane & 31);
    tr_item(W, DFF, DMODEL, WT + (size_t)n0 * DMODEL, 64 * kb, col, scr, lane);
}
struct S5In { const float *lam_re, *lam_im, *log_dt, *b_re, *b_im, *c_re, *c_im, *dd; };
__device__ __forceinline__ v4u pack8f(const float* v) { v4u o; o.x = pk2(v[0], v[1]); o.y = pk2(v[2], v[3]); o.z = pk2(v[4], v[5]); o.w = pk2(v[6], v[7]); return o; }
__device__ __forceinline__ void s5_item(LAS unsigned char* L, int tid, const S5In& P, int lg, int d, bf16* TZF, bf16* EM) {
    LAS float* sm = (LAS float*)(L);
    LAS float *s_fr = sm, *s_fi = sm + 64, *s_apr = sm + 128, *s_api = sm + 192, *BBr = sm + 256, *BBi = sm + 1280, *CAr = sm + 2304, *CAi = sm + 3328, *Kd = sm + 4352;
    if (tid < 64) {
        const int p = tid;
        const float dt = expf(P.log_dt[lg]);
        const float lr = P.lam_re[lg * 64 + p], li = P.lam_im[lg * 64 + p];
        const float mag = expf(lr * dt); float sn, cs; sincosf(li * dt, &sn, &cs);
        const float ar = mag * cs, ai = mag * sn;
        const float den = lr * lr + li * li, nr = ar - 1.0f, ni = ai;
        s_fr[p] = (nr * lr + ni * li) / den; s_fi[p] = (ni * lr - nr * li) / den;
        const float fd = (float)d; const float magd = expf(fd * lr * dt); float snd, csd; sincosf(fd * li * dt, &snd, &csd);
        s_apr[p] = magd * csd; s_api[p] = magd * snd;
    }
    __syncthreads();
    for (int idx = tid; idx < 1024; idx += 512) {
        { const int p = idx >> 4; const float br = P.b_re[(size_t)lg * 1024 + idx], bi = P.b_im[(size_t)lg * 1024 + idx]; const float fr_ = s_fr[p], fi_ = s_fi[p];
          BBr[idx] = fr_ * br - fi_ * bi; BBi[idx] = fr_ * bi + fi_ * br; }
        { const int p = idx & 63; const float cr = P.c_re[(size_t)lg * 1024 + idx], ci = P.c_im[(size_t)lg * 1024 + idx]; const float ar_ = s_apr[p], ai_ = s_api[p];
          CAr[idx] = cr * ar_ - ci * ai_; CAi[idx] = cr * ai_ + ci * ar_; }
    }
    __syncthreads();
    if (d <= 31 && tid < 256) { const int j = tid >> 4, jp = tid & 15; float acc = 0.f;
        for (int p = 0; p < 64; ++p) acc += CAr[j * 64 + p] * BBr[p * 16 + jp] - CAi[j * 64 + p] * BBi[p * 16 + jp];
        if (d == 0 && j == jp) acc += P.dd[lg * 16 + j];
        Kd[tid] = acc; }
    __syncthreads();
    bf16* TZ = TZF + (size_t)lg * 512 * 640; bf16* EE = EM + (size_t)lg * 256 * 512;
    if (d <= 31) {
        const int cnt = (32 - d) * 16;
        for (int idx = tid; idx < cnt; idx += 512) { const int tt = idx >> 4, j = idx & 15; float v[16];
#pragma unroll
            for (int q = 0; q < 16; ++q) v[q] = Kd[j * 16 + q];
            bf16* dst = TZ + (size_t)((d + tt) * 16 + j) * 640 + tt * 16;
            *(GAS v4u*)dst = pack8f(v); *(GAS v4u*)(dst + 8) = pack8f(v + 8);
            if (d >= 1) { bf16* dz = TZ + (size_t)(tt * 16 + j) * 640 + (d + tt) * 16; const v4u z = {0u, 0u, 0u, 0u}; *(GAS v4u*)dz = z; *(GAS v4u*)(dz + 8) = z; } }
        if (tid < 128) { const int ri = tid >> 6, p = tid & 63; const float ar_ = s_apr[p], ai_ = s_api[p]; float v[16];
#pragma unroll
            for (int q = 0; q < 16; ++q) { const float br = BBr[p * 16 + q], bi = BBi[p * 16 + q]; v[q] = ri == 0 ? (ar_ * br - ai_ * bi) : (ar_ * bi + ai_ * br); }
            bf16* dst = EE + (size_t)tid * 512 + (31 - d) * 16; *(GAS v4u*)dst = pack8f(v); *(GAS v4u*)(dst + 8) = pack8f(v + 8);
        } else if (tid < 256) { bf16* dz = EE + (size_t)tid * 512 + (31 - d) * 16; const v4u z = {0u, 0u, 0u, 0u}; *(GAS v4u*)dz = z; *(GAS v4u*)(dz + 8) = z; }
    }
    if (d >= 1 && tid < 256) { const int j = tid >> 4, ri = (tid >> 3) & 1, pc = tid & 7; float v[8];
#pragma unroll
        for (int q = 0; q < 8; ++q) v[q] = ri == 0 ? CAr[j * 64 + pc * 8 + q] : -CAi[j * 64 + pc * 8 + q];
        *(GAS v4u*)(TZ + (size_t)((d - 1) * 16 + j) * 640 + 512 + ri * 64 + pc * 8) = pack8f(v); }
    __syncthreads();
}
__device__ __forceinline__ void norm_row(const float* xrow, const float* gain, bf16* orow, int lane, f32x4 (&hn)[4]) {
    const GAS f32x4* xr = (const GAS f32x4*)xrow + lane; const GAS f32x4* gr = (const GAS f32x4*)gain + lane;
    float s2 = 0.f;
#pragma unroll
    for (int j = 0; j < 4; ++j) { hn[j] = xr[64 * j]; s2 += (hn[j].x * hn[j].x + hn[j].y * hn[j].y) + (hn[j].z * hn[j].z + hn[j].w * hn[j].w); }
    const float rs = 1.0f / sqrtf(wave_sum(s2) * (1.0f / DMODEL) + EPS_NORM);
    GAS unsigned long long* o8 = (GAS unsigned long long*)orow + lane;
#pragma unroll
    for (int j = 0; j < 4; ++j) { const f32x4 g = gr[64 * j]; hn[j] = hn[j] * rs * g;
        o8[64 * j] = (unsigned long long)pk2(hn[j].x, hn[j].y) | ((unsigned long long)pk2(hn[j].z, hn[j].w) << 32); }
}

__global__ void __launch_bounds__(NWAVES * 64, 2) trunk_fwd(Args args) {
    extern __shared__ __attribute__((aligned(16))) unsigned char lds[];
    const int WAVE = __builtin_amdgcn_readfirstlane((int)threadIdx.x >> 6);
#define MYTID() ({ int l_; asm volatile("v_mbcnt_lo_u32_b32 %0, -1, 0\n\tv_mbcnt_hi_u32_b32 %0, -1, %0" : "=v"(l_)); WAVE * 64 + l_; })
    LAS unsigned char* const L0 = (LAS unsigned char*)lds;
#define OPQ LAS unsigned char* L = L0; asm volatile("" : "+s"(L))
    OPQ;
    {
        const int tid0 = MYTID();
        for (int u = tid0; u < (LDS_BYTES - LDSCTL_OFF) / 4; u += NWAVES * 64) ((LAS unsigned*)(L + LDSCTL_OFF))[u] = 0u;
        __syncthreads();
        if (tid0 == 0) {
#pragma unroll
            for (int k = 0; k < 31; ++k) ((LAS unsigned long long*)(L + PTR_OFF))[k] = (unsigned long long)(uintptr_t)args.in[k];
            ((LAS unsigned long long*)(L + PTR_OFF))[31] = (unsigned long long)(uintptr_t)args.out;
            ((LAS unsigned long long*)(L + PTR_OFF))[32] = (unsigned long long)(uintptr_t)args.ws; }
        __syncthreads();
    }
    { XcdBarrier b0 = xcd_barrier_post((unsigned*)(LDP(unsigned char, 32) + WS_CTL) + CW_BAR, (volatile LAS unsigned*)(L + MISC_OFF) + 8, MYTID()); (void)b0; }
#define GRID_BAR() do { OPQ; XcdBarrier b_; b_.bar = (unsigned*)(LDP(unsigned char, 32) + WS_CTL) + CW_BAR; b_.x = xb_xcc_id(); b_.st = (volatile LAS unsigned*)(L + MISC_OFF) + 8; xcd_barrier(b_, MYTID()); } while (0)
#define LQ() ({ int l_ = l; asm volatile("" : "+s"(l_)); l_; })
#define TID_SETUP OPQ; int wave_ = WAVE; asm volatile("" : "+s"(wave_)); const int wave = wave_; const int tid = MYTID(), lane = tid & 63; const int G = gridDim.x; const int vcu = ((int)blockIdx.x % 8) * (G / 8) + (int)blockIdx.x / 8; const int gw = vcu * NWAVES + wave, NGW = G * NWAVES; (void)lane; (void)gw; (void)NGW; (void)tid
#define WSP(T, off) ((T*)(LDP(unsigned char, 32) + (off)))
#define ACTP(T, off) ((T*)(LDP(unsigned char, 32) + WS_ACT + (off)))

    {
        TID_SETUP;
        LAS float* scr = (LAS float*)(L + RING_OFF + wave * 16384);
        constexpr int I_WIN = 16 * 176, I_GLU = 8 * 16, I_PS = 8 * 32, I_PA = 16 * 32, I_OUT = 16 * 32, I_GU = 16 * 176, I_DN = 44 * 32;
        constexpr int I_LAYER = I_WIN + I_GLU + I_PS + I_PA + I_OUT;
        constexpr int NITEMS = 2 * I_LAYER + I_GU + I_DN + 8 * I_GU + 8 * I_DN;
        for (int it = gw; it < NITEMS; it += NGW) {
            int r = it;
            if (r < 2 * I_LAYER) { const int l = r / I_LAYER; r -= l * I_LAYER;
                if (r < I_WIN) { tr_win(LDP(const float, 3) + (size_t)l * DMODEL * INCOLS, WSP(bf16, WS_WIN) + (size_t)l * INCOLS * DMODEL, r, scr, lane); continue; } r -= I_WIN;
                if (r < I_GLU) { tr_plain(LDP(const float, 12) + (size_t)l * 512 * 512, 512, 512, WSP(bf16, WS_WGLU) + (size_t)l * 512 * 512, r, scr, lane); continue; } r -= I_GLU;
                if (r < I_PS) { tr_plain(LDP(const float, 19) + (size_t)l * 512 * 1024, 512, 1024, WSP(bf16, WS_WPS) + (size_t)l * 1024 * 512, r, scr, lane); continue; } r -= I_PS;
                if (r < I_PA) { tr_plain(LDP(const float, 20) + (size_t)l * 1024 * 1024, 1024, 1024, WSP(bf16, WS_WPA) + (size_t)l * 1024 * 1024, r, scr, lane); continue; } r -= I_PA;
                tr_plain(LDP(const float, 21) + (size_t)l * 1024 * 1024, 1024, 1024, WSP(bf16, WS_WOUT) + (size_t)l * 1024 * 1024, r, scr, lane); continue; }
            r -= 2 * I_LAYER;
            if (r < I_GU) { tr_gu(LDP(const float, 23), LDP(const float, 24), WSP(bf16, WS_WDGU), r, scr, lane); continue; } r -= I_GU;
            if (r < I_DN) { tr_plain(LDP(const float, 25), DFF, DMODEL, WSP(bf16, WS_WDD), r, scr, lane); continue; } r -= I_DN;
            if (r < 8 * I_GU) { const int e = r / I_GU; r -= e * I_GU; tr_gu(LDP(const float, 27) + (size_t)e * DMODEL * DFF, LDP(const float, 28) + (size_t)e * DMODEL * DFF, WSP(bf16, WS_WMGU) + (size_t)e * INCOLS * DMODEL, r, scr, lane); continue; } r -= 8 * I_GU;
            { const int e = r / I_DN; r -= e * I_DN; tr_plain(LDP(const float, 29) + (size_t)e * DFF * DMODEL, DFF, DMODEL, WSP(bf16, WS_WMD) + (size_t)e * DMODEL * DFF, r, scr, lane); }
        }
        __syncthreads();
        { S5In s5p; s5p.lam_re = LDP(const float, 4); s5p.lam_im = LDP(const float, 5); s5p.log_dt = LDP(const float, 6); s5p.b_re = LDP(const float, 7); s5p.b_im = LDP(const float, 8);
          s5p.c_re = LDP(const float, 9); s5p.c_im = LDP(const float, 10); s5p.dd = LDP(const float, 11);
          for (int it = vcu; it < 2 * 32 * 33; it += G) s5_item(L, tid, s5p, it / 33, it % 33, WSP(bf16, WS_TZF), WSP(bf16, WS_EM)); }
        { const int* positions = LDP(const int, 1); float* ROPE = WSP(float, WS_ROPE);
          for (int idx = vcu * (NWAVES * 64) + tid; idx < NTOK * 32; idx += G * NWAVES * 64) { const int n = idx >> 5, fi = idx & 31;
            const float invf = powf(10000.0f, -(float)(2 * fi) / 64.0f); const float ang = (float)positions[n] * invf; float sn, cs; sincosf(ang, &sn, &cs);
            ROPE[(size_t)n * 64 + fi] = cs; ROPE[(size_t)n * 64 + 32 + fi] = sn; } }
    }
    GRID_BAR();

    for (int l = 0; l < 2; ++l) {
        for (int half = 0; half < 2; ++half) {
            const int tokbase = half * NH;
            { TID_SETUP; const float* xsrc = LDP(const float, (LQ() == 0) ? 0 : 31); const float* gain = LDP(const float, 2) + l * DMODEL; bf16* HB = ACTP(bf16, A_HB);
              for (int m = gw; m < NH; m += NGW) { f32x4 hn[4]; norm_row(xsrc + (size_t)(tokbase + m) * DMODEL, gain, HB + (size_t)m * DMODEL, lane, hn); } }
            GRID_BAR();
            { OPQ; pg8::Gemm g{ACTP(bf16, A_HB), WSP(bf16, WS_WIN) + (size_t)l * INCOLS * DMODEL, DMODEL, DMODEL, DMODEL}; pg8::SchedPlain S; S.init(NH / 256, INCOLS / 256, gridDim.x, (int)blockIdx.x);
              pg8::EpiIn E{ACTP(unsigned char, 0), WSP(const float, WS_ROPE), tokbase};
              pg8::gemm_phase<pg8::EpiIn, pg8::SchedPlain, true, true>(L0 + RING_OFF, g, S, E, MYTID()); }
            GRID_BAR();
            { OPQ; pg8::Gemm g{ACTP(bf16, A_UBUF), WSP(bf16, WS_EM) + (size_t)l * 32 * 256 * 512, 640, 512, 512}; pg8::SchedS5 S; S.init(1, gridDim.x, (int)blockIdx.x);
              pg8::EpiSloc E{ACTP(float, A_SLOC)};
              pg8::gemm_phase<pg8::EpiSloc, pg8::SchedS5, true, true>(L0 + RING_OFF, g, S, E, MYTID()); }
            GRID_BAR();
            { TID_SETUP;
              if (wave == 0) {
                const int id = vcu * 64 + lane;
                if (id < 8 * 32 * 64) { const int bl = id >> 11, g = (id >> 6) & 31, p = id & 63; const int lg = l * 32 + g;
                    const float dt = expf(LDP(const float, 6)[lg]); const float lr = LDP(const float, 4)[lg * 64 + p], li = LDP(const float, 5)[lg * 64 + p];
                    const float magT = expf(32.0f * lr * dt); float snT, csT; sincosf(32.0f * li * dt, &snT, &csT); const float aTr = magT * csT, aTi = magT * snT;
                    float sr = 0.f, si = 0.f; const size_t row0 = (size_t)g * 1024 + (size_t)bl * 128;
                    const float* sl = ACTP(const float, A_SLOC) + row0 * 128 + p; bf16* ub = ACTP(bf16, A_UBUF) + row0 * 640 + 512 + p;
                    for (int c0 = 0; c0 < 128; c0 += 8) { float lr_[8], li_[8];
#pragma unroll
                        for (int q = 0; q < 8; ++q) { lr_[q] = sl[(size_t)(c0 + q) * 128]; li_[q] = sl[(size_t)(c0 + q) * 128 + 64]; }
#pragma unroll
                        for (int q = 0; q < 8; ++q) { ub[(size_t)(c0 + q) * 640] = (bf16)f2bf(sr); ub[(size_t)(c0 + q) * 640 + 64] = (bf16)f2bf(si);
                            const float nr_ = aTr * sr - aTi * si + lr_[q], ni_ = aTr * si + aTi * sr + li_[q]; sr = nr_; si = ni_; } } }
              } }
            GRID_BAR();
            { OPQ; pg8::Gemm g{ACTP(bf16, A_UBUF), WSP(bf16, WS_TZF) + (size_t)l * 32 * 512 * 640, 640, 640, 640}; pg8::SchedS5 S; S.init(2, gridDim.x, (int)blockIdx.x);
              pg8::EpiYa E{ACTP(bf16, A_YA)};
              pg8::gemm_phase<pg8::EpiYa, pg8::SchedS5, true, true>(L0 + RING_OFF, g, S, E, MYTID()); }
            GRID_BAR();
            { OPQ; pg8::Gemm g{ACTP(bf16, A_YA), WSP(bf16, WS_WGLU) + (size_t)l * 512 * 512, 512, 512, 512}; pg8::SchedPlain S; S.init(NH / 256, 2, gridDim.x, (int)blockIdx.x);
              pg8::EpiGlu E{ACTP(bf16, A_YA), ACTP(bf16, A_YA2), LDP(const float, 13) + l * 512};
              pg8::gemm_phase<pg8::EpiGlu, pg8::SchedPlain, true, true>(L0 + RING_OFF, g, S, E, MYTID()); }
            GRID_BAR();
            {
                const int G = gridDim.x; const int vcu = ((int)blockIdx.x % 8) * (G / 8) + (int)blockIdx.x / 8;
                for (int i = 0; i < 16; ++i) {
                    OPQ; const int s = vcu & 7; const int bvh = (i >> 1) * 32 + (vcu >> 3); const int qb = (i & 1) ? 15 - s : s;
                    const int b = bvh >> 5, vh = bvh & 31, h = vh >> 2, c = (vh >> 1) & 1, vhalf = vh & 1;
                    const size_t rb = (size_t)b * SEQLEN;
                    attn_body::attn_unit<8>(qb, (const attn_body::bf16*)(ACTP(bf16, A_Q) + rb * 1024 + h * 128 + c * 64), (const attn_body::bf16*)(ACTP(bf16, A_K) + rb * 1024 + h * 128 + c * 64),
                                            (const attn_body::bf16*)(ACTP(bf16, A_V) + rb * 1024 + h * 128 + vhalf * 64), (attn_body::bf16*)(ACTP(bf16, A_OV) + rb * 2048 + h * 256 + c * 128 + vhalf * 64), (char*)lds + RING_OFF, MYTID());
                }
            }
            GRID_BAR();
            {
                TID_SETUP;
                int lq = l; asm volatile("" : "+s"(lq));
                const float lam_init = 0.8f - 0.6f * expf(-0.3f * (float)lq);
                const float p1 = wave_sum(LDP(const float, 14)[lq * 64 + lane] * LDP(const float, 15)[lq * 64 + lane]), p2 = wave_sum(LDP(const float, 16)[lq * 64 + lane] * LDP(const float, 17)[lq * 64 + lane]);
                const float lam = expf(p1) - expf(p2) + lam_init;
                const int head = lane >> 3, dch = lane & 7;
                const float* subln = LDP(const float, 18) + lq * 128 + dch * 16;
                pg8::f32x4 g0 = *(const GAS pg8::f32x4*)subln, g1 = *(const GAS pg8::f32x4*)(subln + 4), g2 = *(const GAS pg8::f32x4*)(subln + 8), g3 = *(const GAS pg8::f32x4*)(subln + 12);
                g0 *= (1.0f - lam_init); g1 *= (1.0f - lam_init); g2 *= (1.0f - lam_init); g3 *= (1.0f - lam_init);
                const bf16* OV = ACTP(const bf16, A_OV); bf16* YB = ACTP(bf16, A_YB);
                for (int m = gw; m < NH; m += NGW) {
                    const bf16* o1p = OV + (size_t)m * 2048 + head * 256 + dch * 16; const bf16* o2p = o1p + 128;
                    pg8::f32x4 a0, a1, a2, a3, b0, b1, b2, b3;
                    pg8::unpack8(*(const GAS pg8::u32x4*)o1p, a0, a1); pg8::unpack8(*(const GAS pg8::u32x4*)(o1p + 8), a2, a3);
                    pg8::unpack8(*(const GAS pg8::u32x4*)o2p, b0, b1); pg8::unpack8(*(const GAS pg8::u32x4*)(o2p + 8), b2, b3);
                    a0 -= lam * b0; a1 -= lam * b1; a2 -= lam * b2; a3 -= lam * b3;
                    float ss = (a0.x * a0.x + a0.y * a0.y + a0.z * a0.z + a0.w * a0.w) + (a1.x * a1.x + a1.y * a1.y + a1.z * a1.z + a1.w * a1.w)
                             + (a2.x * a2.x + a2.y * a2.y + a2.z * a2.z + a2.w * a2.w) + (a3.x * a3.x + a3.y * a3.y + a3.z * a3.z + a3.w * a3.w);
                    ss += swz_xor(ss, SWZ_XOR(1)); ss += swz_xor(ss, SWZ_XOR(2)); ss += swz_xor(ss, SWZ_XOR(4));
                    const float r = 1.0f / sqrtf(ss * (1.0f / 128.0f) + EPS_SUBLN);
                    bf16* dst = YB + (size_t)m * 1024 + head * 128 + dch * 16;
                    *(GAS pg8::u32x4*)dst = pg8::pack8(a0 * r * g0, a1 * r * g1); *(GAS pg8::u32x4*)(dst + 8) = pg8::pack8(a2 * r * g2, a3 * r * g3);
                }
            }
            GRID_BAR();
            { OPQ; pg8::Gemm g{ACTP(bf16, A_YA2), WSP(bf16, WS_WPS) + (size_t)l * 1024 * 512, 512, 512, 512}; pg8::SchedPlain S; S.init(NH / 256, 4, gridDim.x, (int)blockIdx.x);
              pg8::EpiGate<0> E{ACTP(bf16, A_SGS), nullptr};
              pg8::gemm_phase<pg8::EpiGate<0>, pg8::SchedPlain, true, true>(L0 + RING_OFF, g, S, E, MYTID()); }
            GRID_BAR();
            { OPQ; pg8::Gemm g{ACTP(bf16, A_YB), WSP(bf16, WS_WPA) + (size_t)l * 1024 * 1024, 1024, 1024, 1024}; pg8::SchedPlain S; S.init(NH / 256, 4, gridDim.x, (int)blockIdx.x);
              pg8::EpiGate<1> E{ACTP(bf16, A_SGA), ACTP(bf16, A_SGS)};
              pg8::gemm_phase<pg8::EpiGate<1>, pg8::SchedPlain, true, true>(L0 + RING_OFF, g, S, E, MYTID()); }
            GRID_BAR();
            { OPQ; pg8::Gemm g{ACTP(bf16, A_SGA), WSP(bf16, WS_WOUT) + (size_t)l * 1024 * 1024, 1024, 1024, 1024}; pg8::SchedPlain S; S.init(NH / 256, 4, gridDim.x, (int)blockIdx.x);
              pg8::EpiRes E{LDP(const float, (LQ() == 0) ? 0 : 31), LDP(float, 31), tokbase};
              pg8::gemm_phase<pg8::EpiRes, pg8::SchedPlain, true, true>(L0 + RING_OFF, g, S, E, MYTID()); }
            GRID_BAR();
            if (LQ() == 0) {
                { TID_SETUP; const float* xs = LDP(const float, 31); const float* gain = LDP(const float, 22); bf16* H2 = ACTP(bf16, A_H2);
                  for (int m = gw; m < NH; m += NGW) { f32x4 hn[4]; norm_row(xs + (size_t)(tokbase + m) * DMODEL, gain, H2 + (size_t)m * DMODEL, lane, hn); } }
                GRID_BAR();
                { OPQ; pg8::Gemm g{ACTP(bf16, A_H2), WSP(bf16, WS_WDGU), 1024, 1024, 1024}; pg8::SchedPlain S; S.init(NH / 256, 22, gridDim.x, (int)blockIdx.x);
                  pg8::EpiSwi E{ACTP(bf16, A_FA)};
                  pg8::gemm_phase<pg8::EpiSwi, pg8::SchedPlain, true, true>(L0 + RING_OFF, g, S, E, MYTID()); }
                GRID_BAR();
                { OPQ; pg8::Gemm g{ACTP(bf16, A_FA), WSP(bf16, WS_WDD), 2816, 2816, 2816}; pg8::SchedPlain S; S.init(NH / 256, 4, gridDim.x, (int)blockIdx.x);
                  pg8::EpiRes E{LDP(const float, 31), LDP(float, 31), tokbase};
                  pg8::gemm_phase<pg8::EpiRes, pg8::SchedPlain, true, true>(L0 + RING_OFF, g, S, E, MYTID()); }
                GRID_BAR();
            } else {
                {
                    TID_SETUP;
                    LAS float* rwT = (LAS float*)(L);
                    LAS unsigned* cntL = (LAS unsigned*)(L + 32768);
                    { const float* router_w = LDP(const float, 26); for (int idx = tid; idx < 8192; idx += NWAVES * 64) { const int k = idx >> 3, e = idx & 7; rwT[e * 1024 + k] = router_w[idx]; } }
                    if (tid < 8) cntL[tid] = 0u;
                    __syncthreads();
                    const float* xs = LDP(const float, 31); const float* gain = LDP(const float, 22) + DMODEL; bf16* H2 = ACTP(bf16, A_H2);
                    unsigned* RT_E = WSP(unsigned, WS_ROUTE + R_E); float* RT_W = WSP(float, WS_ROUTE + R_W);
                    for (int i = 0; i < 16; ++i) { const int row = vcu * 128 + wave * 16 + i;
                        f32x4 hn[4]; norm_row(xs + (size_t)(tokbase + row) * DMODEL, gain, H2 + (size_t)row * DMODEL, lane, hn);
                        float lg[8];
#pragma unroll
                        for (int e = 0; e < 8; ++e) { float a = 0.f;
#pragma unroll
                            for (int j = 0; j < 4; ++j) { const f32x4 w = *(const LAS f32x4*)(rwT + e * 1024 + 4 * lane + 256 * j); a += (hn[j].x * w.x + hn[j].y * w.y) + (hn[j].z * w.z + hn[j].w * w.w); }
                            lg[e] = wave_sum(a); }
                        if (lane == 0) { int e1 = 0; float v1 = lg[0];
#pragma unroll
                            for (int e = 1; e < 8; ++e) if (lg[e] > v1) { v1 = lg[e]; e1 = e; }
                            int e2 = -1; float v2 = -INFINITY;
#pragma unroll
                            for (int e = 0; e < 8; ++e) if (e != e1 && lg[e] > v2) { v2 = lg[e]; e2 = e; }
                            if (e2 < 0) e2 = (e1 == 0) ? 1 : 0;
                            const float ex = expf(v2 - v1); const float w1 = 1.0f / (1.0f + ex), w2 = ex / (1.0f + ex);
                            RT_E[row] = (unsigned)e1 | ((unsigned)e2 << 8); RT_W[2 * row] = w1; RT_W[2 * row + 1] = w2;
                            __hip_atomic_fetch_add(cntL + e1, 1u, __ATOMIC_RELAXED, __HIP_MEMORY_SCOPE_WORKGROUP); __hip_atomic_fetch_add(cntL + e2, 1u, __ATOMIC_RELAXED, __HIP_MEMORY_SCOPE_WORKGROUP); }
                    }
                    __syncthreads();
                    if (tid < 8) WSP(unsigned, WS_ROUTE + R_CNT)[vcu * 8 + tid] = cntL[tid];
                }
                GRID_BAR();
                {
                    TID_SETUP;
                    volatile LAS unsigned* MISC = (volatile LAS unsigned*)(L + MISC_OFF);
                    LAS unsigned* tab = (LAS unsigned*)(L);
                    LAS unsigned* tot = (LAS unsigned*)(L + 8192);
                    LAS unsigned* off = (LAS unsigned*)(L + 8192 + 64);
                    LAS unsigned* wcn = (LAS unsigned*)(L + 8192 + 128);
                    LAS unsigned* slt = (LAS unsigned*)(L + 8192 + 512);
                    const unsigned* RT_CNT = WSP(const unsigned, WS_ROUTE + R_CNT); const unsigned* RT_E = WSP(const unsigned, WS_ROUTE + R_E); int* RT_S = WSP(int, WS_ROUTE + R_S);
                    const bf16* H2 = ACTP(const bf16, A_H2); bf16* H2G = ACTP(bf16, A_H2G);
                    if (tid < 256) { const GAS v4u* src = (const GAS v4u*)(RT_CNT + tid * 8); const v4u a = src[0], b = src[1];
                        tab[tid * 8 + 0] = a.x; tab[tid * 8 + 1] = a.y; tab[tid * 8 + 2] = a.z; tab[tid * 8 + 3] = a.w; tab[tid * 8 + 4] = b.x; tab[tid * 8 + 5] = b.y; tab[tid * 8 + 6] = b.z; tab[tid * 8 + 7] = b.w; }
                    __syncthreads();
                    if (tid < 8) { unsigned t = 0, o = 0; for (int blk = 0; blk < 256; ++blk) { const unsigned c = tab[blk * 8 + tid]; if (blk < vcu) o += c; t += c; } tot[tid] = t; off[tid] = o; }
                    __syncthreads();
                    if (tid == 0) { unsigned sp = 0; for (int e = 0; e < 8; ++e) { MISC[16 + e] = sp; sp += (tot[e] + 255u) >> 8; } MISC[24] = sp; }
                    __syncthreads();
                    int my_e = 0, my_rank = 0;
                    if (tid < 256) { const int row = vcu * 128 + (tid >> 1); const unsigned ee = RT_E[row]; my_e = (tid & 1) ? (int)((ee >> 8) & 255u) : (int)(ee & 255u);
#pragma unroll
                        for (int e = 0; e < 8; ++e) { const unsigned long long mask = __ballot(my_e == e); if (my_e == e) my_rank = __popcll(mask & ((1ull << lane) - 1ull)); if (lane == 0) wcn[wave * 8 + e] = (unsigned)__popcll(mask); } }
                    __syncthreads();
                    if (tid < 256) { unsigned pre = 0; for (int w = 0; w < wave; ++w) pre += wcn[w * 8 + my_e];
                        const unsigned slot = MISC[16 + my_e] * 256u + off[my_e] + pre + (unsigned)my_rank;
                        RT_S[(vcu * 128 + (tid >> 1)) * 2 + (tid & 1)] = (int)slot; slt[tid] = slot; }
                    __syncthreads();
                    for (int i = 0; i < 32; ++i) { const int id = wave * 32 + i; const unsigned slot = slt[id];
                        const GAS v4u* src = (const GAS v4u*)(H2 + (size_t)(vcu * 128 + (id >> 1)) * DMODEL) + lane * 2; GAS v4u* dst = (GAS v4u*)(H2G + (size_t)slot * DMODEL) + lane * 2;
                        const v4u a = src[0], b = src[1]; dst[0] = a; dst[1] = b; }
                    if (vcu < 8) { const unsigned e = (unsigned)vcu; const unsigned r0 = MISC[16 + e] * 256u + tot[e], r1 = MISC[17 + e] * 256u; const v4u z = {0u, 0u, 0u, 0u};
                        for (unsigned r = r0 + (unsigned)wave; r < r1; r += NWAVES) { GAS v4u* dst = (GAS v4u*)(H2G + (size_t)r * DMODEL) + lane * 2; dst[0] = z; dst[1] = z; } }
                }
                GRID_BAR();
#define MOE_SCHED(S, NN) do { volatile LAS unsigned* MISC = (volatile LAS unsigned*)(L + MISC_OFF); S.nn = (NN); \
        S.sp1 = __builtin_amdgcn_readfirstlane((int)MISC[17]); S.sp2 = __builtin_amdgcn_readfirstlane((int)MISC[18]); S.sp3 = __builtin_amdgcn_readfirstlane((int)MISC[19]); S.sp4 = __builtin_amdgcn_readfirstlane((int)MISC[20]); \
        S.sp5 = __builtin_amdgcn_readfirstlane((int)MISC[21]); S.sp6 = __builtin_amdgcn_readfirstlane((int)MISC[22]); S.sp7 = __builtin_amdgcn_readfirstlane((int)MISC[23]); \
        S.so.init(__builtin_amdgcn_readfirstlane((int)MISC[24]), (NN), gridDim.x, (int)blockIdx.x); } while (0)
                { OPQ; pg8::SchedMoe S; MOE_SCHED(S, 22);
                  pg8::Gemm g{ACTP(bf16, A_H2G), WSP(bf16, WS_WMGU), 1024, 1024, 1024}; pg8::EpiSwi E{ACTP(bf16, A_AG)};
                  pg8::gemm_phase<pg8::EpiSwi, pg8::SchedMoe, true, true>(L0 + RING_OFF, g, S, E, MYTID()); }
                GRID_BAR();
                { OPQ; pg8::SchedMoe S; MOE_SCHED(S, 4);
                  pg8::Gemm g{ACTP(bf16, A_AG), WSP(bf16, WS_WMD), 2816, 2816, 2816}; pg8::EpiBf E{ACTP(bf16, A_YG)};
                  pg8::gemm_phase<pg8::EpiBf, pg8::SchedMoe, true, true>(L0 + RING_OFF, g, S, E, MYTID()); }
                GRID_BAR();
                {
                    TID_SETUP;
                    const int* RT_S = WSP(const int, WS_ROUTE + R_S); const float* RT_W = WSP(const float, WS_ROUTE + R_W); float* xo = LDP(float, 31); const bf16* YG = ACTP(const bf16, A_YG);
                    const GAS f32x4* gr = (const GAS f32x4*)LDP(const float, 30) + lane;
                    for (int m = gw; m < NH; m += NGW) {
                        const int s1 = RT_S[2 * m], s2 = RT_S[2 * m + 1]; const float w1 = RT_W[2 * m], w2 = RT_W[2 * m + 1];
                        GAS f32x4* xr = (GAS f32x4*)(xo + (size_t)(tokbase + m) * DMODEL) + lane;
                        const GAS unsigned long long* y1 = (const GAS unsigned long long*)(YG + (size_t)s1 * DMODEL) + lane; const GAS unsigned long long* y2 = (const GAS unsigned long long*)(YG + (size_t)s2 * DMODEL) + lane;
                        f32x4 v[4]; float sq = 0.f;
#pragma unroll
                        for (int j = 0; j < 4; ++j) { const unsigned long long a = y1[64 * j], b = y2[64 * j]; f32x4 xa = xr[64 * j];
                            const unsigned alo = (unsigned)a, ahi = (unsigned)(a >> 32), blo = (unsigned)b, bhi = (unsigned)(b >> 32);
                            xa.x += w1 * __uint_as_float(alo << 16) + w2 * __uint_as_float(blo << 16); xa.y += w1 * __uint_as_float(alo & 0xffff0000u) + w2 * __uint_as_float(blo & 0xffff0000u);
                            xa.z += w1 * __uint_as_float(ahi << 16) + w2 * __uint_as_float(bhi << 16); xa.w += w1 * __uint_as_float(ahi & 0xffff0000u) + w2 * __uint_as_float(bhi & 0xffff0000u);
                            v[j] = xa; sq += (xa.x * xa.x + xa.y * xa.y) + (xa.z * xa.z + xa.w * xa.w); }
                        const float rs = 1.0f / sqrtf(wave_sum(sq) * (1.0f / DMODEL) + EPS_NORM);
#pragma unroll
                        for (int j = 0; j < 4; ++j) xr[64 * j] = v[j] * rs * gr[64 * j];
                    }
                }
                GRID_BAR();
            }
        }
    }
#undef GRID_BAR
#undef TID_SETUP
#undef LQ
#undef MYTID
#undef OPQ
#undef WSP
#undef ACTP
#undef MOE_SCHED
}

extern "C" void kernel_launch(void* const* d_in, const int* in_sizes, int n_in, void* d_out, int out_size, void* d_ws, size_t ws_size, hipStream_t stream) {
    static int grid = 0;
    if (grid == 0) {
        if (n_in != 31 || in_sizes[0] != NTOK * DMODEL || out_size != NTOK * DMODEL || ws_size < WS_END) {
            fprintf(stderr, "kernel_launch: unexpected shapes: n_in %d in0 %d out %d ws %zu (need %zu); nothing launched\n", n_in, n_in > 0 ? in_sizes[0] : -1, out_size, ws_size, (size_t)WS_END); grid = -1; return; }
        int dev = 0, cus = 0, per_cu = 0;
        if (hipGetDevice(&dev) != hipSuccess || hipDeviceGetAttribute(&cus, hipDeviceAttributeMultiprocessorCount, dev) != hipSuccess) { grid = -1; return; }
        if (hipFuncSetAttribute((const void*)trunk_fwd, hipFuncAttributeMaxDynamicSharedMemorySize, LDS_BYTES) != hipSuccess) { fprintf(stderr, "kernel_launch: hipFuncSetAttribute failed\n"); grid = -1; return; }
        if (hipOccupancyMaxActiveBlocksPerMultiprocessor(&per_cu, (const void*)trunk_fwd, NWAVES * 64, LDS_BYTES) != hipSuccess || per_cu < 1)
            fprintf(stderr, "kernel_launch: note: occupancy query reports %d workgroups per CU\n", per_cu);
        (void)hipGetLastError();
        grid = 256;
        if (cus < 256) { fprintf(stderr, "kernel_launch: device has %d CUs, need 256; nothing launched\n", cus); grid = -1; return; }
    }
    if (grid < 0) return;
    if (hipMemsetAsync((char*)d_ws + WS_CTL, 0, CTL_ZERO_BYTES, stream) != hipSuccess) return;
    Args a{};
    for (int i = 0; i < 31; ++i) a.in[i] = d_in[i];
    a.out = (float*)d_out; a.ws = (unsigned char*)d_ws;
    hipLaunchKernelGGL(trunk_fwd, dim3(grid), dim3(NWAVES * 64), LDS_BYTES, stream, a);
}
```

```cpp
#include <hip/hip_runtime.h>
#include <hip/hip_bf16.h>
#include <cstdio>
#include <cstdint>
#include <cmath>
namespace pg8 {
#define PG8_LAS __attribute__((address_space(3)))
typedef unsigned short bf16_t;
typedef short bf16x8 __attribute__((ext_vector_type(8)));
typedef float f32x4 __attribute__((ext_vector_type(4)));
typedef unsigned u32x4 __attribute__((ext_vector_type(4)));
constexpr int BM = 256, BK = 64, HALF = 128, HTB = HALF * BK * 2  , STAGE_BYTES = 8 * HTB, NXCD = 8, WGM = 8;

__host__ __device__ __forceinline__ int lds_byte(int r, int c) { const int st = (r >> 4) * 2 + (c >> 5), rr = r & 15, cc = c & 31, ob = rr * 64 + cc * 2; return st * 1024 + (ob ^ (((ob >> 9) & 1) << 5)); }
__host__ __device__ __forceinline__ void stage_rc(int b, int& R, int& C) { const int st = b / 1024, sb = b % 1024, swz = sb ^ (((sb >> 9) & 1) << 5); R = (st >> 1) * 16 + swz / 64; C = (st & 1) * 32 + (swz % 64) / 2; }
__host__ __device__ __forceinline__ int perm32(int rho) { const int n = rho >> 4, i = rho & 15; return 8 * (i >> 2) + 4 * n + (i & 3); }

struct Unit { int pm, pn; };
struct Gemm { const bf16_t* A; const bf16_t* Bt; int lda, ldb, K; };

struct StaticOrder {
    int nM, nN, nwg, G, c;
    __host__ __device__ void init(int nM_, int nN_, int G_, int c_) { nM = nM_; nN = nN_; nwg = nM * nN; G = G_; c = c_; }
    __host__ __device__ bool next(int i, Unit& u) const {
        const long L = (long)i * G + c; if (L >= nwg) return false;
        int wgid = (int)L; { const int q = nwg / NXCD, r = nwg % NXCD, xcd = wgid % NXCD, off = wgid / NXCD; wgid = (xcd < r ? xcd * (q + 1) : r * (q + 1) + (xcd - r) * q) + off; }
        const int nig = WGM * nN, gid = wgid / nig, fm = gid * WGM, gsz = (nM - fm) < WGM ? (nM - fm) : WGM;
        u.pm = fm + ((wgid % nig) % gsz); u.pn = (wgid % nig) / gsz; return true;
    }
    __device__ __forceinline__ void a_ready(const Unit&) const {}
    __device__ __forceinline__ void done(const Unit&) const {}
};


struct SchedPlain {
    StaticOrder so;
    __device__ __forceinline__ void init(int nM, int nN, int G, int c) { so.init(nM, nN, G, c); }
    __device__ __forceinline__ bool next(int i, Unit& u) const { return so.next(i, u); }
    __device__ __forceinline__ void a_ready(const Unit&) const {}
    __device__ __forceinline__ void done(const Unit&) const {}
};
struct SchedS5 {
    StaticOrder so; int nng;
    __device__ __forceinline__ void init(int nng_, int G, int c) { nng = nng_; so.init(128, nng_, G, c); }
    __device__ __forceinline__ bool next(int i, Unit& u) const { if (!so.next(i, u)) return false; u.pn = (u.pm >> 2) * nng + u.pn; return true; }
    __device__ __forceinline__ void a_ready(const Unit&) const {}
    __device__ __forceinline__ void done(const Unit&) const {}
};
struct SchedMoe {
    StaticOrder so; int nn; int sp1, sp2, sp3, sp4, sp5, sp6, sp7;
    __device__ __forceinline__ bool next(int i, Unit& u) const {
        if (!so.next(i, u)) return false;
        const int pm = u.pm; const int e = (pm >= sp1) + (pm >= sp2) + (pm >= sp3) + (pm >= sp4) + (pm >= sp5) + (pm >= sp6) + (pm >= sp7);
        u.pn = e * nn + u.pn; return true;
    }
    __device__ __forceinline__ void a_ready(const Unit&) const {}
    __device__ __forceinline__ void done(const Unit&) const {}
};

typedef float f32x2c_t __attribute__((ext_vector_type(2))); typedef __bf16 bf16x2c_t __attribute__((ext_vector_type(2)));
__device__ __forceinline__ unsigned cvt_pk_bf16(float lo, float hi) { f32x2c_t v = {lo, hi}; bf16x2c_t b = __builtin_convertvector(v, bf16x2c_t); return __builtin_bit_cast(unsigned, b); }
__device__ __forceinline__ u32x4 pack8(const f32x4 a, const f32x4 b) { u32x4 w; w.x = cvt_pk_bf16(a[0], a[1]); w.y = cvt_pk_bf16(a[2], a[3]); w.z = cvt_pk_bf16(b[0], b[1]); w.w = cvt_pk_bf16(b[2], b[3]); return w; }
__device__ __forceinline__ void unpack8(const u32x4 w, f32x4& a, f32x4& b) {
    a[0] = __uint_as_float(w.x << 16); a[1] = __uint_as_float(w.x & 0xffff0000u); a[2] = __uint_as_float(w.y << 16); a[3] = __uint_as_float(w.y & 0xffff0000u);
    b[0] = __uint_as_float(w.z << 16); b[1] = __uint_as_float(w.z & 0xffff0000u); b[2] = __uint_as_float(w.w << 16); b[3] = __uint_as_float(w.w & 0xffff0000u); }
__device__ __forceinline__ float sigm(float z) { return __builtin_amdgcn_rcpf(1.0f + __builtin_amdgcn_exp2f(-1.4426950408889634f * z)); }
__device__ __forceinline__ f32x4 sigm4(const f32x4 z) { f32x4 r; r[0] = sigm(z[0]); r[1] = sigm(z[1]); r[2] = sigm(z[2]); r[3] = sigm(z[3]); return r; }
__device__ __forceinline__ float gelu_t(float x) { const float u = 1.5957691216057308f * (x + 0.044715f * x * x * x); return x * sigm(u); }
__device__ __forceinline__ f32x4 gelu4(const f32x4 z) { f32x4 r; r[0] = gelu_t(z[0]); r[1] = gelu_t(z[1]); r[2] = gelu_t(z[2]); r[3] = gelu_t(z[3]); return r; }
constexpr size_t EA_U = (size_t)64 << 20, EA_Q = (size_t)120 << 20, EA_K = (size_t)184 << 20, EA_V = (size_t)248 << 20, EA_SGS = (size_t)312 << 20, EA_SGA = (size_t)376 << 20;
constexpr float QSCALE = 0.125f * 1.4426950408889634f;

struct EpiIn {
    static constexpr bool PERM = true, AFTER_DRAIN = false;
    unsigned char* act; const float* rope; int tokbase;
    __device__ __forceinline__ void operator()(const f32x4 (&acc)[2][2][4][2], const Unit& u, int wr, int wc, int fr_in, int fq_in) const {
        int fr = fr_in, fq = fq_in; asm volatile("" : "+v"(fr), "+v"(fq));
        const int pn = u.pn, rowb = u.pm * BM + wr * 64 + fr, cow = wc * 32 + fq * 8;
        if (pn < 2) {
#pragma unroll
            for (int ai = 0; ai < 2; ++ai)
#pragma unroll
                for (int m = 0; m < 4; ++m) { const int row = rowb + ai * HALF + m * 16;
#pragma unroll
                    for (int bj = 0; bj < 2; ++bj) { const int c = pn * 256 + bj * HALF + cow; const int g = c >> 4, jj = c & 15;
                        bf16_t* dst = (bf16_t*)(act + EA_U) + ((size_t)(g * 1024 + (row >> 5)) * 640 + (row & 31) * 16 + jj);
                        *(u32x4*)dst = pack8(acc[ai][bj][m][0], acc[ai][bj][m][1]); } }
        } else if (pn < 10) {
            const bool isq = pn < 6; bf16_t* base = (bf16_t*)(act + (isq ? EA_Q : EA_K)); const int colt = (isq ? pn - 2 : pn - 6) * 256; const float sc = isq ? QSCALE : 1.0f;
            const int dlo = 16 * (wc & 1) + 4 * fq;
#pragma unroll
            for (int ai = 0; ai < 2; ++ai)
#pragma unroll
                for (int m = 0; m < 4; ++m) { const int row = rowb + ai * HALF + m * 16;
                    const float* tr = rope + (size_t)(tokbase + row) * 64 + dlo; const f32x4 cs = *(const f32x4*)tr, sn = *(const f32x4*)(tr + 32);
#pragma unroll
                    for (int bj = 0; bj < 2; ++bj) { const f32x4 v0 = acc[ai][bj][m][0], v1 = acc[ai][bj][m][1];
                        const f32x4 o0 = (v0 * cs - v1 * sn) * sc, o1 = (v1 * cs + v0 * sn) * sc;
                        *(u32x4*)(base + (size_t)row * 1024 + colt + bj * HALF + cow) = pack8(o0, o1); } }
        } else if (pn < 14) {
            const int colt = (pn - 10) * 256;
#pragma unroll
            for (int ai = 0; ai < 2; ++ai)
#pragma unroll
                for (int m = 0; m < 4; ++m) { const int row = rowb + ai * HALF + m * 16;
#pragma unroll
                    for (int bj = 0; bj < 2; ++bj) *(u32x4*)((bf16_t*)(act + EA_V) + (size_t)row * 1024 + colt + bj * HALF + cow) = pack8(acc[ai][bj][m][0], acc[ai][bj][m][1]); }
        } else {
            bf16_t* base = (bf16_t*)(act + (pn < 18 ? EA_SGS : EA_SGA)); const int colt = (pn < 18 ? pn - 14 : pn - 18) * 256;
#pragma unroll
            for (int ai = 0; ai < 2; ++ai)
#pragma unroll
                for (int m = 0; m < 4; ++m) { const int row = rowb + ai * HALF + m * 16;
#pragma unroll
                    for (int bj = 0; bj < 2; ++bj) *(u32x4*)(base + (size_t)row * 1024 + colt + bj * HALF + cow) = pack8(sigm4(acc[ai][bj][m][0]), sigm4(acc[ai][bj][m][1])); }
        }
    }
};
struct EpiSloc {
    static constexpr bool PERM = false, AFTER_DRAIN = false;
    float* S;
    __device__ __forceinline__ void operator()(const f32x4 (&acc)[2][2][4][2], const Unit& u, int wr, int wc, int fr_in, int fq_in) const {
        int fr = fr_in, fq = fq_in; asm volatile("" : "+v"(fr), "+v"(fq));
        const int rowb = u.pm * BM + wr * 64 + fr, col0 = wc * 32 + 4 * fq;
#pragma unroll
        for (int ai = 0; ai < 2; ++ai)
#pragma unroll
            for (int m = 0; m < 4; ++m) { float* rowp = S + (size_t)(rowb + ai * HALF + m * 16) * 128 + col0;
#pragma unroll
                for (int n = 0; n < 2; ++n) *(f32x4*)(rowp + n * 16) = acc[ai][0][m][n]; }
    }
};
struct EpiYa {
    static constexpr bool PERM = true, AFTER_DRAIN = false;
    bf16_t* YA;
    __device__ __forceinline__ void operator()(const f32x4 (&acc)[2][2][4][2], const Unit& u, int wr, int wc, int fr_in, int fq_in) const {
        int fr = fr_in, fq = fq_in; asm volatile("" : "+v"(fr), "+v"(fq));
        const int g = u.pm >> 2, pni = u.pn & 1; const int rowb = (u.pm & 3) * BM + wr * 64 + fr; const int jj = 8 * (fq & 1);
#pragma unroll
        for (int ai = 0; ai < 2; ++ai)
#pragma unroll
            for (int m = 0; m < 4; ++m) { const int R = rowb + ai * HALF + m * 16;
#pragma unroll
                for (int bj = 0; bj < 2; ++bj) { const int t = pni * 16 + bj * 8 + wc * 2 + (fq >> 1);
                    *(u32x4*)(YA + (size_t)(R * 32 + t) * 512 + g * 16 + jj) = pack8(gelu4(acc[ai][bj][m][0]), gelu4(acc[ai][bj][m][1])); } }
    }
};
struct EpiGlu {
    static constexpr bool PERM = true, AFTER_DRAIN = false;
    const bf16_t* YA; bf16_t* O; const float* bias;
    __device__ __forceinline__ void operator()(const f32x4 (&acc)[2][2][4][2], const Unit& u, int wr, int wc, int fr_in, int fq_in) const {
        int fr = fr_in, fq = fq_in; asm volatile("" : "+v"(fr), "+v"(fq));
        const int rowb = u.pm * BM + wr * 64 + fr, col0 = u.pn * BM + wc * 32 + 8 * fq;
        f32x4 bv[2][2];
#pragma unroll
        for (int bj = 0; bj < 2; ++bj)
#pragma unroll
            for (int n = 0; n < 2; ++n) bv[bj][n] = *(const f32x4*)(bias + col0 + bj * HALF + 4 * n);
#pragma unroll
        for (int ai = 0; ai < 2; ++ai)
#pragma unroll
            for (int m = 0; m < 4; ++m) { const size_t off = (size_t)(rowb + ai * HALF + m * 16) * 512 + col0;
#pragma unroll
                for (int bj = 0; bj < 2; ++bj) { f32x4 y0, y1; unpack8(*(const u32x4*)(YA + off + bj * HALF), y0, y1);
                    *(u32x4*)(O + off + bj * HALF) = pack8(y0 * sigm4(acc[ai][bj][m][0] + bv[bj][0]), y1 * sigm4(acc[ai][bj][m][1] + bv[bj][1])); } }
    }
};
template <int MODE> struct EpiGate {
    static constexpr bool PERM = true, AFTER_DRAIN = false;
    bf16_t* G; const bf16_t* T0;
    __device__ __forceinline__ void operator()(const f32x4 (&acc)[2][2][4][2], const Unit& u, int wr, int wc, int fr_in, int fq_in) const {
        int fr = fr_in, fq = fq_in; asm volatile("" : "+v"(fr), "+v"(fq));
        const int rowb = u.pm * BM + wr * 64 + fr, col0 = u.pn * BM + wc * 32 + 8 * fq;
#pragma unroll
        for (int ai = 0; ai < 2; ++ai)
#pragma unroll
            for (int m = 0; m < 4; ++m) { const size_t off = (size_t)(rowb + ai * HALF + m * 16) * 1024 + col0;
#pragma unroll
                for (int bj = 0; bj < 2; ++bj) { f32x4 g0, g1; unpack8(*(const u32x4*)(G + off + bj * HALF), g0, g1);
                    f32x4 o0 = g0 * acc[ai][bj][m][0], o1 = g1 * acc[ai][bj][m][1];
                    if (MODE == 1) { f32x4 t0, t1; unpack8(*(const u32x4*)(T0 + off + bj * HALF), t0, t1); o0 += t0; o1 += t1; }
                    *(u32x4*)(G + off + bj * HALF) = pack8(o0, o1); } }
    }
};
struct EpiRes {
    static constexpr bool PERM = false, AFTER_DRAIN = false;
    const float* xin; float* xout; int tokbase;
    __device__ __forceinline__ void operator()(const f32x4 (&acc)[2][2][4][2], const Unit& u, int wr, int wc, int fr_in, int fq_in) const {
        int fr = fr_in, fq = fq_in; asm volatile("" : "+v"(fr), "+v"(fq));
        const int rowb = tokbase + u.pm * BM + wr * 64 + fr, col0 = u.pn * BM + wc * 32 + 4 * fq;
#pragma unroll
        for (int ai = 0; ai < 2; ++ai)
#pragma unroll
            for (int m = 0; m < 4; ++m) { const size_t off = (size_t)(rowb + ai * HALF + m * 16) * 1024 + col0;
#pragma unroll
                for (int bj = 0; bj < 2; ++bj)
#pragma unroll
                    for (int n = 0; n < 2; ++n) { const f32x4 xi = *(const f32x4*)(xin + off + bj * HALF + n * 16); *(f32x4*)(xout + off + bj * HALF + n * 16) = xi + acc[ai][bj][m][n]; } }
    }
};
struct EpiSwi {
    static constexpr bool PERM = true, AFTER_DRAIN = false;
    bf16_t* O;
    __device__ __forceinline__ void operator()(const f32x4 (&acc)[2][2][4][2], const Unit& u, int wr, int wc, int fr_in, int fq_in) const {
        int fr = fr_in, fq = fq_in; asm volatile("" : "+v"(fr), "+v"(fq));
        const int rowb = u.pm * BM + wr * 64 + fr, col0 = (u.pn % 22) * HALF + wc * 32 + 8 * fq;
#pragma unroll
        for (int ai = 0; ai < 2; ++ai)
#pragma unroll
            for (int m = 0; m < 4; ++m) { const f32x4 g0 = acc[ai][0][m][0], g1 = acc[ai][0][m][1];
                *(u32x4*)(O + (size_t)(rowb + ai * HALF + m * 16) * 2816 + col0) = pack8(g0 * sigm4(g0) * acc[ai][1][m][0], g1 * sigm4(g1) * acc[ai][1][m][1]); }
    }
};
struct EpiBf {
    static constexpr bool PERM = true, AFTER_DRAIN = false;
    bf16_t* O;
    __device__ __forceinline__ void operator()(const f32x4 (&acc)[2][2][4][2], const Unit& u, int wr, int wc, int fr_in, int fq_in) const {
        int fr = fr_in, fq = fq_in; asm volatile("" : "+v"(fr), "+v"(fq));
        const int rowb = u.pm * BM + wr * 64 + fr, col0 = (u.pn & 3) * BM + wc * 32 + 8 * fq;
#pragma unroll
        for (int ai = 0; ai < 2; ++ai)
#pragma unroll
            for (int m = 0; m < 4; ++m)
#pragma unroll
                for (int bj = 0; bj < 2; ++bj) *(u32x4*)(O + (size_t)(rowb + ai * HALF + m * 16) * 1024 + col0 + bj * HALF) = pack8(acc[ai][bj][m][0], acc[ai][bj][m][1]);
    }
};

template <class Epi, class Sched, bool ALIGN_EPI = false, bool SP2 = false>
__device__ __forceinline__ void gemm_phase(PG8_LAS unsigned char* lds, const Gemm g, const Sched& S, const Epi& E, const int tid_in) {
    const int tid = tid_in, wid = __builtin_amdgcn_readfirstlane(tid >> 6), lane = tid & 63, wr = wid >> 2, wc = wid & 3, fr = lane & 15, fq = lane >> 4;
    const int K = g.K, nt = K / BK;
    unsigned voffA[2], voffB[2];
#pragma unroll
    for (int i = 0; i < 2; ++i) { int R, C; stage_rc(tid * 16 + i * 8192, R, C); const int Rb = Epi::PERM ? ((R & ~31) + perm32(R & 31)) : R;
        voffA[i] = (unsigned)(R * g.lda + C) * 2u; voffB[i] = (unsigned)(Rb * g.ldb + C) * 2u; }
    const size_t kstep = (size_t)(BK * 2);
    const size_t hstepA = (size_t)HALF * g.lda * 2, hstepB = (size_t)HALF * g.ldb * 2;
    const size_t tstepA = 2 * hstepA, tstepB = 2 * hstepB;
    const unsigned ldsw = (unsigned)wid * 1024u;
    const int aoff = lds_byte(wr * 64 + fr, fq * 8), boff = lds_byte(wc * 32 + fr, fq * 8);
#define PG8_SA(b, h) (((b) * 2 + (h)) * HTB)
#define PG8_SB(b, h) ((4 + (b) * 2 + (h)) * HTB)
#define PG8_STAGE(bufoff, gbase, voff) do { _Pragma("unroll") for (int _i = 0; _i < 2; ++_i) \
        __builtin_amdgcn_global_load_lds((const unsigned*)((const char*)(gbase) + (voff)[_i]), (PG8_LAS unsigned*)(lds + (bufoff) + ldsw + _i * 8192), 16, 0, 0); } while (0)
#define PG8_LDA(dst, b, h) do { _Pragma("unroll") for (int m = 0; m < 4; ++m) _Pragma("unroll") for (int k = 0; k < 2; ++k) dst[m][k] = *(const PG8_LAS bf16x8*)(lds + PG8_SA(b, h) + aoff + m * 2048 + k * 1024); } while (0)
#define PG8_LDB(dst, b, h) do { _Pragma("unroll") for (int n = 0; n < 2; ++n) _Pragma("unroll") for (int k = 0; k < 2; ++k) dst[n][k] = *(const PG8_LAS bf16x8*)(lds + PG8_SB(b, h) + boff + n * 2048 + k * 1024); } while (0)
#define PG8_MMA(ai, bj, At, Bt) do { __builtin_amdgcn_s_setprio(1); _Pragma("unroll") for (int m = 0; m < 4; ++m) _Pragma("unroll") for (int n = 0; n < 2; ++n) _Pragma("unroll") for (int k = 0; k < 2; ++k) \
        acc[ai][bj][m][n] = __builtin_amdgcn_mfma_f32_16x16x32_bf16(Bt[n][k], At[m][k], acc[ai][bj][m][n], 0, 0, 0); __builtin_amdgcn_s_setprio(0); } while (0)
#define PG8_WAIT_V(n) asm volatile("s_waitcnt vmcnt(" #n ")" ::: "memory")
#define PG8_WAIT_L(n) asm volatile("s_waitcnt lgkmcnt(" #n ")" ::: "memory")
#define PG8_BAR __builtin_amdgcn_s_barrier()
#define PG8_SCHED __builtin_amdgcn_sched_barrier(0)
    Unit cur, nxt; int ui = 0;
    if (!S.next(0, cur)) return;
    f32x4 acc[2][2][4][2];
#pragma unroll
    for (int a = 0; a < 2; ++a)
#pragma unroll
        for (int b = 0; b < 2; ++b)
#pragma unroll
            for (int m = 0; m < 4; ++m)
#pragma unroll
                for (int n = 0; n < 2; ++n) acc[a][b][m][n] = (f32x4){0.f, 0.f, 0.f, 0.f};
    bf16x8 At[4][2], B0[2][2], B1[2][2];
    const char* cA = (const char*)g.A + (size_t)cur.pm * tstepA; const char* cB = (const char*)g.Bt + (size_t)cur.pn * tstepB;
    S.a_ready(cur);
    if constexpr (SP2) {
        PG8_STAGE(PG8_SB(0, 0), cB, voffB); PG8_STAGE(PG8_SB(0, 1), cB + hstepB, voffB); PG8_STAGE(PG8_SA(0, 0), cA, voffA); PG8_STAGE(PG8_SA(0, 1), cA + hstepA, voffA);
        if (wr == 1) PG8_BAR;
        PG8_WAIT_V(2); PG8_BAR;
        PG8_STAGE(PG8_SB(1, 0), cB + kstep, voffB); PG8_STAGE(PG8_SA(1, 0), cA + kstep, voffA); PG8_STAGE(PG8_SB(1, 1), cB + hstepB + kstep, voffB);
        PG8_WAIT_V(6); PG8_BAR;
    } else {
        PG8_STAGE(PG8_SB(0, 0), cB, voffB); PG8_STAGE(PG8_SA(0, 0), cA, voffA); PG8_STAGE(PG8_SB(0, 1), cB + hstepB, voffB); PG8_STAGE(PG8_SA(0, 1), cA + hstepA, voffA);
        if (wr == 1) PG8_BAR;
        PG8_WAIT_V(4); PG8_BAR;
        PG8_STAGE(PG8_SB(1, 0), cB + kstep, voffB); PG8_STAGE(PG8_SA(1, 0), cA + kstep, voffA); PG8_STAGE(PG8_SB(1, 1), cB + hstepB + kstep, voffB);
        PG8_WAIT_V(6); PG8_BAR;
    }
    for (;;) {
        const bool has_next = S.next(ui + 1, nxt);
        const char* nA = has_next ? (const char*)g.A + (size_t)nxt.pm * tstepA : cA; const char* nB = has_next ? (const char*)g.Bt + (size_t)nxt.pn * tstepB : cB;
        for (int t = 0; t < nt; t += 2) {
            const bool last = (t == nt - 2);
            const char* a1 = cA + (size_t)(t + 1) * kstep;
            const char* a2 = last ? nA : cA + (size_t)(t + 2) * kstep; const char* b2 = last ? nB : cB + (size_t)(t + 2) * kstep;
            const char* a3 = a2 + kstep; const char* b3 = b2 + kstep;
            if (last && has_next) S.a_ready(nxt);
            if constexpr (SP2) {
            PG8_LDB(B0, 0, 0); PG8_LDB(B1, 0, 1); PG8_SCHED; PG8_LDA(At, 0, 0); PG8_STAGE(PG8_SA(1, 1), a1 + hstepA, voffA);
            PG8_WAIT_V(8); PG8_WAIT_L(0); PG8_BAR; PG8_MMA(0, 0, At, B0); PG8_MMA(0, 1, At, B1); PG8_BAR; PG8_SCHED;
            PG8_LDA(At, 0, 1); PG8_STAGE(PG8_SB(0, 0), b2, voffB); PG8_STAGE(PG8_SB(0, 1), b2 + hstepB, voffB); PG8_STAGE(PG8_SA(0, 0), a2, voffA);
            PG8_WAIT_V(8); PG8_WAIT_L(0); PG8_BAR; PG8_MMA(1, 0, At, B0); PG8_MMA(1, 1, At, B1); PG8_BAR; PG8_SCHED;
            PG8_LDB(B0, 1, 0); PG8_LDB(B1, 1, 1); PG8_SCHED; PG8_LDA(At, 1, 0); PG8_STAGE(PG8_SA(0, 1), a2 + hstepA, voffA);
            PG8_WAIT_V(8); PG8_WAIT_L(0); PG8_BAR; PG8_MMA(0, 0, At, B0); PG8_MMA(0, 1, At, B1); PG8_BAR; PG8_SCHED;
            PG8_LDA(At, 1, 1); PG8_STAGE(PG8_SB(1, 0), b3, voffB); PG8_STAGE(PG8_SB(1, 1), b3 + hstepB, voffB); PG8_STAGE(PG8_SA(1, 0), a3, voffA);
            PG8_WAIT_V(8); PG8_WAIT_L(0); PG8_BAR; PG8_MMA(1, 0, At, B0); PG8_MMA(1, 1, At, B1); PG8_BAR; PG8_SCHED;
            } else {
            PG8_LDB(B0, 0, 0); PG8_SCHED; PG8_LDA(At, 0, 0); PG8_STAGE(PG8_SA(1, 1), a1 + hstepA, voffA);
            PG8_WAIT_L(8); PG8_BAR; PG8_WAIT_L(0); PG8_MMA(0, 0, At, B0); PG8_BAR; PG8_SCHED;
            PG8_LDB(B1, 0, 1); PG8_STAGE(PG8_SB(0, 0), b2, voffB);
            PG8_BAR; PG8_WAIT_L(0); PG8_MMA(0, 1, At, B1); PG8_BAR;
            PG8_LDA(At, 0, 1); PG8_STAGE(PG8_SA(0, 0), a2, voffA);
            PG8_BAR; PG8_WAIT_L(0); PG8_MMA(1, 0, At, B0); PG8_BAR; PG8_SCHED;
            PG8_STAGE(PG8_SB(0, 1), b2 + hstepB, voffB);
            PG8_WAIT_V(6); PG8_BAR; PG8_MMA(1, 1, At, B1); PG8_BAR;
            PG8_LDB(B0, 1, 0); PG8_SCHED; PG8_LDA(At, 1, 0); PG8_STAGE(PG8_SA(0, 1), a2 + hstepA, voffA);
            PG8_WAIT_L(8); PG8_BAR; PG8_WAIT_L(0); PG8_MMA(0, 0, At, B0); PG8_BAR; PG8_SCHED;
            PG8_LDB(B1, 1, 1); PG8_STAGE(PG8_SB(1, 0), b3, voffB);
            PG8_BAR; PG8_WAIT_L(0); PG8_MMA(0, 1, At, B1); PG8_BAR;
            PG8_LDA(At, 1, 1); PG8_STAGE(PG8_SA(1, 0), a3, voffA);
            PG8_BAR; PG8_WAIT_L(0); PG8_MMA(1, 0, At, B0); PG8_BAR; PG8_SCHED;
            PG8_STAGE(PG8_SB(1, 1), b3 + hstepB, voffB);
            PG8_WAIT_V(6); PG8_BAR; PG8_MMA(1, 1, At, B1); PG8_BAR;
            }
        }
        if constexpr (ALIGN_EPI) { if (wr == 0) PG8_BAR; }
        if constexpr (!Epi::AFTER_DRAIN) { E(acc, cur, wr, wc, fr, fq); S.done(cur); }
        if (!has_next) break;
#pragma unroll
        for (int a = 0; a < 2; ++a)
#pragma unroll
            for (int b = 0; b < 2; ++b)
#pragma unroll
                for (int m = 0; m < 4; ++m)
#pragma unroll
                    for (int n = 0; n < 2; ++n) acc[a][b][m][n] = (f32x4){0.f, 0.f, 0.f, 0.f};
        cur = nxt; cA = nA; cB = nB; ++ui;
        if constexpr (ALIGN_EPI) { if (wr == 1) PG8_BAR; }
    }
    PG8_WAIT_V(0);
    if constexpr (!ALIGN_EPI) { if (wr == 0) PG8_BAR; }
    PG8_BAR;
    if constexpr (Epi::AFTER_DRAIN) { E.fused(acc, cur, wr, wc, fr, fq, lds, wid, lane); S.done(cur); }
#undef PG8_SA
#undef PG8_SB
#undef PG8_STAGE
#undef PG8_LDA
#undef PG8_LDB
#undef PG8_MMA
#undef PG8_WAIT_V
#undef PG8_WAIT_L
#undef PG8_BAR
#undef PG8_SCHED
}
}

#include <hip/hip_bf16.h>
#include <cmath>
namespace attn_body {
using bf16=__hip_bfloat16;
using bf16x8=__attribute__((ext_vector_type(8)))short;
using s16x4=__attribute__((ext_vector_type(4)))short;
using f32x16=__attribute__((ext_vector_type(16)))float;
using u32x4=__attribute__((ext_vector_type(4)))unsigned;
constexpr int SEQ=4096,D=64,DM=1024,OPITCH=2048;
constexpr int NW=8,QBLK=32,QB=QBLK*NW,KVBLK=64,NQB=SEQ/QB;
constexpr int ATTN_PITCH=DM, ATTN_UNIT_ROWS=QB;
__device__ __forceinline__ int crow(int r,int hi){return (r&3)+8*(r>>2)+4*hi;}
#define SBAR() __builtin_amdgcn_sched_barrier(0)
__device__ __forceinline__ void cmask(f32x16&p0,f32x16&p1,int jb,int qrel,int hi){
  const float NEG=-INFINITY; int kb=64*jb+4*hi;
  #pragma unroll
  for(int r=0;r<16;++r){int kv=kb+(r&3)+8*(r>>2); if(kv>qrel)p0[r]=NEG; if(kv+32>qrel)p1[r]=NEG;}
}

constexpr int NSLOT=3, SLOTB=8192;
constexpr int LDS_K=0, LDS_V=NSLOT*SLOTB, LDS_WS=2*NSLOT*SLOTB, LDS_OST=LDS_WS+NW*64*4, LDS_BYTES=LDS_OST+NW*4096;
constexpr float C2=0.125f*1.4426950408889634f;
__device__ __forceinline__ void glds16(const void*gsrc,unsigned lds_dst){unsigned keep;
  asm volatile("s_mov_b32 %0, m0\n\ts_mov_b32 m0, %2\n\ts_nop 0\n\tglobal_load_lds_dwordx4 %1, off\n\ts_mov_b32 m0, %0":"=&s"(keep):"v"(gsrc),"s"(lds_dst):"memory");}
__device__ __forceinline__ float max3f(float a,float b,float c){float r;asm("v_max3_f32 %0, %1, %2, %3":"=v"(r):"v"(a),"v"(b),"v"(c));return r;}
__device__ __forceinline__ float max2f(float a,float b){float r;asm("v_max_f32_e32 %0, %1, %2":"=v"(r):"v"(a),"v"(b));return r;}
__device__ __forceinline__ float fadd_s(float a,float b){float r;asm("v_add_f32_e32 %0, %1, %2":"=v"(r):"v"(a),"v"(b));return r;}
__device__ __forceinline__ float fsub_s(float a,float b){float r;asm("v_sub_f32_e32 %0, %1, %2":"=v"(r):"v"(a),"v"(b));return r;}
typedef float f32x2_t __attribute__((ext_vector_type(2))); typedef __bf16 bf16x2_t __attribute__((ext_vector_type(2)));
__device__ __forceinline__ unsigned cvtpk_s(float lo,float hi){f32x2_t v={lo,hi};bf16x2_t b=__builtin_convertvector(v,bf16x2_t);return __builtin_bit_cast(unsigned,b);}
#define WAIT_BAR(N) asm volatile("s_waitcnt vmcnt(" #N ") lgkmcnt(0)\n\ts_barrier":::"memory")

__device__ __forceinline__ f32x16 mfma_z(bf16x8 a_,bf16x8 b_){ f32x16 d_; asm volatile("s_nop 1\n\tv_mfma_f32_32x32x16_bf16 %0, %1, %2, 0":"=&v"(d_):"v"(a_),"v"(b_)); return d_; }
__device__ __forceinline__ void qkt(f32x16&p0,f32x16&p1,const char*Kslot,const bf16x8*qr,int r32,int hi){
  const char*kb=Kslot+hi*1024+r32*16;
  #pragma unroll
  for(int d0=0;d0<4;++d0){
    const bf16x8 b0=*reinterpret_cast<const bf16x8*>(kb+d0*2048);
    const bf16x8 b1=*reinterpret_cast<const bf16x8*>(kb+d0*2048+512);
    if(d0==0){f32x16 z0=f32x16{},z1=f32x16{};asm volatile("":"+v"(z0),"+v"(z1));
      p0=__builtin_amdgcn_mfma_f32_32x32x16_bf16(b0,qr[0],z0,0,0,0);p1=__builtin_amdgcn_mfma_f32_32x32x16_bf16(b1,qr[0],z1,0,0,0);}
    else{p0=__builtin_amdgcn_mfma_f32_32x32x16_bf16(b0,qr[d0],p0,0,0,0);p1=__builtin_amdgcn_mfma_f32_32x32x16_bf16(b1,qr[d0],p1,0,0,0);}}
}
typedef __attribute__((address_space(3))) const char* lds_cptr;
typedef short v4i16_t __attribute__((ext_vector_type(4)));
__device__ __forceinline__ void kload8(bf16x8*kf,lds_cptr kp){
  kf[0]=*(const __attribute__((address_space(3))) bf16x8*)(kp);      kf[1]=*(const __attribute__((address_space(3))) bf16x8*)(kp+512);
  kf[2]=*(const __attribute__((address_space(3))) bf16x8*)(kp+2048); kf[3]=*(const __attribute__((address_space(3))) bf16x8*)(kp+2560);
  kf[4]=*(const __attribute__((address_space(3))) bf16x8*)(kp+4096); kf[5]=*(const __attribute__((address_space(3))) bf16x8*)(kp+4608);
  kf[6]=*(const __attribute__((address_space(3))) bf16x8*)(kp+6144); kf[7]=*(const __attribute__((address_space(3))) bf16x8*)(kp+6656);
}
__device__ __forceinline__ void kload2(bf16x8*kf,lds_cptr kp,int j){ kf[2*j]=*(const __attribute__((address_space(3))) bf16x8*)(kp+j*2048); kf[2*j+1]=*(const __attribute__((address_space(3))) bf16x8*)(kp+j*2048+512); }
__device__ __forceinline__ s16x4 vtr(lds_cptr p){ return __builtin_bit_cast(s16x4,__builtin_amdgcn_ds_read_tr16_b64_v4i16((__attribute__((address_space(3))) v4i16_t*)p)); }
__device__ __forceinline__ float rowmax(const f32x16&p0,const f32x16&p1){
  float a=max3f(p0[0],p0[1],p1[0]),b=max3f(p0[2],p0[3],p1[1]);a=max3f(a,p1[2],p1[3]);
  #pragma unroll
  for(int r=4;r<16;r+=4){a=max3f(a,p0[r],p0[r+1]);b=max3f(b,p0[r+2],p0[r+3]);a=max3f(a,p1[r],p1[r+1]);b=max3f(b,p1[r+2],p1[r+3]);}
  const float m=max2f(a,b);
  auto rr=__builtin_amdgcn_permlane32_swap(__float_as_uint(m),__float_as_uint(m),false,false);
  return max2f(__uint_as_float(rr[0]),__uint_as_float(rr[1]));
}
__device__ __forceinline__ void pv(f32x16*o,int vb,bf16x8 pa0,bf16x8 pa1,bf16x8 pa2,bf16x8 pa3){
  #pragma unroll
  for(int d0=0;d0<2;++d0){s16x4 lo[4],hi[4];
    #pragma unroll
    for(int ks=0;ks<4;++ks){
      asm volatile("ds_read_b64_tr_b16 %0,%1 offset:%c2":"=&v"(lo[ks]):"v"(vb),"i"(d0*4096+ks*1024):"memory");
      asm volatile("ds_read_b64_tr_b16 %0,%1 offset:%c2":"=&v"(hi[ks]):"v"(vb),"i"(d0*4096+ks*1024+512):"memory");}
    asm volatile("s_waitcnt lgkmcnt(0)":::"memory");SBAR();
    #define PK(k) (bf16x8){lo[k][0],lo[k][1],lo[k][2],lo[k][3],hi[k][0],hi[k][1],hi[k][2],hi[k][3]}
    o[d0]=__builtin_amdgcn_mfma_f32_32x32x16_bf16(pa0,PK(0),o[d0],0,0,0);
    o[d0]=__builtin_amdgcn_mfma_f32_32x32x16_bf16(pa1,PK(1),o[d0],0,0,0);
    o[d0]=__builtin_amdgcn_mfma_f32_32x32x16_bf16(pa2,PK(2),o[d0],0,0,0);
    o[d0]=__builtin_amdgcn_mfma_f32_32x32x16_bf16(pa3,PK(3),o[d0],0,0,0);
    #undef PK
  }
}

#ifndef ATTN_STORE16
#define ATTN_STORE16(p,v) (*(u32x4*)(p)=(v))
#endif
template<int THRL> __device__ __forceinline__ void attn_unit(int qb,const bf16*Qh,const bf16*__restrict__ Kh,const bf16*__restrict__ Vh,bf16*Oh,char*shm,const int tid_in){
  const int tid=tid_in,lane=tid&63,r32=lane&31,hi=lane>>5; const int wid=__builtin_amdgcn_readfirstlane(tid>>6);
  const int q0=qb*QB;
  const bf16*Qw=Qh+(long)(q0+wid*QBLK)*DM;
  const unsigned lds0=(unsigned)(uintptr_t)shm;
  float*wsf=(float*)(shm+LDS_WS)+wid*64;
  const bf16*ksrc=Kh+(long)lane*DM+wid*8;
  const bf16*vsrc=Vh+(long)(16*(wid&3)+(lane>>2))*DM+(wid>>2)*32+(lane&3)*8;
  const unsigned kdst=lds0+LDS_K+wid*1024, vdst=lds0+LDS_V+wid*1024;
  #define DMA_K(t,slot) glds16(ksrc+(long)(t)*KVBLK*DM,(unsigned)__builtin_amdgcn_readfirstlane(kdst+(slot)))
  #define DMA_V(t,slot) glds16(vsrc+(long)(t)*KVBLK*DM,(unsigned)__builtin_amdgcn_readfirstlane(vdst+(slot)))
  const int vb0=(int)(lds0+LDS_V)+((lane>>4)&1)*32+(lane&3)*8+(4*hi+((lane&15)>>2))*64;
  const char*Kbase=shm+LDS_K; bf16x8 kf[8];
  const lds_cptr shm3=(lds_cptr)shm; const lds_cptr kp0=shm3+LDS_K+hi*1024+r32*16; const lds_cptr vp0=shm3+LDS_V+((lane>>4)&1)*32+(lane&3)*8+(4*hi+((lane&15)>>2))*64;
  const int NT=(q0+QB)/KVBLK;
  DMA_K(0,0);DMA_V(0,0);DMA_K(1,SLOTB);
  bf16x8 qr[4];
  #pragma unroll
  for(int d0=0;d0<4;++d0)qr[d0]=*reinterpret_cast<const bf16x8*>(&Qw[(long)r32*DM+d0*16+hi*8]);
  float mhat=0.f,l_reg=0.f;f32x16 o[2];o[0]=f32x16{};o[1]=f32x16{};
  const int qrel=wid*QBLK+r32;
  #define CMASK(P0,P1,t) do{int jb_=(t)-(NT-4); if(jb_>=0)cmask(P0,P1,jb_,qrel,hi);}while(0)
  bool resc=false;
  #define START(P0,P1) do{ const float rm=rowmax(P0,P1); resc=false; \
    { const float dl=rm; mhat=fadd_s(mhat,dl); \
      _Pragma("unroll") for(int r=0;r<16;++r){P0[r]=fsub_s(P0[r],dl);P1[r]=fsub_s(P1[r],dl);} \
      } \
    _Pragma("unroll") for(int r=0;r<16;++r)P0[r]=__builtin_amdgcn_exp2f(P0[r]); }while(0)
  #define RESC() do{ if(resc){ asm volatile("s_waitcnt lgkmcnt(0)":::"memory"); \
      _Pragma("unroll") for(int d_=0;d_<2;++d_) _Pragma("unroll") for(int r=0;r<16;++r)o[d_][r]*=wsf[crow(r,hi)]; } }while(0)
  f32x16 pA0,pA1,pB0,pB1;
  int sl_prev=0,sl_cur=0,sl_next=SLOTB;
  #define ROT() do{sl_prev=sl_cur;sl_cur=sl_next;sl_next=(sl_next==(NSLOT-1)*SLOTB)?0:sl_next+SLOTB;}while(0)
  DMA_K(2,2*SLOTB);
  WAIT_BAR(3);
  qkt(pA0,pA1,Kbase,qr,r32,hi);asm volatile("s_nop 15\n\ts_nop 7":"+v"(pA0),"+v"(pA1));CMASK(pA0,pA1,0);
  START(pA0,pA1);
  _Pragma("unroll") for(int r=0;r<16;++r)pA1[r]=__builtin_amdgcn_exp2f(pA1[r]);
  WAIT_BAR(0);
  DMA_K(3,0);DMA_V(1,SLOTB);
  ROT();
  kload8(kf,kp0+sl_cur);
  WAIT_BAR(2);
  s16x4 vlo[8],vhi[8]; u32x4 pw0,pw1,pw2,pw3;
  #define PKW(P,B) cvtpk_s(P[B],P[B+1])
  #define PAF(k) __builtin_bit_cast(bf16x8,pw##k)
  #define VFR(i) (bf16x8){vlo[i][0],vlo[i][1],vlo[i][2],vlo[i][3],vhi[i][0],vhi[i][1],vhi[i][2],vhi[i][3]}
  #define PIN(x) asm volatile("":"+v"(x))
  #define MX3(a,b,c) __builtin_fmaxf(__builtin_fmaxf((a),(b)),(c))
  #define GAPA(MF,A0,A1,A2,A3,W0,W1,PW) do{ MF; sacc+=A0; sacc+=A1; sacc+=A2; sacc+=A3; PIN(sacc); W0; W1; PIN(PW); SBAR(); }while(0)
  #define EX(v) __builtin_amdgcn_exp2f(v)
  #define GAPB(MF,X,B) do{ MF; X[B]=EX(fsub_s(X[B],mhat)); X[B+1]=EX(fsub_s(X[B+1],mhat)); X[B+2]=EX(fsub_s(X[B+2],mhat)); X[B+3]=EX(fsub_s(X[B+3],mhat)); PIN(X); SBAR(); }while(0)
  #define VRD(i) do{ vlo[i]=vtr(vp_+(((i)>>2)*4096+((i)&3)*1024)); vhi[i]=vtr(vp_+(((i)>>2)*4096+((i)&3)*1024+512)); }while(0)
  #define KRD(G,j) do{ if(G){ kload2(kf,kp0+sl_next,j); SBAR(); } }while(0)
  #define STEP(C0,C1,P0,P1,t,GK,GV,GL) do{ SBAR(); \
    const lds_cptr vp_=vp0+sl_prev; \
    VRD(0); SBAR(); float sacc=(P0[0]+P0[1]); \
    GAPA(C0=mfma_z(kf[0],qr[0]), P0[2],P0[3],P0[4],P0[5],     pw0[0]=PKW(P0,0), pw0[1]=PKW(P0,2), pw0); \
    VRD(4); SBAR(); GAPA(C1=mfma_z(kf[1],qr[0]), P0[6],P0[7],P0[8],P0[9],     pw0[2]=PKW(P0,4), pw0[3]=PKW(P0,6), pw0); \
    VRD(1); SBAR(); GAPA(C0=__builtin_amdgcn_mfma_f32_32x32x16_bf16(kf[2],qr[1],C0,0,0,0),   P0[10],P0[11],P0[12],P0[13], pw1[0]=PKW(P0,8), pw1[1]=PKW(P0,10), pw1); \
    VRD(5); SBAR(); GAPA(C1=__builtin_amdgcn_mfma_f32_32x32x16_bf16(kf[3],qr[1],C1,0,0,0),   P0[14],P0[15],P1[0],P1[1],   pw1[2]=PKW(P0,12),pw1[3]=PKW(P0,14), pw1); \
    VRD(2); SBAR(); GAPA(C0=__builtin_amdgcn_mfma_f32_32x32x16_bf16(kf[4],qr[2],C0,0,0,0),   P1[2],P1[3],P1[4],P1[5],     pw2[0]=PKW(P1,0), pw2[1]=PKW(P1,2), pw2); \
    VRD(6); SBAR(); GAPA(C1=__builtin_amdgcn_mfma_f32_32x32x16_bf16(kf[5],qr[2],C1,0,0,0),   P1[6],P1[7],P1[8],P1[9],     pw2[2]=PKW(P1,4), pw2[3]=PKW(P1,6), pw2); \
    VRD(3); SBAR(); GAPA(C0=__builtin_amdgcn_mfma_f32_32x32x16_bf16(kf[6],qr[3],C0,0,0,0),   P1[10],P1[11],P1[12],P1[13], pw3[0]=PKW(P1,8), pw3[1]=PKW(P1,10), pw3); \
    VRD(7); SBAR(); GAPA(C1=__builtin_amdgcn_mfma_f32_32x32x16_bf16(kf[7],qr[3],C1,0,0,0),   P1[14],P1[15],0.f,0.f,       pw3[2]=PKW(P1,12),pw3[3]=PKW(P1,14), pw3); \
    l_reg+=sacc; \
    if(GK){DMA_K((t)+3,sl_cur);} if(GV){DMA_V((t)+1,sl_next);} \
    CMASK(C0,C1,t); \
    { float a=MX3(C0[0],C0[1],C1[0]),b=MX3(C0[2],C0[3],C1[1]); a=MX3(a,C1[2],C1[3]); \
      _Pragma("unroll") for(int r=4;r<16;r+=4){a=MX3(a,C0[r],C0[r+1]);b=MX3(b,C0[r+2],C0[r+3]);a=MX3(a,C1[r],C1[r+1]);b=MX3(b,C1[r+2],C1[r+3]);} \
      float rm=__builtin_fmaxf(a,b); { auto rr=__builtin_amdgcn_permlane32_swap(__float_as_uint(rm),__float_as_uint(rm),false,false); rm=__builtin_fmaxf(__uint_as_float(rr[0]),__uint_as_float(rr[1])); } \
      resc=false; \
      const float rel=rm-mhat; \
      if(__builtin_expect(__any(rel>(float)THRL),0)){ const float dl=__builtin_fmaxf(rel,0.f); mhat+=dl; \
        const float f=__builtin_amdgcn_exp2f(-dl); l_reg*=f; if(hi==0)wsf[r32]=f; resc=true; } } \
    SBAR(); \
    GAPB(o[0]=__builtin_amdgcn_mfma_f32_32x32x16_bf16(PAF(0),VFR(0),o[0],0,0,0), C0,0); \
    GAPB(o[1]=__builtin_amdgcn_mfma_f32_32x32x16_bf16(PAF(0),VFR(4),o[1],0,0,0), C0,4); \
    KRD(GL,0); GAPB(o[0]=__builtin_amdgcn_mfma_f32_32x32x16_bf16(PAF(1),VFR(1),o[0],0,0,0), C0,8); \
    KRD(GL,1); GAPB(o[1]=__builtin_amdgcn_mfma_f32_32x32x16_bf16(PAF(1),VFR(5),o[1],0,0,0), C0,12); \
    KRD(GL,2); GAPB(o[0]=__builtin_amdgcn_mfma_f32_32x32x16_bf16(PAF(2),VFR(2),o[0],0,0,0), C1,0); \
    KRD(GL,3); GAPB(o[1]=__builtin_amdgcn_mfma_f32_32x32x16_bf16(PAF(2),VFR(6),o[1],0,0,0), C1,4); \
    GAPB(o[0]=__builtin_amdgcn_mfma_f32_32x32x16_bf16(PAF(3),VFR(3),o[0],0,0,0), C1,8); \
    GAPB(o[1]=__builtin_amdgcn_mfma_f32_32x32x16_bf16(PAF(3),VFR(7),o[1],0,0,0), C1,12); \
    }while(0)
  int t=1;
  #undef CMASK
  #define CMASK(P0,P1,t) do{}while(0)
  for(;t+5<NT;t+=2){
    STEP(pB0,pB1,pA0,pA1,t,true,true,true);     WAIT_BAR(2); RESC(); ROT();
    STEP(pA0,pA1,pB0,pB1,t+1,true,true,true);   WAIT_BAR(2); RESC(); ROT();
  }
  #undef CMASK
  #define CMASK(P0,P1,t) do{int jb_=(t)-(NT-4); if(jb_>=0)cmask(P0,P1,jb_,qrel,hi);}while(0)
  #define ENDW(tt) do{ if((tt)+3<NT){WAIT_BAR(2);} else if((tt)+2<NT){WAIT_BAR(1);} else {WAIT_BAR(0);} }while(0)
  for(;t+1<NT;t+=2){
    STEP(pB0,pB1,pA0,pA1,t,(t+3<NT),(t+1<NT),(t+1<NT));       ENDW(t);   RESC(); ROT();
    STEP(pA0,pA1,pB0,pB1,t+1,(t+4<NT),(t+2<NT),(t+2<NT));     ENDW(t+1); RESC(); ROT();
  }
  STEP(pB0,pB1,pA0,pA1,NT-1,false,false,false); RESC();
  { float sacc=pB0[0]+pB0[1]; _Pragma("unroll") for(int r=2;r<16;++r)sacc+=pB0[r]; _Pragma("unroll") for(int r=0;r<16;++r)sacc+=pB1[r]; l_reg+=sacc;
    pw0=(u32x4){PKW(pB0,0),PKW(pB0,2),PKW(pB0,4),PKW(pB0,6)};pw1=(u32x4){PKW(pB0,8),PKW(pB0,10),PKW(pB0,12),PKW(pB0,14)};pw2=(u32x4){PKW(pB1,0),PKW(pB1,2),PKW(pB1,4),PKW(pB1,6)};pw3=(u32x4){PKW(pB1,8),PKW(pB1,10),PKW(pB1,12),PKW(pB1,14)};
    SBAR(); pv(o,vb0+sl_cur,PAF(0),PAF(1),PAF(2),PAF(3)); }
  #undef PKW
  #undef PAF
  #undef VFR
  #undef PIN
  #undef MX3
  #undef GAPA
  #undef GAPB
  #undef EX
  #undef VRD
  #undef KRD
  #undef STEP
  #undef ENDW
  l_reg+=__uint_as_float((unsigned)__builtin_amdgcn_ds_bpermute((lane^32)<<2,(int)__float_as_uint(l_reg)));
  if(hi==0)wsf[32+r32]=l_reg;asm volatile("s_waitcnt lgkmcnt(0)":::"memory");
  float rli[16];
  #pragma unroll
  for(int r=0;r<16;++r)rli[r]=__builtin_amdgcn_rcpf(wsf[32+crow(r,hi)]);
  bf16*Ow=Oh+(long)(q0+wid*QBLK)*OPITCH;
  { bf16*stg=(bf16*)(shm+LDS_OST)+wid*2048;
    #pragma unroll
    for(int r=0;r<16;++r){const int orow=crow(r,hi);
      #pragma unroll
      for(int d0=0;d0<2;++d0)stg[orow*64+d0*32+r32]=__float2bfloat16(o[d0][r]*rli[r]);}
    asm volatile("s_waitcnt lgkmcnt(0)":::"memory");
    #pragma unroll
    for(int i=0;i<4;++i){const int row=i*8+(lane>>3),ch=lane&7; const u32x4 v=*(const u32x4*)(stg+row*64+ch*8); ATTN_STORE16(Ow+(long)row*OPITCH+ch*8,v);} }
  asm volatile("s_waitcnt lgkmcnt(0)\n\ts_barrier":::"memory");
  #undef DMA_K
  #undef DMA_V
  #undef CMASK
  #undef START
  #undef RESC
  #undef ROT
}

__device__ __forceinline__ float rowmax_cv(const f32x16&p0,const f32x16&p1){
  float a=__builtin_fmaxf(p0[0],p1[0]);
  #pragma unroll
  for(int r=1;r<16;++r){a=__builtin_fmaxf(a,p0[r]);a=__builtin_fmaxf(a,p1[r]);}
  auto rr=__builtin_amdgcn_permlane32_swap(__float_as_uint(a),__float_as_uint(a),false,false);
  return __builtin_fmaxf(__uint_as_float(rr[0]),__uint_as_float(rr[1]));
}
__device__ __forceinline__ void attn_unit_simple(int qb,const bf16*Qh,const bf16*__restrict__ Kh,const bf16*__restrict__ Vh,bf16*Oh,char*shm,const int tid_in){
  const int tid=tid_in,lane=tid&63,r32=lane&31,hi=lane>>5; const int wid=__builtin_amdgcn_readfirstlane(tid>>6);
  const int q0=qb*QB;
  const bf16*Qw=Qh+(long)(q0+wid*QBLK)*DM;
  const unsigned lds0=(unsigned)(uintptr_t)shm;
  float*wsf=(float*)(shm+LDS_WS)+wid*64;
  const bf16*ksrc=Kh+(long)lane*DM+wid*8;
  const bf16*vsrc=Vh+(long)(16*(wid&3)+(lane>>2))*DM+(wid>>2)*32+(lane&3)*8;
  u32x4*kdstp=(u32x4*)(shm+LDS_K+wid*1024+lane*16); u32x4*vdstp=(u32x4*)(shm+LDS_V+wid*1024+lane*16);
  const int vb0=(int)(lds0+LDS_V)+((lane>>4)&1)*32+(lane&3)*8+(4*hi+((lane&15)>>2))*64;
  const char*Kbase=shm+LDS_K;
  const int NT=(q0+QB)/KVBLK;
  bf16x8 qr[4];
  #pragma unroll
  for(int d0=0;d0<4;++d0)qr[d0]=*reinterpret_cast<const bf16x8*>(&Qw[(long)r32*DM+d0*16+hi*8]);
  float m_run=-1e30f,l_reg=0.f; f32x16 o[2]; o[0]=f32x16{}; o[1]=f32x16{};
  const int qrel=wid*QBLK+r32;
  u32x4 kreg=*(const u32x4*)ksrc, vreg=*(const u32x4*)vsrc;
  for(int t=0;t<NT;++t){
    *kdstp=kreg; *vdstp=vreg;
    if(t+1<NT){ kreg=*(const u32x4*)(ksrc+(long)(t+1)*KVBLK*DM); vreg=*(const u32x4*)(vsrc+(long)(t+1)*KVBLK*DM); }
    __syncthreads();
    f32x16 p0,p1;
    qkt(p0,p1,Kbase,qr,r32,hi);
    { const int jb=t-(NT-4); if(jb>=0){ const float NEG=-INFINITY; const int kb=64*jb+4*hi;
        #pragma unroll
        for(int r=0;r<16;++r){const int kv=kb+(r&3)+8*(r>>2); if(kv>qrel)p0[r]=NEG; if(kv+32>qrel)p1[r]=NEG;} } }
    const float rm=rowmax_cv(p0,p1);
    const float mn=__builtin_fmaxf(m_run,rm); const float alpha=__builtin_amdgcn_exp2f(m_run-mn); m_run=mn;
    float sacc=0.f;
    #pragma unroll
    for(int r=0;r<16;++r){p0[r]=__builtin_amdgcn_exp2f(p0[r]-mn);p1[r]=__builtin_amdgcn_exp2f(p1[r]-mn);sacc+=p0[r]+p1[r];}
    l_reg=l_reg*alpha+sacc;
    if(hi==0)wsf[r32]=alpha;
    asm volatile("s_waitcnt lgkmcnt(0)":::"memory");
    #pragma unroll
    for(int d_=0;d_<2;++d_)
      #pragma unroll
      for(int r=0;r<16;++r)o[d_][r]*=wsf[crow(r,hi)];
    u32x4 pw0,pw1,pw2,pw3;
    #define PKW2(P,B) cvtpk_s(P[B],P[B+1])
    pw0=(u32x4){PKW2(p0,0),PKW2(p0,2),PKW2(p0,4),PKW2(p0,6)};pw1=(u32x4){PKW2(p0,8),PKW2(p0,10),PKW2(p0,12),PKW2(p0,14)};
    pw2=(u32x4){PKW2(p1,0),PKW2(p1,2),PKW2(p1,4),PKW2(p1,6)};pw3=(u32x4){PKW2(p1,8),PKW2(p1,10),PKW2(p1,12),PKW2(p1,14)};
    #undef PKW2
    pv(o,vb0,__builtin_bit_cast(bf16x8,pw0),__builtin_bit_cast(bf16x8,pw1),__builtin_bit_cast(bf16x8,pw2),__builtin_bit_cast(bf16x8,pw3));
    asm volatile("s_waitcnt lgkmcnt(0)":::"memory");
    __syncthreads();
  }
  l_reg+=__uint_as_float((unsigned)__builtin_amdgcn_ds_bpermute((lane^32)<<2,(int)__float_as_uint(l_reg)));
  if(hi==0)wsf[32+r32]=l_reg;asm volatile("s_waitcnt lgkmcnt(0)":::"memory");
  float rli[16];
  #pragma unroll
  for(int r=0;r<16;++r)rli[r]=__builtin_amdgcn_rcpf(wsf[32+crow(r,hi)]);
  bf16*Ow=Oh+(long)(q0+wid*QBLK)*OPITCH;
  { bf16*stg=(bf16*)(shm+LDS_OST)+wid*2048;
    #pragma unroll
    for(int r=0;r<16;++r){const int orow=crow(r,hi);
      #pragma unroll
      for(int d0=0;d0<2;++d0)stg[orow*64+d0*32+r32]=__float2bfloat16(o[d0][r]*rli[r]);}
    asm volatile("s_waitcnt lgkmcnt(0)":::"memory");
    #pragma unroll
    for(int i=0;i<4;++i){const int row=i*8+(lane>>3),ch=lane&7; const u32x4 v=*(const u32x4*)(stg+row*64+ch*8); ATTN_STORE16(Ow+(long)row*OPITCH+ch*8,v);} }
  asm volatile("s_waitcnt vmcnt(0) lgkmcnt(0)":::"memory");
  __syncthreads();
}

constexpr int DA_SLOT=32768, DA_V=16384, DA_WS=98304, DA_ROWS=128;
__device__ __forceinline__ f32x16 mfma_c(bf16x8 a_,bf16x8 b_,const f32x16&c_){ f32x16 d_; asm volatile("s_nop 1\n\tv_mfma_f32_32x32x16_bf16 %0, %1, %2, %3":"=&v"(d_):"v"(a_),"v"(b_),"v"(c_)); return d_; }
template<int THRL> __device__ __forceinline__ void dattn_unit(int qblk,const bf16*Qb,const bf16*__restrict__ Kb,const bf16*__restrict__ Vb,bf16*Yb,float lam,const float*gsub,float gscale,char*shm,const int tid_in){
  const int tid=tid_in,lane=tid&63,r32=lane&31,hi=lane>>5; const int wid=__builtin_amdgcn_readfirstlane(tid>>6);
  const int c=wid>>2, rg=wid&3;
  const int q0=qblk*DA_ROWS; const int NT=(q0+DA_ROWS)/KVBLK;
  const bf16*Qw=Qb+c*64+(long)(q0+rg*32)*DM;
  const unsigned lds0=(unsigned)(uintptr_t)shm; const lds_cptr shm3=(lds_cptr)shm;
  float*wsf=(float*)(shm+DA_WS)+wid*64;
  const int pk0=2*wid;
  const bf16*ksrc0=Kb+(pk0>>3)*64+(long)lane*DM+(pk0&7)*8;
  const unsigned kdst0=lds0+(pk0>>3)*8192+(pk0&7)*1024;
  const bf16*vsrc0=Vb+(long)(16*(pk0&3)+(lane>>2))*DM+(pk0>>2)*32+(lane&3)*8;
  const unsigned vdst0=lds0+DA_V+pk0*1024;
  #define DA_RFL(x) ((unsigned)__builtin_amdgcn_readfirstlane((int)(x)))
  #define DA_DMA(t,so) do{ const long to_=(long)(t)*KVBLK*DM; \
      glds16(ksrc0+to_,DA_RFL(kdst0+(so))); glds16(ksrc0+to_+8,DA_RFL(kdst0+(so)+1024)); \
      glds16(vsrc0+to_,DA_RFL(vdst0+(so))); glds16(vsrc0+to_+16*DM,DA_RFL(vdst0+(so)+1024)); }while(0)
  const lds_cptr kp0=shm3+c*8192+hi*1024+r32*16;
  const lds_cptr vp0=shm3+DA_V+((lane>>4)&1)*32+(lane&3)*8+(4*hi+((lane&15)>>2))*64;
  bf16x8 qr[4];
  #pragma unroll
  DA_DMA(0,0); if(NT>1){ DA_DMA(1,DA_SLOT); }
  #pragma unroll
  for(int d0=0;d0<4;++d0)qr[d0]=*reinterpret_cast<const bf16x8*>(&Qw[(long)r32*DM+d0*16+hi*8]);
  asm volatile("":"+v"(qr[0]),"+v"(qr[1]),"+v"(qr[2]),"+v"(qr[3]));
  float mhat=0.f,l_reg=0.f; f32x16 o[4]; o[0]=f32x16{}; o[1]=f32x16{}; o[2]=f32x16{}; o[3]=f32x16{};
  f32x16 negm;
  #pragma unroll
  for(int r=0;r<16;++r)negm[r]=0.f;
  const int qrel=rg*32+r32;
  int slot=0;
  for(int t=0;t<NT;++t){
    if(t+1<NT){ asm volatile("s_waitcnt vmcnt(4) lgkmcnt(0)\n\ts_barrier":::"memory"); } else { asm volatile("s_waitcnt vmcnt(0) lgkmcnt(0)\n\ts_barrier":::"memory"); }
    if(t+2<NT){ int s2=slot+2*DA_SLOT; if(s2>=3*DA_SLOT)s2-=3*DA_SLOT; DA_DMA(t+2,s2); }
    const lds_cptr kp=kp0+slot;
    f32x16 p0,p1;
    { const bf16x8 k0=*(const __attribute__((address_space(3))) bf16x8*)(kp), k1=*(const __attribute__((address_space(3))) bf16x8*)(kp+512);
      p0=mfma_c(k0,qr[0],negm); p1=mfma_c(k1,qr[0],negm); }
    #pragma unroll
    for(int d0=1;d0<4;++d0){ const bf16x8 k0=*(const __attribute__((address_space(3))) bf16x8*)(kp+d0*2048), k1=*(const __attribute__((address_space(3))) bf16x8*)(kp+d0*2048+512);
      p0=__builtin_amdgcn_mfma_f32_32x32x16_bf16(k0,qr[d0],p0,0,0,0); p1=__builtin_amdgcn_mfma_f32_32x32x16_bf16(k1,qr[d0],p1,0,0,0); }
    { const int jb=t-(NT-2); if(jb>=0){ const float NEG=-INFINITY; const int kb=64*jb+4*hi;
        #pragma unroll
        for(int r=0;r<16;++r){const int kv=kb+(r&3)+8*(r>>2); if(kv>qrel)p0[r]=NEG; if(kv+32>qrel)p1[r]=NEG;} } }
    float rm=__builtin_fmaxf(p0[0],p1[0]);
    #pragma unroll
    for(int r=1;r<16;++r){rm=__builtin_fmaxf(rm,p0[r]);rm=__builtin_fmaxf(rm,p1[r]);}
    rm=__builtin_fmaxf(rm,__uint_as_float((unsigned)__builtin_amdgcn_ds_bpermute((lane^32)<<2,(int)__float_as_uint(rm))));
    if(t==0){
      mhat=rm;
      #pragma unroll
      for(int r=0;r<16;++r){p0[r]-=rm;p1[r]-=rm;negm[r]=-rm;}
    } else if(__any(rm>(float)THRL)){
      const float dl=__builtin_fmaxf(rm,0.f); const float f=__builtin_amdgcn_exp2f(-dl); mhat+=dl; l_reg*=f;
      #pragma unroll
      for(int r=0;r<16;++r){p0[r]-=dl;p1[r]-=dl;negm[r]=-mhat;}
      if(hi==0)wsf[r32]=f;
      asm volatile("s_waitcnt lgkmcnt(0)":::"memory");
      #pragma unroll
      for(int d_=0;d_<4;++d_)
        #pragma unroll
        for(int r=0;r<16;++r)o[d_][r]*=wsf[crow(r,hi)];
    }
    float sacc=0.f;
    #pragma unroll
    for(int r=0;r<16;++r){p0[r]=__builtin_amdgcn_exp2f(p0[r]);p1[r]=__builtin_amdgcn_exp2f(p1[r]);sacc+=p0[r]+p1[r];}
    l_reg+=sacc;
    u32x4 pw0,pw1,pw2,pw3;
    pw0=(u32x4){cvtpk_s(p0[0],p0[1]),cvtpk_s(p0[2],p0[3]),cvtpk_s(p0[4],p0[5]),cvtpk_s(p0[6],p0[7])}; pw1=(u32x4){cvtpk_s(p0[8],p0[9]),cvtpk_s(p0[10],p0[11]),cvtpk_s(p0[12],p0[13]),cvtpk_s(p0[14],p0[15])};
    pw2=(u32x4){cvtpk_s(p1[0],p1[1]),cvtpk_s(p1[2],p1[3]),cvtpk_s(p1[4],p1[5]),cvtpk_s(p1[6],p1[7])}; pw3=(u32x4){cvtpk_s(p1[8],p1[9]),cvtpk_s(p1[10],p1[11]),cvtpk_s(p1[12],p1[13]),cvtpk_s(p1[14],p1[15])};
    const lds_cptr vp=vp0+slot;
    #pragma unroll
    for(int d0=0;d0<4;++d0){
      #define DA_VF(ks) ({ const s16x4 lo_=vtr(vp+d0*4096+(ks)*1024), hi_=vtr(vp+d0*4096+(ks)*1024+512); (bf16x8){lo_[0],lo_[1],lo_[2],lo_[3],hi_[0],hi_[1],hi_[2],hi_[3]}; })
      o[d0]=__builtin_amdgcn_mfma_f32_32x32x16_bf16(__builtin_bit_cast(bf16x8,pw0),DA_VF(0),o[d0],0,0,0);
      o[d0]=__builtin_amdgcn_mfma_f32_32x32x16_bf16(__builtin_bit_cast(bf16x8,pw1),DA_VF(1),o[d0],0,0,0);
      o[d0]=__builtin_amdgcn_mfma_f32_32x32x16_bf16(__builtin_bit_cast(bf16x8,pw2),DA_VF(2),o[d0],0,0,0);
      o[d0]=__builtin_amdgcn_mfma_f32_32x32x16_bf16(__builtin_bit_cast(bf16x8,pw3),DA_VF(3),o[d0],0,0,0);
      #undef DA_VF
    }
    slot+=DA_SLOT; if(slot>=3*DA_SLOT)slot=0;
  }
  int lane_e=lane; asm volatile("":"+v"(lane_e)); const int r32e=lane_e&31, hie=lane_e>>5;
  l_reg+=__uint_as_float((unsigned)__builtin_amdgcn_ds_bpermute((lane^32)<<2,(int)__float_as_uint(l_reg)));
  asm volatile("s_waitcnt vmcnt(0) lgkmcnt(0)\n\ts_barrier":::"memory");
  if(hie==0)wsf[32+r32e]=l_reg; asm volatile("s_waitcnt lgkmcnt(0)":::"memory");
  float rli[16];
  #pragma unroll
  for(int r=0;r<16;++r)rli[r]=__builtin_amdgcn_rcpf(wsf[32+crow(r,hie)]);
  float*st2=(float*)shm+rg*4096;
  if(c==1){
    #pragma unroll
    for(int d0=0;d0<4;++d0)
      #pragma unroll
      for(int r=0;r<16;++r)st2[crow(r,hie)*128+d0*32+r32e]=lam*o[d0][r]*rli[r];
  }
  asm volatile("s_waitcnt lgkmcnt(0)\n\ts_barrier":::"memory");
  if(c==0){
    float ssq[16];
    #pragma unroll
    for(int r=0;r<16;++r){ float a_=0.f;
      #pragma unroll
      for(int d0=0;d0<4;++d0){ const float x_=o[d0][r]*rli[r]-st2[crow(r,hie)*128+d0*32+r32e]; o[d0][r]=x_; a_+=x_*x_; }
      a_+=__uint_as_float((unsigned)__builtin_amdgcn_ds_swizzle((int)__float_as_uint(a_),(1<<10)|0x1f)); a_+=__uint_as_float((unsigned)__builtin_amdgcn_ds_swizzle((int)__float_as_uint(a_),(2<<10)|0x1f));
      a_+=__uint_as_float((unsigned)__builtin_amdgcn_ds_swizzle((int)__float_as_uint(a_),(4<<10)|0x1f)); a_+=__uint_as_float((unsigned)__builtin_amdgcn_ds_swizzle((int)__float_as_uint(a_),(8<<10)|0x1f));
      a_+=__uint_as_float((unsigned)__builtin_amdgcn_ds_swizzle((int)__float_as_uint(a_),(16<<10)|0x1f));
      ssq[r]=1.0f/__builtin_sqrtf(a_*(1.0f/128.0f)+1e-5f); }
    float g4[4];
    #pragma unroll
    for(int d0=0;d0<4;++d0)g4[d0]=gsub[d0*32+r32e]*gscale;
    bf16*stg=(bf16*)(shm+65536)+rg*4096;
    #pragma unroll
    for(int r=0;r<16;++r)
      #pragma unroll
      for(int d0=0;d0<4;++d0)stg[crow(r,hie)*128+d0*32+r32e]=__float2bfloat16(o[d0][r]*ssq[r]*g4[d0]);
    asm volatile("s_waitcnt lgkmcnt(0)":::"memory");
    bf16*Yw=Yb+(long)(q0+rg*32)*DM;
    #pragma unroll
    for(int i=0;i<8;++i){const int row=i*4+(lane_e>>4),ch=lane_e&15; const u32x4 v=*(const u32x4*)(stg+row*128+ch*8); *(u32x4*)(Yw+(long)row*DM+ch*8)=v;}
  }
  asm volatile("s_waitcnt vmcnt(0) lgkmcnt(0)\n\ts_barrier":::"memory");
  #undef DA_DMA
  #undef DA_RFL
}
constexpr int ATTN_LDS_BYTES=LDS_BYTES;
#undef SBAR
#undef WAIT_BAR
}

#define GAS __attribute__((address_space(1)))
#define LAS __attribute__((address_space(3)))
typedef unsigned short bf16;
typedef unsigned v4u __attribute__((ext_vector_type(4)));
typedef float f32x4 __attribute__((ext_vector_type(4)));
typedef short bf16x8 __attribute__((ext_vector_type(8)));
typedef GAS unsigned gu32;
typedef GAS unsigned long long gu64;
#define RLX_AGENT __ATOMIC_RELAXED, __HIP_MEMORY_SCOPE_AGENT
#define LDS_WAIT() asm volatile("s_waitcnt lgkmcnt(0)" ::: "memory")
#define VM_WAIT() asm volatile("s_waitcnt vmcnt(0)" ::: "memory")
__device__ __forceinline__ unsigned long long rt() { return __builtin_amdgcn_s_memrealtime(); }
__device__ __forceinline__ unsigned f2bf(float f) { unsigned u = __builtin_bit_cast(unsigned, f); return (u + 0x7fffu + ((u >> 16) & 1u)) >> 16; }
__device__ __forceinline__ unsigned pk2(float lo, float hi) { return f2bf(lo) | (f2bf(hi) << 16); }

#define XB_TMO      128
#define XB_XCNT(j)  (256  + 64 * (j))
#define XB_XSUB(j)  (1280 + 64 * (j))
#define XB_XGEN(j)  (2304 + 64 * (j))
#define XB_TOP      3328
#define XB_TOPGEN   3392
#define XCD_BAR_WORDS 3456
#define XB_SPIN_CAP (1u << 26)

__device__ __forceinline__ unsigned xb_ld(unsigned* p)              { return __hip_atomic_load(p, __ATOMIC_RELAXED, __HIP_MEMORY_SCOPE_AGENT); }
__device__ __forceinline__ unsigned xb_add(unsigned* p, unsigned v) { return __hip_atomic_fetch_add(p, v, __ATOMIC_RELAXED, __HIP_MEMORY_SCOPE_AGENT); }
__device__ __forceinline__ unsigned xb_xcc_id() { return (unsigned)__builtin_amdgcn_s_getreg((3 << 11) | 20) & 0xFu; }
#define XB_SPIN(cond, bar) do { unsigned _sp = 0; while (cond) { __builtin_amdgcn_s_sleep(1); \
    if ((++_sp & 255u) == 0u) { if (xb_ld(&(bar)[XB_TMO])) break; if (_sp > XB_SPIN_CAP) { atomicAdd(&(bar)[XB_TMO], 1u); break; } } } } while (0)

struct XcdBarrier {
    unsigned* bar; unsigned x;
    volatile LAS unsigned* st;
};

__device__ __forceinline__ XcdBarrier xcd_barrier_post(unsigned* bar, volatile LAS unsigned* st, const int tid) {
    XcdBarrier b; b.bar = bar; b.x = xb_xcc_id(); b.st = st;
    if (tid == 0) (void)xb_add(&bar[XB_XCNT(b.x)], 1u);
    return b;
}
__device__ __forceinline__ void xcd_barrier_complete(unsigned* bar, unsigned x, unsigned& nloc, unsigned& nx) {
    const unsigned G = gridDim.x * gridDim.y * gridDim.z;
    unsigned sum, cnt, mine, sp = 0u;
    for (;;) {
        sum = 0u; cnt = 0u; mine = 0u;
#pragma unroll
        for (unsigned j = 0; j < 16; ++j) { const unsigned c = xb_ld(&bar[XB_XCNT(j)]); sum += c; cnt += (c > 0u) ? 1u : 0u; mine = (j == x) ? c : mine; }
        if (sum == G) break;
        __builtin_amdgcn_s_sleep(1);
        if ((++sp & 255u) == 0u) { if (xb_ld(&bar[XB_TMO])) break; if (sp > XB_SPIN_CAP) { atomicAdd(&bar[XB_TMO], 1u); break; } }
    }
    nloc = mine > 0u ? mine : 1u; nx = cnt > 0u ? cnt : 1u;
}

__device__ __forceinline__ void xcd_barrier(const XcdBarrier& b, const int tid) {
    asm volatile("s_waitcnt vmcnt(0)" ::: "memory");
    __syncthreads();
    if (tid == 0) {
        unsigned* bar = b.bar;
        __builtin_amdgcn_s_waitcnt(0);
        unsigned nloc = b.st[0], nx = b.st[1];
        if (nloc == 0u) { xcd_barrier_complete(bar, b.x, nloc, nx); b.st[0] = nloc; b.st[1] = nx; }
        const unsigned old = xb_add(&bar[XB_XSUB(b.x)], 1u);
        const unsigned gen = old / nloc;
        if (old + 1u == (gen + 1u) * nloc) {
            __builtin_amdgcn_fence(__ATOMIC_RELEASE, "agent");
            asm volatile("s_waitcnt vmcnt(0)" ::: "memory");
            const unsigned og = xb_add(&bar[XB_TOP], 1u);
            const unsigned tg = og / nx;
            if (og + 1u == (tg + 1u) * nx) xb_add(&bar[XB_TOPGEN], 1u);
            else XB_SPIN(xb_ld(&bar[XB_TOPGEN]) == tg, bar);
            __builtin_amdgcn_fence(__ATOMIC_ACQUIRE, "agent");
            xb_add(&bar[XB_XGEN(b.x)], 1u);
            asm volatile("s_waitcnt vmcnt(0)" ::: "memory");
        } else {
            XB_SPIN(xb_ld(&bar[XB_XGEN(b.x)]) == gen, bar);
            __builtin_amdgcn_fence(__ATOMIC_ACQUIRE, "agent");
            asm volatile("s_waitcnt vmcnt(0)" ::: "memory");
        }
    }
    __syncthreads();
}

constexpr int NWAVES = 8;
constexpr int NTOK = 65536, NH = 32768, DMODEL = 1024, SEQLEN = 4096, INCOLS = 5632, DFF = 2816, NEXP = 8;
constexpr int MOE_PANELS_MAX = 264;
constexpr float EPS_NORM = 1e-6f, EPS_SUBLN = 1e-5f;

constexpr size_t MiB = 1u << 20;
constexpr size_t WS_CTL = 0, CTL_ZERO_BYTES = 1 * MiB;
constexpr size_t WS_WIN = 1 * MiB;
constexpr size_t WS_WGLU = 23 * MiB;
constexpr size_t WS_WPS = 24 * MiB;
constexpr size_t WS_WPA = 26 * MiB;
constexpr size_t WS_WOUT = 30 * MiB;
constexpr size_t WS_WDGU = 34 * MiB;
constexpr size_t WS_WDD = 45 * MiB;
constexpr size_t WS_WMGU = 51 * MiB;
constexpr size_t WS_WMD = 139 * MiB;
constexpr size_t WS_TZF = 183 * MiB;
constexpr size_t WS_EM = 223 * MiB;
constexpr size_t WS_ROPE = 239 * MiB;
constexpr size_t WS_ROUTE = 255 * MiB;
constexpr size_t WS_ACT = 260 * MiB;
constexpr size_t WS_END = 960 * MiB;
constexpr size_t A_HB = 0, A_UBUF = 64 * MiB, A_SLOC = 104 * MiB, A_Q = 120 * MiB, A_K = 184 * MiB, A_V = 248 * MiB, A_SGS = 312 * MiB, A_SGA = 376 * MiB, A_YA = 440 * MiB, A_YA2 = 472 * MiB, A_OV = 504 * MiB, A_YB = 632 * MiB;
constexpr size_t A_H2 = 0, A_FA = 64 * MiB;
constexpr size_t A_H2G = 64 * MiB, A_AG = 196 * MiB, A_YG = 559 * MiB;
static_assert(A_UBUF == pg8::EA_U && A_Q == pg8::EA_Q && A_K == pg8::EA_K && A_V == pg8::EA_V && A_SGS == pg8::EA_SGS && A_SGA == pg8::EA_SGA, "EpiIn offsets");
static_assert(A_YB + 64 * MiB <= WS_END - WS_ACT && A_OV + 128 * MiB <= WS_END - WS_ACT && A_YG + 132 * MiB <= WS_END - WS_ACT, "act map");
constexpr size_t R_E = 0, R_W = 256 * 1024, R_S = 512 * 1024, R_CNT = 768 * 1024;
constexpr int CW_BAR = 4096;

constexpr int RING_OFF = 0, RING_BYTES = 131072;
constexpr int LDSCTL_OFF = RING_BYTES, MISC_OFF = LDSCTL_OFF + 320;
constexpr int LDS_BYTES = 147456;

constexpr int PTR_OFF = LDSCTL_OFF + 1024;
struct Args { const void* in[31]; float* out; unsigned char* ws; };
__device__ __forceinline__ unsigned long long ldp64(LAS unsigned char* L, int slot) {
    const unsigned long long v = ((volatile LAS unsigned long long*)(L + PTR_OFF))[slot];
    const unsigned lo = __builtin_amdgcn_readfirstlane((unsigned)v), hi = __builtin_amdgcn_readfirstlane((unsigned)(v >> 32));
    return ((unsigned long long)hi << 32) | lo;
}
#define LDP(T, slot) ((T*)(GAS T*)(uintptr_t)ldp64(L, (slot)))

#define SWZ_XOR(k) (((k) << 10) | 0x1f)
#define swz_xor(v, pat) __builtin_bit_cast(float, __builtin_amdgcn_ds_swizzle(__builtin_bit_cast(int, (float)(v)), (pat)))
__device__ __forceinline__ float wave_sum(float v) {
    v += swz_xor(v, SWZ_XOR(1)); v += swz_xor(v, SWZ_XOR(2)); v += swz_xor(v, SWZ_XOR(4)); v += swz_xor(v, SWZ_XOR(8)); v += swz_xor(v, SWZ_XOR(16));
    const float lo = __builtin_bit_cast(float, __builtin_amdgcn_readlane(__builtin_bit_cast(int, v), 0));
    const float hi = __builtin_bit_cast(float, __builtin_amdgcn_readlane(__builtin_bit_cast(int, v), 32));
    return lo + hi;
}
__device__ __forceinline__ void tr_item(const float* W, int ldw, int K, bf16* WTn0, int k0, int srccol, LAS float* scr, int lane) {
#pragma unroll 8
    for (int i = 0; i < 32; ++i) { const int kk = 2 * i + (lane >> 5); scr[kk * 33 + (lane & 31)] = W[(size_t)(k0 + kk) * ldw + srccol]; }
    LDS_WAIT(); asm volatile("" ::: "memory");
    const int c = lane & 7;
#pragma unroll
    for (int j = 0; j < 4; ++j) { const int n = (lane >> 3) + 8 * j; const LAS float* s = scr + (8 * c) * 33 + n;
        v4u o; o.x = pk2(s[0 * 33], s[1 * 33]); o.y = pk2(s[2 * 33], s[3 * 33]); o.z = pk2(s[4 * 33], s[5 * 33]); o.w = pk2(s[6 * 33], s[7 * 33]);
        *(GAS v4u*)(WTn0 + (size_t)n * K + k0 + 8 * c) = o; }
    LDS_WAIT(); asm volatile("" ::: "memory");
}
__device__ __forceinline__ int win_orig(int n) { if (n < 512 || n >= 2560) return n; const int i = n & 63; return (n & ~63) + 16 * ((i >> 5) & 1) + 4 * ((i >> 3) & 3) + (i & 3) + 32 * ((i >> 2) & 1); }
__device__ __forceinline__ void tr_plain(const float* W, int K, int N, bf16* WT, int item, LAS float* scr, int lane) {
    const int nblk = N / 32, kb = item / nblk, nb = item % nblk;
    tr_item(W, N, K, WT + (size_t)(32 * nb) * K, 64 * kb, 32 * nb + (lane & 31), scr, lane);
}
__device__ __forceinline__ void tr_win(const float* W, bf16* WT, int item, LAS float* scr, int lane) {
    const int nblk = INCOLS / 32, kb = item / nblk, nb = item % nblk;
    tr_item(W, INCOLS, DMODEL, WT + (size_t)(32 * nb) * DMODEL, 64 * kb, win_orig(32 * nb + (lane & 31)), scr, lane);
}
__device__ __forceinline__ void tr_gu(const float* Wg, const float* Wu, bf16* WT, int item, LAS float* scr, int lane) {
    const int nblk = INCOLS / 32, kb = item / nblk, nb = item % nblk; const int n0 = 32 * nb, pn = n0 >> 8, r = n0 & 255;
    const float* W = r < 128 ? Wg : Wu; const int col = pn * 128 + (r & 127) + (lane & 31);
    tr_item(W, DFF, DMODEL, WT + (size_t)n0 * DMODEL, 64 * kb, col, scr, lane);
}
struct S5In { const float *lam_re, *lam_im, *log_dt, *b_re, *b_im, *c_re, *c_im, *dd; };
__device__ __forceinline__ v4u pack8f(const float* v) { v4u o; o.x = pk2(v[0], v[1]); o.y = pk2(v[2], v[3]); o.z = pk2(v[4], v[5]); o.w = pk2(v[6], v[7]); return o; }
__device__ __forceinline__ void s5_item(LAS unsigned char* L, int tid, const S5In& P, int lg, int d, bf16* TZF, bf16* EM) {
    LAS float* sm = (LAS float*)(L);
    LAS float *s_fr = sm, *s_fi = sm + 64, *s_apr = sm + 128, *s_api = sm + 192, *BBr = sm + 256, *BBi = sm + 1280, *CAr = sm + 2304, *CAi = sm + 3328, *Kd = sm + 4352;
    if (tid < 64) {
        const int p = tid;
        const float dt = expf(P.log_dt[lg]);
        const float lr = P.lam_re[lg * 64 + p], li = P.lam_im[lg * 64 + p];
        const float mag = expf(lr * dt); float sn, cs; sincosf(li * dt, &sn, &cs);
        const float ar = mag * cs, ai = mag * sn;
        const float den = lr * lr + li * li, nr = ar - 1.0f, ni = ai;
        s_fr[p] = (nr * lr + ni * li) / den; s_fi[p] = (ni * lr - nr * li) / den;
        const float fd = (float)d; const float magd = expf(fd * lr * dt); float snd, csd; sincosf(fd * li * dt, &snd, &csd);
        s_apr[p] = magd * csd; s_api[p] = magd * snd;
    }
    __syncthreads();
    for (int idx = tid; idx < 1024; idx += 512) {
        { const int p = idx >> 4; const float br = P.b_re[(size_t)lg * 1024 + idx], bi = P.b_im[(size_t)lg * 1024 + idx]; const float fr_ = s_fr[p], fi_ = s_fi[p];
          BBr[idx] = fr_ * br - fi_ * bi; BBi[idx] = fr_ * bi + fi_ * br; }
        { const int p = idx & 63; const float cr = P.c_re[(size_t)lg * 1024 + idx], ci = P.c_im[(size_t)lg * 1024 + idx]; const float ar_ = s_apr[p], ai_ = s_api[p];
          CAr[idx] = cr * ar_ - ci * ai_; CAi[idx] = cr * ai_ + ci * ar_; }
    }
    __syncthreads();
    if (d <= 31 && tid < 256) { const int j = tid >> 4, jp = tid & 15; float acc = 0.f;
        for (int p = 0; p < 64; ++p) acc += CAr[j * 64 + p] * BBr[p * 16 + jp] - CAi[j * 64 + p] * BBi[p * 16 + jp];
        if (d == 0 && j == jp) acc += P.dd[lg * 16 + j];
        Kd[tid] = acc; }
    __syncthreads();
    bf16* TZ = TZF + (size_t)lg * 512 * 640; bf16* EE = EM + (size_t)lg * 256 * 512;
    if (d <= 31) {
        const int cnt = (32 - d) * 16;
        for (int idx = tid; idx < cnt; idx += 512) { const int tt = idx >> 4, j = idx & 15; float v[16];
#pragma unroll
            for (int q = 0; q < 16; ++q) v[q] = Kd[j * 16 + q];
            bf16* dst = TZ + (size_t)((d + tt) * 16 + j) * 640 + tt * 16;
            *(GAS v4u*)dst = pack8f(v); *(GAS v4u*)(dst + 8) = pack8f(v + 8);
            if (d >= 1) { bf16* dz = TZ + (size_t)(tt * 16 + j) * 640 + (d + tt) * 16; const v4u z = {0u, 0u, 0u, 0u}; *(GAS v4u*)dz = z; *(GAS v4u*)(dz + 8) = z; } }
        if (tid < 128) { const int ri = tid >> 6, p = tid & 63; const float ar_ = s_apr[p], ai_ = s_api[p]; float v[16];
#pragma unroll
            for (int q = 0; q < 16; ++q) { const float br = BBr[p * 16 + q], bi = BBi[p * 16 + q]; v[q] = ri == 0 ? (ar_ * br - ai_ * bi) : (ar_ * bi + ai_ * br); }
            bf16* dst = EE + (size_t)tid * 512 + (31 - d) * 16; *(GAS v4u*)dst = pack8f(v); *(GAS v4u*)(dst + 8) = pack8f(v + 8);
        } else if (tid < 256) { bf16* dz = EE + (size_t)tid * 512 + (31 - d) * 16; const v4u z = {0u, 0u, 0u, 0u}; *(GAS v4u*)dz = z; *(GAS v4u*)(dz + 8) = z; }
    }
    if (d >= 1 && tid < 256) { const int j = tid >> 4, ri = (tid >> 3) & 1, pc = tid & 7; float v[8];
#pragma unroll
        for (int q = 0; q < 8; ++q) v[q] = ri == 0 ? CAr[j * 64 + pc * 8 + q] : -CAi[j * 64 + pc * 8 + q];
        *(GAS v4u*)(TZ + (size_t)((d - 1) * 16 + j) * 640 + 512 + ri * 64 + pc * 8) = pack8f(v); }
    __syncthreads();
}
__device__ __forceinline__ void norm_row(const float* xrow, const float* gain, bf16* orow, int lane, f32x4 (&hn)[4]) {
    const GAS f32x4* xr = (const GAS f32x4*)xrow + lane; const GAS f32x4* gr = (const GAS f32x4*)gain + lane;
    float s2 = 0.f;
#pragma unroll
    for (int j = 0; j < 4; ++j) { hn[j] = xr[64 * j]; s2 += (hn[j].x * hn[j].x + hn[j].y * hn[j].y) + (hn[j].z * hn[j].z + hn[j].w * hn[j].w); }
    const float rs = 1.0f / sqrtf(wave_sum(s2) * (1.0f / DMODEL) + EPS_NORM);
    GAS unsigned long long* o8 = (GAS unsigned long long*)orow + lane;
#pragma unroll
    for (int j = 0; j < 4; ++j) { const f32x4 g = gr[64 * j]; hn[j] = hn[j] * rs * g;
        o8[64 * j] = (unsigned long long)pk2(hn[j].x, hn[j].y) | ((unsigned long long)pk2(hn[j].z, hn[j].w) << 32); }
}

__global__ void __launch_bounds__(NWAVES * 64, 2) trunk_fwd(Args args) {
    extern __shared__ __attribute__((aligned(16))) unsigned char lds[];
    const int WAVE = __builtin_amdgcn_readfirstlane((int)threadIdx.x >> 6);
#define MYTID() ({ int l_; asm volatile("v_mbcnt_lo_u32_b32 %0, -1, 0\n\tv_mbcnt_hi_u32_b32 %0, -1, %0" : "=v"(l_)); WAVE * 64 + l_; })
    LAS unsigned char* const L0 = (LAS unsigned char*)lds;
#define OPQ LAS unsigned char* L = L0; asm volatile("" : "+s"(L))
    OPQ;
    {
        const int tid0 = MYTID();
        for (int u = tid0; u < (LDS_BYTES - LDSCTL_OFF) / 4; u += NWAVES * 64) ((LAS unsigned*)(L + LDSCTL_OFF))[u] = 0u;
        __syncthreads();
        if (tid0 == 0) {
#pragma unroll
            for (int k = 0; k < 31; ++k) ((LAS unsigned long long*)(L + PTR_OFF))[k] = (unsigned long long)(uintptr_t)args.in[k];
            ((LAS unsigned long long*)(L + PTR_OFF))[31] = (unsigned long long)(uintptr_t)args.out;
            ((LAS unsigned long long*)(L + PTR_OFF))[32] = (unsigned long long)(uintptr_t)args.ws; }
        __syncthreads();
    }
    { XcdBarrier b0 = xcd_barrier_post((unsigned*)(LDP(unsigned char, 32) + WS_CTL) + CW_BAR, (volatile LAS unsigned*)(L + MISC_OFF) + 8, MYTID()); (void)b0; }
#define GRID_BAR() do { OPQ; XcdBarrier b_; b_.bar = (unsigned*)(LDP(unsigned char, 32) + WS_CTL) + CW_BAR; b_.x = xb_xcc_id(); b_.st = (volatile LAS unsigned*)(L + MISC_OFF) + 8; xcd_barrier(b_, MYTID()); } while (0)
#define LQ() ({ int l_ = l; asm volatile("" : "+s"(l_)); l_; })
#define TID_SETUP OPQ; int wave_ = WAVE; asm volatile("" : "+s"(wave_)); const int wave = wave_; const int tid = MYTID(), lane = tid & 63; const int G = gridDim.x; const int vcu = ((int)blockIdx.x % 8) * (G / 8) + (int)blockIdx.x / 8; const int gw = vcu * NWAVES + wave, NGW = G * NWAVES; (void)lane; (void)gw; (void)NGW; (void)tid
#define WSP(T, off) ((T*)(LDP(unsigned char, 32) + (off)))
#define ACTP(T, off) ((T*)(LDP(unsigned char, 32) + WS_ACT + (off)))

    {
        TID_SETUP;
        LAS float* scr = (LAS float*)(L + RING_OFF + wave * 16384);
        constexpr int I_WIN = 16 * 176, I_GLU = 8 * 16, I_PS = 8 * 32, I_PA = 16 * 32, I_OUT = 16 * 32, I_GU = 16 * 176, I_DN = 44 * 32;
        constexpr int I_LAYER = I_WIN + I_GLU + I_PS + I_PA + I_OUT;
        constexpr int NITEMS = 2 * I_LAYER + I_GU + I_DN + 8 * I_GU + 8 * I_DN;
        for (int it = gw; it < NITEMS; it += NGW) {
            int r = it;
            if (r < 2 * I_LAYER) { const int l = r / I_LAYER; r -= l * I_LAYER;
                if (r < I_WIN) { tr_win(LDP(const float, 3) + (size_t)l * DMODEL * INCOLS, WSP(bf16, WS_WIN) + (size_t)l * INCOLS * DMODEL, r, scr, lane); continue; } r -= I_WIN;
                if (r < I_GLU) { tr_plain(LDP(const float, 12) + (size_t)l * 512 * 512, 512, 512, WSP(bf16, WS_WGLU) + (size_t)l * 512 * 512, r, scr, lane); continue; } r -= I_GLU;
                if (r < I_PS) { tr_plain(LDP(const float, 19) + (size_t)l * 512 * 1024, 512, 1024, WSP(bf16, WS_WPS) + (size_t)l * 1024 * 512, r, scr, lane); continue; } r -= I_PS;
                if (r < I_PA) { tr_plain(LDP(const float, 20) + (size_t)l * 1024 * 1024, 1024, 1024, WSP(bf16, WS_WPA) + (size_t)l * 1024 * 1024, r, scr, lane); continue; } r -= I_PA;
                tr_plain(LDP(const float, 21) + (size_t)l * 1024 * 1024, 1024, 1024, WSP(bf16, WS_WOUT) + (size_t)l * 1024 * 1024, r, scr, lane); continue; }
            r -= 2 * I_LAYER;
            if (r < I_GU) { tr_gu(LDP(const float, 23), LDP(const float, 24), WSP(bf16, WS_WDGU), r, scr, lane); continue; } r -= I_GU;
            if (r < I_DN) { tr_plain(LDP(const float, 25), DFF, DMODEL, WSP(bf16, WS_WDD), r, scr, lane); continue; } r -= I_DN;
            if (r < 8 * I_GU) { const int e = r / I_GU; r -= e * I_GU; tr_gu(LDP(const float, 27) + (size_t)e * DMODEL * DFF, LDP(const float, 28) + (size_t)e * DMODEL * DFF, WSP(bf16, WS_WMGU) + (size_t)e * INCOLS * DMODEL, r, scr, lane); continue; } r -= 8 * I_GU;
            { const int e = r / I_DN; r -= e * I_DN; tr_plain(LDP(const float, 29) + (size_t)e * DFF * DMODEL, DFF, DMODEL, WSP(bf16, WS_WMD) + (size_t)e * DMODEL * DFF, r, scr, lane); }
        }
        __syncthreads();
        { S5In s5p; s5p.lam_re = LDP(const float, 4); s5p.lam_im = LDP(const float, 5); s5p.log_dt = LDP(const float, 6); s5p.b_re = LDP(const float, 7); s5p.b_im = LDP(const float, 8);
          s5p.c_re = LDP(const float, 9); s5p.c_im = LDP(const float, 10); s5p.dd = LDP(const float, 11);
          for (int it = vcu; it < 2 * 32 * 33; it += G) s5_item(L, tid, s5p, it / 33, it % 33, WSP(bf16, WS_TZF), WSP(bf16, WS_EM)); }
        { const int* positions = LDP(const int, 1); float* ROPE = WSP(float, WS_ROPE);
          for (int idx = vcu * (NWAVES * 64) + tid; idx < NTOK * 32; idx += G * NWAVES * 64) { const int n = idx >> 5, fi = idx & 31;
            const float invf = powf(10000.0f, -(float)(2 * fi) / 64.0f); const float ang = (float)positions[n] * invf; float sn, cs; sincosf(ang, &sn, &cs);
            ROPE[(size_t)n * 64 + fi] = cs; ROPE[(size_t)n * 64 + 32 + fi] = sn; } }
    }
    GRID_BAR();

    for (int l = 0; l < 2; ++l) {
        for (int half = 0; half < 2; ++half) {
            const int tokbase = half * NH;
            { TID_SETUP; const float* xsrc = LDP(const float, (LQ() == 0) ? 0 : 31); const float* gain = LDP(const float, 2) + l * DMODEL; bf16* HB = ACTP(bf16, A_HB);
              for (int m = gw; m < NH; m += NGW) { f32x4 hn[4]; norm_row(xsrc + (size_t)(tokbase + m) * DMODEL, gain, HB + (size_t)m * DMODEL, lane, hn); } }
            GRID_BAR();
            { OPQ; pg8::Gemm g{ACTP(bf16, A_HB), WSP(bf16, WS_WIN) + (size_t)l * INCOLS * DMODEL, DMODEL, DMODEL, DMODEL}; pg8::SchedPlain S; S.init(NH / 256, INCOLS / 256, gridDim.x, (int)blockIdx.x);
              pg8::EpiIn E{ACTP(unsigned char, 0), WSP(const float, WS_ROPE), tokbase};
              pg8::gemm_phase<pg8::EpiIn, pg8::SchedPlain, true, true>(L0 + RING_OFF, g, S, E, MYTID()); }
            GRID_BAR();
            { OPQ; pg8::Gemm g{ACTP(bf16, A_UBUF), WSP(bf16, WS_EM) + (size_t)l * 32 * 256 * 512, 640, 512, 512}; pg8::SchedS5 S; S.init(1, gridDim.x, (int)blockIdx.x);
              pg8::EpiSloc E{ACTP(float, A_SLOC)};
              pg8::gemm_phase<pg8::EpiSloc, pg8::SchedS5, true, true>(L0 + RING_OFF, g, S, E, MYTID()); }
            GRID_BAR();
            { TID_SETUP;
              if (wave == 0) {
                const int id = vcu * 64 + lane;
                if (id < 8 * 32 * 64) { const int bl = id >> 11, g = (id >> 6) & 31, p = id & 63; const int lg = l * 32 + g;
                    const float dt = expf(LDP(const float, 6)[lg]); const float lr = LDP(const float, 4)[lg * 64 + p], li = LDP(const float, 5)[lg * 64 + p];
                    const float magT = expf(32.0f * lr * dt); float snT, csT; sincosf(32.0f * li * dt, &snT, &csT); const float aTr = magT * csT, aTi = magT * snT;
                    float sr = 0.f, si = 0.f; const size_t row0 = (size_t)g * 1024 + (size_t)bl * 128;
                    const float* sl = ACTP(const float, A_SLOC) + row0 * 128 + p; bf16* ub = ACTP(bf16, A_UBUF) + row0 * 640 + 512 + p;
                    for (int c0 = 0; c0 < 128; c0 += 8) { float lr_[8], li_[8];
#pragma unroll
                        for (int q = 0; q < 8; ++q) { lr_[q] = sl[(size_t)(c0 + q) * 128]; li_[q] = sl[(size_t)(c0 + q) * 128 + 64]; }
#pragma unroll
                        for (int q = 0; q < 8; ++q) { ub[(size_t)(c0 + q) * 640] = (bf16)f2bf(sr); ub[(size_t)(c0 + q) * 640 + 64] = (bf16)f2bf(si);
                            const float nr_ = aTr * sr - aTi * si + lr_[q], ni_ = aTr * si + aTi * sr + li_[q]; sr = nr_; si = ni_; } } }
              } }
            GRID_BAR();
            { OPQ; pg8::Gemm g{ACTP(bf16, A_UBUF), WSP(bf16, WS_TZF) + (size_t)l * 32 * 512 * 640, 640, 640, 640}; pg8::SchedS5 S; S.init(2, gridDim.x, (int)blockIdx.x);
              pg8::EpiYa E{ACTP(bf16, A_YA)};
              pg8::gemm_phase<pg8::EpiYa, pg8::SchedS5, true, true>(L0 + RING_OFF, g, S, E, MYTID()); }
            GRID_BAR();
            { OPQ; pg8::Gemm g{ACTP(bf16, A_YA), WSP(bf16, WS_WGLU) + (size_t)l * 512 * 512, 512, 512, 512}; pg8::SchedPlain S; S.init(NH / 256, 2, gridDim.x, (int)blockIdx.x);
              pg8::EpiGlu E{ACTP(bf16, A_YA), ACTP(bf16, A_YA2), LDP(const float, 13) + l * 512};
              pg8::gemm_phase<pg8::EpiGlu, pg8::SchedPlain, true, true>(L0 + RING_OFF, g, S, E, MYTID()); }
            GRID_BAR();
            {
                TID_SETUP;
                int lq = l; asm volatile("" : "+s"(lq));
                const float lam_init = 0.8f - 0.6f * expf(-0.3f * (float)lq);
                const float p1 = wave_sum(LDP(const float, 14)[lq * 64 + lane] * LDP(const float, 15)[lq * 64 + lane]), p2 = wave_sum(LDP(const float, 16)[lq * 64 + lane] * LDP(const float, 17)[lq * 64 + lane]);
                float lam_v = expf(p1) - expf(p2) + lam_init, gsc_v = 1.0f - lam_init; asm volatile("" : "+v"(lam_v), "+v"(gsc_v));
                const int lam_i = __builtin_amdgcn_readfirstlane(__builtin_bit_cast(int, lam_v)), gsc_i = __builtin_amdgcn_readfirstlane(__builtin_bit_cast(int, gsc_v));
                const float lam = __builtin_bit_cast(float, lam_i), gsc = __builtin_bit_cast(float, gsc_i);
                for (int i = 0; i < 8; ++i) {
                    OPQ; const int bh = (i >> 1) * 16 + (vcu >> 4); const int j = vcu & 15; const int qblk = (i & 1) ? 31 - j : j;
                    const int b = bh >> 3, h = bh & 7; const size_t rb = (size_t)b * SEQLEN;
                    attn_body::dattn_unit<8>(qblk, (const attn_body::bf16*)(ACTP(bf16, A_Q) + rb * 1024 + h * 128), (const attn_body::bf16*)(ACTP(bf16, A_K) + rb * 1024 + h * 128),
                                             (const attn_body::bf16*)(ACTP(bf16, A_V) + rb * 1024 + h * 128), (attn_body::bf16*)(ACTP(bf16, A_YB) + rb * 1024 + h * 128),
                                             lam, LDP(const float, 18) + lq * 128, gsc, (char*)lds + RING_OFF, MYTID());
                }
            }
            GRID_BAR();
            { OPQ; pg8::Gemm g{ACTP(bf16, A_YA2), WSP(bf16, WS_WPS) + (size_t)l * 1024 * 512, 512, 512, 512}; pg8::SchedPlain S; S.init(NH / 256, 4, gridDim.x, (int)blockIdx.x);
              pg8::EpiGate<0> E{ACTP(bf16, A_SGS), nullptr};
              pg8::gemm_phase<pg8::EpiGate<0>, pg8::SchedPlain, true, true>(L0 + RING_OFF, g, S, E, MYTID()); }
            GRID_BAR();
            { OPQ; pg8::Gemm g{ACTP(bf16, A_YB), WSP(bf16, WS_WPA) + (size_t)l * 1024 * 1024, 1024, 1024, 1024}; pg8::SchedPlain S; S.init(NH / 256, 4, gridDim.x, (int)blockIdx.x);
              pg8::EpiGate<1> E{ACTP(bf16, A_SGA), ACTP(bf16, A_SGS)};
              pg8::gemm_phase<pg8::EpiGate<1>, pg8::SchedPlain, true, true>(L0 + RING_OFF, g, S, E, MYTID()); }
            GRID_BAR();
            { OPQ; pg8::Gemm g{ACTP(bf16, A_SGA), WSP(bf16, WS_WOUT) + (size_t)l * 1024 * 1024, 1024, 1024, 1024}; pg8::SchedPlain S; S.init(NH / 256, 4, gridDim.x, (int)blockIdx.x);
              pg8::EpiRes E{LDP(const float, (LQ() == 0) ? 0 : 31), LDP(float, 31), tokbase};
              pg8::gemm_phase<pg8::EpiRes, pg8::SchedPlain, true, true>(L0 + RING_OFF, g, S, E, MYTID()); }
            GRID_BAR();
            if (LQ() == 0) {
                { TID_SETUP; const float* xs = LDP(const float, 31); const float* gain = LDP(const float, 22); bf16* H2 = ACTP(bf16, A_H2);
                  for (int m = gw; m < NH; m += NGW) { f32x4 hn[4]; norm_row(xs + (size_t)(tokbase + m) * DMODEL, gain, H2 + (size_t)m * DMODEL, lane, hn); } }
                GRID_BAR();
                { OPQ; pg8::Gemm g{ACTP(bf16, A_H2), WSP(bf16, WS_WDGU), 1024, 1024, 1024}; pg8::SchedPlain S; S.init(NH / 256, 22, gridDim.x, (int)blockIdx.x);
                  pg8::EpiSwi E{ACTP(bf16, A_FA)};
                  pg8::gemm_phase<pg8::EpiSwi, pg8::SchedPlain, true, true>(L0 + RING_OFF, g, S, E, MYTID()); }
                GRID_BAR();
                { OPQ; pg8::Gemm g{ACTP(bf16, A_FA), WSP(bf16, WS_WDD), 2816, 2816, 2816}; pg8::SchedPlain S; S.init(NH / 256, 4, gridDim.x, (int)blockIdx.x);
                  pg8::EpiRes E{LDP(const float, 31), LDP(float, 31), tokbase};
                  pg8::gemm_phase<pg8::EpiRes, pg8::SchedPlain, true, true>(L0 + RING_OFF, g, S, E, MYTID()); }
                GRID_BAR();
            } else {
                {
                    TID_SETUP;
                    LAS float* rwT = (LAS float*)(L);
                    LAS unsigned* cntL = (LAS unsigned*)(L + 32768);
                    { const float* router_w = LDP(const float, 26); for (int idx = tid; idx < 8192; idx += NWAVES * 64) { const int k = idx >> 3, e = idx & 7; rwT[e * 1024 + k] = router_w[idx]; } }
                    if (tid < 8) cntL[tid] = 0u;
                    __syncthreads();
                    const float* xs = LDP(const float, 31); const float* gain = LDP(const float, 22) + DMODEL; bf16* H2 = ACTP(bf16, A_H2);
                    unsigned* RT_E = WSP(unsigned, WS_ROUTE + R_E); float* RT_W = WSP(float, WS_ROUTE + R_W);
                    for (int i = 0; i < 16; ++i) { const int row = vcu * 128 + wave * 16 + i;
                        f32x4 hn[4]; norm_row(xs + (size_t)(tokbase + row) * DMODEL, gain, H2 + (size_t)row * DMODEL, lane, hn);
                        float lg[8];
#pragma unroll
                        for (int e = 0; e < 8; ++e) { float a = 0.f;
#pragma unroll
                            for (int j = 0; j < 4; ++j) { const f32x4 w = *(const LAS f32x4*)(rwT + e * 1024 + 4 * lane + 256 * j); a += (hn[j].x * w.x + hn[j].y * w.y) + (hn[j].z * w.z + hn[j].w * w.w); }
                            lg[e] = wave_sum(a); }
                        if (lane == 0) { int e1 = 0; float v1 = lg[0];
#pragma unroll
                            for (int e = 1; e < 8; ++e) if (lg[e] > v1) { v1 = lg[e]; e1 = e; }
                            int e2 = -1; float v2 = -INFINITY;
#pragma unroll
                            for (int e = 0; e < 8; ++e) if (e != e1 && lg[e] > v2) { v2 = lg[e]; e2 = e; }
                            if (e2 < 0) e2 = (e1 == 0) ? 1 : 0;
                            const float ex = expf(v2 - v1); const float w1 = 1.0f / (1.0f + ex), w2 = ex / (1.0f + ex);
                            RT_E[row] = (unsigned)e1 | ((unsigned)e2 << 8); RT_W[2 * row] = w1; RT_W[2 * row + 1] = w2;
                            __hip_atomic_fetch_add(cntL + e1, 1u, __ATOMIC_RELAXED, __HIP_MEMORY_SCOPE_WORKGROUP); __hip_atomic_fetch_add(cntL + e2, 1u, __ATOMIC_RELAXED, __HIP_MEMORY_SCOPE_WORKGROUP); }
                    }
                    __syncthreads();
                    if (tid < 8) WSP(unsigned, WS_ROUTE + R_CNT)[vcu * 8 + tid] = cntL[tid];
                }
                GRID_BAR();
                {
                    TID_SETUP;
                    volatile LAS unsigned* MISC = (volatile LAS unsigned*)(L + MISC_OFF);
                    LAS unsigned* tab = (LAS unsigned*)(L);
                    LAS unsigned* tot = (LAS unsigned*)(L + 8192);
                    LAS unsigned* off = (LAS unsigned*)(L + 8192 + 64);
                    LAS unsigned* wcn = (LAS unsigned*)(L + 8192 + 128);
                    LAS unsigned* slt = (LAS unsigned*)(L + 8192 + 512);
                    const unsigned* RT_CNT = WSP(const unsigned, WS_ROUTE + R_CNT); const unsigned* RT_E = WSP(const unsigned, WS_ROUTE + R_E); int* RT_S = WSP(int, WS_ROUTE + R_S);
                    const bf16* H2 = ACTP(const bf16, A_H2); bf16* H2G = ACTP(bf16, A_H2G);
                    if (tid < 256) { const GAS v4u* src = (const GAS v4u*)(RT_CNT + tid * 8); const v4u a = src[0], b = src[1];
                        tab[tid * 8 + 0] = a.x; tab[tid * 8 + 1] = a.y; tab[tid * 8 + 2] = a.z; tab[tid * 8 + 3] = a.w; tab[tid * 8 + 4] = b.x; tab[tid * 8 + 5] = b.y; tab[tid * 8 + 6] = b.z; tab[tid * 8 + 7] = b.w; }
                    __syncthreads();
                    if (tid < 8) { unsigned t = 0, o = 0; for (int blk = 0; blk < 256; ++blk) { const unsigned c = tab[blk * 8 + tid]; if (blk < vcu) o += c; t += c; } tot[tid] = t; off[tid] = o; }
                    __syncthreads();
                    if (tid == 0) { unsigned sp = 0; for (int e = 0; e < 8; ++e) { MISC[16 + e] = sp; sp += (tot[e] + 255u) >> 8; } MISC[24] = sp; }
                    __syncthreads();
                    int my_e = 0, my_rank = 0;
                    if (tid < 256) { const int row = vcu * 128 + (tid >> 1); const unsigned ee = RT_E[row]; my_e = (tid & 1) ? (int)((ee >> 8) & 255u) : (int)(ee & 255u);
#pragma unroll
                        for (int e = 0; e < 8; ++e) { const unsigned long long mask = __ballot(my_e == e); if (my_e == e) my_rank = __popcll(mask & ((1ull << lane) - 1ull)); if (lane == 0) wcn[wave * 8 + e] = (unsigned)__popcll(mask); } }
                    __syncthreads();
                    if (tid < 256) { unsigned pre = 0; for (int w = 0; w < wave; ++w) pre += wcn[w * 8 + my_e];
                        const unsigned slot = MISC[16 + my_e] * 256u + off[my_e] + pre + (unsigned)my_rank;
                        RT_S[(vcu * 128 + (tid >> 1)) * 2 + (tid & 1)] = (int)slot; slt[tid] = slot; }
                    __syncthreads();
                    for (int i = 0; i < 32; ++i) { const int id = wave * 32 + i; const unsigned slot = slt[id];
                        const GAS v4u* src = (const GAS v4u*)(H2 + (size_t)(vcu * 128 + (id >> 1)) * DMODEL) + lane * 2; GAS v4u* dst = (GAS v4u*)(H2G + (size_t)slot * DMODEL) + lane * 2;
                        const v4u a = src[0], b = src[1]; dst[0] = a; dst[1] = b; }
                    if (vcu < 8) { const unsigned e = (unsigned)vcu; const unsigned r0 = MISC[16 + e] * 256u + tot[e], r1 = MISC[17 + e] * 256u; const v4u z = {0u, 0u, 0u, 0u};
                        for (unsigned r = r0 + (unsigned)wave; r < r1; r += NWAVES) { GAS v4u* dst = (GAS v4u*)(H2G + (size_t)r * DMODEL) + lane * 2; dst[0] = z; dst[1] = z; } }
                }
                GRID_BAR();
#define MOE_SCHED(S, NN) do { volatile LAS unsigned* MISC = (volatile LAS unsigned*)(L + MISC_OFF); S.nn = (NN); \
        S.sp1 = __builtin_amdgcn_readfirstlane((int)MISC[17]); S.sp2 = __builtin_amdgcn_readfirstlane((int)MISC[18]); S.sp3 = __builtin_amdgcn_readfirstlane((int)MISC[19]); S.sp4 = __builtin_amdgcn_readfirstlane((int)MISC[20]); \
        S.sp5 = __builtin_amdgcn_readfirstlane((int)MISC[21]); S.sp6 = __builtin_amdgcn_readfirstlane((int)MISC[22]); S.sp7 = __builtin_amdgcn_readfirstlane((int)MISC[23]); \
        S.so.init(__builtin_amdgcn_readfirstlane((int)MISC[24]), (NN), gridDim.x, (int)blockIdx.x); } while (0)
                { OPQ; pg8::SchedMoe S; MOE_SCHED(S, 22);
                  pg8::Gemm g{ACTP(bf16, A_H2G), WSP(bf16, WS_WMGU), 1024, 1024, 1024}; pg8::EpiSwi E{ACTP(bf16, A_AG)};
                  pg8::gemm_phase<pg8::EpiSwi, pg8::SchedMoe, true, true>(L0 + RING_OFF, g, S, E, MYTID()); }
                GRID_BAR();
                { OPQ; pg8::SchedMoe S; MOE_SCHED(S, 4);
                  pg8::Gemm g{ACTP(bf16, A_AG), WSP(bf16, WS_WMD), 2816, 2816, 2816}; pg8::EpiBf E{ACTP(bf16, A_YG)};
                  pg8::gemm_phase<pg8::EpiBf, pg8::SchedMoe, true, true>(L0 + RING_OFF, g, S, E, MYTID()); }
                GRID_BAR();
                {
                    TID_SETUP;
                    const int* RT_S = WSP(const int, WS_ROUTE + R_S); const float* RT_W = WSP(const float, WS_ROUTE + R_W); float* xo = LDP(float, 31); const bf16* YG = ACTP(const bf16, A_YG);
                    const GAS f32x4* gr = (const GAS f32x4*)LDP(const float, 30) + lane;
                    for (int m = gw; m < NH; m += NGW) {
                        const int s1 = RT_S[2 * m], s2 = RT_S[2 * m + 1]; const float w1 = RT_W[2 * m], w2 = RT_W[2 * m + 1];
                        GAS f32x4* xr = (GAS f32x4*)(xo + (size_t)(tokbase + m) * DMODEL) + lane;
                        const GAS unsigned long long* y1 = (const GAS unsigned long long*)(YG + (size_t)s1 * DMODEL) + lane; const GAS unsigned long long* y2 = (const GAS unsigned long long*)(YG + (size_t)s2 * DMODEL) + lane;
                        f32x4 v[4]; float sq = 0.f;
#pragma unroll
                        for (int j = 0; j < 4; ++j) { const unsigned long long a = y1[64 * j], b = y2[64 * j]; f32x4 xa = xr[64 * j];
                            const unsigned alo = (unsigned)a, ahi = (unsigned)(a >> 32), blo = (unsigned)b, bhi = (unsigned)(b >> 32);
                            xa.x += w1 * __uint_as_float(alo << 16) + w2 * __uint_as_float(blo << 16); xa.y += w1 * __uint_as_float(alo & 0xffff0000u) + w2 * __uint_as_float(blo & 0xffff0000u);
                            xa.z += w1 * __uint_as_float(ahi << 16) + w2 * __uint_as_float(bhi << 16); xa.w += w1 * __uint_as_float(ahi & 0xffff0000u) + w2 * __uint_as_float(bhi & 0xffff0000u);
                            v[j] = xa; sq += (xa.x * xa.x + xa.y * xa.y) + (xa.z * xa.z + xa.w * xa.w); }
                        const float rs = 1.0f / sqrtf(wave_sum(sq) * (1.0f / DMODEL) + EPS_NORM);
#pragma unroll
                        for (int j = 0; j < 4; ++j) xr[64 * j] = v[j] * rs * gr[64 * j];
                    }
                }
                GRID_BAR();
            }
        }
    }
#undef GRID_BAR
#undef TID_SETUP
#undef LQ
#undef MYTID
#undef OPQ
#undef WSP
#undef ACTP
#undef MOE_SCHED
}

extern "C" void kernel_launch(void* const* d_in, const int* in_sizes, int n_in, void* d_out, int out_size, void* d_ws, size_t ws_size, hipStream_t stream) {
    static int grid = 0;
    if (grid == 0) {
        if (n_in != 31 || in_sizes[0] != NTOK * DMODEL || out_size != NTOK * DMODEL || ws_size < WS_END) {
            fprintf(stderr, "kernel_launch: unexpected shapes: n_in %d in0 %d out %d ws %zu (need %zu); nothing launched\n", n_in, n_in > 0 ? in_sizes[0] : -1, out_size, ws_size, (size_t)WS_END); grid = -1; return; }
        int dev = 0, cus = 0, per_cu = 0;
        if (hipGetDevice(&dev) != hipSuccess || hipDeviceGetAttribute(&cus, hipDeviceAttributeMultiprocessorCount, dev) != hipSuccess) { grid = -1; return; }
        if (hipFuncSetAttribute((const void*)trunk_fwd, hipFuncAttributeMaxDynamicSharedMemorySize, LDS_BYTES) != hipSuccess) { fprintf(stderr, "kernel_launch: hipFuncSetAttribute failed\n"); grid = -1; return; }
        if (hipOccupancyMaxActiveBlocksPerMultiprocessor(&per_cu, (const void*)trunk_fwd, NWAVES * 64, LDS_BYTES) != hipSuccess || per_cu < 1)
            fprintf(stderr, "kernel_launch: note: occupancy query reports %d workgroups per CU\n", per_cu);
        (void)hipGetLastError();
        grid = 256;
        if (cus < 256) { fprintf(stderr, "kernel_launch: device has %d CUs, need 256; nothing launched\n", cus); grid = -1; return; }
    }
    if (grid < 0) return;
    if (hipMemsetAsync((char*)d_ws + WS_CTL, 0, CTL_ZERO_BYTES, stream) != hipSuccess) return;
    Args a{};
    for (int i = 0; i < 31; ++i) a.in[i] = d_in[i];
    a.out = (float*)d_out; a.ws = (unsigned char*)d_ws;
    hipLaunchKernelGGL(trunk_fwd, dim3(grid), dim3(NWAVES * 64), LDS_BYTES, stream, a);
}
```

```cpp
#include <hip/hip_runtime.h>
#include <hip/hip_bf16.h>
#include <cstdio>
#include <cstdint>
#include <cmath>
namespace pg8 {
#define PG8_LAS __attribute__((address_space(3)))
typedef unsigned short bf16_t;
typedef short bf16x8 __attribute__((ext_vector_type(8)));
typedef float f32x4 __attribute__((ext_vector_type(4)));
typedef unsigned u32x4 __attribute__((ext_vector_type(4)));
constexpr int BM = 256, BK = 64, HALF = 128, HTB = HALF * BK * 2  , STAGE_BYTES = 8 * HTB, NXCD = 8, WGM = 8;

__host__ __device__ __forceinline__ int lds_byte(int r, int c) { const int st = (r >> 4) * 2 + (c >> 5), rr = r & 15, cc = c & 31, ob = rr * 64 + cc * 2; return st * 1024 + (ob ^ (((ob >> 9) & 1) << 5)); }
__host__ __device__ __forceinline__ void stage_rc(int b, int& R, int& C) { const int st = b / 1024, sb = b % 1024, swz = sb ^ (((sb >> 9) & 1) << 5); R = (st >> 1) * 16 + swz / 64; C = (st & 1) * 32 + (swz % 64) / 2; }
__host__ __device__ __forceinline__ int perm32(int rho) { const int n = rho >> 4, i = rho & 15; return 8 * (i >> 2) + 4 * n + (i & 3); }

struct Unit { int pm, pn; };
struct Gemm { const bf16_t* A; const bf16_t* Bt; int lda, ldb, K; };

struct StaticOrder {
    int nM, nN, nwg, G, c;
    __host__ __device__ void init(int nM_, int nN_, int G_, int c_) { nM = nM_; nN = nN_; nwg = nM * nN; G = G_; c = c_; }
    __host__ __device__ bool next(int i, Unit& u) const {
        const long L = (long)i * G + c; if (L >= nwg) return false;
        int wgid = (int)L; { const int q = nwg / NXCD, r = nwg % NXCD, xcd = wgid % NXCD, off = wgid / NXCD; wgid = (xcd < r ? xcd * (q + 1) : r * (q + 1) + (xcd - r) * q) + off; }
        const int nig = WGM * nN, gid = wgid / nig, fm = gid * WGM, gsz = (nM - fm) < WGM ? (nM - fm) : WGM;
        u.pm = fm + ((wgid % nig) % gsz); u.pn = (wgid % nig) / gsz; return true;
    }
    __device__ __forceinline__ void a_ready(const Unit&) const {}
    __device__ __forceinline__ void done(const Unit&) const {}
};


struct SchedPlain {
    StaticOrder so;
    __device__ __forceinline__ void init(int nM, int nN, int G, int c) { so.init(nM, nN, G, c); }
    __device__ __forceinline__ bool next(int i, Unit& u) const { return so.next(i, u); }
    __device__ __forceinline__ void a_ready(const Unit&) const {}
    __device__ __forceinline__ void done(const Unit&) const {}
};
struct SchedS5 {
    StaticOrder so; int nng;
    __device__ __forceinline__ void init(int nng_, int G, int c) { nng = nng_; so.init(128, nng_, G, c); }
    __device__ __forceinline__ bool next(int i, Unit& u) const { if (!so.next(i, u)) return false; u.pn = (u.pm >> 2) * nng + u.pn; return true; }
    __device__ __forceinline__ void a_ready(const Unit&) const {}
    __device__ __forceinline__ void done(const Unit&) const {}
};
struct SchedMoe {
    StaticOrder so; int nn; int sp1, sp2, sp3, sp4, sp5, sp6, sp7;
    __device__ __forceinline__ bool next(int i, Unit& u) const {
        if (!so.next(i, u)) return false;
        const int pm = u.pm; const int e = (pm >= sp1) + (pm >= sp2) + (pm >= sp3) + (pm >= sp4) + (pm >= sp5) + (pm >= sp6) + (pm >= sp7);
        u.pn = e * nn + u.pn; return true;
    }
    __device__ __forceinline__ void a_ready(const Unit&) const {}
    __device__ __forceinline__ void done(const Unit&) const {}
};

typedef float f32x2c_t __attribute__((ext_vector_type(2))); typedef __bf16 bf16x2c_t __attribute__((ext_vector_type(2)));
__device__ __forceinline__ unsigned cvt_pk_bf16(float lo, float hi) { f32x2c_t v = {lo, hi}; bf16x2c_t b = __builtin_convertvector(v, bf16x2c_t); return __builtin_bit_cast(unsigned, b); }
__device__ __forceinline__ u32x4 pack8(const f32x4 a, const f32x4 b) { u32x4 w; w.x = cvt_pk_bf16(a[0], a[1]); w.y = cvt_pk_bf16(a[2], a[3]); w.z = cvt_pk_bf16(b[0], b[1]); w.w = cvt_pk_bf16(b[2], b[3]); return w; }
__device__ __forceinline__ void unpack8(const u32x4 w, f32x4& a, f32x4& b) {
    a[0] = __uint_as_float(w.x << 16); a[1] = __uint_as_float(w.x & 0xffff0000u); a[2] = __uint_as_float(w.y << 16); a[3] = __uint_as_float(w.y & 0xffff0000u);
    b[0] = __uint_as_float(w.z << 16); b[1] = __uint_as_float(w.z & 0xffff0000u); b[2] = __uint_as_float(w.w << 16); b[3] = __uint_as_float(w.w & 0xffff0000u); }
__device__ __forceinline__ float sigm(float z) { return __builtin_amdgcn_rcpf(1.0f + __builtin_amdgcn_exp2f(-1.4426950408889634f * z)); }
__device__ __forceinline__ f32x4 sigm4(const f32x4 z) { f32x4 r; r[0] = sigm(z[0]); r[1] = sigm(z[1]); r[2] = sigm(z[2]); r[3] = sigm(z[3]); return r; }
__device__ __forceinline__ float gelu_t(float x) { const float u = 1.5957691216057308f * (x + 0.044715f * x * x * x); return x * sigm(u); }
__device__ __forceinline__ f32x4 gelu4(const f32x4 z) { f32x4 r; r[0] = gelu_t(z[0]); r[1] = gelu_t(z[1]); r[2] = gelu_t(z[2]); r[3] = gelu_t(z[3]); return r; }
constexpr size_t EA_U = (size_t)64 << 20, EA_Q = (size_t)120 << 20, EA_K = (size_t)184 << 20, EA_V = (size_t)248 << 20, EA_SGS = (size_t)312 << 20, EA_SGA = (size_t)376 << 20;
constexpr float QSCALE = 0.125f * 1.4426950408889634f;

struct EpiIn {
    static constexpr bool PERM = true, AFTER_DRAIN = false;
    unsigned char* act; const float* rope; int tokbase;
    __device__ __forceinline__ void operator()(const f32x4 (&acc)[2][2][4][2], const Unit& u, int wr, int wc, int fr_in, int fq_in) const {
        int fr = fr_in, fq = fq_in; asm volatile("" : "+v"(fr), "+v"(fq));
        const int pn = u.pn, rowb = u.pm * BM + wr * 64 + fr, cow = wc * 32 + fq * 8;
        if (pn < 2) {
#pragma unroll
            for (int ai = 0; ai < 2; ++ai)
#pragma unroll
                for (int m = 0; m < 4; ++m) { const int row = rowb + ai * HALF + m * 16;
#pragma unroll
                    for (int bj = 0; bj < 2; ++bj) { const int c = pn * 256 + bj * HALF + cow; const int g = c >> 4, jj = c & 15;
                        bf16_t* dst = (bf16_t*)(act + EA_U) + ((size_t)(g * 1024 + (row >> 5)) * 640 + (row & 31) * 16 + jj);
                        *(u32x4*)dst = pack8(acc[ai][bj][m][0], acc[ai][bj][m][1]); } }
        } else if (pn < 10) {
            const bool isq = pn < 6; bf16_t* base = (bf16_t*)(act + (isq ? EA_Q : EA_K)); const int colt = (isq ? pn - 2 : pn - 6) * 256; const float sc = isq ? QSCALE : 1.0f;
            const int dlo = 16 * (wc & 1) + 4 * fq;
#pragma unroll
            for (int ai = 0; ai < 2; ++ai)
#pragma unroll
                for (int m = 0; m < 4; ++m) { const int row = rowb + ai * HALF + m * 16;
                    const float* tr = rope + (size_t)(tokbase + row) * 64 + dlo; const f32x4 cs = *(const f32x4*)tr, sn = *(const f32x4*)(tr + 32);
#pragma unroll
                    for (int bj = 0; bj < 2; ++bj) { const f32x4 v0 = acc[ai][bj][m][0], v1 = acc[ai][bj][m][1];
                        const f32x4 o0 = (v0 * cs - v1 * sn) * sc, o1 = (v1 * cs + v0 * sn) * sc;
                        *(u32x4*)(base + (size_t)row * 1024 + colt + bj * HALF + cow) = pack8(o0, o1); } }
        } else if (pn < 14) {
            const int colt = (pn - 10) * 256;
#pragma unroll
            for (int ai = 0; ai < 2; ++ai)
#pragma unroll
                for (int m = 0; m < 4; ++m) { const int row = rowb + ai * HALF + m * 16;
#pragma unroll
                    for (int bj = 0; bj < 2; ++bj) *(u32x4*)((bf16_t*)(act + EA_V) + (size_t)row * 1024 + colt + bj * HALF + cow) = pack8(acc[ai][bj][m][0], acc[ai][bj][m][1]); }
        } else {
            bf16_t* base = (bf16_t*)(act + (pn < 18 ? EA_SGS : EA_SGA)); const int colt = (pn < 18 ? pn - 14 : pn - 18) * 256;
#pragma unroll
            for (int ai = 0; ai < 2; ++ai)
#pragma unroll
                for (int m = 0; m < 4; ++m) { const int row = rowb + ai * HALF + m * 16;
#pragma unroll
                    for (int bj = 0; bj < 2; ++bj) *(u32x4*)(base + (size_t)row * 1024 + colt + bj * HALF + cow) = pack8(sigm4(acc[ai][bj][m][0]), sigm4(acc[ai][bj][m][1])); }
        }
    }
};
struct EpiSloc {
    static constexpr bool PERM = false, AFTER_DRAIN = false;
    float* S;
    __device__ __forceinline__ void operator()(const f32x4 (&acc)[2][2][4][2], const Unit& u, int wr, int wc, int fr_in, int fq_in) const {
        int fr = fr_in, fq = fq_in; asm volatile("" : "+v"(fr), "+v"(fq));
        const int rowb = u.pm * BM + wr * 64 + fr, col0 = wc * 32 + 4 * fq;
#pragma unroll
        for (int ai = 0; ai < 2; ++ai)
#pragma unroll
            for (int m = 0; m < 4; ++m) { float* rowp = S + (size_t)(rowb + ai * HALF + m * 16) * 128 + col0;
#pragma unroll
                for (int n = 0; n < 2; ++n) *(f32x4*)(rowp + n * 16) = acc[ai][0][m][n]; }
    }
};
struct EpiYa {
    static constexpr bool PERM = true, AFTER_DRAIN = false;
    bf16_t* YA;
    __device__ __forceinline__ void operator()(const f32x4 (&acc)[2][2][4][2], const Unit& u, int wr, int wc, int fr_in, int fq_in) const {
        int fr = fr_in, fq = fq_in; asm volatile("" : "+v"(fr), "+v"(fq));
        const int g = u.pm >> 2, pni = u.pn & 1; const int rowb = (u.pm & 3) * BM + wr * 64 + fr; const int jj = 8 * (fq & 1);
#pragma unroll
        for (int ai = 0; ai < 2; ++ai)
#pragma unroll
            for (int m = 0; m < 4; ++m) { const int R = rowb + ai * HALF + m * 16;
#pragma unroll
                for (int bj = 0; bj < 2; ++bj) { const int t = pni * 16 + bj * 8 + wc * 2 + (fq >> 1);
                    *(u32x4*)(YA + (size_t)(R * 32 + t) * 512 + g * 16 + jj) = pack8(gelu4(acc[ai][bj][m][0]), gelu4(acc[ai][bj][m][1])); } }
    }
};
struct EpiGlu {
    static constexpr bool PERM = true, AFTER_DRAIN = false;
    const bf16_t* YA; bf16_t* O; const float* bias;
    __device__ __forceinline__ void operator()(const f32x4 (&acc)[2][2][4][2], const Unit& u, int wr, int wc, int fr_in, int fq_in) const {
        int fr = fr_in, fq = fq_in; asm volatile("" : "+v"(fr), "+v"(fq));
        const int rowb = u.pm * BM + wr * 64 + fr, col0 = u.pn * BM + wc * 32 + 8 * fq;
        f32x4 bv[2][2];
#pragma unroll
        for (int bj = 0; bj < 2; ++bj)
#pragma unroll
            for (int n = 0; n < 2; ++n) bv[bj][n] = *(const f32x4*)(bias + col0 + bj * HALF + 4 * n);
#pragma unroll
        for (int ai = 0; ai < 2; ++ai)
#pragma unroll
            for (int m = 0; m < 4; ++m) { const size_t off = (size_t)(rowb + ai * HALF + m * 16) * 512 + col0;
#pragma unroll
                for (int bj = 0; bj < 2; ++bj) { f32x4 y0, y1; unpack8(*(const u32x4*)(YA + off + bj * HALF), y0, y1);
                    *(u32x4*)(O + off + bj * HALF) = pack8(y0 * sigm4(acc[ai][bj][m][0] + bv[bj][0]), y1 * sigm4(acc[ai][bj][m][1] + bv[bj][1])); } }
    }
};
template <int MODE> struct EpiGate {
    static constexpr bool PERM = true, AFTER_DRAIN = false;
    bf16_t* G; const bf16_t* T0;
    __device__ __forceinline__ void operator()(const f32x4 (&acc)[2][2][4][2], const Unit& u, int wr, int wc, int fr_in, int fq_in) const {
        int fr = fr_in, fq = fq_in; asm volatile("" : "+v"(fr), "+v"(fq));
        const int rowb = u.pm * BM + wr * 64 + fr, col0 = u.pn * BM + wc * 32 + 8 * fq;
#pragma unroll
        for (int ai = 0; ai < 2; ++ai)
#pragma unroll
            for (int m = 0; m < 4; ++m) { const size_t off = (size_t)(rowb + ai * HALF + m * 16) * 1024 + col0;
#pragma unroll
                for (int bj = 0; bj < 2; ++bj) { f32x4 g0, g1; unpack8(*(const u32x4*)(G + off + bj * HALF), g0, g1);
                    f32x4 o0 = g0 * acc[ai][bj][m][0], o1 = g1 * acc[ai][bj][m][1];
                    if (MODE == 1) { f32x4 t0, t1; unpack8(*(const u32x4*)(T0 + off + bj * HALF), t0, t1); o0 += t0; o1 += t1; }
                    *(u32x4*)(G + off + bj * HALF) = pack8(o0, o1); } }
    }
};
struct EpiRes {
    static constexpr bool PERM = false, AFTER_DRAIN = false;
    const float* xin; float* xout; int tokbase;
    __device__ __forceinline__ void operator()(const f32x4 (&acc)[2][2][4][2], const Unit& u, int wr, int wc, int fr_in, int fq_in) const {
        int fr = fr_in, fq = fq_in; asm volatile("" : "+v"(fr), "+v"(fq));
        const int rowb = tokbase + u.pm * BM + wr * 64 + fr, col0 = u.pn * BM + wc * 32 + 4 * fq;
#pragma unroll
        for (int ai = 0; ai < 2; ++ai)
#pragma unroll
            for (int m = 0; m < 4; ++m) { const size_t off = (size_t)(rowb + ai * HALF + m * 16) * 1024 + col0;
#pragma unroll
                for (int bj = 0; bj < 2; ++bj)
#pragma unroll
                    for (int n = 0; n < 2; ++n) { const f32x4 xi = *(const f32x4*)(xin + off + bj * HALF + n * 16); *(f32x4*)(xout + off + bj * HALF + n * 16) = xi + acc[ai][bj][m][n]; } }
    }
};
struct EpiSwi {
    static constexpr bool PERM = true, AFTER_DRAIN = false;
    bf16_t* O;
    __device__ __forceinline__ void operator()(const f32x4 (&acc)[2][2][4][2], const Unit& u, int wr, int wc, int fr_in, int fq_in) const {
        int fr = fr_in, fq = fq_in; asm volatile("" : "+v"(fr), "+v"(fq));
        const int rowb = u.pm * BM + wr * 64 + fr, col0 = (u.pn % 22) * HALF + wc * 32 + 8 * fq;
#pragma unroll
        for (int ai = 0; ai < 2; ++ai)
#pragma unroll
            for (int m = 0; m < 4; ++m) { const f32x4 g0 = acc[ai][0][m][0], g1 = acc[ai][0][m][1];
                *(u32x4*)(O + (size_t)(rowb + ai * HALF + m * 16) * 2816 + col0) = pack8(g0 * sigm4(g0) * acc[ai][1][m][0], g1 * sigm4(g1) * acc[ai][1][m][1]); }
    }
};
struct EpiBf {
    static constexpr bool PERM = true, AFTER_DRAIN = false;
    bf16_t* O;
    __device__ __forceinline__ void operator()(const f32x4 (&acc)[2][2][4][2], const Unit& u, int wr, int wc, int fr_in, int fq_in) const {
        int fr = fr_in, fq = fq_in; asm volatile("" : "+v"(fr), "+v"(fq));
        const int rowb = u.pm * BM + wr * 64 + fr, col0 = (u.pn & 3) * BM + wc * 32 + 8 * fq;
#pragma unroll
        for (int ai = 0; ai < 2; ++ai)
#pragma unroll
            for (int m = 0; m < 4; ++m)
#pragma unroll
                for (int bj = 0; bj < 2; ++bj) *(u32x4*)(O + (size_t)(rowb + ai * HALF + m * 16) * 1024 + col0 + bj * HALF) = pack8(acc[ai][bj][m][0], acc[ai][bj][m][1]);
    }
};

template <class Epi, class Sched, bool ALIGN_EPI = false, bool SP2 = false>
__device__ __forceinline__ void gemm_phase(PG8_LAS unsigned char* lds, const Gemm g, const Sched& S, const Epi& E, const int tid_in) {
    const int tid = tid_in, wid = __builtin_amdgcn_readfirstlane(tid >> 6), lane = tid & 63, wr = wid >> 2, wc = wid & 3, fr = lane & 15, fq = lane >> 4;
    const int K = g.K, nt = K / BK;
    unsigned voffA[2], voffB[2];
#pragma unroll
    for (int i = 0; i < 2; ++i) { int R, C; stage_rc(tid * 16 + i * 8192, R, C); const int Rb = Epi::PERM ? ((R & ~31) + perm32(R & 31)) : R;
        voffA[i] = (unsigned)(R * g.lda + C) * 2u; voffB[i] = (unsigned)(Rb * g.ldb + C) * 2u; }
    const size_t kstep = (size_t)(BK * 2);
    const size_t hstepA = (size_t)HALF * g.lda * 2, hstepB = (size_t)HALF * g.ldb * 2;
    const size_t tstepA = 2 * hstepA, tstepB = 2 * hstepB;
    const unsigned ldsw = (unsigned)wid * 1024u;
    const int aoff = lds_byte(wr * 64 + fr, fq * 8), boff = lds_byte(wc * 32 + fr, fq * 8);
#define PG8_SA(b, h) (((b) * 2 + (h)) * HTB)
#define PG8_SB(b, h) ((4 + (b) * 2 + (h)) * HTB)
#define PG8_STAGE(bufoff, gbase, voff) do { _Pragma("unroll") for (int _i = 0; _i < 2; ++_i) \
        __builtin_amdgcn_global_load_lds((const unsigned*)((const char*)(gbase) + (voff)[_i]), (PG8_LAS unsigned*)(lds + (bufoff) + ldsw + _i * 8192), 16, 0, 0); } while (0)
#define PG8_LDA(dst, b, h) do { _Pragma("unroll") for (int m = 0; m < 4; ++m) _Pragma("unroll") for (int k = 0; k < 2; ++k) dst[m][k] = *(const PG8_LAS bf16x8*)(lds + PG8_SA(b, h) + aoff + m * 2048 + k * 1024); } while (0)
#define PG8_LDB(dst, b, h) do { _Pragma("unroll") for (int n = 0; n < 2; ++n) _Pragma("unroll") for (int k = 0; k < 2; ++k) dst[n][k] = *(const PG8_LAS bf16x8*)(lds + PG8_SB(b, h) + boff + n * 2048 + k * 1024); } while (0)
#define PG8_MMA(ai, bj, At, Bt) do { __builtin_amdgcn_s_setprio(1); _Pragma("unroll") for (int m = 0; m < 4; ++m) _Pragma("unroll") for (int n = 0; n < 2; ++n) _Pragma("unroll") for (int k = 0; k < 2; ++k) \
        acc[ai][bj][m][n] = __builtin_amdgcn_mfma_f32_16x16x32_bf16(Bt[n][k], At[m][k], acc[ai][bj][m][n], 0, 0, 0); __builtin_amdgcn_s_setprio(0); } while (0)
#define PG8_WAIT_V(n) asm volatile("s_waitcnt vmcnt(" #n ")" ::: "memory")
#define PG8_WAIT_L(n) asm volatile("s_waitcnt lgkmcnt(" #n ")" ::: "memory")
#define PG8_BAR __builtin_amdgcn_s_barrier()
#define PG8_SCHED __builtin_amdgcn_sched_barrier(0)
    Unit cur, nxt; int ui = 0;
    if (!S.next(0, cur)) return;
    f32x4 acc[2][2][4][2];
#pragma unroll
    for (int a = 0; a < 2; ++a)
#pragma unroll
        for (int b = 0; b < 2; ++b)
#pragma unroll
            for (int m = 0; m < 4; ++m)
#pragma unroll
                for (int n = 0; n < 2; ++n) acc[a][b][m][n] = (f32x4){0.f, 0.f, 0.f, 0.f};
    bf16x8 At[4][2], B0[2][2], B1[2][2];
    const char* cA = (const char*)g.A + (size_t)cur.pm * tstepA; const char* cB = (const char*)g.Bt + (size_t)cur.pn * tstepB;
    S.a_ready(cur);
    if constexpr (SP2) {
        PG8_STAGE(PG8_SB(0, 0), cB, voffB); PG8_STAGE(PG8_SB(0, 1), cB + hstepB, voffB); PG8_STAGE(PG8_SA(0, 0), cA, voffA); PG8_STAGE(PG8_SA(0, 1), cA + hstepA, voffA);
        if (wr == 1) PG8_BAR;
        PG8_WAIT_V(2); PG8_BAR;
        PG8_STAGE(PG8_SB(1, 0), cB + kstep, voffB); PG8_STAGE(PG8_SA(1, 0), cA + kstep, voffA); PG8_STAGE(PG8_SB(1, 1), cB + hstepB + kstep, voffB);
        PG8_WAIT_V(6); PG8_BAR;
    } else {
        PG8_STAGE(PG8_SB(0, 0), cB, voffB); PG8_STAGE(PG8_SA(0, 0), cA, voffA); PG8_STAGE(PG8_SB(0, 1), cB + hstepB, voffB); PG8_STAGE(PG8_SA(0, 1), cA + hstepA, voffA);
        if (wr == 1) PG8_BAR;
        PG8_WAIT_V(4); PG8_BAR;
        PG8_STAGE(PG8_SB(1, 0), cB + kstep, voffB); PG8_STAGE(PG8_SA(1, 0), cA + kstep, voffA); PG8_STAGE(PG8_SB(1, 1), cB + hstepB + kstep, voffB);
        PG8_WAIT_V(6); PG8_BAR;
    }
    for (;;) {
        const bool has_next = S.next(ui + 1, nxt);
        const char* nA = has_next ? (const char*)g.A + (size_t)nxt.pm * tstepA : cA; const char* nB = has_next ? (const char*)g.Bt + (size_t)nxt.pn * tstepB : cB;
        for (int t = 0; t < nt; t += 2) {
            const bool last = (t == nt - 2);
            const char* a1 = cA + (size_t)(t + 1) * kstep;
            const char* a2 = last ? nA : cA + (size_t)(t + 2) * kstep; const char* b2 = last ? nB : cB + (size_t)(t + 2) * kstep;
            const char* a3 = a2 + kstep; const char* b3 = b2 + kstep;
            if (last && has_next) S.a_ready(nxt);
            if constexpr (SP2) {
            PG8_LDB(B0, 0, 0); PG8_LDB(B1, 0, 1); PG8_SCHED; PG8_LDA(At, 0, 0); PG8_STAGE(PG8_SA(1, 1), a1 + hstepA, voffA);
            PG8_WAIT_V(8); PG8_WAIT_L(0); PG8_BAR; PG8_MMA(0, 0, At, B0); PG8_MMA(0, 1, At, B1); PG8_BAR; PG8_SCHED;
            PG8_LDA(At, 0, 1); PG8_STAGE(PG8_SB(0, 0), b2, voffB); PG8_STAGE(PG8_SB(0, 1), b2 + hstepB, voffB); PG8_STAGE(PG8_SA(0, 0), a2, voffA);
            PG8_WAIT_V(8); PG8_WAIT_L(0); PG8_BAR; PG8_MMA(1, 0, At, B0); PG8_MMA(1, 1, At, B1); PG8_BAR; PG8_SCHED;
            PG8_LDB(B0, 1, 0); PG8_LDB(B1, 1, 1); PG8_SCHED; PG8_LDA(At, 1, 0); PG8_STAGE(PG8_SA(0, 1), a2 + hstepA, voffA);
            PG8_WAIT_V(8); PG8_WAIT_L(0); PG8_BAR; PG8_MMA(0, 0, At, B0); PG8_MMA(0, 1, At, B1); PG8_BAR; PG8_SCHED;
            PG8_LDA(At, 1, 1); PG8_STAGE(PG8_SB(1, 0), b3, voffB); PG8_STAGE(PG8_SB(1, 1), b3 + hstepB, voffB); PG8_STAGE(PG8_SA(1, 0), a3, voffA);
            PG8_WAIT_V(8); PG8_WAIT_L(0); PG8_BAR; PG8_MMA(1, 0, At, B0); PG8_MMA(1, 1, At, B1); PG8_BAR; PG8_SCHED;
            } else {
            PG8_LDB(B0, 0, 0); PG8_SCHED; PG8_LDA(At, 0, 0); PG8_STAGE(PG8_SA(1, 1), a1 + hstepA, voffA);
            PG8_WAIT_L(8); PG8_BAR; PG8_WAIT_L(0); PG8_MMA(0, 0, At, B0); PG8_BAR; PG8_SCHED;
            PG8_LDB(B1, 0, 1); PG8_STAGE(PG8_SB(0, 0), b2, voffB);
            PG8_BAR; PG8_WAIT_L(0); PG8_MMA(0, 1, At, B1); PG8_BAR;
            PG8_LDA(At, 0, 1); PG8_STAGE(PG8_SA(0, 0), a2, voffA);
            PG8_BAR; PG8_WAIT_L(0); PG8_MMA(1, 0, At, B0); PG8_BAR; PG8_SCHED;
            PG8_STAGE(PG8_SB(0, 1), b2 + hstepB, voffB);
            PG8_WAIT_V(6); PG8_BAR; PG8_MMA(1, 1, At, B1); PG8_BAR;
            PG8_LDB(B0, 1, 0); PG8_SCHED; PG8_LDA(At, 1, 0); PG8_STAGE(PG8_SA(0, 1), a2 + hstepA, voffA);
            PG8_WAIT_L(8); PG8_BAR; PG8_WAIT_L(0); PG8_MMA(0, 0, At, B0); PG8_BAR; PG8_SCHED;
            PG8_LDB(B1, 1, 1); PG8_STAGE(PG8_SB(1, 0), b3, voffB);
            PG8_BAR; PG8_WAIT_L(0); PG8_MMA(0, 1, At, B1); PG8_BAR;
            PG8_LDA(At, 1, 1); PG8_STAGE(PG8_SA(1, 0), a3, voffA);
            PG8_BAR; PG8_WAIT_L(0); PG8_MMA(1, 0, At, B0); PG8_BAR; PG8_SCHED;
            PG8_STAGE(PG8_SB(1, 1), b3 + hstepB, voffB);
            PG8_WAIT_V(6); PG8_BAR; PG8_MMA(1, 1, At, B1); PG8_BAR;
            }
        }
        if constexpr (ALIGN_EPI) { if (wr == 0) PG8_BAR; }
        if constexpr (!Epi::AFTER_DRAIN) { E(acc, cur, wr, wc, fr, fq); S.done(cur); }
        if (!has_next) break;
#pragma unroll
        for (int a = 0; a < 2; ++a)
#pragma unroll
            for (int b = 0; b < 2; ++b)
#pragma unroll
                for (int m = 0; m < 4; ++m)
#pragma unroll
                    for (int n = 0; n < 2; ++n) acc[a][b][m][n] = (f32x4){0.f, 0.f, 0.f, 0.f};
        cur = nxt; cA = nA; cB = nB; ++ui;
        if constexpr (ALIGN_EPI) { if (wr == 1) PG8_BAR; }
    }
    PG8_WAIT_V(0);
    if constexpr (!ALIGN_EPI) { if (wr == 0) PG8_BAR; }
    PG8_BAR;
    if constexpr (Epi::AFTER_DRAIN) { E.fused(acc, cur, wr, wc, fr, fq, lds, wid, lane); S.done(cur); }
#undef PG8_SA
#undef PG8_SB
#undef PG8_STAGE
#undef PG8_LDA
#undef PG8_LDB
#undef PG8_MMA
#undef PG8_WAIT_V
#undef PG8_WAIT_L
#undef PG8_BAR
#undef PG8_SCHED
}
}

#include <hip/hip_bf16.h>
#include <cmath>
namespace attn_body {
using bf16=__hip_bfloat16;
using bf16x8=__attribute__((ext_vector_type(8)))short;
using s16x4=__attribute__((ext_vector_type(4)))short;
using f32x16=__attribute__((ext_vector_type(16)))float;
using u32x4=__attribute__((ext_vector_type(4)))unsigned;
constexpr int SEQ=4096,D=64,DM=1024,OPITCH=2048;
constexpr int NW=8,QBLK=32,QB=QBLK*NW,KVBLK=64,NQB=SEQ/QB;
constexpr int ATTN_PITCH=DM, ATTN_UNIT_ROWS=QB;
__device__ __forceinline__ int crow(int r,int hi){return (r&3)+8*(r>>2)+4*hi;}
#define SBAR() __builtin_amdgcn_sched_barrier(0)
__device__ __forceinline__ void cmask(f32x16&p0,f32x16&p1,int jb,int qrel,int hi){
  const float NEG=-INFINITY; int kb=64*jb+4*hi;
  #pragma unroll
  for(int r=0;r<16;++r){int kv=kb+(r&3)+8*(r>>2); if(kv>qrel)p0[r]=NEG; if(kv+32>qrel)p1[r]=NEG;}
}

constexpr int NSLOT=3, SLOTB=8192;
constexpr int LDS_K=0, LDS_V=NSLOT*SLOTB, LDS_WS=2*NSLOT*SLOTB, LDS_OST=LDS_WS+NW*64*4, LDS_BYTES=LDS_OST+NW*4096;
constexpr float C2=0.125f*1.4426950408889634f;
__device__ __forceinline__ void glds16(const void*gsrc,unsigned lds_dst){unsigned keep;
  asm volatile("s_mov_b32 %0, m0\n\ts_mov_b32 m0, %2\n\ts_nop 0\n\tglobal_load_lds_dwordx4 %1, off\n\ts_mov_b32 m0, %0":"=&s"(keep):"v"(gsrc),"s"(lds_dst):"memory");}
__device__ __forceinline__ float max3f(float a,float b,float c){float r;asm("v_max3_f32 %0, %1, %2, %3":"=v"(r):"v"(a),"v"(b),"v"(c));return r;}
__device__ __forceinline__ float max2f(float a,float b){float r;asm("v_max_f32_e32 %0, %1, %2":"=v"(r):"v"(a),"v"(b));return r;}
__device__ __forceinline__ float fadd_s(float a,float b){float r;asm("v_add_f32_e32 %0, %1, %2":"=v"(r):"v"(a),"v"(b));return r;}
__device__ __forceinline__ float fsub_s(float a,float b){float r;asm("v_sub_f32_e32 %0, %1, %2":"=v"(r):"v"(a),"v"(b));return r;}
typedef float f32x2_t __attribute__((ext_vector_type(2))); typedef __bf16 bf16x2_t __attribute__((ext_vector_type(2)));
__device__ __forceinline__ unsigned cvtpk_s(float lo,float hi){f32x2_t v={lo,hi};bf16x2_t b=__builtin_convertvector(v,bf16x2_t);return __builtin_bit_cast(unsigned,b);}
#define WAIT_BAR(N) asm volatile("s_waitcnt vmcnt(" #N ") lgkmcnt(0)\n\ts_barrier":::"memory")

__device__ __forceinline__ f32x16 mfma_z(bf16x8 a_,bf16x8 b_){ f32x16 d_; asm volatile("s_nop 1\n\tv_mfma_f32_32x32x16_bf16 %0, %1, %2, 0":"=&v"(d_):"v"(a_),"v"(b_)); return d_; }
__device__ __forceinline__ void qkt(f32x16&p0,f32x16&p1,const char*Kslot,const bf16x8*qr,int r32,int hi){
  const char*kb=Kslot+hi*1024+r32*16;
  #pragma unroll
  for(int d0=0;d0<4;++d0){
    const bf16x8 b0=*reinterpret_cast<const bf16x8*>(kb+d0*2048);
    const bf16x8 b1=*reinterpret_cast<const bf16x8*>(kb+d0*2048+512);
    if(d0==0){f32x16 z0=f32x16{},z1=f32x16{};asm volatile("":"+v"(z0),"+v"(z1));
      p0=__builtin_amdgcn_mfma_f32_32x32x16_bf16(b0,qr[0],z0,0,0,0);p1=__builtin_amdgcn_mfma_f32_32x32x16_bf16(b1,qr[0],z1,0,0,0);}
    else{p0=__builtin_amdgcn_mfma_f32_32x32x16_bf16(b0,qr[d0],p0,0,0,0);p1=__builtin_amdgcn_mfma_f32_32x32x16_bf16(b1,qr[d0],p1,0,0,0);}}
}
typedef __attribute__((address_space(3))) const char* lds_cptr;
typedef short v4i16_t __attribute__((ext_vector_type(4)));
__device__ __forceinline__ void kload8(bf16x8*kf,lds_cptr kp){
  kf[0]=*(const __attribute__((address_space(3))) bf16x8*)(kp);      kf[1]=*(const __attribute__((address_space(3))) bf16x8*)(kp+512);
  kf[2]=*(const __attribute__((address_space(3))) bf16x8*)(kp+2048); kf[3]=*(const __attribute__((address_space(3))) bf16x8*)(kp+2560);
  kf[4]=*(const __attribute__((address_space(3))) bf16x8*)(kp+4096); kf[5]=*(const __attribute__((address_space(3))) bf16x8*)(kp+4608);
  kf[6]=*(const __attribute__((address_space(3))) bf16x8*)(kp+6144); kf[7]=*(const __attribute__((address_space(3))) bf16x8*)(kp+6656);
}
__device__ __forceinline__ void kload2(bf16x8*kf,lds_cptr kp,int j){ kf[2*j]=*(const __attribute__((address_space(3))) bf16x8*)(kp+j*2048); kf[2*j+1]=*(const __attribute__((address_space(3))) bf16x8*)(kp+j*2048+512); }
__device__ __forceinline__ s16x4 vtr(lds_cptr p){ return __builtin_bit_cast(s16x4,__builtin_amdgcn_ds_read_tr16_b64_v4i16((__attribute__((address_space(3))) v4i16_t*)p)); }
__device__ __forceinline__ float rowmax(const f32x16&p0,const f32x16&p1){
  float a=max3f(p0[0],p0[1],p1[0]),b=max3f(p0[2],p0[3],p1[1]);a=max3f(a,p1[2],p1[3]);
  #pragma unroll
  for(int r=4;r<16;r+=4){a=max3f(a,p0[r],p0[r+1]);b=max3f(b,p0[r+2],p0[r+3]);a=max3f(a,p1[r],p1[r+1]);b=max3f(b,p1[r+2],p1[r+3]);}
  const float m=max2f(a,b);
  auto rr=__builtin_amdgcn_permlane32_swap(__float_as_uint(m),__float_as_uint(m),false,false);
  return max2f(__uint_as_float(rr[0]),__uint_as_float(rr[1]));
}
__device__ __forceinline__ void pv(f32x16*o,int vb,bf16x8 pa0,bf16x8 pa1,bf16x8 pa2,bf16x8 pa3){
  #pragma unroll
  for(int d0=0;d0<2;++d0){s16x4 lo[4],hi[4];
    #pragma unroll
    for(int ks=0;ks<4;++ks){
      asm volatile("ds_read_b64_tr_b16 %0,%1 offset:%c2":"=&v"(lo[ks]):"v"(vb),"i"(d0*4096+ks*1024):"memory");
      asm volatile("ds_read_b64_tr_b16 %0,%1 offset:%c2":"=&v"(hi[ks]):"v"(vb),"i"(d0*4096+ks*1024+512):"memory");}
    asm volatile("s_waitcnt lgkmcnt(0)":::"memory");SBAR();
    #define PK(k) (bf16x8){lo[k][0],lo[k][1],lo[k][2],lo[k][3],hi[k][0],hi[k][1],hi[k][2],hi[k][3]}
    o[d0]=__builtin_amdgcn_mfma_f32_32x32x16_bf16(pa0,PK(0),o[d0],0,0,0);
    o[d0]=__builtin_amdgcn_mfma_f32_32x32x16_bf16(pa1,PK(1),o[d0],0,0,0);
    o[d0]=__builtin_amdgcn_mfma_f32_32x32x16_bf16(pa2,PK(2),o[d0],0,0,0);
    o[d0]=__builtin_amdgcn_mfma_f32_32x32x16_bf16(pa3,PK(3),o[d0],0,0,0);
    #undef PK
  }
}

#ifndef ATTN_STORE16
#define ATTN_STORE16(p,v) (*(u32x4*)(p)=(v))
#endif
template<int THRL> __device__ __forceinline__ void attn_unit(int qb,const bf16*Qh,const bf16*__restrict__ Kh,const bf16*__restrict__ Vh,bf16*Oh,char*shm,const int tid_in){
  const int tid=tid_in,lane=tid&63,r32=lane&31,hi=lane>>5; const int wid=__builtin_amdgcn_readfirstlane(tid>>6);
  const int q0=qb*QB;
  const bf16*Qw=Qh+(long)(q0+wid*QBLK)*DM;
  const unsigned lds0=(unsigned)(uintptr_t)shm;
  float*wsf=(float*)(shm+LDS_WS)+wid*64;
  const bf16*ksrc=Kh+(long)lane*DM+wid*8;
  const bf16*vsrc=Vh+(long)(16*(wid&3)+(lane>>2))*DM+(wid>>2)*32+(lane&3)*8;
  const unsigned kdst=lds0+LDS_K+wid*1024, vdst=lds0+LDS_V+wid*1024;
  #define DMA_K(t,slot) glds16(ksrc+(long)(t)*KVBLK*DM,(unsigned)__builtin_amdgcn_readfirstlane(kdst+(slot)))
  #define DMA_V(t,slot) glds16(vsrc+(long)(t)*KVBLK*DM,(unsigned)__builtin_amdgcn_readfirstlane(vdst+(slot)))
  const int vb0=(int)(lds0+LDS_V)+((lane>>4)&1)*32+(lane&3)*8+(4*hi+((lane&15)>>2))*64;
  const char*Kbase=shm+LDS_K; bf16x8 kf[8];
  const lds_cptr shm3=(lds_cptr)shm; const lds_cptr kp0=shm3+LDS_K+hi*1024+r32*16; const lds_cptr vp0=shm3+LDS_V+((lane>>4)&1)*32+(lane&3)*8+(4*hi+((lane&15)>>2))*64;
  const int NT=(q0+QB)/KVBLK;
  DMA_K(0,0);DMA_V(0,0);DMA_K(1,SLOTB);
  bf16x8 qr[4];
  #pragma unroll
  for(int d0=0;d0<4;++d0)qr[d0]=*reinterpret_cast<const bf16x8*>(&Qw[(long)r32*DM+d0*16+hi*8]);
  float mhat=0.f,l_reg=0.f;f32x16 o[2];o[0]=f32x16{};o[1]=f32x16{};
  const int qrel=wid*QBLK+r32;
  #define CMASK(P0,P1,t) do{int jb_=(t)-(NT-4); if(jb_>=0)cmask(P0,P1,jb_,qrel,hi);}while(0)
  bool resc=false;
  #define START(P0,P1) do{ const float rm=rowmax(P0,P1); resc=false; \
    { const float dl=rm; mhat=fadd_s(mhat,dl); \
      _Pragma("unroll") for(int r=0;r<16;++r){P0[r]=fsub_s(P0[r],dl);P1[r]=fsub_s(P1[r],dl);} \
      } \
    _Pragma("unroll") for(int r=0;r<16;++r)P0[r]=__builtin_amdgcn_exp2f(P0[r]); }while(0)
  #define RESC() do{ if(resc){ asm volatile("s_waitcnt lgkmcnt(0)":::"memory"); \
      _Pragma("unroll") for(int d_=0;d_<2;++d_) _Pragma("unroll") for(int r=0;r<16;++r)o[d_][r]*=wsf[crow(r,hi)]; } }while(0)
  f32x16 pA0,pA1,pB0,pB1;
  int sl_prev=0,sl_cur=0,sl_next=SLOTB;
  #define ROT() do{sl_prev=sl_cur;sl_cur=sl_next;sl_next=(sl_next==(NSLOT-1)*SLOTB)?0:sl_next+SLOTB;}while(0)
  DMA_K(2,2*SLOTB);
  WAIT_BAR(3);
  qkt(pA0,pA1,Kbase,qr,r32,hi);asm volatile("s_nop 15\n\ts_nop 7":"+v"(pA0),"+v"(pA1));CMASK(pA0,pA1,0);
  START(pA0,pA1);
  _Pragma("unroll") for(int r=0;r<16;++r)pA1[r]=__builtin_amdgcn_exp2f(pA1[r]);
  WAIT_BAR(0);
  DMA_K(3,0);DMA_V(1,SLOTB);
  ROT();
  kload8(kf,kp0+sl_cur);
  WAIT_BAR(2);
  s16x4 vlo[8],vhi[8]; u32x4 pw0,pw1,pw2,pw3;
  #define PKW(P,B) cvtpk_s(P[B],P[B+1])
  #define PAF(k) __builtin_bit_cast(bf16x8,pw##k)
  #define VFR(i) (bf16x8){vlo[i][0],vlo[i][1],vlo[i][2],vlo[i][3],vhi[i][0],vhi[i][1],vhi[i][2],vhi[i][3]}
  #define PIN(x) asm volatile("":"+v"(x))
  #define MX3(a,b,c) __builtin_fmaxf(__builtin_fmaxf((a),(b)),(c))
  #define GAPA(MF,A0,A1,A2,A3,W0,W1,PW) do{ MF; sacc+=A0; sacc+=A1; sacc+=A2; sacc+=A3; PIN(sacc); W0; W1; PIN(PW); SBAR(); }while(0)
  #define EX(v) __builtin_amdgcn_exp2f(v)
  #define GAPB(MF,X,B) do{ MF; X[B]=EX(fsub_s(X[B],mhat)); X[B+1]=EX(fsub_s(X[B+1],mhat)); X[B+2]=EX(fsub_s(X[B+2],mhat)); X[B+3]=EX(fsub_s(X[B+3],mhat)); PIN(X); SBAR(); }while(0)
  #define VRD(i) do{ vlo[i]=vtr(vp_+(((i)>>2)*4096+((i)&3)*1024)); vhi[i]=vtr(vp_+(((i)>>2)*4096+((i)&3)*1024+512)); }while(0)
  #define KRD(G,j) do{ if(G){ kload2(kf,kp0+sl_next,j); SBAR(); } }while(0)
  #define STEP(C0,C1,P0,P1,t,GK,GV,GL) do{ SBAR(); \
    const lds_cptr vp_=vp0+sl_prev; \
    VRD(0); SBAR(); float sacc=(P0[0]+P0[1]); \
    GAPA(C0=mfma_z(kf[0],qr[0]), P0[2],P0[3],P0[4],P0[5],     pw0[0]=PKW(P0,0), pw0[1]=PKW(P0,2), pw0); \
    VRD(4); SBAR(); GAPA(C1=mfma_z(kf[1],qr[0]), P0[6],P0[7],P0[8],P0[9],     pw0[2]=PKW(P0,4), pw0[3]=PKW(P0,6), pw0); \
    VRD(1); SBAR(); GAPA(C0=__builtin_amdgcn_mfma_f32_32x32x16_bf16(kf[2],qr[1],C0,0,0,0),   P0[10],P0[11],P0[12],P0[13], pw1[0]=PKW(P0,8), pw1[1]=PKW(P0,10), pw1); \
    VRD(5); SBAR(); GAPA(C1=__builtin_amdgcn_mfma_f32_32x32x16_bf16(kf[3],qr[1],C1,0,0,0),   P0[14],P0[15],P1[0],P1[1],   pw1[2]=PKW(P0,12),pw1[3]=PKW(P0,14), pw1); \
    VRD(2); SBAR(); GAPA(C0=__builtin_amdgcn_mfma_f32_32x32x16_bf16(kf[4],qr[2],C0,0,0,0),   P1[2],P1[3],P1[4],P1[5],     pw2[0]=PKW(P1,0), pw2[1]=PKW(P1,2), pw2); \
    VRD(6); SBAR(); GAPA(C1=__builtin_amdgcn_mfma_f32_32x32x16_bf16(kf[5],qr[2],C1,0,0,0),   P1[6],P1[7],P1[8],P1[9],     pw2[2]=PKW(P1,4), pw2[3]=PKW(P1,6), pw2); \
    VRD(3); SBAR(); GAPA(C0=__builtin_amdgcn_mfma_f32_32x32x16_bf16(kf[6],qr[3],C0,0,0,0),   P1[10],P1[11],P1[12],P1[13], pw3[0]=PKW(P1,8), pw3[1]=PKW(P1,10), pw3); \
    VRD(7); SBAR(); GAPA(C1=__builtin_amdgcn_mfma_f32_32x32x16_bf16(kf[7],qr[3],C1,0,0,0),   P1[14],P1[15],0.f,0.f,       pw3[2]=PKW(P1,12),pw3[3]=PKW(P1,14), pw3); \
    l_reg+=sacc; \
    if(GK){DMA_K((t)+3,sl_cur);} if(GV){DMA_V((t)+1,sl_next);} \
    CMASK(C0,C1,t); \
    { float a=MX3(C0[0],C0[1],C1[0]),b=MX3(C0[2],C0[3],C1[1]); a=MX3(a,C1[2],C1[3]); \
      _Pragma("unroll") for(int r=4;r<16;r+=4){a=MX3(a,C0[r],C0[r+1]);b=MX3(b,C0[r+2],C0[r+3]);a=MX3(a,C1[r],C1[r+1]);b=MX3(b,C1[r+2],C1[r+3]);} \
      float rm=__builtin_fmaxf(a,b); { auto rr=__builtin_amdgcn_permlane32_swap(__float_as_uint(rm),__float_as_uint(rm),false,false); rm=__builtin_fmaxf(__uint_as_float(rr[0]),__uint_as_float(rr[1])); } \
      resc=false; \
      const float rel=rm-mhat; \
      if(__builtin_expect(__any(rel>(float)THRL),0)){ const float dl=__builtin_fmaxf(rel,0.f); mhat+=dl; \
        const float f=__builtin_amdgcn_exp2f(-dl); l_reg*=f; if(hi==0)wsf[r32]=f; resc=true; } } \
    SBAR(); \
    GAPB(o[0]=__builtin_amdgcn_mfma_f32_32x32x16_bf16(PAF(0),VFR(0),o[0],0,0,0), C0,0); \
    GAPB(o[1]=__builtin_amdgcn_mfma_f32_32x32x16_bf16(PAF(0),VFR(4),o[1],0,0,0), C0,4); \
    KRD(GL,0); GAPB(o[0]=__builtin_amdgcn_mfma_f32_32x32x16_bf16(PAF(1),VFR(1),o[0],0,0,0), C0,8); \
    KRD(GL,1); GAPB(o[1]=__builtin_amdgcn_mfma_f32_32x32x16_bf16(PAF(1),VFR(5),o[1],0,0,0), C0,12); \
    KRD(GL,2); GAPB(o[0]=__builtin_amdgcn_mfma_f32_32x32x16_bf16(PAF(2),VFR(2),o[0],0,0,0), C1,0); \
    KRD(GL,3); GAPB(o[1]=__builtin_amdgcn_mfma_f32_32x32x16_bf16(PAF(2),VFR(6),o[1],0,0,0), C1,4); \
    GAPB(o[0]=__builtin_amdgcn_mfma_f32_32x32x16_bf16(PAF(3),VFR(3),o[0],0,0,0), C1,8); \
    GAPB(o[1]=__builtin_amdgcn_mfma_f32_32x32x16_bf16(PAF(3),VFR(7),o[1],0,0,0), C1,12); \
    }while(0)
  int t=1;
  #undef CMASK
  #define CMASK(P0,P1,t) do{}while(0)
  for(;t+5<NT;t+=2){
    STEP(pB0,pB1,pA0,pA1,t,true,true,true);     WAIT_BAR(2); RESC(); ROT();
    STEP(pA0,pA1,pB0,pB1,t+1,true,true,true);   WAIT_BAR(2); RESC(); ROT();
  }
  #undef CMASK
  #define CMASK(P0,P1,t) do{int jb_=(t)-(NT-4); if(jb_>=0)cmask(P0,P1,jb_,qrel,hi);}while(0)
  #define ENDW(tt) do{ if((tt)+3<NT){WAIT_BAR(2);} else if((tt)+2<NT){WAIT_BAR(1);} else {WAIT_BAR(0);} }while(0)
  for(;t+1<NT;t+=2){
    STEP(pB0,pB1,pA0,pA1,t,(t+3<NT),(t+1<NT),(t+1<NT));       ENDW(t);   RESC(); ROT();
    STEP(pA0,pA1,pB0,pB1,t+1,(t+4<NT),(t+2<NT),(t+2<NT));     ENDW(t+1); RESC(); ROT();
  }
  STEP(pB0,pB1,pA0,pA1,NT-1,false,false,false); RESC();
  { float sacc=pB0[0]+pB0[1]; _Pragma("unroll") for(int r=2;r<16;++r)sacc+=pB0[r]; _Pragma("unroll") for(int r=0;r<16;++r)sacc+=pB1[r]; l_reg+=sacc;
    pw0=(u32x4){PKW(pB0,0),PKW(pB0,2),PKW(pB0,4),PKW(pB0,6)};pw1=(u32x4){PKW(pB0,8),PKW(pB0,10),PKW(pB0,12),PKW(pB0,14)};pw2=(u32x4){PKW(pB1,0),PKW(pB1,2),PKW(pB1,4),PKW(pB1,6)};pw3=(u32x4){PKW(pB1,8),PKW(pB1,10),PKW(pB1,12),PKW(pB1,14)};
    SBAR(); pv(o,vb0+sl_cur,PAF(0),PAF(1),PAF(2),PAF(3)); }
  #undef PKW
  #undef PAF
  #undef VFR
  #undef PIN
  #undef MX3
  #undef GAPA
  #undef GAPB
  #undef EX
  #undef VRD
  #undef KRD
  #undef STEP
  #undef ENDW
  l_reg+=__uint_as_float((unsigned)__builtin_amdgcn_ds_bpermute((lane^32)<<2,(int)__float_as_uint(l_reg)));
  if(hi==0)wsf[32+r32]=l_reg;asm volatile("s_waitcnt lgkmcnt(0)":::"memory");
  float rli[16];
  #pragma unroll
  for(int r=0;r<16;++r)rli[r]=__builtin_amdgcn_rcpf(wsf[32+crow(r,hi)]);
  bf16*Ow=Oh+(long)(q0+wid*QBLK)*OPITCH;
  { bf16*stg=(bf16*)(shm+LDS_OST)+wid*2048;
    #pragma unroll
    for(int r=0;r<16;++r){const int orow=crow(r,hi);
      #pragma unroll
      for(int d0=0;d0<2;++d0)stg[orow*64+d0*32+r32]=__float2bfloat16(o[d0][r]*rli[r]);}
    asm volatile("s_waitcnt lgkmcnt(0)":::"memory");
    #pragma unroll
    for(int i=0;i<4;++i){const int row=i*8+(lane>>3),ch=lane&7; const u32x4 v=*(const u32x4*)(stg+row*64+ch*8); ATTN_STORE16(Ow+(long)row*OPITCH+ch*8,v);} }
  asm volatile("s_waitcnt lgkmcnt(0)\n\ts_barrier":::"memory");
  #undef DMA_K
  #undef DMA_V
  #undef CMASK
  #undef START
  #undef RESC
  #undef ROT
}

__device__ __forceinline__ float rowmax_cv(const f32x16&p0,const f32x16&p1){
  float a=__builtin_fmaxf(p0[0],p1[0]);
  #pragma unroll
  for(int r=1;r<16;++r){a=__builtin_fmaxf(a,p0[r]);a=__builtin_fmaxf(a,p1[r]);}
  auto rr=__builtin_amdgcn_permlane32_swap(__float_as_uint(a),__float_as_uint(a),false,false);
  return __builtin_fmaxf(__uint_as_float(rr[0]),__uint_as_float(rr[1]));
}
__device__ __forceinline__ void attn_unit_simple(int qb,const bf16*Qh,const bf16*__restrict__ Kh,const bf16*__restrict__ Vh,bf16*Oh,char*shm,const int tid_in){
  const int tid=tid_in,lane=tid&63,r32=lane&31,hi=lane>>5; const int wid=__builtin_amdgcn_readfirstlane(tid>>6);
  const int q0=qb*QB;
  const bf16*Qw=Qh+(long)(q0+wid*QBLK)*DM;
  const unsigned lds0=(unsigned)(uintptr_t)shm;
  float*wsf=(float*)(shm+LDS_WS)+wid*64;
  const bf16*ksrc=Kh+(long)lane*DM+wid*8;
  const bf16*vsrc=Vh+(long)(16*(wid&3)+(lane>>2))*DM+(wid>>2)*32+(lane&3)*8;
  u32x4*kdstp=(u32x4*)(shm+LDS_K+wid*1024+lane*16); u32x4*vdstp=(u32x4*)(shm+LDS_V+wid*1024+lane*16);
  const int vb0=(int)(lds0+LDS_V)+((lane>>4)&1)*32+(lane&3)*8+(4*hi+((lane&15)>>2))*64;
  const char*Kbase=shm+LDS_K;
  const int NT=(q0+QB)/KVBLK;
  bf16x8 qr[4];
  #pragma unroll
  for(int d0=0;d0<4;++d0)qr[d0]=*reinterpret_cast<const bf16x8*>(&Qw[(long)r32*DM+d0*16+hi*8]);
  float m_run=-1e30f,l_reg=0.f; f32x16 o[2]; o[0]=f32x16{}; o[1]=f32x16{};
  const int qrel=wid*QBLK+r32;
  u32x4 kreg=*(const u32x4*)ksrc, vreg=*(const u32x4*)vsrc;
  for(int t=0;t<NT;++t){
    *kdstp=kreg; *vdstp=vreg;
    if(t+1<NT){ kreg=*(const u32x4*)(ksrc+(long)(t+1)*KVBLK*DM); vreg=*(const u32x4*)(vsrc+(long)(t+1)*KVBLK*DM); }
    __syncthreads();
    f32x16 p0,p1;
    qkt(p0,p1,Kbase,qr,r32,hi);
    { const int jb=t-(NT-4); if(jb>=0){ const float NEG=-INFINITY; const int kb=64*jb+4*hi;
        #pragma unroll
        for(int r=0;r<16;++r){const int kv=kb+(r&3)+8*(r>>2); if(kv>qrel)p0[r]=NEG; if(kv+32>qrel)p1[r]=NEG;} } }
    const float rm=rowmax_cv(p0,p1);
    const float mn=__builtin_fmaxf(m_run,rm); const float alpha=__builtin_amdgcn_exp2f(m_run-mn); m_run=mn;
    float sacc=0.f;
    #pragma unroll
    for(int r=0;r<16;++r){p0[r]=__builtin_amdgcn_exp2f(p0[r]-mn);p1[r]=__builtin_amdgcn_exp2f(p1[r]-mn);sacc+=p0[r]+p1[r];}
    l_reg=l_reg*alpha+sacc;
    if(hi==0)wsf[r32]=alpha;
    asm volatile("s_waitcnt lgkmcnt(0)":::"memory");
    #pragma unroll
    for(int d_=0;d_<2;++d_)
      #pragma unroll
      for(int r=0;r<16;++r)o[d_][r]*=wsf[crow(r,hi)];
    u32x4 pw0,pw1,pw2,pw3;
    #define PKW2(P,B) cvtpk_s(P[B],P[B+1])
    pw0=(u32x4){PKW2(p0,0),PKW2(p0,2),PKW2(p0,4),PKW2(p0,6)};pw1=(u32x4){PKW2(p0,8),PKW2(p0,10),PKW2(p0,12),PKW2(p0,14)};
    pw2=(u32x4){PKW2(p1,0),PKW2(p1,2),PKW2(p1,4),PKW2(p1,6)};pw3=(u32x4){PKW2(p1,8),PKW2(p1,10),PKW2(p1,12),PKW2(p1,14)};
    #undef PKW2
    pv(o,vb0,__builtin_bit_cast(bf16x8,pw0),__builtin_bit_cast(bf16x8,pw1),__builtin_bit_cast(bf16x8,pw2),__builtin_bit_cast(bf16x8,pw3));
    asm volatile("s_waitcnt lgkmcnt(0)":::"memory");
    __syncthreads();
  }
  l_reg+=__uint_as_float((unsigned)__builtin_amdgcn_ds_bpermute((lane^32)<<2,(int)__float_as_uint(l_reg)));
  if(hi==0)wsf[32+r32]=l_reg;asm volatile("s_waitcnt lgkmcnt(0)":::"memory");
  float rli[16];
  #pragma unroll
  for(int r=0;r<16;++r)rli[r]=__builtin_amdgcn_rcpf(wsf[32+crow(r,hi)]);
  bf16*Ow=Oh+(long)(q0+wid*QBLK)*OPITCH;
  { bf16*stg=(bf16*)(shm+LDS_OST)+wid*2048;
    #pragma unroll
    for(int r=0;r<16;++r){const int orow=crow(r,hi);
      #pragma unroll
      for(int d0=0;d0<2;++d0)stg[orow*64+d0*32+r32]=__float2bfloat16(o[d0][r]*rli[r]);}
    asm volatile("s_waitcnt lgkmcnt(0)":::"memory");
    #pragma unroll
    for(int i=0;i<4;++i){const int row=i*8+(lane>>3),ch=lane&7; const u32x4 v=*(const u32x4*)(stg+row*64+ch*8); ATTN_STORE16(Ow+(long)row*OPITCH+ch*8,v);} }
  asm volatile("s_waitcnt vmcnt(0) lgkmcnt(0)":::"memory");
  __syncthreads();
}

constexpr int DA_SLOT=32768, DA_V=16384, DA_WS=98304, DA_ROWS=128;
__device__ __forceinline__ f32x16 mfma_c(bf16x8 a_,bf16x8 b_,const f32x16&c_){ f32x16 d_; asm volatile("s_nop 1\n\tv_mfma_f32_32x32x16_bf16 %0, %1, %2, %3":"=&v"(d_):"v"(a_),"v"(b_),"v"(c_)); return d_; }
template<int THRL> __device__ __forceinline__ void dattn_unit(int qblk,const bf16*Qb,const bf16*__restrict__ Kb,const bf16*__restrict__ Vb,bf16*Yb,float lam,const float*gsub,float gscale,char*shm,const int tid_in){
  const int tid=tid_in,lane=tid&63,r32=lane&31,hi=lane>>5; const int wid=__builtin_amdgcn_readfirstlane(tid>>6);
  const int c=wid>>2, rg=wid&3;
  const int q0=qblk*DA_ROWS; const int NT=(q0+DA_ROWS)/KVBLK;
  const bf16*Qw=Qb+c*64+(long)(q0+rg*32)*DM;
  const unsigned lds0=(unsigned)(uintptr_t)shm; const lds_cptr shm3=(lds_cptr)shm;
  float*wsf=(float*)(shm+DA_WS)+wid*64;
  const int pk0=2*wid;
  const bf16*ksrc0=Kb+(pk0>>3)*64+(long)lane*DM+(pk0&7)*8;
  const unsigned kdst0=lds0+(pk0>>3)*8192+(pk0&7)*1024;
  const bf16*vsrc0=Vb+(long)(16*(pk0&3)+(lane>>2))*DM+(pk0>>2)*32+(lane&3)*8;
  const unsigned vdst0=lds0+DA_V+pk0*1024;
  #define DA_RFL(x) ((unsigned)__builtin_amdgcn_readfirstlane((int)(x)))
  #define DA_DMA(t,so) do{ const long to_=(long)(t)*KVBLK*DM; \
      glds16(ksrc0+to_,DA_RFL(kdst0+(so))); glds16(ksrc0+to_+8,DA_RFL(kdst0+(so)+1024)); \
      glds16(vsrc0+to_,DA_RFL(vdst0+(so))); glds16(vsrc0+to_+16*DM,DA_RFL(vdst0+(so)+1024)); }while(0)
  const lds_cptr kp0=shm3+c*8192+hi*1024+r32*16;
  const lds_cptr vp0=shm3+DA_V+((lane>>4)&1)*32+(lane&3)*8+(4*hi+((lane&15)>>2))*64;
  bf16x8 qr[4];
  #pragma unroll
  DA_DMA(0,0); if(NT>1){ DA_DMA(1,DA_SLOT); }
  #pragma unroll
  for(int d0=0;d0<4;++d0)qr[d0]=*reinterpret_cast<const bf16x8*>(&Qw[(long)r32*DM+d0*16+hi*8]);
  asm volatile("":"+v"(qr[0]),"+v"(qr[1]),"+v"(qr[2]),"+v"(qr[3]));
  float mhat=0.f,l_reg=0.f; f32x16 o[4]; o[0]=f32x16{}; o[1]=f32x16{}; o[2]=f32x16{}; o[3]=f32x16{};
  f32x16 negm;
  #pragma unroll
  for(int r=0;r<16;++r)negm[r]=0.f;
  const int qrel=rg*32+r32;
  int slot=0;
  for(int t=0;t<NT;++t){
    if(t+1<NT){ asm volatile("s_waitcnt vmcnt(4) lgkmcnt(0)\n\ts_barrier":::"memory"); } else { asm volatile("s_waitcnt vmcnt(0) lgkmcnt(0)\n\ts_barrier":::"memory"); }
    if(t+2<NT){ int s2=slot+2*DA_SLOT; if(s2>=3*DA_SLOT)s2-=3*DA_SLOT; DA_DMA(t+2,s2); }
    const lds_cptr kp=kp0+slot;
    f32x16 p0,p1;
    { const bf16x8 k0=*(const __attribute__((address_space(3))) bf16x8*)(kp), k1=*(const __attribute__((address_space(3))) bf16x8*)(kp+512);
      p0=mfma_c(k0,qr[0],negm); p1=mfma_c(k1,qr[0],negm); }
    #pragma unroll
    for(int d0=1;d0<4;++d0){ const bf16x8 k0=*(const __attribute__((address_space(3))) bf16x8*)(kp+d0*2048), k1=*(const __attribute__((address_space(3))) bf16x8*)(kp+d0*2048+512);
      p0=__builtin_amdgcn_mfma_f32_32x32x16_bf16(k0,qr[d0],p0,0,0,0); p1=__builtin_amdgcn_mfma_f32_32x32x16_bf16(k1,qr[d0],p1,0,0,0); }
    { const int jb=t-(NT-2); if(jb>=0){ const float NEG=-INFINITY; const int kb=64*jb+4*hi;
        #pragma unroll
        for(int r=0;r<16;++r){const int kv=kb+(r&3)+8*(r>>2); if(kv>qrel)p0[r]=NEG; if(kv+32>qrel)p1[r]=NEG;} } }
    float rm=__builtin_fmaxf(p0[0],p1[0]);
    #pragma unroll
    for(int r=1;r<16;++r){rm=__builtin_fmaxf(rm,p0[r]);rm=__builtin_fmaxf(rm,p1[r]);}
    rm=__builtin_fmaxf(rm,__uint_as_float((unsigned)__builtin_amdgcn_ds_bpermute((lane^32)<<2,(int)__float_as_uint(rm))));
    if(t==0){
      mhat=rm;
      #pragma unroll
      for(int r=0;r<16;++r){p0[r]-=rm;p1[r]-=rm;negm[r]=-rm;}
    } else if(__any(rm>(float)THRL)){
      const float dl=__builtin_fmaxf(rm,0.f); const float f=__builtin_amdgcn_exp2f(-dl); mhat+=dl; l_reg*=f;
      #pragma unroll
      for(int r=0;r<16;++r){p0[r]-=dl;p1[r]-=dl;negm[r]=-mhat;}
      if(hi==0)wsf[r32]=f;
      asm volatile("s_waitcnt lgkmcnt(0)":::"memory");
      #pragma unroll
      for(int d_=0;d_<4;++d_)
        #pragma unroll
        for(int r=0;r<16;++r)o[d_][r]*=wsf[crow(r,hi)];
    }
    float sacc=0.f;
    #pragma unroll
    for(int r=0;r<16;++r){p0[r]=__builtin_amdgcn_exp2f(p0[r]);p1[r]=__builtin_amdgcn_exp2f(p1[r]);sacc+=p0[r]+p1[r];}
    l_reg+=sacc;
    u32x4 pw0,pw1,pw2,pw3;
    pw0=(u32x4){cvtpk_s(p0[0],p0[1]),cvtpk_s(p0[2],p0[3]),cvtpk_s(p0[4],p0[5]),cvtpk_s(p0[6],p0[7])}; pw1=(u32x4){cvtpk_s(p0[8],p0[9]),cvtpk_s(p0[10],p0[11]),cvtpk_s(p0[12],p0[13]),cvtpk_s(p0[14],p0[15])};
    pw2=(u32x4){cvtpk_s(p1[0],p1[1]),cvtpk_s(p1[2],p1[3]),cvtpk_s(p1[4],p1[5]),cvtpk_s(p1[6],p1[7])}; pw3=(u32x4){cvtpk_s(p1[8],p1[9]),cvtpk_s(p1[10],p1[11]),cvtpk_s(p1[12],p1[13]),cvtpk_s(p1[14],p1[15])};
    const lds_cptr vp=vp0+slot;
    #pragma unroll
    for(int d0=0;d0<4;++d0){
      #define DA_VF(ks) ({ const s16x4 lo_=vtr(vp+d0*4096+(ks)*1024), hi_=vtr(vp+d0*4096+(ks)*1024+512); (bf16x8){lo_[0],lo_[1],lo_[2],lo_[3],hi_[0],hi_[1],hi_[2],hi_[3]}; })
      o[d0]=__builtin_amdgcn_mfma_f32_32x32x16_bf16(__builtin_bit_cast(bf16x8,pw0),DA_VF(0),o[d0],0,0,0);
      o[d0]=__builtin_amdgcn_mfma_f32_32x32x16_bf16(__builtin_bit_cast(bf16x8,pw1),DA_VF(1),o[d0],0,0,0);
      o[d0]=__builtin_amdgcn_mfma_f32_32x32x16_bf16(__builtin_bit_cast(bf16x8,pw2),DA_VF(2),o[d0],0,0,0);
      o[d0]=__builtin_amdgcn_mfma_f32_32x32x16_bf16(__builtin_bit_cast(bf16x8,pw3),DA_VF(3),o[d0],0,0,0);
      #undef DA_VF
    }
    slot+=DA_SLOT; if(slot>=3*DA_SLOT)slot=0;
  }
  int lane_e=lane; asm volatile("":"+v"(lane_e)); const int r32e=lane_e&31, hie=lane_e>>5;
  l_reg+=__uint_as_float((unsigned)__builtin_amdgcn_ds_bpermute((lane^32)<<2,(int)__float_as_uint(l_reg)));
  asm volatile("s_waitcnt vmcnt(0) lgkmcnt(0)\n\ts_barrier":::"memory");
  if(hie==0)wsf[32+r32e]=l_reg; asm volatile("s_waitcnt lgkmcnt(0)":::"memory");
  float rli[16];
  #pragma unroll
  for(int r=0;r<16;++r)rli[r]=__builtin_amdgcn_rcpf(wsf[32+crow(r,hie)]);
  float*st2=(float*)shm+rg*4096;
  if(c==1){
    #pragma unroll
    for(int d0=0;d0<4;++d0)
      #pragma unroll
      for(int r=0;r<16;++r)st2[crow(r,hie)*128+d0*32+r32e]=lam*o[d0][r]*rli[r];
  }
  asm volatile("s_waitcnt lgkmcnt(0)\n\ts_barrier":::"memory");
  if(c==0){
    float ssq[16];
    #pragma unroll
    for(int r=0;r<16;++r){ float a_=0.f;
      #pragma unroll
      for(int d0=0;d0<4;++d0){ const float x_=o[d0][r]*rli[r]-st2[crow(r,hie)*128+d0*32+r32e]; o[d0][r]=x_; a_+=x_*x_; }
      a_+=__uint_as_float((unsigned)__builtin_amdgcn_ds_swizzle((int)__float_as_uint(a_),(1<<10)|0x1f)); a_+=__uint_as_float((unsigned)__builtin_amdgcn_ds_swizzle((int)__float_as_uint(a_),(2<<10)|0x1f));
      a_+=__uint_as_float((unsigned)__builtin_amdgcn_ds_swizzle((int)__float_as_uint(a_),(4<<10)|0x1f)); a_+=__uint_as_float((unsigned)__builtin_amdgcn_ds_swizzle((int)__float_as_uint(a_),(8<<10)|0x1f));
      a_+=__uint_as_float((unsigned)__builtin_amdgcn_ds_swizzle((int)__float_as_uint(a_),(16<<10)|0x1f));
      ssq[r]=1.0f/__builtin_sqrtf(a_*(1.0f/128.0f)+1e-5f); }
    float g4[4];
    #pragma unroll
    for(int d0=0;d0<4;++d0)g4[d0]=gsub[d0*32+r32e]*gscale;
    bf16*stg=(bf16*)(shm+65536)+rg*4096;
    #pragma unroll
    for(int r=0;r<16;++r)
      #pragma unroll
      for(int d0=0;d0<4;++d0)stg[crow(r,hie)*128+d0*32+r32e]=__float2bfloat16(o[d0][r]*ssq[r]*g4[d0]);
    asm volatile("s_waitcnt lgkmcnt(0)":::"memory");
    bf16*Yw=Yb+(long)(q0+rg*32)*DM;
    #pragma unroll
    for(int i=0;i<8;++i){const int row=i*4+(lane_e>>4),ch=lane_e&15; const u32x4 v=*(const u32x4*)(stg+row*128+ch*8); *(u32x4*)(Yw+(long)row*DM+ch*8)=v;}
  }
  asm volatile("s_waitcnt vmcnt(0) lgkmcnt(0)\n\ts_barrier":::"memory");
  #undef DA_DMA
  #undef DA_RFL
}
#ifndef DB_VPRE
#define DB_VPRE 0
#endif
#ifndef DB_FILLX
#define DB_FILLX 1
#endif
template<int THRL> __device__ __forceinline__ void dattn2_unit(int qblk,const bf16*Qb,const bf16*__restrict__ Kb,const bf16*__restrict__ Vb,bf16*Yb,float lam,const float*gsub,float gscale,char*shm,const int tid_in){
  const int tid=tid_in,lane=tid&63,r32=lane&31,hi=lane>>5; const int wid=__builtin_amdgcn_readfirstlane(tid>>6);
  const int c=wid>>2, rg=wid&3;
  const int q0=qblk*DA_ROWS; const int NT=(q0+DA_ROWS)/KVBLK;
  const bf16*Qw=Qb+c*64+(long)(q0+rg*32)*DM;
  const unsigned lds0=(unsigned)(uintptr_t)shm; const lds_cptr shm3=(lds_cptr)shm;
  const int pk0=2*wid;
  const bf16*ksrc0=Kb+(pk0>>3)*64+(long)((pk0&7)*8+(lane>>3))*DM+((lane&7)^((lane>>3)&7))*8;
  const unsigned kdst0=lds0+(pk0>>3)*8192+(pk0&7)*1024;
  const bf16*vsrc0=Vb+(long)(16*(pk0&3)+(lane>>2))*DM+(pk0>>2)*32+(lane&3)*8;
  const unsigned vdst0=lds0+DA_V+pk0*1024;
  #define DB_RFL(x) ((unsigned)__builtin_amdgcn_readfirstlane((int)(x)))
  #define DB_DMA(t,so) do{ const long to_=(long)(t)*KVBLK*DM; \
      glds16(ksrc0+to_,DB_RFL(kdst0+(so))); glds16(ksrc0+to_+8*DM,DB_RFL(kdst0+(so)+1024)); \
      glds16(vsrc0+to_,DB_RFL(vdst0+(so))); glds16(vsrc0+to_+16*DM,DB_RFL(vdst0+(so)+1024)); }while(0)
  #define DB_SLOT(t) (((t)&3)*DA_SLOT)
  const lds_cptr kp0=shm3+c*8192+r32*128+((hi^(r32&7))*16);
  #define DB_KLD(kf_,kp_,d0) do{ const lds_cptr a_=(lds_cptr)(size_t)(((unsigned)(size_t)(kp_))^((unsigned)(d0)<<5)); kf_[2*(d0)]=*(const __attribute__((address_space(3))) bf16x8*)(a_); kf_[2*(d0)+1]=*(const __attribute__((address_space(3))) bf16x8*)(a_+4096); }while(0)
  const lds_cptr vp0=shm3+DA_V+((lane>>4)&1)*32+(lane&3)*8+(4*hi+((lane&15)>>2))*64;
  bf16x8 qr[4];
  DB_DMA(0,0); DB_DMA(1,DA_SLOT);
  #pragma unroll
  for(int d0=0;d0<4;++d0)qr[d0]=*reinterpret_cast<const bf16x8*>(&Qw[(long)r32*DM+d0*16+hi*8]);
  asm volatile("":"+v"(qr[0]),"+v"(qr[1]),"+v"(qr[2]),"+v"(qr[3]));
  float mref=0.f,l_reg=0.f; f32x16 o[4]; o[0]=f32x16{}; o[1]=f32x16{}; o[2]=f32x16{}; o[3]=f32x16{};
  f32x16 p0,p1; u32x4 pw0,pw1,pw2,pw3; s16x4 va[8],vb[8];
  #pragma unroll
  for(int r=0;r<16;++r){ p0[r]=0.f; p1[r]=0.f; }
  asm volatile("":"+v"(p0),"+v"(p1));
  const int qrel=rg*32+r32;
  #define DB_WAITT(u) do{ if((u)+1<NT){ asm volatile("s_waitcnt vmcnt(4)":::"memory"); } else { asm volatile("s_waitcnt vmcnt(0)":::"memory"); } }while(0)
  #define DB_ISSUE(u) do{ if((u)<NT){ DB_DMA((u),DB_SLOT(u)); } }while(0)
  #define DB_BAR() asm volatile("s_waitcnt lgkmcnt(0)\n\ts_barrier":::"memory")
  #define DB_BARP() asm volatile("s_waitcnt lgkmcnt(0)\n\ts_barrier":"+v"(p0),"+v"(p1)::"memory")
  #define DB_VLD(x,vp_,d0) do{ _Pragma("unroll") for(int ks_=0;ks_<4;++ks_){ x[2*ks_]=vtr((vp_)+(d0)*4096+ks_*1024); x[2*ks_+1]=vtr((vp_)+(d0)*4096+ks_*1024+512); } }while(0)
  #define DB_VF(x,ks) ((bf16x8){x[2*(ks)][0],x[2*(ks)][1],x[2*(ks)][2],x[2*(ks)][3],x[2*(ks)+1][0],x[2*(ks)+1][1],x[2*(ks)+1][2],x[2*(ks)+1][3]})
  #define DB_PVM(x,d0) do{ o[d0]=__builtin_amdgcn_mfma_f32_32x32x16_bf16(DB_VF(x,0),__builtin_bit_cast(bf16x8,pw0),o[d0],0,0,0); o[d0]=__builtin_amdgcn_mfma_f32_32x32x16_bf16(DB_VF(x,1),__builtin_bit_cast(bf16x8,pw1),o[d0],0,0,0); \
      o[d0]=__builtin_amdgcn_mfma_f32_32x32x16_bf16(DB_VF(x,2),__builtin_bit_cast(bf16x8,pw2),o[d0],0,0,0); o[d0]=__builtin_amdgcn_mfma_f32_32x32x16_bf16(DB_VF(x,3),__builtin_bit_cast(bf16x8,pw3),o[d0],0,0,0); }while(0)
  #define DB_QKM(kf_) do{ p0=__builtin_amdgcn_mfma_f32_32x32x16_bf16(kf_[0],qr[0],p0,0,0,0); p1=__builtin_amdgcn_mfma_f32_32x32x16_bf16(kf_[1],qr[0],p1,0,0,0); \
      _Pragma("unroll") for(int d0_=1;d0_<4;++d0_){ p0=__builtin_amdgcn_mfma_f32_32x32x16_bf16(kf_[2*d0_],qr[d0_],p0,0,0,0); p1=__builtin_amdgcn_mfma_f32_32x32x16_bf16(kf_[2*d0_+1],qr[d0_],p1,0,0,0); } }while(0)
  #define DB_FILL() do{ float nm_=-mref; asm volatile("":"+v"(nm_)); _Pragma("unroll") for(int r=0;r<16;++r){ p0[r]=nm_; p1[r]=nm_; } }while(0)
  #define DB_M(tp,tq) do{ const lds_cptr vp_=vp0+DB_SLOT(tp); const lds_cptr kp_=kp0+DB_SLOT(tq); bf16x8 kf_[8]; \
      if(!DB_VPRE){ DB_VLD(va,vp_,0); DB_VLD(vb,vp_,1); SBAR(); } DB_PVM(va,0); DB_VLD(va,vp_,2); SBAR(); \
      DB_PVM(vb,1); DB_VLD(vb,vp_,3); SBAR(); \
      DB_PVM(va,2); DB_KLD(kf_,kp_,0); DB_KLD(kf_,kp_,1); SBAR(); \
      DB_PVM(vb,3); DB_KLD(kf_,kp_,2); DB_KLD(kf_,kp_,3); SBAR(); \
      if(!DB_FILLX){ DB_FILL(); } DB_QKM(kf_); }while(0)
  #define DB_QK0(tq) do{ const lds_cptr kp_=kp0+DB_SLOT(tq); bf16x8 kf_[8]; DB_KLD(kf_,kp_,0); DB_KLD(kf_,kp_,1); DB_KLD(kf_,kp_,2); DB_KLD(kf_,kp_,3); SBAR(); DB_QKM(kf_); }while(0)
  #define DB_PVL(tp) do{ const lds_cptr vp_=vp0+DB_SLOT(tp); if(!DB_VPRE){ DB_VLD(va,vp_,0); DB_VLD(vb,vp_,1); SBAR(); } DB_PVM(va,0); DB_VLD(va,vp_,2); SBAR(); DB_PVM(vb,1); DB_VLD(vb,vp_,3); SBAR(); DB_PVM(va,2); SBAR(); DB_PVM(vb,3); }while(0)
  #define DB_X(tt,FIRST) do{ { const int jb_=(tt)-(NT-2); if(jb_>=0){ cmask(p0,p1,jb_,qrel,hi); } } \
      const float rm_=rowmax(p0,p1); \
      if(FIRST){ mref=rm_; _Pragma("unroll") for(int r=0;r<16;++r){ p0[r]-=rm_; p1[r]-=rm_; } } \
      else if(__any(rm_>(float)THRL)){ const float dl_=__builtin_fmaxf(rm_,0.f); const float f_=__builtin_amdgcn_exp2f(-dl_); mref+=dl_; l_reg*=f_; \
        _Pragma("unroll") for(int r=0;r<16;++r){ p0[r]-=dl_; p1[r]-=dl_; } \
        _Pragma("unroll") for(int d_=0;d_<4;++d_) _Pragma("unroll") for(int r=0;r<16;++r){ float x_=o[d_][r]; asm volatile("v_mul_f32_e32 %0, %0, %1":"+v"(x_):"v"(f_)); o[d_][r]=x_; } } \
      float sacc_=0.f; _Pragma("unroll") for(int r=0;r<16;++r){ p0[r]=__builtin_amdgcn_exp2f(p0[r]); p1[r]=__builtin_amdgcn_exp2f(p1[r]); sacc_+=p0[r]+p1[r]; } l_reg+=sacc_; \
      pw0=(u32x4){cvtpk_s(p0[0],p0[1]),cvtpk_s(p0[2],p0[3]),cvtpk_s(p0[4],p0[5]),cvtpk_s(p0[6],p0[7])}; pw1=(u32x4){cvtpk_s(p0[8],p0[9]),cvtpk_s(p0[10],p0[11]),cvtpk_s(p0[12],p0[13]),cvtpk_s(p0[14],p0[15])}; \
      pw2=(u32x4){cvtpk_s(p1[0],p1[1]),cvtpk_s(p1[2],p1[3]),cvtpk_s(p1[4],p1[5]),cvtpk_s(p1[6],p1[7])}; pw3=(u32x4){cvtpk_s(p1[8],p1[9]),cvtpk_s(p1[10],p1[11]),cvtpk_s(p1[12],p1[13]),cvtpk_s(p1[14],p1[15])}; \
      if(DB_VPRE){ const lds_cptr vq_=vp0+DB_SLOT(tt); DB_VLD(va,vq_,0); DB_VLD(vb,vq_,1); } if(DB_FILLX){ DB_FILL(); } }while(0)
  DB_WAITT(0);
  if(c==1){ DB_BAR(); DB_ISSUE(2); }
  DB_BAR();
  DB_QK0(0);
  if(c==1){ DB_WAITT(1); } DB_BARP(); DB_ISSUE(2+c);
  DB_X(0,true);
  for(int t=1;t<NT;++t){
    if(c==0){ DB_WAITT(t); } DB_BAR();
    DB_M(t-1,t);
    if(c==1){ DB_WAITT(t+1); } DB_BARP(); DB_ISSUE(t+2+c);
    DB_X(t,false);
  }
  DB_BAR(); DB_PVL(NT-1);
  if(c==0){ DB_BAR(); }
  int lane_e=lane; asm volatile("":"+v"(lane_e)); const int r32e=lane_e&31, hie=lane_e>>5;
  l_reg+=__uint_as_float((unsigned)__builtin_amdgcn_ds_bpermute((lane_e^32)<<2,(int)__float_as_uint(l_reg)));
  asm volatile("s_waitcnt vmcnt(0) lgkmcnt(0)\n\ts_barrier":::"memory");
  const float rl=__builtin_amdgcn_rcpf(l_reg);
  float*st2=(float*)shm+rg*4096+lane_e;
  if(c==1){ const float s_=lam*rl;
    #pragma unroll
    for(int d0=0;d0<4;++d0)
      #pragma unroll
      for(int r=0;r<16;++r)st2[(d0*16+r)*64]=o[d0][r]*s_;
  }
  asm volatile("s_waitcnt lgkmcnt(0)\n\ts_barrier":::"memory");
  if(c==0){
    float a_=0.f;
    #pragma unroll
    for(int d0=0;d0<4;++d0)
      #pragma unroll
      for(int r=0;r<16;++r){ const float x_=o[d0][r]*rl-st2[(d0*16+r)*64]; o[d0][r]=x_; a_+=x_*x_; }
    a_+=__uint_as_float((unsigned)__builtin_amdgcn_ds_bpermute((lane_e^32)<<2,(int)__float_as_uint(a_)));
    const float rs=gscale/__builtin_sqrtf(a_*(1.0f/128.0f)+1e-5f);
    char*stg=shm+65536+rg*(32*272)+r32e*272+hie*8;
    #pragma unroll
    for(int d0=0;d0<4;++d0)
      #pragma unroll
      for(int g=0;g<4;++g){ const float4 gv=*reinterpret_cast<const float4*>(gsub+d0*32+8*g+4*hie);
        uint2 w_; w_.x=cvtpk_s(o[d0][4*g]*rs*gv.x,o[d0][4*g+1]*rs*gv.y); w_.y=cvtpk_s(o[d0][4*g+2]*rs*gv.z,o[d0][4*g+3]*rs*gv.w);
        *reinterpret_cast<uint2*>(stg+(d0*32+8*g)*2)=w_; }
    asm volatile("s_waitcnt lgkmcnt(0)":::"memory");
    bf16*Yw=Yb+(long)(q0+rg*32)*DM; const char*stb=shm+65536+rg*(32*272);
    #pragma unroll
    for(int i=0;i<8;++i){const int row=i*4+(lane_e>>4),ch=lane_e&15; const u32x4 v=*(const u32x4*)(stb+row*272+ch*16); *(u32x4*)(Yw+(long)row*DM+ch*8)=v;}
  }
  asm volatile("s_waitcnt vmcnt(0) lgkmcnt(0)\n\ts_barrier":::"memory");
  #undef DB_RFL
  #undef DB_KLD
  #undef DB_DMA
  #undef DB_SLOT
  #undef DB_WAITT
  #undef DB_ISSUE
  #undef DB_BARP
  #undef DB_BAR
  #undef DB_VLD
  #undef DB_VF
  #undef DB_PVM
  #undef DB_QKM
  #undef DB_M
  #undef DB_QK0
  #undef DB_PVL
  #undef DB_X
}
constexpr int ATTN_LDS_BYTES=LDS_BYTES;
#undef SBAR
#undef WAIT_BAR
}

#define GAS __attribute__((address_space(1)))
#define LAS __attribute__((address_space(3)))
typedef unsigned short bf16;
typedef unsigned v4u __attribute__((ext_vector_type(4)));
typedef float f32x4 __attribute__((ext_vector_type(4)));
typedef short bf16x8 __attribute__((ext_vector_type(8)));
typedef GAS unsigned gu32;
typedef GAS unsigned long long gu64;
#define RLX_AGENT __ATOMIC_RELAXED, __HIP_MEMORY_SCOPE_AGENT
#define LDS_WAIT() asm volatile("s_waitcnt lgkmcnt(0)" ::: "memory")
#define VM_WAIT() asm volatile("s_waitcnt vmcnt(0)" ::: "memory")
__device__ __forceinline__ unsigned long long rt() { return __builtin_amdgcn_s_memrealtime(); }
__device__ __forceinline__ unsigned f2bf(float f) { unsigned u = __builtin_bit_cast(unsigned, f); return (u + 0x7fffu + ((u >> 16) & 1u)) >> 16; }
__device__ __forceinline__ unsigned pk2(float lo, float hi) { return f2bf(lo) | (f2bf(hi) << 16); }

#define XB_TMO      128
#define XB_XCNT(j)  (256  + 64 * (j))
#define XB_XSUB(j)  (1280 + 64 * (j))
#define XB_XGEN(j)  (2304 + 64 * (j))
#define XB_TOP      3328
#define XB_TOPGEN   3392
#define XCD_BAR_WORDS 3456
#define XB_SPIN_CAP (1u << 26)

__device__ __forceinline__ unsigned xb_ld(unsigned* p)              { return __hip_atomic_load(p, __ATOMIC_RELAXED, __HIP_MEMORY_SCOPE_AGENT); }
__device__ __forceinline__ unsigned xb_add(unsigned* p, unsigned v) { return __hip_atomic_fetch_add(p, v, __ATOMIC_RELAXED, __HIP_MEMORY_SCOPE_AGENT); }
__device__ __forceinline__ unsigned xb_xcc_id() { return (unsigned)__builtin_amdgcn_s_getreg((3 << 11) | 20) & 0xFu; }
#define XB_SPIN(cond, bar) do { unsigned _sp = 0; while (cond) { __builtin_amdgcn_s_sleep(1); \
    if ((++_sp & 255u) == 0u) { if (xb_ld(&(bar)[XB_TMO])) break; if (_sp > XB_SPIN_CAP) { atomicAdd(&(bar)[XB_TMO], 1u); break; } } } } while (0)

struct XcdBarrier {
    unsigned* bar; unsigned x;
    volatile LAS unsigned* st;
};

__device__ __forceinline__ XcdBarrier xcd_barrier_post(unsigned* bar, volatile LAS unsigned* st, const int tid) {
    XcdBarrier b; b.bar = bar; b.x = xb_xcc_id(); b.st = st;
    if (tid == 0) (void)xb_add(&bar[XB_XCNT(b.x)], 1u);
    return b;
}
__device__ __forceinline__ void xcd_barrier_complete(unsigned* bar, unsigned x, unsigned& nloc, unsigned& nx) {
    const unsigned G = gridDim.x * gridDim.y * gridDim.z;
    unsigned sum, cnt, mine, sp = 0u;
    for (;;) {
        sum = 0u; cnt = 0u; mine = 0u;
#pragma unroll
        for (unsigned j = 0; j < 16; ++j) { const unsigned c = xb_ld(&bar[XB_XCNT(j)]); sum += c; cnt += (c > 0u) ? 1u : 0u; mine = (j == x) ? c : mine; }
        if (sum == G) break;
        __builtin_amdgcn_s_sleep(1);
        if ((++sp & 255u) == 0u) { if (xb_ld(&bar[XB_TMO])) break; if (sp > XB_SPIN_CAP) { atomicAdd(&bar[XB_TMO], 1u); break; } }
    }
    nloc = mine > 0u ? mine : 1u; nx = cnt > 0u ? cnt : 1u;
}

__device__ __forceinline__ void xcd_barrier(const XcdBarrier& b, const int tid) {
    asm volatile("s_waitcnt vmcnt(0)" ::: "memory");
    __syncthreads();
    if (tid == 0) {
        unsigned* bar = b.bar;
        __builtin_amdgcn_s_waitcnt(0);
        unsigned nloc = b.st[0], nx = b.st[1];
        if (nloc == 0u) { xcd_barrier_complete(bar, b.x, nloc, nx); b.st[0] = nloc; b.st[1] = nx; }
        const unsigned old = xb_add(&bar[XB_XSUB(b.x)], 1u);
        const unsigned gen = old / nloc;
        if (old + 1u == (gen + 1u) * nloc) {
            __builtin_amdgcn_fence(__ATOMIC_RELEASE, "agent");
            asm volatile("s_waitcnt vmcnt(0)" ::: "memory");
            const unsigned og = xb_add(&bar[XB_TOP], 1u);
            const unsigned tg = og / nx;
            if (og + 1u == (tg + 1u) * nx) xb_add(&bar[XB_TOPGEN], 1u);
            else XB_SPIN(xb_ld(&bar[XB_TOPGEN]) == tg, bar);
            __builtin_amdgcn_fence(__ATOMIC_ACQUIRE, "agent");
            xb_add(&bar[XB_XGEN(b.x)], 1u);
            asm volatile("s_waitcnt vmcnt(0)" ::: "memory");
        } else {
            XB_SPIN(xb_ld(&bar[XB_XGEN(b.x)]) == gen, bar);
            __builtin_amdgcn_fence(__ATOMIC_ACQUIRE, "agent");
            asm volatile("s_waitcnt vmcnt(0)" ::: "memory");
        }
    }
    __syncthreads();
}

constexpr int NWAVES = 8;
constexpr int NTOK = 65536, NH = 32768, DMODEL = 1024, SEQLEN = 4096, INCOLS = 5632, DFF = 2816, NEXP = 8;
constexpr int MOE_PANELS_MAX = 264;
constexpr float EPS_NORM = 1e-6f, EPS_SUBLN = 1e-5f;

constexpr size_t MiB = 1u << 20;
constexpr size_t WS_CTL = 0, CTL_ZERO_BYTES = 1 * MiB;
constexpr size_t WS_WIN = 1 * MiB;
constexpr size_t WS_WGLU = 23 * MiB;
constexpr size_t WS_WPS = 24 * MiB;
constexpr size_t WS_WPA = 26 * MiB;
constexpr size_t WS_WOUT = 30 * MiB;
constexpr size_t WS_WDGU = 34 * MiB;
constexpr size_t WS_WDD = 45 * MiB;
constexpr size_t WS_WMGU = 51 * MiB;
constexpr size_t WS_WMD = 139 * MiB;
constexpr size_t WS_TZF = 183 * MiB;
constexpr size_t WS_EM = 223 * MiB;
constexpr size_t WS_ROPE = 239 * MiB;
constexpr size_t WS_ROUTE = 255 * MiB;
constexpr size_t WS_ACT = 260 * MiB;
constexpr size_t WS_END = 960 * MiB;
constexpr size_t A_HB = 0, A_UBUF = 64 * MiB, A_SLOC = 104 * MiB, A_Q = 120 * MiB, A_K = 184 * MiB, A_V = 248 * MiB, A_SGS = 312 * MiB, A_SGA = 376 * MiB, A_YA = 440 * MiB, A_YA2 = 472 * MiB, A_OV = 504 * MiB, A_YB = 632 * MiB;
constexpr size_t A_H2 = 0, A_FA = 64 * MiB;
constexpr size_t A_H2G = 64 * MiB, A_AG = 196 * MiB, A_YG = 559 * MiB;
static_assert(A_UBUF == pg8::EA_U && A_Q == pg8::EA_Q && A_K == pg8::EA_K && A_V == pg8::EA_V && A_SGS == pg8::EA_SGS && A_SGA == pg8::EA_SGA, "EpiIn offsets");
static_assert(A_YB + 64 * MiB <= WS_END - WS_ACT && A_OV + 128 * MiB <= WS_END - WS_ACT && A_YG + 132 * MiB <= WS_END - WS_ACT, "act map");
constexpr size_t R_E = 0, R_W = 256 * 1024, R_S = 512 * 1024, R_CNT = 768 * 1024;
constexpr int CW_BAR = 4096;

constexpr int RING_OFF = 0, RING_BYTES = 131072;
constexpr int LDSCTL_OFF = RING_BYTES, MISC_OFF = LDSCTL_OFF + 320;
constexpr int LDS_BYTES = 147456;

constexpr int PTR_OFF = LDSCTL_OFF + 1024;
struct Args { const void* in[31]; float* out; unsigned char* ws; };
__device__ __forceinline__ unsigned long long ldp64(LAS unsigned char* L, int slot) {
    const unsigned long long v = ((volatile LAS unsigned long long*)(L + PTR_OFF))[slot];
    const unsigned lo = __builtin_amdgcn_readfirstlane((unsigned)v), hi = __builtin_amdgcn_readfirstlane((unsigned)(v >> 32));
    return ((unsigned long long)hi << 32) | lo;
}
#define LDP(T, slot) ((T*)(GAS T*)(uintptr_t)ldp64(L, (slot)))

#define SWZ_XOR(k) (((k) << 10) | 0x1f)
#define swz_xor(v, pat) __builtin_bit_cast(float, __builtin_amdgcn_ds_swizzle(__builtin_bit_cast(int, (float)(v)), (pat)))
__device__ __forceinline__ float wave_sum(float v) {
    v += swz_xor(v, SWZ_XOR(1)); v += swz_xor(v, SWZ_XOR(2)); v += swz_xor(v, SWZ_XOR(4)); v += swz_xor(v, SWZ_XOR(8)); v += swz_xor(v, SWZ_XOR(16));
    const float lo = __builtin_bit_cast(float, __builtin_amdgcn_readlane(__builtin_bit_cast(int, v), 0));
    const float hi = __builtin_bit_cast(float, __builtin_amdgcn_readlane(__builtin_bit_cast(int, v), 32));
    return lo + hi;
}
__device__ __forceinline__ void tr_item(const float* W, int ldw, int K, bf16* WTn0, int k0, int srccol, LAS float* scr, int lane) {
#pragma unroll 8
    for (int i = 0; i < 32; ++i) { const int kk = 2 * i + (lane >> 5); scr[kk * 33 + (lane & 31)] = W[(size_t)(k0 + kk) * ldw + srccol]; }
    LDS_WAIT(); asm volatile("" ::: "memory");
    const int c = lane & 7;
#pragma unroll
    for (int j = 0; j < 4; ++j) { const int n = (lane >> 3) + 8 * j; const LAS float* s = scr + (8 * c) * 33 + n;
        v4u o; o.x = pk2(s[0 * 33], s[1 * 33]); o.y = pk2(s[2 * 33], s[3 * 33]); o.z = pk2(s[4 * 33], s[5 * 33]); o.w = pk2(s[6 * 33], s[7 * 33]);
        *(GAS v4u*)(WTn0 + (size_t)n * K + k0 + 8 * c) = o; }
    LDS_WAIT(); asm volatile("" ::: "memory");
}
__device__ __forceinline__ int win_orig(int n) { if (n < 512 || n >= 2560) return n; const int i = n & 63; return (n & ~63) + 16 * ((i >> 5) & 1) + 4 * ((i >> 3) & 3) + (i & 3) + 32 * ((i >> 2) & 1); }
__device__ __forceinline__ void tr_plain(const float* W, int K, int N, bf16* WT, int item, LAS float* scr, int lane) {
    const int nblk = N / 32, kb = item / nblk, nb = item % nblk;
    tr_item(W, N, K, WT + (size_t)(32 * nb) * K, 64 * kb, 32 * nb + (lane & 31), scr, lane);
}
__device__ __forceinline__ void tr_win(const float* W, bf16* WT, int item, LAS float* scr, int lane) {
    const int nblk = INCOLS / 32, kb = item / nblk, nb = item % nblk;
    tr_item(W, INCOLS, DMODEL, WT + (size_t)(32 * nb) * DMODEL, 64 * kb, win_orig(32 * nb + (lane & 31)), scr, lane);
}
__device__ __forceinline__ void tr_gu(const float* Wg, const float* Wu, bf16* WT, int item, LAS float* scr, int lane) {
    const int nblk = INCOLS / 32, kb = item / nblk, nb = item % nblk; const int n0 = 32 * nb, pn = n0 >> 8, r = n0 & 255;
    const float* W = r < 128 ? Wg : Wu; const int col = pn * 128 + (r & 127) + (lane & 31);
    tr_item(W, DFF, DMODEL, WT + (size_t)n0 * DMODEL, 64 * kb, col, scr, lane);
}
struct S5In { const float *lam_re, *lam_im, *log_dt, *b_re, *b_im, *c_re, *c_im, *dd; };
__device__ __forceinline__ v4u pack8f(const float* v) { v4u o; o.x = pk2(v[0], v[1]); o.y = pk2(v[2], v[3]); o.z = pk2(v[4], v[5]); o.w = pk2(v[6], v[7]); return o; }
__device__ __forceinline__ void s5_item(LAS unsigned char* L, int tid, const S5In& P, int lg, int d, bf16* TZF, bf16* EM) {
    LAS float* sm = (LAS float*)(L);
    LAS float *s_fr = sm, *s_fi = sm + 64, *s_apr = sm + 128, *s_api = sm + 192, *BBr = sm + 256, *BBi = sm + 1280, *CAr = sm + 2304, *CAi = sm + 3328, *Kd = sm + 4352;
    if (tid < 64) {
        const int p = tid;
        const float dt = expf(P.log_dt[lg]);
        const float lr = P.lam_re[lg * 64 + p], li = P.lam_im[lg * 64 + p];
        const float mag = expf(lr * dt); float sn, cs; sincosf(li * dt, &sn, &cs);
        const float ar = mag * cs, ai = mag * sn;
        const float den = lr * lr + li * li, nr = ar - 1.0f, ni = ai;
        s_fr[p] = (nr * lr + ni * li) / den; s_fi[p] = (ni * lr - nr * li) / den;
        const float fd = (float)d; const float magd = expf(fd * lr * dt); float snd, csd; sincosf(fd * li * dt, &snd, &csd);
        s_apr[p] = magd * csd; s_api[p] = magd * snd;
    }
    __syncthreads();
    for (int idx = tid; idx < 1024; idx += 512) {
        { const int p = idx >> 4; const float br = P.b_re[(size_t)lg * 1024 + idx], bi = P.b_im[(size_t)lg * 1024 + idx]; const float fr_ = s_fr[p], fi_ = s_fi[p];
          BBr[idx] = fr_ * br - fi_ * bi; BBi[idx] = fr_ * bi + fi_ * br; }
        { const int p = idx & 63; const float cr = P.c_re[(size_t)lg * 1024 + idx], ci = P.c_im[(size_t)lg * 1024 + idx]; const float ar_ = s_apr[p], ai_ = s_api[p];
          CAr[idx] = cr * ar_ - ci * ai_; CAi[idx] = cr * ai_ + ci * ar_; }
    }
    __syncthreads();
    if (d <= 31 && tid < 256) { const int j = tid >> 4, jp = tid & 15; float acc = 0.f;
        for (int p = 0; p < 64; ++p) acc += CAr[j * 64 + p] * BBr[p * 16 + jp] - CAi[j * 64 + p] * BBi[p * 16 + jp];
        if (d == 0 && j == jp) acc += P.dd[lg * 16 + j];
        Kd[tid] = acc; }
    __syncthreads();
    bf16* TZ = TZF + (size_t)lg * 512 * 640; bf16* EE = EM + (size_t)lg * 256 * 512;
    if (d <= 31) {
        const int cnt = (32 - d) * 16;
        for (int idx = tid; idx < cnt; idx += 512) { const int tt = idx >> 4, j = idx & 15; float v[16];
#pragma unroll
            for (int q = 0; q < 16; ++q) v[q] = Kd[j * 16 + q];
            bf16* dst = TZ + (size_t)((d + tt) * 16 + j) * 640 + tt * 16;
            *(GAS v4u*)dst = pack8f(v); *(GAS v4u*)(dst + 8) = pack8f(v + 8);
            if (d >= 1) { bf16* dz = TZ + (size_t)(tt * 16 + j) * 640 + (d + tt) * 16; const v4u z = {0u, 0u, 0u, 0u}; *(GAS v4u*)dz = z; *(GAS v4u*)(dz + 8) = z; } }
        if (tid < 128) { const int ri = tid >> 6, p = tid & 63; const float ar_ = s_apr[p], ai_ = s_api[p]; float v[16];
#pragma unroll
            for (int q = 0; q < 16; ++q) { const float br = BBr[p * 16 + q], bi = BBi[p * 16 + q]; v[q] = ri == 0 ? (ar_ * br - ai_ * bi) : (ar_ * bi + ai_ * br); }
            bf16* dst = EE + (size_t)tid * 512 + (31 - d) * 16; *(GAS v4u*)dst = pack8f(v); *(GAS v4u*)(dst + 8) = pack8f(v + 8);
        } else if (tid < 256) { bf16* dz = EE + (size_t)tid * 512 + (31 - d) * 16; const v4u z = {0u, 0u, 0u, 0u}; *(GAS v4u*)dz = z; *(GAS v4u*)(dz + 8) = z; }
    }
    if (d >= 1 && tid < 256) { const int j = tid >> 4, ri = (tid >> 3) & 1, pc = tid & 7; float v[8];
#pragma unroll
        for (int q = 0; q < 8; ++q) v[q] = ri == 0 ? CAr[j * 64 + pc * 8 + q] : -CAi[j * 64 + pc * 8 + q];
        *(GAS v4u*)(TZ + (size_t)((d - 1) * 16 + j) * 640 + 512 + ri * 64 + pc * 8) = pack8f(v); }
    __syncthreads();
}
__device__ __forceinline__ void norm_row(const float* xrow, const float* gain, bf16* orow, int lane, f32x4 (&hn)[4]) {
    const GAS f32x4* xr = (const GAS f32x4*)xrow + lane; const GAS f32x4* gr = (const GAS f32x4*)gain + lane;
    float s2 = 0.f;
#pragma unroll
    for (int j = 0; j < 4; ++j) { hn[j] = xr[64 * j]; s2 += (hn[j].x * hn[j].x + hn[j].y * hn[j].y) + (hn[j].z * hn[j].z + hn[j].w * hn[j].w); }
    const float rs = 1.0f / sqrtf(wave_sum(s2) * (1.0f / DMODEL) + EPS_NORM);
    GAS unsigned long long* o8 = (GAS unsigned long long*)orow + lane;
#pragma unroll
    for (int j = 0; j < 4; ++j) { const f32x4 g = gr[64 * j]; hn[j] = hn[j] * rs * g;
        o8[64 * j] = (unsigned long long)pk2(hn[j].x, hn[j].y) | ((unsigned long long)pk2(hn[j].z, hn[j].w) << 32); }
}

__global__ void __launch_bounds__(NWAVES * 64, 2) trunk_fwd(Args args) {
    extern __shared__ __attribute__((aligned(16))) unsigned char lds[];
    const int WAVE = __builtin_amdgcn_readfirstlane((int)threadIdx.x >> 6);
#define MYTID() ({ int l_; asm volatile("v_mbcnt_lo_u32_b32 %0, -1, 0\n\tv_mbcnt_hi_u32_b32 %0, -1, %0" : "=v"(l_)); WAVE * 64 + l_; })
    LAS unsigned char* const L0 = (LAS unsigned char*)lds;
#define OPQ LAS unsigned char* L = L0; asm volatile("" : "+s"(L))
    OPQ;
    {
        const int tid0 = MYTID();
        for (int u = tid0; u < (LDS_BYTES - LDSCTL_OFF) / 4; u += NWAVES * 64) ((LAS unsigned*)(L + LDSCTL_OFF))[u] = 0u;
        __syncthreads();
        if (tid0 == 0) {
#pragma unroll
            for (int k = 0; k < 31; ++k) ((LAS unsigned long long*)(L + PTR_OFF))[k] = (unsigned long long)(uintptr_t)args.in[k];
            ((LAS unsigned long long*)(L + PTR_OFF))[31] = (unsigned long long)(uintptr_t)args.out;
            ((LAS unsigned long long*)(L + PTR_OFF))[32] = (unsigned long long)(uintptr_t)args.ws; }
        __syncthreads();
    }
    { XcdBarrier b0 = xcd_barrier_post((unsigned*)(LDP(unsigned char, 32) + WS_CTL) + CW_BAR, (volatile LAS unsigned*)(L + MISC_OFF) + 8, MYTID()); (void)b0; }
#define GRID_BAR() do { OPQ; XcdBarrier b_; b_.bar = (unsigned*)(LDP(unsigned char, 32) + WS_CTL) + CW_BAR; b_.x = xb_xcc_id(); b_.st = (volatile LAS unsigned*)(L + MISC_OFF) + 8; xcd_barrier(b_, MYTID()); } while (0)
#define LQ() ({ int l_ = l; asm volatile("" : "+s"(l_)); l_; })
#define TID_SETUP OPQ; int wave_ = WAVE; asm volatile("" : "+s"(wave_)); const int wave = wave_; const int tid = MYTID(), lane = tid & 63; const int G = gridDim.x; const int vcu = ((int)blockIdx.x % 8) * (G / 8) + (int)blockIdx.x / 8; const int gw = vcu * NWAVES + wave, NGW = G * NWAVES; (void)lane; (void)gw; (void)NGW; (void)tid
#define WSP(T, off) ((T*)(LDP(unsigned char, 32) + (off)))
#define ACTP(T, off) ((T*)(LDP(unsigned char, 32) + WS_ACT + (off)))

    {
        TID_SETUP;
        LAS float* scr = (LAS float*)(L + RING_OFF + wave * 16384);
        constexpr int I_WIN = 16 * 176, I_GLU = 8 * 16, I_PS = 8 * 32, I_PA = 16 * 32, I_OUT = 16 * 32, I_GU = 16 * 176, I_DN = 44 * 32;
        constexpr int I_LAYER = I_WIN + I_GLU + I_PS + I_PA + I_OUT;
        constexpr int NITEMS = 2 * I_LAYER + I_GU + I_DN + 8 * I_GU + 8 * I_DN;
        for (int it = gw; it < NITEMS; it += NGW) {
            int r = it;
            if (r < 2 * I_LAYER) { const int l = r / I_LAYER; r -= l * I_LAYER;
                if (r < I_WIN) { tr_win(LDP(const float, 3) + (size_t)l * DMODEL * INCOLS, WSP(bf16, WS_WIN) + (size_t)l * INCOLS * DMODEL, r, scr, lane); continue; } r -= I_WIN;
                if (r < I_GLU) { tr_plain(LDP(const float, 12) + (size_t)l * 512 * 512, 512, 512, WSP(bf16, WS_WGLU) + (size_t)l * 512 * 512, r, scr, lane); continue; } r -= I_GLU;
                if (r < I_PS) { tr_plain(LDP(const float, 19) + (size_t)l * 512 * 1024, 512, 1024, WSP(bf16, WS_WPS) + (size_t)l * 1024 * 512, r, scr, lane); continue; } r -= I_PS;
                if (r < I_PA) { tr_plain(LDP(const float, 20) + (size_t)l * 1024 * 1024, 1024, 1024, WSP(bf16, WS_WPA) + (size_t)l * 1024 * 1024, r, scr, lane); continue; } r -= I_PA;
                tr_plain(LDP(const float, 21) + (size_t)l * 1024 * 1024, 1024, 1024, WSP(bf16, WS_WOUT) + (size_t)l * 1024 * 1024, r, scr, lane); continue; }
            r -= 2 * I_LAYER;
            if (r < I_GU) { tr_gu(LDP(const float, 23), LDP(const float, 24), WSP(bf16, WS_WDGU), r, scr, lane); continue; } r -= I_GU;
            if (r < I_DN) { tr_plain(LDP(const float, 25), DFF, DMODEL, WSP(bf16, WS_WDD), r, scr, lane); continue; } r -= I_DN;
            if (r < 8 * I_GU) { const int e = r / I_GU; r -= e * I_GU; tr_gu(LDP(const float, 27) + (size_t)e * DMODEL * DFF, LDP(const float, 28) + (size_t)e * DMODEL * DFF, WSP(bf16, WS_WMGU) + (size_t)e * INCOLS * DMODEL, r, scr, lane); continue; } r -= 8 * I_GU;
            { const int e = r / I_DN; r -= e * I_DN; tr_plain(LDP(const float, 29) + (size_t)e * DFF * DMODEL, DFF, DMODEL, WSP(bf16, WS_WMD) + (size_t)e * DMODEL * DFF, r, scr, lane); }
        }
        __syncthreads();
        { S5In s5p; s5p.lam_re = LDP(const float, 4); s5p.lam_im = LDP(const float, 5); s5p.log_dt = LDP(const float, 6); s5p.b_re = LDP(const float, 7); s5p.b_im = LDP(const float, 8);
          s5p.c_re = LDP(const float, 9); s5p.c_im = LDP(const float, 10); s5p.dd = LDP(const float, 11);
          for (int it = vcu; it < 2 * 32 * 33; it += G) s5_item(L, tid, s5p, it / 33, it % 33, WSP(bf16, WS_TZF), WSP(bf16, WS_EM)); }
        { const int* positions = LDP(const int, 1); float* ROPE = WSP(float, WS_ROPE);
          for (int idx = vcu * (NWAVES * 64) + tid; idx < NTOK * 32; idx += G * NWAVES * 64) { const int n = idx >> 5, fi = idx & 31;
            const float invf = powf(10000.0f, -(float)(2 * fi) / 64.0f); const float ang = (float)positions[n] * invf; float sn, cs; sincosf(ang, &sn, &cs);
            ROPE[(size_t)n * 64 + fi] = cs; ROPE[(size_t)n * 64 + 32 + fi] = sn; } }
    }
    GRID_BAR();

    for (int l = 0; l < 2; ++l) {
        for (int half = 0; half < 2; ++half) {
            const int tokbase = half * NH;
            { TID_SETUP; const float* xsrc = LDP(const float, (LQ() == 0) ? 0 : 31); const float* gain = LDP(const float, 2) + l * DMODEL; bf16* HB = ACTP(bf16, A_HB);
              for (int m = gw; m < NH; m += NGW) { f32x4 hn[4]; norm_row(xsrc + (size_t)(tokbase + m) * DMODEL, gain, HB + (size_t)m * DMODEL, lane, hn); } }
            GRID_BAR();
            { OPQ; pg8::Gemm g{ACTP(bf16, A_HB), WSP(bf16, WS_WIN) + (size_t)l * INCOLS * DMODEL, DMODEL, DMODEL, DMODEL}; pg8::SchedPlain S; S.init(NH / 256, INCOLS / 256, gridDim.x, (int)blockIdx.x);
              pg8::EpiIn E{ACTP(unsigned char, 0), WSP(const float, WS_ROPE), tokbase};
              pg8::gemm_phase<pg8::EpiIn, pg8::SchedPlain, true, true>(L0 + RING_OFF, g, S, E, MYTID()); }
            GRID_BAR();
            { OPQ; pg8::Gemm g{ACTP(bf16, A_UBUF), WSP(bf16, WS_EM) + (size_t)l * 32 * 256 * 512, 640, 512, 512}; pg8::SchedS5 S; S.init(1, gridDim.x, (int)blockIdx.x);
              pg8::EpiSloc E{ACTP(float, A_SLOC)};
              pg8::gemm_phase<pg8::EpiSloc, pg8::SchedS5, true, true>(L0 + RING_OFF, g, S, E, MYTID()); }
            GRID_BAR();
            { TID_SETUP;
              if (wave == 0) {
                const int id = vcu * 64 + lane;
                if (id < 8 * 32 * 64) { const int bl = id >> 11, g = (id >> 6) & 31, p = id & 63; const int lg = l * 32 + g;
                    const float dt = expf(LDP(const float, 6)[lg]); const float lr = LDP(const float, 4)[lg * 64 + p], li = LDP(const float, 5)[lg * 64 + p];
                    const float magT = expf(32.0f * lr * dt); float snT, csT; sincosf(32.0f * li * dt, &snT, &csT); const float aTr = magT * csT, aTi = magT * snT;
                    float sr = 0.f, si = 0.f; const size_t row0 = (size_t)g * 1024 + (size_t)bl * 128;
                    const float* sl = ACTP(const float, A_SLOC) + row0 * 128 + p; bf16* ub = ACTP(bf16, A_UBUF) + row0 * 640 + 512 + p;
                    for (int c0 = 0; c0 < 128; c0 += 8) { float lr_[8], li_[8];
#pragma unroll
                        for (int q = 0; q < 8; ++q) { lr_[q] = sl[(size_t)(c0 + q) * 128]; li_[q] = sl[(size_t)(c0 + q) * 128 + 64]; }
#pragma unroll
                        for (int q = 0; q < 8; ++q) { ub[(size_t)(c0 + q) * 640] = (bf16)f2bf(sr); ub[(size_t)(c0 + q) * 640 + 64] = (bf16)f2bf(si);
                            const float nr_ = aTr * sr - aTi * si + lr_[q], ni_ = aTr * si + aTi * sr + li_[q]; sr = nr_; si = ni_; } } }
              } }
            GRID_BAR();
            { OPQ; pg8::Gemm g{ACTP(bf16, A_UBUF), WSP(bf16, WS_TZF) + (size_t)l * 32 * 512 * 640, 640, 640, 640}; pg8::SchedS5 S; S.init(2, gridDim.x, (int)blockIdx.x);
              pg8::EpiYa E{ACTP(bf16, A_YA)};
              pg8::gemm_phase<pg8::EpiYa, pg8::SchedS5, true, true>(L0 + RING_OFF, g, S, E, MYTID()); }
            GRID_BAR();
            { OPQ; pg8::Gemm g{ACTP(bf16, A_YA), WSP(bf16, WS_WGLU) + (size_t)l * 512 * 512, 512, 512, 512}; pg8::SchedPlain S; S.init(NH / 256, 2, gridDim.x, (int)blockIdx.x);
              pg8::EpiGlu E{ACTP(bf16, A_YA), ACTP(bf16, A_YA2), LDP(const float, 13) + l * 512};
              pg8::gemm_phase<pg8::EpiGlu, pg8::SchedPlain, true, true>(L0 + RING_OFF, g, S, E, MYTID()); }
            GRID_BAR();
            {
                TID_SETUP;
                int lq = l; asm volatile("" : "+s"(lq));
                const float lam_init = 0.8f - 0.6f * expf(-0.3f * (float)lq);
                const float p1 = wave_sum(LDP(const float, 14)[lq * 64 + lane] * LDP(const float, 15)[lq * 64 + lane]), p2 = wave_sum(LDP(const float, 16)[lq * 64 + lane] * LDP(const float, 17)[lq * 64 + lane]);
                float lam_v = expf(p1) - expf(p2) + lam_init, gsc_v = 1.0f - lam_init; asm volatile("" : "+v"(lam_v), "+v"(gsc_v));
                const int lam_i = __builtin_amdgcn_readfirstlane(__builtin_bit_cast(int, lam_v)), gsc_i = __builtin_amdgcn_readfirstlane(__builtin_bit_cast(int, gsc_v));
                const float lam = __builtin_bit_cast(float, lam_i), gsc = __builtin_bit_cast(float, gsc_i);
                for (int i = 0; i < 8; ++i) {
                    OPQ; const int bh = (i >> 1) * 16 + (vcu >> 4); const int j = vcu & 15; const int qblk = (i & 1) ? 31 - j : j;
                    const int b = bh >> 3, h = bh & 7; const size_t rb = (size_t)b * SEQLEN;
                    attn_body::dattn2_unit<8>(qblk, (const attn_body::bf16*)(ACTP(bf16, A_Q) + rb * 1024 + h * 128), (const attn_body::bf16*)(ACTP(bf16, A_K) + rb * 1024 + h * 128),
                                             (const attn_body::bf16*)(ACTP(bf16, A_V) + rb * 1024 + h * 128), (attn_body::bf16*)(ACTP(bf16, A_YB) + rb * 1024 + h * 128),
                                             lam, LDP(const float, 18) + lq * 128, gsc, (char*)lds + RING_OFF, MYTID());
                }
            }
            GRID_BAR();
            { OPQ; pg8::Gemm g{ACTP(bf16, A_YA2), WSP(bf16, WS_WPS) + (size_t)l * 1024 * 512, 512, 512, 512}; pg8::SchedPlain S; S.init(NH / 256, 4, gridDim.x, (int)blockIdx.x);
              pg8::EpiGate<0> E{ACTP(bf16, A_SGS), nullptr};
              pg8::gemm_phase<pg8::EpiGate<0>, pg8::SchedPlain, true, true>(L0 + RING_OFF, g, S, E, MYTID()); }
            GRID_BAR();
            { OPQ; pg8::Gemm g{ACTP(bf16, A_YB), WSP(bf16, WS_WPA) + (size_t)l * 1024 * 1024, 1024, 1024, 1024}; pg8::SchedPlain S; S.init(NH / 256, 4, gridDim.x, (int)blockIdx.x);
              pg8::EpiGate<1> E{ACTP(bf16, A_SGA), ACTP(bf16, A_SGS)};
              pg8::gemm_phase<pg8::EpiGate<1>, pg8::SchedPlain, true, true>(L0 + RING_OFF, g, S, E, MYTID()); }
            GRID_BAR();
            { OPQ; pg8::Gemm g{ACTP(bf16, A_SGA), WSP(bf16, WS_WOUT) + (size_t)l * 1024 * 1024, 1024, 1024, 1024}; pg8::SchedPlain S; S.init(NH / 256, 4, gridDim.x, (int)blockIdx.x);
              pg8::EpiRes E{LDP(const float, (LQ() == 0) ? 0 : 31), LDP(float, 31), tokbase};
              pg8::gemm_phase<pg8::EpiRes, pg8::SchedPlain, true, true>(L0 + RING_OFF, g, S, E, MYTID()); }
            GRID_BAR();
            if (LQ() == 0) {
                { TID_SETUP; const float* xs = LDP(const float, 31); const float* gain = LDP(const float, 22); bf16* H2 = ACTP(bf16, A_H2);
                  for (int m = gw; m < NH; m += NGW) { f32x4 hn[4]; norm_row(xs + (size_t)(tokbase + m) * DMODEL, gain, H2 + (size_t)m * DMODEL, lane, hn); } }
                GRID_BAR();
                { OPQ; pg8::Gemm g{ACTP(bf16, A_H2), WSP(bf16, WS_WDGU), 1024, 1024, 1024}; pg8::SchedPlain S; S.init(NH / 256, 22, gridDim.x, (int)blockIdx.x);
                  pg8::EpiSwi E{ACTP(bf16, A_FA)};
                  pg8::gemm_phase<pg8::EpiSwi, pg8::SchedPlain, true, true>(L0 + RING_OFF, g, S, E, MYTID()); }
                GRID_BAR();
                { OPQ; pg8::Gemm g{ACTP(bf16, A_FA), WSP(bf16, WS_WDD), 2816, 2816, 2816}; pg8::SchedPlain S; S.init(NH / 256, 4, gridDim.x, (int)blockIdx.x);
                  pg8::EpiRes E{LDP(const float, 31), LDP(float, 31), tokbase};
                  pg8::gemm_phase<pg8::EpiRes, pg8::SchedPlain, true, true>(L0 + RING_OFF, g, S, E, MYTID()); }
                GRID_BAR();
            } else {
                {
                    TID_SETUP;
                    LAS float* rwT = (LAS float*)(L);
                    LAS unsigned* cntL = (LAS unsigned*)(L + 32768);
                    { const float* router_w = LDP(const float, 26); for (int idx = tid; idx < 8192; idx += NWAVES * 64) { const int k = idx >> 3, e = idx & 7; rwT[e * 1024 + k] = router_w[idx]; } }
                    if (tid < 8) cntL[tid] = 0u;
                    __syncthreads();
                    const float* xs = LDP(const float, 31); const float* gain = LDP(const float, 22) + DMODEL; bf16* H2 = ACTP(bf16, A_H2);
                    unsigned* RT_E = WSP(unsigned, WS_ROUTE + R_E); float* RT_W = WSP(float, WS_ROUTE + R_W);
                    for (int i = 0; i < 16; ++i) { const int row = vcu * 128 + wave * 16 + i;
                        f32x4 hn[4]; norm_row(xs + (size_t)(tokbase + row) * DMODEL, gain, H2 + (size_t)row * DMODEL, lane, hn);
                        float lg[8];
#pragma unroll
                        for (int e = 0; e < 8; ++e) { float a = 0.f;
#pragma unroll
                            for (int j = 0; j < 4; ++j) { const f32x4 w = *(const LAS f32x4*)(rwT + e * 1024 + 4 * lane + 256 * j); a += (hn[j].x * w.x + hn[j].y * w.y) + (hn[j].z * w.z + hn[j].w * w.w); }
                            lg[e] = wave_sum(a); }
                        if (lane == 0) { int e1 = 0; float v1 = lg[0];
#pragma unroll
                            for (int e = 1; e < 8; ++e) if (lg[e] > v1) { v1 = lg[e]; e1 = e; }
                            int e2 = -1; float v2 = -INFINITY;
#pragma unroll
                            for (int e = 0; e < 8; ++e) if (e != e1 && lg[e] > v2) { v2 = lg[e]; e2 = e; }
                            if (e2 < 0) e2 = (e1 == 0) ? 1 : 0;
                            const float ex = expf(v2 - v1); const float w1 = 1.0f / (1.0f + ex), w2 = ex / (1.0f + ex);
                            RT_E[row] = (unsigned)e1 | ((unsigned)e2 << 8); RT_W[2 * row] = w1; RT_W[2 * row + 1] = w2;
                            __hip_atomic_fetch_add(cntL + e1, 1u, __ATOMIC_RELAXED, __HIP_MEMORY_SCOPE_WORKGROUP); __hip_atomic_fetch_add(cntL + e2, 1u, __ATOMIC_RELAXED, __HIP_MEMORY_SCOPE_WORKGROUP); }
                    }
                    __syncthreads();
                    if (tid < 8) WSP(unsigned, WS_ROUTE + R_CNT)[vcu * 8 + tid] = cntL[tid];
                }
                GRID_BAR();
                {
                    TID_SETUP;
                    volatile LAS unsigned* MISC = (volatile LAS unsigned*)(L + MISC_OFF);
                    LAS unsigned* tab = (LAS unsigned*)(L);
                    LAS unsigned* tot = (LAS unsigned*)(L + 8192);
                    LAS unsigned* off = (LAS unsigned*)(L + 8192 + 64);
                    LAS unsigned* wcn = (LAS unsigned*)(L + 8192 + 128);
                    LAS unsigned* slt = (LAS unsigned*)(L + 8192 + 512);
                    const unsigned* RT_CNT = WSP(const unsigned, WS_ROUTE + R_CNT); const unsigned* RT_E = WSP(const unsigned, WS_ROUTE + R_E); int* RT_S = WSP(int, WS_ROUTE + R_S);
                    const bf16* H2 = ACTP(const bf16, A_H2); bf16* H2G = ACTP(bf16, A_H2G);
                    if (tid < 256) { const GAS v4u* src = (const GAS v4u*)(RT_CNT + tid * 8); const v4u a = src[0], b = src[1];
                        tab[tid * 8 + 0] = a.x; tab[tid * 8 + 1] = a.y; tab[tid * 8 + 2] = a.z; tab[tid * 8 + 3] = a.w; tab[tid * 8 + 4] = b.x; tab[tid * 8 + 5] = b.y; tab[tid * 8 + 6] = b.z; tab[tid * 8 + 7] = b.w; }
                    __syncthreads();
                    if (tid < 8) { unsigned t = 0, o = 0; for (int blk = 0; blk < 256; ++blk) { const unsigned c = tab[blk * 8 + tid]; if (blk < vcu) o += c; t += c; } tot[tid] = t; off[tid] = o; }
                    __syncthreads();
                    if (tid == 0) { unsigned sp = 0; for (int e = 0; e < 8; ++e) { MISC[16 + e] = sp; sp += (tot[e] + 255u) >> 8; } MISC[24] = sp; }
                    __syncthreads();
                    int my_e = 0, my_rank = 0;
                    if (tid < 256) { const int row = vcu * 128 + (tid >> 1); const unsigned ee = RT_E[row]; my_e = (tid & 1) ? (int)((ee >> 8) & 255u) : (int)(ee & 255u);
#pragma unroll
                        for (int e = 0; e < 8; ++e) { const unsigned long long mask = __ballot(my_e == e); if (my_e == e) my_rank = __popcll(mask & ((1ull << lane) - 1ull)); if (lane == 0) wcn[wave * 8 + e] = (unsigned)__popcll(mask); } }
                    __syncthreads();
                    if (tid < 256) { unsigned pre = 0; for (int w = 0; w < wave; ++w) pre += wcn[w * 8 + my_e];
                        const unsigned slot = MISC[16 + my_e] * 256u + off[my_e] + pre + (unsigned)my_rank;
                        RT_S[(vcu * 128 + (tid >> 1)) * 2 + (tid & 1)] = (int)slot; slt[tid] = slot; }
                    __syncthreads();
                    for (int i = 0; i < 32; ++i) { const int id = wave * 32 + i; const unsigned slot = slt[id];
                        const GAS v4u* src = (const GAS v4u*)(H2 + (size_t)(vcu * 128 + (id >> 1)) * DMODEL) + lane * 2; GAS v4u* dst = (GAS v4u*)(H2G + (size_t)slot * DMODEL) + lane * 2;
                        const v4u a = src[0], b = src[1]; dst[0] = a; dst[1] = b; }
                    if (vcu < 8) { const unsigned e = (unsigned)vcu; const unsigned r0 = MISC[16 + e] * 256u + tot[e], r1 = MISC[17 + e] * 256u; const v4u z = {0u, 0u, 0u, 0u};
                        for (unsigned r = r0 + (unsigned)wave; r < r1; r += NWAVES) { GAS v4u* dst = (GAS v4u*)(H2G + (size_t)r * DMODEL) + lane * 2; dst[0] = z; dst[1] = z; } }
                }
                GRID_BAR();
#define MOE_SCHED(S, NN) do { volatile LAS unsigned* MISC = (volatile LAS unsigned*)(L + MISC_OFF); S.nn = (NN); \
        S.sp1 = __builtin_amdgcn_readfirstlane((int)MISC[17]); S.sp2 = __builtin_amdgcn_readfirstlane((int)MISC[18]); S.sp3 = __builtin_amdgcn_readfirstlane((int)MISC[19]); S.sp4 = __builtin_amdgcn_readfirstlane((int)MISC[20]); \
        S.sp5 = __builtin_amdgcn_readfirstlane((int)MISC[21]); S.sp6 = __builtin_amdgcn_readfirstlane((int)MISC[22]); S.sp7 = __builtin_amdgcn_readfirstlane((int)MISC[23]); \
        S.so.init(__builtin_amdgcn_readfirstlane((int)MISC[24]), (NN), gridDim.x, (int)blockIdx.x); } while (0)
                { OPQ; pg8::SchedMoe S; MOE_SCHED(S, 22);
                  pg8::Gemm g{ACTP(bf16, A_H2G), WSP(bf16, WS_WMGU), 1024, 1024, 1024}; pg8::EpiSwi E{ACTP(bf16, A_AG)};
                  pg8::gemm_phase<pg8::EpiSwi, pg8::SchedMoe, true, true>(L0 + RING_OFF, g, S, E, MYTID()); }
                GRID_BAR();
                { OPQ; pg8::SchedMoe S; MOE_SCHED(S, 4);
                  pg8::Gemm g{ACTP(bf16, A_AG), WSP(bf16, WS_WMD), 2816, 2816, 2816}; pg8::EpiBf E{ACTP(bf16, A_YG)};
                  pg8::gemm_phase<pg8::EpiBf, pg8::SchedMoe, true, true>(L0 + RING_OFF, g, S, E, MYTID()); }
                GRID_BAR();
                {
                    TID_SETUP;
                    const int* RT_S = WSP(const int, WS_ROUTE + R_S); const float* RT_W = WSP(const float, WS_ROUTE + R_W); float* xo = LDP(float, 31); const bf16* YG = ACTP(const bf16, A_YG);
                    const GAS f32x4* gr = (const GAS f32x4*)LDP(const float, 30) + lane;
                    for (int m = gw; m < NH; m += NGW) {
                        const int s1 = RT_S[2 * m], s2 = RT_S[2 * m + 1]; const float w1 = RT_W[2 * m], w2 = RT_W[2 * m + 1];
                        GAS f32x4* xr = (GAS f32x4*)(xo + (size_t)(tokbase + m) * DMODEL) + lane;
                        const GAS unsigned long long* y1 = (const GAS unsigned long long*)(YG + (size_t)s1 * DMODEL) + lane; const GAS unsigned long long* y2 = (const GAS unsigned long long*)(YG + (size_t)s2 * DMODEL) + lane;
                        f32x4 v[4]; float sq = 0.f;
#pragma unroll
                        for (int j = 0; j < 4; ++j) { const unsigned long long a = y1[64 * j], b = y2[64 * j]; f32x4 xa = xr[64 * j];
                            const unsigned alo = (unsigned)a, ahi = (unsigned)(a >> 32), blo = (unsigned)b, bhi = (unsigned)(b >> 32);
                            xa.x += w1 * __uint_as_float(alo << 16) + w2 * __uint_as_float(blo << 16); xa.y += w1 * __uint_as_float(alo & 0xffff0000u) + w2 * __uint_as_float(blo & 0xffff0000u);
                            xa.z += w1 * __uint_as_float(ahi << 16) + w2 * __uint_as_float(bhi << 16); xa.w += w1 * __uint_as_float(ahi & 0xffff0000u) + w2 * __uint_as_float(bhi & 0xffff0000u);
                            v[j] = xa; sq += (xa.x * xa.x + xa.y * xa.y) + (xa.z * xa.z + xa.w * xa.w); }
                        const float rs = 1.0f / sqrtf(wave_sum(sq) * (1.0f / DMODEL) + EPS_NORM);
#pragma unroll
                        for (int j = 0; j < 4; ++j) xr[64 * j] = v[j] * rs * gr[64 * j];
                    }
                }
                GRID_BAR();
            }
        }
    }
#undef GRID_BAR
#undef TID_SETUP
#undef LQ
#undef MYTID
#undef OPQ
#undef WSP
#undef ACTP
#undef MOE_SCHED
}

extern "C" void kernel_launch(void* const* d_in, const int* in_sizes, int n_in, void* d_out, int out_size, void* d_ws, size_t ws_size, hipStream_t stream) {
    static int grid = 0;
    if (grid == 0) {
        if (n_in != 31 || in_sizes[0] != NTOK * DMODEL || out_size != NTOK * DMODEL || ws_size < WS_END) {
            fprintf(stderr, "kernel_launch: unexpected shapes: n_in %d in0 %d out %d ws %zu (need %zu); nothing launched\n", n_in, n_in > 0 ? in_sizes[0] : -1, out_size, ws_size, (size_t)WS_END); grid = -1; return; }
        int dev = 0, cus = 0, per_cu = 0;
        if (hipGetDevice(&dev) != hipSuccess || hipDeviceGetAttribute(&cus, hipDeviceAttributeMultiprocessorCount, dev) != hipSuccess) { grid = -1; return; }
        if (hipFuncSetAttribute((const void*)trunk_fwd, hipFuncAttributeMaxDynamicSharedMemorySize, LDS_BYTES) != hipSuccess) { fprintf(stderr, "kernel_launch: hipFuncSetAttribute failed\n"); grid = -1; return; }
        if (hipOccupancyMaxActiveBlocksPerMultiprocessor(&per_cu, (const void*)trunk_fwd, NWAVES * 64, LDS_BYTES) != hipSuccess || per_cu < 1)
            fprintf(stderr, "kernel_launch: note: occupancy query reports %d workgroups per CU\n", per_cu);
        (void)hipGetLastError();
        grid = 256;
        if (cus < 256) { fprintf(stderr, "kernel_launch: device has %d CUs, need 256; nothing launched\n", cus); grid = -1; return; }
    }
    if (grid < 0) return;
    if (hipMemsetAsync((char*)d_ws + WS_CTL, 0, CTL_ZERO_BYTES, stream) != hipSuccess) return;
    Args a{};
    for (int i = 0; i < 31; ++i) a.in[i] = d_in[i];
    a.out = (float*)d_out; a.ws = (unsigned char*)d_ws;
    hipLaunchKernelGGL(trunk_fwd, dim3(grid), dim3(NWAVES * 64), LDS_BYTES, stream, a);
}
```

```cpp
#include <hip/hip_runtime.h>
#include <hip/hip_bf16.h>
#include <cstdio>
#include <cstdint>
#include <cmath>
namespace pg8 {
#define PG8_LAS __attribute__((address_space(3)))
typedef unsigned short bf16_t;
typedef short bf16x8 __attribute__((ext_vector_type(8)));
typedef float f32x4 __attribute__((ext_vector_type(4)));
typedef unsigned u32x4 __attribute__((ext_vector_type(4)));
constexpr int BM = 256, BK = 64, HALF = 128, HTB = HALF * BK * 2  , STAGE_BYTES = 8 * HTB, NXCD = 8, WGM = 8;

__host__ __device__ __forceinline__ int lds_byte(int r, int c) { const int st = (r >> 4) * 2 + (c >> 5), rr = r & 15, cc = c & 31, ob = rr * 64 + cc * 2; return st * 1024 + (ob ^ (((ob >> 9) & 1) << 5)); }
__host__ __device__ __forceinline__ void stage_rc(int b, int& R, int& C) { const int st = b / 1024, sb = b % 1024, swz = sb ^ (((sb >> 9) & 1) << 5); R = (st >> 1) * 16 + swz / 64; C = (st & 1) * 32 + (swz % 64) / 2; }
__host__ __device__ __forceinline__ int perm32(int rho) { const int n = rho >> 4, i = rho & 15; return 8 * (i >> 2) + 4 * n + (i & 3); }

struct Unit { int pm, pn; };
struct Gemm { const bf16_t* A; const bf16_t* Bt; int lda, ldb, K; };

struct StaticOrder {
    int nM, nN, nwg, G, c;
    __host__ __device__ void init(int nM_, int nN_, int G_, int c_) { nM = nM_; nN = nN_; nwg = nM * nN; G = G_; c = c_; }
    __host__ __device__ bool next(int i, Unit& u) const {
        const long L = (long)i * G + c; if (L >= nwg) return false;
        int wgid = (int)L; { const int q = nwg / NXCD, r = nwg % NXCD, xcd = wgid % NXCD, off = wgid / NXCD; wgid = (xcd < r ? xcd * (q + 1) : r * (q + 1) + (xcd - r) * q) + off; }
        const int nig = WGM * nN, gid = wgid / nig, fm = gid * WGM, gsz = (nM - fm) < WGM ? (nM - fm) : WGM;
        u.pm = fm + ((wgid % nig) % gsz); u.pn = (wgid % nig) / gsz; return true;
    }
    __device__ __forceinline__ void a_ready(const Unit&) const {}
    __device__ __forceinline__ void done(const Unit&) const {}
};


struct SchedPlain {
    StaticOrder so;
    __device__ __forceinline__ void init(int nM, int nN, int G, int c) { so.init(nM, nN, G, c); }
    __device__ __forceinline__ bool next(int i, Unit& u) const { return so.next(i, u); }
    __device__ __forceinline__ void a_ready(const Unit&) const {}
    __device__ __forceinline__ void done(const Unit&) const {}
};
struct SchedS5 {
    StaticOrder so; int nng;
    __device__ __forceinline__ void init(int nng_, int G, int c) { nng = nng_; so.init(128, nng_, G, c); }
    __device__ __forceinline__ bool next(int i, Unit& u) const { if (!so.next(i, u)) return false; u.pn = (u.pm >> 2) * nng + u.pn; return true; }
    __device__ __forceinline__ void a_ready(const Unit&) const {}
    __device__ __forceinline__ void done(const Unit&) const {}
};
struct SchedMoe {
    StaticOrder so; int nn; int sp1, sp2, sp3, sp4, sp5, sp6, sp7;
    __device__ __forceinline__ bool next(int i, Unit& u) const {
        if (!so.next(i, u)) return false;
        const int pm = u.pm; const int e = (pm >= sp1) + (pm >= sp2) + (pm >= sp3) + (pm >= sp4) + (pm >= sp5) + (pm >= sp6) + (pm >= sp7);
        u.pn = e * nn + u.pn; return true;
    }
    __device__ __forceinline__ void a_ready(const Unit&) const {}
    __device__ __forceinline__ void done(const Unit&) const {}
};

typedef float f32x2c_t __attribute__((ext_vector_type(2))); typedef __bf16 bf16x2c_t __attribute__((ext_vector_type(2)));
__device__ __forceinline__ unsigned cvt_pk_bf16(float lo, float hi) { f32x2c_t v = {lo, hi}; bf16x2c_t b = __builtin_convertvector(v, bf16x2c_t); return __builtin_bit_cast(unsigned, b); }
__device__ __forceinline__ u32x4 pack8(const f32x4 a, const f32x4 b) { u32x4 w; w.x = cvt_pk_bf16(a[0], a[1]); w.y = cvt_pk_bf16(a[2], a[3]); w.z = cvt_pk_bf16(b[0], b[1]); w.w = cvt_pk_bf16(b[2], b[3]); return w; }
__device__ __forceinline__ void unpack8(const u32x4 w, f32x4& a, f32x4& b) {
    a[0] = __uint_as_float(w.x << 16); a[1] = __uint_as_float(w.x & 0xffff0000u); a[2] = __uint_as_float(w.y << 16); a[3] = __uint_as_float(w.y & 0xffff0000u);
    b[0] = __uint_as_float(w.z << 16); b[1] = __uint_as_float(w.z & 0xffff0000u); b[2] = __uint_as_float(w.w << 16); b[3] = __uint_as_float(w.w & 0xffff0000u); }
__device__ __forceinline__ float sigm(float z) { return __builtin_amdgcn_rcpf(1.0f + __builtin_amdgcn_exp2f(-1.4426950408889634f * z)); }
__device__ __forceinline__ f32x4 sigm4(const f32x4 z) { f32x4 r; r[0] = sigm(z[0]); r[1] = sigm(z[1]); r[2] = sigm(z[2]); r[3] = sigm(z[3]); return r; }
__device__ __forceinline__ float gelu_t(float x) { const float u = 1.5957691216057308f * (x + 0.044715f * x * x * x); return x * sigm(u); }
__device__ __forceinline__ f32x4 gelu4(const f32x4 z) { f32x4 r; r[0] = gelu_t(z[0]); r[1] = gelu_t(z[1]); r[2] = gelu_t(z[2]); r[3] = gelu_t(z[3]); return r; }
constexpr size_t EA_U = (size_t)64 << 20, EA_Q = (size_t)120 << 20, EA_K = (size_t)184 << 20, EA_V = (size_t)248 << 20, EA_SGS = (size_t)312 << 20, EA_SGA = (size_t)376 << 20;
constexpr float QSCALE = 0.125f * 1.4426950408889634f;

struct EpiIn {
    static constexpr bool PERM = true, AFTER_DRAIN = false;
    unsigned char* act; const float* rope; int tokbase;
    __device__ __forceinline__ void operator()(const f32x4 (&acc)[2][2][4][2], const Unit& u, int wr, int wc, int fr_in, int fq_in) const {
        int fr = fr_in, fq = fq_in; asm volatile("" : "+v"(fr), "+v"(fq));
        const int pn = u.pn, rowb = u.pm * BM + wr * 64 + fr, cow = wc * 32 + fq * 8;
        if (pn < 2) {
#pragma unroll
            for (int ai = 0; ai < 2; ++ai)
#pragma unroll
                for (int m = 0; m < 4; ++m) { const int row = rowb + ai * HALF + m * 16;
#pragma unroll
                    for (int bj = 0; bj < 2; ++bj) { const int c = pn * 256 + bj * HALF + cow; const int g = c >> 4, jj = c & 15;
                        bf16_t* dst = (bf16_t*)(act + EA_U) + ((size_t)(g * 1024 + (row >> 5)) * 640 + (row & 31) * 16 + jj);
                        *(u32x4*)dst = pack8(acc[ai][bj][m][0], acc[ai][bj][m][1]); } }
        } else if (pn < 10) {
            const bool isq = pn < 6; bf16_t* base = (bf16_t*)(act + (isq ? EA_Q : EA_K)); const int colt = (isq ? pn - 2 : pn - 6) * 256; const float sc = isq ? QSCALE : 1.0f;
            const int dlo = 16 * (wc & 1) + 4 * fq;
#pragma unroll
            for (int ai = 0; ai < 2; ++ai)
#pragma unroll
                for (int m = 0; m < 4; ++m) { const int row = rowb + ai * HALF + m * 16;
                    const float* tr = rope + (size_t)(tokbase + row) * 64 + dlo; const f32x4 cs = *(const f32x4*)tr, sn = *(const f32x4*)(tr + 32);
#pragma unroll
                    for (int bj = 0; bj < 2; ++bj) { const f32x4 v0 = acc[ai][bj][m][0], v1 = acc[ai][bj][m][1];
                        const f32x4 o0 = (v0 * cs - v1 * sn) * sc, o1 = (v1 * cs + v0 * sn) * sc;
                        *(u32x4*)(base + (size_t)row * 1024 + colt + bj * HALF + cow) = pack8(o0, o1); } }
        } else if (pn < 14) {
            const int colt = (pn - 10) * 256;
#pragma unroll
            for (int ai = 0; ai < 2; ++ai)
#pragma unroll
                for (int m = 0; m < 4; ++m) { const int row = rowb + ai * HALF + m * 16;
#pragma unroll
                    for (int bj = 0; bj < 2; ++bj) *(u32x4*)((bf16_t*)(act + EA_V) + (size_t)row * 1024 + colt + bj * HALF + cow) = pack8(acc[ai][bj][m][0], acc[ai][bj][m][1]); }
        } else {
            bf16_t* base = (bf16_t*)(act + (pn < 18 ? EA_SGS : EA_SGA)); const int colt = (pn < 18 ? pn - 14 : pn - 18) * 256;
#pragma unroll
            for (int ai = 0; ai < 2; ++ai)
#pragma unroll
                for (int m = 0; m < 4; ++m) { const int row = rowb + ai * HALF + m * 16;
#pragma unroll
                    for (int bj = 0; bj < 2; ++bj) *(u32x4*)(base + (size_t)row * 1024 + colt + bj * HALF + cow) = pack8(sigm4(acc[ai][bj][m][0]), sigm4(acc[ai][bj][m][1])); }
        }
    }
};
struct EpiSloc {
    static constexpr bool PERM = false, AFTER_DRAIN = false;
    float* S;
    __device__ __forceinline__ void operator()(const f32x4 (&acc)[2][2][4][2], const Unit& u, int wr, int wc, int fr_in, int fq_in) const {
        int fr = fr_in, fq = fq_in; asm volatile("" : "+v"(fr), "+v"(fq));
        const int rowb = u.pm * BM + wr * 64 + fr, col0 = wc * 32 + 4 * fq;
#pragma unroll
        for (int ai = 0; ai < 2; ++ai)
#pragma unroll
            for (int m = 0; m < 4; ++m) { float* rowp = S + (size_t)(rowb + ai * HALF + m * 16) * 128 + col0;
#pragma unroll
                for (int n = 0; n < 2; ++n) *(f32x4*)(rowp + n * 16) = acc[ai][0][m][n]; }
    }
};
struct EpiYa {
    static constexpr bool PERM = true, AFTER_DRAIN = false;
    bf16_t* YA;
    __device__ __forceinline__ void operator()(const f32x4 (&acc)[2][2][4][2], const Unit& u, int wr, int wc, int fr_in, int fq_in) const {
        int fr = fr_in, fq = fq_in; asm volatile("" : "+v"(fr), "+v"(fq));
        const int g = u.pm >> 2, pni = u.pn & 1; const int rowb = (u.pm & 3) * BM + wr * 64 + fr; const int jj = 8 * (fq & 1);
#pragma unroll
        for (int ai = 0; ai < 2; ++ai)
#pragma unroll
            for (int m = 0; m < 4; ++m) { const int R = rowb + ai * HALF + m * 16;
#pragma unroll
                for (int bj = 0; bj < 2; ++bj) { const int t = pni * 16 + bj * 8 + wc * 2 + (fq >> 1);
                    *(u32x4*)(YA + (size_t)(R * 32 + t) * 512 + g * 16 + jj) = pack8(gelu4(acc[ai][bj][m][0]), gelu4(acc[ai][bj][m][1])); } }
    }
};
struct EpiGlu {
    static constexpr bool PERM = true, AFTER_DRAIN = false;
    const bf16_t* YA; bf16_t* O; const float* bias;
    __device__ __forceinline__ void operator()(const f32x4 (&acc)[2][2][4][2], const Unit& u, int wr, int wc, int fr_in, int fq_in) const {
        int fr = fr_in, fq = fq_in; asm volatile("" : "+v"(fr), "+v"(fq));
        const int rowb = u.pm * BM + wr * 64 + fr, col0 = u.pn * BM + wc * 32 + 8 * fq;
        f32x4 bv[2][2];
#pragma unroll
        for (int bj = 0; bj < 2; ++bj)
#pragma unroll
            for (int n = 0; n < 2; ++n) bv[bj][n] = *(const f32x4*)(bias + col0 + bj * HALF + 4 * n);
#pragma unroll
        for (int ai = 0; ai < 2; ++ai)
#pragma unroll
            for (int m = 0; m < 4; ++m) { const size_t off = (size_t)(rowb + ai * HALF + m * 16) * 512 + col0;
#pragma unroll
                for (int bj = 0; bj < 2; ++bj) { f32x4 y0, y1; unpack8(*(const u32x4*)(YA + off + bj * HALF), y0, y1);
                    *(u32x4*)(O + off + bj * HALF) = pack8(y0 * sigm4(acc[ai][bj][m][0] + bv[bj][0]), y1 * sigm4(acc[ai][bj][m][1] + bv[bj][1])); } }
    }
};
template <int MODE> struct EpiGate {
    static constexpr bool PERM = true, AFTER_DRAIN = false;
    bf16_t* G; const bf16_t* T0;
    __device__ __forceinline__ void operator()(const f32x4 (&acc)[2][2][4][2], const Unit& u, int wr, int wc, int fr_in, int fq_in) const {
        int fr = fr_in, fq = fq_in; asm volatile("" : "+v"(fr), "+v"(fq));
        const int rowb = u.pm * BM + wr * 64 + fr, col0 = u.pn * BM + wc * 32 + 8 * fq;
#pragma unroll
        for (int ai = 0; ai < 2; ++ai)
#pragma unroll
            for (int m = 0; m < 4; ++m) { const size_t off = (size_t)(rowb + ai * HALF + m * 16) * 1024 + col0;
#pragma unroll
                for (int bj = 0; bj < 2; ++bj) { f32x4 g0, g1; unpack8(*(const u32x4*)(G + off + bj * HALF), g0, g1);
                    f32x4 o0 = g0 * acc[ai][bj][m][0], o1 = g1 * acc[ai][bj][m][1];
                    if (MODE == 1) { f32x4 t0, t1; unpack8(*(const u32x4*)(T0 + off + bj * HALF), t0, t1); o0 += t0; o1 += t1; }
                    *(u32x4*)(G + off + bj * HALF) = pack8(o0, o1); } }
    }
};
struct EpiRes {
    static constexpr bool PERM = false, AFTER_DRAIN = false;
    const float* xin; float* xout; int tokbase;
    __device__ __forceinline__ void operator()(const f32x4 (&acc)[2][2][4][2], const Unit& u, int wr, int wc, int fr_in, int fq_in) const {
        int fr = fr_in, fq = fq_in; asm volatile("" : "+v"(fr), "+v"(fq));
        const int rowb = tokbase + u.pm * BM + wr * 64 + fr, col0 = u.pn * BM + wc * 32 + 4 * fq;
#pragma unroll
        for (int ai = 0; ai < 2; ++ai)
#pragma unroll
            for (int m = 0; m < 4; ++m) { const size_t off = (size_t)(rowb + ai * HALF + m * 16) * 1024 + col0;
#pragma unroll
                for (int bj = 0; bj < 2; ++bj)
#pragma unroll
                    for (int n = 0; n < 2; ++n) { const f32x4 xi = *(const f32x4*)(xin + off + bj * HALF + n * 16); *(f32x4*)(xout + off + bj * HALF + n * 16) = xi + acc[ai][bj][m][n]; } }
    }
};
struct EpiSwi {
    static constexpr bool PERM = true, AFTER_DRAIN = false;
    bf16_t* O;
    __device__ __forceinline__ void operator()(const f32x4 (&acc)[2][2][4][2], const Unit& u, int wr, int wc, int fr_in, int fq_in) const {
        int fr = fr_in, fq = fq_in; asm volatile("" : "+v"(fr), "+v"(fq));
        const int rowb = u.pm * BM + wr * 64 + fr, col0 = (u.pn % 22) * HALF + wc * 32 + 8 * fq;
#pragma unroll
        for (int ai = 0; ai < 2; ++ai)
#pragma unroll
            for (int m = 0; m < 4; ++m) { const f32x4 g0 = acc[ai][0][m][0], g1 = acc[ai][0][m][1];
                *(u32x4*)(O + (size_t)(rowb + ai * HALF + m * 16) * 2816 + col0) = pack8(g0 * sigm4(g0) * acc[ai][1][m][0], g1 * sigm4(g1) * acc[ai][1][m][1]); }
    }
};
struct EpiBf {
    static constexpr bool PERM = true, AFTER_DRAIN = false;
    bf16_t* O;
    __device__ __forceinline__ void operator()(const f32x4 (&acc)[2][2][4][2], const Unit& u, int wr, int wc, int fr_in, int fq_in) const {
        int fr = fr_in, fq = fq_in; asm volatile("" : "+v"(fr), "+v"(fq));
        const int rowb = u.pm * BM + wr * 64 + fr, col0 = (u.pn & 3) * BM + wc * 32 + 8 * fq;
#pragma unroll
        for (int ai = 0; ai < 2; ++ai)
#pragma unroll
            for (int m = 0; m < 4; ++m)
#pragma unroll
                for (int bj = 0; bj < 2; ++bj) *(u32x4*)(O + (size_t)(rowb + ai * HALF + m * 16) * 1024 + col0 + bj * HALF) = pack8(acc[ai][bj][m][0], acc[ai][bj][m][1]);
    }
};

template <class Epi, class Sched, bool ALIGN_EPI = false, bool SP2 = false>
__device__ __forceinline__ void gemm_phase(PG8_LAS unsigned char* lds, const Gemm g, const Sched& S, const Epi& E, const int tid_in) {
    const int tid = tid_in, wid = __builtin_amdgcn_readfirstlane(tid >> 6), lane = tid & 63, wr = wid >> 2, wc = wid & 3, fr = lane & 15, fq = lane >> 4;
    const int K = g.K, nt = K / BK;
    unsigned voffA[2], voffB[2];
#pragma unroll
    for (int i = 0; i < 2; ++i) { int R, C; stage_rc(tid * 16 + i * 8192, R, C); const int Rb = Epi::PERM ? ((R & ~31) + perm32(R & 31)) : R;
        voffA[i] = (unsigned)(R * g.lda + C) * 2u; voffB[i] = (unsigned)(Rb * g.ldb + C) * 2u; }
    const size_t kstep = (size_t)(BK * 2);
    const size_t hstepA = (size_t)HALF * g.lda * 2, hstepB = (size_t)HALF * g.ldb * 2;
    const size_t tstepA = 2 * hstepA, tstepB = 2 * hstepB;
    const unsigned ldsw = (unsigned)wid * 1024u;
    const int aoff = lds_byte(wr * 64 + fr, fq * 8), boff = lds_byte(wc * 32 + fr, fq * 8);
#define PG8_SA(b, h) (((b) * 2 + (h)) * HTB)
#define PG8_SB(b, h) ((4 + (b) * 2 + (h)) * HTB)
#define PG8_STAGE(bufoff, gbase, voff) do { _Pragma("unroll") for (int _i = 0; _i < 2; ++_i) \
        __builtin_amdgcn_global_load_lds((const unsigned*)((const char*)(gbase) + (voff)[_i]), (PG8_LAS unsigned*)(lds + (bufoff) + ldsw + _i * 8192), 16, 0, 0); } while (0)
#define PG8_LDA(dst, b, h) do { _Pragma("unroll") for (int m = 0; m < 4; ++m) _Pragma("unroll") for (int k = 0; k < 2; ++k) dst[m][k] = *(const PG8_LAS bf16x8*)(lds + PG8_SA(b, h) + aoff + m * 2048 + k * 1024); } while (0)
#define PG8_LDB(dst, b, h) do { _Pragma("unroll") for (int n = 0; n < 2; ++n) _Pragma("unroll") for (int k = 0; k < 2; ++k) dst[n][k] = *(const PG8_LAS bf16x8*)(lds + PG8_SB(b, h) + boff + n * 2048 + k * 1024); } while (0)
#define PG8_MMA(ai, bj, At, Bt) do { __builtin_amdgcn_s_setprio(1); _Pragma("unroll") for (int m = 0; m < 4; ++m) _Pragma("unroll") for (int n = 0; n < 2; ++n) _Pragma("unroll") for (int k = 0; k < 2; ++k) \
        acc[ai][bj][m][n] = __builtin_amdgcn_mfma_f32_16x16x32_bf16(Bt[n][k], At[m][k], acc[ai][bj][m][n], 0, 0, 0); __builtin_amdgcn_s_setprio(0); } while (0)
#define PG8_WAIT_V(n) asm volatile("s_waitcnt vmcnt(" #n ")" ::: "memory")
#define PG8_WAIT_L(n) asm volatile("s_waitcnt lgkmcnt(" #n ")" ::: "memory")
#define PG8_BAR __builtin_amdgcn_s_barrier()
#define PG8_SCHED __builtin_amdgcn_sched_barrier(0)
    Unit cur, nxt; int ui = 0;
    if (!S.next(0, cur)) return;
    f32x4 acc[2][2][4][2];
#pragma unroll
    for (int a = 0; a < 2; ++a)
#pragma unroll
        for (int b = 0; b < 2; ++b)
#pragma unroll
            for (int m = 0; m < 4; ++m)
#pragma unroll
                for (int n = 0; n < 2; ++n) acc[a][b][m][n] = (f32x4){0.f, 0.f, 0.f, 0.f};
    bf16x8 At[4][2], B0[2][2], B1[2][2];
    const char* cA = (const char*)g.A + (size_t)cur.pm * tstepA; const char* cB = (const char*)g.Bt + (size_t)cur.pn * tstepB;
    S.a_ready(cur);
    if constexpr (SP2) {
        PG8_STAGE(PG8_SB(0, 0), cB, voffB); PG8_STAGE(PG8_SB(0, 1), cB + hstepB, voffB); PG8_STAGE(PG8_SA(0, 0), cA, voffA); PG8_STAGE(PG8_SA(0, 1), cA + hstepA, voffA);
        if (wr == 1) PG8_BAR;
        PG8_WAIT_V(2); PG8_BAR;
        PG8_STAGE(PG8_SB(1, 0), cB + kstep, voffB); PG8_STAGE(PG8_SA(1, 0), cA + kstep, voffA); PG8_STAGE(PG8_SB(1, 1), cB + hstepB + kstep, voffB);
        PG8_WAIT_V(6); PG8_BAR;
    } else {
        PG8_STAGE(PG8_SB(0, 0), cB, voffB); PG8_STAGE(PG8_SA(0, 0), cA, voffA); PG8_STAGE(PG8_SB(0, 1), cB + hstepB, voffB); PG8_STAGE(PG8_SA(0, 1), cA + hstepA, voffA);
        if (wr == 1) PG8_BAR;
        PG8_WAIT_V(4); PG8_BAR;
        PG8_STAGE(PG8_SB(1, 0), cB + kstep, voffB); PG8_STAGE(PG8_SA(1, 0), cA + kstep, voffA); PG8_STAGE(PG8_SB(1, 1), cB + hstepB + kstep, voffB);
        PG8_WAIT_V(6); PG8_BAR;
    }
    for (;;) {
        const bool has_next = S.next(ui + 1, nxt);
        const char* nA = has_next ? (const char*)g.A + (size_t)nxt.pm * tstepA : cA; const char* nB = has_next ? (const char*)g.Bt + (size_t)nxt.pn * tstepB : cB;
        for (int t = 0; t < nt; t += 2) {
            const bool last = (t == nt - 2);
            const char* a1 = cA + (size_t)(t + 1) * kstep;
            const char* a2 = last ? nA : cA + (size_t)(t + 2) * kstep; const char* b2 = last ? nB : cB + (size_t)(t + 2) * kstep;
            const char* a3 = a2 + kstep; const char* b3 = b2 + kstep;
            if (last && has_next) S.a_ready(nxt);
            if constexpr (SP2) {
            PG8_LDB(B0, 0, 0); PG8_LDB(B1, 0, 1); PG8_SCHED; PG8_LDA(At, 0, 0); PG8_STAGE(PG8_SA(1, 1), a1 + hstepA, voffA);
            PG8_WAIT_V(8); PG8_WAIT_L(0); PG8_BAR; PG8_MMA(0, 0, At, B0); PG8_MMA(0, 1, At, B1); PG8_BAR; PG8_SCHED;
            PG8_LDA(At, 0, 1); PG8_STAGE(PG8_SB(0, 0), b2, voffB); PG8_STAGE(PG8_SB(0, 1), b2 + hstepB, voffB); PG8_STAGE(PG8_SA(0, 0), a2, voffA);
            PG8_WAIT_V(8); PG8_WAIT_L(0); PG8_BAR; PG8_MMA(1, 0, At, B0); PG8_MMA(1, 1, At, B1); PG8_BAR; PG8_SCHED;
            PG8_LDB(B0, 1, 0); PG8_LDB(B1, 1, 1); PG8_SCHED; PG8_LDA(At, 1, 0); PG8_STAGE(PG8_SA(0, 1), a2 + hstepA, voffA);
            PG8_WAIT_V(8); PG8_WAIT_L(0); PG8_BAR; PG8_MMA(0, 0, At, B0); PG8_MMA(0, 1, At, B1); PG8_BAR; PG8_SCHED;
            PG8_LDA(At, 1, 1); PG8_STAGE(PG8_SB(1, 0), b3, voffB); PG8_STAGE(PG8_SB(1, 1), b3 + hstepB, voffB); PG8_STAGE(PG8_SA(1, 0), a3, voffA);
            PG8_WAIT_V(8); PG8_WAIT_L(0); PG8_BAR; PG8_MMA(1, 0, At, B0); PG8_MMA(1, 1, At, B1); PG8_BAR; PG8_SCHED;
            } else {
            PG8_LDB(B0, 0, 0); PG8_SCHED; PG8_LDA(At, 0, 0); PG8_STAGE(PG8_SA(1, 1), a1 + hstepA, voffA);
            PG8_WAIT_L(8); PG8_BAR; PG8_WAIT_L(0); PG8_MMA(0, 0, At, B0); PG8_BAR; PG8_SCHED;
            PG8_LDB(B1, 0, 1); PG8_STAGE(PG8_SB(0, 0), b2, voffB);
            PG8_BAR; PG8_WAIT_L(0); PG8_MMA(0, 1, At, B1); PG8_BAR;
            PG8_LDA(At, 0, 1); PG8_STAGE(PG8_SA(0, 0), a2, voffA);
            PG8_BAR; PG8_WAIT_L(0); PG8_MMA(1, 0, At, B0); PG8_BAR; PG8_SCHED;
            PG8_STAGE(PG8_SB(0, 1), b2 + hstepB, voffB);
            PG8_WAIT_V(6); PG8_BAR; PG8_MMA(1, 1, At, B1); PG8_BAR;
            PG8_LDB(B0, 1, 0); PG8_SCHED; PG8_LDA(At, 1, 0); PG8_STAGE(PG8_SA(0, 1), a2 + hstepA, voffA);
            PG8_WAIT_L(8); PG8_BAR; PG8_WAIT_L(0); PG8_MMA(0, 0, At, B0); PG8_BAR; PG8_SCHED;
            PG8_LDB(B1, 1, 1); PG8_STAGE(PG8_SB(1, 0), b3, voffB);
            PG8_BAR; PG8_WAIT_L(0); PG8_MMA(0, 1, At, B1); PG8_BAR;
            PG8_LDA(At, 1, 1); PG8_STAGE(PG8_SA(1, 0), a3, voffA);
            PG8_BAR; PG8_WAIT_L(0); PG8_MMA(1, 0, At, B0); PG8_BAR; PG8_SCHED;
            PG8_STAGE(PG8_SB(1, 1), b3 + hstepB, voffB);
            PG8_WAIT_V(6); PG8_BAR; PG8_MMA(1, 1, At, B1); PG8_BAR;
            }
        }
        if constexpr (ALIGN_EPI) { if (wr == 0) PG8_BAR; }
        if constexpr (!Epi::AFTER_DRAIN) { E(acc, cur, wr, wc, fr, fq); S.done(cur); }
        if (!has_next) break;
#pragma unroll
        for (int a = 0; a < 2; ++a)
#pragma unroll
            for (int b = 0; b < 2; ++b)
#pragma unroll
                for (int m = 0; m < 4; ++m)
#pragma unroll
                    for (int n = 0; n < 2; ++n) acc[a][b][m][n] = (f32x4){0.f, 0.f, 0.f, 0.f};
        cur = nxt; cA = nA; cB = nB; ++ui;
        if constexpr (ALIGN_EPI) { if (wr == 1) PG8_BAR; }
    }
    PG8_WAIT_V(0);
    if constexpr (!ALIGN_EPI) { if (wr == 0) PG8_BAR; }
    PG8_BAR;
    if constexpr (Epi::AFTER_DRAIN) { E.fused(acc, cur, wr, wc, fr, fq, lds, wid, lane); S.done(cur); }
#undef PG8_SA
#undef PG8_SB
#undef PG8_STAGE
#undef PG8_LDA
#undef PG8_LDB
#undef PG8_MMA
#undef PG8_WAIT_V
#undef PG8_WAIT_L
#undef PG8_BAR
#undef PG8_SCHED
}
}

#include <hip/hip_bf16.h>
#include <cmath>
namespace attn_body {
using bf16=__hip_bfloat16;
using bf16x8=__attribute__((ext_vector_type(8)))short;
using s16x4=__attribute__((ext_vector_type(4)))short;
using f32x16=__attribute__((ext_vector_type(16)))float;
using u32x4=__attribute__((ext_vector_type(4)))unsigned;
constexpr int SEQ=4096,D=64,DM=1024,OPITCH=2048;
constexpr int NW=8,QBLK=32,QB=QBLK*NW,KVBLK=64,NQB=SEQ/QB;
constexpr int ATTN_PITCH=DM, ATTN_UNIT_ROWS=QB;
__device__ __forceinline__ int crow(int r,int hi){return (r&3)+8*(r>>2)+4*hi;}
#define SBAR() __builtin_amdgcn_sched_barrier(0)
__device__ __forceinline__ void cmask(f32x16&p0,f32x16&p1,int jb,int qrel,int hi){
  const float NEG=-INFINITY; int kb=64*jb+4*hi;
  #pragma unroll
  for(int r=0;r<16;++r){int kv=kb+(r&3)+8*(r>>2); if(kv>qrel)p0[r]=NEG; if(kv+32>qrel)p1[r]=NEG;}
}

constexpr int NSLOT=3, SLOTB=8192;
constexpr int LDS_K=0, LDS_V=NSLOT*SLOTB, LDS_WS=2*NSLOT*SLOTB, LDS_OST=LDS_WS+NW*64*4, LDS_BYTES=LDS_OST+NW*4096;
constexpr float C2=0.125f*1.4426950408889634f;
__device__ __forceinline__ void glds16(const void*gsrc,unsigned lds_dst){unsigned keep;
  asm volatile("s_mov_b32 %0, m0\n\ts_mov_b32 m0, %2\n\ts_nop 0\n\tglobal_load_lds_dwordx4 %1, off\n\ts_mov_b32 m0, %0":"=&s"(keep):"v"(gsrc),"s"(lds_dst):"memory");}
__device__ __forceinline__ float max3f(float a,float b,float c){float r;asm("v_max3_f32 %0, %1, %2, %3":"=v"(r):"v"(a),"v"(b),"v"(c));return r;}
__device__ __forceinline__ float max2f(float a,float b){float r;asm("v_max_f32_e32 %0, %1, %2":"=v"(r):"v"(a),"v"(b));return r;}
__device__ __forceinline__ float fadd_s(float a,float b){float r;asm("v_add_f32_e32 %0, %1, %2":"=v"(r):"v"(a),"v"(b));return r;}
__device__ __forceinline__ float fsub_s(float a,float b){float r;asm("v_sub_f32_e32 %0, %1, %2":"=v"(r):"v"(a),"v"(b));return r;}
typedef float f32x2_t __attribute__((ext_vector_type(2))); typedef __bf16 bf16x2_t __attribute__((ext_vector_type(2)));
__device__ __forceinline__ unsigned cvtpk_s(float lo,float hi){f32x2_t v={lo,hi};bf16x2_t b=__builtin_convertvector(v,bf16x2_t);return __builtin_bit_cast(unsigned,b);}
#define WAIT_BAR(N) asm volatile("s_waitcnt vmcnt(" #N ") lgkmcnt(0)\n\ts_barrier":::"memory")

__device__ __forceinline__ f32x16 mfma_z(bf16x8 a_,bf16x8 b_){ f32x16 d_; asm volatile("s_nop 1\n\tv_mfma_f32_32x32x16_bf16 %0, %1, %2, 0":"=&v"(d_):"v"(a_),"v"(b_)); return d_; }
__device__ __forceinline__ void qkt(f32x16&p0,f32x16&p1,const char*Kslot,const bf16x8*qr,int r32,int hi){
  const char*kb=Kslot+hi*1024+r32*16;
  #pragma unroll
  for(int d0=0;d0<4;++d0){
    const bf16x8 b0=*reinterpret_cast<const bf16x8*>(kb+d0*2048);
    const bf16x8 b1=*reinterpret_cast<const bf16x8*>(kb+d0*2048+512);
    if(d0==0){f32x16 z0=f32x16{},z1=f32x16{};asm volatile("":"+v"(z0),"+v"(z1));
      p0=__builtin_amdgcn_mfma_f32_32x32x16_bf16(b0,qr[0],z0,0,0,0);p1=__builtin_amdgcn_mfma_f32_32x32x16_bf16(b1,qr[0],z1,0,0,0);}
    else{p0=__builtin_amdgcn_mfma_f32_32x32x16_bf16(b0,qr[d0],p0,0,0,0);p1=__builtin_amdgcn_mfma_f32_32x32x16_bf16(b1,qr[d0],p1,0,0,0);}}
}
typedef __attribute__((address_space(3))) const char* lds_cptr;
typedef short v4i16_t __attribute__((ext_vector_type(4)));
__device__ __forceinline__ void kload8(bf16x8*kf,lds_cptr kp){
  kf[0]=*(const __attribute__((address_space(3))) bf16x8*)(kp);      kf[1]=*(const __attribute__((address_space(3))) bf16x8*)(kp+512);
  kf[2]=*(const __attribute__((address_space(3))) bf16x8*)(kp+2048); kf[3]=*(const __attribute__((address_space(3))) bf16x8*)(kp+2560);
  kf[4]=*(const __attribute__((address_space(3))) bf16x8*)(kp+4096); kf[5]=*(const __attribute__((address_space(3))) bf16x8*)(kp+4608);
  kf[6]=*(const __attribute__((address_space(3))) bf16x8*)(kp+6144); kf[7]=*(const __attribute__((address_space(3))) bf16x8*)(kp+6656);
}
__device__ __forceinline__ void kload2(bf16x8*kf,lds_cptr kp,int j){ kf[2*j]=*(const __attribute__((address_space(3))) bf16x8*)(kp+j*2048); kf[2*j+1]=*(const __attribute__((address_space(3))) bf16x8*)(kp+j*2048+512); }
__device__ __forceinline__ s16x4 vtr(lds_cptr p){ return __builtin_bit_cast(s16x4,__builtin_amdgcn_ds_read_tr16_b64_v4i16((__attribute__((address_space(3))) v4i16_t*)p)); }
__device__ __forceinline__ float rowmax(const f32x16&p0,const f32x16&p1){
  float a=max3f(p0[0],p0[1],p1[0]),b=max3f(p0[2],p0[3],p1[1]);a=max3f(a,p1[2],p1[3]);
  #pragma unroll
  for(int r=4;r<16;r+=4){a=max3f(a,p0[r],p0[r+1]);b=max3f(b,p0[r+2],p0[r+3]);a=max3f(a,p1[r],p1[r+1]);b=max3f(b,p1[r+2],p1[r+3]);}
  const float m=max2f(a,b);
  auto rr=__builtin_amdgcn_permlane32_swap(__float_as_uint(m),__float_as_uint(m),false,false);
  return max2f(__uint_as_float(rr[0]),__uint_as_float(rr[1]));
}
__device__ __forceinline__ void pv(f32x16*o,int vb,bf16x8 pa0,bf16x8 pa1,bf16x8 pa2,bf16x8 pa3){
  #pragma unroll
  for(int d0=0;d0<2;++d0){s16x4 lo[4],hi[4];
    #pragma unroll
    for(int ks=0;ks<4;++ks){
      asm volatile("ds_read_b64_tr_b16 %0,%1 offset:%c2":"=&v"(lo[ks]):"v"(vb),"i"(d0*4096+ks*1024):"memory");
      asm volatile("ds_read_b64_tr_b16 %0,%1 offset:%c2":"=&v"(hi[ks]):"v"(vb),"i"(d0*4096+ks*1024+512):"memory");}
    asm volatile("s_waitcnt lgkmcnt(0)":::"memory");SBAR();
    #define PK(k) (bf16x8){lo[k][0],lo[k][1],lo[k][2],lo[k][3],hi[k][0],hi[k][1],hi[k][2],hi[k][3]}
    o[d0]=__builtin_amdgcn_mfma_f32_32x32x16_bf16(pa0,PK(0),o[d0],0,0,0);
    o[d0]=__builtin_amdgcn_mfma_f32_32x32x16_bf16(pa1,PK(1),o[d0],0,0,0);
    o[d0]=__builtin_amdgcn_mfma_f32_32x32x16_bf16(pa2,PK(2),o[d0],0,0,0);
    o[d0]=__builtin_amdgcn_mfma_f32_32x32x16_bf16(pa3,PK(3),o[d0],0,0,0);
    #undef PK
  }
}

#ifndef ATTN_STORE16
#define ATTN_STORE16(p,v) (*(u32x4*)(p)=(v))
#endif
template<int THRL> __device__ __forceinline__ void attn_unit(int qb,const bf16*Qh,const bf16*__restrict__ Kh,const bf16*__restrict__ Vh,bf16*Oh,char*shm,const int tid_in){
  const int tid=tid_in,lane=tid&63,r32=lane&31,hi=lane>>5; const int wid=__builtin_amdgcn_readfirstlane(tid>>6);
  const int q0=qb*QB;
  const bf16*Qw=Qh+(long)(q0+wid*QBLK)*DM;
  const unsigned lds0=(unsigned)(uintptr_t)shm;
  float*wsf=(float*)(shm+LDS_WS)+wid*64;
  const bf16*ksrc=Kh+(long)lane*DM+wid*8;
  const bf16*vsrc=Vh+(long)(16*(wid&3)+(lane>>2))*DM+(wid>>2)*32+(lane&3)*8;
  const unsigned kdst=lds0+LDS_K+wid*1024, vdst=lds0+LDS_V+wid*1024;
  #define DMA_K(t,slot) glds16(ksrc+(long)(t)*KVBLK*DM,(unsigned)__builtin_amdgcn_readfirstlane(kdst+(slot)))
  #define DMA_V(t,slot) glds16(vsrc+(long)(t)*KVBLK*DM,(unsigned)__builtin_amdgcn_readfirstlane(vdst+(slot)))
  const int vb0=(int)(lds0+LDS_V)+((lane>>4)&1)*32+(lane&3)*8+(4*hi+((lane&15)>>2))*64;
  const char*Kbase=shm+LDS_K; bf16x8 kf[8];
  const lds_cptr shm3=(lds_cptr)shm; const lds_cptr kp0=shm3+LDS_K+hi*1024+r32*16; const lds_cptr vp0=shm3+LDS_V+((lane>>4)&1)*32+(lane&3)*8+(4*hi+((lane&15)>>2))*64;
  const int NT=(q0+QB)/KVBLK;
  DMA_K(0,0);DMA_V(0,0);DMA_K(1,SLOTB);
  bf16x8 qr[4];
  #pragma unroll
  for(int d0=0;d0<4;++d0)qr[d0]=*reinterpret_cast<const bf16x8*>(&Qw[(long)r32*DM+d0*16+hi*8]);
  float mhat=0.f,l_reg=0.f;f32x16 o[2];o[0]=f32x16{};o[1]=f32x16{};
  const int qrel=wid*QBLK+r32;
  #define CMASK(P0,P1,t) do{int jb_=(t)-(NT-4); if(jb_>=0)cmask(P0,P1,jb_,qrel,hi);}while(0)
  bool resc=false;
  #define START(P0,P1) do{ const float rm=rowmax(P0,P1); resc=false; \
    { const float dl=rm; mhat=fadd_s(mhat,dl); \
      _Pragma("unroll") for(int r=0;r<16;++r){P0[r]=fsub_s(P0[r],dl);P1[r]=fsub_s(P1[r],dl);} \
      } \
    _Pragma("unroll") for(int r=0;r<16;++r)P0[r]=__builtin_amdgcn_exp2f(P0[r]); }while(0)
  #define RESC() do{ if(resc){ asm volatile("s_waitcnt lgkmcnt(0)":::"memory"); \
      _Pragma("unroll") for(int d_=0;d_<2;++d_) _Pragma("unroll") for(int r=0;r<16;++r)o[d_][r]*=wsf[crow(r,hi)]; } }while(0)
  f32x16 pA0,pA1,pB0,pB1;
  int sl_prev=0,sl_cur=0,sl_next=SLOTB;
  #define ROT() do{sl_prev=sl_cur;sl_cur=sl_next;sl_next=(sl_next==(NSLOT-1)*SLOTB)?0:sl_next+SLOTB;}while(0)
  DMA_K(2,2*SLOTB);
  WAIT_BAR(3);
  qkt(pA0,pA1,Kbase,qr,r32,hi);asm volatile("s_nop 15\n\ts_nop 7":"+v"(pA0),"+v"(pA1));CMASK(pA0,pA1,0);
  START(pA0,pA1);
  _Pragma("unroll") for(int r=0;r<16;++r)pA1[r]=__builtin_amdgcn_exp2f(pA1[r]);
  WAIT_BAR(0);
  DMA_K(3,0);DMA_V(1,SLOTB);
  ROT();
  kload8(kf,kp0+sl_cur);
  WAIT_BAR(2);
  s16x4 vlo[8],vhi[8]; u32x4 pw0,pw1,pw2,pw3;
  #define PKW(P,B) cvtpk_s(P[B],P[B+1])
  #define PAF(k) __builtin_bit_cast(bf16x8,pw##k)
  #define VFR(i) (bf16x8){vlo[i][0],vlo[i][1],vlo[i][2],vlo[i][3],vhi[i][0],vhi[i][1],vhi[i][2],vhi[i][3]}
  #define PIN(x) asm volatile("":"+v"(x))
  #define MX3(a,b,c) __builtin_fmaxf(__builtin_fmaxf((a),(b)),(c))
  #define GAPA(MF,A0,A1,A2,A3,W0,W1,PW) do{ MF; sacc+=A0; sacc+=A1; sacc+=A2; sacc+=A3; PIN(sacc); W0; W1; PIN(PW); SBAR(); }while(0)
  #define EX(v) __builtin_amdgcn_exp2f(v)
  #define GAPB(MF,X,B) do{ MF; X[B]=EX(fsub_s(X[B],mhat)); X[B+1]=EX(fsub_s(X[B+1],mhat)); X[B+2]=EX(fsub_s(X[B+2],mhat)); X[B+3]=EX(fsub_s(X[B+3],mhat)); PIN(X); SBAR(); }while(0)
  #define VRD(i) do{ vlo[i]=vtr(vp_+(((i)>>2)*4096+((i)&3)*1024)); vhi[i]=vtr(vp_+(((i)>>2)*4096+((i)&3)*1024+512)); }while(0)
  #define KRD(G,j) do{ if(G){ kload2(kf,kp0+sl_next,j); SBAR(); } }while(0)
  #define STEP(C0,C1,P0,P1,t,GK,GV,GL) do{ SBAR(); \
    const lds_cptr vp_=vp0+sl_prev; \
    VRD(0); SBAR(); float sacc=(P0[0]+P0[1]); \
    GAPA(C0=mfma_z(kf[0],qr[0]), P0[2],P0[3],P0[4],P0[5],     pw0[0]=PKW(P0,0), pw0[1]=PKW(P0,2), pw0); \
    VRD(4); SBAR(); GAPA(C1=mfma_z(kf[1],qr[0]), P0[6],P0[7],P0[8],P0[9],     pw0[2]=PKW(P0,4), pw0[3]=PKW(P0,6), pw0); \
    VRD(1); SBAR(); GAPA(C0=__builtin_amdgcn_mfma_f32_32x32x16_bf16(kf[2],qr[1],C0,0,0,0),   P0[10],P0[11],P0[12],P0[13], pw1[0]=PKW(P0,8), pw1[1]=PKW(P0,10), pw1); \
    VRD(5); SBAR(); GAPA(C1=__builtin_amdgcn_mfma_f32_32x32x16_bf16(kf[3],qr[1],C1,0,0,0),   P0[14],P0[15],P1[0],P1[1],   pw1[2]=PKW(P0,12),pw1[3]=PKW(P0,14), pw1); \
    VRD(2); SBAR(); GAPA(C0=__builtin_amdgcn_mfma_f32_32x32x16_bf16(kf[4],qr[2],C0,0,0,0),   P1[2],P1[3],P1[4],P1[5],     pw2[0]=PKW(P1,0), pw2[1]=PKW(P1,2), pw2); \
    VRD(6); SBAR(); GAPA(C1=__builtin_amdgcn_mfma_f32_32x32x16_bf16(kf[5],qr[2],C1,0,0,0),   P1[6],P1[7],P1[8],P1[9],     pw2[2]=PKW(P1,4), pw2[3]=PKW(P1,6), pw2); \
    VRD(3); SBAR(); GAPA(C0=__builtin_amdgcn_mfma_f32_32x32x16_bf16(kf[6],qr[3],C0,0,0,0),   P1[10],P1[11],P1[12],P1[13], pw3[0]=PKW(P1,8), pw3[1]=PKW(P1,10), pw3); \
    VRD(7); SBAR(); GAPA(C1=__builtin_amdgcn_mfma_f32_32x32x16_bf16(kf[7],qr[3],C1,0,0,0),   P1[14],P1[15],0.f,0.f,       pw3[2]=PKW(P1,12),pw3[3]=PKW(P1,14), pw3); \
    l_reg+=sacc; \
    if(GK){DMA_K((t)+3,sl_cur);} if(GV){DMA_V((t)+1,sl_next);} \
    CMASK(C0,C1,t); \
    { float a=MX3(C0[0],C0[1],C1[0]),b=MX3(C0[2],C0[3],C1[1]); a=MX3(a,C1[2],C1[3]); \
      _Pragma("unroll") for(int r=4;r<16;r+=4){a=MX3(a,C0[r],C0[r+1]);b=MX3(b,C0[r+2],C0[r+3]);a=MX3(a,C1[r],C1[r+1]);b=MX3(b,C1[r+2],C1[r+3]);} \
      float rm=__builtin_fmaxf(a,b); { auto rr=__builtin_amdgcn_permlane32_swap(__float_as_uint(rm),__float_as_uint(rm),false,false); rm=__builtin_fmaxf(__uint_as_float(rr[0]),__uint_as_float(rr[1])); } \
      resc=false; \
      const float rel=rm-mhat; \
      if(__builtin_expect(__any(rel>(float)THRL),0)){ const float dl=__builtin_fmaxf(rel,0.f); mhat+=dl; \
        const float f=__builtin_amdgcn_exp2f(-dl); l_reg*=f; if(hi==0)wsf[r32]=f; resc=true; } } \
    SBAR(); \
    GAPB(o[0]=__builtin_amdgcn_mfma_f32_32x32x16_bf16(PAF(0),VFR(0),o[0],0,0,0), C0,0); \
    GAPB(o[1]=__builtin_amdgcn_mfma_f32_32x32x16_bf16(PAF(0),VFR(4),o[1],0,0,0), C0,4); \
    KRD(GL,0); GAPB(o[0]=__builtin_amdgcn_mfma_f32_32x32x16_bf16(PAF(1),VFR(1),o[0],0,0,0), C0,8); \
    KRD(GL,1); GAPB(o[1]=__builtin_amdgcn_mfma_f32_32x32x16_bf16(PAF(1),VFR(5),o[1],0,0,0), C0,12); \
    KRD(GL,2); GAPB(o[0]=__builtin_amdgcn_mfma_f32_32x32x16_bf16(PAF(2),VFR(2),o[0],0,0,0), C1,0); \
    KRD(GL,3); GAPB(o[1]=__builtin_amdgcn_mfma_f32_32x32x16_bf16(PAF(2),VFR(6),o[1],0,0,0), C1,4); \
    GAPB(o[0]=__builtin_amdgcn_mfma_f32_32x32x16_bf16(PAF(3),VFR(3),o[0],0,0,0), C1,8); \
    GAPB(o[1]=__builtin_amdgcn_mfma_f32_32x32x16_bf16(PAF(3),VFR(7),o[1],0,0,0), C1,12); \
    }while(0)
  int t=1;
  #undef CMASK
  #define CMASK(P0,P1,t) do{}while(0)
  for(;t+5<NT;t+=2){
    STEP(pB0,pB1,pA0,pA1,t,true,true,true);     WAIT_BAR(2); RESC(); ROT();
    STEP(pA0,pA1,pB0,pB1,t+1,true,true,true);   WAIT_BAR(2); RESC(); ROT();
  }
  #undef CMASK
  #define CMASK(P0,P1,t) do{int jb_=(t)-(NT-4); if(jb_>=0)cmask(P0,P1,jb_,qrel,hi);}while(0)
  #define ENDW(tt) do{ if((tt)+3<NT){WAIT_BAR(2);} else if((tt)+2<NT){WAIT_BAR(1);} else {WAIT_BAR(0);} }while(0)
  for(;t+1<NT;t+=2){
    STEP(pB0,pB1,pA0,pA1,t,(t+3<NT),(t+1<NT),(t+1<NT));       ENDW(t);   RESC(); ROT();
    STEP(pA0,pA1,pB0,pB1,t+1,(t+4<NT),(t+2<NT),(t+2<NT));     ENDW(t+1); RESC(); ROT();
  }
  STEP(pB0,pB1,pA0,pA1,NT-1,false,false,false); RESC();
  { float sacc=pB0[0]+pB0[1]; _Pragma("unroll") for(int r=2;r<16;++r)sacc+=pB0[r]; _Pragma("unroll") for(int r=0;r<16;++r)sacc+=pB1[r]; l_reg+=sacc;
    pw0=(u32x4){PKW(pB0,0),PKW(pB0,2),PKW(pB0,4),PKW(pB0,6)};pw1=(u32x4){PKW(pB0,8),PKW(pB0,10),PKW(pB0,12),PKW(pB0,14)};pw2=(u32x4){PKW(pB1,0),PKW(pB1,2),PKW(pB1,4),PKW(pB1,6)};pw3=(u32x4){PKW(pB1,8),PKW(pB1,10),PKW(pB1,12),PKW(pB1,14)};
    SBAR(); pv(o,vb0+sl_cur,PAF(0),PAF(1),PAF(2),PAF(3)); }
  #undef PKW
  #undef PAF
  #undef VFR
  #undef PIN
  #undef MX3
  #undef GAPA
  #undef GAPB
  #undef EX
  #undef VRD
  #undef KRD
  #undef STEP
  #undef ENDW
  l_reg+=__uint_as_float((unsigned)__builtin_amdgcn_ds_bpermute((lane^32)<<2,(int)__float_as_uint(l_reg)));
  if(hi==0)wsf[32+r32]=l_reg;asm volatile("s_waitcnt lgkmcnt(0)":::"memory");
  float rli[16];
  #pragma unroll
  for(int r=0;r<16;++r)rli[r]=__builtin_amdgcn_rcpf(wsf[32+crow(r,hi)]);
  bf16*Ow=Oh+(long)(q0+wid*QBLK)*OPITCH;
  { bf16*stg=(bf16*)(shm+LDS_OST)+wid*2048;
    #pragma unroll
    for(int r=0;r<16;++r){const int orow=crow(r,hi);
      #pragma unroll
      for(int d0=0;d0<2;++d0)stg[orow*64+d0*32+r32]=__float2bfloat16(o[d0][r]*rli[r]);}
    asm volatile("s_waitcnt lgkmcnt(0)":::"memory");
    #pragma unroll
    for(int i=0;i<4;++i){const int row=i*8+(lane>>3),ch=lane&7; const u32x4 v=*(const u32x4*)(stg+row*64+ch*8); ATTN_STORE16(Ow+(long)row*OPITCH+ch*8,v);} }
  asm volatile("s_waitcnt lgkmcnt(0)\n\ts_barrier":::"memory");
  #undef DMA_K
  #undef DMA_V
  #undef CMASK
  #undef START
  #undef RESC
  #undef ROT
}

__device__ __forceinline__ float rowmax_cv(const f32x16&p0,const f32x16&p1){
  float a=__builtin_fmaxf(p0[0],p1[0]);
  #pragma unroll
  for(int r=1;r<16;++r){a=__builtin_fmaxf(a,p0[r]);a=__builtin_fmaxf(a,p1[r]);}
  auto rr=__builtin_amdgcn_permlane32_swap(__float_as_uint(a),__float_as_uint(a),false,false);
  return __builtin_fmaxf(__uint_as_float(rr[0]),__uint_as_float(rr[1]));
}
__device__ __forceinline__ void attn_unit_simple(int qb,const bf16*Qh,const bf16*__restrict__ Kh,const bf16*__restrict__ Vh,bf16*Oh,char*shm,const int tid_in){
  const int tid=tid_in,lane=tid&63,r32=lane&31,hi=lane>>5; const int wid=__builtin_amdgcn_readfirstlane(tid>>6);
  const int q0=qb*QB;
  const bf16*Qw=Qh+(long)(q0+wid*QBLK)*DM;
  const unsigned lds0=(unsigned)(uintptr_t)shm;
  float*wsf=(float*)(shm+LDS_WS)+wid*64;
  const bf16*ksrc=Kh+(long)lane*DM+wid*8;
  const bf16*vsrc=Vh+(long)(16*(wid&3)+(lane>>2))*DM+(wid>>2)*32+(lane&3)*8;
  u32x4*kdstp=(u32x4*)(shm+LDS_K+wid*1024+lane*16); u32x4*vdstp=(u32x4*)(shm+LDS_V+wid*1024+lane*16);
  const int vb0=(int)(lds0+LDS_V)+((lane>>4)&1)*32+(lane&3)*8+(4*hi+((lane&15)>>2))*64;
  const char*Kbase=shm+LDS_K;
  const int NT=(q0+QB)/KVBLK;
  bf16x8 qr[4];
  #pragma unroll
  for(int d0=0;d0<4;++d0)qr[d0]=*reinterpret_cast<const bf16x8*>(&Qw[(long)r32*DM+d0*16+hi*8]);
  float m_run=-1e30f,l_reg=0.f; f32x16 o[2]; o[0]=f32x16{}; o[1]=f32x16{};
  const int qrel=wid*QBLK+r32;
  u32x4 kreg=*(const u32x4*)ksrc, vreg=*(const u32x4*)vsrc;
  for(int t=0;t<NT;++t){
    *kdstp=kreg; *vdstp=vreg;
    if(t+1<NT){ kreg=*(const u32x4*)(ksrc+(long)(t+1)*KVBLK*DM); vreg=*(const u32x4*)(vsrc+(long)(t+1)*KVBLK*DM); }
    __syncthreads();
    f32x16 p0,p1;
    qkt(p0,p1,Kbase,qr,r32,hi);
    { const int jb=t-(NT-4); if(jb>=0){ const float NEG=-INFINITY; const int kb=64*jb+4*hi;
        #pragma unroll
        for(int r=0;r<16;++r){const int kv=kb+(r&3)+8*(r>>2); if(kv>qrel)p0[r]=NEG; if(kv+32>qrel)p1[r]=NEG;} } }
    const float rm=rowmax_cv(p0,p1);
    const float mn=__builtin_fmaxf(m_run,rm); const float alpha=__builtin_amdgcn_exp2f(m_run-mn); m_run=mn;
    float sacc=0.f;
    #pragma unroll
    for(int r=0;r<16;++r){p0[r]=__builtin_amdgcn_exp2f(p0[r]-mn);p1[r]=__builtin_amdgcn_exp2f(p1[r]-mn);sacc+=p0[r]+p1[r];}
    l_reg=l_reg*alpha+sacc;
    if(hi==0)wsf[r32]=alpha;
    asm volatile("s_waitcnt lgkmcnt(0)":::"memory");
    #pragma unroll
    for(int d_=0;d_<2;++d_)
      #pragma unroll
      for(int r=0;r<16;++r)o[d_][r]*=wsf[crow(r,hi)];
    u32x4 pw0,pw1,pw2,pw3;
    #define PKW2(P,B) cvtpk_s(P[B],P[B+1])
    pw0=(u32x4){PKW2(p0,0),PKW2(p0,2),PKW2(p0,4),PKW2(p0,6)};pw1=(u32x4){PKW2(p0,8),PKW2(p0,10),PKW2(p0,12),PKW2(p0,14)};
    pw2=(u32x4){PKW2(p1,0),PKW2(p1,2),PKW2(p1,4),PKW2(p1,6)};pw3=(u32x4){PKW2(p1,8),PKW2(p1,10),PKW2(p1,12),PKW2(p1,14)};
    #undef PKW2
    pv(o,vb0,__builtin_bit_cast(bf16x8,pw0),__builtin_bit_cast(bf16x8,pw1),__builtin_bit_cast(bf16x8,pw2),__builtin_bit_cast(bf16x8,pw3));
    asm volatile("s_waitcnt lgkmcnt(0)":::"memory");
    __syncthreads();
  }
  l_reg+=__uint_as_float((unsigned)__builtin_amdgcn_ds_bpermute((lane^32)<<2,(int)__float_as_uint(l_reg)));
  if(hi==0)wsf[32+r32]=l_reg;asm volatile("s_waitcnt lgkmcnt(0)":::"memory");
  float rli[16];
  #pragma unroll
  for(int r=0;r<16;++r)rli[r]=__builtin_amdgcn_rcpf(wsf[32+crow(r,hi)]);
  bf16*Ow=Oh+(long)(q0+wid*QBLK)*OPITCH;
  { bf16*stg=(bf16*)(shm+LDS_OST)+wid*2048;
    #pragma unroll
    for(int r=0;r<16;++r){const int orow=crow(r,hi);
      #pragma unroll
      for(int d0=0;d0<2;++d0)stg[orow*64+d0*32+r32]=__float2bfloat16(o[d0][r]*rli[r]);}
    asm volatile("s_waitcnt lgkmcnt(0)":::"memory");
    #pragma unroll
    for(int i=0;i<4;++i){const int row=i*8+(lane>>3),ch=lane&7; const u32x4 v=*(const u32x4*)(stg+row*64+ch*8); ATTN_STORE16(Ow+(long)row*OPITCH+ch*8,v);} }
  asm volatile("s_waitcnt vmcnt(0) lgkmcnt(0)":::"memory");
  __syncthreads();
}

constexpr int DA_SLOT=32768, DA_V=16384, DA_WS=98304, DA_ROWS=128;
__device__ __forceinline__ f32x16 mfma_c(bf16x8 a_,bf16x8 b_,const f32x16&c_){ f32x16 d_; asm volatile("s_nop 1\n\tv_mfma_f32_32x32x16_bf16 %0, %1, %2, %3":"=&v"(d_):"v"(a_),"v"(b_),"v"(c_)); return d_; }
template<int THRL> __device__ __forceinline__ void dattn_unit(int qblk,const bf16*Qb,const bf16*__restrict__ Kb,const bf16*__restrict__ Vb,bf16*Yb,float lam,const float*gsub,float gscale,char*shm,const int tid_in){
  const int tid=tid_in,lane=tid&63,r32=lane&31,hi=lane>>5; const int wid=__builtin_amdgcn_readfirstlane(tid>>6);
  const int c=wid>>2, rg=wid&3;
  const int q0=qblk*DA_ROWS; const int NT=(q0+DA_ROWS)/KVBLK;
  const bf16*Qw=Qb+c*64+(long)(q0+rg*32)*DM;
  const unsigned lds0=(unsigned)(uintptr_t)shm; const lds_cptr shm3=(lds_cptr)shm;
  float*wsf=(float*)(shm+DA_WS)+wid*64;
  const int pk0=2*wid;
  const bf16*ksrc0=Kb+(pk0>>3)*64+(long)lane*DM+(pk0&7)*8;
  const unsigned kdst0=lds0+(pk0>>3)*8192+(pk0&7)*1024;
  const bf16*vsrc0=Vb+(long)(16*(pk0&3)+(lane>>2))*DM+(pk0>>2)*32+(lane&3)*8;
  const unsigned vdst0=lds0+DA_V+pk0*1024;
  #define DA_RFL(x) ((unsigned)__builtin_amdgcn_readfirstlane((int)(x)))
  #define DA_DMA(t,so) do{ const long to_=(long)(t)*KVBLK*DM; \
      glds16(ksrc0+to_,DA_RFL(kdst0+(so))); glds16(ksrc0+to_+8,DA_RFL(kdst0+(so)+1024)); \
      glds16(vsrc0+to_,DA_RFL(vdst0+(so))); glds16(vsrc0+to_+16*DM,DA_RFL(vdst0+(so)+1024)); }while(0)
  const lds_cptr kp0=shm3+c*8192+hi*1024+r32*16;
  const lds_cptr vp0=shm3+DA_V+((lane>>4)&1)*32+(lane&3)*8+(4*hi+((lane&15)>>2))*64;
  bf16x8 qr[4];
  #pragma unroll
  DA_DMA(0,0); if(NT>1){ DA_DMA(1,DA_SLOT); }
  #pragma unroll
  for(int d0=0;d0<4;++d0)qr[d0]=*reinterpret_cast<const bf16x8*>(&Qw[(long)r32*DM+d0*16+hi*8]);
  asm volatile("":"+v"(qr[0]),"+v"(qr[1]),"+v"(qr[2]),"+v"(qr[3]));
  float mhat=0.f,l_reg=0.f; f32x16 o[4]; o[0]=f32x16{}; o[1]=f32x16{}; o[2]=f32x16{}; o[3]=f32x16{};
  f32x16 negm;
  #pragma unroll
  for(int r=0;r<16;++r)negm[r]=0.f;
  const int qrel=rg*32+r32;
  int slot=0;
  for(int t=0;t<NT;++t){
    if(t+1<NT){ asm volatile("s_waitcnt vmcnt(4) lgkmcnt(0)\n\ts_barrier":::"memory"); } else { asm volatile("s_waitcnt vmcnt(0) lgkmcnt(0)\n\ts_barrier":::"memory"); }
    if(t+2<NT){ int s2=slot+2*DA_SLOT; if(s2>=3*DA_SLOT)s2-=3*DA_SLOT; DA_DMA(t+2,s2); }
    const lds_cptr kp=kp0+slot;
    f32x16 p0,p1;
    { const bf16x8 k0=*(const __attribute__((address_space(3))) bf16x8*)(kp), k1=*(const __attribute__((address_space(3))) bf16x8*)(kp+512);
      p0=mfma_c(k0,qr[0],negm); p1=mfma_c(k1,qr[0],negm); }
    #pragma unroll
    for(int d0=1;d0<4;++d0){ const bf16x8 k0=*(const __attribute__((address_space(3))) bf16x8*)(kp+d0*2048), k1=*(const __attribute__((address_space(3))) bf16x8*)(kp+d0*2048+512);
      p0=__builtin_amdgcn_mfma_f32_32x32x16_bf16(k0,qr[d0],p0,0,0,0); p1=__builtin_amdgcn_mfma_f32_32x32x16_bf16(k1,qr[d0],p1,0,0,0); }
    { const int jb=t-(NT-2); if(jb>=0){ const float NEG=-INFINITY; const int kb=64*jb+4*hi;
        #pragma unroll
        for(int r=0;r<16;++r){const int kv=kb+(r&3)+8*(r>>2); if(kv>qrel)p0[r]=NEG; if(kv+32>qrel)p1[r]=NEG;} } }
    float rm=__builtin_fmaxf(p0[0],p1[0]);
    #pragma unroll
    for(int r=1;r<16;++r){rm=__builtin_fmaxf(rm,p0[r]);rm=__builtin_fmaxf(rm,p1[r]);}
    rm=__builtin_fmaxf(rm,__uint_as_float((unsigned)__builtin_amdgcn_ds_bpermute((lane^32)<<2,(int)__float_as_uint(rm))));
    if(t==0){
      mhat=rm;
      #pragma unroll
      for(int r=0;r<16;++r){p0[r]-=rm;p1[r]-=rm;negm[r]=-rm;}
    } else if(__any(rm>(float)THRL)){
      const float dl=__builtin_fmaxf(rm,0.f); const float f=__builtin_amdgcn_exp2f(-dl); mhat+=dl; l_reg*=f;
      #pragma unroll
      for(int r=0;r<16;++r){p0[r]-=dl;p1[r]-=dl;negm[r]=-mhat;}
      if(hi==0)wsf[r32]=f;
      asm volatile("s_waitcnt lgkmcnt(0)":::"memory");
      #pragma unroll
      for(int d_=0;d_<4;++d_)
        #pragma unroll
        for(int r=0;r<16;++r)o[d_][r]*=wsf[crow(r,hi)];
    }
    float sacc=0.f;
    #pragma unroll
    for(int r=0;r<16;++r){p0[r]=__builtin_amdgcn_exp2f(p0[r]);p1[r]=__builtin_amdgcn_exp2f(p1[r]);sacc+=p0[r]+p1[r];}
    l_reg+=sacc;
    u32x4 pw0,pw1,pw2,pw3;
    pw0=(u32x4){cvtpk_s(p0[0],p0[1]),cvtpk_s(p0[2],p0[3]),cvtpk_s(p0[4],p0[5]),cvtpk_s(p0[6],p0[7])}; pw1=(u32x4){cvtpk_s(p0[8],p0[9]),cvtpk_s(p0[10],p0[11]),cvtpk_s(p0[12],p0[13]),cvtpk_s(p0[14],p0[15])};
    pw2=(u32x4){cvtpk_s(p1[0],p1[1]),cvtpk_s(p1[2],p1[3]),cvtpk_s(p1[4],p1[5]),cvtpk_s(p1[6],p1[7])}; pw3=(u32x4){cvtpk_s(p1[8],p1[9]),cvtpk_s(p1[10],p1[11]),cvtpk_s(p1[12],p1[13]),cvtpk_s(p1[14],p1[15])};
    const lds_cptr vp=vp0+slot;
    #pragma unroll
    for(int d0=0;d0<4;++d0){
      #define DA_VF(ks) ({ const s16x4 lo_=vtr(vp+d0*4096+(ks)*1024), hi_=vtr(vp+d0*4096+(ks)*1024+512); (bf16x8){lo_[0],lo_[1],lo_[2],lo_[3],hi_[0],hi_[1],hi_[2],hi_[3]}; })
      o[d0]=__builtin_amdgcn_mfma_f32_32x32x16_bf16(__builtin_bit_cast(bf16x8,pw0),DA_VF(0),o[d0],0,0,0);
      o[d0]=__builtin_amdgcn_mfma_f32_32x32x16_bf16(__builtin_bit_cast(bf16x8,pw1),DA_VF(1),o[d0],0,0,0);
      o[d0]=__builtin_amdgcn_mfma_f32_32x32x16_bf16(__builtin_bit_cast(bf16x8,pw2),DA_VF(2),o[d0],0,0,0);
      o[d0]=__builtin_amdgcn_mfma_f32_32x32x16_bf16(__builtin_bit_cast(bf16x8,pw3),DA_VF(3),o[d0],0,0,0);
      #undef DA_VF
    }
    slot+=DA_SLOT; if(slot>=3*DA_SLOT)slot=0;
  }
  int lane_e=lane; asm volatile("":"+v"(lane_e)); const int r32e=lane_e&31, hie=lane_e>>5;
  l_reg+=__uint_as_float((unsigned)__builtin_amdgcn_ds_bpermute((lane^32)<<2,(int)__float_as_uint(l_reg)));
  asm volatile("s_waitcnt vmcnt(0) lgkmcnt(0)\n\ts_barrier":::"memory");
  if(hie==0)wsf[32+r32e]=l_reg; asm volatile("s_waitcnt lgkmcnt(0)":::"memory");
  float rli[16];
  #pragma unroll
  for(int r=0;r<16;++r)rli[r]=__builtin_amdgcn_rcpf(wsf[32+crow(r,hie)]);
  float*st2=(float*)shm+rg*4096;
  if(c==1){
    #pragma unroll
    for(int d0=0;d0<4;++d0)
      #pragma unroll
      for(int r=0;r<16;++r)st2[crow(r,hie)*128+d0*32+r32e]=lam*o[d0][r]*rli[r];
  }
  asm volatile("s_waitcnt lgkmcnt(0)\n\ts_barrier":::"memory");
  if(c==0){
    float ssq[16];
    #pragma unroll
    for(int r=0;r<16;++r){ float a_=0.f;
      #pragma unroll
      for(int d0=0;d0<4;++d0){ const float x_=o[d0][r]*rli[r]-st2[crow(r,hie)*128+d0*32+r32e]; o[d0][r]=x_; a_+=x_*x_; }
      a_+=__uint_as_float((unsigned)__builtin_amdgcn_ds_swizzle((int)__float_as_uint(a_),(1<<10)|0x1f)); a_+=__uint_as_float((unsigned)__builtin_amdgcn_ds_swizzle((int)__float_as_uint(a_),(2<<10)|0x1f));
      a_+=__uint_as_float((unsigned)__builtin_amdgcn_ds_swizzle((int)__float_as_uint(a_),(4<<10)|0x1f)); a_+=__uint_as_float((unsigned)__builtin_amdgcn_ds_swizzle((int)__float_as_uint(a_),(8<<10)|0x1f));
      a_+=__uint_as_float((unsigned)__builtin_amdgcn_ds_swizzle((int)__float_as_uint(a_),(16<<10)|0x1f));
      ssq[r]=1.0f/__builtin_sqrtf(a_*(1.0f/128.0f)+1e-5f); }
    float g4[4];
    #pragma unroll
    for(int d0=0;d0<4;++d0)g4[d0]=gsub[d0*32+r32e]*gscale;
    bf16*stg=(bf16*)(shm+65536)+rg*4096;
    #pragma unroll
    for(int r=0;r<16;++r)
      #pragma unroll
      for(int d0=0;d0<4;++d0)stg[crow(r,hie)*128+d0*32+r32e]=__float2bfloat16(o[d0][r]*ssq[r]*g4[d0]);
    asm volatile("s_waitcnt lgkmcnt(0)":::"memory");
    bf16*Yw=Yb+(long)(q0+rg*32)*DM;
    #pragma unroll
    for(int i=0;i<8;++i){const int row=i*4+(lane_e>>4),ch=lane_e&15; const u32x4 v=*(const u32x4*)(stg+row*128+ch*8); *(u32x4*)(Yw+(long)row*DM+ch*8)=v;}
  }
  asm volatile("s_waitcnt vmcnt(0) lgkmcnt(0)\n\ts_barrier":::"memory");
  #undef DA_DMA
  #undef DA_RFL
}
#ifndef DB_VPRE
#define DB_VPRE 0
#endif
#ifndef DB_FILLX
#define DB_FILLX 1
#endif
template<int THRL> __device__ __forceinline__ void dattn2_unit(int qblk,const bf16*Qb,const bf16*__restrict__ Kb,const bf16*__restrict__ Vb,bf16*Yb,float lam,const float*gsub,float gscale,char*shm,const int tid_in){
  const int tid=tid_in,lane=tid&63,r32=lane&31,hi=lane>>5; const int wid=__builtin_amdgcn_readfirstlane(tid>>6);
  const int c=wid>>2, rg=wid&3;
  const int q0=qblk*DA_ROWS; const int NT=(q0+DA_ROWS)/KVBLK;
  const bf16*Qw=Qb+c*64+(long)(q0+rg*32)*DM;
  const unsigned lds0=(unsigned)(uintptr_t)shm; const lds_cptr shm3=(lds_cptr)shm;
  const int pk0=2*wid;
  const bf16*ksrc0=Kb+(pk0>>3)*64+(long)((pk0&7)*8+(lane>>3))*DM+((lane&7)^((lane>>3)&7))*8;
  const unsigned kdst0=lds0+(pk0>>3)*8192+(pk0&7)*1024;
  const bf16*vsrc0=Vb+(long)(16*(pk0&3)+(lane>>2))*DM+(pk0>>2)*32+(lane&3)*8;
  const unsigned vdst0=lds0+DA_V+pk0*1024;
  #define DB_RFL(x) ((unsigned)__builtin_amdgcn_readfirstlane((int)(x)))
  #define DB_DMA(t,so) do{ const long to_=(long)(t)*KVBLK*DM; \
      glds16(ksrc0+to_,DB_RFL(kdst0+(so))); glds16(ksrc0+to_+8*DM,DB_RFL(kdst0+(so)+1024)); \
      glds16(vsrc0+to_,DB_RFL(vdst0+(so))); glds16(vsrc0+to_+16*DM,DB_RFL(vdst0+(so)+1024)); }while(0)
  #define DB_SLOT(t) (((t)&3)*DA_SLOT)
  const lds_cptr kp0=shm3+c*8192+r32*128+((hi^(r32&7))*16);
  #define DB_KLD(kf_,kp_,d0) do{ const lds_cptr a_=(lds_cptr)(size_t)(((unsigned)(size_t)(kp_))^((unsigned)(d0)<<5)); kf_[2*(d0)]=*(const __attribute__((address_space(3))) bf16x8*)(a_); kf_[2*(d0)+1]=*(const __attribute__((address_space(3))) bf16x8*)(a_+4096); }while(0)
  const lds_cptr vp0=shm3+DA_V+((lane>>4)&1)*32+(lane&3)*8+(4*hi+((lane&15)>>2))*64;
  bf16x8 qr[4];
  DB_DMA(0,0); DB_DMA(1,DA_SLOT);
  #pragma unroll
  for(int d0=0;d0<4;++d0)qr[d0]=*reinterpret_cast<const bf16x8*>(&Qw[(long)r32*DM+d0*16+hi*8]);
  asm volatile("":"+v"(qr[0]),"+v"(qr[1]),"+v"(qr[2]),"+v"(qr[3]));
  float mref=0.f,l_reg=0.f; f32x16 o[4]; o[0]=f32x16{}; o[1]=f32x16{}; o[2]=f32x16{}; o[3]=f32x16{};
  f32x16 p0,p1; u32x4 pw0,pw1,pw2,pw3; s16x4 va[8],vb[8];
  #pragma unroll
  for(int r=0;r<16;++r){ p0[r]=0.f; p1[r]=0.f; }
  asm volatile("":"+v"(p0),"+v"(p1));
  const int qrel=rg*32+r32;
  #define DB_WAITT(u) do{ if((u)+1<NT){ asm volatile("s_waitcnt vmcnt(4)":::"memory"); } else { asm volatile("s_waitcnt vmcnt(0)":::"memory"); } }while(0)
  #define DB_ISSUE(u) do{ if((u)<NT){ DB_DMA((u),DB_SLOT(u)); } }while(0)
  #define DB_BAR() asm volatile("s_waitcnt lgkmcnt(0)\n\ts_barrier":::"memory")
  #define DB_BARP() asm volatile("s_waitcnt lgkmcnt(0)\n\ts_barrier":"+v"(p0),"+v"(p1)::"memory")
  #define DB_VLD(x,vp_,d0) do{ _Pragma("unroll") for(int ks_=0;ks_<4;++ks_){ x[2*ks_]=vtr((vp_)+(d0)*4096+ks_*1024); x[2*ks_+1]=vtr((vp_)+(d0)*4096+ks_*1024+512); } }while(0)
  #define DB_VF(x,ks) ((bf16x8){x[2*(ks)][0],x[2*(ks)][1],x[2*(ks)][2],x[2*(ks)][3],x[2*(ks)+1][0],x[2*(ks)+1][1],x[2*(ks)+1][2],x[2*(ks)+1][3]})
  #define DB_PVM(x,d0) do{ o[d0]=__builtin_amdgcn_mfma_f32_32x32x16_bf16(DB_VF(x,0),__builtin_bit_cast(bf16x8,pw0),o[d0],0,0,0); o[d0]=__builtin_amdgcn_mfma_f32_32x32x16_bf16(DB_VF(x,1),__builtin_bit_cast(bf16x8,pw1),o[d0],0,0,0); \
      o[d0]=__builtin_amdgcn_mfma_f32_32x32x16_bf16(DB_VF(x,2),__builtin_bit_cast(bf16x8,pw2),o[d0],0,0,0); o[d0]=__builtin_amdgcn_mfma_f32_32x32x16_bf16(DB_VF(x,3),__builtin_bit_cast(bf16x8,pw3),o[d0],0,0,0); }while(0)
  #define DB_QKM(kf_) do{ p0=__builtin_amdgcn_mfma_f32_32x32x16_bf16(kf_[0],qr[0],p0,0,0,0); p1=__builtin_amdgcn_mfma_f32_32x32x16_bf16(kf_[1],qr[0],p1,0,0,0); \
      _Pragma("unroll") for(int d0_=1;d0_<4;++d0_){ p0=__builtin_amdgcn_mfma_f32_32x32x16_bf16(kf_[2*d0_],qr[d0_],p0,0,0,0); p1=__builtin_amdgcn_mfma_f32_32x32x16_bf16(kf_[2*d0_+1],qr[d0_],p1,0,0,0); } }while(0)
  #define DB_FILL() do{ float nm_=-mref; asm volatile("":"+v"(nm_)); _Pragma("unroll") for(int r=0;r<16;++r){ p0[r]=nm_; p1[r]=nm_; } }while(0)
  #define DB_M(tp,tq) do{ const lds_cptr vp_=vp0+DB_SLOT(tp); const lds_cptr kp_=kp0+DB_SLOT(tq); bf16x8 kf_[8]; \
      if(!DB_VPRE){ DB_VLD(va,vp_,0); DB_VLD(vb,vp_,1); SBAR(); } DB_PVM(va,0); DB_VLD(va,vp_,2); SBAR(); \
      DB_PVM(vb,1); DB_VLD(vb,vp_,3); SBAR(); \
      DB_PVM(va,2); DB_KLD(kf_,kp_,0); DB_KLD(kf_,kp_,1); SBAR(); \
      DB_PVM(vb,3); DB_KLD(kf_,kp_,2); DB_KLD(kf_,kp_,3); SBAR(); \
      if(!DB_FILLX){ DB_FILL(); } DB_QKM(kf_); }while(0)
  #define DB_QK0(tq) do{ const lds_cptr kp_=kp0+DB_SLOT(tq); bf16x8 kf_[8]; DB_KLD(kf_,kp_,0); DB_KLD(kf_,kp_,1); DB_KLD(kf_,kp_,2); DB_KLD(kf_,kp_,3); SBAR(); DB_QKM(kf_); }while(0)
  #define DB_PVL(tp) do{ const lds_cptr vp_=vp0+DB_SLOT(tp); if(!DB_VPRE){ DB_VLD(va,vp_,0); DB_VLD(vb,vp_,1); SBAR(); } DB_PVM(va,0); DB_VLD(va,vp_,2); SBAR(); DB_PVM(vb,1); DB_VLD(vb,vp_,3); SBAR(); DB_PVM(va,2); SBAR(); DB_PVM(vb,3); }while(0)
  #define DB_X(tt,FIRST) do{ { const int jb_=(tt)-(NT-2); if(jb_>=0){ cmask(p0,p1,jb_,qrel,hi); } } \
      const float rm_=rowmax(p0,p1); \
      if(FIRST){ mref=rm_; _Pragma("unroll") for(int r=0;r<16;++r){ p0[r]-=rm_; p1[r]-=rm_; } } \
      else if(__any(rm_>(float)THRL)){ const float dl_=__builtin_fmaxf(rm_,0.f); const float f_=__builtin_amdgcn_exp2f(-dl_); mref+=dl_; l_reg*=f_; \
        _Pragma("unroll") for(int r=0;r<16;++r){ p0[r]-=dl_; p1[r]-=dl_; } \
        _Pragma("unroll") for(int d_=0;d_<4;++d_) _Pragma("unroll") for(int r=0;r<16;++r){ float x_=o[d_][r]; asm volatile("v_mul_f32_e32 %0, %0, %1":"+v"(x_):"v"(f_)); o[d_][r]=x_; } } \
      float sacc_=0.f; _Pragma("unroll") for(int r=0;r<16;++r){ p0[r]=__builtin_amdgcn_exp2f(p0[r]); p1[r]=__builtin_amdgcn_exp2f(p1[r]); sacc_+=p0[r]+p1[r]; } l_reg+=sacc_; \
      pw0=(u32x4){cvtpk_s(p0[0],p0[1]),cvtpk_s(p0[2],p0[3]),cvtpk_s(p0[4],p0[5]),cvtpk_s(p0[6],p0[7])}; pw1=(u32x4){cvtpk_s(p0[8],p0[9]),cvtpk_s(p0[10],p0[11]),cvtpk_s(p0[12],p0[13]),cvtpk_s(p0[14],p0[15])}; \
      pw2=(u32x4){cvtpk_s(p1[0],p1[1]),cvtpk_s(p1[2],p1[3]),cvtpk_s(p1[4],p1[5]),cvtpk_s(p1[6],p1[7])}; pw3=(u32x4){cvtpk_s(p1[8],p1[9]),cvtpk_s(p1[10],p1[11]),cvtpk_s(p1[12],p1[13]),cvtpk_s(p1[14],p1[15])}; \
      if(DB_VPRE){ const lds_cptr vq_=vp0+DB_SLOT(tt); DB_VLD(va,vq_,0); DB_VLD(vb,vq_,1); } if(DB_FILLX){ DB_FILL(); } }while(0)
  DB_WAITT(0);
  if(c==1){ DB_BAR(); DB_ISSUE(2); }
  DB_BAR();
  DB_QK0(0);
  if(c==1){ DB_WAITT(1); } DB_BARP(); DB_ISSUE(2+c);
  DB_X(0,true);
  for(int t=1;t<NT;++t){
    if(c==0){ DB_WAITT(t); } DB_BAR();
    DB_M(t-1,t);
    if(c==1){ DB_WAITT(t+1); } DB_BARP(); DB_ISSUE(t+2+c);
    DB_X(t,false);
  }
  DB_BAR(); DB_PVL(NT-1);
  if(c==0){ DB_BAR(); }
  int lane_e=lane; asm volatile("":"+v"(lane_e)); const int r32e=lane_e&31, hie=lane_e>>5;
  l_reg+=__uint_as_float((unsigned)__builtin_amdgcn_ds_bpermute((lane_e^32)<<2,(int)__float_as_uint(l_reg)));
  asm volatile("s_waitcnt vmcnt(0) lgkmcnt(0)\n\ts_barrier":::"memory");
  const float rl=__builtin_amdgcn_rcpf(l_reg);
  float*st2=(float*)shm+rg*4096+lane_e;
  if(c==1){ const float s_=lam*rl;
    #pragma unroll
    for(int d0=0;d0<4;++d0)
      #pragma unroll
      for(int r=0;r<16;++r)st2[(d0*16+r)*64]=o[d0][r]*s_;
  }
  asm volatile("s_waitcnt lgkmcnt(0)\n\ts_barrier":::"memory");
  if(c==0){
    float a_=0.f;
    #pragma unroll
    for(int d0=0;d0<4;++d0)
      #pragma unroll
      for(int r=0;r<16;++r){ const float x_=o[d0][r]*rl-st2[(d0*16+r)*64]; o[d0][r]=x_; a_+=x_*x_; }
    a_+=__uint_as_float((unsigned)__builtin_amdgcn_ds_bpermute((lane_e^32)<<2,(int)__float_as_uint(a_)));
    const float rs=gscale/__builtin_sqrtf(a_*(1.0f/128.0f)+1e-5f);
    char*stg=shm+65536+rg*(32*272)+r32e*272+hie*8;
    #pragma unroll
    for(int d0=0;d0<4;++d0)
      #pragma unroll
      for(int g=0;g<4;++g){ const float4 gv=*reinterpret_cast<const float4*>(gsub+d0*32+8*g+4*hie);
        uint2 w_; w_.x=cvtpk_s(o[d0][4*g]*rs*gv.x,o[d0][4*g+1]*rs*gv.y); w_.y=cvtpk_s(o[d0][4*g+2]*rs*gv.z,o[d0][4*g+3]*rs*gv.w);
        *reinterpret_cast<uint2*>(stg+(d0*32+8*g)*2)=w_; }
    asm volatile("s_waitcnt lgkmcnt(0)":::"memory");
    bf16*Yw=Yb+(long)(q0+rg*32)*DM; const char*stb=shm+65536+rg*(32*272);
    #pragma unroll
    for(int i=0;i<8;++i){const int row=i*4+(lane_e>>4),ch=lane_e&15; const u32x4 v=*(const u32x4*)(stb+row*272+ch*16); *(u32x4*)(Yw+(long)row*DM+ch*8)=v;}
  }
  asm volatile("s_waitcnt vmcnt(0) lgkmcnt(0)\n\ts_barrier":::"memory");
  #undef DB_RFL
  #undef DB_KLD
  #undef DB_DMA
  #undef DB_SLOT
  #undef DB_WAITT
  #undef DB_ISSUE
  #undef DB_BARP
  #undef DB_BAR
  #undef DB_VLD
  #undef DB_VF
  #undef DB_PVM
  #undef DB_QKM
  #undef DB_M
  #undef DB_QK0
  #undef DB_PVL
  #undef DB_X
}
constexpr int ATTN_LDS_BYTES=LDS_BYTES;
#undef SBAR
#undef WAIT_BAR
}

#define GAS __attribute__((address_space(1)))
#define LAS __attribute__((address_space(3)))
typedef unsigned short bf16;
typedef unsigned v4u __attribute__((ext_vector_type(4)));
typedef float f32x4 __attribute__((ext_vector_type(4)));
typedef short bf16x8 __attribute__((ext_vector_type(8)));
typedef GAS unsigned gu32;
typedef GAS unsigned long long gu64;
#define RLX_AGENT __ATOMIC_RELAXED, __HIP_MEMORY_SCOPE_AGENT
#define LDS_WAIT() asm volatile("s_waitcnt lgkmcnt(0)" ::: "memory")
#define VM_WAIT() asm volatile("s_waitcnt vmcnt(0)" ::: "memory")
__device__ __forceinline__ unsigned long long rt() { return __builtin_amdgcn_s_memrealtime(); }
__device__ __forceinline__ unsigned f2bf(float f) { unsigned u = __builtin_bit_cast(unsigned, f); return (u + 0x7fffu + ((u >> 16) & 1u)) >> 16; }
__device__ __forceinline__ unsigned pk2(float lo, float hi) { return f2bf(lo) | (f2bf(hi) << 16); }

#define XB_TMO      128
#define XB_XCNT(j)  (256  + 64 * (j))
#define XB_XSUB(j)  (1280 + 64 * (j))
#define XB_XGEN(j)  (2304 + 64 * (j))
#define XB_TOP      3328
#define XB_TOPGEN   3392
#define XCD_BAR_WORDS 3456
#define XB_SPIN_CAP (1u << 26)

__device__ __forceinline__ unsigned xb_ld(unsigned* p)              { return __hip_atomic_load(p, __ATOMIC_RELAXED, __HIP_MEMORY_SCOPE_AGENT); }
__device__ __forceinline__ unsigned xb_add(unsigned* p, unsigned v) { return __hip_atomic_fetch_add(p, v, __ATOMIC_RELAXED, __HIP_MEMORY_SCOPE_AGENT); }
__device__ __forceinline__ unsigned xb_xcc_id() { return (unsigned)__builtin_amdgcn_s_getreg((3 << 11) | 20) & 0xFu; }
#define XB_SPIN(cond, bar) do { unsigned _sp = 0; while (cond) { __builtin_amdgcn_s_sleep(1); \
    if ((++_sp & 255u) == 0u) { if (xb_ld(&(bar)[XB_TMO])) break; if (_sp > XB_SPIN_CAP) { atomicAdd(&(bar)[XB_TMO], 1u); break; } } } } while (0)

struct XcdBarrier {
    unsigned* bar; unsigned x;
    volatile LAS unsigned* st;
};

__device__ __forceinline__ XcdBarrier xcd_barrier_post(unsigned* bar, volatile LAS unsigned* st, const int tid) {
    XcdBarrier b; b.bar = bar; b.x = xb_xcc_id(); b.st = st;
    if (tid == 0) (void)xb_add(&bar[XB_XCNT(b.x)], 1u);
    return b;
}
__device__ __forceinline__ void xcd_barrier_complete(unsigned* bar, unsigned x, unsigned& nloc, unsigned& nx) {
    const unsigned G = gridDim.x * gridDim.y * gridDim.z;
    unsigned sum, cnt, mine, sp = 0u;
    for (;;) {
        sum = 0u; cnt = 0u; mine = 0u;
#pragma unroll
        for (unsigned j = 0; j < 16; ++j) { const unsigned c = xb_ld(&bar[XB_XCNT(j)]); sum += c; cnt += (c > 0u) ? 1u : 0u; mine = (j == x) ? c : mine; }
        if (sum == G) break;
        __builtin_amdgcn_s_sleep(1);
        if ((++sp & 255u) == 0u) { if (xb_ld(&bar[XB_TMO])) break; if (sp > XB_SPIN_CAP) { atomicAdd(&bar[XB_TMO], 1u); break; } }
    }
    nloc = mine > 0u ? mine : 1u; nx = cnt > 0u ? cnt : 1u;
}

__device__ __forceinline__ void xcd_barrier(const XcdBarrier& b, const int tid) {
    asm volatile("s_waitcnt vmcnt(0)" ::: "memory");
    __syncthreads();
    if (tid == 0) {
        unsigned* bar = b.bar;
        __builtin_amdgcn_s_waitcnt(0);
        unsigned nloc = b.st[0], nx = b.st[1];
        if (nloc == 0u) { xcd_barrier_complete(bar, b.x, nloc, nx); b.st[0] = nloc; b.st[1] = nx; }
        const unsigned old = xb_add(&bar[XB_XSUB(b.x)], 1u);
        const unsigned gen = old / nloc;
        if (old + 1u == (gen + 1u) * nloc) {
            __builtin_amdgcn_fence(__ATOMIC_RELEASE, "agent");
            asm volatile("s_waitcnt vmcnt(0)" ::: "memory");
            const unsigned og = xb_add(&bar[XB_TOP], 1u);
            const unsigned tg = og / nx;
            if (og + 1u == (tg + 1u) * nx) xb_add(&bar[XB_TOPGEN], 1u);
            else XB_SPIN(xb_ld(&bar[XB_TOPGEN]) == tg, bar);
            __builtin_amdgcn_fence(__ATOMIC_ACQUIRE, "agent");
            xb_add(&bar[XB_XGEN(b.x)], 1u);
            asm volatile("s_waitcnt vmcnt(0)" ::: "memory");
        } else {
            XB_SPIN(xb_ld(&bar[XB_XGEN(b.x)]) == gen, bar);
            __builtin_amdgcn_fence(__ATOMIC_ACQUIRE, "agent");
            asm volatile("s_waitcnt vmcnt(0)" ::: "memory");
        }
    }
    __syncthreads();
}

constexpr int NWAVES = 8;
constexpr int NTOK = 65536, NH = 32768, DMODEL = 1024, SEQLEN = 4096, INCOLS = 5632, DFF = 2816, NEXP = 8;
constexpr int MOE_PANELS_MAX = 264;
constexpr float EPS_NORM = 1e-6f, EPS_SUBLN = 1e-5f;

constexpr size_t MiB = 1u << 20;
constexpr size_t WS_CTL = 0, CTL_ZERO_BYTES = 1 * MiB;
constexpr size_t WS_WIN = 1 * MiB;
constexpr size_t WS_WGLU = 23 * MiB;
constexpr size_t WS_WPS = 24 * MiB;
constexpr size_t WS_WPA = 26 * MiB;
constexpr size_t WS_WOUT = 30 * MiB;
constexpr size_t WS_WDGU = 34 * MiB;
constexpr size_t WS_WDD = 45 * MiB;
constexpr size_t WS_WMGU = 51 * MiB;
constexpr size_t WS_WMD = 139 * MiB;
constexpr size_t WS_TZF = 183 * MiB;
constexpr size_t WS_EM = 223 * MiB;
constexpr size_t WS_ROPE = 239 * MiB;
constexpr size_t WS_ROUTE = 255 * MiB;
constexpr size_t WS_ACT = 260 * MiB;
constexpr size_t WS_END = 960 * MiB;
constexpr size_t A_HB = 0, A_UBUF = 64 * MiB, A_SLOC = 104 * MiB, A_Q = 120 * MiB, A_K = 184 * MiB, A_V = 248 * MiB, A_SGS = 312 * MiB, A_SGA = 376 * MiB, A_YA = 440 * MiB, A_YA2 = 472 * MiB, A_OV = 504 * MiB, A_YB = 632 * MiB;
constexpr size_t A_H2 = 0, A_FA = 64 * MiB;
constexpr size_t A_H2G = 64 * MiB, A_AG = 196 * MiB, A_YG = 559 * MiB;
static_assert(A_UBUF == pg8::EA_U && A_Q == pg8::EA_Q && A_K == pg8::EA_K && A_V == pg8::EA_V && A_SGS == pg8::EA_SGS && A_SGA == pg8::EA_SGA, "EpiIn offsets");
static_assert(A_YB + 64 * MiB <= WS_END - WS_ACT && A_OV + 128 * MiB <= WS_END - WS_ACT && A_YG + 132 * MiB <= WS_END - WS_ACT, "act map");
constexpr size_t R_E = 0, R_W = 256 * 1024, R_S = 512 * 1024, R_CNT = 768 * 1024;
constexpr int CW_BAR = 4096;

constexpr int RING_OFF = 0, RING_BYTES = 131072;
constexpr int LDSCTL_OFF = RING_BYTES, MISC_OFF = LDSCTL_OFF + 320;
constexpr int LDS_BYTES = 147456;

constexpr int PTR_OFF = LDSCTL_OFF + 1024;
struct Args { const void* in[31]; float* out; unsigned char* ws; };
__device__ __forceinline__ unsigned long long ldp64(LAS unsigned char* L, int slot) {
    const unsigned long long v = ((volatile LAS unsigned long long*)(L + PTR_OFF))[slot];
    const unsigned lo = __builtin_amdgcn_readfirstlane((unsigned)v), hi = __builtin_amdgcn_readfirstlane((unsigned)(v >> 32));
    return ((unsigned long long)hi << 32) | lo;
}
#define LDP(T, slot) ((T*)(GAS T*)(uintptr_t)ldp64(L, (slot)))

#define SWZ_XOR(k) (((k) << 10) | 0x1f)
#define swz_xor(v, pat) __builtin_bit_cast(float, __builtin_amdgcn_ds_swizzle(__builtin_bit_cast(int, (float)(v)), (pat)))
__device__ __forceinline__ float wave_sum(float v) {
#define WS_DPP(x, ctrl) __builtin_bit_cast(float, __builtin_amdgcn_update_dpp(0, __builtin_bit_cast(int, (float)(x)), (ctrl), 0xf, 0xf, false))
    v += WS_DPP(v, 0xB1); v += WS_DPP(v, 0x4E); v += WS_DPP(v, 0x141); v += WS_DPP(v, 0x140);
#undef WS_DPP
    const float r0 = __builtin_bit_cast(float, __builtin_amdgcn_readlane(__builtin_bit_cast(int, v), 0)), r1 = __builtin_bit_cast(float, __builtin_amdgcn_readlane(__builtin_bit_cast(int, v), 16));
    const float r2 = __builtin_bit_cast(float, __builtin_amdgcn_readlane(__builtin_bit_cast(int, v), 32)), r3 = __builtin_bit_cast(float, __builtin_amdgcn_readlane(__builtin_bit_cast(int, v), 48));
    return (r0 + r1) + (r2 + r3);
}
__device__ __forceinline__ void tr_item(const float* W, int ldw, int K, bf16* WTn0, int k0, int srccol, LAS float* scr, int lane) {
#pragma unroll 8
    for (int i = 0; i < 32; ++i) { const int kk = 2 * i + (lane >> 5); scr[kk * 33 + (lane & 31)] = W[(size_t)(k0 + kk) * ldw + srccol]; }
    LDS_WAIT(); asm volatile("" ::: "memory");
    const int c = lane & 7;
#pragma unroll
    for (int j = 0; j < 4; ++j) { const int n = (lane >> 3) + 8 * j; const LAS float* s = scr + (8 * c) * 33 + n;
        v4u o; o.x = pk2(s[0 * 33], s[1 * 33]); o.y = pk2(s[2 * 33], s[3 * 33]); o.z = pk2(s[4 * 33], s[5 * 33]); o.w = pk2(s[6 * 33], s[7 * 33]);
        *(GAS v4u*)(WTn0 + (size_t)n * K + k0 + 8 * c) = o; }
    LDS_WAIT(); asm volatile("" ::: "memory");
}
__device__ __forceinline__ int win_orig(int n) { if (n < 512 || n >= 2560) return n; const int i = n & 63; return (n & ~63) + 16 * ((i >> 5) & 1) + 4 * ((i >> 3) & 3) + (i & 3) + 32 * ((i >> 2) & 1); }
__device__ __forceinline__ void tr_plain(const float* W, int K, int N, bf16* WT, int item, LAS float* scr, int lane) {
    const int nblk = N / 32, kb = item / nblk, nb = item % nblk;
    tr_item(W, N, K, WT + (size_t)(32 * nb) * K, 64 * kb, 32 * nb + (lane & 31), scr, lane);
}
__device__ __forceinline__ void tr_win(const float* W, bf16* WT, int item, LAS float* scr, int lane) {
    const int nblk = INCOLS / 32, kb = item / nblk, nb = item % nblk;
    tr_item(W, INCOLS, DMODEL, WT + (size_t)(32 * nb) * DMODEL, 64 * kb, win_orig(32 * nb + (lane & 31)), scr, lane);
}
__device__ __forceinline__ void tr_gu(const float* Wg, const float* Wu, bf16* WT, int item, LAS float* scr, int lane) {
    const int nblk = INCOLS / 32, kb = item / nblk, nb = item % nblk; const int n0 = 32 * nb, pn = n0 >> 8, r = n0 & 255;
    const float* W = r < 128 ? Wg : Wu; const int col = pn * 128 + (r & 127) + (lane & 31);
    tr_item(W, DFF, DMODEL, WT + (size_t)n0 * DMODEL, 64 * kb, col, scr, lane);
}
struct S5In { const float *lam_re, *lam_im, *log_dt, *b_re, *b_im, *c_re, *c_im, *dd; };
__device__ __forceinline__ v4u pack8f(const float* v) { v4u o; o.x = pk2(v[0], v[1]); o.y = pk2(v[2], v[3]); o.z = pk2(v[4], v[5]); o.w = pk2(v[6], v[7]); return o; }
__device__ __forceinline__ void s5_item(LAS unsigned char* L, int tid, const S5In& P, int lg, int d, bf16* TZF, bf16* EM) {
    LAS float* sm = (LAS float*)(L);
    LAS float *s_fr = sm, *s_fi = sm + 64, *s_apr = sm + 128, *s_api = sm + 192, *BBr = sm + 256, *BBi = sm + 1280, *CAr = sm + 2304, *CAi = sm + 3328, *Kd = sm + 4352;
    if (tid < 64) {
        const int p = tid;
        const float dt = expf(P.log_dt[lg]);
        const float lr = P.lam_re[lg * 64 + p], li = P.lam_im[lg * 64 + p];
        const float mag = expf(lr * dt); float sn, cs; sincosf(li * dt, &sn, &cs);
        const float ar = mag * cs, ai = mag * sn;
        const float den = lr * lr + li * li, nr = ar - 1.0f, ni = ai;
        s_fr[p] = (nr * lr + ni * li) / den; s_fi[p] = (ni * lr - nr * li) / den;
        const float fd = (float)d; const float magd = expf(fd * lr * dt); float snd, csd; sincosf(fd * li * dt, &snd, &csd);
        s_apr[p] = magd * csd; s_api[p] = magd * snd;
    }
    __syncthreads();
    for (int idx = tid; idx < 1024; idx += 512) {
        { const int p = idx >> 4; const float br = P.b_re[(size_t)lg * 1024 + idx], bi = P.b_im[(size_t)lg * 1024 + idx]; const float fr_ = s_fr[p], fi_ = s_fi[p];
          BBr[idx] = fr_ * br - fi_ * bi; BBi[idx] = fr_ * bi + fi_ * br; }
        { const int p = idx & 63; const float cr = P.c_re[(size_t)lg * 1024 + idx], ci = P.c_im[(size_t)lg * 1024 + idx]; const float ar_ = s_apr[p], ai_ = s_api[p];
          CAr[idx] = cr * ar_ - ci * ai_; CAi[idx] = cr * ai_ + ci * ar_; }
    }
    __syncthreads();
    if (d <= 31 && tid < 256) { const int j = tid >> 4, jp = tid & 15; float acc = 0.f;
        for (int p = 0; p < 64; ++p) acc += CAr[j * 64 + p] * BBr[p * 16 + jp] - CAi[j * 64 + p] * BBi[p * 16 + jp];
        if (d == 0 && j == jp) acc += P.dd[lg * 16 + j];
        Kd[tid] = acc; }
    __syncthreads();
    bf16* TZ = TZF + (size_t)lg * 512 * 640; bf16* EE = EM + (size_t)lg * 256 * 512;
    if (d <= 31) {
        const int cnt = (32 - d) * 16;
        for (int idx = tid; idx < cnt; idx += 512) { const int tt = idx >> 4, j = idx & 15; float v[16];
#pragma unroll
            for (int q = 0; q < 16; ++q) v[q] = Kd[j * 16 + q];
            bf16* dst = TZ + (size_t)((d + tt) * 16 + j) * 640 + tt * 16;
            *(GAS v4u*)dst = pack8f(v); *(GAS v4u*)(dst + 8) = pack8f(v + 8);
            if (d >= 1) { bf16* dz = TZ + (size_t)(tt * 16 + j) * 640 + (d + tt) * 16; const v4u z = {0u, 0u, 0u, 0u}; *(GAS v4u*)dz = z; *(GAS v4u*)(dz + 8) = z; } }
        if (tid < 128) { const int ri = tid >> 6, p = tid & 63; const float ar_ = s_apr[p], ai_ = s_api[p]; float v[16];
#pragma unroll
            for (int q = 0; q < 16; ++q) { const float br = BBr[p * 16 + q], bi = BBi[p * 16 + q]; v[q] = ri == 0 ? (ar_ * br - ai_ * bi) : (ar_ * bi + ai_ * br); }
            bf16* dst = EE + (size_t)tid * 512 + (31 - d) * 16; *(GAS v4u*)dst = pack8f(v); *(GAS v4u*)(dst + 8) = pack8f(v + 8);
        } else if (tid < 256) { bf16* dz = EE + (size_t)tid * 512 + (31 - d) * 16; const v4u z = {0u, 0u, 0u, 0u}; *(GAS v4u*)dz = z; *(GAS v4u*)(dz + 8) = z; }
    }
    if (d >= 1 && tid < 256) { const int j = tid >> 4, ri = (tid >> 3) & 1, pc = tid & 7; float v[8];
#pragma unroll
        for (int q = 0; q < 8; ++q) v[q] = ri == 0 ? CAr[j * 64 + pc * 8 + q] : -CAi[j * 64 + pc * 8 + q];
        *(GAS v4u*)(TZ + (size_t)((d - 1) * 16 + j) * 640 + 512 + ri * 64 + pc * 8) = pack8f(v); }
    __syncthreads();
}
__device__ __forceinline__ void norm_rows4(const float* x0, size_t xstep, const f32x4 (&g)[4], bf16* o0, size_t ostep, int lane) {
    f32x4 h[4][4];
#pragma unroll
    for (int r = 0; r < 4; ++r) { const GAS f32x4* xr = (const GAS f32x4*)(x0 + r * xstep) + lane;
#pragma unroll
        for (int j = 0; j < 4; ++j) h[r][j] = xr[64 * j]; }
#pragma unroll
    for (int r = 0; r < 4; ++r) { float s2 = 0.f;
#pragma unroll
        for (int j = 0; j < 4; ++j) s2 += (h[r][j].x * h[r][j].x + h[r][j].y * h[r][j].y) + (h[r][j].z * h[r][j].z + h[r][j].w * h[r][j].w);
        const float rs = 1.0f / sqrtf(wave_sum(s2) * (1.0f / DMODEL) + EPS_NORM);
        GAS unsigned long long* o8 = (GAS unsigned long long*)(o0 + r * ostep) + lane;
#pragma unroll
        for (int j = 0; j < 4; ++j) { const f32x4 v = h[r][j] * rs * g[j]; o8[64 * j] = (unsigned long long)pk2(v.x, v.y) | ((unsigned long long)pk2(v.z, v.w) << 32); } }
}
__device__ __forceinline__ void norm_row(const float* xrow, const float* gain, bf16* orow, int lane, f32x4 (&hn)[4]) {
    const GAS f32x4* xr = (const GAS f32x4*)xrow + lane; const GAS f32x4* gr = (const GAS f32x4*)gain + lane;
    float s2 = 0.f;
#pragma unroll
    for (int j = 0; j < 4; ++j) { hn[j] = xr[64 * j]; s2 += (hn[j].x * hn[j].x + hn[j].y * hn[j].y) + (hn[j].z * hn[j].z + hn[j].w * hn[j].w); }
    const float rs = 1.0f / sqrtf(wave_sum(s2) * (1.0f / DMODEL) + EPS_NORM);
    GAS unsigned long long* o8 = (GAS unsigned long long*)orow + lane;
#pragma unroll
    for (int j = 0; j < 4; ++j) { const f32x4 g = gr[64 * j]; hn[j] = hn[j] * rs * g;
        o8[64 * j] = (unsigned long long)pk2(hn[j].x, hn[j].y) | ((unsigned long long)pk2(hn[j].z, hn[j].w) << 32); }
}

__global__ void __launch_bounds__(NWAVES * 64, 2) trunk_fwd(Args args) {
    extern __shared__ __attribute__((aligned(16))) unsigned char lds[];
    const int WAVE = __builtin_amdgcn_readfirstlane((int)threadIdx.x >> 6);
#define MYTID() ({ int l_; asm volatile("v_mbcnt_lo_u32_b32 %0, -1, 0\n\tv_mbcnt_hi_u32_b32 %0, -1, %0" : "=v"(l_)); WAVE * 64 + l_; })
    LAS unsigned char* const L0 = (LAS unsigned char*)lds;
#define OPQ LAS unsigned char* L = L0; asm volatile("" : "+s"(L))
    OPQ;
    {
        const int tid0 = MYTID();
        for (int u = tid0; u < (LDS_BYTES - LDSCTL_OFF) / 4; u += NWAVES * 64) ((LAS unsigned*)(L + LDSCTL_OFF))[u] = 0u;
        __syncthreads();
        if (tid0 == 0) {
#pragma unroll
            for (int k = 0; k < 31; ++k) ((LAS unsigned long long*)(L + PTR_OFF))[k] = (unsigned long long)(uintptr_t)args.in[k];
            ((LAS unsigned long long*)(L + PTR_OFF))[31] = (unsigned long long)(uintptr_t)args.out;
            ((LAS unsigned long long*)(L + PTR_OFF))[32] = (unsigned long long)(uintptr_t)args.ws; }
        __syncthreads();
    }
    { XcdBarrier b0 = xcd_barrier_post((unsigned*)(LDP(unsigned char, 32) + WS_CTL) + CW_BAR, (volatile LAS unsigned*)(L + MISC_OFF) + 8, MYTID()); (void)b0; }
#define GRID_BAR() do { OPQ; XcdBarrier b_; b_.bar = (unsigned*)(LDP(unsigned char, 32) + WS_CTL) + CW_BAR; b_.x = xb_xcc_id(); b_.st = (volatile LAS unsigned*)(L + MISC_OFF) + 8; xcd_barrier(b_, MYTID()); } while (0)
#define LQ() ({ int l_ = l; asm volatile("" : "+s"(l_)); l_; })
#define TID_SETUP OPQ; int wave_ = WAVE; asm volatile("" : "+s"(wave_)); const int wave = wave_; const int tid = MYTID(), lane = tid & 63; const int G = gridDim.x; const int vcu = ((int)blockIdx.x % 8) * (G / 8) + (int)blockIdx.x / 8; const int gw = vcu * NWAVES + wave, NGW = G * NWAVES; (void)lane; (void)gw; (void)NGW; (void)tid
#define WSP(T, off) ((T*)(LDP(unsigned char, 32) + (off)))
#define ACTP(T, off) ((T*)(LDP(unsigned char, 32) + WS_ACT + (off)))

    {
        TID_SETUP;
        LAS float* scr = (LAS float*)(L + RING_OFF + wave * 16384);
        constexpr int I_WIN = 16 * 176, I_GLU = 8 * 16, I_PS = 8 * 32, I_PA = 16 * 32, I_OUT = 16 * 32, I_GU = 16 * 176, I_DN = 44 * 32;
        constexpr int I_LAYER = I_WIN + I_GLU + I_PS + I_PA + I_OUT;
        constexpr int NITEMS = 2 * I_LAYER + I_GU + I_DN + 8 * I_GU + 8 * I_DN;
        for (int it = gw; it < NITEMS; it += NGW) {
            int r = it;
            if (r < 2 * I_LAYER) { const int l = r / I_LAYER; r -= l * I_LAYER;
                if (r < I_WIN) { tr_win(LDP(const float, 3) + (size_t)l * DMODEL * INCOLS, WSP(bf16, WS_WIN) + (size_t)l * INCOLS * DMODEL, r, scr, lane); continue; } r -= I_WIN;
                if (r < I_GLU) { tr_plain(LDP(const float, 12) + (size_t)l * 512 * 512, 512, 512, WSP(bf16, WS_WGLU) + (size_t)l * 512 * 512, r, scr, lane); continue; } r -= I_GLU;
                if (r < I_PS) { tr_plain(LDP(const float, 19) + (size_t)l * 512 * 1024, 512, 1024, WSP(bf16, WS_WPS) + (size_t)l * 1024 * 512, r, scr, lane); continue; } r -= I_PS;
                if (r < I_PA) { tr_plain(LDP(const float, 20) + (size_t)l * 1024 * 1024, 1024, 1024, WSP(bf16, WS_WPA) + (size_t)l * 1024 * 1024, r, scr, lane); continue; } r -= I_PA;
                tr_plain(LDP(const float, 21) + (size_t)l * 1024 * 1024, 1024, 1024, WSP(bf16, WS_WOUT) + (size_t)l * 1024 * 1024, r, scr, lane); continue; }
            r -= 2 * I_LAYER;
            if (r < I_GU) { tr_gu(LDP(const float, 23), LDP(const float, 24), WSP(bf16, WS_WDGU), r, scr, lane); continue; } r -= I_GU;
            if (r < I_DN) { tr_plain(LDP(const float, 25), DFF, DMODEL, WSP(bf16, WS_WDD), r, scr, lane); continue; } r -= I_DN;
            if (r < 8 * I_GU) { const int e = r / I_GU; r -= e * I_GU; tr_gu(LDP(const float, 27) + (size_t)e * DMODEL * DFF, LDP(const float, 28) + (size_t)e * DMODEL * DFF, WSP(bf16, WS_WMGU) + (size_t)e * INCOLS * DMODEL, r, scr, lane); continue; } r -= 8 * I_GU;
            { const int e = r / I_DN; r -= e * I_DN; tr_plain(LDP(const float, 29) + (size_t)e * DFF * DMODEL, DFF, DMODEL, WSP(bf16, WS_WMD) + (size_t)e * DMODEL * DFF, r, scr, lane); }
        }
        __syncthreads();
        { S5In s5p; s5p.lam_re = LDP(const float, 4); s5p.lam_im = LDP(const float, 5); s5p.log_dt = LDP(const float, 6); s5p.b_re = LDP(const float, 7); s5p.b_im = LDP(const float, 8);
          s5p.c_re = LDP(const float, 9); s5p.c_im = LDP(const float, 10); s5p.dd = LDP(const float, 11);
          for (int it = vcu; it < 2 * 32 * 33; it += G) s5_item(L, tid, s5p, it / 33, it % 33, WSP(bf16, WS_TZF), WSP(bf16, WS_EM)); }
        { const int* positions = LDP(const int, 1); float* ROPE = WSP(float, WS_ROPE);
          for (int idx = vcu * (NWAVES * 64) + tid; idx < NTOK * 32; idx += G * NWAVES * 64) { const int n = idx >> 5, fi = idx & 31;
            const float invf = powf(10000.0f, -(float)(2 * fi) / 64.0f); const float ang = (float)positions[n] * invf; float sn, cs; sincosf(ang, &sn, &cs);
            ROPE[(size_t)n * 64 + fi] = cs; ROPE[(size_t)n * 64 + 32 + fi] = sn; } }
    }
    GRID_BAR();

    for (int l = 0; l < 2; ++l) {
        for (int half = 0; half < 2; ++half) {
            const int tokbase = half * NH;
            { TID_SETUP; const float* xsrc = LDP(const float, (LQ() == 0) ? 0 : 31); const float* gain = LDP(const float, 2) + l * DMODEL; bf16* HB = ACTP(bf16, A_HB);
              f32x4 gq[4];
#pragma unroll
              for (int j = 0; j < 4; ++j) gq[j] = ((const GAS f32x4*)gain + lane)[64 * j];
              for (int m = gw; m < NH; m += 4 * NGW) norm_rows4(xsrc + (size_t)(tokbase + m) * DMODEL, (size_t)NGW * DMODEL, gq, HB + (size_t)m * DMODEL, (size_t)NGW * DMODEL, lane); }
            GRID_BAR();
            { OPQ; pg8::Gemm g{ACTP(bf16, A_HB), WSP(bf16, WS_WIN) + (size_t)l * INCOLS * DMODEL, DMODEL, DMODEL, DMODEL}; pg8::SchedPlain S; S.init(NH / 256, INCOLS / 256, gridDim.x, (int)blockIdx.x);
              pg8::EpiIn E{ACTP(unsigned char, 0), WSP(const float, WS_ROPE), tokbase};
              pg8::gemm_phase<pg8::EpiIn, pg8::SchedPlain, true, true>(L0 + RING_OFF, g, S, E, MYTID()); }
            GRID_BAR();
            { OPQ; pg8::Gemm g{ACTP(bf16, A_UBUF), WSP(bf16, WS_EM) + (size_t)l * 32 * 256 * 512, 640, 512, 512}; pg8::SchedS5 S; S.init(1, gridDim.x, (int)blockIdx.x);
              pg8::EpiSloc E{ACTP(float, A_SLOC)};
              pg8::gemm_phase<pg8::EpiSloc, pg8::SchedS5, true, true>(L0 + RING_OFF, g, S, E, MYTID()); }
            GRID_BAR();
            { TID_SETUP;
              if (wave == 0) {
                const int id = vcu * 64 + lane;
                if (id < 8 * 32 * 64) { const int bl = id >> 11, g = (id >> 6) & 31, p = id & 63; const int lg = l * 32 + g;
                    const float dt = expf(LDP(const float, 6)[lg]); const float lr = LDP(const float, 4)[lg * 64 + p], li = LDP(const float, 5)[lg * 64 + p];
                    const float magT = expf(32.0f * lr * dt); float snT, csT; sincosf(32.0f * li * dt, &snT, &csT); const float aTr = magT * csT, aTi = magT * snT;
                    float sr = 0.f, si = 0.f; const size_t row0 = (size_t)g * 1024 + (size_t)bl * 128;
                    const float* sl = ACTP(const float, A_SLOC) + row0 * 128 + p; bf16* ub = ACTP(bf16, A_UBUF) + row0 * 640 + 512 + p;
                    for (int c0 = 0; c0 < 128; c0 += 8) { float lr_[8], li_[8];
#pragma unroll
                        for (int q = 0; q < 8; ++q) { lr_[q] = sl[(size_t)(c0 + q) * 128]; li_[q] = sl[(size_t)(c0 + q) * 128 + 64]; }
#pragma unroll
                        for (int q = 0; q < 8; ++q) { ub[(size_t)(c0 + q) * 640] = (bf16)f2bf(sr); ub[(size_t)(c0 + q) * 640 + 64] = (bf16)f2bf(si);
                            const float nr_ = aTr * sr - aTi * si + lr_[q], ni_ = aTr * si + aTi * sr + li_[q]; sr = nr_; si = ni_; } } }
              } }
            GRID_BAR();
            { OPQ; pg8::Gemm g{ACTP(bf16, A_UBUF), WSP(bf16, WS_TZF) + (size_t)l * 32 * 512 * 640, 640, 640, 640}; pg8::SchedS5 S; S.init(2, gridDim.x, (int)blockIdx.x);
              pg8::EpiYa E{ACTP(bf16, A_YA)};
              pg8::gemm_phase<pg8::EpiYa, pg8::SchedS5, true, true>(L0 + RING_OFF, g, S, E, MYTID()); }
            GRID_BAR();
            { OPQ; pg8::Gemm g{ACTP(bf16, A_YA), WSP(bf16, WS_WGLU) + (size_t)l * 512 * 512, 512, 512, 512}; pg8::SchedPlain S; S.init(NH / 256, 2, gridDim.x, (int)blockIdx.x);
              pg8::EpiGlu E{ACTP(bf16, A_YA), ACTP(bf16, A_YA2), LDP(const float, 13) + l * 512};
              pg8::gemm_phase<pg8::EpiGlu, pg8::SchedPlain, true, true>(L0 + RING_OFF, g, S, E, MYTID()); }
            GRID_BAR();
            {
                TID_SETUP;
                int lq = l; asm volatile("" : "+s"(lq));
                const float lam_init = 0.8f - 0.6f * expf(-0.3f * (float)lq);
                const float p1 = wave_sum(LDP(const float, 14)[lq * 64 + lane] * LDP(const float, 15)[lq * 64 + lane]), p2 = wave_sum(LDP(const float, 16)[lq * 64 + lane] * LDP(const float, 17)[lq * 64 + lane]);
                float lam_v = expf(p1) - expf(p2) + lam_init, gsc_v = 1.0f - lam_init; asm volatile("" : "+v"(lam_v), "+v"(gsc_v));
                const int lam_i = __builtin_amdgcn_readfirstlane(__builtin_bit_cast(int, lam_v)), gsc_i = __builtin_amdgcn_readfirstlane(__builtin_bit_cast(int, gsc_v));
                const float lam = __builtin_bit_cast(float, lam_i), gsc = __builtin_bit_cast(float, gsc_i);
                for (int i = 0; i < 8; ++i) {
                    OPQ; const int bh = (i >> 1) * 16 + (vcu >> 4); const int j = vcu & 15; const int qblk = (i & 1) ? 31 - j : j;
                    const int b = bh >> 3, h = bh & 7; const size_t rb = (size_t)b * SEQLEN;
                    attn_body::dattn2_unit<8>(qblk, (const attn_body::bf16*)(ACTP(bf16, A_Q) + rb * 1024 + h * 128), (const attn_body::bf16*)(ACTP(bf16, A_K) + rb * 1024 + h * 128),
                                             (const attn_body::bf16*)(ACTP(bf16, A_V) + rb * 1024 + h * 128), (attn_body::bf16*)(ACTP(bf16, A_YB) + rb * 1024 + h * 128),
                                             lam, LDP(const float, 18) + lq * 128, gsc, (char*)lds + RING_OFF, MYTID());
                }
            }
            GRID_BAR();
            { OPQ; pg8::Gemm g{ACTP(bf16, A_YA2), WSP(bf16, WS_WPS) + (size_t)l * 1024 * 512, 512, 512, 512}; pg8::SchedPlain S; S.init(NH / 256, 4, gridDim.x, (int)blockIdx.x);
              pg8::EpiGate<0> E{ACTP(bf16, A_SGS), nullptr};
              pg8::gemm_phase<pg8::EpiGate<0>, pg8::SchedPlain, true, true>(L0 + RING_OFF, g, S, E, MYTID()); }
            GRID_BAR();
            { OPQ; pg8::Gemm g{ACTP(bf16, A_YB), WSP(bf16, WS_WPA) + (size_t)l * 1024 * 1024, 1024, 1024, 1024}; pg8::SchedPlain S; S.init(NH / 256, 4, gridDim.x, (int)blockIdx.x);
              pg8::EpiGate<1> E{ACTP(bf16, A_SGA), ACTP(bf16, A_SGS)};
              pg8::gemm_phase<pg8::EpiGate<1>, pg8::SchedPlain, true, true>(L0 + RING_OFF, g, S, E, MYTID()); }
            GRID_BAR();
            { OPQ; pg8::Gemm g{ACTP(bf16, A_SGA), WSP(bf16, WS_WOUT) + (size_t)l * 1024 * 1024, 1024, 1024, 1024}; pg8::SchedPlain S; S.init(NH / 256, 4, gridDim.x, (int)blockIdx.x);
              pg8::EpiRes E{LDP(const float, (LQ() == 0) ? 0 : 31), LDP(float, 31), tokbase};
              pg8::gemm_phase<pg8::EpiRes, pg8::SchedPlain, true, true>(L0 + RING_OFF, g, S, E, MYTID()); }
            GRID_BAR();
            if (LQ() == 0) {
                { TID_SETUP; const float* xs = LDP(const float, 31); const float* gain = LDP(const float, 22); bf16* H2 = ACTP(bf16, A_H2);
                  f32x4 gq[4];
#pragma unroll
                  for (int j = 0; j < 4; ++j) gq[j] = ((const GAS f32x4*)gain + lane)[64 * j];
                  for (int m = gw; m < NH; m += 4 * NGW) norm_rows4(xs + (size_t)(tokbase + m) * DMODEL, (size_t)NGW * DMODEL, gq, H2 + (size_t)m * DMODEL, (size_t)NGW * DMODEL, lane); }
                GRID_BAR();
                { OPQ; pg8::Gemm g{ACTP(bf16, A_H2), WSP(bf16, WS_WDGU), 1024, 1024, 1024}; pg8::SchedPlain S; S.init(NH / 256, 22, gridDim.x, (int)blockIdx.x);
                  pg8::EpiSwi E{ACTP(bf16, A_FA)};
                  pg8::gemm_phase<pg8::EpiSwi, pg8::SchedPlain, true, true>(L0 + RING_OFF, g, S, E, MYTID()); }
                GRID_BAR();
                { OPQ; pg8::Gemm g{ACTP(bf16, A_FA), WSP(bf16, WS_WDD), 2816, 2816, 2816}; pg8::SchedPlain S; S.init(NH / 256, 4, gridDim.x, (int)blockIdx.x);
                  pg8::EpiRes E{LDP(const float, 31), LDP(float, 31), tokbase};
                  pg8::gemm_phase<pg8::EpiRes, pg8::SchedPlain, true, true>(L0 + RING_OFF, g, S, E, MYTID()); }
                GRID_BAR();
            } else {
                {
                    TID_SETUP;
                    LAS float* rwT = (LAS float*)(L);
                    LAS unsigned* cntL = (LAS unsigned*)(L + 32768);
                    { const float* router_w = LDP(const float, 26); for (int idx = tid; idx < 8192; idx += NWAVES * 64) { const int k = idx >> 3, e = idx & 7; rwT[e * 1024 + k] = router_w[idx]; } }
                    if (tid < 8) cntL[tid] = 0u;
                    __syncthreads();
                    const float* xs = LDP(const float, 31); const float* gain = LDP(const float, 22) + DMODEL; bf16* H2 = ACTP(bf16, A_H2);
                    unsigned* RT_E = WSP(unsigned, WS_ROUTE + R_E); float* RT_W = WSP(float, WS_ROUTE + R_W);
                    f32x4 gq[4];
#pragma unroll
                    for (int j = 0; j < 4; ++j) gq[j] = ((const GAS f32x4*)gain + lane)[64 * j];
                    for (int i2 = 0; i2 < 16; i2 += 4) { f32x4 xv[4][4];
#pragma unroll
                      for (int u = 0; u < 4; ++u) { const GAS f32x4* xr = (const GAS f32x4*)(xs + (size_t)(tokbase + vcu * 128 + wave * 16 + i2 + u) * DMODEL) + lane;
#pragma unroll
                        for (int j = 0; j < 4; ++j) xv[u][j] = xr[64 * j]; }
#pragma unroll
                      for (int u = 0; u < 4; ++u) { const int row = vcu * 128 + wave * 16 + i2 + u;
                        f32x4 hn[4]; { float s2 = 0.f;
#pragma unroll
                            for (int j = 0; j < 4; ++j) s2 += (xv[u][j].x * xv[u][j].x + xv[u][j].y * xv[u][j].y) + (xv[u][j].z * xv[u][j].z + xv[u][j].w * xv[u][j].w);
                            const float rs = 1.0f / sqrtf(wave_sum(s2) * (1.0f / DMODEL) + EPS_NORM);
                            GAS unsigned long long* o8 = (GAS unsigned long long*)(H2 + (size_t)row * DMODEL) + lane;
#pragma unroll
                            for (int j = 0; j < 4; ++j) { hn[j] = xv[u][j] * rs * gq[j]; o8[64 * j] = (unsigned long long)pk2(hn[j].x, hn[j].y) | ((unsigned long long)pk2(hn[j].z, hn[j].w) << 32); } }
                        float lg[8];
#pragma unroll
                        for (int e = 0; e < 8; ++e) { float a = 0.f;
#pragma unroll
                            for (int j = 0; j < 4; ++j) { const f32x4 w = *(const LAS f32x4*)(rwT + e * 1024 + 4 * lane + 256 * j); a += (hn[j].x * w.x + hn[j].y * w.y) + (hn[j].z * w.z + hn[j].w * w.w); }
                            lg[e] = wave_sum(a); }
                        if (lane == 0) { int e1 = 0; float v1 = lg[0];
#pragma unroll
                            for (int e = 1; e < 8; ++e) if (lg[e] > v1) { v1 = lg[e]; e1 = e; }
                            int e2 = -1; float v2 = -INFINITY;
#pragma unroll
                            for (int e = 0; e < 8; ++e) if (e != e1 && lg[e] > v2) { v2 = lg[e]; e2 = e; }
                            if (e2 < 0) e2 = (e1 == 0) ? 1 : 0;
                            const float ex = expf(v2 - v1); const float w1 = 1.0f / (1.0f + ex), w2 = ex / (1.0f + ex);
                            RT_E[row] = (unsigned)e1 | ((unsigned)e2 << 8); RT_W[2 * row] = w1; RT_W[2 * row + 1] = w2;
                            __hip_atomic_fetch_add(cntL + e1, 1u, __ATOMIC_RELAXED, __HIP_MEMORY_SCOPE_WORKGROUP); __hip_atomic_fetch_add(cntL + e2, 1u, __ATOMIC_RELAXED, __HIP_MEMORY_SCOPE_WORKGROUP); }
                      }
                    }
                    __syncthreads();
                    if (tid < 8) WSP(unsigned, WS_ROUTE + R_CNT)[vcu * 8 + tid] = cntL[tid];
                }
                GRID_BAR();
                {
                    TID_SETUP;
                    volatile LAS unsigned* MISC = (volatile LAS unsigned*)(L + MISC_OFF);
                    LAS unsigned* tab = (LAS unsigned*)(L);
                    LAS unsigned* tot = (LAS unsigned*)(L + 8192);
                    LAS unsigned* off = (LAS unsigned*)(L + 8192 + 64);
                    LAS unsigned* wcn = (LAS unsigned*)(L + 8192 + 128);
                    LAS unsigned* slt = (LAS unsigned*)(L + 8192 + 512);
                    const unsigned* RT_CNT = WSP(const unsigned, WS_ROUTE + R_CNT); const unsigned* RT_E = WSP(const unsigned, WS_ROUTE + R_E); int* RT_S = WSP(int, WS_ROUTE + R_S);
                    const bf16* H2 = ACTP(const bf16, A_H2); bf16* H2G = ACTP(bf16, A_H2G);
                    if (tid < 256) { const GAS v4u* src = (const GAS v4u*)(RT_CNT + tid * 8); const v4u a = src[0], b = src[1];
                        tab[tid * 8 + 0] = a.x; tab[tid * 8 + 1] = a.y; tab[tid * 8 + 2] = a.z; tab[tid * 8 + 3] = a.w; tab[tid * 8 + 4] = b.x; tab[tid * 8 + 5] = b.y; tab[tid * 8 + 6] = b.z; tab[tid * 8 + 7] = b.w; }
                    __syncthreads();
                    if (tid < 8) { unsigned t = 0, o = 0; for (int blk = 0; blk < 256; ++blk) { const unsigned c = tab[blk * 8 + tid]; if (blk < vcu) o += c; t += c; } tot[tid] = t; off[tid] = o; }
                    __syncthreads();
                    if (tid == 0) { unsigned sp = 0; for (int e = 0; e < 8; ++e) { MISC[16 + e] = sp; sp += (tot[e] + 255u) >> 8; } MISC[24] = sp; }
                    __syncthreads();
                    int my_e = 0, my_rank = 0;
                    if (tid < 256) { const int row = vcu * 128 + (tid >> 1); const unsigned ee = RT_E[row]; my_e = (tid & 1) ? (int)((ee >> 8) & 255u) : (int)(ee & 255u);
#pragma unroll
                        for (int e = 0; e < 8; ++e) { const unsigned long long mask = __ballot(my_e == e); if (my_e == e) my_rank = __popcll(mask & ((1ull << lane) - 1ull)); if (lane == 0) wcn[wave * 8 + e] = (unsigned)__popcll(mask); } }
                    __syncthreads();
                    if (tid < 256) { unsigned pre = 0; for (int w = 0; w < wave; ++w) pre += wcn[w * 8 + my_e];
                        const unsigned slot = MISC[16 + my_e] * 256u + off[my_e] + pre + (unsigned)my_rank;
                        RT_S[(vcu * 128 + (tid >> 1)) * 2 + (tid & 1)] = (int)slot; slt[tid] = slot; }
                    __syncthreads();
                    for (int i = 0; i < 32; i += 4) { v4u a[4], b[4];
#pragma unroll
                        for (int u = 0; u < 4; ++u) { const int id = wave * 32 + i + u; const GAS v4u* src = (const GAS v4u*)(H2 + (size_t)(vcu * 128 + (id >> 1)) * DMODEL) + lane * 2; a[u] = src[0]; b[u] = src[1]; }
#pragma unroll
                        for (int u = 0; u < 4; ++u) { const unsigned slot = slt[wave * 32 + i + u]; GAS v4u* dst = (GAS v4u*)(H2G + (size_t)slot * DMODEL) + lane * 2; dst[0] = a[u]; dst[1] = b[u]; } }
                    if (vcu < 8) { const unsigned e = (unsigned)vcu; const unsigned r0 = MISC[16 + e] * 256u + tot[e], r1 = MISC[17 + e] * 256u; const v4u z = {0u, 0u, 0u, 0u};
                        for (unsigned r = r0 + (unsigned)wave; r < r1; r += NWAVES) { GAS v4u* dst = (GAS v4u*)(H2G + (size_t)r * DMODEL) + lane * 2; dst[0] = z; dst[1] = z; } }
                }
                GRID_BAR();
#define MOE_SCHED(S, NN) do { volatile LAS unsigned* MISC = (volatile LAS unsigned*)(L + MISC_OFF); S.nn = (NN); \
        S.sp1 = __builtin_amdgcn_readfirstlane((int)MISC[17]); S.sp2 = __builtin_amdgcn_readfirstlane((int)MISC[18]); S.sp3 = __builtin_amdgcn_readfirstlane((int)MISC[19]); S.sp4 = __builtin_amdgcn_readfirstlane((int)MISC[20]); \
        S.sp5 = __builtin_amdgcn_readfirstlane((int)MISC[21]); S.sp6 = __builtin_amdgcn_readfirstlane((int)MISC[22]); S.sp7 = __builtin_amdgcn_readfirstlane((int)MISC[23]); \
        S.so.init(__builtin_amdgcn_readfirstlane((int)MISC[24]), (NN), gridDim.x, (int)blockIdx.x); } while (0)
                { OPQ; pg8::SchedMoe S; MOE_SCHED(S, 22);
                  pg8::Gemm g{ACTP(bf16, A_H2G), WSP(bf16, WS_WMGU), 1024, 1024, 1024}; pg8::EpiSwi E{ACTP(bf16, A_AG)};
                  pg8::gemm_phase<pg8::EpiSwi, pg8::SchedMoe, true, true>(L0 + RING_OFF, g, S, E, MYTID()); }
                GRID_BAR();
                { OPQ; pg8::SchedMoe S; MOE_SCHED(S, 4);
                  pg8::Gemm g{ACTP(bf16, A_AG), WSP(bf16, WS_WMD), 2816, 2816, 2816}; pg8::EpiBf E{ACTP(bf16, A_YG)};
                  pg8::gemm_phase<pg8::EpiBf, pg8::SchedMoe, true, true>(L0 + RING_OFF, g, S, E, MYTID()); }
                GRID_BAR();
                {
                    TID_SETUP;
                    const int* RT_S = WSP(const int, WS_ROUTE + R_S); const float* RT_W = WSP(const float, WS_ROUTE + R_W); float* xo = LDP(float, 31); const bf16* YG = ACTP(const bf16, A_YG);
                    const GAS f32x4* gr = (const GAS f32x4*)LDP(const float, 30) + lane;
                    f32x4 gq[4];
#pragma unroll
                    for (int j = 0; j < 4; ++j) gq[j] = gr[64 * j];
                    for (int m = gw; m < NH; m += 4 * NGW) {
                        int s1[4], s2[4]; float w1[4], w2[4];
#pragma unroll
                        for (int r = 0; r < 4; ++r) { const int mm = m + r * NGW; s1[r] = RT_S[2 * mm]; s2[r] = RT_S[2 * mm + 1]; w1[r] = RT_W[2 * mm]; w2[r] = RT_W[2 * mm + 1]; }
                        f32x4 xa[4][4]; unsigned long long ya[4][4], yb[4][4];
#pragma unroll
                        for (int r = 0; r < 4; ++r) { const GAS f32x4* xr = (const GAS f32x4*)(xo + (size_t)(tokbase + m + r * NGW) * DMODEL) + lane;
                            const GAS unsigned long long* y1 = (const GAS unsigned long long*)(YG + (size_t)s1[r] * DMODEL) + lane; const GAS unsigned long long* y2 = (const GAS unsigned long long*)(YG + (size_t)s2[r] * DMODEL) + lane;
#pragma unroll
                            for (int j = 0; j < 4; ++j) { xa[r][j] = xr[64 * j]; ya[r][j] = y1[64 * j]; yb[r][j] = y2[64 * j]; } }
#pragma unroll
                        for (int r = 0; r < 4; ++r) { float sq = 0.f;
#pragma unroll
                            for (int j = 0; j < 4; ++j) { const unsigned long long a = ya[r][j], b = yb[r][j]; f32x4 x4 = xa[r][j];
                                const unsigned alo = (unsigned)a, ahi = (unsigned)(a >> 32), blo = (unsigned)b, bhi = (unsigned)(b >> 32);
                                x4.x += w1[r] * __uint_as_float(alo << 16) + w2[r] * __uint_as_float(blo << 16); x4.y += w1[r] * __uint_as_float(alo & 0xffff0000u) + w2[r] * __uint_as_float(blo & 0xffff0000u);
                                x4.z += w1[r] * __uint_as_float(ahi << 16) + w2[r] * __uint_as_float(bhi << 16); x4.w += w1[r] * __uint_as_float(ahi & 0xffff0000u) + w2[r] * __uint_as_float(bhi & 0xffff0000u);
                                xa[r][j] = x4; sq += (x4.x * x4.x + x4.y * x4.y) + (x4.z * x4.z + x4.w * x4.w); }
                            const float rs = 1.0f / sqrtf(wave_sum(sq) * (1.0f / DMODEL) + EPS_NORM);
                            GAS f32x4* xw = (GAS f32x4*)(xo + (size_t)(tokbase + m + r * NGW) * DMODEL) + lane;
#pragma unroll
                            for (int j = 0; j < 4; ++j) xw[64 * j] = xa[r][j] * rs * gq[j]; }
                    }
                }
                GRID_BAR();
            }
        }
    }
#undef GRID_BAR
#undef TID_SETUP
#undef LQ
#undef MYTID
#undef OPQ
#undef WSP
#undef ACTP
#undef MOE_SCHED
}

extern "C" void kernel_launch(void* const* d_in, const int* in_sizes, int n_in, void* d_out, int out_size, void* d_ws, size_t ws_size, hipStream_t stream) {
    static int grid = 0;
    if (grid == 0) {
        if (n_in != 31 || in_sizes[0] != NTOK * DMODEL || out_size != NTOK * DMODEL || ws_size < WS_END) {
            fprintf(stderr, "kernel_launch: unexpected shapes: n_in %d in0 %d out %d ws %zu (need %zu); nothing launched\n", n_in, n_in > 0 ? in_sizes[0] : -1, out_size, ws_size, (size_t)WS_END); grid = -1; return; }
        int dev = 0, cus = 0, per_cu = 0;
        if (hipGetDevice(&dev) != hipSuccess || hipDeviceGetAttribute(&cus, hipDeviceAttributeMultiprocessorCount, dev) != hipSuccess) { grid = -1; return; }
        if (hipFuncSetAttribute((const void*)trunk_fwd, hipFuncAttributeMaxDynamicSharedMemorySize, LDS_BYTES) != hipSuccess) { fprintf(stderr, "kernel_launch: hipFuncSetAttribute failed\n"); grid = -1; return; }
        if (hipOccupancyMaxActiveBlocksPerMultiprocessor(&per_cu, (const void*)trunk_fwd, NWAVES * 64, LDS_BYTES) != hipSuccess || per_cu < 1)
            fprintf(stderr, "kernel_launch: note: occupancy query reports %d workgroups per CU\n", per_cu);
        (void)hipGetLastError();
        grid = 256;
        if (cus < 256) { fprintf(stderr, "kernel_launch: device has %d CUs, need 256; nothing launched\n", cus); grid = -1; return; }
    }
    if (grid < 0) return;
    if (hipMemsetAsync((char*)d_ws + WS_CTL, 0, CTL_ZERO_BYTES, stream) != hipSuccess) return;
    Args a{};
    for (int i = 0; i < 31; ++i) a.in[i] = d_in[i];
    a.out = (float*)d_out; a.ws = (unsigned char*)d_ws;
    hipLaunchKernelGGL(trunk_fwd, dim3(grid), dim3(NWAVES * 64), LDS_BYTES, stream, a);
}
```

```cpp
#include <hip/hip_runtime.h>
#include <hip/hip_bf16.h>
#include <cstdio>
#include <cstdint>
#include <cmath>
namespace pg8 {
#define PG8_LAS __attribute__((address_space(3)))
typedef unsigned short bf16_t;
typedef short bf16x8 __attribute__((ext_vector_type(8)));
typedef float f32x4 __attribute__((ext_vector_type(4)));
typedef unsigned u32x4 __attribute__((ext_vector_type(4)));
constexpr int BM = 256, BK = 64, HALF = 128, HTB = HALF * BK * 2  , STAGE_BYTES = 8 * HTB, NXCD = 8, WGM = 8;

__host__ __device__ __forceinline__ int lds_byte(int r, int c) { const int st = (r >> 4) * 2 + (c >> 5), rr = r & 15, cc = c & 31, ob = rr * 64 + cc * 2; return st * 1024 + (ob ^ (((ob >> 9) & 1) << 5)); }
__host__ __device__ __forceinline__ void stage_rc(int b, int& R, int& C) { const int st = b / 1024, sb = b % 1024, swz = sb ^ (((sb >> 9) & 1) << 5); R = (st >> 1) * 16 + swz / 64; C = (st & 1) * 32 + (swz % 64) / 2; }
__host__ __device__ __forceinline__ int perm32(int rho) { const int n = rho >> 4, i = rho & 15; return 8 * (i >> 2) + 4 * n + (i & 3); }

struct Unit { int pm, pn; };
struct Gemm { const bf16_t* A; const bf16_t* Bt; int lda, ldb, K; };

struct StaticOrder {
    int nM, nN, nwg, G, c;
    __host__ __device__ void init(int nM_, int nN_, int G_, int c_) { nM = nM_; nN = nN_; nwg = nM * nN; G = G_; c = c_; }
    __host__ __device__ bool next(int i, Unit& u) const {
        const long L = (long)i * G + c; if (L >= nwg) return false;
        int wgid = (int)L; { const int q = nwg / NXCD, r = nwg % NXCD, xcd = wgid % NXCD, off = wgid / NXCD; wgid = (xcd < r ? xcd * (q + 1) : r * (q + 1) + (xcd - r) * q) + off; }
        const int nig = WGM * nN, gid = wgid / nig, fm = gid * WGM, gsz = (nM - fm) < WGM ? (nM - fm) : WGM;
        u.pm = fm + ((wgid % nig) % gsz); u.pn = (wgid % nig) / gsz; return true;
    }
    __device__ __forceinline__ void a_ready(const Unit&) const {}
    __device__ __forceinline__ void done(const Unit&) const {}
};


struct SchedPlain {
    StaticOrder so;
    __device__ __forceinline__ void init(int nM, int nN, int G, int c) { so.init(nM, nN, G, c); }
    __device__ __forceinline__ bool next(int i, Unit& u) const { return so.next(i, u); }
    __device__ __forceinline__ void a_ready(const Unit&) const {}
    __device__ __forceinline__ void done(const Unit&) const {}
};
struct SchedS5 {
    StaticOrder so; int nng;
    __device__ __forceinline__ void init(int nng_, int G, int c) { nng = nng_; so.init(128, nng_, G, c); }
    __device__ __forceinline__ bool next(int i, Unit& u) const { if (!so.next(i, u)) return false; u.pn = (u.pm >> 2) * nng + u.pn; return true; }
    __device__ __forceinline__ void a_ready(const Unit&) const {}
    __device__ __forceinline__ void done(const Unit&) const {}
};
struct SchedMoe {
    StaticOrder so; int nn; int sp1, sp2, sp3, sp4, sp5, sp6, sp7;
    __device__ __forceinline__ bool next(int i, Unit& u) const {
        if (!so.next(i, u)) return false;
        const int pm = u.pm; const int e = (pm >= sp1) + (pm >= sp2) + (pm >= sp3) + (pm >= sp4) + (pm >= sp5) + (pm >= sp6) + (pm >= sp7);
        u.pn = e * nn + u.pn; return true;
    }
    __device__ __forceinline__ void a_ready(const Unit&) const {}
    __device__ __forceinline__ void done(const Unit&) const {}
};

typedef float f32x2c_t __attribute__((ext_vector_type(2))); typedef __bf16 bf16x2c_t __attribute__((ext_vector_type(2)));
__device__ __forceinline__ unsigned cvt_pk_bf16(float lo, float hi) { f32x2c_t v = {lo, hi}; bf16x2c_t b = __builtin_convertvector(v, bf16x2c_t); return __builtin_bit_cast(unsigned, b); }
__device__ __forceinline__ u32x4 pack8(const f32x4 a, const f32x4 b) { u32x4 w; w.x = cvt_pk_bf16(a[0], a[1]); w.y = cvt_pk_bf16(a[2], a[3]); w.z = cvt_pk_bf16(b[0], b[1]); w.w = cvt_pk_bf16(b[2], b[3]); return w; }
__device__ __forceinline__ void unpack8(const u32x4 w, f32x4& a, f32x4& b) {
    a[0] = __uint_as_float(w.x << 16); a[1] = __uint_as_float(w.x & 0xffff0000u); a[2] = __uint_as_float(w.y << 16); a[3] = __uint_as_float(w.y & 0xffff0000u);
    b[0] = __uint_as_float(w.z << 16); b[1] = __uint_as_float(w.z & 0xffff0000u); b[2] = __uint_as_float(w.w << 16); b[3] = __uint_as_float(w.w & 0xffff0000u); }
__device__ __forceinline__ float sigm(float z) { return __builtin_amdgcn_rcpf(1.0f + __builtin_amdgcn_exp2f(-1.4426950408889634f * z)); }
__device__ __forceinline__ f32x4 sigm4(const f32x4 z) { f32x4 r; r[0] = sigm(z[0]); r[1] = sigm(z[1]); r[2] = sigm(z[2]); r[3] = sigm(z[3]); return r; }
__device__ __forceinline__ float gelu_t(float x) { const float u = 1.5957691216057308f * (x + 0.044715f * x * x * x); return x * sigm(u); }
__device__ __forceinline__ f32x4 gelu4(const f32x4 z) { f32x4 r; r[0] = gelu_t(z[0]); r[1] = gelu_t(z[1]); r[2] = gelu_t(z[2]); r[3] = gelu_t(z[3]); return r; }
constexpr size_t EA_U = (size_t)64 << 20, EA_Q = (size_t)120 << 20, EA_K = (size_t)184 << 20, EA_V = (size_t)248 << 20, EA_SGS = (size_t)312 << 20, EA_SGA = (size_t)376 << 20;
constexpr float QSCALE = 0.125f * 1.4426950408889634f;

struct EpiIn {
    static constexpr bool PERM = true, AFTER_DRAIN = false;
    unsigned char* act; const float* rope; int tokbase;
    __device__ __forceinline__ void operator()(const f32x4 (&acc)[2][2][4][2], const Unit& u, int wr, int wc, int fr_in, int fq_in) const {
        int fr = fr_in, fq = fq_in; asm volatile("" : "+v"(fr), "+v"(fq));
        const int pn = u.pn, rowb = u.pm * BM + wr * 64 + fr, cow = wc * 32 + fq * 8;
        if (pn < 2) {
#pragma unroll
            for (int ai = 0; ai < 2; ++ai)
#pragma unroll
                for (int m = 0; m < 4; ++m) { const int row = rowb + ai * HALF + m * 16;
#pragma unroll
                    for (int bj = 0; bj < 2; ++bj) { const int c = pn * 256 + bj * HALF + cow; const int g = c >> 4, jj = c & 15;
                        bf16_t* dst = (bf16_t*)(act + EA_U) + ((size_t)(g * 1024 + (row >> 5)) * 640 + (row & 31) * 16 + jj);
                        *(u32x4*)dst = pack8(acc[ai][bj][m][0], acc[ai][bj][m][1]); } }
        } else if (pn < 10) {
            const bool isq = pn < 6; bf16_t* base = (bf16_t*)(act + (isq ? EA_Q : EA_K)); const int colt = (isq ? pn - 2 : pn - 6) * 256; const float sc = isq ? QSCALE : 1.0f;
            const int dlo = 16 * (wc & 1) + 4 * fq;
#pragma unroll
            for (int ai = 0; ai < 2; ++ai)
#pragma unroll
                for (int m = 0; m < 4; ++m) { const int row = rowb + ai * HALF + m * 16;
                    const float* tr = rope + (size_t)(tokbase + row) * 64 + dlo; const f32x4 cs = *(const f32x4*)tr, sn = *(const f32x4*)(tr + 32);
#pragma unroll
                    for (int bj = 0; bj < 2; ++bj) { const f32x4 v0 = acc[ai][bj][m][0], v1 = acc[ai][bj][m][1];
                        const f32x4 o0 = (v0 * cs - v1 * sn) * sc, o1 = (v1 * cs + v0 * sn) * sc;
                        *(u32x4*)(base + (size_t)row * 1024 + colt + bj * HALF + cow) = pack8(o0, o1); } }
        } else if (pn < 14) {
            const int colt = (pn - 10) * 256;
#pragma unroll
            for (int ai = 0; ai < 2; ++ai)
#pragma unroll
                for (int m = 0; m < 4; ++m) { const int row = rowb + ai * HALF + m * 16;
#pragma unroll
                    for (int bj = 0; bj < 2; ++bj) *(u32x4*)((bf16_t*)(act + EA_V) + (size_t)row * 1024 + colt + bj * HALF + cow) = pack8(acc[ai][bj][m][0], acc[ai][bj][m][1]); }
        } else {
            bf16_t* base = (bf16_t*)(act + (pn < 18 ? EA_SGS : EA_SGA)); const int colt = (pn < 18 ? pn - 14 : pn - 18) * 256;
#pragma unroll
            for (int ai = 0; ai < 2; ++ai)
#pragma unroll
                for (int m = 0; m < 4; ++m) { const int row = rowb + ai * HALF + m * 16;
#pragma unroll
                    for (int bj = 0; bj < 2; ++bj) *(u32x4*)(base + (size_t)row * 1024 + colt + bj * HALF + cow) = pack8(sigm4(acc[ai][bj][m][0]), sigm4(acc[ai][bj][m][1])); }
        }
    }
};
struct EpiSloc {
    static constexpr bool PERM = false, AFTER_DRAIN = false;
    float* S;
    __device__ __forceinline__ void operator()(const f32x4 (&acc)[2][2][4][2], const Unit& u, int wr, int wc, int fr_in, int fq_in) const {
        int fr = fr_in, fq = fq_in; asm volatile("" : "+v"(fr), "+v"(fq));
        const int rowb = u.pm * BM + wr * 64 + fr, col0 = wc * 32 + 4 * fq;
#pragma unroll
        for (int ai = 0; ai < 2; ++ai)
#pragma unroll
            for (int m = 0; m < 4; ++m) { float* rowp = S + (size_t)(rowb + ai * HALF + m * 16) * 128 + col0;
#pragma unroll
                for (int n = 0; n < 2; ++n) *(f32x4*)(rowp + n * 16) = acc[ai][0][m][n]; }
    }
};
struct EpiYa {
    static constexpr bool PERM = true, AFTER_DRAIN = false;
    bf16_t* YA;
    __device__ __forceinline__ void operator()(const f32x4 (&acc)[2][2][4][2], const Unit& u, int wr, int wc, int fr_in, int fq_in) const {
        int fr = fr_in, fq = fq_in; asm volatile("" : "+v"(fr), "+v"(fq));
        const int g = u.pm >> 2, pni = u.pn & 1; const int rowb = (u.pm & 3) * BM + wr * 64 + fr; const int jj = 8 * (fq & 1);
#pragma unroll
        for (int ai = 0; ai < 2; ++ai)
#pragma unroll
            for (int m = 0; m < 4; ++m) { const int R = rowb + ai * HALF + m * 16;
#pragma unroll
                for (int bj = 0; bj < 2; ++bj) { const int t = pni * 16 + bj * 8 + wc * 2 + (fq >> 1);
                    *(u32x4*)(YA + (size_t)(R * 32 + t) * 512 + g * 16 + jj) = pack8(gelu4(acc[ai][bj][m][0]), gelu4(acc[ai][bj][m][1])); } }
    }
};
struct EpiGlu {
    static constexpr bool PERM = true, AFTER_DRAIN = false;
    const bf16_t* YA; bf16_t* O; const float* bias;
    __device__ __forceinline__ void operator()(const f32x4 (&acc)[2][2][4][2], const Unit& u, int wr, int wc, int fr_in, int fq_in) const {
        int fr = fr_in, fq = fq_in; asm volatile("" : "+v"(fr), "+v"(fq));
        const int rowb = u.pm * BM + wr * 64 + fr, col0 = u.pn * BM + wc * 32 + 8 * fq;
        f32x4 bv[2][2];
#pragma unroll
        for (int bj = 0; bj < 2; ++bj)
#pragma unroll
            for (int n = 0; n < 2; ++n) bv[bj][n] = *(const f32x4*)(bias + col0 + bj * HALF + 4 * n);
#pragma unroll
        for (int ai = 0; ai < 2; ++ai)
#pragma unroll
            for (int m = 0; m < 4; ++m) { const size_t off = (size_t)(rowb + ai * HALF + m * 16) * 512 + col0;
#pragma unroll
                for (int bj = 0; bj < 2; ++bj) { f32x4 y0, y1; unpack8(*(const u32x4*)(YA + off + bj * HALF), y0, y1);
                    *(u32x4*)(O + off + bj * HALF) = pack8(y0 * sigm4(acc[ai][bj][m][0] + bv[bj][0]), y1 * sigm4(acc[ai][bj][m][1] + bv[bj][1])); } }
    }
};
template <int MODE> struct EpiGate {
    static constexpr bool PERM = true, AFTER_DRAIN = false;
    bf16_t* G; const bf16_t* T0;
    __device__ __forceinline__ void operator()(const f32x4 (&acc)[2][2][4][2], const Unit& u, int wr, int wc, int fr_in, int fq_in) const {
        int fr = fr_in, fq = fq_in; asm volatile("" : "+v"(fr), "+v"(fq));
        const int rowb = u.pm * BM + wr * 64 + fr, col0 = u.pn * BM + wc * 32 + 8 * fq;
#pragma unroll
        for (int ai = 0; ai < 2; ++ai)
#pragma unroll
            for (int m = 0; m < 4; ++m) { const size_t off = (size_t)(rowb + ai * HALF + m * 16) * 1024 + col0;
#pragma unroll
                for (int bj = 0; bj < 2; ++bj) { f32x4 g0, g1; unpack8(*(const u32x4*)(G + off + bj * HALF), g0, g1);
                    f32x4 o0 = g0 * acc[ai][bj][m][0], o1 = g1 * acc[ai][bj][m][1];
                    if (MODE == 1) { f32x4 t0, t1; unpack8(*(const u32x4*)(T0 + off + bj * HALF), t0, t1); o0 += t0; o1 += t1; }
                    *(u32x4*)(G + off + bj * HALF) = pack8(o0, o1); } }
    }
};
struct EpiRes {
    static constexpr bool PERM = true, AFTER_DRAIN = false;
    const float* xin32; bf16_t* xb; int tokbase;
    __device__ __forceinline__ void operator()(const f32x4 (&acc)[2][2][4][2], const Unit& u, int wr, int wc, int fr_in, int fq_in) const {
        int fr = fr_in, fq = fq_in; asm volatile("" : "+v"(fr), "+v"(fq));
        const int rowb = tokbase + u.pm * BM + wr * 64 + fr, col0 = u.pn * BM + wc * 32 + 8 * fq;
        const bool f32in = xin32 != nullptr;
#pragma unroll
        for (int ai = 0; ai < 2; ++ai)
#pragma unroll
            for (int m = 0; m < 4; ++m) { const size_t off = (size_t)(rowb + ai * HALF + m * 16) * 1024 + col0;
#pragma unroll
                for (int bj = 0; bj < 2; ++bj) { f32x4 x0, x1;
                    if (f32in) { x0 = *(const f32x4*)(xin32 + off + bj * HALF); x1 = *(const f32x4*)(xin32 + off + bj * HALF + 4); }
                    else unpack8(*(const u32x4*)(xb + off + bj * HALF), x0, x1);
                    *(u32x4*)(xb + off + bj * HALF) = pack8(x0 + acc[ai][bj][m][0], x1 + acc[ai][bj][m][1]); } }
    }
};
struct EpiSwi {
    static constexpr bool PERM = true, AFTER_DRAIN = false;
    bf16_t* O;
    __device__ __forceinline__ void operator()(const f32x4 (&acc)[2][2][4][2], const Unit& u, int wr, int wc, int fr_in, int fq_in) const {
        int fr = fr_in, fq = fq_in; asm volatile("" : "+v"(fr), "+v"(fq));
        const int rowb = u.pm * BM + wr * 64 + fr, col0 = (u.pn % 22) * HALF + wc * 32 + 8 * fq;
#pragma unroll
        for (int ai = 0; ai < 2; ++ai)
#pragma unroll
            for (int m = 0; m < 4; ++m) { const f32x4 g0 = acc[ai][0][m][0], g1 = acc[ai][0][m][1];
                *(u32x4*)(O + (size_t)(rowb + ai * HALF + m * 16) * 2816 + col0) = pack8(g0 * sigm4(g0) * acc[ai][1][m][0], g1 * sigm4(g1) * acc[ai][1][m][1]); }
    }
};
struct EpiBf {
    static constexpr bool PERM = true, AFTER_DRAIN = false;
    bf16_t* O;
    __device__ __forceinline__ void operator()(const f32x4 (&acc)[2][2][4][2], const Unit& u, int wr, int wc, int fr_in, int fq_in) const {
        int fr = fr_in, fq = fq_in; asm volatile("" : "+v"(fr), "+v"(fq));
        const int rowb = u.pm * BM + wr * 64 + fr, col0 = (u.pn & 3) * BM + wc * 32 + 8 * fq;
#pragma unroll
        for (int ai = 0; ai < 2; ++ai)
#pragma unroll
            for (int m = 0; m < 4; ++m)
#pragma unroll
                for (int bj = 0; bj < 2; ++bj) *(u32x4*)(O + (size_t)(rowb + ai * HALF + m * 16) * 1024 + col0 + bj * HALF) = pack8(acc[ai][bj][m][0], acc[ai][bj][m][1]);
    }
};

template <class Epi, class Sched, bool ALIGN_EPI = false, bool SP2 = false>
__device__ __forceinline__ void gemm_phase(PG8_LAS unsigned char* lds, const Gemm g, const Sched& S, const Epi& E, const int tid_in) {
    const int tid = tid_in, wid = __builtin_amdgcn_readfirstlane(tid >> 6), lane = tid & 63, wr = wid >> 2, wc = wid & 3, fr = lane & 15, fq = lane >> 4;
    const int K = g.K, nt = K / BK;
    unsigned voffA[2], voffB[2];
#pragma unroll
    for (int i = 0; i < 2; ++i) { int R, C; stage_rc(tid * 16 + i * 8192, R, C); const int Rb = Epi::PERM ? ((R & ~31) + perm32(R & 31)) : R;
        voffA[i] = (unsigned)(R * g.lda + C) * 2u; voffB[i] = (unsigned)(Rb * g.ldb + C) * 2u; }
    const size_t kstep = (size_t)(BK * 2);
    const size_t hstepA = (size_t)HALF * g.lda * 2, hstepB = (size_t)HALF * g.ldb * 2;
    const size_t tstepA = 2 * hstepA, tstepB = 2 * hstepB;
    const unsigned ldsw = (unsigned)wid * 1024u;
    const int aoff = lds_byte(wr * 64 + fr, fq * 8), boff = lds_byte(wc * 32 + fr, fq * 8);
#define PG8_SA(b, h) (((b) * 2 + (h)) * HTB)
#define PG8_SB(b, h) ((4 + (b) * 2 + (h)) * HTB)
#define PG8_STAGE(bufoff, gbase, voff) do { _Pragma("unroll") for (int _i = 0; _i < 2; ++_i) \
        __builtin_amdgcn_global_load_lds((const unsigned*)((const char*)(gbase) + (voff)[_i]), (PG8_LAS unsigned*)(lds + (bufoff) + ldsw + _i * 8192), 16, 0, 0); } while (0)
#define PG8_LDA(dst, b, h) do { _Pragma("unroll") for (int m = 0; m < 4; ++m) _Pragma("unroll") for (int k = 0; k < 2; ++k) dst[m][k] = *(const PG8_LAS bf16x8*)(lds + PG8_SA(b, h) + aoff + m * 2048 + k * 1024); } while (0)
#define PG8_LDB(dst, b, h) do { _Pragma("unroll") for (int n = 0; n < 2; ++n) _Pragma("unroll") for (int k = 0; k < 2; ++k) dst[n][k] = *(const PG8_LAS bf16x8*)(lds + PG8_SB(b, h) + boff + n * 2048 + k * 1024); } while (0)
#define PG8_MMA(ai, bj, At, Bt) do { __builtin_amdgcn_s_setprio(1); _Pragma("unroll") for (int m = 0; m < 4; ++m) _Pragma("unroll") for (int n = 0; n < 2; ++n) _Pragma("unroll") for (int k = 0; k < 2; ++k) \
        acc[ai][bj][m][n] = __builtin_amdgcn_mfma_f32_16x16x32_bf16(Bt[n][k], At[m][k], acc[ai][bj][m][n], 0, 0, 0); __builtin_amdgcn_s_setprio(0); } while (0)
#define PG8_WAIT_V(n) asm volatile("s_waitcnt vmcnt(" #n ")" ::: "memory")
#define PG8_WAIT_L(n) asm volatile("s_waitcnt lgkmcnt(" #n ")" ::: "memory")
#define PG8_BAR __builtin_amdgcn_s_barrier()
#define PG8_SCHED __builtin_amdgcn_sched_barrier(0)
    Unit cur, nxt; int ui = 0;
    if (!S.next(0, cur)) return;
    f32x4 acc[2][2][4][2];
#pragma unroll
    for (int a = 0; a < 2; ++a)
#pragma unroll
        for (int b = 0; b < 2; ++b)
#pragma unroll
            for (int m = 0; m < 4; ++m)
#pragma unroll
                for (int n = 0; n < 2; ++n) acc[a][b][m][n] = (f32x4){0.f, 0.f, 0.f, 0.f};
    bf16x8 At[4][2], B0[2][2], B1[2][2];
    const char* cA = (const char*)g.A + (size_t)cur.pm * tstepA; const char* cB = (const char*)g.Bt + (size_t)cur.pn * tstepB;
    S.a_ready(cur);
    if constexpr (SP2) {
        PG8_STAGE(PG8_SB(0, 0), cB, voffB); PG8_STAGE(PG8_SB(0, 1), cB + hstepB, voffB); PG8_STAGE(PG8_SA(0, 0), cA, voffA); PG8_STAGE(PG8_SA(0, 1), cA + hstepA, voffA);
        if (wr == 1) PG8_BAR;
        PG8_WAIT_V(2); PG8_BAR;
        PG8_STAGE(PG8_SB(1, 0), cB + kstep, voffB); PG8_STAGE(PG8_SA(1, 0), cA + kstep, voffA); PG8_STAGE(PG8_SB(1, 1), cB + hstepB + kstep, voffB);
        PG8_WAIT_V(6); PG8_BAR;
    } else {
        PG8_STAGE(PG8_SB(0, 0), cB, voffB); PG8_STAGE(PG8_SA(0, 0), cA, voffA); PG8_STAGE(PG8_SB(0, 1), cB + hstepB, voffB); PG8_STAGE(PG8_SA(0, 1), cA + hstepA, voffA);
        if (wr == 1) PG8_BAR;
        PG8_WAIT_V(4); PG8_BAR;
        PG8_STAGE(PG8_SB(1, 0), cB + kstep, voffB); PG8_STAGE(PG8_SA(1, 0), cA + kstep, voffA); PG8_STAGE(PG8_SB(1, 1), cB + hstepB + kstep, voffB);
        PG8_WAIT_V(6); PG8_BAR;
    }
    for (;;) {
        const bool has_next = S.next(ui + 1, nxt);
        const char* nA = has_next ? (const char*)g.A + (size_t)nxt.pm * tstepA : cA; const char* nB = has_next ? (const char*)g.Bt + (size_t)nxt.pn * tstepB : cB;
        for (int t = 0; t < nt; t += 2) {
            const bool last = (t == nt - 2);
            const char* a1 = cA + (size_t)(t + 1) * kstep;
            const char* a2 = last ? nA : cA + (size_t)(t + 2) * kstep; const char* b2 = last ? nB : cB + (size_t)(t + 2) * kstep;
            const char* a3 = a2 + kstep; const char* b3 = b2 + kstep;
            if (last && has_next) S.a_ready(nxt);
            if constexpr (SP2) {
            PG8_LDB(B0, 0, 0); PG8_LDB(B1, 0, 1); PG8_SCHED; PG8_LDA(At, 0, 0); PG8_STAGE(PG8_SA(1, 1), a1 + hstepA, voffA);
            PG8_WAIT_V(8); PG8_WAIT_L(0); PG8_BAR; PG8_MMA(0, 0, At, B0); PG8_MMA(0, 1, At, B1); PG8_BAR; PG8_SCHED;
            PG8_LDA(At, 0, 1); PG8_STAGE(PG8_SB(0, 0), b2, voffB); PG8_STAGE(PG8_SB(0, 1), b2 + hstepB, voffB); PG8_STAGE(PG8_SA(0, 0), a2, voffA);
            PG8_WAIT_V(8); PG8_WAIT_L(0); PG8_BAR; PG8_MMA(1, 0, At, B0); PG8_MMA(1, 1, At, B1); PG8_BAR; PG8_SCHED;
            PG8_LDB(B0, 1, 0); PG8_LDB(B1, 1, 1); PG8_SCHED; PG8_LDA(At, 1, 0); PG8_STAGE(PG8_SA(0, 1), a2 + hstepA, voffA);
            PG8_WAIT_V(8); PG8_WAIT_L(0); PG8_BAR; PG8_MMA(0, 0, At, B0); PG8_MMA(0, 1, At, B1); PG8_BAR; PG8_SCHED;
            PG8_LDA(At, 1, 1); PG8_STAGE(PG8_SB(1, 0), b3, voffB); PG8_STAGE(PG8_SB(1, 1), b3 + hstepB, voffB); PG8_STAGE(PG8_SA(1, 0), a3, voffA);
            PG8_WAIT_V(8); PG8_WAIT_L(0); PG8_BAR; PG8_MMA(1, 0, At, B0); PG8_MMA(1, 1, At, B1); PG8_BAR; PG8_SCHED;
            } else {
            PG8_LDB(B0, 0, 0); PG8_SCHED; PG8_LDA(At, 0, 0); PG8_STAGE(PG8_SA(1, 1), a1 + hstepA, voffA);
            PG8_WAIT_L(8); PG8_BAR; PG8_WAIT_L(0); PG8_MMA(0, 0, At, B0); PG8_BAR; PG8_SCHED;
            PG8_LDB(B1, 0, 1); PG8_STAGE(PG8_SB(0, 0), b2, voffB);
            PG8_BAR; PG8_WAIT_L(0); PG8_MMA(0, 1, At, B1); PG8_BAR;
            PG8_LDA(At, 0, 1); PG8_STAGE(PG8_SA(0, 0), a2, voffA);
            PG8_BAR; PG8_WAIT_L(0); PG8_MMA(1, 0, At, B0); PG8_BAR; PG8_SCHED;
            PG8_STAGE(PG8_SB(0, 1), b2 + hstepB, voffB);
            PG8_WAIT_V(6); PG8_BAR; PG8_MMA(1, 1, At, B1); PG8_BAR;
            PG8_LDB(B0, 1, 0); PG8_SCHED; PG8_LDA(At, 1, 0); PG8_STAGE(PG8_SA(0, 1), a2 + hstepA, voffA);
            PG8_WAIT_L(8); PG8_BAR; PG8_WAIT_L(0); PG8_MMA(0, 0, At, B0); PG8_BAR; PG8_SCHED;
            PG8_LDB(B1, 1, 1); PG8_STAGE(PG8_SB(1, 0), b3, voffB);
            PG8_BAR; PG8_WAIT_L(0); PG8_MMA(0, 1, At, B1); PG8_BAR;
            PG8_LDA(At, 1, 1); PG8_STAGE(PG8_SA(1, 0), a3, voffA);
            PG8_BAR; PG8_WAIT_L(0); PG8_MMA(1, 0, At, B0); PG8_BAR; PG8_SCHED;
            PG8_STAGE(PG8_SB(1, 1), b3 + hstepB, voffB);
            PG8_WAIT_V(6); PG8_BAR; PG8_MMA(1, 1, At, B1); PG8_BAR;
            }
        }
        if constexpr (ALIGN_EPI) { if (wr == 0) PG8_BAR; }
        if constexpr (!Epi::AFTER_DRAIN) { E(acc, cur, wr, wc, fr, fq); S.done(cur); }
        if (!has_next) break;
#pragma unroll
        for (int a = 0; a < 2; ++a)
#pragma unroll
            for (int b = 0; b < 2; ++b)
#pragma unroll
                for (int m = 0; m < 4; ++m)
#pragma unroll
                    for (int n = 0; n < 2; ++n) acc[a][b][m][n] = (f32x4){0.f, 0.f, 0.f, 0.f};
        cur = nxt; cA = nA; cB = nB; ++ui;
        if constexpr (ALIGN_EPI) { if (wr == 1) PG8_BAR; }
    }
    PG8_WAIT_V(0);
    if constexpr (!ALIGN_EPI) { if (wr == 0) PG8_BAR; }
    PG8_BAR;
    if constexpr (Epi::AFTER_DRAIN) { E.fused(acc, cur, wr, wc, fr, fq, lds, wid, lane); S.done(cur); }
#undef PG8_SA
#undef PG8_SB
#undef PG8_STAGE
#undef PG8_LDA
#undef PG8_LDB
#undef PG8_MMA
#undef PG8_WAIT_V
#undef PG8_WAIT_L
#undef PG8_BAR
#undef PG8_SCHED
}
}

#include <hip/hip_bf16.h>
#include <cmath>
namespace attn_body {
using bf16=__hip_bfloat16;
using bf16x8=__attribute__((ext_vector_type(8)))short;
using s16x4=__attribute__((ext_vector_type(4)))short;
using f32x16=__attribute__((ext_vector_type(16)))float;
using u32x4=__attribute__((ext_vector_type(4)))unsigned;
constexpr int SEQ=4096,D=64,DM=1024,OPITCH=2048;
constexpr int NW=8,QBLK=32,QB=QBLK*NW,KVBLK=64,NQB=SEQ/QB;
constexpr int ATTN_PITCH=DM, ATTN_UNIT_ROWS=QB;
__device__ __forceinline__ int crow(int r,int hi){return (r&3)+8*(r>>2)+4*hi;}
#define SBAR() __builtin_amdgcn_sched_barrier(0)
__device__ __forceinline__ void cmask(f32x16&p0,f32x16&p1,int jb,int qrel,int hi){
  const float NEG=-INFINITY; int kb=64*jb+4*hi;
  #pragma unroll
  for(int r=0;r<16;++r){int kv=kb+(r&3)+8*(r>>2); if(kv>qrel)p0[r]=NEG; if(kv+32>qrel)p1[r]=NEG;}
}

constexpr int NSLOT=3, SLOTB=8192;
constexpr int LDS_K=0, LDS_V=NSLOT*SLOTB, LDS_WS=2*NSLOT*SLOTB, LDS_OST=LDS_WS+NW*64*4, LDS_BYTES=LDS_OST+NW*4096;
constexpr float C2=0.125f*1.4426950408889634f;
__device__ __forceinline__ void glds16(const void*gsrc,unsigned lds_dst){unsigned keep;
  asm volatile("s_mov_b32 %0, m0\n\ts_mov_b32 m0, %2\n\ts_nop 0\n\tglobal_load_lds_dwordx4 %1, off\n\ts_mov_b32 m0, %0":"=&s"(keep):"v"(gsrc),"s"(lds_dst):"memory");}
__device__ __forceinline__ float max3f(float a,float b,float c){float r;asm("v_max3_f32 %0, %1, %2, %3":"=v"(r):"v"(a),"v"(b),"v"(c));return r;}
__device__ __forceinline__ float max2f(float a,float b){float r;asm("v_max_f32_e32 %0, %1, %2":"=v"(r):"v"(a),"v"(b));return r;}
__device__ __forceinline__ float fadd_s(float a,float b){float r;asm("v_add_f32_e32 %0, %1, %2":"=v"(r):"v"(a),"v"(b));return r;}
__device__ __forceinline__ float fsub_s(float a,float b){float r;asm("v_sub_f32_e32 %0, %1, %2":"=v"(r):"v"(a),"v"(b));return r;}
typedef float f32x2_t __attribute__((ext_vector_type(2))); typedef __bf16 bf16x2_t __attribute__((ext_vector_type(2)));
__device__ __forceinline__ unsigned cvtpk_s(float lo,float hi){f32x2_t v={lo,hi};bf16x2_t b=__builtin_convertvector(v,bf16x2_t);return __builtin_bit_cast(unsigned,b);}
#define WAIT_BAR(N) asm volatile("s_waitcnt vmcnt(" #N ") lgkmcnt(0)\n\ts_barrier":::"memory")

__device__ __forceinline__ f32x16 mfma_z(bf16x8 a_,bf16x8 b_){ f32x16 d_; asm volatile("s_nop 1\n\tv_mfma_f32_32x32x16_bf16 %0, %1, %2, 0":"=&v"(d_):"v"(a_),"v"(b_)); return d_; }
__device__ __forceinline__ void qkt(f32x16&p0,f32x16&p1,const char*Kslot,const bf16x8*qr,int r32,int hi){
  const char*kb=Kslot+hi*1024+r32*16;
  #pragma unroll
  for(int d0=0;d0<4;++d0){
    const bf16x8 b0=*reinterpret_cast<const bf16x8*>(kb+d0*2048);
    const bf16x8 b1=*reinterpret_cast<const bf16x8*>(kb+d0*2048+512);
    if(d0==0){f32x16 z0=f32x16{},z1=f32x16{};asm volatile("":"+v"(z0),"+v"(z1));
      p0=__builtin_amdgcn_mfma_f32_32x32x16_bf16(b0,qr[0],z0,0,0,0);p1=__builtin_amdgcn_mfma_f32_32x32x16_bf16(b1,qr[0],z1,0,0,0);}
    else{p0=__builtin_amdgcn_mfma_f32_32x32x16_bf16(b0,qr[d0],p0,0,0,0);p1=__builtin_amdgcn_mfma_f32_32x32x16_bf16(b1,qr[d0],p1,0,0,0);}}
}
typedef __attribute__((address_space(3))) const char* lds_cptr;
typedef short v4i16_t __attribute__((ext_vector_type(4)));
__device__ __forceinline__ void kload8(bf16x8*kf,lds_cptr kp){
  kf[0]=*(const __attribute__((address_space(3))) bf16x8*)(kp);      kf[1]=*(const __attribute__((address_space(3))) bf16x8*)(kp+512);
  kf[2]=*(const __attribute__((address_space(3))) bf16x8*)(kp+2048); kf[3]=*(const __attribute__((address_space(3))) bf16x8*)(kp+2560);
  kf[4]=*(const __attribute__((address_space(3))) bf16x8*)(kp+4096); kf[5]=*(const __attribute__((address_space(3))) bf16x8*)(kp+4608);
  kf[6]=*(const __attribute__((address_space(3))) bf16x8*)(kp+6144); kf[7]=*(const __attribute__((address_space(3))) bf16x8*)(kp+6656);
}
__device__ __forceinline__ void kload2(bf16x8*kf,lds_cptr kp,int j){ kf[2*j]=*(const __attribute__((address_space(3))) bf16x8*)(kp+j*2048); kf[2*j+1]=*(const __attribute__((address_space(3))) bf16x8*)(kp+j*2048+512); }
__device__ __forceinline__ s16x4 vtr(lds_cptr p){ return __builtin_bit_cast(s16x4,__builtin_amdgcn_ds_read_tr16_b64_v4i16((__attribute__((address_space(3))) v4i16_t*)p)); }
__device__ __forceinline__ float rowmax(const f32x16&p0,const f32x16&p1){
  float a=max3f(p0[0],p0[1],p1[0]),b=max3f(p0[2],p0[3],p1[1]);a=max3f(a,p1[2],p1[3]);
  #pragma unroll
  for(int r=4;r<16;r+=4){a=max3f(a,p0[r],p0[r+1]);b=max3f(b,p0[r+2],p0[r+3]);a=max3f(a,p1[r],p1[r+1]);b=max3f(b,p1[r+2],p1[r+3]);}
  const float m=max2f(a,b);
  auto rr=__builtin_amdgcn_permlane32_swap(__float_as_uint(m),__float_as_uint(m),false,false);
  return max2f(__uint_as_float(rr[0]),__uint_as_float(rr[1]));
}
__device__ __forceinline__ void pv(f32x16*o,int vb,bf16x8 pa0,bf16x8 pa1,bf16x8 pa2,bf16x8 pa3){
  #pragma unroll
  for(int d0=0;d0<2;++d0){s16x4 lo[4],hi[4];
    #pragma unroll
    for(int ks=0;ks<4;++ks){
      asm volatile("ds_read_b64_tr_b16 %0,%1 offset:%c2":"=&v"(lo[ks]):"v"(vb),"i"(d0*4096+ks*1024):"memory");
      asm volatile("ds_read_b64_tr_b16 %0,%1 offset:%c2":"=&v"(hi[ks]):"v"(vb),"i"(d0*4096+ks*1024+512):"memory");}
    asm volatile("s_waitcnt lgkmcnt(0)":::"memory");SBAR();
    #define PK(k) (bf16x8){lo[k][0],lo[k][1],lo[k][2],lo[k][3],hi[k][0],hi[k][1],hi[k][2],hi[k][3]}
    o[d0]=__builtin_amdgcn_mfma_f32_32x32x16_bf16(pa0,PK(0),o[d0],0,0,0);
    o[d0]=__builtin_amdgcn_mfma_f32_32x32x16_bf16(pa1,PK(1),o[d0],0,0,0);
    o[d0]=__builtin_amdgcn_mfma_f32_32x32x16_bf16(pa2,PK(2),o[d0],0,0,0);
    o[d0]=__builtin_amdgcn_mfma_f32_32x32x16_bf16(pa3,PK(3),o[d0],0,0,0);
    #undef PK
  }
}

#ifndef ATTN_STORE16
#define ATTN_STORE16(p,v) (*(u32x4*)(p)=(v))
#endif
template<int THRL> __device__ __forceinline__ void attn_unit(int qb,const bf16*Qh,const bf16*__restrict__ Kh,const bf16*__restrict__ Vh,bf16*Oh,char*shm,const int tid_in){
  const int tid=tid_in,lane=tid&63,r32=lane&31,hi=lane>>5; const int wid=__builtin_amdgcn_readfirstlane(tid>>6);
  const int q0=qb*QB;
  const bf16*Qw=Qh+(long)(q0+wid*QBLK)*DM;
  const unsigned lds0=(unsigned)(uintptr_t)shm;
  float*wsf=(float*)(shm+LDS_WS)+wid*64;
  const bf16*ksrc=Kh+(long)lane*DM+wid*8;
  const bf16*vsrc=Vh+(long)(16*(wid&3)+(lane>>2))*DM+(wid>>2)*32+(lane&3)*8;
  const unsigned kdst=lds0+LDS_K+wid*1024, vdst=lds0+LDS_V+wid*1024;
  #define DMA_K(t,slot) glds16(ksrc+(long)(t)*KVBLK*DM,(unsigned)__builtin_amdgcn_readfirstlane(kdst+(slot)))
  #define DMA_V(t,slot) glds16(vsrc+(long)(t)*KVBLK*DM,(unsigned)__builtin_amdgcn_readfirstlane(vdst+(slot)))
  const int vb0=(int)(lds0+LDS_V)+((lane>>4)&1)*32+(lane&3)*8+(4*hi+((lane&15)>>2))*64;
  const char*Kbase=shm+LDS_K; bf16x8 kf[8];
  const lds_cptr shm3=(lds_cptr)shm; const lds_cptr kp0=shm3+LDS_K+hi*1024+r32*16; const lds_cptr vp0=shm3+LDS_V+((lane>>4)&1)*32+(lane&3)*8+(4*hi+((lane&15)>>2))*64;
  const int NT=(q0+QB)/KVBLK;
  DMA_K(0,0);DMA_V(0,0);DMA_K(1,SLOTB);
  bf16x8 qr[4];
  #pragma unroll
  for(int d0=0;d0<4;++d0)qr[d0]=*reinterpret_cast<const bf16x8*>(&Qw[(long)r32*DM+d0*16+hi*8]);
  float mhat=0.f,l_reg=0.f;f32x16 o[2];o[0]=f32x16{};o[1]=f32x16{};
  const int qrel=wid*QBLK+r32;
  #define CMASK(P0,P1,t) do{int jb_=(t)-(NT-4); if(jb_>=0)cmask(P0,P1,jb_,qrel,hi);}while(0)
  bool resc=false;
  #define START(P0,P1) do{ const float rm=rowmax(P0,P1); resc=false; \
    { const float dl=rm; mhat=fadd_s(mhat,dl); \
      _Pragma("unroll") for(int r=0;r<16;++r){P0[r]=fsub_s(P0[r],dl);P1[r]=fsub_s(P1[r],dl);} \
      } \
    _Pragma("unroll") for(int r=0;r<16;++r)P0[r]=__builtin_amdgcn_exp2f(P0[r]); }while(0)
  #define RESC() do{ if(resc){ asm volatile("s_waitcnt lgkmcnt(0)":::"memory"); \
      _Pragma("unroll") for(int d_=0;d_<2;++d_) _Pragma("unroll") for(int r=0;r<16;++r)o[d_][r]*=wsf[crow(r,hi)]; } }while(0)
  f32x16 pA0,pA1,pB0,pB1;
  int sl_prev=0,sl_cur=0,sl_next=SLOTB;
  #define ROT() do{sl_prev=sl_cur;sl_cur=sl_next;sl_next=(sl_next==(NSLOT-1)*SLOTB)?0:sl_next+SLOTB;}while(0)
  DMA_K(2,2*SLOTB);
  WAIT_BAR(3);
  qkt(pA0,pA1,Kbase,qr,r32,hi);asm volatile("s_nop 15\n\ts_nop 7":"+v"(pA0),"+v"(pA1));CMASK(pA0,pA1,0);
  START(pA0,pA1);
  _Pragma("unroll") for(int r=0;r<16;++r)pA1[r]=__builtin_amdgcn_exp2f(pA1[r]);
  WAIT_BAR(0);
  DMA_K(3,0);DMA_V(1,SLOTB);
  ROT();
  kload8(kf,kp0+sl_cur);
  WAIT_BAR(2);
  s16x4 vlo[8],vhi[8]; u32x4 pw0,pw1,pw2,pw3;
  #define PKW(P,B) cvtpk_s(P[B],P[B+1])
  #define PAF(k) __builtin_bit_cast(bf16x8,pw##k)
  #define VFR(i) (bf16x8){vlo[i][0],vlo[i][1],vlo[i][2],vlo[i][3],vhi[i][0],vhi[i][1],vhi[i][2],vhi[i][3]}
  #define PIN(x) asm volatile("":"+v"(x))
  #define MX3(a,b,c) __builtin_fmaxf(__builtin_fmaxf((a),(b)),(c))
  #define GAPA(MF,A0,A1,A2,A3,W0,W1,PW) do{ MF; sacc+=A0; sacc+=A1; sacc+=A2; sacc+=A3; PIN(sacc); W0; W1; PIN(PW); SBAR(); }while(0)
  #define EX(v) __builtin_amdgcn_exp2f(v)
  #define GAPB(MF,X,B) do{ MF; X[B]=EX(fsub_s(X[B],mhat)); X[B+1]=EX(fsub_s(X[B+1],mhat)); X[B+2]=EX(fsub_s(X[B+2],mhat)); X[B+3]=EX(fsub_s(X[B+3],mhat)); PIN(X); SBAR(); }while(0)
  #define VRD(i) do{ vlo[i]=vtr(vp_+(((i)>>2)*4096+((i)&3)*1024)); vhi[i]=vtr(vp_+(((i)>>2)*4096+((i)&3)*1024+512)); }while(0)
  #define KRD(G,j) do{ if(G){ kload2(kf,kp0+sl_next,j); SBAR(); } }while(0)
  #define STEP(C0,C1,P0,P1,t,GK,GV,GL) do{ SBAR(); \
    const lds_cptr vp_=vp0+sl_prev; \
    VRD(0); SBAR(); float sacc=(P0[0]+P0[1]); \
    GAPA(C0=mfma_z(kf[0],qr[0]), P0[2],P0[3],P0[4],P0[5],     pw0[0]=PKW(P0,0), pw0[1]=PKW(P0,2), pw0); \
    VRD(4); SBAR(); GAPA(C1=mfma_z(kf[1],qr[0]), P0[6],P0[7],P0[8],P0[9],     pw0[2]=PKW(P0,4), pw0[3]=PKW(P0,6), pw0); \
    VRD(1); SBAR(); GAPA(C0=__builtin_amdgcn_mfma_f32_32x32x16_bf16(kf[2],qr[1],C0,0,0,0),   P0[10],P0[11],P0[12],P0[13], pw1[0]=PKW(P0,8), pw1[1]=PKW(P0,10), pw1); \
    VRD(5); SBAR(); GAPA(C1=__builtin_amdgcn_mfma_f32_32x32x16_bf16(kf[3],qr[1],C1,0,0,0),   P0[14],P0[15],P1[0],P1[1],   pw1[2]=PKW(P0,12),pw1[3]=PKW(P0,14), pw1); \
    VRD(2); SBAR(); GAPA(C0=__builtin_amdgcn_mfma_f32_32x32x16_bf16(kf[4],qr[2],C0,0,0,0),   P1[2],P1[3],P1[4],P1[5],     pw2[0]=PKW(P1,0), pw2[1]=PKW(P1,2), pw2); \
    VRD(6); SBAR(); GAPA(C1=__builtin_amdgcn_mfma_f32_32x32x16_bf16(kf[5],qr[2],C1,0,0,0),   P1[6],P1[7],P1[8],P1[9],     pw2[2]=PKW(P1,4), pw2[3]=PKW(P1,6), pw2); \
    VRD(3); SBAR(); GAPA(C0=__builtin_amdgcn_mfma_f32_32x32x16_bf16(kf[6],qr[3],C0,0,0,0),   P1[10],P1[11],P1[12],P1[13], pw3[0]=PKW(P1,8), pw3[1]=PKW(P1,10), pw3); \
    VRD(7); SBAR(); GAPA(C1=__builtin_amdgcn_mfma_f32_32x32x16_bf16(kf[7],qr[3],C1,0,0,0),   P1[14],P1[15],0.f,0.f,       pw3[2]=PKW(P1,12),pw3[3]=PKW(P1,14), pw3); \
    l_reg+=sacc; \
    if(GK){DMA_K((t)+3,sl_cur);} if(GV){DMA_V((t)+1,sl_next);} \
    CMASK(C0,C1,t); \
    { float a=MX3(C0[0],C0[1],C1[0]),b=MX3(C0[2],C0[3],C1[1]); a=MX3(a,C1[2],C1[3]); \
      _Pragma("unroll") for(int r=4;r<16;r+=4){a=MX3(a,C0[r],C0[r+1]);b=MX3(b,C0[r+2],C0[r+3]);a=MX3(a,C1[r],C1[r+1]);b=MX3(b,C1[r+2],C1[r+3]);} \
      float rm=__builtin_fmaxf(a,b); { auto rr=__builtin_amdgcn_permlane32_swap(__float_as_uint(rm),__float_as_uint(rm),false,false); rm=__builtin_fmaxf(__uint_as_float(rr[0]),__uint_as_float(rr[1])); } \
      resc=false; \
      const float rel=rm-mhat; \
      if(__builtin_expect(__any(rel>(float)THRL),0)){ const float dl=__builtin_fmaxf(rel,0.f); mhat+=dl; \
        const float f=__builtin_amdgcn_exp2f(-dl); l_reg*=f; if(hi==0)wsf[r32]=f; resc=true; } } \
    SBAR(); \
    GAPB(o[0]=__builtin_amdgcn_mfma_f32_32x32x16_bf16(PAF(0),VFR(0),o[0],0,0,0), C0,0); \
    GAPB(o[1]=__builtin_amdgcn_mfma_f32_32x32x16_bf16(PAF(0),VFR(4),o[1],0,0,0), C0,4); \
    KRD(GL,0); GAPB(o[0]=__builtin_amdgcn_mfma_f32_32x32x16_bf16(PAF(1),VFR(1),o[0],0,0,0), C0,8); \
    KRD(GL,1); GAPB(o[1]=__builtin_amdgcn_mfma_f32_32x32x16_bf16(PAF(1),VFR(5),o[1],0,0,0), C0,12); \
    KRD(GL,2); GAPB(o[0]=__builtin_amdgcn_mfma_f32_32x32x16_bf16(PAF(2),VFR(2),o[0],0,0,0), C1,0); \
    KRD(GL,3); GAPB(o[1]=__builtin_amdgcn_mfma_f32_32x32x16_bf16(PAF(2),VFR(6),o[1],0,0,0), C1,4); \
    GAPB(o[0]=__builtin_amdgcn_mfma_f32_32x32x16_bf16(PAF(3),VFR(3),o[0],0,0,0), C1,8); \
    GAPB(o[1]=__builtin_amdgcn_mfma_f32_32x32x16_bf16(PAF(3),VFR(7),o[1],0,0,0), C1,12); \
    }while(0)
  int t=1;
  #undef CMASK
  #define CMASK(P0,P1,t) do{}while(0)
  for(;t+5<NT;t+=2){
    STEP(pB0,pB1,pA0,pA1,t,true,true,true);     WAIT_BAR(2); RESC(); ROT();
    STEP(pA0,pA1,pB0,pB1,t+1,true,true,true);   WAIT_BAR(2); RESC(); ROT();
  }
  #undef CMASK
  #define CMASK(P0,P1,t) do{int jb_=(t)-(NT-4); if(jb_>=0)cmask(P0,P1,jb_,qrel,hi);}while(0)
  #define ENDW(tt) do{ if((tt)+3<NT){WAIT_BAR(2);} else if((tt)+2<NT){WAIT_BAR(1);} else {WAIT_BAR(0);} }while(0)
  for(;t+1<NT;t+=2){
    STEP(pB0,pB1,pA0,pA1,t,(t+3<NT),(t+1<NT),(t+1<NT));       ENDW(t);   RESC(); ROT();
    STEP(pA0,pA1,pB0,pB1,t+1,(t+4<NT),(t+2<NT),(t+2<NT));     ENDW(t+1); RESC(); ROT();
  }
  STEP(pB0,pB1,pA0,pA1,NT-1,false,false,false); RESC();
  { float sacc=pB0[0]+pB0[1]; _Pragma("unroll") for(int r=2;r<16;++r)sacc+=pB0[r]; _Pragma("unroll") for(int r=0;r<16;++r)sacc+=pB1[r]; l_reg+=sacc;
    pw0=(u32x4){PKW(pB0,0),PKW(pB0,2),PKW(pB0,4),PKW(pB0,6)};pw1=(u32x4){PKW(pB0,8),PKW(pB0,10),PKW(pB0,12),PKW(pB0,14)};pw2=(u32x4){PKW(pB1,0),PKW(pB1,2),PKW(pB1,4),PKW(pB1,6)};pw3=(u32x4){PKW(pB1,8),PKW(pB1,10),PKW(pB1,12),PKW(pB1,14)};
    SBAR(); pv(o,vb0+sl_cur,PAF(0),PAF(1),PAF(2),PAF(3)); }
  #undef PKW
  #undef PAF
  #undef VFR
  #undef PIN
  #undef MX3
  #undef GAPA
  #undef GAPB
  #undef EX
  #undef VRD
  #undef KRD
  #undef STEP
  #undef ENDW
  l_reg+=__uint_as_float((unsigned)__builtin_amdgcn_ds_bpermute((lane^32)<<2,(int)__float_as_uint(l_reg)));
  if(hi==0)wsf[32+r32]=l_reg;asm volatile("s_waitcnt lgkmcnt(0)":::"memory");
  float rli[16];
  #pragma unroll
  for(int r=0;r<16;++r)rli[r]=__builtin_amdgcn_rcpf(wsf[32+crow(r,hi)]);
  bf16*Ow=Oh+(long)(q0+wid*QBLK)*OPITCH;
  { bf16*stg=(bf16*)(shm+LDS_OST)+wid*2048;
    #pragma unroll
    for(int r=0;r<16;++r){const int orow=crow(r,hi);
      #pragma unroll
      for(int d0=0;d0<2;++d0)stg[orow*64+d0*32+r32]=__float2bfloat16(o[d0][r]*rli[r]);}
    asm volatile("s_waitcnt lgkmcnt(0)":::"memory");
    #pragma unroll
    for(int i=0;i<4;++i){const int row=i*8+(lane>>3),ch=lane&7; const u32x4 v=*(const u32x4*)(stg+row*64+ch*8); ATTN_STORE16(Ow+(long)row*OPITCH+ch*8,v);} }
  asm volatile("s_waitcnt lgkmcnt(0)\n\ts_barrier":::"memory");
  #undef DMA_K
  #undef DMA_V
  #undef CMASK
  #undef START
  #undef RESC
  #undef ROT
}

__device__ __forceinline__ float rowmax_cv(const f32x16&p0,const f32x16&p1){
  float a=__builtin_fmaxf(p0[0],p1[0]);
  #pragma unroll
  for(int r=1;r<16;++r){a=__builtin_fmaxf(a,p0[r]);a=__builtin_fmaxf(a,p1[r]);}
  auto rr=__builtin_amdgcn_permlane32_swap(__float_as_uint(a),__float_as_uint(a),false,false);
  return __builtin_fmaxf(__uint_as_float(rr[0]),__uint_as_float(rr[1]));
}
__device__ __forceinline__ void attn_unit_simple(int qb,const bf16*Qh,const bf16*__restrict__ Kh,const bf16*__restrict__ Vh,bf16*Oh,char*shm,const int tid_in){
  const int tid=tid_in,lane=tid&63,r32=lane&31,hi=lane>>5; const int wid=__builtin_amdgcn_readfirstlane(tid>>6);
  const int q0=qb*QB;
  const bf16*Qw=Qh+(long)(q0+wid*QBLK)*DM;
  const unsigned lds0=(unsigned)(uintptr_t)shm;
  float*wsf=(float*)(shm+LDS_WS)+wid*64;
  const bf16*ksrc=Kh+(long)lane*DM+wid*8;
  const bf16*vsrc=Vh+(long)(16*(wid&3)+(lane>>2))*DM+(wid>>2)*32+(lane&3)*8;
  u32x4*kdstp=(u32x4*)(shm+LDS_K+wid*1024+lane*16); u32x4*vdstp=(u32x4*)(shm+LDS_V+wid*1024+lane*16);
  const int vb0=(int)(lds0+LDS_V)+((lane>>4)&1)*32+(lane&3)*8+(4*hi+((lane&15)>>2))*64;
  const char*Kbase=shm+LDS_K;
  const int NT=(q0+QB)/KVBLK;
  bf16x8 qr[4];
  #pragma unroll
  for(int d0=0;d0<4;++d0)qr[d0]=*reinterpret_cast<const bf16x8*>(&Qw[(long)r32*DM+d0*16+hi*8]);
  float m_run=-1e30f,l_reg=0.f; f32x16 o[2]; o[0]=f32x16{}; o[1]=f32x16{};
  const int qrel=wid*QBLK+r32;
  u32x4 kreg=*(const u32x4*)ksrc, vreg=*(const u32x4*)vsrc;
  for(int t=0;t<NT;++t){
    *kdstp=kreg; *vdstp=vreg;
    if(t+1<NT){ kreg=*(const u32x4*)(ksrc+(long)(t+1)*KVBLK*DM); vreg=*(const u32x4*)(vsrc+(long)(t+1)*KVBLK*DM); }
    __syncthreads();
    f32x16 p0,p1;
    qkt(p0,p1,Kbase,qr,r32,hi);
    { const int jb=t-(NT-4); if(jb>=0){ const float NEG=-INFINITY; const int kb=64*jb+4*hi;
        #pragma unroll
        for(int r=0;r<16;++r){const int kv=kb+(r&3)+8*(r>>2); if(kv>qrel)p0[r]=NEG; if(kv+32>qrel)p1[r]=NEG;} } }
    const float rm=rowmax_cv(p0,p1);
    const float mn=__builtin_fmaxf(m_run,rm); const float alpha=__builtin_amdgcn_exp2f(m_run-mn); m_run=mn;
    float sacc=0.f;
    #pragma unroll
    for(int r=0;r<16;++r){p0[r]=__builtin_amdgcn_exp2f(p0[r]-mn);p1[r]=__builtin_amdgcn_exp2f(p1[r]-mn);sacc+=p0[r]+p1[r];}
    l_reg=l_reg*alpha+sacc;
    if(hi==0)wsf[r32]=alpha;
    asm volatile("s_waitcnt lgkmcnt(0)":::"memory");
    #pragma unroll
    for(int d_=0;d_<2;++d_)
      #pragma unroll
      for(int r=0;r<16;++r)o[d_][r]*=wsf[crow(r,hi)];
    u32x4 pw0,pw1,pw2,pw3;
    #define PKW2(P,B) cvtpk_s(P[B],P[B+1])
    pw0=(u32x4){PKW2(p0,0),PKW2(p0,2),PKW2(p0,4),PKW2(p0,6)};pw1=(u32x4){PKW2(p0,8),PKW2(p0,10),PKW2(p0,12),PKW2(p0,14)};
    pw2=(u32x4){PKW2(p1,0),PKW2(p1,2),PKW2(p1,4),PKW2(p1,6)};pw3=(u32x4){PKW2(p1,8),PKW2(p1,10),PKW2(p1,12),PKW2(p1,14)};
    #undef PKW2
    pv(o,vb0,__builtin_bit_cast(bf16x8,pw0),__builtin_bit_cast(bf16x8,pw1),__builtin_bit_cast(bf16x8,pw2),__builtin_bit_cast(bf16x8,pw3));
    asm volatile("s_waitcnt lgkmcnt(0)":::"memory");
    __syncthreads();
  }
  l_reg+=__uint_as_float((unsigned)__builtin_amdgcn_ds_bpermute((lane^32)<<2,(int)__float_as_uint(l_reg)));
  if(hi==0)wsf[32+r32]=l_reg;asm volatile("s_waitcnt lgkmcnt(0)":::"memory");
  float rli[16];
  #pragma unroll
  for(int r=0;r<16;++r)rli[r]=__builtin_amdgcn_rcpf(wsf[32+crow(r,hi)]);
  bf16*Ow=Oh+(long)(q0+wid*QBLK)*OPITCH;
  { bf16*stg=(bf16*)(shm+LDS_OST)+wid*2048;
    #pragma unroll
    for(int r=0;r<16;++r){const int orow=crow(r,hi);
      #pragma unroll
      for(int d0=0;d0<2;++d0)stg[orow*64+d0*32+r32]=__float2bfloat16(o[d0][r]*rli[r]);}
    asm volatile("s_waitcnt lgkmcnt(0)":::"memory");
    #pragma unroll
    for(int i=0;i<4;++i){const int row=i*8+(lane>>3),ch=lane&7; const u32x4 v=*(const u32x4*)(stg+row*64+ch*8); ATTN_STORE16(Ow+(long)row*OPITCH+ch*8,v);} }
  asm volatile("s_waitcnt vmcnt(0) lgkmcnt(0)":::"memory");
  __syncthreads();
}

constexpr int DA_SLOT=32768, DA_V=16384, DA_WS=98304, DA_ROWS=128;
__device__ __forceinline__ f32x16 mfma_c(bf16x8 a_,bf16x8 b_,const f32x16&c_){ f32x16 d_; asm volatile("s_nop 1\n\tv_mfma_f32_32x32x16_bf16 %0, %1, %2, %3":"=&v"(d_):"v"(a_),"v"(b_),"v"(c_)); return d_; }
template<int THRL> __device__ __forceinline__ void dattn_unit(int qblk,const bf16*Qb,const bf16*__restrict__ Kb,const bf16*__restrict__ Vb,bf16*Yb,float lam,const float*gsub,float gscale,char*shm,const int tid_in){
  const int tid=tid_in,lane=tid&63,r32=lane&31,hi=lane>>5; const int wid=__builtin_amdgcn_readfirstlane(tid>>6);
  const int c=wid>>2, rg=wid&3;
  const int q0=qblk*DA_ROWS; const int NT=(q0+DA_ROWS)/KVBLK;
  const bf16*Qw=Qb+c*64+(long)(q0+rg*32)*DM;
  const unsigned lds0=(unsigned)(uintptr_t)shm; const lds_cptr shm3=(lds_cptr)shm;
  float*wsf=(float*)(shm+DA_WS)+wid*64;
  const int pk0=2*wid;
  const bf16*ksrc0=Kb+(pk0>>3)*64+(long)lane*DM+(pk0&7)*8;
  const unsigned kdst0=lds0+(pk0>>3)*8192+(pk0&7)*1024;
  const bf16*vsrc0=Vb+(long)(16*(pk0&3)+(lane>>2))*DM+(pk0>>2)*32+(lane&3)*8;
  const unsigned vdst0=lds0+DA_V+pk0*1024;
  #define DA_RFL(x) ((unsigned)__builtin_amdgcn_readfirstlane((int)(x)))
  #define DA_DMA(t,so) do{ const long to_=(long)(t)*KVBLK*DM; \
      glds16(ksrc0+to_,DA_RFL(kdst0+(so))); glds16(ksrc0+to_+8,DA_RFL(kdst0+(so)+1024)); \
      glds16(vsrc0+to_,DA_RFL(vdst0+(so))); glds16(vsrc0+to_+16*DM,DA_RFL(vdst0+(so)+1024)); }while(0)
  const lds_cptr kp0=shm3+c*8192+hi*1024+r32*16;
  const lds_cptr vp0=shm3+DA_V+((lane>>4)&1)*32+(lane&3)*8+(4*hi+((lane&15)>>2))*64;
  bf16x8 qr[4];
  #pragma unroll
  DA_DMA(0,0); if(NT>1){ DA_DMA(1,DA_SLOT); }
  #pragma unroll
  for(int d0=0;d0<4;++d0)qr[d0]=*reinterpret_cast<const bf16x8*>(&Qw[(long)r32*DM+d0*16+hi*8]);
  asm volatile("":"+v"(qr[0]),"+v"(qr[1]),"+v"(qr[2]),"+v"(qr[3]));
  float mhat=0.f,l_reg=0.f; f32x16 o[4]; o[0]=f32x16{}; o[1]=f32x16{}; o[2]=f32x16{}; o[3]=f32x16{};
  f32x16 negm;
  #pragma unroll
  for(int r=0;r<16;++r)negm[r]=0.f;
  const int qrel=rg*32+r32;
  int slot=0;
  for(int t=0;t<NT;++t){
    if(t+1<NT){ asm volatile("s_waitcnt vmcnt(4) lgkmcnt(0)\n\ts_barrier":::"memory"); } else { asm volatile("s_waitcnt vmcnt(0) lgkmcnt(0)\n\ts_barrier":::"memory"); }
    if(t+2<NT){ int s2=slot+2*DA_SLOT; if(s2>=3*DA_SLOT)s2-=3*DA_SLOT; DA_DMA(t+2,s2); }
    const lds_cptr kp=kp0+slot;
    f32x16 p0,p1;
    { const bf16x8 k0=*(const __attribute__((address_space(3))) bf16x8*)(kp), k1=*(const __attribute__((address_space(3))) bf16x8*)(kp+512);
      p0=mfma_c(k0,qr[0],negm); p1=mfma_c(k1,qr[0],negm); }
    #pragma unroll
    for(int d0=1;d0<4;++d0){ const bf16x8 k0=*(const __attribute__((address_space(3))) bf16x8*)(kp+d0*2048), k1=*(const __attribute__((address_space(3))) bf16x8*)(kp+d0*2048+512);
      p0=__builtin_amdgcn_mfma_f32_32x32x16_bf16(k0,qr[d0],p0,0,0,0); p1=__builtin_amdgcn_mfma_f32_32x32x16_bf16(k1,qr[d0],p1,0,0,0); }
    { const int jb=t-(NT-2); if(jb>=0){ const float NEG=-INFINITY; const int kb=64*jb+4*hi;
        #pragma unroll
        for(int r=0;r<16;++r){const int kv=kb+(r&3)+8*(r>>2); if(kv>qrel)p0[r]=NEG; if(kv+32>qrel)p1[r]=NEG;} } }
    float rm=__builtin_fmaxf(p0[0],p1[0]);
    #pragma unroll
    for(int r=1;r<16;++r){rm=__builtin_fmaxf(rm,p0[r]);rm=__builtin_fmaxf(rm,p1[r]);}
    rm=__builtin_fmaxf(rm,__uint_as_float((unsigned)__builtin_amdgcn_ds_bpermute((lane^32)<<2,(int)__float_as_uint(rm))));
    if(t==0){
      mhat=rm;
      #pragma unroll
      for(int r=0;r<16;++r){p0[r]-=rm;p1[r]-=rm;negm[r]=-rm;}
    } else if(__any(rm>(float)THRL)){
      const float dl=__builtin_fmaxf(rm,0.f); const float f=__builtin_amdgcn_exp2f(-dl); mhat+=dl; l_reg*=f;
      #pragma unroll
      for(int r=0;r<16;++r){p0[r]-=dl;p1[r]-=dl;negm[r]=-mhat;}
      if(hi==0)wsf[r32]=f;
      asm volatile("s_waitcnt lgkmcnt(0)":::"memory");
      #pragma unroll
      for(int d_=0;d_<4;++d_)
        #pragma unroll
        for(int r=0;r<16;++r)o[d_][r]*=wsf[crow(r,hi)];
    }
    float sacc=0.f;
    #pragma unroll
    for(int r=0;r<16;++r){p0[r]=__builtin_amdgcn_exp2f(p0[r]);p1[r]=__builtin_amdgcn_exp2f(p1[r]);sacc+=p0[r]+p1[r];}
    l_reg+=sacc;
    u32x4 pw0,pw1,pw2,pw3;
    pw0=(u32x4){cvtpk_s(p0[0],p0[1]),cvtpk_s(p0[2],p0[3]),cvtpk_s(p0[4],p0[5]),cvtpk_s(p0[6],p0[7])}; pw1=(u32x4){cvtpk_s(p0[8],p0[9]),cvtpk_s(p0[10],p0[11]),cvtpk_s(p0[12],p0[13]),cvtpk_s(p0[14],p0[15])};
    pw2=(u32x4){cvtpk_s(p1[0],p1[1]),cvtpk_s(p1[2],p1[3]),cvtpk_s(p1[4],p1[5]),cvtpk_s(p1[6],p1[7])}; pw3=(u32x4){cvtpk_s(p1[8],p1[9]),cvtpk_s(p1[10],p1[11]),cvtpk_s(p1[12],p1[13]),cvtpk_s(p1[14],p1[15])};
    const lds_cptr vp=vp0+slot;
    #pragma unroll
    for(int d0=0;d0<4;++d0){
      #define DA_VF(ks) ({ const s16x4 lo_=vtr(vp+d0*4096+(ks)*1024), hi_=vtr(vp+d0*4096+(ks)*1024+512); (bf16x8){lo_[0],lo_[1],lo_[2],lo_[3],hi_[0],hi_[1],hi_[2],hi_[3]}; })
      o[d0]=__builtin_amdgcn_mfma_f32_32x32x16_bf16(__builtin_bit_cast(bf16x8,pw0),DA_VF(0),o[d0],0,0,0);
      o[d0]=__builtin_amdgcn_mfma_f32_32x32x16_bf16(__builtin_bit_cast(bf16x8,pw1),DA_VF(1),o[d0],0,0,0);
      o[d0]=__builtin_amdgcn_mfma_f32_32x32x16_bf16(__builtin_bit_cast(bf16x8,pw2),DA_VF(2),o[d0],0,0,0);
      o[d0]=__builtin_amdgcn_mfma_f32_32x32x16_bf16(__builtin_bit_cast(bf16x8,pw3),DA_VF(3),o[d0],0,0,0);
      #undef DA_VF
    }
    slot+=DA_SLOT; if(slot>=3*DA_SLOT)slot=0;
  }
  int lane_e=lane; asm volatile("":"+v"(lane_e)); const int r32e=lane_e&31, hie=lane_e>>5;
  l_reg+=__uint_as_float((unsigned)__builtin_amdgcn_ds_bpermute((lane^32)<<2,(int)__float_as_uint(l_reg)));
  asm volatile("s_waitcnt vmcnt(0) lgkmcnt(0)\n\ts_barrier":::"memory");
  if(hie==0)wsf[32+r32e]=l_reg; asm volatile("s_waitcnt lgkmcnt(0)":::"memory");
  float rli[16];
  #pragma unroll
  for(int r=0;r<16;++r)rli[r]=__builtin_amdgcn_rcpf(wsf[32+crow(r,hie)]);
  float*st2=(float*)shm+rg*4096;
  if(c==1){
    #pragma unroll
    for(int d0=0;d0<4;++d0)
      #pragma unroll
      for(int r=0;r<16;++r)st2[crow(r,hie)*128+d0*32+r32e]=lam*o[d0][r]*rli[r];
  }
  asm volatile("s_waitcnt lgkmcnt(0)\n\ts_barrier":::"memory");
  if(c==0){
    float ssq[16];
    #pragma unroll
    for(int r=0;r<16;++r){ float a_=0.f;
      #pragma unroll
      for(int d0=0;d0<4;++d0){ const float x_=o[d0][r]*rli[r]-st2[crow(r,hie)*128+d0*32+r32e]; o[d0][r]=x_; a_+=x_*x_; }
      a_+=__uint_as_float((unsigned)__builtin_amdgcn_ds_swizzle((int)__float_as_uint(a_),(1<<10)|0x1f)); a_+=__uint_as_float((unsigned)__builtin_amdgcn_ds_swizzle((int)__float_as_uint(a_),(2<<10)|0x1f));
      a_+=__uint_as_float((unsigned)__builtin_amdgcn_ds_swizzle((int)__float_as_uint(a_),(4<<10)|0x1f)); a_+=__uint_as_float((unsigned)__builtin_amdgcn_ds_swizzle((int)__float_as_uint(a_),(8<<10)|0x1f));
      a_+=__uint_as_float((unsigned)__builtin_amdgcn_ds_swizzle((int)__float_as_uint(a_),(16<<10)|0x1f));
      ssq[r]=1.0f/__builtin_sqrtf(a_*(1.0f/128.0f)+1e-5f); }
    float g4[4];
    #pragma unroll
    for(int d0=0;d0<4;++d0)g4[d0]=gsub[d0*32+r32e]*gscale;
    bf16*stg=(bf16*)(shm+65536)+rg*4096;
    #pragma unroll
    for(int r=0;r<16;++r)
      #pragma unroll
      for(int d0=0;d0<4;++d0)stg[crow(r,hie)*128+d0*32+r32e]=__float2bfloat16(o[d0][r]*ssq[r]*g4[d0]);
    asm volatile("s_waitcnt lgkmcnt(0)":::"memory");
    bf16*Yw=Yb+(long)(q0+rg*32)*DM;
    #pragma unroll
    for(int i=0;i<8;++i){const int row=i*4+(lane_e>>4),ch=lane_e&15; const u32x4 v=*(const u32x4*)(stg+row*128+ch*8); *(u32x4*)(Yw+(long)row*DM+ch*8)=v;}
  }
  asm volatile("s_waitcnt vmcnt(0) lgkmcnt(0)\n\ts_barrier":::"memory");
  #undef DA_DMA
  #undef DA_RFL
}
#ifndef DB_VPRE
#define DB_VPRE 0
#endif
#ifndef DB_FILLX
#define DB_FILLX 1
#endif
template<int THRL> __device__ __forceinline__ void dattn2_unit(int qblk,const bf16*Qb,const bf16*__restrict__ Kb,const bf16*__restrict__ Vb,bf16*Yb,float lam,const float*gsub,float gscale,char*shm,const int tid_in){
  const int tid=tid_in,lane=tid&63,r32=lane&31,hi=lane>>5; const int wid=__builtin_amdgcn_readfirstlane(tid>>6);
  const int c=wid>>2, rg=wid&3;
  const int q0=qblk*DA_ROWS; const int NT=(q0+DA_ROWS)/KVBLK;
  const bf16*Qw=Qb+c*64+(long)(q0+rg*32)*DM;
  const unsigned lds0=(unsigned)(uintptr_t)shm; const lds_cptr shm3=(lds_cptr)shm;
  const int pk0=2*wid;
  const bf16*ksrc0=Kb+(pk0>>3)*64+(long)((pk0&7)*8+(lane>>3))*DM+((lane&7)^((lane>>3)&7))*8;
  const unsigned kdst0=lds0+(pk0>>3)*8192+(pk0&7)*1024;
  const bf16*vsrc0=Vb+(long)(16*(pk0&3)+(lane>>2))*DM+(pk0>>2)*32+(lane&3)*8;
  const unsigned vdst0=lds0+DA_V+pk0*1024;
  #define DB_RFL(x) ((unsigned)__builtin_amdgcn_readfirstlane((int)(x)))
  #define DB_DMA(t,so) do{ const long to_=(long)(t)*KVBLK*DM; \
      glds16(ksrc0+to_,DB_RFL(kdst0+(so))); glds16(ksrc0+to_+8*DM,DB_RFL(kdst0+(so)+1024)); \
      glds16(vsrc0+to_,DB_RFL(vdst0+(so))); glds16(vsrc0+to_+16*DM,DB_RFL(vdst0+(so)+1024)); }while(0)
  #define DB_SLOT(t) (((t)&3)*DA_SLOT)
  const lds_cptr kp0=shm3+c*8192+r32*128+((hi^(r32&7))*16);
  #define DB_KLD(kf_,kp_,d0) do{ const lds_cptr a_=(lds_cptr)(size_t)(((unsigned)(size_t)(kp_))^((unsigned)(d0)<<5)); kf_[2*(d0)]=*(const __attribute__((address_space(3))) bf16x8*)(a_); kf_[2*(d0)+1]=*(const __attribute__((address_space(3))) bf16x8*)(a_+4096); }while(0)
  const lds_cptr vp0=shm3+DA_V+((lane>>4)&1)*32+(lane&3)*8+(4*hi+((lane&15)>>2))*64;
  bf16x8 qr[4];
  DB_DMA(0,0); DB_DMA(1,DA_SLOT);
  #pragma unroll
  for(int d0=0;d0<4;++d0)qr[d0]=*reinterpret_cast<const bf16x8*>(&Qw[(long)r32*DM+d0*16+hi*8]);
  asm volatile("":"+v"(qr[0]),"+v"(qr[1]),"+v"(qr[2]),"+v"(qr[3]));
  float mref=0.f,l_reg=0.f; f32x16 o[4]; o[0]=f32x16{}; o[1]=f32x16{}; o[2]=f32x16{}; o[3]=f32x16{};
  f32x16 p0,p1; u32x4 pw0,pw1,pw2,pw3; s16x4 va[8],vb[8];
  #pragma unroll
  for(int r=0;r<16;++r){ p0[r]=0.f; p1[r]=0.f; }
  asm volatile("":"+v"(p0),"+v"(p1));
  const int qrel=rg*32+r32;
  #define DB_WAITT(u) do{ if((u)+1<NT){ asm volatile("s_waitcnt vmcnt(4)":::"memory"); } else { asm volatile("s_waitcnt vmcnt(0)":::"memory"); } }while(0)
  #define DB_ISSUE(u) do{ if((u)<NT){ DB_DMA((u),DB_SLOT(u)); } }while(0)
  #define DB_BAR() asm volatile("s_waitcnt lgkmcnt(0)\n\ts_barrier":::"memory")
  #define DB_BARP() asm volatile("s_waitcnt lgkmcnt(0)\n\ts_barrier":"+v"(p0),"+v"(p1)::"memory")
  #define DB_VLD(x,vp_,d0) do{ _Pragma("unroll") for(int ks_=0;ks_<4;++ks_){ x[2*ks_]=vtr((vp_)+(d0)*4096+ks_*1024); x[2*ks_+1]=vtr((vp_)+(d0)*4096+ks_*1024+512); } }while(0)
  #define DB_VF(x,ks) ((bf16x8){x[2*(ks)][0],x[2*(ks)][1],x[2*(ks)][2],x[2*(ks)][3],x[2*(ks)+1][0],x[2*(ks)+1][1],x[2*(ks)+1][2],x[2*(ks)+1][3]})
  #define DB_PVM(x,d0) do{ o[d0]=__builtin_amdgcn_mfma_f32_32x32x16_bf16(DB_VF(x,0),__builtin_bit_cast(bf16x8,pw0),o[d0],0,0,0); o[d0]=__builtin_amdgcn_mfma_f32_32x32x16_bf16(DB_VF(x,1),__builtin_bit_cast(bf16x8,pw1),o[d0],0,0,0); \
      o[d0]=__builtin_amdgcn_mfma_f32_32x32x16_bf16(DB_VF(x,2),__builtin_bit_cast(bf16x8,pw2),o[d0],0,0,0); o[d0]=__builtin_amdgcn_mfma_f32_32x32x16_bf16(DB_VF(x,3),__builtin_bit_cast(bf16x8,pw3),o[d0],0,0,0); }while(0)
  #define DB_QKM(kf_) do{ p0=__builtin_amdgcn_mfma_f32_32x32x16_bf16(kf_[0],qr[0],p0,0,0,0); p1=__builtin_amdgcn_mfma_f32_32x32x16_bf16(kf_[1],qr[0],p1,0,0,0); \
      _Pragma("unroll") for(int d0_=1;d0_<4;++d0_){ p0=__builtin_amdgcn_mfma_f32_32x32x16_bf16(kf_[2*d0_],qr[d0_],p0,0,0,0); p1=__builtin_amdgcn_mfma_f32_32x32x16_bf16(kf_[2*d0_+1],qr[d0_],p1,0,0,0); } }while(0)
  #define DB_FILL() do{ float nm_=-mref; asm volatile("":"+v"(nm_)); _Pragma("unroll") for(int r=0;r<16;++r){ p0[r]=nm_; p1[r]=nm_; } }while(0)
  #define DB_M(tp,tq) do{ const lds_cptr vp_=vp0+DB_SLOT(tp); const lds_cptr kp_=kp0+DB_SLOT(tq); bf16x8 kf_[8]; \
      if(!DB_VPRE){ DB_VLD(va,vp_,0); DB_VLD(vb,vp_,1); SBAR(); } DB_PVM(va,0); DB_VLD(va,vp_,2); SBAR(); \
      DB_PVM(vb,1); DB_VLD(vb,vp_,3); SBAR(); \
      DB_PVM(va,2); DB_KLD(kf_,kp_,0); DB_KLD(kf_,kp_,1); SBAR(); \
      DB_PVM(vb,3); DB_KLD(kf_,kp_,2); DB_KLD(kf_,kp_,3); SBAR(); \
      if(!DB_FILLX){ DB_FILL(); } DB_QKM(kf_); }while(0)
  #define DB_QK0(tq) do{ const lds_cptr kp_=kp0+DB_SLOT(tq); bf16x8 kf_[8]; DB_KLD(kf_,kp_,0); DB_KLD(kf_,kp_,1); DB_KLD(kf_,kp_,2); DB_KLD(kf_,kp_,3); SBAR(); DB_QKM(kf_); }while(0)
  #define DB_PVL(tp) do{ const lds_cptr vp_=vp0+DB_SLOT(tp); if(!DB_VPRE){ DB_VLD(va,vp_,0); DB_VLD(vb,vp_,1); SBAR(); } DB_PVM(va,0); DB_VLD(va,vp_,2); SBAR(); DB_PVM(vb,1); DB_VLD(vb,vp_,3); SBAR(); DB_PVM(va,2); SBAR(); DB_PVM(vb,3); }while(0)
  #define DB_X(tt,FIRST) do{ { const int jb_=(tt)-(NT-2); if(jb_>=0){ cmask(p0,p1,jb_,qrel,hi); } } \
      const float rm_=rowmax(p0,p1); \
      if(FIRST){ mref=rm_; _Pragma("unroll") for(int r=0;r<16;++r){ p0[r]-=rm_; p1[r]-=rm_; } } \
      else if(__any(rm_>(float)THRL)){ const float dl_=__builtin_fmaxf(rm_,0.f); const float f_=__builtin_amdgcn_exp2f(-dl_); mref+=dl_; l_reg*=f_; \
        _Pragma("unroll") for(int r=0;r<16;++r){ p0[r]-=dl_; p1[r]-=dl_; } \
        _Pragma("unroll") for(int d_=0;d_<4;++d_) _Pragma("unroll") for(int r=0;r<16;++r){ float x_=o[d_][r]; asm volatile("v_mul_f32_e32 %0, %0, %1":"+v"(x_):"v"(f_)); o[d_][r]=x_; } } \
      float sacc_=0.f; _Pragma("unroll") for(int r=0;r<16;++r){ p0[r]=__builtin_amdgcn_exp2f(p0[r]); p1[r]=__builtin_amdgcn_exp2f(p1[r]); sacc_+=p0[r]+p1[r]; } l_reg+=sacc_; \
      pw0=(u32x4){cvtpk_s(p0[0],p0[1]),cvtpk_s(p0[2],p0[3]),cvtpk_s(p0[4],p0[5]),cvtpk_s(p0[6],p0[7])}; pw1=(u32x4){cvtpk_s(p0[8],p0[9]),cvtpk_s(p0[10],p0[11]),cvtpk_s(p0[12],p0[13]),cvtpk_s(p0[14],p0[15])}; \
      pw2=(u32x4){cvtpk_s(p1[0],p1[1]),cvtpk_s(p1[2],p1[3]),cvtpk_s(p1[4],p1[5]),cvtpk_s(p1[6],p1[7])}; pw3=(u32x4){cvtpk_s(p1[8],p1[9]),cvtpk_s(p1[10],p1[11]),cvtpk_s(p1[12],p1[13]),cvtpk_s(p1[14],p1[15])}; \
      if(DB_VPRE){ const lds_cptr vq_=vp0+DB_SLOT(tt); DB_VLD(va,vq_,0); DB_VLD(vb,vq_,1); } if(DB_FILLX){ DB_FILL(); } }while(0)
  DB_WAITT(0);
  if(c==1){ DB_BAR(); DB_ISSUE(2); }
  DB_BAR();
  DB_QK0(0);
  if(c==1){ DB_WAITT(1); } DB_BARP(); DB_ISSUE(2+c);
  DB_X(0,true);
  for(int t=1;t<NT;++t){
    if(c==0){ DB_WAITT(t); } DB_BAR();
    DB_M(t-1,t);
    if(c==1){ DB_WAITT(t+1); } DB_BARP(); DB_ISSUE(t+2+c);
    DB_X(t,false);
  }
  DB_BAR(); DB_PVL(NT-1);
  if(c==0){ DB_BAR(); }
  int lane_e=lane; asm volatile("":"+v"(lane_e)); const int r32e=lane_e&31, hie=lane_e>>5;
  l_reg+=__uint_as_float((unsigned)__builtin_amdgcn_ds_bpermute((lane_e^32)<<2,(int)__float_as_uint(l_reg)));
  asm volatile("s_waitcnt vmcnt(0) lgkmcnt(0)\n\ts_barrier":::"memory");
  const float rl=__builtin_amdgcn_rcpf(l_reg);
  float*st2=(float*)shm+rg*4096+lane_e;
  if(c==1){ const float s_=lam*rl;
    #pragma unroll
    for(int d0=0;d0<4;++d0)
      #pragma unroll
      for(int r=0;r<16;++r)st2[(d0*16+r)*64]=o[d0][r]*s_;
  }
  asm volatile("s_waitcnt lgkmcnt(0)\n\ts_barrier":::"memory");
  if(c==0){
    float a_=0.f;
    #pragma unroll
    for(int d0=0;d0<4;++d0)
      #pragma unroll
      for(int r=0;r<16;++r){ const float x_=o[d0][r]*rl-st2[(d0*16+r)*64]; o[d0][r]=x_; a_+=x_*x_; }
    a_+=__uint_as_float((unsigned)__builtin_amdgcn_ds_bpermute((lane_e^32)<<2,(int)__float_as_uint(a_)));
    const float rs=gscale/__builtin_sqrtf(a_*(1.0f/128.0f)+1e-5f);
    char*stg=shm+65536+rg*(32*272)+r32e*272+hie*8;
    #pragma unroll
    for(int d0=0;d0<4;++d0)
      #pragma unroll
      for(int g=0;g<4;++g){ const float4 gv=*reinterpret_cast<const float4*>(gsub+d0*32+8*g+4*hie);
        uint2 w_; w_.x=cvtpk_s(o[d0][4*g]*rs*gv.x,o[d0][4*g+1]*rs*gv.y); w_.y=cvtpk_s(o[d0][4*g+2]*rs*gv.z,o[d0][4*g+3]*rs*gv.w);
        *reinterpret_cast<uint2*>(stg+(d0*32+8*g)*2)=w_; }
    asm volatile("s_waitcnt lgkmcnt(0)":::"memory");
    bf16*Yw=Yb+(long)(q0+rg*32)*DM; const char*stb=shm+65536+rg*(32*272);
    #pragma unroll
    for(int i=0;i<8;++i){const int row=i*4+(lane_e>>4),ch=lane_e&15; const u32x4 v=*(const u32x4*)(stb+row*272+ch*16); *(u32x4*)(Yw+(long)row*DM+ch*8)=v;}
  }
  asm volatile("s_waitcnt vmcnt(0) lgkmcnt(0)\n\ts_barrier":::"memory");
  #undef DB_RFL
  #undef DB_KLD
  #undef DB_DMA
  #undef DB_SLOT
  #undef DB_WAITT
  #undef DB_ISSUE
  #undef DB_BARP
  #undef DB_BAR
  #undef DB_VLD
  #undef DB_VF
  #undef DB_PVM
  #undef DB_QKM
  #undef DB_M
  #undef DB_QK0
  #undef DB_PVL
  #undef DB_X
}
constexpr int ATTN_LDS_BYTES=LDS_BYTES;
#undef SBAR
#undef WAIT_BAR
}

#define GAS __attribute__((address_space(1)))
#define LAS __attribute__((address_space(3)))
typedef unsigned short bf16;
typedef unsigned v4u __attribute__((ext_vector_type(4)));
typedef float f32x4 __attribute__((ext_vector_type(4)));
typedef short bf16x8 __attribute__((ext_vector_type(8)));
typedef GAS unsigned gu32;
typedef GAS unsigned long long gu64;
#define RLX_AGENT __ATOMIC_RELAXED, __HIP_MEMORY_SCOPE_AGENT
#define LDS_WAIT() asm volatile("s_waitcnt lgkmcnt(0)" ::: "memory")
#define VM_WAIT() asm volatile("s_waitcnt vmcnt(0)" ::: "memory")
__device__ __forceinline__ unsigned long long rt() { return __builtin_amdgcn_s_memrealtime(); }
__device__ __forceinline__ unsigned f2bf(float f) { unsigned u = __builtin_bit_cast(unsigned, f); return (u + 0x7fffu + ((u >> 16) & 1u)) >> 16; }
__device__ __forceinline__ unsigned pk2(float lo, float hi) { return f2bf(lo) | (f2bf(hi) << 16); }

#define XB_TMO      128
#define XB_XCNT(j)  (256  + 64 * (j))
#define XB_XSUB(j)  (1280 + 64 * (j))
#define XB_XGEN(j)  (2304 + 64 * (j))
#define XB_TOP      3328
#define XB_TOPGEN   3392
#define XCD_BAR_WORDS 3456
#define XB_SPIN_CAP (1u << 26)

__device__ __forceinline__ unsigned xb_ld(unsigned* p)              { return __hip_atomic_load(p, __ATOMIC_RELAXED, __HIP_MEMORY_SCOPE_AGENT); }
__device__ __forceinline__ unsigned xb_add(unsigned* p, unsigned v) { return __hip_atomic_fetch_add(p, v, __ATOMIC_RELAXED, __HIP_MEMORY_SCOPE_AGENT); }
__device__ __forceinline__ unsigned xb_xcc_id() { return (unsigned)__builtin_amdgcn_s_getreg((3 << 11) | 20) & 0xFu; }
#define XB_SPIN(cond, bar) do { unsigned _sp = 0; while (cond) { __builtin_amdgcn_s_sleep(1); \
    if ((++_sp & 255u) == 0u) { if (xb_ld(&(bar)[XB_TMO])) break; if (_sp > XB_SPIN_CAP) { atomicAdd(&(bar)[XB_TMO], 1u); break; } } } } while (0)

struct XcdBarrier {
    unsigned* bar; unsigned x;
    volatile LAS unsigned* st;
};

__device__ __forceinline__ XcdBarrier xcd_barrier_post(unsigned* bar, volatile LAS unsigned* st, const int tid) {
    XcdBarrier b; b.bar = bar; b.x = xb_xcc_id(); b.st = st;
    if (tid == 0) (void)xb_add(&bar[XB_XCNT(b.x)], 1u);
    return b;
}
__device__ __forceinline__ void xcd_barrier_complete(unsigned* bar, unsigned x, unsigned& nloc, unsigned& nx) {
    const unsigned G = gridDim.x * gridDim.y * gridDim.z;
    unsigned sum, cnt, mine, sp = 0u;
    for (;;) {
        sum = 0u; cnt = 0u; mine = 0u;
#pragma unroll
        for (unsigned j = 0; j < 16; ++j) { const unsigned c = xb_ld(&bar[XB_XCNT(j)]); sum += c; cnt += (c > 0u) ? 1u : 0u; mine = (j == x) ? c : mine; }
        if (sum == G) break;
        __builtin_amdgcn_s_sleep(1);
        if ((++sp & 255u) == 0u) { if (xb_ld(&bar[XB_TMO])) break; if (sp > XB_SPIN_CAP) { atomicAdd(&bar[XB_TMO], 1u); break; } }
    }
    nloc = mine > 0u ? mine : 1u; nx = cnt > 0u ? cnt : 1u;
}

__device__ __forceinline__ void xcd_barrier(const XcdBarrier& b, const int tid) {
    asm volatile("s_waitcnt vmcnt(0)" ::: "memory");
    __syncthreads();
    if (tid == 0) {
        unsigned* bar = b.bar;
        __builtin_amdgcn_s_waitcnt(0);
        unsigned nloc = b.st[0], nx = b.st[1];
        if (nloc == 0u) { xcd_barrier_complete(bar, b.x, nloc, nx); b.st[0] = nloc; b.st[1] = nx; }
        const unsigned old = xb_add(&bar[XB_XSUB(b.x)], 1u);
        const unsigned gen = old / nloc;
        if (old + 1u == (gen + 1u) * nloc) {
            __builtin_amdgcn_fence(__ATOMIC_RELEASE, "agent");
            asm volatile("s_waitcnt vmcnt(0)" ::: "memory");
            const unsigned og = xb_add(&bar[XB_TOP], 1u);
            const unsigned tg = og / nx;
            if (og + 1u == (tg + 1u) * nx) xb_add(&bar[XB_TOPGEN], 1u);
            else XB_SPIN(xb_ld(&bar[XB_TOPGEN]) == tg, bar);
            __builtin_amdgcn_fence(__ATOMIC_ACQUIRE, "agent");
            xb_add(&bar[XB_XGEN(b.x)], 1u);
            asm volatile("s_waitcnt vmcnt(0)" ::: "memory");
        } else {
            XB_SPIN(xb_ld(&bar[XB_XGEN(b.x)]) == gen, bar);
            __builtin_amdgcn_fence(__ATOMIC_ACQUIRE, "agent");
            asm volatile("s_waitcnt vmcnt(0)" ::: "memory");
        }
    }
    __syncthreads();
}

constexpr int NWAVES = 8;
constexpr int NTOK = 65536, NH = 32768, DMODEL = 1024, SEQLEN = 4096, INCOLS = 5632, DFF = 2816, NEXP = 8;
constexpr int MOE_PANELS_MAX = 264;
constexpr float EPS_NORM = 1e-6f, EPS_SUBLN = 1e-5f;

constexpr size_t MiB = 1u << 20;
constexpr size_t WS_CTL = 0, CTL_ZERO_BYTES = 1 * MiB;
constexpr size_t WS_WIN = 1 * MiB;
constexpr size_t WS_WGLU = 23 * MiB;
constexpr size_t WS_WPS = 24 * MiB;
constexpr size_t WS_WPA = 26 * MiB;
constexpr size_t WS_WOUT = 30 * MiB;
constexpr size_t WS_WDGU = 34 * MiB;
constexpr size_t WS_WDD = 45 * MiB;
constexpr size_t WS_WMGU = 51 * MiB;
constexpr size_t WS_WMD = 139 * MiB;
constexpr size_t WS_TZF = 183 * MiB;
constexpr size_t WS_EM = 223 * MiB;
constexpr size_t WS_ROPE = 239 * MiB;
constexpr size_t WS_ROUTE = 255 * MiB;
constexpr size_t WS_ACT = 260 * MiB;
constexpr size_t WS_END = 960 * MiB;
constexpr size_t A_HB = 0, A_UBUF = 64 * MiB, A_SLOC = 104 * MiB, A_Q = 120 * MiB, A_K = 184 * MiB, A_V = 248 * MiB, A_SGS = 312 * MiB, A_SGA = 376 * MiB, A_YA = 440 * MiB, A_YA2 = 472 * MiB, A_OV = 504 * MiB, A_YB = 632 * MiB;
constexpr size_t A_H2 = 0, A_FA = 64 * MiB;
constexpr size_t A_H2M = 632 * MiB, A_H2G = 0, A_AG = 132 * MiB, A_YG = 0;
constexpr size_t A_XB = 504 * MiB;
static_assert(A_UBUF == pg8::EA_U && A_Q == pg8::EA_Q && A_K == pg8::EA_K && A_V == pg8::EA_V && A_SGS == pg8::EA_SGS && A_SGA == pg8::EA_SGA, "EpiIn offsets");
static_assert(A_YB + 64 * MiB <= WS_END - WS_ACT && A_YA2 + 32 * MiB <= A_XB && A_XB + 128 * MiB <= A_YB && A_AG + 363 * MiB <= A_XB && A_H2G + 132 * MiB <= A_AG && A_H2M >= A_XB + 128 * MiB && A_H2M + 64 * MiB <= WS_END - WS_ACT && A_FA + 176 * MiB <= A_XB, "act map");
constexpr size_t R_E = 0, R_W = 256 * 1024, R_S = 512 * 1024, R_CNT = 768 * 1024;
constexpr int CW_BAR = 4096;

constexpr int RING_OFF = 0, RING_BYTES = 131072;
constexpr int LDSCTL_OFF = RING_BYTES, MISC_OFF = LDSCTL_OFF + 320;
constexpr int LDS_BYTES = 147456;

constexpr int PTR_OFF = LDSCTL_OFF + 1024;
struct Args { const void* in[31]; float* out; unsigned char* ws; };
__device__ __forceinline__ unsigned long long ldp64(LAS unsigned char* L, int slot) {
    const unsigned long long v = ((volatile LAS unsigned long long*)(L + PTR_OFF))[slot];
    const unsigned lo = __builtin_amdgcn_readfirstlane((unsigned)v), hi = __builtin_amdgcn_readfirstlane((unsigned)(v >> 32));
    return ((unsigned long long)hi << 32) | lo;
}
#define LDP(T, slot) ((T*)(GAS T*)(uintptr_t)ldp64(L, (slot)))

#define SWZ_XOR(k) (((k) << 10) | 0x1f)
#define swz_xor(v, pat) __builtin_bit_cast(float, __builtin_amdgcn_ds_swizzle(__builtin_bit_cast(int, (float)(v)), (pat)))
__device__ __forceinline__ float wave_sum(float v) {
#define WS_DPP(x, ctrl) __builtin_bit_cast(float, __builtin_amdgcn_update_dpp(0, __builtin_bit_cast(int, (float)(x)), (ctrl), 0xf, 0xf, false))
    v += WS_DPP(v, 0xB1); v += WS_DPP(v, 0x4E); v += WS_DPP(v, 0x141); v += WS_DPP(v, 0x140);
#undef WS_DPP
    const float r0 = __builtin_bit_cast(float, __builtin_amdgcn_readlane(__builtin_bit_cast(int, v), 0)), r1 = __builtin_bit_cast(float, __builtin_amdgcn_readlane(__builtin_bit_cast(int, v), 16));
    const float r2 = __builtin_bit_cast(float, __builtin_amdgcn_readlane(__builtin_bit_cast(int, v), 32)), r3 = __builtin_bit_cast(float, __builtin_amdgcn_readlane(__builtin_bit_cast(int, v), 48));
    return (r0 + r1) + (r2 + r3);
}
__device__ __forceinline__ void tr_item(const float* W, int ldw, int K, bf16* WTn0, int k0, int srccol, LAS float* scr, int lane) {
    float wv[32];
#pragma unroll
    for (int i = 0; i < 32; ++i) wv[i] = W[(size_t)(k0 + 2 * i + (lane >> 5)) * ldw + srccol];
#pragma unroll
    for (int i = 0; i < 32; ++i) scr[(2 * i + (lane >> 5)) * 33 + (lane & 31)] = wv[i];
    LDS_WAIT(); asm volatile("" ::: "memory");
    const int c = lane & 7;
#pragma unroll
    for (int j = 0; j < 4; ++j) { const int n = (lane >> 3) + 8 * j; const LAS float* s = scr + (8 * c) * 33 + n;
        v4u o; o.x = pk2(s[0 * 33], s[1 * 33]); o.y = pk2(s[2 * 33], s[3 * 33]); o.z = pk2(s[4 * 33], s[5 * 33]); o.w = pk2(s[6 * 33], s[7 * 33]);
        *(GAS v4u*)(WTn0 + (size_t)n * K + k0 + 8 * c) = o; }
    LDS_WAIT(); asm volatile("" ::: "memory");
}
__device__ __forceinline__ int win_orig(int n) { if (n < 512 || n >= 2560) return n; const int i = n & 63; return (n & ~63) + 16 * ((i >> 5) & 1) + 4 * ((i >> 3) & 3) + (i & 3) + 32 * ((i >> 2) & 1); }
__device__ __forceinline__ void tr_plain(const float* W, int K, int N, bf16* WT, int item, LAS float* scr, int lane) {
    const int nblk = N / 32, kb = item / nblk, nb = item % nblk;
    tr_item(W, N, K, WT + (size_t)(32 * nb) * K, 64 * kb, 32 * nb + (lane & 31), scr, lane);
}
__device__ __forceinline__ void tr_win(const float* W, bf16* WT, int item, LAS float* scr, int lane) {
    const int nblk = INCOLS / 32, kb = item / nblk, nb = item % nblk;
    tr_item(W, INCOLS, DMODEL, WT + (size_t)(32 * nb) * DMODEL, 64 * kb, win_orig(32 * nb + (lane & 31)), scr, lane);
}
__device__ __forceinline__ void tr_gu(const float* Wg, const float* Wu, bf16* WT, int item, LAS float* scr, int lane) {
    const int nblk = INCOLS / 32, kb = item / nblk, nb = item % nblk; const int n0 = 32 * nb, pn = n0 >> 8, r = n0 & 255;
    const float* W = r < 128 ? Wg : Wu; const int col = pn * 128 + (r & 127) + (lane & 31);
    tr_item(W, DFF, DMODEL, WT + (size_t)n0 * DMODEL, 64 * kb, col, scr, lane);
}
struct S5In { const float *lam_re, *lam_im, *log_dt, *b_re, *b_im, *c_re, *c_im, *dd; };
__device__ __forceinline__ v4u pack8f(const float* v) { v4u o; o.x = pk2(v[0], v[1]); o.y = pk2(v[2], v[3]); o.z = pk2(v[4], v[5]); o.w = pk2(v[6], v[7]); return o; }
__device__ __forceinline__ void s5_item(LAS unsigned char* L, int tid, const S5In& P, int lg, int d, bf16* TZF, bf16* EM) {
    LAS float* sm = (LAS float*)(L);
    LAS float *s_fr = sm, *s_fi = sm + 64, *s_apr = sm + 128, *s_api = sm + 192, *BBr = sm + 256, *BBi = sm + 1280, *CAr = sm + 2304, *CAi = sm + 3328, *Kd = sm + 4352;
    if (tid < 64) {
        const int p = tid;
        const float dt = expf(P.log_dt[lg]);
        const float lr = P.lam_re[lg * 64 + p], li = P.lam_im[lg * 64 + p];
        const float mag = expf(lr * dt); float sn, cs; sincosf(li * dt, &sn, &cs);
        const float ar = mag * cs, ai = mag * sn;
        const float den = lr * lr + li * li, nr = ar - 1.0f, ni = ai;
        s_fr[p] = (nr * lr + ni * li) / den; s_fi[p] = (ni * lr - nr * li) / den;
        const float fd = (float)d; const float magd = expf(fd * lr * dt); float snd, csd; sincosf(fd * li * dt, &snd, &csd);
        s_apr[p] = magd * csd; s_api[p] = magd * snd;
    }
    __syncthreads();
    for (int idx = tid; idx < 1024; idx += 512) {
        { const int p = idx >> 4; const float br = P.b_re[(size_t)lg * 1024 + idx], bi = P.b_im[(size_t)lg * 1024 + idx]; const float fr_ = s_fr[p], fi_ = s_fi[p];
          BBr[idx] = fr_ * br - fi_ * bi; BBi[idx] = fr_ * bi + fi_ * br; }
        { const int p = idx & 63; const float cr = P.c_re[(size_t)lg * 1024 + idx], ci = P.c_im[(size_t)lg * 1024 + idx]; const float ar_ = s_apr[p], ai_ = s_api[p];
          CAr[idx] = cr * ar_ - ci * ai_; CAi[idx] = cr * ai_ + ci * ar_; }
    }
    __syncthreads();
    if (d <= 31 && tid < 256) { const int j = tid >> 4, jp = tid & 15; float acc = 0.f;
        for (int p = 0; p < 64; ++p) acc += CAr[j * 64 + p] * BBr[p * 16 + jp] - CAi[j * 64 + p] * BBi[p * 16 + jp];
        if (d == 0 && j == jp) acc += P.dd[lg * 16 + j];
        Kd[tid] = acc; }
    __syncthreads();
    bf16* TZ = TZF + (size_t)lg * 512 * 640; bf16* EE = EM + (size_t)lg * 256 * 512;
    if (d <= 31) {
        const int cnt = (32 - d) * 16;
        for (int idx = tid; idx < cnt; idx += 512) { const int tt = idx >> 4, j = idx & 15; float v[16];
#pragma unroll
            for (int q = 0; q < 16; ++q) v[q] = Kd[j * 16 + q];
            bf16* dst = TZ + (size_t)((d + tt) * 16 + j) * 640 + tt * 16;
            *(GAS v4u*)dst = pack8f(v); *(GAS v4u*)(dst + 8) = pack8f(v + 8);
            if (d >= 1) { bf16* dz = TZ + (size_t)(tt * 16 + j) * 640 + (d + tt) * 16; const v4u z = {0u, 0u, 0u, 0u}; *(GAS v4u*)dz = z; *(GAS v4u*)(dz + 8) = z; } }
        if (tid < 128) { const int ri = tid >> 6, p = tid & 63; const float ar_ = s_apr[p], ai_ = s_api[p]; float v[16];
#pragma unroll
            for (int q = 0; q < 16; ++q) { const float br = BBr[p * 16 + q], bi = BBi[p * 16 + q]; v[q] = ri == 0 ? (ar_ * br - ai_ * bi) : (ar_ * bi + ai_ * br); }
            bf16* dst = EE + (size_t)tid * 512 + (31 - d) * 16; *(GAS v4u*)dst = pack8f(v); *(GAS v4u*)(dst + 8) = pack8f(v + 8);
        } else if (tid < 256) { bf16* dz = EE + (size_t)tid * 512 + (31 - d) * 16; const v4u z = {0u, 0u, 0u, 0u}; *(GAS v4u*)dz = z; *(GAS v4u*)(dz + 8) = z; }
    }
    if (d >= 1 && tid < 256) { const int j = tid >> 4, ri = (tid >> 3) & 1, pc = tid & 7; float v[8];
#pragma unroll
        for (int q = 0; q < 8; ++q) v[q] = ri == 0 ? CAr[j * 64 + pc * 8 + q] : -CAi[j * 64 + pc * 8 + q];
        *(GAS v4u*)(TZ + (size_t)((d - 1) * 16 + j) * 640 + 512 + ri * 64 + pc * 8) = pack8f(v); }
    __syncthreads();
}
__device__ __forceinline__ void norm_rows4(const float* x0, size_t xstep, const f32x4 (&g)[4], bf16* o0, size_t ostep, int lane) {
    f32x4 h[4][4];
#pragma unroll
    for (int r = 0; r < 4; ++r) { const GAS f32x4* xr = (const GAS f32x4*)(x0 + r * xstep) + lane;
#pragma unroll
        for (int j = 0; j < 4; ++j) h[r][j] = xr[64 * j]; }
#pragma unroll
    for (int r = 0; r < 4; ++r) { float s2 = 0.f;
#pragma unroll
        for (int j = 0; j < 4; ++j) s2 += (h[r][j].x * h[r][j].x + h[r][j].y * h[r][j].y) + (h[r][j].z * h[r][j].z + h[r][j].w * h[r][j].w);
        const float rs = 1.0f / sqrtf(wave_sum(s2) * (1.0f / DMODEL) + EPS_NORM);
        GAS unsigned long long* o8 = (GAS unsigned long long*)(o0 + r * ostep) + lane;
#pragma unroll
        for (int j = 0; j < 4; ++j) { const f32x4 v = h[r][j] * rs * g[j]; o8[64 * j] = (unsigned long long)pk2(v.x, v.y) | ((unsigned long long)pk2(v.z, v.w) << 32); } }
}
__device__ __forceinline__ f32x4 bf4_f32(unsigned long long a) { const unsigned lo = (unsigned)a, hi = (unsigned)(a >> 32); f32x4 r; r.x = __uint_as_float(lo << 16); r.y = __uint_as_float(lo & 0xffff0000u); r.z = __uint_as_float(hi << 16); r.w = __uint_as_float(hi & 0xffff0000u); return r; }
__device__ __forceinline__ void norm_rows4b(const bf16* x0, size_t xstep, const f32x4 (&g)[4], bf16* o0, size_t ostep, int lane) {
    unsigned long long hb[4][4];
#pragma unroll
    for (int r = 0; r < 4; ++r) { const GAS unsigned long long* xr = (const GAS unsigned long long*)(x0 + r * xstep) + lane;
#pragma unroll
        for (int j = 0; j < 4; ++j) hb[r][j] = xr[64 * j]; }
#pragma unroll
    for (int r = 0; r < 4; ++r) { float s2 = 0.f; f32x4 h[4];
#pragma unroll
        for (int j = 0; j < 4; ++j) { h[j] = bf4_f32(hb[r][j]); s2 += (h[j].x * h[j].x + h[j].y * h[j].y) + (h[j].z * h[j].z + h[j].w * h[j].w); }
        const float rs = 1.0f / sqrtf(wave_sum(s2) * (1.0f / DMODEL) + EPS_NORM);
        GAS unsigned long long* o8 = (GAS unsigned long long*)(o0 + r * ostep) + lane;
#pragma unroll
        for (int j = 0; j < 4; ++j) { const f32x4 v = h[j] * rs * g[j]; o8[64 * j] = (unsigned long long)pk2(v.x, v.y) | ((unsigned long long)pk2(v.z, v.w) << 32); } }
}
__device__ __forceinline__ void norm_row(const float* xrow, const float* gain, bf16* orow, int lane, f32x4 (&hn)[4]) {
    const GAS f32x4* xr = (const GAS f32x4*)xrow + lane; const GAS f32x4* gr = (const GAS f32x4*)gain + lane;
    float s2 = 0.f;
#pragma unroll
    for (int j = 0; j < 4; ++j) { hn[j] = xr[64 * j]; s2 += (hn[j].x * hn[j].x + hn[j].y * hn[j].y) + (hn[j].z * hn[j].z + hn[j].w * hn[j].w); }
    const float rs = 1.0f / sqrtf(wave_sum(s2) * (1.0f / DMODEL) + EPS_NORM);
    GAS unsigned long long* o8 = (GAS unsigned long long*)orow + lane;
#pragma unroll
    for (int j = 0; j < 4; ++j) { const f32x4 g = gr[64 * j]; hn[j] = hn[j] * rs * g;
        o8[64 * j] = (unsigned long long)pk2(hn[j].x, hn[j].y) | ((unsigned long long)pk2(hn[j].z, hn[j].w) << 32); }
}

__global__ void __launch_bounds__(NWAVES * 64, 2) trunk_fwd(Args args) {
    extern __shared__ __attribute__((aligned(16))) unsigned char lds[];
    const int WAVE = __builtin_amdgcn_readfirstlane((int)threadIdx.x >> 6);
#define MYTID() ({ int l_; asm volatile("v_mbcnt_lo_u32_b32 %0, -1, 0\n\tv_mbcnt_hi_u32_b32 %0, -1, %0" : "=v"(l_)); WAVE * 64 + l_; })
    LAS unsigned char* const L0 = (LAS unsigned char*)lds;
#define OPQ LAS unsigned char* L = L0; asm volatile("" : "+s"(L))
    OPQ;
    {
        const int tid0 = MYTID();
        for (int u = tid0; u < (LDS_BYTES - LDSCTL_OFF) / 4; u += NWAVES * 64) ((LAS unsigned*)(L + LDSCTL_OFF))[u] = 0u;
        __syncthreads();
        if (tid0 == 0) {
#pragma unroll
            for (int k = 0; k < 31; ++k) ((LAS unsigned long long*)(L + PTR_OFF))[k] = (unsigned long long)(uintptr_t)args.in[k];
            ((LAS unsigned long long*)(L + PTR_OFF))[31] = (unsigned long long)(uintptr_t)args.out;
            ((LAS unsigned long long*)(L + PTR_OFF))[32] = (unsigned long long)(uintptr_t)args.ws; }
        __syncthreads();
    }
    { XcdBarrier b0 = xcd_barrier_post((unsigned*)(LDP(unsigned char, 32) + WS_CTL) + CW_BAR, (volatile LAS unsigned*)(L + MISC_OFF) + 8, MYTID()); (void)b0; }
#define GRID_BAR() do { OPQ; XcdBarrier b_; b_.bar = (unsigned*)(LDP(unsigned char, 32) + WS_CTL) + CW_BAR; b_.x = xb_xcc_id(); b_.st = (volatile LAS unsigned*)(L + MISC_OFF) + 8; xcd_barrier(b_, MYTID()); } while (0)
#define LQ() ({ int l_ = l; asm volatile("" : "+s"(l_)); l_; })
#define TID_SETUP OPQ; int wave_ = WAVE; asm volatile("" : "+s"(wave_)); const int wave = wave_; const int tid = MYTID(), lane = tid & 63; const int G = gridDim.x; const int vcu = ((int)blockIdx.x % 8) * (G / 8) + (int)blockIdx.x / 8; const int gw = vcu * NWAVES + wave, NGW = G * NWAVES; (void)lane; (void)gw; (void)NGW; (void)tid
#define WSP(T, off) ((T*)(LDP(unsigned char, 32) + (off)))
#define ACTP(T, off) ((T*)(LDP(unsigned char, 32) + WS_ACT + (off)))

    {
        TID_SETUP;
        LAS float* scr = (LAS float*)(L + RING_OFF + wave * 16384);
        constexpr int I_WIN = 16 * 176, I_GLU = 8 * 16, I_PS = 8 * 32, I_PA = 16 * 32, I_OUT = 16 * 32, I_GU = 16 * 176, I_DN = 44 * 32;
        constexpr int I_LAYER = I_WIN + I_GLU + I_PS + I_PA + I_OUT;
        constexpr int NITEMS = 2 * I_LAYER + I_GU + I_DN + 8 * I_GU + 8 * I_DN;
        for (int it = gw; it < NITEMS; it += NGW) {
            int r = it;
            if (r < 2 * I_LAYER) { const int l = r / I_LAYER; r -= l * I_LAYER;
                if (r < I_WIN) { tr_win(LDP(const float, 3) + (size_t)l * DMODEL * INCOLS, WSP(bf16, WS_WIN) + (size_t)l * INCOLS * DMODEL, r, scr, lane); continue; } r -= I_WIN;
                if (r < I_GLU) { tr_plain(LDP(const float, 12) + (size_t)l * 512 * 512, 512, 512, WSP(bf16, WS_WGLU) + (size_t)l * 512 * 512, r, scr, lane); continue; } r -= I_GLU;
                if (r < I_PS) { tr_plain(LDP(const float, 19) + (size_t)l * 512 * 1024, 512, 1024, WSP(bf16, WS_WPS) + (size_t)l * 1024 * 512, r, scr, lane); continue; } r -= I_PS;
                if (r < I_PA) { tr_plain(LDP(const float, 20) + (size_t)l * 1024 * 1024, 1024, 1024, WSP(bf16, WS_WPA) + (size_t)l * 1024 * 1024, r, scr, lane); continue; } r -= I_PA;
                tr_plain(LDP(const float, 21) + (size_t)l * 1024 * 1024, 1024, 1024, WSP(bf16, WS_WOUT) + (size_t)l * 1024 * 1024, r, scr, lane); continue; }
            r -= 2 * I_LAYER;
            if (r < I_GU) { tr_gu(LDP(const float, 23), LDP(const float, 24), WSP(bf16, WS_WDGU), r, scr, lane); continue; } r -= I_GU;
            if (r < I_DN) { tr_plain(LDP(const float, 25), DFF, DMODEL, WSP(bf16, WS_WDD), r, scr, lane); continue; } r -= I_DN;
            if (r < 8 * I_GU) { const int e = r / I_GU; r -= e * I_GU; tr_gu(LDP(const float, 27) + (size_t)e * DMODEL * DFF, LDP(const float, 28) + (size_t)e * DMODEL * DFF, WSP(bf16, WS_WMGU) + (size_t)e * INCOLS * DMODEL, r, scr, lane); continue; } r -= 8 * I_GU;
            { const int e = r / I_DN; r -= e * I_DN; tr_plain(LDP(const float, 29) + (size_t)e * DFF * DMODEL, DFF, DMODEL, WSP(bf16, WS_WMD) + (size_t)e * DMODEL * DFF, r, scr, lane); }
        }
        __syncthreads();
        { S5In s5p; s5p.lam_re = LDP(const float, 4); s5p.lam_im = LDP(const float, 5); s5p.log_dt = LDP(const float, 6); s5p.b_re = LDP(const float, 7); s5p.b_im = LDP(const float, 8);
          s5p.c_re = LDP(const float, 9); s5p.c_im = LDP(const float, 10); s5p.dd = LDP(const float, 11);
          for (int it = vcu; it < 2 * 32 * 33; it += G) s5_item(L, tid, s5p, it / 33, it % 33, WSP(bf16, WS_TZF), WSP(bf16, WS_EM)); }
        { const int* positions = LDP(const int, 1); float* ROPE = WSP(float, WS_ROPE);
          for (int idx = vcu * (NWAVES * 64) + tid; idx < NTOK * 32; idx += G * NWAVES * 64) { const int n = idx >> 5, fi = idx & 31;
            const float invf = powf(10000.0f, -(float)(2 * fi) / 64.0f); const float ang = (float)positions[n] * invf; float sn, cs; sincosf(ang, &sn, &cs);
            ROPE[(size_t)n * 64 + fi] = cs; ROPE[(size_t)n * 64 + 32 + fi] = sn; } }
    }
    GRID_BAR();

    for (int l = 0; l < 2; ++l) {
        for (int half = 0; half < 2; ++half) {
            const int tokbase = half * NH;
            { TID_SETUP; const float* xsrc = LDP(const float, 0); const bf16* XB = ACTP(const bf16, A_XB); const float* gain = LDP(const float, 2) + l * DMODEL; bf16* HB = ACTP(bf16, A_HB);
              f32x4 gq[4];
#pragma unroll
              for (int j = 0; j < 4; ++j) gq[j] = ((const GAS f32x4*)gain + lane)[64 * j];
              if (LQ() == 0) { for (int m = gw; m < NH; m += 4 * NGW) norm_rows4(xsrc + (size_t)(tokbase + m) * DMODEL, (size_t)NGW * DMODEL, gq, HB + (size_t)m * DMODEL, (size_t)NGW * DMODEL, lane); }
              else { for (int m = gw; m < NH; m += 4 * NGW) norm_rows4b(XB + (size_t)(tokbase + m) * DMODEL, (size_t)NGW * DMODEL, gq, HB + (size_t)m * DMODEL, (size_t)NGW * DMODEL, lane); } }
            GRID_BAR();
            { OPQ; pg8::Gemm g{ACTP(bf16, A_HB), WSP(bf16, WS_WIN) + (size_t)l * INCOLS * DMODEL, DMODEL, DMODEL, DMODEL}; pg8::SchedPlain S; S.init(NH / 256, INCOLS / 256, gridDim.x, (int)blockIdx.x);
              pg8::EpiIn E{ACTP(unsigned char, 0), WSP(const float, WS_ROPE), tokbase};
              pg8::gemm_phase<pg8::EpiIn, pg8::SchedPlain, true, true>(L0 + RING_OFF, g, S, E, MYTID()); }
            GRID_BAR();
            { OPQ; pg8::Gemm g{ACTP(bf16, A_UBUF), WSP(bf16, WS_EM) + (size_t)l * 32 * 256 * 512, 640, 512, 512}; pg8::SchedS5 S; S.init(1, gridDim.x, (int)blockIdx.x);
              pg8::EpiSloc E{ACTP(float, A_SLOC)};
              pg8::gemm_phase<pg8::EpiSloc, pg8::SchedS5, true, true>(L0 + RING_OFF, g, S, E, MYTID()); }
            GRID_BAR();
            { TID_SETUP;
              if (wave == 0) {
                const int id = vcu * 64 + lane;
                if (id < 8 * 32 * 64) { const int bl = id >> 11, g = (id >> 6) & 31, p = id & 63; const int lg = l * 32 + g;
                    const float dt = expf(LDP(const float, 6)[lg]); const float lr = LDP(const float, 4)[lg * 64 + p], li = LDP(const float, 5)[lg * 64 + p];
                    const float magT = expf(32.0f * lr * dt); float snT, csT; sincosf(32.0f * li * dt, &snT, &csT); const float aTr = magT * csT, aTi = magT * snT;
                    float sr = 0.f, si = 0.f; const size_t row0 = (size_t)g * 1024 + (size_t)bl * 128;
                    const float* sl = ACTP(const float, A_SLOC) + row0 * 128 + p; bf16* ub = ACTP(bf16, A_UBUF) + row0 * 640 + 512 + p;
                    for (int c0 = 0; c0 < 128; c0 += 8) { float lr_[8], li_[8];
#pragma unroll
                        for (int q = 0; q < 8; ++q) { lr_[q] = sl[(size_t)(c0 + q) * 128]; li_[q] = sl[(size_t)(c0 + q) * 128 + 64]; }
#pragma unroll
                        for (int q = 0; q < 8; ++q) { ub[(size_t)(c0 + q) * 640] = (bf16)f2bf(sr); ub[(size_t)(c0 + q) * 640 + 64] = (bf16)f2bf(si);
                            const float nr_ = aTr * sr - aTi * si + lr_[q], ni_ = aTr * si + aTi * sr + li_[q]; sr = nr_; si = ni_; } } }
              } }
            GRID_BAR();
            { OPQ; pg8::Gemm g{ACTP(bf16, A_UBUF), WSP(bf16, WS_TZF) + (size_t)l * 32 * 512 * 640, 640, 640, 640}; pg8::SchedS5 S; S.init(2, gridDim.x, (int)blockIdx.x);
              pg8::EpiYa E{ACTP(bf16, A_YA)};
              pg8::gemm_phase<pg8::EpiYa, pg8::SchedS5, true, true>(L0 + RING_OFF, g, S, E, MYTID()); }
            GRID_BAR();
            { OPQ; pg8::Gemm g{ACTP(bf16, A_YA), WSP(bf16, WS_WGLU) + (size_t)l * 512 * 512, 512, 512, 512}; pg8::SchedPlain S; S.init(NH / 256, 2, gridDim.x, (int)blockIdx.x);
              pg8::EpiGlu E{ACTP(bf16, A_YA), ACTP(bf16, A_YA2), LDP(const float, 13) + l * 512};
              pg8::gemm_phase<pg8::EpiGlu, pg8::SchedPlain, true, true>(L0 + RING_OFF, g, S, E, MYTID()); }
            GRID_BAR();
            {
                TID_SETUP;
                int lq = l; asm volatile("" : "+s"(lq));
                const float lam_init = 0.8f - 0.6f * expf(-0.3f * (float)lq);
                const float p1 = wave_sum(LDP(const float, 14)[lq * 64 + lane] * LDP(const float, 15)[lq * 64 + lane]), p2 = wave_sum(LDP(const float, 16)[lq * 64 + lane] * LDP(const float, 17)[lq * 64 + lane]);
                float lam_v = expf(p1) - expf(p2) + lam_init, gsc_v = 1.0f - lam_init; asm volatile("" : "+v"(lam_v), "+v"(gsc_v));
                const int lam_i = __builtin_amdgcn_readfirstlane(__builtin_bit_cast(int, lam_v)), gsc_i = __builtin_amdgcn_readfirstlane(__builtin_bit_cast(int, gsc_v));
                const float lam = __builtin_bit_cast(float, lam_i), gsc = __builtin_bit_cast(float, gsc_i);
                for (int i = 0; i < 8; ++i) {
                    OPQ; const int bh = (i >> 1) * 16 + (vcu >> 4); const int j = vcu & 15; const int qblk = (i & 1) ? 31 - j : j;
                    const int b = bh >> 3, h = bh & 7; const size_t rb = (size_t)b * SEQLEN;
                    attn_body::dattn2_unit<8>(qblk, (const attn_body::bf16*)(ACTP(bf16, A_Q) + rb * 1024 + h * 128), (const attn_body::bf16*)(ACTP(bf16, A_K) + rb * 1024 + h * 128),
                                             (const attn_body::bf16*)(ACTP(bf16, A_V) + rb * 1024 + h * 128), (attn_body::bf16*)(ACTP(bf16, A_YB) + rb * 1024 + h * 128),
                                             lam, LDP(const float, 18) + lq * 128, gsc, (char*)lds + RING_OFF, MYTID());
                }
            }
            GRID_BAR();
            { OPQ; pg8::Gemm g{ACTP(bf16, A_YA2), WSP(bf16, WS_WPS) + (size_t)l * 1024 * 512, 512, 512, 512}; pg8::SchedPlain S; S.init(NH / 256, 4, gridDim.x, (int)blockIdx.x);
              pg8::EpiGate<0> E{ACTP(bf16, A_SGS), nullptr};
              pg8::gemm_phase<pg8::EpiGate<0>, pg8::SchedPlain, true, true>(L0 + RING_OFF, g, S, E, MYTID()); }
            GRID_BAR();
            { OPQ; pg8::Gemm g{ACTP(bf16, A_YB), WSP(bf16, WS_WPA) + (size_t)l * 1024 * 1024, 1024, 1024, 1024}; pg8::SchedPlain S; S.init(NH / 256, 4, gridDim.x, (int)blockIdx.x);
              pg8::EpiGate<1> E{ACTP(bf16, A_SGA), ACTP(bf16, A_SGS)};
              pg8::gemm_phase<pg8::EpiGate<1>, pg8::SchedPlain, true, true>(L0 + RING_OFF, g, S, E, MYTID()); }
            GRID_BAR();
            { OPQ; pg8::Gemm g{ACTP(bf16, A_SGA), WSP(bf16, WS_WOUT) + (size_t)l * 1024 * 1024, 1024, 1024, 1024}; pg8::SchedPlain S; S.init(NH / 256, 4, gridDim.x, (int)blockIdx.x);
              pg8::EpiRes E{(LQ() == 0) ? LDP(const float, 0) : (const float*)nullptr, ACTP(bf16, A_XB), tokbase};
              pg8::gemm_phase<pg8::EpiRes, pg8::SchedPlain, true, true>(L0 + RING_OFF, g, S, E, MYTID()); }
            GRID_BAR();
            if (LQ() == 0) {
                { TID_SETUP; const bf16* xs = ACTP(const bf16, A_XB); const float* gain = LDP(const float, 22); bf16* H2 = ACTP(bf16, A_H2);
                  f32x4 gq[4];
#pragma unroll
                  for (int j = 0; j < 4; ++j) gq[j] = ((const GAS f32x4*)gain + lane)[64 * j];
                  for (int m = gw; m < NH; m += 4 * NGW) norm_rows4b(xs + (size_t)(tokbase + m) * DMODEL, (size_t)NGW * DMODEL, gq, H2 + (size_t)m * DMODEL, (size_t)NGW * DMODEL, lane); }
                GRID_BAR();
                { OPQ; pg8::Gemm g{ACTP(bf16, A_H2), WSP(bf16, WS_WDGU), 1024, 1024, 1024}; pg8::SchedPlain S; S.init(NH / 256, 22, gridDim.x, (int)blockIdx.x);
                  pg8::EpiSwi E{ACTP(bf16, A_FA)};
                  pg8::gemm_phase<pg8::EpiSwi, pg8::SchedPlain, true, true>(L0 + RING_OFF, g, S, E, MYTID()); }
                GRID_BAR();
                { OPQ; pg8::Gemm g{ACTP(bf16, A_FA), WSP(bf16, WS_WDD), 2816, 2816, 2816}; pg8::SchedPlain S; S.init(NH / 256, 4, gridDim.x, (int)blockIdx.x);
                  pg8::EpiRes E{(const float*)nullptr, ACTP(bf16, A_XB), tokbase};
                  pg8::gemm_phase<pg8::EpiRes, pg8::SchedPlain, true, true>(L0 + RING_OFF, g, S, E, MYTID()); }
                GRID_BAR();
            } else {
                {
                    TID_SETUP;
                    LAS float* rwT = (LAS float*)(L);
                    LAS unsigned* cntL = (LAS unsigned*)(L + 32768);
                    { const float* router_w = LDP(const float, 26); for (int idx = tid; idx < 8192; idx += NWAVES * 64) { const int k = idx >> 3, e = idx & 7; rwT[e * 1024 + k] = router_w[idx]; } }
                    if (tid < 8) cntL[tid] = 0u;
                    __syncthreads();
                    const bf16* xs = ACTP(const bf16, A_XB); const float* gain = LDP(const float, 22) + DMODEL; bf16* H2 = ACTP(bf16, A_H2M);
                    unsigned* RT_E = WSP(unsigned, WS_ROUTE + R_E); float* RT_W = WSP(float, WS_ROUTE + R_W);
                    f32x4 gq[4];
#pragma unroll
                    for (int j = 0; j < 4; ++j) gq[j] = ((const GAS f32x4*)gain + lane)[64 * j];
                    for (int i2 = 0; i2 < 16; i2 += 4) { f32x4 xv[4][4];
#pragma unroll
                      for (int u = 0; u < 4; ++u) { const GAS unsigned long long* xr = (const GAS unsigned long long*)(xs + (size_t)(tokbase + vcu * 128 + wave * 16 + i2 + u) * DMODEL) + lane;
#pragma unroll
                        for (int j = 0; j < 4; ++j) xv[u][j] = bf4_f32(xr[64 * j]); }
#pragma unroll
                      for (int u = 0; u < 4; ++u) { const int row = vcu * 128 + wave * 16 + i2 + u;
                        f32x4 hn[4]; { float s2 = 0.f;
#pragma unroll
                            for (int j = 0; j < 4; ++j) s2 += (xv[u][j].x * xv[u][j].x + xv[u][j].y * xv[u][j].y) + (xv[u][j].z * xv[u][j].z + xv[u][j].w * xv[u][j].w);
                            const float rs = 1.0f / sqrtf(wave_sum(s2) * (1.0f / DMODEL) + EPS_NORM);
                            GAS unsigned long long* o8 = (GAS unsigned long long*)(H2 + (size_t)row * DMODEL) + lane;
#pragma unroll
                            for (int j = 0; j < 4; ++j) { hn[j] = xv[u][j] * rs * gq[j]; o8[64 * j] = (unsigned long long)pk2(hn[j].x, hn[j].y) | ((unsigned long long)pk2(hn[j].z, hn[j].w) << 32); } }
                        float lg[8];
#pragma unroll
                        for (int e = 0; e < 8; ++e) { float a = 0.f;
#pragma unroll
                            for (int j = 0; j < 4; ++j) { const f32x4 w = *(const LAS f32x4*)(rwT + e * 1024 + 4 * lane + 256 * j); a += (hn[j].x * w.x + hn[j].y * w.y) + (hn[j].z * w.z + hn[j].w * w.w); }
                            lg[e] = wave_sum(a); }
                        if (lane == 0) { int e1 = 0; float v1 = lg[0];
#pragma unroll
                            for (int e = 1; e < 8; ++e) if (lg[e] > v1) { v1 = lg[e]; e1 = e; }
                            int e2 = -1; float v2 = -INFINITY;
#pragma unroll
                            for (int e = 0; e < 8; ++e) if (e != e1 && lg[e] > v2) { v2 = lg[e]; e2 = e; }
                            if (e2 < 0) e2 = (e1 == 0) ? 1 : 0;
                            const float ex = expf(v2 - v1); const float w1 = 1.0f / (1.0f + ex), w2 = ex / (1.0f + ex);
                            RT_E[row] = (unsigned)e1 | ((unsigned)e2 << 8); RT_W[2 * row] = w1; RT_W[2 * row + 1] = w2;
                            __hip_atomic_fetch_add(cntL + e1, 1u, __ATOMIC_RELAXED, __HIP_MEMORY_SCOPE_WORKGROUP); __hip_atomic_fetch_add(cntL + e2, 1u, __ATOMIC_RELAXED, __HIP_MEMORY_SCOPE_WORKGROUP); }
                      }
                    }
                    __syncthreads();
                    if (tid < 8) WSP(unsigned, WS_ROUTE + R_CNT)[vcu * 8 + tid] = cntL[tid];
                }
                GRID_BAR();
                {
                    TID_SETUP;
                    volatile LAS unsigned* MISC = (volatile LAS unsigned*)(L + MISC_OFF);
                    LAS unsigned* tab = (LAS unsigned*)(L);
                    LAS unsigned* tot = (LAS unsigned*)(L + 8192);
                    LAS unsigned* off = (LAS unsigned*)(L + 8192 + 64);
                    LAS unsigned* wcn = (LAS unsigned*)(L + 8192 + 128);
                    LAS unsigned* slt = (LAS unsigned*)(L + 8192 + 512);
                    const unsigned* RT_CNT = WSP(const unsigned, WS_ROUTE + R_CNT); const unsigned* RT_E = WSP(const unsigned, WS_ROUTE + R_E); int* RT_S = WSP(int, WS_ROUTE + R_S);
                    const bf16* H2 = ACTP(const bf16, A_H2M); bf16* H2G = ACTP(bf16, A_H2G);
                    if (tid < 256) { const GAS v4u* src = (const GAS v4u*)(RT_CNT + tid * 8); const v4u a = src[0], b = src[1];
                        tab[tid * 8 + 0] = a.x; tab[tid * 8 + 1] = a.y; tab[tid * 8 + 2] = a.z; tab[tid * 8 + 3] = a.w; tab[tid * 8 + 4] = b.x; tab[tid * 8 + 5] = b.y; tab[tid * 8 + 6] = b.z; tab[tid * 8 + 7] = b.w; }
                    __syncthreads();
                    if (tid < 8) { unsigned t = 0, o = 0; for (int blk = 0; blk < 256; ++blk) { const unsigned c = tab[blk * 8 + tid]; if (blk < vcu) o += c; t += c; } tot[tid] = t; off[tid] = o; }
                    __syncthreads();
                    if (tid == 0) { unsigned sp = 0; for (int e = 0; e < 8; ++e) { MISC[16 + e] = sp; sp += (tot[e] + 255u) >> 8; } MISC[24] = sp; }
                    __syncthreads();
                    int my_e = 0, my_rank = 0;
                    if (tid < 256) { const int row = vcu * 128 + (tid >> 1); const unsigned ee = RT_E[row]; my_e = (tid & 1) ? (int)((ee >> 8) & 255u) : (int)(ee & 255u);
#pragma unroll
                        for (int e = 0; e < 8; ++e) { const unsigned long long mask = __ballot(my_e == e); if (my_e == e) my_rank = __popcll(mask & ((1ull << lane) - 1ull)); if (lane == 0) wcn[wave * 8 + e] = (unsigned)__popcll(mask); } }
                    __syncthreads();
                    if (tid < 256) { unsigned pre = 0; for (int w = 0; w < wave; ++w) pre += wcn[w * 8 + my_e];
                        const unsigned slot = MISC[16 + my_e] * 256u + off[my_e] + pre + (unsigned)my_rank;
                        RT_S[(vcu * 128 + (tid >> 1)) * 2 + (tid & 1)] = (int)slot; slt[tid] = slot; }
                    __syncthreads();
                    for (int i = 0; i < 32; i += 4) { v4u a[4], b[4];
#pragma unroll
                        for (int u = 0; u < 4; ++u) { const int id = wave * 32 + i + u; const GAS v4u* src = (const GAS v4u*)(H2 + (size_t)(vcu * 128 + (id >> 1)) * DMODEL) + lane * 2; a[u] = src[0]; b[u] = src[1]; }
#pragma unroll
                        for (int u = 0; u < 4; ++u) { const unsigned slot = slt[wave * 32 + i + u]; GAS v4u* dst = (GAS v4u*)(H2G + (size_t)slot * DMODEL) + lane * 2; dst[0] = a[u]; dst[1] = b[u]; } }
                    if (vcu < 8) { const unsigned e = (unsigned)vcu; const unsigned r0 = MISC[16 + e] * 256u + tot[e], r1 = MISC[17 + e] * 256u; const v4u z = {0u, 0u, 0u, 0u};
                        for (unsigned r = r0 + (unsigned)wave; r < r1; r += NWAVES) { GAS v4u* dst = (GAS v4u*)(H2G + (size_t)r * DMODEL) + lane * 2; dst[0] = z; dst[1] = z; } }
                }
                GRID_BAR();
#define MOE_SCHED(S, NN) do { volatile LAS unsigned* MISC = (volatile LAS unsigned*)(L + MISC_OFF); S.nn = (NN); \
        S.sp1 = __builtin_amdgcn_readfirstlane((int)MISC[17]); S.sp2 = __builtin_amdgcn_readfirstlane((int)MISC[18]); S.sp3 = __builtin_amdgcn_readfirstlane((int)MISC[19]); S.sp4 = __builtin_amdgcn_readfirstlane((int)MISC[20]); \
        S.sp5 = __builtin_amdgcn_readfirstlane((int)MISC[21]); S.sp6 = __builtin_amdgcn_readfirstlane((int)MISC[22]); S.sp7 = __builtin_amdgcn_readfirstlane((int)MISC[23]); \
        S.so.init(__builtin_amdgcn_readfirstlane((int)MISC[24]), (NN), gridDim.x, (int)blockIdx.x); } while (0)
                { OPQ; pg8::SchedMoe S; MOE_SCHED(S, 22);
                  pg8::Gemm g{ACTP(bf16, A_H2G), WSP(bf16, WS_WMGU), 1024, 1024, 1024}; pg8::EpiSwi E{ACTP(bf16, A_AG)};
                  pg8::gemm_phase<pg8::EpiSwi, pg8::SchedMoe, true, true>(L0 + RING_OFF, g, S, E, MYTID()); }
                GRID_BAR();
                { OPQ; pg8::SchedMoe S; MOE_SCHED(S, 4);
                  pg8::Gemm g{ACTP(bf16, A_AG), WSP(bf16, WS_WMD), 2816, 2816, 2816}; pg8::EpiBf E{ACTP(bf16, A_YG)};
                  pg8::gemm_phase<pg8::EpiBf, pg8::SchedMoe, true, true>(L0 + RING_OFF, g, S, E, MYTID()); }
                GRID_BAR();
                {
                    TID_SETUP;
                    const int* RT_S = WSP(const int, WS_ROUTE + R_S); const float* RT_W = WSP(const float, WS_ROUTE + R_W); float* xo = LDP(float, 31); const bf16* XBc = ACTP(const bf16, A_XB); const bf16* YG = ACTP(const bf16, A_YG);
                    const GAS f32x4* gr = (const GAS f32x4*)LDP(const float, 30) + lane;
                    f32x4 gq[4];
#pragma unroll
                    for (int j = 0; j < 4; ++j) gq[j] = gr[64 * j];
                    for (int m = gw; m < NH; m += 4 * NGW) {
                        int s1[4], s2[4]; float w1[4], w2[4];
#pragma unroll
                        for (int r = 0; r < 4; ++r) { const int mm = m + r * NGW; s1[r] = RT_S[2 * mm]; s2[r] = RT_S[2 * mm + 1]; w1[r] = RT_W[2 * mm]; w2[r] = RT_W[2 * mm + 1]; }
                        f32x4 xa[4][4]; unsigned long long ya[4][4], yb[4][4];
#pragma unroll
                        for (int r = 0; r < 4; ++r) { const GAS unsigned long long* xr = (const GAS unsigned long long*)(XBc + (size_t)(tokbase + m + r * NGW) * DMODEL) + lane;
                            const GAS unsigned long long* y1 = (const GAS unsigned long long*)(YG + (size_t)s1[r] * DMODEL) + lane; const GAS unsigned long long* y2 = (const GAS unsigned long long*)(YG + (size_t)s2[r] * DMODEL) + lane;
#pragma unroll
                            for (int j = 0; j < 4; ++j) { xa[r][j] = bf4_f32(xr[64 * j]); ya[r][j] = y1[64 * j]; yb[r][j] = y2[64 * j]; } }
#pragma unroll
                        for (int r = 0; r < 4; ++r) { float sq = 0.f;
#pragma unroll
                            for (int j = 0; j < 4; ++j) { const unsigned long long a = ya[r][j], b = yb[r][j]; f32x4 x4 = xa[r][j];
                                const unsigned alo = (unsigned)a, ahi = (unsigned)(a >> 32), blo = (unsigned)b, bhi = (unsigned)(b >> 32);
                                x4.x += w1[r] * __uint_as_float(alo << 16) + w2[r] * __uint_as_float(blo << 16); x4.y += w1[r] * __uint_as_float(alo & 0xffff0000u) + w2[r] * __uint_as_float(blo & 0xffff0000u);
                                x4.z += w1[r] * __uint_as_float(ahi << 16) + w2[r] * __uint_as_float(bhi << 16); x4.w += w1[r] * __uint_as_float(ahi & 0xffff0000u) + w2[r] * __uint_as_float(bhi & 0xffff0000u);
                                xa[r][j] = x4; sq += (x4.x * x4.x + x4.y * x4.y) + (x4.z * x4.z + x4.w * x4.w); }
                            const float rs = 1.0f / sqrtf(wave_sum(sq) * (1.0f / DMODEL) + EPS_NORM);
                            GAS f32x4* xw = (GAS f32x4*)(xo + (size_t)(tokbase + m + r * NGW) * DMODEL) + lane;
#pragma unroll
                            for (int j = 0; j < 4; ++j) xw[64 * j] = xa[r][j] * rs * gq[j]; }
                    }
                }
                GRID_BAR();
            }
        }
    }
#undef GRID_BAR
#undef TID_SETUP
#undef LQ
#undef MYTID
#undef OPQ
#undef WSP
#undef ACTP
#undef MOE_SCHED
}

extern "C" void kernel_launch(void* const* d_in, const int* in_sizes, int n_in, void* d_out, int out_size, void* d_ws, size_t ws_size, hipStream_t stream) {
    static int grid = 0;
    if (grid == 0) {
        if (n_in != 31 || in_sizes[0] != NTOK * DMODEL || out_size != NTOK * DMODEL || ws_size < WS_END) {
            fprintf(stderr, "kernel_launch: unexpected shapes: n_in %d in0 %d out %d ws %zu (need %zu); nothing launched\n", n_in, n_in > 0 ? in_sizes[0] : -1, out_size, ws_size, (size_t)WS_END); grid = -1; return; }
        int dev = 0, cus = 0, per_cu = 0;
        if (hipGetDevice(&dev) != hipSuccess || hipDeviceGetAttribute(&cus, hipDeviceAttributeMultiprocessorCount, dev) != hipSuccess) { grid = -1; return; }
        if (hipFuncSetAttribute((const void*)trunk_fwd, hipFuncAttributeMaxDynamicSharedMemorySize, LDS_BYTES) != hipSuccess) { fprintf(stderr, "kernel_launch: hipFuncSetAttribute failed\n"); grid = -1; return; }
        if (hipOccupancyMaxActiveBlocksPerMultiprocessor(&per_cu, (const void*)trunk_fwd, NWAVES * 64, LDS_BYTES) != hipSuccess || per_cu < 1)
            fprintf(stderr, "kernel_launch: note: occupancy query reports %d workgroups per CU\n", per_cu);
        (void)hipGetLastError();
        grid = 256;
        if (cus < 256) { fprintf(stderr, "kernel_launch: device has %d CUs, need 256; nothing launched\n", cus); grid = -1; return; }
    }
    if (grid < 0) return;
    if (hipMemsetAsync((char*)d_ws + WS_CTL, 0, CTL_ZERO_BYTES, stream) != hipSuccess) return;
    Args a{};
    for (int i = 0; i < 31; ++i) a.in[i] = d_in[i];
    a.out = (float*)d_out; a.ws = (unsigned char*)d_ws;
    hipLaunchKernelGGL(trunk_fwd, dim3(grid), dim3(NWAVES * 64), LDS_BYTES, stream, a);
}
```

```cpp
#include <hip/hip_runtime.h>
#include <hip/hip_bf16.h>
#include <cstdio>
#include <cstdint>
#include <cmath>
namespace pg8 {
#define PG8_LAS __attribute__((address_space(3)))
typedef unsigned short bf16_t;
typedef short bf16x8 __attribute__((ext_vector_type(8)));
typedef float f32x4 __attribute__((ext_vector_type(4)));
typedef unsigned u32x4 __attribute__((ext_vector_type(4)));
constexpr int BM = 256, BK = 64, HALF = 128, HTB = HALF * BK * 2  , STAGE_BYTES = 8 * HTB, NXCD = 8, WGM = 8;

__host__ __device__ __forceinline__ int lds_byte(int r, int c) { const int st = (r >> 4) * 2 + (c >> 5), rr = r & 15, cc = c & 31, ob = rr * 64 + cc * 2; return st * 1024 + (ob ^ (((ob >> 9) & 1) << 5)); }
__host__ __device__ __forceinline__ void stage_rc(int b, int& R, int& C) { const int st = b / 1024, sb = b % 1024, swz = sb ^ (((sb >> 9) & 1) << 5); R = (st >> 1) * 16 + swz / 64; C = (st & 1) * 32 + (swz % 64) / 2; }
__host__ __device__ __forceinline__ int perm32(int rho) { const int n = rho >> 4, i = rho & 15; return 8 * (i >> 2) + 4 * n + (i & 3); }

struct Unit { int pm, pn; };
struct Gemm { const bf16_t* A; const bf16_t* Bt; int lda, ldb, K; };

struct StaticOrder {
    int nM, nN, nwg, G, c;
    __host__ __device__ void init(int nM_, int nN_, int G_, int c_) { nM = nM_; nN = nN_; nwg = nM * nN; G = G_; c = c_; }
    __host__ __device__ bool next(int i, Unit& u) const {
        const long L = (long)i * G + c; if (L >= nwg) return false;
        int wgid = (int)L; { const int q = nwg / NXCD, r = nwg % NXCD, xcd = wgid % NXCD, off = wgid / NXCD; wgid = (xcd < r ? xcd * (q + 1) : r * (q + 1) + (xcd - r) * q) + off; }
        const int nig = WGM * nN, gid = wgid / nig, fm = gid * WGM, gsz = (nM - fm) < WGM ? (nM - fm) : WGM;
        u.pm = fm + ((wgid % nig) % gsz); u.pn = (wgid % nig) / gsz; return true;
    }
    __device__ __forceinline__ void a_ready(const Unit&) const {}
    __device__ __forceinline__ void done(const Unit&) const {}
};


struct SchedPlain {
    StaticOrder so;
    __device__ __forceinline__ void init(int nM, int nN, int G, int c) { so.init(nM, nN, G, c); }
    __device__ __forceinline__ bool next(int i, Unit& u) const { return so.next(i, u); }
    __device__ __forceinline__ void a_ready(const Unit&) const {}
    __device__ __forceinline__ void done(const Unit&) const {}
};
struct SchedS5 {
    StaticOrder so; int nng;
    __device__ __forceinline__ void init(int nng_, int G, int c) { nng = nng_; so.init(128, nng_, G, c); }
    __device__ __forceinline__ bool next(int i, Unit& u) const { if (!so.next(i, u)) return false; u.pn = (u.pm >> 2) * nng + u.pn; return true; }
    __device__ __forceinline__ void a_ready(const Unit&) const {}
    __device__ __forceinline__ void done(const Unit&) const {}
};
struct SchedMoe {
    StaticOrder so; int nn; int sp1, sp2, sp3, sp4, sp5, sp6, sp7;
    __device__ __forceinline__ bool next(int i, Unit& u) const {
        if (!so.next(i, u)) return false;
        const int pm = u.pm; const int e = (pm >= sp1) + (pm >= sp2) + (pm >= sp3) + (pm >= sp4) + (pm >= sp5) + (pm >= sp6) + (pm >= sp7);
        u.pn = e * nn + u.pn; return true;
    }
    __device__ __forceinline__ void a_ready(const Unit&) const {}
    __device__ __forceinline__ void done(const Unit&) const {}
};

typedef float f32x2c_t __attribute__((ext_vector_type(2))); typedef __bf16 bf16x2c_t __attribute__((ext_vector_type(2)));
__device__ __forceinline__ unsigned cvt_pk_bf16(float lo, float hi) { f32x2c_t v = {lo, hi}; bf16x2c_t b = __builtin_convertvector(v, bf16x2c_t); return __builtin_bit_cast(unsigned, b); }
__device__ __forceinline__ u32x4 pack8(const f32x4 a, const f32x4 b) { u32x4 w; w.x = cvt_pk_bf16(a[0], a[1]); w.y = cvt_pk_bf16(a[2], a[3]); w.z = cvt_pk_bf16(b[0], b[1]); w.w = cvt_pk_bf16(b[2], b[3]); return w; }
__device__ __forceinline__ void unpack8(const u32x4 w, f32x4& a, f32x4& b) {
    a[0] = __uint_as_float(w.x << 16); a[1] = __uint_as_float(w.x & 0xffff0000u); a[2] = __uint_as_float(w.y << 16); a[3] = __uint_as_float(w.y & 0xffff0000u);
    b[0] = __uint_as_float(w.z << 16); b[1] = __uint_as_float(w.z & 0xffff0000u); b[2] = __uint_as_float(w.w << 16); b[3] = __uint_as_float(w.w & 0xffff0000u); }
__device__ __forceinline__ float sigm(float z) { return __builtin_amdgcn_rcpf(1.0f + __builtin_amdgcn_exp2f(-1.4426950408889634f * z)); }
__device__ __forceinline__ f32x4 sigm4(const f32x4 z) { f32x4 r; r[0] = sigm(z[0]); r[1] = sigm(z[1]); r[2] = sigm(z[2]); r[3] = sigm(z[3]); return r; }
__device__ __forceinline__ float gelu_t(float x) { const float u = 1.5957691216057308f * (x + 0.044715f * x * x * x); return x * sigm(u); }
__device__ __forceinline__ f32x4 gelu4(const f32x4 z) { f32x4 r; r[0] = gelu_t(z[0]); r[1] = gelu_t(z[1]); r[2] = gelu_t(z[2]); r[3] = gelu_t(z[3]); return r; }
constexpr size_t EA_U = (size_t)64 << 20, EA_Q = (size_t)120 << 20, EA_K = (size_t)184 << 20, EA_V = (size_t)248 << 20, EA_SGS = (size_t)312 << 20, EA_SGA = (size_t)376 << 20;
constexpr float QSCALE = 0.125f * 1.4426950408889634f;

struct EpiIn {
    static constexpr bool PERM = true, AFTER_DRAIN = false;
    unsigned char* act; const float* rope; int tokbase;
    __device__ __forceinline__ void operator()(const f32x4 (&acc)[2][2][4][2], const Unit& u, int wr, int wc, int fr_in, int fq_in) const {
        int fr = fr_in, fq = fq_in; asm volatile("" : "+v"(fr), "+v"(fq));
        const int pn = u.pn, rowb = u.pm * BM + wr * 64 + fr, cow = wc * 32 + fq * 8;
        if (pn < 2) {
#pragma unroll
            for (int ai = 0; ai < 2; ++ai)
#pragma unroll
                for (int m = 0; m < 4; ++m) { const int row = rowb + ai * HALF + m * 16;
#pragma unroll
                    for (int bj = 0; bj < 2; ++bj) { const int c = pn * 256 + bj * HALF + cow; const int g = c >> 4, jj = c & 15;
                        bf16_t* dst = (bf16_t*)(act + EA_U) + ((size_t)(g * 1024 + (row >> 5)) * 640 + (row & 31) * 16 + jj);
                        *(u32x4*)dst = pack8(acc[ai][bj][m][0], acc[ai][bj][m][1]); } }
        } else if (pn < 10) {
            const bool isq = pn < 6; bf16_t* base = (bf16_t*)(act + (isq ? EA_Q : EA_K)); const int colt = (isq ? pn - 2 : pn - 6) * 256; const float sc = isq ? QSCALE : 1.0f;
            const int dlo = 16 * (wc & 1) + 4 * fq;
#pragma unroll
            for (int ai = 0; ai < 2; ++ai) { f32x4 csq[4], snq[4];
#pragma unroll
                for (int m = 0; m < 4; ++m) { const float* tr = rope + (size_t)(tokbase + rowb + ai * HALF + m * 16) * 64 + dlo; csq[m] = *(const f32x4*)tr; snq[m] = *(const f32x4*)(tr + 32); }
#pragma unroll
                for (int m = 0; m < 4; ++m) { const int row = rowb + ai * HALF + m * 16; const f32x4 cs = csq[m], sn = snq[m];
#pragma unroll
                    for (int bj = 0; bj < 2; ++bj) { const f32x4 v0 = acc[ai][bj][m][0], v1 = acc[ai][bj][m][1];
                        const f32x4 o0 = (v0 * cs - v1 * sn) * sc, o1 = (v1 * cs + v0 * sn) * sc;
                        *(u32x4*)(base + (size_t)row * 1024 + colt + bj * HALF + cow) = pack8(o0, o1); } } }
        } else if (pn < 14) {
            const int colt = (pn - 10) * 256;
#pragma unroll
            for (int ai = 0; ai < 2; ++ai)
#pragma unroll
                for (int m = 0; m < 4; ++m) { const int row = rowb + ai * HALF + m * 16;
#pragma unroll
                    for (int bj = 0; bj < 2; ++bj) *(u32x4*)((bf16_t*)(act + EA_V) + (size_t)row * 1024 + colt + bj * HALF + cow) = pack8(acc[ai][bj][m][0], acc[ai][bj][m][1]); }
        } else {
            bf16_t* base = (bf16_t*)(act + (pn < 18 ? EA_SGS : EA_SGA)); const int colt = (pn < 18 ? pn - 14 : pn - 18) * 256;
#pragma unroll
            for (int ai = 0; ai < 2; ++ai)
#pragma unroll
                for (int m = 0; m < 4; ++m) { const int row = rowb + ai * HALF + m * 16;
#pragma unroll
                    for (int bj = 0; bj < 2; ++bj) *(u32x4*)(base + (size_t)row * 1024 + colt + bj * HALF + cow) = pack8(sigm4(acc[ai][bj][m][0]), sigm4(acc[ai][bj][m][1])); }
        }
    }
};
struct EpiSloc {
    static constexpr bool PERM = false, AFTER_DRAIN = false;
    float* S;
    __device__ __forceinline__ void operator()(const f32x4 (&acc)[2][2][4][2], const Unit& u, int wr, int wc, int fr_in, int fq_in) const {
        int fr = fr_in, fq = fq_in; asm volatile("" : "+v"(fr), "+v"(fq));
        const int rowb = u.pm * BM + wr * 64 + fr, col0 = wc * 32 + 4 * fq;
#pragma unroll
        for (int ai = 0; ai < 2; ++ai)
#pragma unroll
            for (int m = 0; m < 4; ++m) { float* rowp = S + (size_t)(rowb + ai * HALF + m * 16) * 128 + col0;
#pragma unroll
                for (int n = 0; n < 2; ++n) *(f32x4*)(rowp + n * 16) = acc[ai][0][m][n]; }
    }
};
struct EpiYa {
    static constexpr bool PERM = true, AFTER_DRAIN = false;
    bf16_t* YA;
    __device__ __forceinline__ void operator()(const f32x4 (&acc)[2][2][4][2], const Unit& u, int wr, int wc, int fr_in, int fq_in) const {
        int fr = fr_in, fq = fq_in; asm volatile("" : "+v"(fr), "+v"(fq));
        const int g = u.pm >> 2, pni = u.pn & 1; const int rowb = (u.pm & 3) * BM + wr * 64 + fr; const int jj = 8 * (fq & 1);
#pragma unroll
        for (int ai = 0; ai < 2; ++ai)
#pragma unroll
            for (int m = 0; m < 4; ++m) { const int R = rowb + ai * HALF + m * 16;
#pragma unroll
                for (int bj = 0; bj < 2; ++bj) { const int t = pni * 16 + bj * 8 + wc * 2 + (fq >> 1);
                    *(u32x4*)(YA + (size_t)(R * 32 + t) * 512 + g * 16 + jj) = pack8(gelu4(acc[ai][bj][m][0]), gelu4(acc[ai][bj][m][1])); } }
    }
};
struct EpiGlu {
    static constexpr bool PERM = true, AFTER_DRAIN = false;
    const bf16_t* YA; bf16_t* O; const float* bias;
    __device__ __forceinline__ void operator()(const f32x4 (&acc)[2][2][4][2], const Unit& u, int wr, int wc, int fr_in, int fq_in) const {
        int fr = fr_in, fq = fq_in; asm volatile("" : "+v"(fr), "+v"(fq));
        const int rowb = u.pm * BM + wr * 64 + fr, col0 = u.pn * BM + wc * 32 + 8 * fq;
        f32x4 bv[2][2];
#pragma unroll
        for (int bj = 0; bj < 2; ++bj)
#pragma unroll
            for (int n = 0; n < 2; ++n) bv[bj][n] = *(const f32x4*)(bias + col0 + bj * HALF + 4 * n);
#pragma unroll
        for (int ai = 0; ai < 2; ++ai) { u32x4 yq[4][2];
#pragma unroll
            for (int m = 0; m < 4; ++m)
#pragma unroll
                for (int bj = 0; bj < 2; ++bj) yq[m][bj] = *(const u32x4*)(YA + (size_t)(rowb + ai * HALF + m * 16) * 512 + col0 + bj * HALF);
#pragma unroll
            for (int m = 0; m < 4; ++m) { const size_t off = (size_t)(rowb + ai * HALF + m * 16) * 512 + col0;
#pragma unroll
                for (int bj = 0; bj < 2; ++bj) { f32x4 y0, y1; unpack8(yq[m][bj], y0, y1);
                    *(u32x4*)(O + off + bj * HALF) = pack8(y0 * sigm4(acc[ai][bj][m][0] + bv[bj][0]), y1 * sigm4(acc[ai][bj][m][1] + bv[bj][1])); } } }
    }
};
template <int MODE> struct EpiGate {
    static constexpr bool PERM = true, AFTER_DRAIN = false;
    bf16_t* G; const bf16_t* T0;
    __device__ __forceinline__ void operator()(const f32x4 (&acc)[2][2][4][2], const Unit& u, int wr, int wc, int fr_in, int fq_in) const {
        int fr = fr_in, fq = fq_in; asm volatile("" : "+v"(fr), "+v"(fq));
        const int rowb = u.pm * BM + wr * 64 + fr, col0 = u.pn * BM + wc * 32 + 8 * fq;
#pragma unroll
        for (int ai = 0; ai < 2; ++ai)
#pragma unroll
            for (int bj = 0; bj < 2; ++bj) { u32x4 gq[4], tq[4];
#pragma unroll
                for (int m = 0; m < 4; ++m) { const size_t off = (size_t)(rowb + ai * HALF + m * 16) * 1024 + col0 + bj * HALF; gq[m] = *(const u32x4*)(G + off); if (MODE == 1) tq[m] = *(const u32x4*)(T0 + off); }
#pragma unroll
                for (int m = 0; m < 4; ++m) { const size_t off = (size_t)(rowb + ai * HALF + m * 16) * 1024 + col0 + bj * HALF; f32x4 g0, g1; unpack8(gq[m], g0, g1);
                    f32x4 o0 = g0 * acc[ai][bj][m][0], o1 = g1 * acc[ai][bj][m][1];
                    if (MODE == 1) { f32x4 t0, t1; unpack8(tq[m], t0, t1); o0 += t0; o1 += t1; }
                    *(u32x4*)(G + off) = pack8(o0, o1); } }
    }
};
struct EpiRes {
    static constexpr bool PERM = true, AFTER_DRAIN = false;
    const float* xin32; bf16_t* xb; int tokbase;
    __device__ __forceinline__ void operator()(const f32x4 (&acc)[2][2][4][2], const Unit& u, int wr, int wc, int fr_in, int fq_in) const {
        int fr = fr_in, fq = fq_in; asm volatile("" : "+v"(fr), "+v"(fq));
        const int rowb = tokbase + u.pm * BM + wr * 64 + fr, col0 = u.pn * BM + wc * 32 + 8 * fq;
        const bool f32in = xin32 != nullptr;
#pragma unroll
        for (int ai = 0; ai < 2; ++ai)
#pragma unroll
            for (int bj = 0; bj < 2; ++bj) { f32x4 xq[4][2];
                if (f32in) {
#pragma unroll
                    for (int m = 0; m < 4; ++m) { const size_t off = (size_t)(rowb + ai * HALF + m * 16) * 1024 + col0 + bj * HALF; xq[m][0] = *(const f32x4*)(xin32 + off); xq[m][1] = *(const f32x4*)(xin32 + off + 4); }
                } else { u32x4 xw[4];
#pragma unroll
                    for (int m = 0; m < 4; ++m) xw[m] = *(const u32x4*)(xb + (size_t)(rowb + ai * HALF + m * 16) * 1024 + col0 + bj * HALF);
#pragma unroll
                    for (int m = 0; m < 4; ++m) unpack8(xw[m], xq[m][0], xq[m][1]);
                }
#pragma unroll
                for (int m = 0; m < 4; ++m) *(u32x4*)(xb + (size_t)(rowb + ai * HALF + m * 16) * 1024 + col0 + bj * HALF) = pack8(xq[m][0] + acc[ai][bj][m][0], xq[m][1] + acc[ai][bj][m][1]); }
    }
};
struct EpiSwi {
    static constexpr bool PERM = true, AFTER_DRAIN = false;
    bf16_t* O;
    __device__ __forceinline__ void operator()(const f32x4 (&acc)[2][2][4][2], const Unit& u, int wr, int wc, int fr_in, int fq_in) const {
        int fr = fr_in, fq = fq_in; asm volatile("" : "+v"(fr), "+v"(fq));
        const int rowb = u.pm * BM + wr * 64 + fr, col0 = (u.pn % 22) * HALF + wc * 32 + 8 * fq;
#pragma unroll
        for (int ai = 0; ai < 2; ++ai)
#pragma unroll
            for (int m = 0; m < 4; ++m) { const f32x4 g0 = acc[ai][0][m][0], g1 = acc[ai][0][m][1];
                *(u32x4*)(O + (size_t)(rowb + ai * HALF + m * 16) * 2816 + col0) = pack8(g0 * sigm4(g0) * acc[ai][1][m][0], g1 * sigm4(g1) * acc[ai][1][m][1]); }
    }
};
struct EpiBf {
    static constexpr bool PERM = true, AFTER_DRAIN = false;
    bf16_t* O;
    __device__ __forceinline__ void operator()(const f32x4 (&acc)[2][2][4][2], const Unit& u, int wr, int wc, int fr_in, int fq_in) const {
        int fr = fr_in, fq = fq_in; asm volatile("" : "+v"(fr), "+v"(fq));
        const int rowb = u.pm * BM + wr * 64 + fr, col0 = (u.pn & 3) * BM + wc * 32 + 8 * fq;
#pragma unroll
        for (int ai = 0; ai < 2; ++ai)
#pragma unroll
            for (int m = 0; m < 4; ++m)
#pragma unroll
                for (int bj = 0; bj < 2; ++bj) *(u32x4*)(O + (size_t)(rowb + ai * HALF + m * 16) * 1024 + col0 + bj * HALF) = pack8(acc[ai][bj][m][0], acc[ai][bj][m][1]);
    }
};

template <class Epi, class Sched, bool ALIGN_EPI = false, bool SP2 = false>
__device__ __forceinline__ void gemm_phase(PG8_LAS unsigned char* lds, const Gemm g, const Sched& S, const Epi& E, const int tid_in) {
    const int tid = tid_in, wid = __builtin_amdgcn_readfirstlane(tid >> 6), lane = tid & 63, wr = wid >> 2, wc = wid & 3, fr = lane & 15, fq = lane >> 4;
    const int K = g.K, nt = K / BK;
    unsigned voffA[2], voffB[2];
#pragma unroll
    for (int i = 0; i < 2; ++i) { int R, C; stage_rc(tid * 16 + i * 8192, R, C); const int Rb = Epi::PERM ? ((R & ~31) + perm32(R & 31)) : R;
        voffA[i] = (unsigned)(R * g.lda + C) * 2u; voffB[i] = (unsigned)(Rb * g.ldb + C) * 2u; }
    const size_t kstep = (size_t)(BK * 2);
    const size_t hstepA = (size_t)HALF * g.lda * 2, hstepB = (size_t)HALF * g.ldb * 2;
    const size_t tstepA = 2 * hstepA, tstepB = 2 * hstepB;
    const unsigned ldsw = (unsigned)wid * 1024u;
    const int aoff = lds_byte(wr * 64 + fr, fq * 8), boff = lds_byte(wc * 32 + fr, fq * 8);
#define PG8_SA(b, h) (((b) * 2 + (h)) * HTB)
#define PG8_SB(b, h) ((4 + (b) * 2 + (h)) * HTB)
#define PG8_STAGE(bufoff, gbase, voff) do { _Pragma("unroll") for (int _i = 0; _i < 2; ++_i) \
        __builtin_amdgcn_global_load_lds((const unsigned*)((const char*)(gbase) + (voff)[_i]), (PG8_LAS unsigned*)(lds + (bufoff) + ldsw + _i * 8192), 16, 0, 0); } while (0)
#define PG8_LDA(dst, b, h) do { _Pragma("unroll") for (int m = 0; m < 4; ++m) _Pragma("unroll") for (int k = 0; k < 2; ++k) dst[m][k] = *(const PG8_LAS bf16x8*)(lds + PG8_SA(b, h) + aoff + m * 2048 + k * 1024); } while (0)
#define PG8_LDB(dst, b, h) do { _Pragma("unroll") for (int n = 0; n < 2; ++n) _Pragma("unroll") for (int k = 0; k < 2; ++k) dst[n][k] = *(const PG8_LAS bf16x8*)(lds + PG8_SB(b, h) + boff + n * 2048 + k * 1024); } while (0)
#define PG8_MMA(ai, bj, At, Bt) do { __builtin_amdgcn_s_setprio(1); _Pragma("unroll") for (int m = 0; m < 4; ++m) _Pragma("unroll") for (int n = 0; n < 2; ++n) _Pragma("unroll") for (int k = 0; k < 2; ++k) \
        acc[ai][bj][m][n] = __builtin_amdgcn_mfma_f32_16x16x32_bf16(Bt[n][k], At[m][k], acc[ai][bj][m][n], 0, 0, 0); __builtin_amdgcn_s_setprio(0); } while (0)
#define PG8_WAIT_V(n) asm volatile("s_waitcnt vmcnt(" #n ")" ::: "memory")
#define PG8_WAIT_L(n) asm volatile("s_waitcnt lgkmcnt(" #n ")" ::: "memory")
#define PG8_BAR __builtin_amdgcn_s_barrier()
#define PG8_SCHED __builtin_amdgcn_sched_barrier(0)
    Unit cur, nxt; int ui = 0;
    if (!S.next(0, cur)) return;
    f32x4 acc[2][2][4][2];
#pragma unroll
    for (int a = 0; a < 2; ++a)
#pragma unroll
        for (int b = 0; b < 2; ++b)
#pragma unroll
            for (int m = 0; m < 4; ++m)
#pragma unroll
                for (int n = 0; n < 2; ++n) acc[a][b][m][n] = (f32x4){0.f, 0.f, 0.f, 0.f};
    bf16x8 At[4][2], B0[2][2], B1[2][2];
    const char* cA = (const char*)g.A + (size_t)cur.pm * tstepA; const char* cB = (const char*)g.Bt + (size_t)cur.pn * tstepB;
    S.a_ready(cur);
    if constexpr (SP2) {
        PG8_STAGE(PG8_SB(0, 0), cB, voffB); PG8_STAGE(PG8_SB(0, 1), cB + hstepB, voffB); PG8_STAGE(PG8_SA(0, 0), cA, voffA); PG8_STAGE(PG8_SA(0, 1), cA + hstepA, voffA);
        if (wr == 1) PG8_BAR;
        PG8_WAIT_V(2); PG8_BAR;
        PG8_STAGE(PG8_SB(1, 0), cB + kstep, voffB); PG8_STAGE(PG8_SA(1, 0), cA + kstep, voffA); PG8_STAGE(PG8_SB(1, 1), cB + hstepB + kstep, voffB);
        PG8_WAIT_V(6); PG8_BAR;
    } else {
        PG8_STAGE(PG8_SB(0, 0), cB, voffB); PG8_STAGE(PG8_SA(0, 0), cA, voffA); PG8_STAGE(PG8_SB(0, 1), cB + hstepB, voffB); PG8_STAGE(PG8_SA(0, 1), cA + hstepA, voffA);
        if (wr == 1) PG8_BAR;
        PG8_WAIT_V(4); PG8_BAR;
        PG8_STAGE(PG8_SB(1, 0), cB + kstep, voffB); PG8_STAGE(PG8_SA(1, 0), cA + kstep, voffA); PG8_STAGE(PG8_SB(1, 1), cB + hstepB + kstep, voffB);
        PG8_WAIT_V(6); PG8_BAR;
    }
    for (;;) {
        const bool has_next = S.next(ui + 1, nxt);
        const char* nA = has_next ? (const char*)g.A + (size_t)nxt.pm * tstepA : cA; const char* nB = has_next ? (const char*)g.Bt + (size_t)nxt.pn * tstepB : cB;
        for (int t = 0; t < nt; t += 2) {
            const bool last = (t == nt - 2);
            const char* a1 = cA + (size_t)(t + 1) * kstep;
            const char* a2 = last ? nA : cA + (size_t)(t + 2) * kstep; const char* b2 = last ? nB : cB + (size_t)(t + 2) * kstep;
            const char* a3 = a2 + kstep; const char* b3 = b2 + kstep;
            if (last && has_next) S.a_ready(nxt);
            if constexpr (SP2) {
            PG8_LDB(B0, 0, 0); PG8_LDB(B1, 0, 1); PG8_SCHED; PG8_LDA(At, 0, 0); PG8_STAGE(PG8_SA(1, 1), a1 + hstepA, voffA);
            PG8_WAIT_V(8); PG8_WAIT_L(0); PG8_BAR; PG8_MMA(0, 0, At, B0); PG8_MMA(0, 1, At, B1); PG8_BAR; PG8_SCHED;
            PG8_LDA(At, 0, 1); PG8_STAGE(PG8_SB(0, 0), b2, voffB); PG8_STAGE(PG8_SB(0, 1), b2 + hstepB, voffB); PG8_STAGE(PG8_SA(0, 0), a2, voffA);
            PG8_WAIT_V(8); PG8_WAIT_L(0); PG8_BAR; PG8_MMA(1, 0, At, B0); PG8_MMA(1, 1, At, B1); PG8_BAR; PG8_SCHED;
            PG8_LDB(B0, 1, 0); PG8_LDB(B1, 1, 1); PG8_SCHED; PG8_LDA(At, 1, 0); PG8_STAGE(PG8_SA(0, 1), a2 + hstepA, voffA);
            PG8_WAIT_V(8); PG8_WAIT_L(0); PG8_BAR; PG8_MMA(0, 0, At, B0); PG8_MMA(0, 1, At, B1); PG8_BAR; PG8_SCHED;
            PG8_LDA(At, 1, 1); PG8_STAGE(PG8_SB(1, 0), b3, voffB); PG8_STAGE(PG8_SB(1, 1), b3 + hstepB, voffB); PG8_STAGE(PG8_SA(1, 0), a3, voffA);
            PG8_WAIT_V(8); PG8_WAIT_L(0); PG8_BAR; PG8_MMA(1, 0, At, B0); PG8_MMA(1, 1, At, B1); PG8_BAR; PG8_SCHED;
            } else {
            PG8_LDB(B0, 0, 0); PG8_SCHED; PG8_LDA(At, 0, 0); PG8_STAGE(PG8_SA(1, 1), a1 + hstepA, voffA);
            PG8_WAIT_L(8); PG8_BAR; PG8_WAIT_L(0); PG8_MMA(0, 0, At, B0); PG8_BAR; PG8_SCHED;
            PG8_LDB(B1, 0, 1); PG8_STAGE(PG8_SB(0, 0), b2, voffB);
            PG8_BAR; PG8_WAIT_L(0); PG8_MMA(0, 1, At, B1); PG8_BAR;
            PG8_LDA(At, 0, 1); PG8_STAGE(PG8_SA(0, 0), a2, voffA);
            PG8_BAR; PG8_WAIT_L(0); PG8_MMA(1, 0, At, B0); PG8_BAR; PG8_SCHED;
            PG8_STAGE(PG8_SB(0, 1), b2 + hstepB, voffB);
            PG8_WAIT_V(6); PG8_BAR; PG8_MMA(1, 1, At, B1); PG8_BAR;
            PG8_LDB(B0, 1, 0); PG8_SCHED; PG8_LDA(At, 1, 0); PG8_STAGE(PG8_SA(0, 1), a2 + hstepA, voffA);
            PG8_WAIT_L(8); PG8_BAR; PG8_WAIT_L(0); PG8_MMA(0, 0, At, B0); PG8_BAR; PG8_SCHED;
            PG8_LDB(B1, 1, 1); PG8_STAGE(PG8_SB(1, 0), b3, voffB);
            PG8_BAR; PG8_WAIT_L(0); PG8_MMA(0, 1, At, B1); PG8_BAR;
            PG8_LDA(At, 1, 1); PG8_STAGE(PG8_SA(1, 0), a3, voffA);
            PG8_BAR; PG8_WAIT_L(0); PG8_MMA(1, 0, At, B0); PG8_BAR; PG8_SCHED;
            PG8_STAGE(PG8_SB(1, 1), b3 + hstepB, voffB);
            PG8_WAIT_V(6); PG8_BAR; PG8_MMA(1, 1, At, B1); PG8_BAR;
            }
        }
        if constexpr (ALIGN_EPI) { if (wr == 0) PG8_BAR; }
        if constexpr (!Epi::AFTER_DRAIN) { E(acc, cur, wr, wc, fr, fq); S.done(cur); }
        if (!has_next) break;
#pragma unroll
        for (int a = 0; a < 2; ++a)
#pragma unroll
            for (int b = 0; b < 2; ++b)
#pragma unroll
                for (int m = 0; m < 4; ++m)
#pragma unroll
                    for (int n = 0; n < 2; ++n) acc[a][b][m][n] = (f32x4){0.f, 0.f, 0.f, 0.f};
        cur = nxt; cA = nA; cB = nB; ++ui;
        if constexpr (ALIGN_EPI) { if (wr == 1) PG8_BAR; }
    }
    PG8_WAIT_V(0);
    if constexpr (!ALIGN_EPI) { if (wr == 0) PG8_BAR; }
    PG8_BAR;
    if constexpr (Epi::AFTER_DRAIN) { E.fused(acc, cur, wr, wc, fr, fq, lds, wid, lane); S.done(cur); }
#undef PG8_SA
#undef PG8_SB
#undef PG8_STAGE
#undef PG8_LDA
#undef PG8_LDB
#undef PG8_MMA
#undef PG8_WAIT_V
#undef PG8_WAIT_L
#undef PG8_BAR
#undef PG8_SCHED
}
}

#include <hip/hip_bf16.h>
#include <cmath>
namespace attn_body {
using bf16=__hip_bfloat16;
using bf16x8=__attribute__((ext_vector_type(8)))short;
using s16x4=__attribute__((ext_vector_type(4)))short;
using f32x16=__attribute__((ext_vector_type(16)))float;
using u32x4=__attribute__((ext_vector_type(4)))unsigned;
constexpr int SEQ=4096,D=64,DM=1024,OPITCH=2048;
constexpr int NW=8,QBLK=32,QB=QBLK*NW,KVBLK=64,NQB=SEQ/QB;
constexpr int ATTN_PITCH=DM, ATTN_UNIT_ROWS=QB;
__device__ __forceinline__ int crow(int r,int hi){return (r&3)+8*(r>>2)+4*hi;}
#define SBAR() __builtin_amdgcn_sched_barrier(0)
__device__ __forceinline__ void cmask(f32x16&p0,f32x16&p1,int jb,int qrel,int hi){
  const float NEG=-INFINITY; int kb=64*jb+4*hi;
  #pragma unroll
  for(int r=0;r<16;++r){int kv=kb+(r&3)+8*(r>>2); if(kv>qrel)p0[r]=NEG; if(kv+32>qrel)p1[r]=NEG;}
}

constexpr int NSLOT=3, SLOTB=8192;
constexpr int LDS_K=0, LDS_V=NSLOT*SLOTB, LDS_WS=2*NSLOT*SLOTB, LDS_OST=LDS_WS+NW*64*4, LDS_BYTES=LDS_OST+NW*4096;
constexpr float C2=0.125f*1.4426950408889634f;
__device__ __forceinline__ void glds16(const void*gsrc,unsigned lds_dst){unsigned keep;
  asm volatile("s_mov_b32 %0, m0\n\ts_mov_b32 m0, %2\n\ts_nop 0\n\tglobal_load_lds_dwordx4 %1, off\n\ts_mov_b32 m0, %0":"=&s"(keep):"v"(gsrc),"s"(lds_dst):"memory");}
__device__ __forceinline__ float max3f(float a,float b,float c){float r;asm("v_max3_f32 %0, %1, %2, %3":"=v"(r):"v"(a),"v"(b),"v"(c));return r;}
__device__ __forceinline__ float max2f(float a,float b){float r;asm("v_max_f32_e32 %0, %1, %2":"=v"(r):"v"(a),"v"(b));return r;}
__device__ __forceinline__ float fadd_s(float a,float b){float r;asm("v_add_f32_e32 %0, %1, %2":"=v"(r):"v"(a),"v"(b));return r;}
__device__ __forceinline__ float fsub_s(float a,float b){float r;asm("v_sub_f32_e32 %0, %1, %2":"=v"(r):"v"(a),"v"(b));return r;}
typedef float f32x2_t __attribute__((ext_vector_type(2))); typedef __bf16 bf16x2_t __attribute__((ext_vector_type(2)));
__device__ __forceinline__ unsigned cvtpk_s(float lo,float hi){f32x2_t v={lo,hi};bf16x2_t b=__builtin_convertvector(v,bf16x2_t);return __builtin_bit_cast(unsigned,b);}
#define WAIT_BAR(N) asm volatile("s_waitcnt vmcnt(" #N ") lgkmcnt(0)\n\ts_barrier":::"memory")

__device__ __forceinline__ f32x16 mfma_z(bf16x8 a_,bf16x8 b_){ f32x16 d_; asm volatile("s_nop 1\n\tv_mfma_f32_32x32x16_bf16 %0, %1, %2, 0":"=&v"(d_):"v"(a_),"v"(b_)); return d_; }
__device__ __forceinline__ void qkt(f32x16&p0,f32x16&p1,const char*Kslot,const bf16x8*qr,int r32,int hi){
  const char*kb=Kslot+hi*1024+r32*16;
  #pragma unroll
  for(int d0=0;d0<4;++d0){
    const bf16x8 b0=*reinterpret_cast<const bf16x8*>(kb+d0*2048);
    const bf16x8 b1=*reinterpret_cast<const bf16x8*>(kb+d0*2048+512);
    if(d0==0){f32x16 z0=f32x16{},z1=f32x16{};asm volatile("":"+v"(z0),"+v"(z1));
      p0=__builtin_amdgcn_mfma_f32_32x32x16_bf16(b0,qr[0],z0,0,0,0);p1=__builtin_amdgcn_mfma_f32_32x32x16_bf16(b1,qr[0],z1,0,0,0);}
    else{p0=__builtin_amdgcn_mfma_f32_32x32x16_bf16(b0,qr[d0],p0,0,0,0);p1=__builtin_amdgcn_mfma_f32_32x32x16_bf16(b1,qr[d0],p1,0,0,0);}}
}
typedef __attribute__((address_space(3))) const char* lds_cptr;
typedef short v4i16_t __attribute__((ext_vector_type(4)));
__device__ __forceinline__ void kload8(bf16x8*kf,lds_cptr kp){
  kf[0]=*(const __attribute__((address_space(3))) bf16x8*)(kp);      kf[1]=*(const __attribute__((address_space(3))) bf16x8*)(kp+512);
  kf[2]=*(const __attribute__((address_space(3))) bf16x8*)(kp+2048); kf[3]=*(const __attribute__((address_space(3))) bf16x8*)(kp+2560);
  kf[4]=*(const __attribute__((address_space(3))) bf16x8*)(kp+4096); kf[5]=*(const __attribute__((address_space(3))) bf16x8*)(kp+4608);
  kf[6]=*(const __attribute__((address_space(3))) bf16x8*)(kp+6144); kf[7]=*(const __attribute__((address_space(3))) bf16x8*)(kp+6656);
}
__device__ __forceinline__ void kload2(bf16x8*kf,lds_cptr kp,int j){ kf[2*j]=*(const __attribute__((address_space(3))) bf16x8*)(kp+j*2048); kf[2*j+1]=*(const __attribute__((address_space(3))) bf16x8*)(kp+j*2048+512); }
__device__ __forceinline__ s16x4 vtr(lds_cptr p){ return __builtin_bit_cast(s16x4,__builtin_amdgcn_ds_read_tr16_b64_v4i16((__attribute__((address_space(3))) v4i16_t*)p)); }
__device__ __forceinline__ float rowmax(const f32x16&p0,const f32x16&p1){
  float a=max3f(p0[0],p0[1],p1[0]),b=max3f(p0[2],p0[3],p1[1]);a=max3f(a,p1[2],p1[3]);
  #pragma unroll
  for(int r=4;r<16;r+=4){a=max3f(a,p0[r],p0[r+1]);b=max3f(b,p0[r+2],p0[r+3]);a=max3f(a,p1[r],p1[r+1]);b=max3f(b,p1[r+2],p1[r+3]);}
  const float m=max2f(a,b);
  auto rr=__builtin_amdgcn_permlane32_swap(__float_as_uint(m),__float_as_uint(m),false,false);
  return max2f(__uint_as_float(rr[0]),__uint_as_float(rr[1]));
}
__device__ __forceinline__ void pv(f32x16*o,int vb,bf16x8 pa0,bf16x8 pa1,bf16x8 pa2,bf16x8 pa3){
  #pragma unroll
  for(int d0=0;d0<2;++d0){s16x4 lo[4],hi[4];
    #pragma unroll
    for(int ks=0;ks<4;++ks){
      asm volatile("ds_read_b64_tr_b16 %0,%1 offset:%c2":"=&v"(lo[ks]):"v"(vb),"i"(d0*4096+ks*1024):"memory");
      asm volatile("ds_read_b64_tr_b16 %0,%1 offset:%c2":"=&v"(hi[ks]):"v"(vb),"i"(d0*4096+ks*1024+512):"memory");}
    asm volatile("s_waitcnt lgkmcnt(0)":::"memory");SBAR();
    #define PK(k) (bf16x8){lo[k][0],lo[k][1],lo[k][2],lo[k][3],hi[k][0],hi[k][1],hi[k][2],hi[k][3]}
    o[d0]=__builtin_amdgcn_mfma_f32_32x32x16_bf16(pa0,PK(0),o[d0],0,0,0);
    o[d0]=__builtin_amdgcn_mfma_f32_32x32x16_bf16(pa1,PK(1),o[d0],0,0,0);
    o[d0]=__builtin_amdgcn_mfma_f32_32x32x16_bf16(pa2,PK(2),o[d0],0,0,0);
    o[d0]=__builtin_amdgcn_mfma_f32_32x32x16_bf16(pa3,PK(3),o[d0],0,0,0);
    #undef PK
  }
}

#ifndef ATTN_STORE16
#define ATTN_STORE16(p,v) (*(u32x4*)(p)=(v))
#endif
template<int THRL> __device__ __forceinline__ void attn_unit(int qb,const bf16*Qh,const bf16*__restrict__ Kh,const bf16*__restrict__ Vh,bf16*Oh,char*shm,const int tid_in){
  const int tid=tid_in,lane=tid&63,r32=lane&31,hi=lane>>5; const int wid=__builtin_amdgcn_readfirstlane(tid>>6);
  const int q0=qb*QB;
  const bf16*Qw=Qh+(long)(q0+wid*QBLK)*DM;
  const unsigned lds0=(unsigned)(uintptr_t)shm;
  float*wsf=(float*)(shm+LDS_WS)+wid*64;
  const bf16*ksrc=Kh+(long)lane*DM+wid*8;
  const bf16*vsrc=Vh+(long)(16*(wid&3)+(lane>>2))*DM+(wid>>2)*32+(lane&3)*8;
  const unsigned kdst=lds0+LDS_K+wid*1024, vdst=lds0+LDS_V+wid*1024;
  #define DMA_K(t,slot) glds16(ksrc+(long)(t)*KVBLK*DM,(unsigned)__builtin_amdgcn_readfirstlane(kdst+(slot)))
  #define DMA_V(t,slot) glds16(vsrc+(long)(t)*KVBLK*DM,(unsigned)__builtin_amdgcn_readfirstlane(vdst+(slot)))
  const int vb0=(int)(lds0+LDS_V)+((lane>>4)&1)*32+(lane&3)*8+(4*hi+((lane&15)>>2))*64;
  const char*Kbase=shm+LDS_K; bf16x8 kf[8];
  const lds_cptr shm3=(lds_cptr)shm; const lds_cptr kp0=shm3+LDS_K+hi*1024+r32*16; const lds_cptr vp0=shm3+LDS_V+((lane>>4)&1)*32+(lane&3)*8+(4*hi+((lane&15)>>2))*64;
  const int NT=(q0+QB)/KVBLK;
  DMA_K(0,0);DMA_V(0,0);DMA_K(1,SLOTB);
  bf16x8 qr[4];
  #pragma unroll
  for(int d0=0;d0<4;++d0)qr[d0]=*reinterpret_cast<const bf16x8*>(&Qw[(long)r32*DM+d0*16+hi*8]);
  float mhat=0.f,l_reg=0.f;f32x16 o[2];o[0]=f32x16{};o[1]=f32x16{};
  const int qrel=wid*QBLK+r32;
  #define CMASK(P0,P1,t) do{int jb_=(t)-(NT-4); if(jb_>=0)cmask(P0,P1,jb_,qrel,hi);}while(0)
  bool resc=false;
  #define START(P0,P1) do{ const float rm=rowmax(P0,P1); resc=false; \
    { const float dl=rm; mhat=fadd_s(mhat,dl); \
      _Pragma("unroll") for(int r=0;r<16;++r){P0[r]=fsub_s(P0[r],dl);P1[r]=fsub_s(P1[r],dl);} \
      } \
    _Pragma("unroll") for(int r=0;r<16;++r)P0[r]=__builtin_amdgcn_exp2f(P0[r]); }while(0)
  #define RESC() do{ if(resc){ asm volatile("s_waitcnt lgkmcnt(0)":::"memory"); \
      _Pragma("unroll") for(int d_=0;d_<2;++d_) _Pragma("unroll") for(int r=0;r<16;++r)o[d_][r]*=wsf[crow(r,hi)]; } }while(0)
  f32x16 pA0,pA1,pB0,pB1;
  int sl_prev=0,sl_cur=0,sl_next=SLOTB;
  #define ROT() do{sl_prev=sl_cur;sl_cur=sl_next;sl_next=(sl_next==(NSLOT-1)*SLOTB)?0:sl_next+SLOTB;}while(0)
  DMA_K(2,2*SLOTB);
  WAIT_BAR(3);
  qkt(pA0,pA1,Kbase,qr,r32,hi);asm volatile("s_nop 15\n\ts_nop 7":"+v"(pA0),"+v"(pA1));CMASK(pA0,pA1,0);
  START(pA0,pA1);
  _Pragma("unroll") for(int r=0;r<16;++r)pA1[r]=__builtin_amdgcn_exp2f(pA1[r]);
  WAIT_BAR(0);
  DMA_K(3,0);DMA_V(1,SLOTB);
  ROT();
  kload8(kf,kp0+sl_cur);
  WAIT_BAR(2);
  s16x4 vlo[8],vhi[8]; u32x4 pw0,pw1,pw2,pw3;
  #define PKW(P,B) cvtpk_s(P[B],P[B+1])
  #define PAF(k) __builtin_bit_cast(bf16x8,pw##k)
  #define VFR(i) (bf16x8){vlo[i][0],vlo[i][1],vlo[i][2],vlo[i][3],vhi[i][0],vhi[i][1],vhi[i][2],vhi[i][3]}
  #define PIN(x) asm volatile("":"+v"(x))
  #define MX3(a,b,c) __builtin_fmaxf(__builtin_fmaxf((a),(b)),(c))
  #define GAPA(MF,A0,A1,A2,A3,W0,W1,PW) do{ MF; sacc+=A0; sacc+=A1; sacc+=A2; sacc+=A3; PIN(sacc); W0; W1; PIN(PW); SBAR(); }while(0)
  #define EX(v) __builtin_amdgcn_exp2f(v)
  #define GAPB(MF,X,B) do{ MF; X[B]=EX(fsub_s(X[B],mhat)); X[B+1]=EX(fsub_s(X[B+1],mhat)); X[B+2]=EX(fsub_s(X[B+2],mhat)); X[B+3]=EX(fsub_s(X[B+3],mhat)); PIN(X); SBAR(); }while(0)
  #define VRD(i) do{ vlo[i]=vtr(vp_+(((i)>>2)*4096+((i)&3)*1024)); vhi[i]=vtr(vp_+(((i)>>2)*4096+((i)&3)*1024+512)); }while(0)
  #define KRD(G,j) do{ if(G){ kload2(kf,kp0+sl_next,j); SBAR(); } }while(0)
  #define STEP(C0,C1,P0,P1,t,GK,GV,GL) do{ SBAR(); \
    const lds_cptr vp_=vp0+sl_prev; \
    VRD(0); SBAR(); float sacc=(P0[0]+P0[1]); \
    GAPA(C0=mfma_z(kf[0],qr[0]), P0[2],P0[3],P0[4],P0[5],     pw0[0]=PKW(P0,0), pw0[1]=PKW(P0,2), pw0); \
    VRD(4); SBAR(); GAPA(C1=mfma_z(kf[1],qr[0]), P0[6],P0[7],P0[8],P0[9],     pw0[2]=PKW(P0,4), pw0[3]=PKW(P0,6), pw0); \
    VRD(1); SBAR(); GAPA(C0=__builtin_amdgcn_mfma_f32_32x32x16_bf16(kf[2],qr[1],C0,0,0,0),   P0[10],P0[11],P0[12],P0[13], pw1[0]=PKW(P0,8), pw1[1]=PKW(P0,10), pw1); \
    VRD(5); SBAR(); GAPA(C1=__builtin_amdgcn_mfma_f32_32x32x16_bf16(kf[3],qr[1],C1,0,0,0),   P0[14],P0[15],P1[0],P1[1],   pw1[2]=PKW(P0,12),pw1[3]=PKW(P0,14), pw1); \
    VRD(2); SBAR(); GAPA(C0=__builtin_amdgcn_mfma_f32_32x32x16_bf16(kf[4],qr[2],C0,0,0,0),   P1[2],P1[3],P1[4],P1[5],     pw2[0]=PKW(P1,0), pw2[1]=PKW(P1,2), pw2); \
    VRD(6); SBAR(); GAPA(C1=__builtin_amdgcn_mfma_f32_32x32x16_bf16(kf[5],qr[2],C1,0,0,0),   P1[6],P1[7],P1[8],P1[9],     pw2[2]=PKW(P1,4), pw2[3]=PKW(P1,6), pw2); \
    VRD(3); SBAR(); GAPA(C0=__builtin_amdgcn_mfma_f32_32x32x16_bf16(kf[6],qr[3],C0,0,0,0),   P1[10],P1[11],P1[12],P1[13], pw3[0]=PKW(P1,8), pw3[1]=PKW(P1,10), pw3); \
    VRD(7); SBAR(); GAPA(C1=__builtin_amdgcn_mfma_f32_32x32x16_bf16(kf[7],qr[3],C1,0,0,0),   P1[14],P1[15],0.f,0.f,       pw3[2]=PKW(P1,12),pw3[3]=PKW(P1,14), pw3); \
    l_reg+=sacc; \
    if(GK){DMA_K((t)+3,sl_cur);} if(GV){DMA_V((t)+1,sl_next);} \
    CMASK(C0,C1,t); \
    { float a=MX3(C0[0],C0[1],C1[0]),b=MX3(C0[2],C0[3],C1[1]); a=MX3(a,C1[2],C1[3]); \
      _Pragma("unroll") for(int r=4;r<16;r+=4){a=MX3(a,C0[r],C0[r+1]);b=MX3(b,C0[r+2],C0[r+3]);a=MX3(a,C1[r],C1[r+1]);b=MX3(b,C1[r+2],C1[r+3]);} \
      float rm=__builtin_fmaxf(a,b); { auto rr=__builtin_amdgcn_permlane32_swap(__float_as_uint(rm),__float_as_uint(rm),false,false); rm=__builtin_fmaxf(__uint_as_float(rr[0]),__uint_as_float(rr[1])); } \
      resc=false; \
      const float rel=rm-mhat; \
      if(__builtin_expect(__any(rel>(float)THRL),0)){ const float dl=__builtin_fmaxf(rel,0.f); mhat+=dl; \
        const float f=__builtin_amdgcn_exp2f(-dl); l_reg*=f; if(hi==0)wsf[r32]=f; resc=true; } } \
    SBAR(); \
    GAPB(o[0]=__builtin_amdgcn_mfma_f32_32x32x16_bf16(PAF(0),VFR(0),o[0],0,0,0), C0,0); \
    GAPB(o[1]=__builtin_amdgcn_mfma_f32_32x32x16_bf16(PAF(0),VFR(4),o[1],0,0,0), C0,4); \
    KRD(GL,0); GAPB(o[0]=__builtin_amdgcn_mfma_f32_32x32x16_bf16(PAF(1),VFR(1),o[0],0,0,0), C0,8); \
    KRD(GL,1); GAPB(o[1]=__builtin_amdgcn_mfma_f32_32x32x16_bf16(PAF(1),VFR(5),o[1],0,0,0), C0,12); \
    KRD(GL,2); GAPB(o[0]=__builtin_amdgcn_mfma_f32_32x32x16_bf16(PAF(2),VFR(2),o[0],0,0,0), C1,0); \
    KRD(GL,3); GAPB(o[1]=__builtin_amdgcn_mfma_f32_32x32x16_bf16(PAF(2),VFR(6),o[1],0,0,0), C1,4); \
    GAPB(o[0]=__builtin_amdgcn_mfma_f32_32x32x16_bf16(PAF(3),VFR(3),o[0],0,0,0), C1,8); \
    GAPB(o[1]=__builtin_amdgcn_mfma_f32_32x32x16_bf16(PAF(3),VFR(7),o[1],0,0,0), C1,12); \
    }while(0)
  int t=1;
  #undef CMASK
  #define CMASK(P0,P1,t) do{}while(0)
  for(;t+5<NT;t+=2){
    STEP(pB0,pB1,pA0,pA1,t,true,true,true);     WAIT_BAR(2); RESC(); ROT();
    STEP(pA0,pA1,pB0,pB1,t+1,true,true,true);   WAIT_BAR(2); RESC(); ROT();
  }
  #undef CMASK
  #define CMASK(P0,P1,t) do{int jb_=(t)-(NT-4); if(jb_>=0)cmask(P0,P1,jb_,qrel,hi);}while(0)
  #define ENDW(tt) do{ if((tt)+3<NT){WAIT_BAR(2);} else if((tt)+2<NT){WAIT_BAR(1);} else {WAIT_BAR(0);} }while(0)
  for(;t+1<NT;t+=2){
    STEP(pB0,pB1,pA0,pA1,t,(t+3<NT),(t+1<NT),(t+1<NT));       ENDW(t);   RESC(); ROT();
    STEP(pA0,pA1,pB0,pB1,t+1,(t+4<NT),(t+2<NT),(t+2<NT));     ENDW(t+1); RESC(); ROT();
  }
  STEP(pB0,pB1,pA0,pA1,NT-1,false,false,false); RESC();
  { float sacc=pB0[0]+pB0[1]; _Pragma("unroll") for(int r=2;r<16;++r)sacc+=pB0[r]; _Pragma("unroll") for(int r=0;r<16;++r)sacc+=pB1[r]; l_reg+=sacc;
    pw0=(u32x4){PKW(pB0,0),PKW(pB0,2),PKW(pB0,4),PKW(pB0,6)};pw1=(u32x4){PKW(pB0,8),PKW(pB0,10),PKW(pB0,12),PKW(pB0,14)};pw2=(u32x4){PKW(pB1,0),PKW(pB1,2),PKW(pB1,4),PKW(pB1,6)};pw3=(u32x4){PKW(pB1,8),PKW(pB1,10),PKW(pB1,12),PKW(pB1,14)};
    SBAR(); pv(o,vb0+sl_cur,PAF(0),PAF(1),PAF(2),PAF(3)); }
  #undef PKW
  #undef PAF
  #undef VFR
  #undef PIN
  #undef MX3
  #undef GAPA
  #undef GAPB
  #undef EX
  #undef VRD
  #undef KRD
  #undef STEP
  #undef ENDW
  l_reg+=__uint_as_float((unsigned)__builtin_amdgcn_ds_bpermute((lane^32)<<2,(int)__float_as_uint(l_reg)));
  if(hi==0)wsf[32+r32]=l_reg;asm volatile("s_waitcnt lgkmcnt(0)":::"memory");
  float rli[16];
  #pragma unroll
  for(int r=0;r<16;++r)rli[r]=__builtin_amdgcn_rcpf(wsf[32+crow(r,hi)]);
  bf16*Ow=Oh+(long)(q0+wid*QBLK)*OPITCH;
  { bf16*stg=(bf16*)(shm+LDS_OST)+wid*2048;
    #pragma unroll
    for(int r=0;r<16;++r){const int orow=crow(r,hi);
      #pragma unroll
      for(int d0=0;d0<2;++d0)stg[orow*64+d0*32+r32]=__float2bfloat16(o[d0][r]*rli[r]);}
    asm volatile("s_waitcnt lgkmcnt(0)":::"memory");
    #pragma unroll
    for(int i=0;i<4;++i){const int row=i*8+(lane>>3),ch=lane&7; const u32x4 v=*(const u32x4*)(stg+row*64+ch*8); ATTN_STORE16(Ow+(long)row*OPITCH+ch*8,v);} }
  asm volatile("s_waitcnt lgkmcnt(0)\n\ts_barrier":::"memory");
  #undef DMA_K
  #undef DMA_V
  #undef CMASK
  #undef START
  #undef RESC
  #undef ROT
}

__device__ __forceinline__ float rowmax_cv(const f32x16&p0,const f32x16&p1){
  float a=__builtin_fmaxf(p0[0],p1[0]);
  #pragma unroll
  for(int r=1;r<16;++r){a=__builtin_fmaxf(a,p0[r]);a=__builtin_fmaxf(a,p1[r]);}
  auto rr=__builtin_amdgcn_permlane32_swap(__float_as_uint(a),__float_as_uint(a),false,false);
  return __builtin_fmaxf(__uint_as_float(rr[0]),__uint_as_float(rr[1]));
}
__device__ __forceinline__ void attn_unit_simple(int qb,const bf16*Qh,const bf16*__restrict__ Kh,const bf16*__restrict__ Vh,bf16*Oh,char*shm,const int tid_in){
  const int tid=tid_in,lane=tid&63,r32=lane&31,hi=lane>>5; const int wid=__builtin_amdgcn_readfirstlane(tid>>6);
  const int q0=qb*QB;
  const bf16*Qw=Qh+(long)(q0+wid*QBLK)*DM;
  const unsigned lds0=(unsigned)(uintptr_t)shm;
  float*wsf=(float*)(shm+LDS_WS)+wid*64;
  const bf16*ksrc=Kh+(long)lane*DM+wid*8;
  const bf16*vsrc=Vh+(long)(16*(wid&3)+(lane>>2))*DM+(wid>>2)*32+(lane&3)*8;
  u32x4*kdstp=(u32x4*)(shm+LDS_K+wid*1024+lane*16); u32x4*vdstp=(u32x4*)(shm+LDS_V+wid*1024+lane*16);
  const int vb0=(int)(lds0+LDS_V)+((lane>>4)&1)*32+(lane&3)*8+(4*hi+((lane&15)>>2))*64;
  const char*Kbase=shm+LDS_K;
  const int NT=(q0+QB)/KVBLK;
  bf16x8 qr[4];
  #pragma unroll
  for(int d0=0;d0<4;++d0)qr[d0]=*reinterpret_cast<const bf16x8*>(&Qw[(long)r32*DM+d0*16+hi*8]);
  float m_run=-1e30f,l_reg=0.f; f32x16 o[2]; o[0]=f32x16{}; o[1]=f32x16{};
  const int qrel=wid*QBLK+r32;
  u32x4 kreg=*(const u32x4*)ksrc, vreg=*(const u32x4*)vsrc;
  for(int t=0;t<NT;++t){
    *kdstp=kreg; *vdstp=vreg;
    if(t+1<NT){ kreg=*(const u32x4*)(ksrc+(long)(t+1)*KVBLK*DM); vreg=*(const u32x4*)(vsrc+(long)(t+1)*KVBLK*DM); }
    __syncthreads();
    f32x16 p0,p1;
    qkt(p0,p1,Kbase,qr,r32,hi);
    { const int jb=t-(NT-4); if(jb>=0){ const float NEG=-INFINITY; const int kb=64*jb+4*hi;
        #pragma unroll
        for(int r=0;r<16;++r){const int kv=kb+(r&3)+8*(r>>2); if(kv>qrel)p0[r]=NEG; if(kv+32>qrel)p1[r]=NEG;} } }
    const float rm=rowmax_cv(p0,p1);
    const float mn=__builtin_fmaxf(m_run,rm); const float alpha=__builtin_amdgcn_exp2f(m_run-mn); m_run=mn;
    float sacc=0.f;
    #pragma unroll
    for(int r=0;r<16;++r){p0[r]=__builtin_amdgcn_exp2f(p0[r]-mn);p1[r]=__builtin_amdgcn_exp2f(p1[r]-mn);sacc+=p0[r]+p1[r];}
    l_reg=l_reg*alpha+sacc;
    if(hi==0)wsf[r32]=alpha;
    asm volatile("s_waitcnt lgkmcnt(0)":::"memory");
    #pragma unroll
    for(int d_=0;d_<2;++d_)
      #pragma unroll
      for(int r=0;r<16;++r)o[d_][r]*=wsf[crow(r,hi)];
    u32x4 pw0,pw1,pw2,pw3;
    #define PKW2(P,B) cvtpk_s(P[B],P[B+1])
    pw0=(u32x4){PKW2(p0,0),PKW2(p0,2),PKW2(p0,4),PKW2(p0,6)};pw1=(u32x4){PKW2(p0,8),PKW2(p0,10),PKW2(p0,12),PKW2(p0,14)};
    pw2=(u32x4){PKW2(p1,0),PKW2(p1,2),PKW2(p1,4),PKW2(p1,6)};pw3=(u32x4){PKW2(p1,8),PKW2(p1,10),PKW2(p1,12),PKW2(p1,14)};
    #undef PKW2
    pv(o,vb0,__builtin_bit_cast(bf16x8,pw0),__builtin_bit_cast(bf16x8,pw1),__builtin_bit_cast(bf16x8,pw2),__builtin_bit_cast(bf16x8,pw3));
    asm volatile("s_waitcnt lgkmcnt(0)":::"memory");
    __syncthreads();
  }
  l_reg+=__uint_as_float((unsigned)__builtin_amdgcn_ds_bpermute((lane^32)<<2,(int)__float_as_uint(l_reg)));
  if(hi==0)wsf[32+r32]=l_reg;asm volatile("s_waitcnt lgkmcnt(0)":::"memory");
  float rli[16];
  #pragma unroll
  for(int r=0;r<16;++r)rli[r]=__builtin_amdgcn_rcpf(wsf[32+crow(r,hi)]);
  bf16*Ow=Oh+(long)(q0+wid*QBLK)*OPITCH;
  { bf16*stg=(bf16*)(shm+LDS_OST)+wid*2048;
    #pragma unroll
    for(int r=0;r<16;++r){const int orow=crow(r,hi);
      #pragma unroll
      for(int d0=0;d0<2;++d0)stg[orow*64+d0*32+r32]=__float2bfloat16(o[d0][r]*rli[r]);}
    asm volatile("s_waitcnt lgkmcnt(0)":::"memory");
    #pragma unroll
    for(int i=0;i<4;++i){const int row=i*8+(lane>>3),ch=lane&7; const u32x4 v=*(const u32x4*)(stg+row*64+ch*8); ATTN_STORE16(Ow+(long)row*OPITCH+ch*8,v);} }
  asm volatile("s_waitcnt vmcnt(0) lgkmcnt(0)":::"memory");
  __syncthreads();
}

constexpr int DA_SLOT=32768, DA_V=16384, DA_WS=98304, DA_ROWS=128;
__device__ __forceinline__ f32x16 mfma_c(bf16x8 a_,bf16x8 b_,const f32x16&c_){ f32x16 d_; asm volatile("s_nop 1\n\tv_mfma_f32_32x32x16_bf16 %0, %1, %2, %3":"=&v"(d_):"v"(a_),"v"(b_),"v"(c_)); return d_; }
template<int THRL> __device__ __forceinline__ void dattn_unit(int qblk,const bf16*Qb,const bf16*__restrict__ Kb,const bf16*__restrict__ Vb,bf16*Yb,float lam,const float*gsub,float gscale,char*shm,const int tid_in){
  const int tid=tid_in,lane=tid&63,r32=lane&31,hi=lane>>5; const int wid=__builtin_amdgcn_readfirstlane(tid>>6);
  const int c=wid>>2, rg=wid&3;
  const int q0=qblk*DA_ROWS; const int NT=(q0+DA_ROWS)/KVBLK;
  const bf16*Qw=Qb+c*64+(long)(q0+rg*32)*DM;
  const unsigned lds0=(unsigned)(uintptr_t)shm; const lds_cptr shm3=(lds_cptr)shm;
  float*wsf=(float*)(shm+DA_WS)+wid*64;
  const int pk0=2*wid;
  const bf16*ksrc0=Kb+(pk0>>3)*64+(long)lane*DM+(pk0&7)*8;
  const unsigned kdst0=lds0+(pk0>>3)*8192+(pk0&7)*1024;
  const bf16*vsrc0=Vb+(long)(16*(pk0&3)+(lane>>2))*DM+(pk0>>2)*32+(lane&3)*8;
  const unsigned vdst0=lds0+DA_V+pk0*1024;
  #define DA_RFL(x) ((unsigned)__builtin_amdgcn_readfirstlane((int)(x)))
  #define DA_DMA(t,so) do{ const long to_=(long)(t)*KVBLK*DM; \
      glds16(ksrc0+to_,DA_RFL(kdst0+(so))); glds16(ksrc0+to_+8,DA_RFL(kdst0+(so)+1024)); \
      glds16(vsrc0+to_,DA_RFL(vdst0+(so))); glds16(vsrc0+to_+16*DM,DA_RFL(vdst0+(so)+1024)); }while(0)
  const lds_cptr kp0=shm3+c*8192+hi*1024+r32*16;
  const lds_cptr vp0=shm3+DA_V+((lane>>4)&1)*32+(lane&3)*8+(4*hi+((lane&15)>>2))*64;
  bf16x8 qr[4];
  #pragma unroll
  DA_DMA(0,0); if(NT>1){ DA_DMA(1,DA_SLOT); }
  #pragma unroll
  for(int d0=0;d0<4;++d0)qr[d0]=*reinterpret_cast<const bf16x8*>(&Qw[(long)r32*DM+d0*16+hi*8]);
  asm volatile("":"+v"(qr[0]),"+v"(qr[1]),"+v"(qr[2]),"+v"(qr[3]));
  float mhat=0.f,l_reg=0.f; f32x16 o[4]; o[0]=f32x16{}; o[1]=f32x16{}; o[2]=f32x16{}; o[3]=f32x16{};
  f32x16 negm;
  #pragma unroll
  for(int r=0;r<16;++r)negm[r]=0.f;
  const int qrel=rg*32+r32;
  int slot=0;
  for(int t=0;t<NT;++t){
    if(t+1<NT){ asm volatile("s_waitcnt vmcnt(4) lgkmcnt(0)\n\ts_barrier":::"memory"); } else { asm volatile("s_waitcnt vmcnt(0) lgkmcnt(0)\n\ts_barrier":::"memory"); }
    if(t+2<NT){ int s2=slot+2*DA_SLOT; if(s2>=3*DA_SLOT)s2-=3*DA_SLOT; DA_DMA(t+2,s2); }
    const lds_cptr kp=kp0+slot;
    f32x16 p0,p1;
    { const bf16x8 k0=*(const __attribute__((address_space(3))) bf16x8*)(kp), k1=*(const __attribute__((address_space(3))) bf16x8*)(kp+512);
      p0=mfma_c(k0,qr[0],negm); p1=mfma_c(k1,qr[0],negm); }
    #pragma unroll
    for(int d0=1;d0<4;++d0){ const bf16x8 k0=*(const __attribute__((address_space(3))) bf16x8*)(kp+d0*2048), k1=*(const __attribute__((address_space(3))) bf16x8*)(kp+d0*2048+512);
      p0=__builtin_amdgcn_mfma_f32_32x32x16_bf16(k0,qr[d0],p0,0,0,0); p1=__builtin_amdgcn_mfma_f32_32x32x16_bf16(k1,qr[d0],p1,0,0,0); }
    { const int jb=t-(NT-2); if(jb>=0){ const float NEG=-INFINITY; const int kb=64*jb+4*hi;
        #pragma unroll
        for(int r=0;r<16;++r){const int kv=kb+(r&3)+8*(r>>2); if(kv>qrel)p0[r]=NEG; if(kv+32>qrel)p1[r]=NEG;} } }
    float rm=__builtin_fmaxf(p0[0],p1[0]);
    #pragma unroll
    for(int r=1;r<16;++r){rm=__builtin_fmaxf(rm,p0[r]);rm=__builtin_fmaxf(rm,p1[r]);}
    rm=__builtin_fmaxf(rm,__uint_as_float((unsigned)__builtin_amdgcn_ds_bpermute((lane^32)<<2,(int)__float_as_uint(rm))));
    if(t==0){
      mhat=rm;
      #pragma unroll
      for(int r=0;r<16;++r){p0[r]-=rm;p1[r]-=rm;negm[r]=-rm;}
    } else if(__any(rm>(float)THRL)){
      const float dl=__builtin_fmaxf(rm,0.f); const float f=__builtin_amdgcn_exp2f(-dl); mhat+=dl; l_reg*=f;
      #pragma unroll
      for(int r=0;r<16;++r){p0[r]-=dl;p1[r]-=dl;negm[r]=-mhat;}
      if(hi==0)wsf[r32]=f;
      asm volatile("s_waitcnt lgkmcnt(0)":::"memory");
      #pragma unroll
      for(int d_=0;d_<4;++d_)
        #pragma unroll
        for(int r=0;r<16;++r)o[d_][r]*=wsf[crow(r,hi)];
    }
    float sacc=0.f;
    #pragma unroll
    for(int r=0;r<16;++r){p0[r]=__builtin_amdgcn_exp2f(p0[r]);p1[r]=__builtin_amdgcn_exp2f(p1[r]);sacc+=p0[r]+p1[r];}
    l_reg+=sacc;
    u32x4 pw0,pw1,pw2,pw3;
    pw0=(u32x4){cvtpk_s(p0[0],p0[1]),cvtpk_s(p0[2],p0[3]),cvtpk_s(p0[4],p0[5]),cvtpk_s(p0[6],p0[7])}; pw1=(u32x4){cvtpk_s(p0[8],p0[9]),cvtpk_s(p0[10],p0[11]),cvtpk_s(p0[12],p0[13]),cvtpk_s(p0[14],p0[15])};
    pw2=(u32x4){cvtpk_s(p1[0],p1[1]),cvtpk_s(p1[2],p1[3]),cvtpk_s(p1[4],p1[5]),cvtpk_s(p1[6],p1[7])}; pw3=(u32x4){cvtpk_s(p1[8],p1[9]),cvtpk_s(p1[10],p1[11]),cvtpk_s(p1[12],p1[13]),cvtpk_s(p1[14],p1[15])};
    const lds_cptr vp=vp0+slot;
    #pragma unroll
    for(int d0=0;d0<4;++d0){
      #define DA_VF(ks) ({ const s16x4 lo_=vtr(vp+d0*4096+(ks)*1024), hi_=vtr(vp+d0*4096+(ks)*1024+512); (bf16x8){lo_[0],lo_[1],lo_[2],lo_[3],hi_[0],hi_[1],hi_[2],hi_[3]}; })
      o[d0]=__builtin_amdgcn_mfma_f32_32x32x16_bf16(__builtin_bit_cast(bf16x8,pw0),DA_VF(0),o[d0],0,0,0);
      o[d0]=__builtin_amdgcn_mfma_f32_32x32x16_bf16(__builtin_bit_cast(bf16x8,pw1),DA_VF(1),o[d0],0,0,0);
      o[d0]=__builtin_amdgcn_mfma_f32_32x32x16_bf16(__builtin_bit_cast(bf16x8,pw2),DA_VF(2),o[d0],0,0,0);
      o[d0]=__builtin_amdgcn_mfma_f32_32x32x16_bf16(__builtin_bit_cast(bf16x8,pw3),DA_VF(3),o[d0],0,0,0);
      #undef DA_VF
    }
    slot+=DA_SLOT; if(slot>=3*DA_SLOT)slot=0;
  }
  int lane_e=lane; asm volatile("":"+v"(lane_e)); const int r32e=lane_e&31, hie=lane_e>>5;
  l_reg+=__uint_as_float((unsigned)__builtin_amdgcn_ds_bpermute((lane^32)<<2,(int)__float_as_uint(l_reg)));
  asm volatile("s_waitcnt vmcnt(0) lgkmcnt(0)\n\ts_barrier":::"memory");
  if(hie==0)wsf[32+r32e]=l_reg; asm volatile("s_waitcnt lgkmcnt(0)":::"memory");
  float rli[16];
  #pragma unroll
  for(int r=0;r<16;++r)rli[r]=__builtin_amdgcn_rcpf(wsf[32+crow(r,hie)]);
  float*st2=(float*)shm+rg*4096;
  if(c==1){
    #pragma unroll
    for(int d0=0;d0<4;++d0)
      #pragma unroll
      for(int r=0;r<16;++r)st2[crow(r,hie)*128+d0*32+r32e]=lam*o[d0][r]*rli[r];
  }
  asm volatile("s_waitcnt lgkmcnt(0)\n\ts_barrier":::"memory");
  if(c==0){
    float ssq[16];
    #pragma unroll
    for(int r=0;r<16;++r){ float a_=0.f;
      #pragma unroll
      for(int d0=0;d0<4;++d0){ const float x_=o[d0][r]*rli[r]-st2[crow(r,hie)*128+d0*32+r32e]; o[d0][r]=x_; a_+=x_*x_; }
      a_+=__uint_as_float((unsigned)__builtin_amdgcn_ds_swizzle((int)__float_as_uint(a_),(1<<10)|0x1f)); a_+=__uint_as_float((unsigned)__builtin_amdgcn_ds_swizzle((int)__float_as_uint(a_),(2<<10)|0x1f));
      a_+=__uint_as_float((unsigned)__builtin_amdgcn_ds_swizzle((int)__float_as_uint(a_),(4<<10)|0x1f)); a_+=__uint_as_float((unsigned)__builtin_amdgcn_ds_swizzle((int)__float_as_uint(a_),(8<<10)|0x1f));
      a_+=__uint_as_float((unsigned)__builtin_amdgcn_ds_swizzle((int)__float_as_uint(a_),(16<<10)|0x1f));
      ssq[r]=1.0f/__builtin_sqrtf(a_*(1.0f/128.0f)+1e-5f); }
    float g4[4];
    #pragma unroll
    for(int d0=0;d0<4;++d0)g4[d0]=gsub[d0*32+r32e]*gscale;
    bf16*stg=(bf16*)(shm+65536)+rg*4096;
    #pragma unroll
    for(int r=0;r<16;++r)
      #pragma unroll
      for(int d0=0;d0<4;++d0)stg[crow(r,hie)*128+d0*32+r32e]=__float2bfloat16(o[d0][r]*ssq[r]*g4[d0]);
    asm volatile("s_waitcnt lgkmcnt(0)":::"memory");
    bf16*Yw=Yb+(long)(q0+rg*32)*DM;
    #pragma unroll
    for(int i=0;i<8;++i){const int row=i*4+(lane_e>>4),ch=lane_e&15; const u32x4 v=*(const u32x4*)(stg+row*128+ch*8); *(u32x4*)(Yw+(long)row*DM+ch*8)=v;}
  }
  asm volatile("s_waitcnt vmcnt(0) lgkmcnt(0)\n\ts_barrier":::"memory");
  #undef DA_DMA
  #undef DA_RFL
}
#ifndef DB_VPRE
#define DB_VPRE 0
#endif
#ifndef DB_FILLX
#define DB_FILLX 1
#endif
template<int THRL> __device__ __forceinline__ void dattn2_unit(int qblk,const bf16*Qb,const bf16*__restrict__ Kb,const bf16*__restrict__ Vb,bf16*Yb,float lam,const float*gsub,float gscale,char*shm,const int tid_in){
  const int tid=tid_in,lane=tid&63,r32=lane&31,hi=lane>>5; const int wid=__builtin_amdgcn_readfirstlane(tid>>6);
  const int c=wid>>2, rg=wid&3;
  const int q0=qblk*DA_ROWS; const int NT=(q0+DA_ROWS)/KVBLK;
  const bf16*Qw=Qb+c*64+(long)(q0+rg*32)*DM;
  const unsigned lds0=(unsigned)(uintptr_t)shm; const lds_cptr shm3=(lds_cptr)shm;
  const int pk0=2*wid;
  const bf16*ksrc0=Kb+(pk0>>3)*64+(long)((pk0&7)*8+(lane>>3))*DM+((lane&7)^((lane>>3)&7))*8;
  const unsigned kdst0=lds0+(pk0>>3)*8192+(pk0&7)*1024;
  const bf16*vsrc0=Vb+(long)(16*(pk0&3)+(lane>>2))*DM+(pk0>>2)*32+(lane&3)*8;
  const unsigned vdst0=lds0+DA_V+pk0*1024;
  #define DB_RFL(x) ((unsigned)__builtin_amdgcn_readfirstlane((int)(x)))
  #define DB_DMA(t,so) do{ const long to_=(long)(t)*KVBLK*DM; \
      glds16(ksrc0+to_,DB_RFL(kdst0+(so))); glds16(ksrc0+to_+8*DM,DB_RFL(kdst0+(so)+1024)); \
      glds16(vsrc0+to_,DB_RFL(vdst0+(so))); glds16(vsrc0+to_+16*DM,DB_RFL(vdst0+(so)+1024)); }while(0)
  #define DB_SLOT(t) (((t)&3)*DA_SLOT)
  const lds_cptr kp0=shm3+c*8192+r32*128+((hi^(r32&7))*16);
  #define DB_KLD(kf_,kp_,d0) do{ const lds_cptr a_=(lds_cptr)(size_t)(((unsigned)(size_t)(kp_))^((unsigned)(d0)<<5)); kf_[2*(d0)]=*(const __attribute__((address_space(3))) bf16x8*)(a_); kf_[2*(d0)+1]=*(const __attribute__((address_space(3))) bf16x8*)(a_+4096); }while(0)
  const lds_cptr vp0=shm3+DA_V+((lane>>4)&1)*32+(lane&3)*8+(4*hi+((lane&15)>>2))*64;
  bf16x8 qr[4];
  DB_DMA(0,0); DB_DMA(1,DA_SLOT);
  #pragma unroll
  for(int d0=0;d0<4;++d0)qr[d0]=*reinterpret_cast<const bf16x8*>(&Qw[(long)r32*DM+d0*16+hi*8]);
  asm volatile("":"+v"(qr[0]),"+v"(qr[1]),"+v"(qr[2]),"+v"(qr[3]));
  float mref=0.f,l_reg=0.f; f32x16 o[4]; o[0]=f32x16{}; o[1]=f32x16{}; o[2]=f32x16{}; o[3]=f32x16{};
  f32x16 p0,p1; u32x4 pw0,pw1,pw2,pw3; s16x4 va[8],vb[8];
  #pragma unroll
  for(int r=0;r<16;++r){ p0[r]=0.f; p1[r]=0.f; }
  asm volatile("":"+v"(p0),"+v"(p1));
  const int qrel=rg*32+r32;
  #define DB_WAITT(u) do{ if((u)+1<NT){ asm volatile("s_waitcnt vmcnt(4)":::"memory"); } else { asm volatile("s_waitcnt vmcnt(0)":::"memory"); } }while(0)
  #define DB_ISSUE(u) do{ if((u)<NT){ DB_DMA((u),DB_SLOT(u)); } }while(0)
  #define DB_BAR() asm volatile("s_waitcnt lgkmcnt(0)\n\ts_barrier":::"memory")
  #define DB_BARP() asm volatile("s_waitcnt lgkmcnt(0)\n\ts_barrier":"+v"(p0),"+v"(p1)::"memory")
  #define DB_VLD(x,vp_,d0) do{ _Pragma("unroll") for(int ks_=0;ks_<4;++ks_){ x[2*ks_]=vtr((vp_)+(d0)*4096+ks_*1024); x[2*ks_+1]=vtr((vp_)+(d0)*4096+ks_*1024+512); } }while(0)
  #define DB_VF(x,ks) ((bf16x8){x[2*(ks)][0],x[2*(ks)][1],x[2*(ks)][2],x[2*(ks)][3],x[2*(ks)+1][0],x[2*(ks)+1][1],x[2*(ks)+1][2],x[2*(ks)+1][3]})
  #define DB_PVM(x,d0) do{ o[d0]=__builtin_amdgcn_mfma_f32_32x32x16_bf16(DB_VF(x,0),__builtin_bit_cast(bf16x8,pw0),o[d0],0,0,0); o[d0]=__builtin_amdgcn_mfma_f32_32x32x16_bf16(DB_VF(x,1),__builtin_bit_cast(bf16x8,pw1),o[d0],0,0,0); \
      o[d0]=__builtin_amdgcn_mfma_f32_32x32x16_bf16(DB_VF(x,2),__builtin_bit_cast(bf16x8,pw2),o[d0],0,0,0); o[d0]=__builtin_amdgcn_mfma_f32_32x32x16_bf16(DB_VF(x,3),__builtin_bit_cast(bf16x8,pw3),o[d0],0,0,0); }while(0)
  #define DB_QKM(kf_) do{ p0=__builtin_amdgcn_mfma_f32_32x32x16_bf16(kf_[0],qr[0],p0,0,0,0); p1=__builtin_amdgcn_mfma_f32_32x32x16_bf16(kf_[1],qr[0],p1,0,0,0); \
      _Pragma("unroll") for(int d0_=1;d0_<4;++d0_){ p0=__builtin_amdgcn_mfma_f32_32x32x16_bf16(kf_[2*d0_],qr[d0_],p0,0,0,0); p1=__builtin_amdgcn_mfma_f32_32x32x16_bf16(kf_[2*d0_+1],qr[d0_],p1,0,0,0); } }while(0)
  #define DB_FILL() do{ float nm_=-mref; asm volatile("":"+v"(nm_)); _Pragma("unroll") for(int r=0;r<16;++r){ p0[r]=nm_; p1[r]=nm_; } }while(0)
  #define DB_M(tp,tq) do{ const lds_cptr vp_=vp0+DB_SLOT(tp); const lds_cptr kp_=kp0+DB_SLOT(tq); bf16x8 kf_[8]; \
      if(!DB_VPRE){ DB_VLD(va,vp_,0); DB_VLD(vb,vp_,1); SBAR(); } DB_PVM(va,0); DB_VLD(va,vp_,2); SBAR(); \
      DB_PVM(vb,1); DB_VLD(vb,vp_,3); SBAR(); \
      DB_PVM(va,2); DB_KLD(kf_,kp_,0); DB_KLD(kf_,kp_,1); SBAR(); \
      DB_PVM(vb,3); DB_KLD(kf_,kp_,2); DB_KLD(kf_,kp_,3); SBAR(); \
      if(!DB_FILLX){ DB_FILL(); } DB_QKM(kf_); }while(0)
  #define DB_QK0(tq) do{ const lds_cptr kp_=kp0+DB_SLOT(tq); bf16x8 kf_[8]; DB_KLD(kf_,kp_,0); DB_KLD(kf_,kp_,1); DB_KLD(kf_,kp_,2); DB_KLD(kf_,kp_,3); SBAR(); DB_QKM(kf_); }while(0)
  #define DB_PVL(tp) do{ const lds_cptr vp_=vp0+DB_SLOT(tp); if(!DB_VPRE){ DB_VLD(va,vp_,0); DB_VLD(vb,vp_,1); SBAR(); } DB_PVM(va,0); DB_VLD(va,vp_,2); SBAR(); DB_PVM(vb,1); DB_VLD(vb,vp_,3); SBAR(); DB_PVM(va,2); SBAR(); DB_PVM(vb,3); }while(0)
  #define DB_X(tt,FIRST) do{ { const int jb_=(tt)-(NT-2); if(jb_>=0){ cmask(p0,p1,jb_,qrel,hi); } } \
      const float rm_=rowmax(p0,p1); \
      if(FIRST){ mref=rm_; _Pragma("unroll") for(int r=0;r<16;++r){ p0[r]-=rm_; p1[r]-=rm_; } } \
      else if(__any(rm_>(float)THRL)){ const float dl_=__builtin_fmaxf(rm_,0.f); const float f_=__builtin_amdgcn_exp2f(-dl_); mref+=dl_; l_reg*=f_; \
        _Pragma("unroll") for(int r=0;r<16;++r){ p0[r]-=dl_; p1[r]-=dl_; } \
        _Pragma("unroll") for(int d_=0;d_<4;++d_) _Pragma("unroll") for(int r=0;r<16;++r){ float x_=o[d_][r]; asm volatile("v_mul_f32_e32 %0, %0, %1":"+v"(x_):"v"(f_)); o[d_][r]=x_; } } \
      float sacc_=0.f; _Pragma("unroll") for(int r=0;r<16;++r){ p0[r]=__builtin_amdgcn_exp2f(p0[r]); p1[r]=__builtin_amdgcn_exp2f(p1[r]); sacc_+=p0[r]+p1[r]; } l_reg+=sacc_; \
      pw0=(u32x4){cvtpk_s(p0[0],p0[1]),cvtpk_s(p0[2],p0[3]),cvtpk_s(p0[4],p0[5]),cvtpk_s(p0[6],p0[7])}; pw1=(u32x4){cvtpk_s(p0[8],p0[9]),cvtpk_s(p0[10],p0[11]),cvtpk_s(p0[12],p0[13]),cvtpk_s(p0[14],p0[15])}; \
      pw2=(u32x4){cvtpk_s(p1[0],p1[1]),cvtpk_s(p1[2],p1[3]),cvtpk_s(p1[4],p1[5]),cvtpk_s(p1[6],p1[7])}; pw3=(u32x4){cvtpk_s(p1[8],p1[9]),cvtpk_s(p1[10],p1[11]),cvtpk_s(p1[12],p1[13]),cvtpk_s(p1[14],p1[15])}; \
      if(DB_VPRE){ const lds_cptr vq_=vp0+DB_SLOT(tt); DB_VLD(va,vq_,0); DB_VLD(vb,vq_,1); } if(DB_FILLX){ DB_FILL(); } }while(0)
  DB_WAITT(0);
  if(c==1){ DB_BAR(); DB_ISSUE(2); }
  DB_BAR();
  DB_QK0(0);
  if(c==1){ DB_WAITT(1); } DB_BARP(); DB_ISSUE(2+c);
  DB_X(0,true);
  for(int t=1;t<NT;++t){
    if(c==0){ DB_WAITT(t); } DB_BAR();
    DB_M(t-1,t);
    if(c==1){ DB_WAITT(t+1); } DB_BARP(); DB_ISSUE(t+2+c);
    DB_X(t,false);
  }
  DB_BAR(); DB_PVL(NT-1);
  if(c==0){ DB_BAR(); }
  int lane_e=lane; asm volatile("":"+v"(lane_e)); const int r32e=lane_e&31, hie=lane_e>>5;
  l_reg+=__uint_as_float((unsigned)__builtin_amdgcn_ds_bpermute((lane_e^32)<<2,(int)__float_as_uint(l_reg)));
  asm volatile("s_waitcnt vmcnt(0) lgkmcnt(0)\n\ts_barrier":::"memory");
  const float rl=__builtin_amdgcn_rcpf(l_reg);
  float*st2=(float*)shm+rg*4096+lane_e;
  if(c==1){ const float s_=lam*rl;
    #pragma unroll
    for(int d0=0;d0<4;++d0)
      #pragma unroll
      for(int r=0;r<16;++r)st2[(d0*16+r)*64]=o[d0][r]*s_;
  }
  asm volatile("s_waitcnt lgkmcnt(0)\n\ts_barrier":::"memory");
  if(c==0){
    float a_=0.f;
    #pragma unroll
    for(int d0=0;d0<4;++d0)
      #pragma unroll
      for(int r=0;r<16;++r){ const float x_=o[d0][r]*rl-st2[(d0*16+r)*64]; o[d0][r]=x_; a_+=x_*x_; }
    a_+=__uint_as_float((unsigned)__builtin_amdgcn_ds_bpermute((lane_e^32)<<2,(int)__float_as_uint(a_)));
    const float rs=gscale/__builtin_sqrtf(a_*(1.0f/128.0f)+1e-5f);
    char*stg=shm+65536+rg*(32*272)+r32e*272+hie*8;
    #pragma unroll
    for(int d0=0;d0<4;++d0)
      #pragma unroll
      for(int g=0;g<4;++g){ const float4 gv=*reinterpret_cast<const float4*>(gsub+d0*32+8*g+4*hie);
        uint2 w_; w_.x=cvtpk_s(o[d0][4*g]*rs*gv.x,o[d0][4*g+1]*rs*gv.y); w_.y=cvtpk_s(o[d0][4*g+2]*rs*gv.z,o[d0][4*g+3]*rs*gv.w);
        *reinterpret_cast<uint2*>(stg+(d0*32+8*g)*2)=w_; }
    asm volatile("s_waitcnt lgkmcnt(0)":::"memory");
    bf16*Yw=Yb+(long)(q0+rg*32)*DM; const char*stb=shm+65536+rg*(32*272);
    #pragma unroll
    for(int i=0;i<8;++i){const int row=i*4+(lane_e>>4),ch=lane_e&15; const u32x4 v=*(const u32x4*)(stb+row*272+ch*16); *(u32x4*)(Yw+(long)row*DM+ch*8)=v;}
  }
  asm volatile("s_waitcnt vmcnt(0) lgkmcnt(0)\n\ts_barrier":::"memory");
  #undef DB_RFL
  #undef DB_KLD
  #undef DB_DMA
  #undef DB_SLOT
  #undef DB_WAITT
  #undef DB_ISSUE
  #undef DB_BARP
  #undef DB_BAR
  #undef DB_VLD
  #undef DB_VF
  #undef DB_PVM
  #undef DB_QKM
  #undef DB_M
  #undef DB_QK0
  #undef DB_PVL
  #undef DB_X
}
constexpr int ATTN_LDS_BYTES=LDS_BYTES;
#undef SBAR
#undef WAIT_BAR
}

#define GAS __attribute__((address_space(1)))
#define LAS __attribute__((address_space(3)))
typedef unsigned short bf16;
typedef unsigned v4u __attribute__((ext_vector_type(4)));
typedef float f32x4 __attribute__((ext_vector_type(4)));
typedef short bf16x8 __attribute__((ext_vector_type(8)));
typedef GAS unsigned gu32;
typedef GAS unsigned long long gu64;
#define RLX_AGENT __ATOMIC_RELAXED, __HIP_MEMORY_SCOPE_AGENT
#define LDS_WAIT() asm volatile("s_waitcnt lgkmcnt(0)" ::: "memory")
#define VM_WAIT() asm volatile("s_waitcnt vmcnt(0)" ::: "memory")
__device__ __forceinline__ unsigned long long rt() { return __builtin_amdgcn_s_memrealtime(); }
__device__ __forceinline__ unsigned f2bf(float f) { unsigned u = __builtin_bit_cast(unsigned, f); return (u + 0x7fffu + ((u >> 16) & 1u)) >> 16; }
__device__ __forceinline__ unsigned pk2(float lo, float hi) { return f2bf(lo) | (f2bf(hi) << 16); }

#define XB_TMO      128
#define XB_XCNT(j)  (256  + 64 * (j))
#define XB_XSUB(j)  (1280 + 64 * (j))
#define XB_XGEN(j)  (2304 + 64 * (j))
#define XB_TOP      3328
#define XB_TOPGEN   3392
#define XCD_BAR_WORDS 3456
#define XB_SPIN_CAP (1u << 26)

__device__ __forceinline__ unsigned xb_ld(unsigned* p)              { return __hip_atomic_load(p, __ATOMIC_RELAXED, __HIP_MEMORY_SCOPE_AGENT); }
__device__ __forceinline__ unsigned xb_add(unsigned* p, unsigned v) { return __hip_atomic_fetch_add(p, v, __ATOMIC_RELAXED, __HIP_MEMORY_SCOPE_AGENT); }
__device__ __forceinline__ unsigned xb_xcc_id() { return (unsigned)__builtin_amdgcn_s_getreg((3 << 11) | 20) & 0xFu; }
#define XB_SPIN(cond, bar) do { unsigned _sp = 0; while (cond) { __builtin_amdgcn_s_sleep(1); \
    if ((++_sp & 255u) == 0u) { if (xb_ld(&(bar)[XB_TMO])) break; if (_sp > XB_SPIN_CAP) { atomicAdd(&(bar)[XB_TMO], 1u); break; } } } } while (0)

struct XcdBarrier {
    unsigned* bar; unsigned x;
    volatile LAS unsigned* st;
};

__device__ __forceinline__ XcdBarrier xcd_barrier_post(unsigned* bar, volatile LAS unsigned* st, const int tid) {
    XcdBarrier b; b.bar = bar; b.x = xb_xcc_id(); b.st = st;
    if (tid == 0) (void)xb_add(&bar[XB_XCNT(b.x)], 1u);
    return b;
}
__device__ __forceinline__ void xcd_barrier_complete(unsigned* bar, unsigned x, unsigned& nloc, unsigned& nx) {
    const unsigned G = gridDim.x * gridDim.y * gridDim.z;
    unsigned sum, cnt, mine, sp = 0u;
    for (;;) {
        sum = 0u; cnt = 0u; mine = 0u;
#pragma unroll
        for (unsigned j = 0; j < 16; ++j) { const unsigned c = xb_ld(&bar[XB_XCNT(j)]); sum += c; cnt += (c > 0u) ? 1u : 0u; mine = (j == x) ? c : mine; }
        if (sum == G) break;
        __builtin_amdgcn_s_sleep(1);
        if ((++sp & 255u) == 0u) { if (xb_ld(&bar[XB_TMO])) break; if (sp > XB_SPIN_CAP) { atomicAdd(&bar[XB_TMO], 1u); break; } }
    }
    nloc = mine > 0u ? mine : 1u; nx = cnt > 0u ? cnt : 1u;
}

__device__ __forceinline__ void xcd_barrier(const XcdBarrier& b, const int tid) {
    asm volatile("s_waitcnt vmcnt(0)" ::: "memory");
    __syncthreads();
    if (tid == 0) {
        unsigned* bar = b.bar;
        __builtin_amdgcn_s_waitcnt(0);
        unsigned nloc = b.st[0], nx = b.st[1];
        if (nloc == 0u) { xcd_barrier_complete(bar, b.x, nloc, nx); b.st[0] = nloc; b.st[1] = nx; }
        const unsigned old = xb_add(&bar[XB_XSUB(b.x)], 1u);
        const unsigned gen = old / nloc;
        if (old + 1u == (gen + 1u) * nloc) {
            __builtin_amdgcn_fence(__ATOMIC_RELEASE, "agent");
            asm volatile("s_waitcnt vmcnt(0)" ::: "memory");
            const unsigned og = xb_add(&bar[XB_TOP], 1u);
            const unsigned tg = og / nx;
            if (og + 1u == (tg + 1u) * nx) xb_add(&bar[XB_TOPGEN], 1u);
            else XB_SPIN(xb_ld(&bar[XB_TOPGEN]) == tg, bar);
            __builtin_amdgcn_fence(__ATOMIC_ACQUIRE, "agent");
            xb_add(&bar[XB_XGEN(b.x)], 1u);
            asm volatile("s_waitcnt vmcnt(0)" ::: "memory");
        } else {
            XB_SPIN(xb_ld(&bar[XB_XGEN(b.x)]) == gen, bar);
            __builtin_amdgcn_fence(__ATOMIC_ACQUIRE, "agent");
            asm volatile("s_waitcnt vmcnt(0)" ::: "memory");
        }
    }
    __syncthreads();
}

constexpr int NWAVES = 8;
constexpr int NTOK = 65536, NH = 32768, DMODEL = 1024, SEQLEN = 4096, INCOLS = 5632, DFF = 2816, NEXP = 8;
constexpr int MOE_PANELS_MAX = 264;
constexpr float EPS_NORM = 1e-6f, EPS_SUBLN = 1e-5f;

constexpr size_t MiB = 1u << 20;
constexpr size_t WS_CTL = 0, CTL_ZERO_BYTES = 1 * MiB;
constexpr size_t WS_WIN = 1 * MiB;
constexpr size_t WS_WGLU = 23 * MiB;
constexpr size_t WS_WPS = 24 * MiB;
constexpr size_t WS_WPA = 26 * MiB;
constexpr size_t WS_WOUT = 30 * MiB;
constexpr size_t WS_WDGU = 34 * MiB;
constexpr size_t WS_WDD = 45 * MiB;
constexpr size_t WS_WMGU = 51 * MiB;
constexpr size_t WS_WMD = 139 * MiB;
constexpr size_t WS_TZF = 183 * MiB;
constexpr size_t WS_EM = 223 * MiB;
constexpr size_t WS_ROPE = 239 * MiB;
constexpr size_t WS_ROUTE = 255 * MiB;
constexpr size_t WS_ACT = 260 * MiB;
constexpr size_t WS_END = 960 * MiB;
constexpr size_t A_HB = 0, A_UBUF = 64 * MiB, A_SLOC = 104 * MiB, A_Q = 120 * MiB, A_K = 184 * MiB, A_V = 248 * MiB, A_SGS = 312 * MiB, A_SGA = 376 * MiB, A_YA = 440 * MiB, A_YA2 = 472 * MiB, A_OV = 504 * MiB, A_YB = 632 * MiB;
constexpr size_t A_H2 = 0, A_FA = 64 * MiB;
constexpr size_t A_H2M = 632 * MiB, A_H2G = 0, A_AG = 132 * MiB, A_YG = 0;
constexpr size_t A_XB = 504 * MiB;
static_assert(A_UBUF == pg8::EA_U && A_Q == pg8::EA_Q && A_K == pg8::EA_K && A_V == pg8::EA_V && A_SGS == pg8::EA_SGS && A_SGA == pg8::EA_SGA, "EpiIn offsets");
static_assert(A_YB + 64 * MiB <= WS_END - WS_ACT && A_YA2 + 32 * MiB <= A_XB && A_XB + 128 * MiB <= A_YB && A_AG + 363 * MiB <= A_XB && A_H2G + 132 * MiB <= A_AG && A_H2M >= A_XB + 128 * MiB && A_H2M + 64 * MiB <= WS_END - WS_ACT && A_FA + 176 * MiB <= A_XB, "act map");
constexpr size_t R_E = 0, R_W = 256 * 1024, R_S = 512 * 1024, R_CNT = 768 * 1024;
constexpr int CW_BAR = 4096;

constexpr int RING_OFF = 0, RING_BYTES = 131072;
constexpr int LDSCTL_OFF = RING_BYTES, MISC_OFF = LDSCTL_OFF + 320;
constexpr int LDS_BYTES = 147456;

constexpr int PTR_OFF = LDSCTL_OFF + 1024;
struct Args { const void* in[31]; float* out; unsigned char* ws; };
__device__ __forceinline__ unsigned long long ldp64(LAS unsigned char* L, int slot) {
    const unsigned long long v = ((volatile LAS unsigned long long*)(L + PTR_OFF))[slot];
    const unsigned lo = __builtin_amdgcn_readfirstlane((unsigned)v), hi = __builtin_amdgcn_readfirstlane((unsigned)(v >> 32));
    return ((unsigned long long)hi << 32) | lo;
}
#define LDP(T, slot) ((T*)(GAS T*)(uintptr_t)ldp64(L, (slot)))

#define SWZ_XOR(k) (((k) << 10) | 0x1f)
#define swz_xor(v, pat) __builtin_bit_cast(float, __builtin_amdgcn_ds_swizzle(__builtin_bit_cast(int, (float)(v)), (pat)))
__device__ __forceinline__ float wave_sum(float v) {
#define WS_DPP(x, ctrl) __builtin_bit_cast(float, __builtin_amdgcn_update_dpp(0, __builtin_bit_cast(int, (float)(x)), (ctrl), 0xf, 0xf, false))
    v += WS_DPP(v, 0xB1); v += WS_DPP(v, 0x4E); v += WS_DPP(v, 0x141); v += WS_DPP(v, 0x140);
#undef WS_DPP
    const float r0 = __builtin_bit_cast(float, __builtin_amdgcn_readlane(__builtin_bit_cast(int, v), 0)), r1 = __builtin_bit_cast(float, __builtin_amdgcn_readlane(__builtin_bit_cast(int, v), 16));
    const float r2 = __builtin_bit_cast(float, __builtin_amdgcn_readlane(__builtin_bit_cast(int, v), 32)), r3 = __builtin_bit_cast(float, __builtin_amdgcn_readlane(__builtin_bit_cast(int, v), 48));
    return (r0 + r1) + (r2 + r3);
}
__device__ __forceinline__ void tr_item(const float* W, int ldw, int K, bf16* WTn0, int k0, int srccol, LAS float* scr, int lane) {
    float wv[32];
#pragma unroll
    for (int i = 0; i < 32; ++i) wv[i] = W[(size_t)(k0 + 2 * i + (lane >> 5)) * ldw + srccol];
#pragma unroll
    for (int i = 0; i < 32; ++i) scr[(2 * i + (lane >> 5)) * 33 + (lane & 31)] = wv[i];
    LDS_WAIT(); asm volatile("" ::: "memory");
    const int c = lane & 7;
#pragma unroll
    for (int j = 0; j < 4; ++j) { const int n = (lane >> 3) + 8 * j; const LAS float* s = scr + (8 * c) * 33 + n;
        v4u o; o.x = pk2(s[0 * 33], s[1 * 33]); o.y = pk2(s[2 * 33], s[3 * 33]); o.z = pk2(s[4 * 33], s[5 * 33]); o.w = pk2(s[6 * 33], s[7 * 33]);
        *(GAS v4u*)(WTn0 + (size_t)n * K + k0 + 8 * c) = o; }
    LDS_WAIT(); asm volatile("" ::: "memory");
}
__device__ __forceinline__ int win_orig(int n) { if (n < 512 || n >= 2560) return n; const int i = n & 63; return (n & ~63) + 16 * ((i >> 5) & 1) + 4 * ((i >> 3) & 3) + (i & 3) + 32 * ((i >> 2) & 1); }
__device__ __forceinline__ void tr_plain(const float* W, int K, int N, bf16* WT, int item, LAS float* scr, int lane) {
    const int nblk = N / 32, kb = item / nblk, nb = item % nblk;
    tr_item(W, N, K, WT + (size_t)(32 * nb) * K, 64 * kb, 32 * nb + (lane & 31), scr, lane);
}
__device__ __forceinline__ void tr_win(const float* W, bf16* WT, int item, LAS float* scr, int lane) {
    const int nblk = INCOLS / 32, kb = item / nblk, nb = item % nblk;
    tr_item(W, INCOLS, DMODEL, WT + (size_t)(32 * nb) * DMODEL, 64 * kb, win_orig(32 * nb + (lane & 31)), scr, lane);
}
__device__ __forceinline__ void tr_gu(const float* Wg, const float* Wu, bf16* WT, int item, LAS float* scr, int lane) {
    const int nblk = INCOLS / 32, kb = item / nblk, nb = item % nblk; const int n0 = 32 * nb, pn = n0 >> 8, r = n0 & 255;
    const float* W = r < 128 ? Wg : Wu; const int col = pn * 128 + (r & 127) + (lane & 31);
    tr_item(W, DFF, DMODEL, WT + (size_t)n0 * DMODEL, 64 * kb, col, scr, lane);
}
struct S5In { const float *lam_re, *lam_im, *log_dt, *b_re, *b_im, *c_re, *c_im, *dd; };
__device__ __forceinline__ v4u pack8f(const float* v) { v4u o; o.x = pk2(v[0], v[1]); o.y = pk2(v[2], v[3]); o.z = pk2(v[4], v[5]); o.w = pk2(v[6], v[7]); return o; }
__device__ __forceinline__ void s5_item(LAS unsigned char* L, int tid, const S5In& P, int lg, int d, bf16* TZF, bf16* EM) {
    LAS float* sm = (LAS float*)(L);
    LAS float *s_fr = sm, *s_fi = sm + 64, *s_apr = sm + 128, *s_api = sm + 192, *BBr = sm + 256, *BBi = sm + 1280, *CAr = sm + 2304, *CAi = sm + 3328, *Kd = sm + 4352;
    if (tid < 64) {
        const int p = tid;
        const float dt = expf(P.log_dt[lg]);
        const float lr = P.lam_re[lg * 64 + p], li = P.lam_im[lg * 64 + p];
        const float mag = expf(lr * dt); float sn, cs; sincosf(li * dt, &sn, &cs);
        const float ar = mag * cs, ai = mag * sn;
        const float den = lr * lr + li * li, nr = ar - 1.0f, ni = ai;
        s_fr[p] = (nr * lr + ni * li) / den; s_fi[p] = (ni * lr - nr * li) / den;
        const float fd = (float)d; const float magd = expf(fd * lr * dt); float snd, csd; sincosf(fd * li * dt, &snd, &csd);
        s_apr[p] = magd * csd; s_api[p] = magd * snd;
    }
    __syncthreads();
    for (int idx = tid; idx < 1024; idx += 512) {
        { const int p = idx >> 4; const float br = P.b_re[(size_t)lg * 1024 + idx], bi = P.b_im[(size_t)lg * 1024 + idx]; const float fr_ = s_fr[p], fi_ = s_fi[p];
          BBr[idx] = fr_ * br - fi_ * bi; BBi[idx] = fr_ * bi + fi_ * br; }
        { const int p = idx & 63; const float cr = P.c_re[(size_t)lg * 1024 + idx], ci = P.c_im[(size_t)lg * 1024 + idx]; const float ar_ = s_apr[p], ai_ = s_api[p];
          CAr[idx] = cr * ar_ - ci * ai_; CAi[idx] = cr * ai_ + ci * ar_; }
    }
    __syncthreads();
    if (d <= 31 && tid < 256) { const int j = tid >> 4, jp = tid & 15; float acc = 0.f;
        for (int p = 0; p < 64; ++p) acc += CAr[j * 64 + p] * BBr[p * 16 + jp] - CAi[j * 64 + p] * BBi[p * 16 + jp];
        if (d == 0 && j == jp) acc += P.dd[lg * 16 + j];
        Kd[tid] = acc; }
    __syncthreads();
    bf16* TZ = TZF + (size_t)lg * 512 * 640; bf16* EE = EM + (size_t)lg * 256 * 512;
    if (d <= 31) {
        const int cnt = (32 - d) * 16;
        for (int idx = tid; idx < cnt; idx += 512) { const int tt = idx >> 4, j = idx & 15; float v[16];
#pragma unroll
            for (int q = 0; q < 16; ++q) v[q] = Kd[j * 16 + q];
            bf16* dst = TZ + (size_t)((d + tt) * 16 + j) * 640 + tt * 16;
            *(GAS v4u*)dst = pack8f(v); *(GAS v4u*)(dst + 8) = pack8f(v + 8);
            if (d >= 1) { bf16* dz = TZ + (size_t)(tt * 16 + j) * 640 + (d + tt) * 16; const v4u z = {0u, 0u, 0u, 0u}; *(GAS v4u*)dz = z; *(GAS v4u*)(dz + 8) = z; } }
        if (tid < 128) { const int ri = tid >> 6, p = tid & 63; const float ar_ = s_apr[p], ai_ = s_api[p]; float v[16];
#pragma unroll
            for (int q = 0; q < 16; ++q) { const float br = BBr[p * 16 + q], bi = BBi[p * 16 + q]; v[q] = ri == 0 ? (ar_ * br - ai_ * bi) : (ar_ * bi + ai_ * br); }
            bf16* dst = EE + (size_t)tid * 512 + (31 - d) * 16; *(GAS v4u*)dst = pack8f(v); *(GAS v4u*)(dst + 8) = pack8f(v + 8);
        } else if (tid < 256) { bf16* dz = EE + (size_t)tid * 512 + (31 - d) * 16; const v4u z = {0u, 0u, 0u, 0u}; *(GAS v4u*)dz = z; *(GAS v4u*)(dz + 8) = z; }
    }
    if (d >= 1 && tid < 256) { const int j = tid >> 4, ri = (tid >> 3) & 1, pc = tid & 7; float v[8];
#pragma unroll
        for (int q = 0; q < 8; ++q) v[q] = ri == 0 ? CAr[j * 64 + pc * 8 + q] : -CAi[j * 64 + pc * 8 + q];
        *(GAS v4u*)(TZ + (size_t)((d - 1) * 16 + j) * 640 + 512 + ri * 64 + pc * 8) = pack8f(v); }
    __syncthreads();
}
__device__ __forceinline__ void norm_rows4(const float* x0, size_t xstep, const f32x4 (&g)[4], bf16* o0, size_t ostep, int lane) {
    f32x4 h[4][4];
#pragma unroll
    for (int r = 0; r < 4; ++r) { const GAS f32x4* xr = (const GAS f32x4*)(x0 + r * xstep) + lane;
#pragma unroll
        for (int j = 0; j < 4; ++j) h[r][j] = xr[64 * j]; }
#pragma unroll
    for (int r = 0; r < 4; ++r) { float s2 = 0.f;
#pragma unroll
        for (int j = 0; j < 4; ++j) s2 += (h[r][j].x * h[r][j].x + h[r][j].y * h[r][j].y) + (h[r][j].z * h[r][j].z + h[r][j].w * h[r][j].w);
        const float rs = 1.0f / sqrtf(wave_sum(s2) * (1.0f / DMODEL) + EPS_NORM);
        GAS unsigned long long* o8 = (GAS unsigned long long*)(o0 + r * ostep) + lane;
#pragma unroll
        for (int j = 0; j < 4; ++j) { const f32x4 v = h[r][j] * rs * g[j]; o8[64 * j] = (unsigned long long)pk2(v.x, v.y) | ((unsigned long long)pk2(v.z, v.w) << 32); } }
}
__device__ __forceinline__ f32x4 bf4_f32(unsigned long long a) { const unsigned lo = (unsigned)a, hi = (unsigned)(a >> 32); f32x4 r; r.x = __uint_as_float(lo << 16); r.y = __uint_as_float(lo & 0xffff0000u); r.z = __uint_as_float(hi << 16); r.w = __uint_as_float(hi & 0xffff0000u); return r; }
__device__ __forceinline__ void norm_rows4b(const bf16* x0, size_t xstep, const f32x4 (&g)[4], bf16* o0, size_t ostep, int lane) {
    unsigned long long hb[4][4];
#pragma unroll
    for (int r = 0; r < 4; ++r) { const GAS unsigned long long* xr = (const GAS unsigned long long*)(x0 + r * xstep) + lane;
#pragma unroll
        for (int j = 0; j < 4; ++j) hb[r][j] = xr[64 * j]; }
#pragma unroll
    for (int r = 0; r < 4; ++r) { float s2 = 0.f; f32x4 h[4];
#pragma unroll
        for (int j = 0; j < 4; ++j) { h[j] = bf4_f32(hb[r][j]); s2 += (h[j].x * h[j].x + h[j].y * h[j].y) + (h[j].z * h[j].z + h[j].w * h[j].w); }
        const float rs = 1.0f / sqrtf(wave_sum(s2) * (1.0f / DMODEL) + EPS_NORM);
        GAS unsigned long long* o8 = (GAS unsigned long long*)(o0 + r * ostep) + lane;
#pragma unroll
        for (int j = 0; j < 4; ++j) { const f32x4 v = h[j] * rs * g[j]; o8[64 * j] = (unsigned long long)pk2(v.x, v.y) | ((unsigned long long)pk2(v.z, v.w) << 32); } }
}
__device__ __forceinline__ void norm_row(const float* xrow, const float* gain, bf16* orow, int lane, f32x4 (&hn)[4]) {
    const GAS f32x4* xr = (const GAS f32x4*)xrow + lane; const GAS f32x4* gr = (const GAS f32x4*)gain + lane;
    float s2 = 0.f;
#pragma unroll
    for (int j = 0; j < 4; ++j) { hn[j] = xr[64 * j]; s2 += (hn[j].x * hn[j].x + hn[j].y * hn[j].y) + (hn[j].z * hn[j].z + hn[j].w * hn[j].w); }
    const float rs = 1.0f / sqrtf(wave_sum(s2) * (1.0f / DMODEL) + EPS_NORM);
    GAS unsigned long long* o8 = (GAS unsigned long long*)orow + lane;
#pragma unroll
    for (int j = 0; j < 4; ++j) { const f32x4 g = gr[64 * j]; hn[j] = hn[j] * rs * g;
        o8[64 * j] = (unsigned long long)pk2(hn[j].x, hn[j].y) | ((unsigned long long)pk2(hn[j].z, hn[j].w) << 32); }
}

__global__ void __launch_bounds__(NWAVES * 64, 2) trunk_fwd(Args args) {
    extern __shared__ __attribute__((aligned(16))) unsigned char lds[];
    const int WAVE = __builtin_amdgcn_readfirstlane((int)threadIdx.x >> 6);
#define MYTID() ({ int l_; asm volatile("v_mbcnt_lo_u32_b32 %0, -1, 0\n\tv_mbcnt_hi_u32_b32 %0, -1, %0" : "=v"(l_)); WAVE * 64 + l_; })
    LAS unsigned char* const L0 = (LAS unsigned char*)lds;
#define OPQ LAS unsigned char* L = L0; asm volatile("" : "+s"(L))
    OPQ;
    {
        const int tid0 = MYTID();
        for (int u = tid0; u < (LDS_BYTES - LDSCTL_OFF) / 4; u += NWAVES * 64) ((LAS unsigned*)(L + LDSCTL_OFF))[u] = 0u;
        __syncthreads();
        if (tid0 == 0) {
#pragma unroll
            for (int k = 0; k < 31; ++k) ((LAS unsigned long long*)(L + PTR_OFF))[k] = (unsigned long long)(uintptr_t)args.in[k];
            ((LAS unsigned long long*)(L + PTR_OFF))[31] = (unsigned long long)(uintptr_t)args.out;
            ((LAS unsigned long long*)(L + PTR_OFF))[32] = (unsigned long long)(uintptr_t)args.ws; }
        __syncthreads();
    }
    { XcdBarrier b0 = xcd_barrier_post((unsigned*)(LDP(unsigned char, 32) + WS_CTL) + CW_BAR, (volatile LAS unsigned*)(L + MISC_OFF) + 8, MYTID()); (void)b0; }
#define GRID_BAR() do { OPQ; XcdBarrier b_; b_.bar = (unsigned*)(LDP(unsigned char, 32) + WS_CTL) + CW_BAR; b_.x = xb_xcc_id(); b_.st = (volatile LAS unsigned*)(L + MISC_OFF) + 8; xcd_barrier(b_, MYTID()); } while (0)
#define LQ() ({ int l_ = l; asm volatile("" : "+s"(l_)); l_; })
#define TID_SETUP OPQ; int wave_ = WAVE; asm volatile("" : "+s"(wave_)); const int wave = wave_; const int tid = MYTID(), lane = tid & 63; const int G = gridDim.x; const int vcu = ((int)blockIdx.x % 8) * (G / 8) + (int)blockIdx.x / 8; const int gw = vcu * NWAVES + wave, NGW = G * NWAVES; (void)lane; (void)gw; (void)NGW; (void)tid
#define WSP(T, off) ((T*)(LDP(unsigned char, 32) + (off)))
#define ACTP(T, off) ((T*)(LDP(unsigned char, 32) + WS_ACT + (off)))

    {
        TID_SETUP;
        LAS float* scr = (LAS float*)(L + RING_OFF + wave * 16384);
        constexpr int I_WIN = 16 * 176, I_GLU = 8 * 16, I_PS = 8 * 32, I_PA = 16 * 32, I_OUT = 16 * 32, I_GU = 16 * 176, I_DN = 44 * 32;
        constexpr int I_LAYER = I_WIN + I_GLU + I_PS + I_PA + I_OUT;
        constexpr int NITEMS = 2 * I_LAYER + I_GU + I_DN + 8 * I_GU + 8 * I_DN;
        for (int it = gw; it < NITEMS; it += NGW) {
            int r = it;
            if (r < 2 * I_LAYER) { const int l = r / I_LAYER; r -= l * I_LAYER;
                if (r < I_WIN) { tr_win(LDP(const float, 3) + (size_t)l * DMODEL * INCOLS, WSP(bf16, WS_WIN) + (size_t)l * INCOLS * DMODEL, r, scr, lane); continue; } r -= I_WIN;
                if (r < I_GLU) { tr_plain(LDP(const float, 12) + (size_t)l * 512 * 512, 512, 512, WSP(bf16, WS_WGLU) + (size_t)l * 512 * 512, r, scr, lane); continue; } r -= I_GLU;
                if (r < I_PS) { tr_plain(LDP(const float, 19) + (size_t)l * 512 * 1024, 512, 1024, WSP(bf16, WS_WPS) + (size_t)l * 1024 * 512, r, scr, lane); continue; } r -= I_PS;
                if (r < I_PA) { tr_plain(LDP(const float, 20) + (size_t)l * 1024 * 1024, 1024, 1024, WSP(bf16, WS_WPA) + (size_t)l * 1024 * 1024, r, scr, lane); continue; } r -= I_PA;
                tr_plain(LDP(const float, 21) + (size_t)l * 1024 * 1024, 1024, 1024, WSP(bf16, WS_WOUT) + (size_t)l * 1024 * 1024, r, scr, lane); continue; }
            r -= 2 * I_LAYER;
            if (r < I_GU) { tr_gu(LDP(const float, 23), LDP(const float, 24), WSP(bf16, WS_WDGU), r, scr, lane); continue; } r -= I_GU;
            if (r < I_DN) { tr_plain(LDP(const float, 25), DFF, DMODEL, WSP(bf16, WS_WDD), r, scr, lane); continue; } r -= I_DN;
            if (r < 8 * I_GU) { const int e = r / I_GU; r -= e * I_GU; tr_gu(LDP(const float, 27) + (size_t)e * DMODEL * DFF, LDP(const float, 28) + (size_t)e * DMODEL * DFF, WSP(bf16, WS_WMGU) + (size_t)e * INCOLS * DMODEL, r, scr, lane); continue; } r -= 8 * I_GU;
            { const int e = r / I_DN; r -= e * I_DN; tr_plain(LDP(const float, 29) + (size_t)e * DFF * DMODEL, DFF, DMODEL, WSP(bf16, WS_WMD) + (size_t)e * DMODEL * DFF, r, scr, lane); }
        }
        __syncthreads();
        { S5In s5p; s5p.lam_re = LDP(const float, 4); s5p.lam_im = LDP(const float, 5); s5p.log_dt = LDP(const float, 6); s5p.b_re = LDP(const float, 7); s5p.b_im = LDP(const float, 8);
          s5p.c_re = LDP(const float, 9); s5p.c_im = LDP(const float, 10); s5p.dd = LDP(const float, 11);
          for (int it = vcu; it < 2 * 32 * 33; it += G) s5_item(L, tid, s5p, it / 33, it % 33, WSP(bf16, WS_TZF), WSP(bf16, WS_EM)); }
        { const int* positions = LDP(const int, 1); float* ROPE = WSP(float, WS_ROPE);
          for (int idx = vcu * (NWAVES * 64) + tid; idx < NTOK * 32; idx += G * NWAVES * 64) { const int n = idx >> 5, fi = idx & 31;
            const float invf = powf(10000.0f, -(float)(2 * fi) / 64.0f); const float ang = (float)positions[n] * invf; float sn, cs; sincosf(ang, &sn, &cs);
            ROPE[(size_t)n * 64 + fi] = cs; ROPE[(size_t)n * 64 + 32 + fi] = sn; } }
    }
    GRID_BAR();

    for (int l = 0; l < 2; ++l) {
        for (int half = 0; half < 2; ++half) {
            const int tokbase = half * NH;
            { TID_SETUP; const float* xsrc = LDP(const float, 0); const bf16* XB = ACTP(const bf16, A_XB); const float* gain = LDP(const float, 2) + l * DMODEL; bf16* HB = ACTP(bf16, A_HB);
              f32x4 gq[4];
#pragma unroll
              for (int j = 0; j < 4; ++j) gq[j] = ((const GAS f32x4*)gain + lane)[64 * j];
              if (LQ() == 0) { for (int m = gw; m < NH; m += 4 * NGW) norm_rows4(xsrc + (size_t)(tokbase + m) * DMODEL, (size_t)NGW * DMODEL, gq, HB + (size_t)m * DMODEL, (size_t)NGW * DMODEL, lane); }
              else { for (int m = gw; m < NH; m += 4 * NGW) norm_rows4b(XB + (size_t)(tokbase + m) * DMODEL, (size_t)NGW * DMODEL, gq, HB + (size_t)m * DMODEL, (size_t)NGW * DMODEL, lane); } }
            GRID_BAR();
            { OPQ; pg8::Gemm g{ACTP(bf16, A_HB), WSP(bf16, WS_WIN) + (size_t)l * INCOLS * DMODEL, DMODEL, DMODEL, DMODEL}; pg8::SchedPlain S; S.init(NH / 256, INCOLS / 256, gridDim.x, (int)blockIdx.x);
              pg8::EpiIn E{ACTP(unsigned char, 0), WSP(const float, WS_ROPE), tokbase};
              pg8::gemm_phase<pg8::EpiIn, pg8::SchedPlain, true, true>(L0 + RING_OFF, g, S, E, MYTID()); }
            GRID_BAR();
            { OPQ; pg8::Gemm g{ACTP(bf16, A_UBUF), WSP(bf16, WS_EM) + (size_t)l * 32 * 256 * 512, 640, 512, 512}; pg8::SchedS5 S; S.init(1, gridDim.x, (int)blockIdx.x);
              pg8::EpiSloc E{ACTP(float, A_SLOC)};
              pg8::gemm_phase<pg8::EpiSloc, pg8::SchedS5, true, true>(L0 + RING_OFF, g, S, E, MYTID()); }
            GRID_BAR();
            { TID_SETUP;
              if (wave == 0) {
                const int id = vcu * 64 + lane;
                if (id < 8 * 32 * 64) { const int bl = id >> 11, g = (id >> 6) & 31, p = id & 63; const int lg = l * 32 + g;
                    const float dt = expf(LDP(const float, 6)[lg]); const float lr = LDP(const float, 4)[lg * 64 + p], li = LDP(const float, 5)[lg * 64 + p];
                    const float magT = expf(32.0f * lr * dt); float snT, csT; sincosf(32.0f * li * dt, &snT, &csT); const float aTr = magT * csT, aTi = magT * snT;
                    float sr = 0.f, si = 0.f; const size_t row0 = (size_t)g * 1024 + (size_t)bl * 128;
                    const float* sl = ACTP(const float, A_SLOC) + row0 * 128 + p; bf16* ub = ACTP(bf16, A_UBUF) + row0 * 640 + 512 + p;
                    for (int c0 = 0; c0 < 128; c0 += 8) { float lr_[8], li_[8];
#pragma unroll
                        for (int q = 0; q < 8; ++q) { lr_[q] = sl[(size_t)(c0 + q) * 128]; li_[q] = sl[(size_t)(c0 + q) * 128 + 64]; }
#pragma unroll
                        for (int q = 0; q < 8; ++q) { ub[(size_t)(c0 + q) * 640] = (bf16)f2bf(sr); ub[(size_t)(c0 + q) * 640 + 64] = (bf16)f2bf(si);
                            const float nr_ = aTr * sr - aTi * si + lr_[q], ni_ = aTr * si + aTi * sr + li_[q]; sr = nr_; si = ni_; } } }
              } }
            GRID_BAR();
            { OPQ; pg8::Gemm g{ACTP(bf16, A_UBUF), WSP(bf16, WS_TZF) + (size_t)l * 32 * 512 * 640, 640, 640, 640}; pg8::SchedS5 S; S.init(2, gridDim.x, (int)blockIdx.x);
              pg8::EpiYa E{ACTP(bf16, A_YA)};
              pg8::gemm_phase<pg8::EpiYa, pg8::SchedS5, true, true>(L0 + RING_OFF, g, S, E, MYTID()); }
            GRID_BAR();
            { OPQ; pg8::Gemm g{ACTP(bf16, A_YA), WSP(bf16, WS_WGLU) + (size_t)l * 512 * 512, 512, 512, 512}; pg8::SchedPlain S; S.init(NH / 256, 2, gridDim.x, (int)blockIdx.x);
              pg8::EpiGlu E{ACTP(bf16, A_YA), ACTP(bf16, A_YA2), LDP(const float, 13) + l * 512};
              pg8::gemm_phase<pg8::EpiGlu, pg8::SchedPlain, true, true>(L0 + RING_OFF, g, S, E, MYTID()); }
            GRID_BAR();
            {
                TID_SETUP;
                int lq = l; asm volatile("" : "+s"(lq));
                const float lam_init = 0.8f - 0.6f * expf(-0.3f * (float)lq);
                const float p1 = wave_sum(LDP(const float, 14)[lq * 64 + lane] * LDP(const float, 15)[lq * 64 + lane]), p2 = wave_sum(LDP(const float, 16)[lq * 64 + lane] * LDP(const float, 17)[lq * 64 + lane]);
                float lam_v = expf(p1) - expf(p2) + lam_init, gsc_v = 1.0f - lam_init; asm volatile("" : "+v"(lam_v), "+v"(gsc_v));
                const int lam_i = __builtin_amdgcn_readfirstlane(__builtin_bit_cast(int, lam_v)), gsc_i = __builtin_amdgcn_readfirstlane(__builtin_bit_cast(int, gsc_v));
                const float lam = __builtin_bit_cast(float, lam_i), gsc = __builtin_bit_cast(float, gsc_i);
                for (int i = 0; i < 8; ++i) {
                    OPQ; const int bh = (i >> 1) * 16 + (vcu >> 4); const int j = vcu & 15; const int qblk = (i & 1) ? 31 - j : j;
                    const int b = bh >> 3, h = bh & 7; const size_t rb = (size_t)b * SEQLEN;
                    attn_body::dattn2_unit<8>(qblk, (const attn_body::bf16*)(ACTP(bf16, A_Q) + rb * 1024 + h * 128), (const attn_body::bf16*)(ACTP(bf16, A_K) + rb * 1024 + h * 128),
                                             (const attn_body::bf16*)(ACTP(bf16, A_V) + rb * 1024 + h * 128), (attn_body::bf16*)(ACTP(bf16, A_YB) + rb * 1024 + h * 128),
                                             lam, LDP(const float, 18) + lq * 128, gsc, (char*)lds + RING_OFF, MYTID());
                }
            }
            GRID_BAR();
            { OPQ; pg8::Gemm g{ACTP(bf16, A_YA2), WSP(bf16, WS_WPS) + (size_t)l * 1024 * 512, 512, 512, 512}; pg8::SchedPlain S; S.init(NH / 256, 4, gridDim.x, (int)blockIdx.x);
              pg8::EpiGate<0> E{ACTP(bf16, A_SGS), nullptr};
              pg8::gemm_phase<pg8::EpiGate<0>, pg8::SchedPlain, true, true>(L0 + RING_OFF, g, S, E, MYTID()); }
            GRID_BAR();
            { OPQ; pg8::Gemm g{ACTP(bf16, A_YB), WSP(bf16, WS_WPA) + (size_t)l * 1024 * 1024, 1024, 1024, 1024}; pg8::SchedPlain S; S.init(NH / 256, 4, gridDim.x, (int)blockIdx.x);
              pg8::EpiGate<1> E{ACTP(bf16, A_SGA), ACTP(bf16, A_SGS)};
              pg8::gemm_phase<pg8::EpiGate<1>, pg8::SchedPlain, true, true>(L0 + RING_OFF, g, S, E, MYTID()); }
            GRID_BAR();
            { OPQ; pg8::Gemm g{ACTP(bf16, A_SGA), WSP(bf16, WS_WOUT) + (size_t)l * 1024 * 1024, 1024, 1024, 1024}; pg8::SchedPlain S; S.init(NH / 256, 4, gridDim.x, (int)blockIdx.x);
              pg8::EpiRes E{(LQ() == 0) ? LDP(const float, 0) : (const float*)nullptr, ACTP(bf16, A_XB), tokbase};
              pg8::gemm_phase<pg8::EpiRes, pg8::SchedPlain, true, true>(L0 + RING_OFF, g, S, E, MYTID()); }
            GRID_BAR();
            if (LQ() == 0) {
                { TID_SETUP; const bf16* xs = ACTP(const bf16, A_XB); const float* gain = LDP(const float, 22); bf16* H2 = ACTP(bf16, A_H2);
                  f32x4 gq[4];
#pragma unroll
                  for (int j = 0; j < 4; ++j) gq[j] = ((const GAS f32x4*)gain + lane)[64 * j];
                  for (int m = gw; m < NH; m += 4 * NGW) norm_rows4b(xs + (size_t)(tokbase + m) * DMODEL, (size_t)NGW * DMODEL, gq, H2 + (size_t)m * DMODEL, (size_t)NGW * DMODEL, lane); }
                GRID_BAR();
                { OPQ; pg8::Gemm g{ACTP(bf16, A_H2), WSP(bf16, WS_WDGU), 1024, 1024, 1024}; pg8::SchedPlain S; S.init(NH / 256, 22, gridDim.x, (int)blockIdx.x);
                  pg8::EpiSwi E{ACTP(bf16, A_FA)};
                  pg8::gemm_phase<pg8::EpiSwi, pg8::SchedPlain, true, true>(L0 + RING_OFF, g, S, E, MYTID()); }
                GRID_BAR();
                { OPQ; pg8::Gemm g{ACTP(bf16, A_FA), WSP(bf16, WS_WDD), 2816, 2816, 2816}; pg8::SchedPlain S; S.init(NH / 256, 4, gridDim.x, (int)blockIdx.x);
                  pg8::EpiRes E{(const float*)nullptr, ACTP(bf16, A_XB), tokbase};
                  pg8::gemm_phase<pg8::EpiRes, pg8::SchedPlain, true, true>(L0 + RING_OFF, g, S, E, MYTID()); }
                GRID_BAR();
            } else {
                {
                    TID_SETUP;
                    LAS float* rwT = (LAS float*)(L);
                    LAS unsigned* cntL = (LAS unsigned*)(L + 32768);
                    { const float* router_w = LDP(const float, 26); for (int idx = tid; idx < 8192; idx += NWAVES * 64) { const int k = idx >> 3, e = idx & 7; rwT[e * 1024 + k] = router_w[idx]; } }
                    if (tid < 8) cntL[tid] = 0u;
                    __syncthreads();
                    const bf16* xs = ACTP(const bf16, A_XB); const float* gain = LDP(const float, 22) + DMODEL; bf16* H2 = ACTP(bf16, A_H2M);
                    unsigned* RT_E = WSP(unsigned, WS_ROUTE + R_E); float* RT_W = WSP(float, WS_ROUTE + R_W);
                    f32x4 gq[4];
#pragma unroll
                    for (int j = 0; j < 4; ++j) gq[j] = ((const GAS f32x4*)gain + lane)[64 * j];
                    for (int i2 = 0; i2 < 16; i2 += 4) { f32x4 xv[4][4];
#pragma unroll
                      for (int u = 0; u < 4; ++u) { const GAS unsigned long long* xr = (const GAS unsigned long long*)(xs + (size_t)(tokbase + vcu * 128 + wave * 16 + i2 + u) * DMODEL) + lane;
#pragma unroll
                        for (int j = 0; j < 4; ++j) xv[u][j] = bf4_f32(xr[64 * j]); }
#pragma unroll
                      for (int u = 0; u < 4; ++u) { const int row = vcu * 128 + wave * 16 + i2 + u;
                        f32x4 hn[4]; { float s2 = 0.f;
#pragma unroll
                            for (int j = 0; j < 4; ++j) s2 += (xv[u][j].x * xv[u][j].x + xv[u][j].y * xv[u][j].y) + (xv[u][j].z * xv[u][j].z + xv[u][j].w * xv[u][j].w);
                            const float rs = 1.0f / sqrtf(wave_sum(s2) * (1.0f / DMODEL) + EPS_NORM);
                            GAS unsigned long long* o8 = (GAS unsigned long long*)(H2 + (size_t)row * DMODEL) + lane;
#pragma unroll
                            for (int j = 0; j < 4; ++j) { hn[j] = xv[u][j] * rs * gq[j]; o8[64 * j] = (unsigned long long)pk2(hn[j].x, hn[j].y) | ((unsigned long long)pk2(hn[j].z, hn[j].w) << 32); } }
                        float lg[8];
#pragma unroll
                        for (int e = 0; e < 8; ++e) { float a = 0.f;
#pragma unroll
                            for (int j = 0; j < 4; ++j) { const f32x4 w = *(const LAS f32x4*)(rwT + e * 1024 + 4 * lane + 256 * j); a += (hn[j].x * w.x + hn[j].y * w.y) + (hn[j].z * w.z + hn[j].w * w.w); }
                            lg[e] = wave_sum(a); }
                        if (lane == 0) { int e1 = 0; float v1 = lg[0];
#pragma unroll
                            for (int e = 1; e < 8; ++e) if (lg[e] > v1) { v1 = lg[e]; e1 = e; }
                            int e2 = -1; float v2 = -INFINITY;
#pragma unroll
                            for (int e = 0; e < 8; ++e) if (e != e1 && lg[e] > v2) { v2 = lg[e]; e2 = e; }
                            if (e2 < 0) e2 = (e1 == 0) ? 1 : 0;
                            const float ex = expf(v2 - v1); const float w1 = 1.0f / (1.0f + ex), w2 = ex / (1.0f + ex);
                            RT_E[row] = (unsigned)e1 | ((unsigned)e2 << 8); RT_W[2 * row] = w1; RT_W[2 * row + 1] = w2;
                            __hip_atomic_fetch_add(cntL + e1, 1u, __ATOMIC_RELAXED, __HIP_MEMORY_SCOPE_WORKGROUP); __hip_atomic_fetch_add(cntL + e2, 1u, __ATOMIC_RELAXED, __HIP_MEMORY_SCOPE_WORKGROUP); }
                      }
                    }
                    __syncthreads();
                    if (tid < 8) WSP(unsigned, WS_ROUTE + R_CNT)[vcu * 8 + tid] = cntL[tid];
                }
                GRID_BAR();
                {
                    TID_SETUP;
                    volatile LAS unsigned* MISC = (volatile LAS unsigned*)(L + MISC_OFF);
                    LAS unsigned* tab = (LAS unsigned*)(L);
                    LAS unsigned* tot = (LAS unsigned*)(L + 8192);
                    LAS unsigned* off = (LAS unsigned*)(L + 8192 + 64);
                    LAS unsigned* wcn = (LAS unsigned*)(L + 8192 + 128);
                    LAS unsigned* slt = (LAS unsigned*)(L + 8192 + 512);
                    const unsigned* RT_CNT = WSP(const unsigned, WS_ROUTE + R_CNT); const unsigned* RT_E = WSP(const unsigned, WS_ROUTE + R_E); int* RT_S = WSP(int, WS_ROUTE + R_S);
                    const bf16* H2 = ACTP(const bf16, A_H2M); bf16* H2G = ACTP(bf16, A_H2G);
                    if (tid < 256) { const GAS v4u* src = (const GAS v4u*)(RT_CNT + tid * 8); const v4u a = src[0], b = src[1];
                        tab[tid * 8 + 0] = a.x; tab[tid * 8 + 1] = a.y; tab[tid * 8 + 2] = a.z; tab[tid * 8 + 3] = a.w; tab[tid * 8 + 4] = b.x; tab[tid * 8 + 5] = b.y; tab[tid * 8 + 6] = b.z; tab[tid * 8 + 7] = b.w; }
                    __syncthreads();
                    if (tid < 8) { unsigned t = 0, o = 0; for (int blk = 0; blk < 256; ++blk) { const unsigned c = tab[blk * 8 + tid]; if (blk < vcu) o += c; t += c; } tot[tid] = t; off[tid] = o; }
                    __syncthreads();
                    if (tid == 0) { unsigned sp = 0; for (int e = 0; e < 8; ++e) { MISC[16 + e] = sp; sp += (tot[e] + 255u) >> 8; } MISC[24] = sp; }
                    __syncthreads();
                    int my_e = 0, my_rank = 0;
                    if (tid < 256) { const int row = vcu * 128 + (tid >> 1); const unsigned ee = RT_E[row]; my_e = (tid & 1) ? (int)((ee >> 8) & 255u) : (int)(ee & 255u);
#pragma unroll
                        for (int e = 0; e < 8; ++e) { const unsigned long long mask = __ballot(my_e == e); if (my_e == e) my_rank = __popcll(mask & ((1ull << lane) - 1ull)); if (lane == 0) wcn[wave * 8 + e] = (unsigned)__popcll(mask); } }
                    __syncthreads();
                    if (tid < 256) { unsigned pre = 0; for (int w = 0; w < wave; ++w) pre += wcn[w * 8 + my_e];
                        const unsigned slot = MISC[16 + my_e] * 256u + off[my_e] + pre + (unsigned)my_rank;
                        RT_S[(vcu * 128 + (tid >> 1)) * 2 + (tid & 1)] = (int)slot; slt[tid] = slot; }
                    __syncthreads();
                    for (int i = 0; i < 32; i += 4) { v4u a[4], b[4];
#pragma unroll
                        for (int u = 0; u < 4; ++u) { const int id = wave * 32 + i + u; const GAS v4u* src = (const GAS v4u*)(H2 + (size_t)(vcu * 128 + (id >> 1)) * DMODEL) + lane * 2; a[u] = src[0]; b[u] = src[1]; }
#pragma unroll
                        for (int u = 0; u < 4; ++u) { const unsigned slot = slt[wave * 32 + i + u]; GAS v4u* dst = (GAS v4u*)(H2G + (size_t)slot * DMODEL) + lane * 2; dst[0] = a[u]; dst[1] = b[u]; } }
                    if (vcu < 8) { const unsigned e = (unsigned)vcu; const unsigned r0 = MISC[16 + e] * 256u + tot[e], r1 = MISC[17 + e] * 256u; const v4u z = {0u, 0u, 0u, 0u};
                        for (unsigned r = r0 + (unsigned)wave; r < r1; r += NWAVES) { GAS v4u* dst = (GAS v4u*)(H2G + (size_t)r * DMODEL) + lane * 2; dst[0] = z; dst[1] = z; } }
                }
                GRID_BAR();
#define MOE_SCHED(S, NN) do { volatile LAS unsigned* MISC = (volatile LAS unsigned*)(L + MISC_OFF); S.nn = (NN); \
        S.sp1 = __builtin_amdgcn_readfirstlane((int)MISC[17]); S.sp2 = __builtin_amdgcn_readfirstlane((int)MISC[18]); S.sp3 = __builtin_amdgcn_readfirstlane((int)MISC[19]); S.sp4 = __builtin_amdgcn_readfirstlane((int)MISC[20]); \
        S.sp5 = __builtin_amdgcn_readfirstlane((int)MISC[21]); S.sp6 = __builtin_amdgcn_readfirstlane((int)MISC[22]); S.sp7 = __builtin_amdgcn_readfirstlane((int)MISC[23]); \
        S.so.init(__builtin_amdgcn_readfirstlane((int)MISC[24]), (NN), gridDim.x, (int)blockIdx.x); } while (0)
                { OPQ; pg8::SchedMoe S; MOE_SCHED(S, 22);
                  pg8::Gemm g{ACTP(bf16, A_H2G), WSP(bf16, WS_WMGU), 1024, 1024, 1024}; pg8::EpiSwi E{ACTP(bf16, A_AG)};
                  pg8::gemm_phase<pg8::EpiSwi, pg8::SchedMoe, true, true>(L0 + RING_OFF, g, S, E, MYTID()); }
                GRID_BAR();
                { OPQ; pg8::SchedMoe S; MOE_SCHED(S, 4);
                  pg8::Gemm g{ACTP(bf16, A_AG), WSP(bf16, WS_WMD), 2816, 2816, 2816}; pg8::EpiBf E{ACTP(bf16, A_YG)};
                  pg8::gemm_phase<pg8::EpiBf, pg8::SchedMoe, true, true>(L0 + RING_OFF, g, S, E, MYTID()); }
                GRID_BAR();
                {
                    TID_SETUP;
                    const int* RT_S = WSP(const int, WS_ROUTE + R_S); const float* RT_W = WSP(const float, WS_ROUTE + R_W); float* xo = LDP(float, 31); const bf16* XBc = ACTP(const bf16, A_XB); const bf16* YG = ACTP(const bf16, A_YG);
                    const GAS f32x4* gr = (const GAS f32x4*)LDP(const float, 30) + lane;
                    f32x4 gq[4];
#pragma unroll
                    for (int j = 0; j < 4; ++j) gq[j] = gr[64 * j];
                    for (int m = gw; m < NH; m += 4 * NGW) {
                        int s1[4], s2[4]; float w1[4], w2[4];
#pragma unroll
                        for (int r = 0; r < 4; ++r) { const int mm = m + r * NGW; s1[r] = RT_S[2 * mm]; s2[r] = RT_S[2 * mm + 1]; w1[r] = RT_W[2 * mm]; w2[r] = RT_W[2 * mm + 1]; }
                        f32x4 xa[4][4]; unsigned long long ya[4][4], yb[4][4];
#pragma unroll
                        for (int r = 0; r < 4; ++r) { const GAS unsigned long long* xr = (const GAS unsigned long long*)(XBc + (size_t)(tokbase + m + r * NGW) * DMODEL) + lane;
                            const GAS unsigned long long* y1 = (const GAS unsigned long long*)(YG + (size_t)s1[r] * DMODEL) + lane; const GAS unsigned long long* y2 = (const GAS unsigned long long*)(YG + (size_t)s2[r] * DMODEL) + lane;
#pragma unroll
                            for (int j = 0; j < 4; ++j) { xa[r][j] = bf4_f32(xr[64 * j]); ya[r][j] = y1[64 * j]; yb[r][j] = y2[64 * j]; } }
#pragma unroll
                        for (int r = 0; r < 4; ++r) { float sq = 0.f;
#pragma unroll
                            for (int j = 0; j < 4; ++j) { const unsigned long long a = ya[r][j], b = yb[r][j]; f32x4 x4 = xa[r][j];
                                const unsigned alo = (unsigned)a, ahi = (unsigned)(a >> 32), blo = (unsigned)b, bhi = (unsigned)(b >> 32);
                                x4.x += w1[r] * __uint_as_float(alo << 16) + w2[r] * __uint_as_float(blo << 16); x4.y += w1[r] * __uint_as_float(alo & 0xffff0000u) + w2[r] * __uint_as_float(blo & 0xffff0000u);
                                x4.z += w1[r] * __uint_as_float(ahi << 16) + w2[r] * __uint_as_float(bhi << 16); x4.w += w1[r] * __uint_as_float(ahi & 0xffff0000u) + w2[r] * __uint_as_float(bhi & 0xffff0000u);
                                xa[r][j] = x4; sq += (x4.x * x4.x + x4.y * x4.y) + (x4.z * x4.z + x4.w * x4.w); }
                            const float rs = 1.0f / sqrtf(wave_sum(sq) * (1.0f / DMODEL) + EPS_NORM);
                            GAS f32x4* xw = (GAS f32x4*)(xo + (size_t)(tokbase + m + r * NGW) * DMODEL) + lane;
#pragma unroll
                            for (int j = 0; j < 4; ++j) xw[64 * j] = xa[r][j] * rs * gq[j]; }
                    }
                }
                GRID_BAR();
            }
        }
    }
#undef GRID_BAR
#undef TID_SETUP
#undef LQ
#undef MYTID
#undef OPQ
#undef WSP
#undef ACTP
#undef MOE_SCHED
}

extern "C" void kernel_launch(void* const* d_in, const int* in_sizes, int n_in, void* d_out, int out_size, void* d_ws, size_t ws_size, hipStream_t stream) {
    static int grid = 0;
    if (grid == 0) {
        if (n_in != 31 || in_sizes[0] != NTOK * DMODEL || out_size != NTOK * DMODEL || ws_size < WS_END) {
            fprintf(stderr, "kernel_launch: unexpected shapes: n_in %d in0 %d out %d ws %zu (need %zu); nothing launched\n", n_in, n_in > 0 ? in_sizes[0] : -1, out_size, ws_size, (size_t)WS_END); grid = -1; return; }
        int dev = 0, cus = 0, per_cu = 0;
        if (hipGetDevice(&dev) != hipSuccess || hipDeviceGetAttribute(&cus, hipDeviceAttributeMultiprocessorCount, dev) != hipSuccess) { grid = -1; return; }
        if (hipFuncSetAttribute((const void*)trunk_fwd, hipFuncAttributeMaxDynamicSharedMemorySize, LDS_BYTES) != hipSuccess) { fprintf(stderr, "kernel_launch: hipFuncSetAttribute failed\n"); grid = -1; return; }
        if (hipOccupancyMaxActiveBlocksPerMultiprocessor(&per_cu, (const void*)trunk_fwd, NWAVES * 64, LDS_BYTES) != hipSuccess || per_cu < 1)
            fprintf(stderr, "kernel_launch: note: occupancy query reports %d workgroups per CU\n", per_cu);
        (void)hipGetLastError();
        grid = 256;
        if (cus < 256) { fprintf(stderr, "kernel_launch: device has %d CUs, need 256; nothing launched\n", cus); grid = -1; return; }
    }
    if (grid < 0) return;
    if (hipMemsetAsync((char*)d_ws + WS_CTL, 0, CTL_ZERO_BYTES, stream) != hipSuccess) return;
    Args a{};
    for (int i = 0; i < 31; ++i) a.in[i] = d_in[i];
    a.out = (float*)d_out; a.ws = (unsigned char*)d_ws;
    hipLaunchKernelGGL(trunk_fwd, dim3(grid), dim3(NWAVES * 64), LDS_BYTES, stream, a);
}
```

```cpp
#include <hip/hip_runtime.h>
#include <hip/hip_bf16.h>
#include <cstdio>
#include <cstdint>
#include <cmath>
namespace pg8 {
#define PG8_LAS __attribute__((address_space(3)))
typedef unsigned short bf16_t;
typedef short bf16x8 __attribute__((ext_vector_type(8)));
typedef float f32x4 __attribute__((ext_vector_type(4)));
typedef unsigned u32x4 __attribute__((ext_vector_type(4)));
constexpr int BM = 256, BK = 64, HALF = 128, HTB = HALF * BK * 2  , STAGE_BYTES = 8 * HTB, NXCD = 8, WGM = 8;

__host__ __device__ __forceinline__ int lds_byte(int r, int c) { const int st = (r >> 4) * 2 + (c >> 5), rr = r & 15, cc = c & 31, ob = rr * 64 + cc * 2; return st * 1024 + (ob ^ (((ob >> 9) & 1) << 5)); }
__host__ __device__ __forceinline__ void stage_rc(int b, int& R, int& C) { const int st = b / 1024, sb = b % 1024, swz = sb ^ (((sb >> 9) & 1) << 5); R = (st >> 1) * 16 + swz / 64; C = (st & 1) * 32 + (swz % 64) / 2; }
__host__ __device__ __forceinline__ int perm32(int rho) { const int n = rho >> 4, i = rho & 15; return 8 * (i >> 2) + 4 * n + (i & 3); }

struct Unit { int pm, pn; };
struct Gemm { const bf16_t* A; const bf16_t* Bt; int lda, ldb, K; };

struct StaticOrder {
    int nM, nN, nwg, G, c;
    __host__ __device__ void init(int nM_, int nN_, int G_, int c_) { nM = nM_; nN = nN_; nwg = nM * nN; G = G_; c = c_; }
    __host__ __device__ bool next(int i, Unit& u) const {
        const long L = (long)i * G + c; if (L >= nwg) return false;
        int wgid = (int)L; { const int q = nwg / NXCD, r = nwg % NXCD, xcd = wgid % NXCD, off = wgid / NXCD; wgid = (xcd < r ? xcd * (q + 1) : r * (q + 1) + (xcd - r) * q) + off; }
        const int nig = WGM * nN, gid = wgid / nig, fm = gid * WGM, gsz = (nM - fm) < WGM ? (nM - fm) : WGM;
        u.pm = fm + ((wgid % nig) % gsz); u.pn = (wgid % nig) / gsz; return true;
    }
    __device__ __forceinline__ void a_ready(const Unit&) const {}
    __device__ __forceinline__ void done(const Unit&) const {}
};


struct SchedPlain {
    StaticOrder so;
    __device__ __forceinline__ void init(int nM, int nN, int G, int c) { so.init(nM, nN, G, c); }
    __device__ __forceinline__ bool next(int i, Unit& u) const { return so.next(i, u); }
    __device__ __forceinline__ void a_ready(const Unit&) const {}
    __device__ __forceinline__ void done(const Unit&) const {}
};
struct SchedS5 {
    StaticOrder so; int nng;
    __device__ __forceinline__ void init(int nng_, int G, int c) { nng = nng_; so.init(128, nng_, G, c); }
    __device__ __forceinline__ bool next(int i, Unit& u) const { if (!so.next(i, u)) return false; u.pn = (u.pm >> 2) * nng + u.pn; return true; }
    __device__ __forceinline__ void a_ready(const Unit&) const {}
    __device__ __forceinline__ void done(const Unit&) const {}
};
struct SchedMoe {
    StaticOrder so; int nn; int sp1, sp2, sp3, sp4, sp5, sp6, sp7;
    __device__ __forceinline__ bool next(int i, Unit& u) const {
        if (!so.next(i, u)) return false;
        const int pm = u.pm; const int e = (pm >= sp1) + (pm >= sp2) + (pm >= sp3) + (pm >= sp4) + (pm >= sp5) + (pm >= sp6) + (pm >= sp7);
        u.pn = e * nn + u.pn; return true;
    }
    __device__ __forceinline__ void a_ready(const Unit&) const {}
    __device__ __forceinline__ void done(const Unit&) const {}
};

typedef float f32x2c_t __attribute__((ext_vector_type(2))); typedef __bf16 bf16x2c_t __attribute__((ext_vector_type(2)));
__device__ __forceinline__ unsigned cvt_pk_bf16(float lo, float hi) { f32x2c_t v = {lo, hi}; bf16x2c_t b = __builtin_convertvector(v, bf16x2c_t); return __builtin_bit_cast(unsigned, b); }
__device__ __forceinline__ u32x4 pack8(const f32x4 a, const f32x4 b) { u32x4 w; w.x = cvt_pk_bf16(a[0], a[1]); w.y = cvt_pk_bf16(a[2], a[3]); w.z = cvt_pk_bf16(b[0], b[1]); w.w = cvt_pk_bf16(b[2], b[3]); return w; }
__device__ __forceinline__ void unpack8(const u32x4 w, f32x4& a, f32x4& b) {
    a[0] = __uint_as_float(w.x << 16); a[1] = __uint_as_float(w.x & 0xffff0000u); a[2] = __uint_as_float(w.y << 16); a[3] = __uint_as_float(w.y & 0xffff0000u);
    b[0] = __uint_as_float(w.z << 16); b[1] = __uint_as_float(w.z & 0xffff0000u); b[2] = __uint_as_float(w.w << 16); b[3] = __uint_as_float(w.w & 0xffff0000u); }
__device__ __forceinline__ float sigm(float z) { return __builtin_amdgcn_rcpf(1.0f + __builtin_amdgcn_exp2f(-1.4426950408889634f * z)); }
__device__ __forceinline__ f32x4 sigm4(const f32x4 z) { f32x4 r; r[0] = sigm(z[0]); r[1] = sigm(z[1]); r[2] = sigm(z[2]); r[3] = sigm(z[3]); return r; }
__device__ __forceinline__ float gelu_t(float x) { const float u = 1.5957691216057308f * (x + 0.044715f * x * x * x); return x * sigm(u); }
__device__ __forceinline__ f32x4 gelu4(const f32x4 z) { f32x4 r; r[0] = gelu_t(z[0]); r[1] = gelu_t(z[1]); r[2] = gelu_t(z[2]); r[3] = gelu_t(z[3]); return r; }
constexpr size_t EA_U = (size_t)64 << 20, EA_Q = (size_t)120 << 20, EA_K = (size_t)184 << 20, EA_V = (size_t)248 << 20, EA_SGS = (size_t)312 << 20, EA_SGA = (size_t)376 << 20;
constexpr float QSCALE = 0.125f * 1.4426950408889634f;

struct EpiIn {
    static constexpr bool PERM = true, AFTER_DRAIN = false;
    unsigned char* act; const float* rope; int tokbase;
    __device__ __forceinline__ void operator()(const f32x4 (&acc)[2][2][4][2], const Unit& u, int wr, int wc, int fr_in, int fq_in) const {
        int fr = fr_in, fq = fq_in; asm volatile("" : "+v"(fr), "+v"(fq));
        const int pn = u.pn, rowb = u.pm * BM + wr * 64 + fr, cow = wc * 32 + fq * 8;
        if (pn < 2) {
#pragma unroll
            for (int ai = 0; ai < 2; ++ai)
#pragma unroll
                for (int m = 0; m < 4; ++m) { const int row = rowb + ai * HALF + m * 16;
#pragma unroll
                    for (int bj = 0; bj < 2; ++bj) { const int c = pn * 256 + bj * HALF + cow; const int g = c >> 4, jj = c & 15;
                        bf16_t* dst = (bf16_t*)(act + EA_U) + ((size_t)(g * 1024 + (row >> 5)) * 640 + (row & 31) * 16 + jj);
                        *(u32x4*)dst = pack8(acc[ai][bj][m][0], acc[ai][bj][m][1]); } }
        } else if (pn < 10) {
            const bool isq = pn < 6; bf16_t* base = (bf16_t*)(act + (isq ? EA_Q : EA_K)); const int colt = (isq ? pn - 2 : pn - 6) * 256; const float sc = isq ? QSCALE : 1.0f;
            const int dlo = 16 * (wc & 1) + 4 * fq;
#pragma unroll
            for (int ai = 0; ai < 2; ++ai) { f32x4 csq[4], snq[4];
#pragma unroll
                for (int m = 0; m < 4; ++m) { const float* tr = rope + (size_t)(tokbase + rowb + ai * HALF + m * 16) * 64 + dlo; csq[m] = *(const f32x4*)tr; snq[m] = *(const f32x4*)(tr + 32); }
#pragma unroll
                for (int m = 0; m < 4; ++m) { const int row = rowb + ai * HALF + m * 16; const f32x4 cs = csq[m], sn = snq[m];
#pragma unroll
                    for (int bj = 0; bj < 2; ++bj) { const f32x4 v0 = acc[ai][bj][m][0], v1 = acc[ai][bj][m][1];
                        const f32x4 o0 = (v0 * cs - v1 * sn) * sc, o1 = (v1 * cs + v0 * sn) * sc;
                        *(u32x4*)(base + (size_t)row * 1024 + colt + bj * HALF + cow) = pack8(o0, o1); } } }
        } else if (pn < 14) {
            const int colt = (pn - 10) * 256;
#pragma unroll
            for (int ai = 0; ai < 2; ++ai)
#pragma unroll
                for (int m = 0; m < 4; ++m) { const int row = rowb + ai * HALF + m * 16;
#pragma unroll
                    for (int bj = 0; bj < 2; ++bj) *(u32x4*)((bf16_t*)(act + EA_V) + (size_t)row * 1024 + colt + bj * HALF + cow) = pack8(acc[ai][bj][m][0], acc[ai][bj][m][1]); }
        } else {
            bf16_t* base = (bf16_t*)(act + (pn < 18 ? EA_SGS : EA_SGA)); const int colt = (pn < 18 ? pn - 14 : pn - 18) * 256;
#pragma unroll
            for (int ai = 0; ai < 2; ++ai)
#pragma unroll
                for (int m = 0; m < 4; ++m) { const int row = rowb + ai * HALF + m * 16;
#pragma unroll
                    for (int bj = 0; bj < 2; ++bj) *(u32x4*)(base + (size_t)row * 1024 + colt + bj * HALF + cow) = pack8(sigm4(acc[ai][bj][m][0]), sigm4(acc[ai][bj][m][1])); }
        }
    }
};
struct EpiSloc {
    static constexpr bool PERM = false, AFTER_DRAIN = false;
    float* S;
    __device__ __forceinline__ void operator()(const f32x4 (&acc)[2][2][4][2], const Unit& u, int wr, int wc, int fr_in, int fq_in) const {
        int fr = fr_in, fq = fq_in; asm volatile("" : "+v"(fr), "+v"(fq));
        const int rowb = u.pm * BM + wr * 64 + fr, col0 = wc * 32 + 4 * fq;
#pragma unroll
        for (int ai = 0; ai < 2; ++ai)
#pragma unroll
            for (int m = 0; m < 4; ++m) { float* rowp = S + (size_t)(rowb + ai * HALF + m * 16) * 128 + col0;
#pragma unroll
                for (int n = 0; n < 2; ++n) *(f32x4*)(rowp + n * 16) = acc[ai][0][m][n]; }
    }
};
struct EpiYa {
    static constexpr bool PERM = true, AFTER_DRAIN = false;
    bf16_t* YA;
    __device__ __forceinline__ void operator()(const f32x4 (&acc)[2][2][4][2], const Unit& u, int wr, int wc, int fr_in, int fq_in) const {
        int fr = fr_in, fq = fq_in; asm volatile("" : "+v"(fr), "+v"(fq));
        const int g = u.pm >> 2, pni = u.pn & 1; const int rowb = (u.pm & 3) * BM + wr * 64 + fr; const int jj = 8 * (fq & 1);
#pragma unroll
        for (int ai = 0; ai < 2; ++ai)
#pragma unroll
            for (int m = 0; m < 4; ++m) { const int R = rowb + ai * HALF + m * 16;
#pragma unroll
                for (int bj = 0; bj < 2; ++bj) { const int t = pni * 16 + bj * 8 + wc * 2 + (fq >> 1);
                    *(u32x4*)(YA + (size_t)(R * 32 + t) * 512 + g * 16 + jj) = pack8(gelu4(acc[ai][bj][m][0]), gelu4(acc[ai][bj][m][1])); } }
    }
};
struct EpiGlu {
    static constexpr bool PERM = true, AFTER_DRAIN = false;
    const bf16_t* YA; bf16_t* O; const float* bias;
    __device__ __forceinline__ void operator()(const f32x4 (&acc)[2][2][4][2], const Unit& u, int wr, int wc, int fr_in, int fq_in) const {
        int fr = fr_in, fq = fq_in; asm volatile("" : "+v"(fr), "+v"(fq));
        const int rowb = u.pm * BM + wr * 64 + fr, col0 = u.pn * BM + wc * 32 + 8 * fq;
        f32x4 bv[2][2];
#pragma unroll
        for (int bj = 0; bj < 2; ++bj)
#pragma unroll
            for (int n = 0; n < 2; ++n) bv[bj][n] = *(const f32x4*)(bias + col0 + bj * HALF + 4 * n);
#pragma unroll
        for (int ai = 0; ai < 2; ++ai) { u32x4 yq[4][2];
#pragma unroll
            for (int m = 0; m < 4; ++m)
#pragma unroll
                for (int bj = 0; bj < 2; ++bj) yq[m][bj] = *(const u32x4*)(YA + (size_t)(rowb + ai * HALF + m * 16) * 512 + col0 + bj * HALF);
#pragma unroll
            for (int m = 0; m < 4; ++m) { const size_t off = (size_t)(rowb + ai * HALF + m * 16) * 512 + col0;
#pragma unroll
                for (int bj = 0; bj < 2; ++bj) { f32x4 y0, y1; unpack8(yq[m][bj], y0, y1);
                    *(u32x4*)(O + off + bj * HALF) = pack8(y0 * sigm4(acc[ai][bj][m][0] + bv[bj][0]), y1 * sigm4(acc[ai][bj][m][1] + bv[bj][1])); } } }
    }
};
template <int MODE> struct EpiGate {
    static constexpr bool PERM = true, AFTER_DRAIN = false;
    bf16_t* G; const bf16_t* T0;
    __device__ __forceinline__ void operator()(const f32x4 (&acc)[2][2][4][2], const Unit& u, int wr, int wc, int fr_in, int fq_in) const {
        int fr = fr_in, fq = fq_in; asm volatile("" : "+v"(fr), "+v"(fq));
        const int rowb = u.pm * BM + wr * 64 + fr, col0 = u.pn * BM + wc * 32 + 8 * fq;
        u32x4 gA[4], tA[4], gB[4], tB[4];
#define EG_LOAD(ai, bj, gq, tq) do { _Pragma("unroll") for (int m = 0; m < 4; ++m) { const size_t off = (size_t)(rowb + (ai) * HALF + m * 16) * 1024 + col0 + (bj) * HALF; gq[m] = *(const u32x4*)(G + off); if (MODE == 1) tq[m] = *(const u32x4*)(T0 + off); } } while (0)
#define EG_STORE(ai, bj, gq, tq) do { _Pragma("unroll") for (int m = 0; m < 4; ++m) { const size_t off = (size_t)(rowb + (ai) * HALF + m * 16) * 1024 + col0 + (bj) * HALF; f32x4 g0, g1; unpack8(gq[m], g0, g1); \
            f32x4 o0 = g0 * acc[ai][bj][m][0], o1 = g1 * acc[ai][bj][m][1]; if (MODE == 1) { f32x4 t0, t1; unpack8(tq[m], t0, t1); o0 += t0; o1 += t1; } *(u32x4*)(G + off) = pack8(o0, o1); } } while (0)
        if (MODE == 0) { EG_LOAD(0, 0, gA, tA); EG_LOAD(0, 1, gB, tB); EG_STORE(0, 0, gA, tA); EG_LOAD(1, 0, gA, tA); EG_STORE(0, 1, gB, tB); EG_LOAD(1, 1, gB, tB); EG_STORE(1, 0, gA, tA); EG_STORE(1, 1, gB, tB); }
        else { EG_LOAD(0, 0, gA, tA); EG_STORE(0, 0, gA, tA); EG_LOAD(0, 1, gA, tA); EG_STORE(0, 1, gA, tA); EG_LOAD(1, 0, gA, tA); EG_STORE(1, 0, gA, tA); EG_LOAD(1, 1, gA, tA); EG_STORE(1, 1, gA, tA); }
#undef EG_LOAD
#undef EG_STORE
    }
};
struct EpiRes {
    static constexpr bool PERM = true, AFTER_DRAIN = false;
    const float* xin32; bf16_t* xb; int tokbase;
    __device__ __forceinline__ void operator()(const f32x4 (&acc)[2][2][4][2], const Unit& u, int wr, int wc, int fr_in, int fq_in) const {
        int fr = fr_in, fq = fq_in; asm volatile("" : "+v"(fr), "+v"(fq));
        const int rowb = tokbase + u.pm * BM + wr * 64 + fr, col0 = u.pn * BM + wc * 32 + 8 * fq;
        const bool f32in = xin32 != nullptr;
        if (f32in) { f32x4 xA[4][2], xB[4][2];
#define ER_LOAD(ai, bj, xq) do { _Pragma("unroll") for (int m = 0; m < 4; ++m) { const size_t off = (size_t)(rowb + (ai) * HALF + m * 16) * 1024 + col0 + (bj) * HALF; xq[m][0] = *(const f32x4*)(xin32 + off); xq[m][1] = *(const f32x4*)(xin32 + off + 4); } } while (0)
#define ER_STORE(ai, bj, xq) do { _Pragma("unroll") for (int m = 0; m < 4; ++m) *(u32x4*)(xb + (size_t)(rowb + (ai) * HALF + m * 16) * 1024 + col0 + (bj) * HALF) = pack8(xq[m][0] + acc[ai][bj][m][0], xq[m][1] + acc[ai][bj][m][1]); } while (0)
            ER_LOAD(0, 0, xA); ER_STORE(0, 0, xA); ER_LOAD(0, 1, xA); ER_STORE(0, 1, xA); ER_LOAD(1, 0, xA); ER_STORE(1, 0, xA); ER_LOAD(1, 1, xA); ER_STORE(1, 1, xA); (void)xB;
#undef ER_LOAD
#undef ER_STORE
        } else { u32x4 wA[4], wB[4];
#define ER_LOAD(ai, bj, xw) do { _Pragma("unroll") for (int m = 0; m < 4; ++m) xw[m] = *(const u32x4*)(xb + (size_t)(rowb + (ai) * HALF + m * 16) * 1024 + col0 + (bj) * HALF); } while (0)
#define ER_STORE(ai, bj, xw) do { _Pragma("unroll") for (int m = 0; m < 4; ++m) { f32x4 x0, x1; unpack8(xw[m], x0, x1); *(u32x4*)(xb + (size_t)(rowb + (ai) * HALF + m * 16) * 1024 + col0 + (bj) * HALF) = pack8(x0 + acc[ai][bj][m][0], x1 + acc[ai][bj][m][1]); } } while (0)
            ER_LOAD(0, 0, wA); ER_LOAD(0, 1, wB); ER_STORE(0, 0, wA); ER_LOAD(1, 0, wA); ER_STORE(0, 1, wB); ER_LOAD(1, 1, wB); ER_STORE(1, 0, wA); ER_STORE(1, 1, wB);
#undef ER_LOAD
#undef ER_STORE
        }
    }
};
struct EpiSwi {
    static constexpr bool PERM = true, AFTER_DRAIN = false;
    bf16_t* O;
    __device__ __forceinline__ void operator()(const f32x4 (&acc)[2][2][4][2], const Unit& u, int wr, int wc, int fr_in, int fq_in) const {
        int fr = fr_in, fq = fq_in; asm volatile("" : "+v"(fr), "+v"(fq));
        const int rowb = u.pm * BM + wr * 64 + fr, col0 = (u.pn % 22) * HALF + wc * 32 + 8 * fq;
#pragma unroll
        for (int ai = 0; ai < 2; ++ai)
#pragma unroll
            for (int m = 0; m < 4; ++m) { const f32x4 g0 = acc[ai][0][m][0], g1 = acc[ai][0][m][1];
                *(u32x4*)(O + (size_t)(rowb + ai * HALF + m * 16) * 2816 + col0) = pack8(g0 * sigm4(g0) * acc[ai][1][m][0], g1 * sigm4(g1) * acc[ai][1][m][1]); }
    }
};
struct EpiBf {
    static constexpr bool PERM = true, AFTER_DRAIN = false;
    bf16_t* O;
    __device__ __forceinline__ void operator()(const f32x4 (&acc)[2][2][4][2], const Unit& u, int wr, int wc, int fr_in, int fq_in) const {
        int fr = fr_in, fq = fq_in; asm volatile("" : "+v"(fr), "+v"(fq));
        const int rowb = u.pm * BM + wr * 64 + fr, col0 = (u.pn & 3) * BM + wc * 32 + 8 * fq;
#pragma unroll
        for (int ai = 0; ai < 2; ++ai)
#pragma unroll
            for (int m = 0; m < 4; ++m)
#pragma unroll
                for (int bj = 0; bj < 2; ++bj) *(u32x4*)(O + (size_t)(rowb + ai * HALF + m * 16) * 1024 + col0 + bj * HALF) = pack8(acc[ai][bj][m][0], acc[ai][bj][m][1]);
    }
};

template <class Epi, class Sched, bool ALIGN_EPI = false, bool SP2 = false>
__device__ __forceinline__ void gemm_phase(PG8_LAS unsigned char* lds, const Gemm g, const Sched& S, const Epi& E, const int tid_in) {
    const int tid = tid_in, wid = __builtin_amdgcn_readfirstlane(tid >> 6), lane = tid & 63, wr = wid >> 2, wc = wid & 3, fr = lane & 15, fq = lane >> 4;
    const int K = g.K, nt = K / BK;
    unsigned voffA[2], voffB[2];
#pragma unroll
    for (int i = 0; i < 2; ++i) { int R, C; stage_rc(tid * 16 + i * 8192, R, C); const int Rb = Epi::PERM ? ((R & ~31) + perm32(R & 31)) : R;
        voffA[i] = (unsigned)(R * g.lda + C) * 2u; voffB[i] = (unsigned)(Rb * g.ldb + C) * 2u; }
    const size_t kstep = (size_t)(BK * 2);
    const size_t hstepA = (size_t)HALF * g.lda * 2, hstepB = (size_t)HALF * g.ldb * 2;
    const size_t tstepA = 2 * hstepA, tstepB = 2 * hstepB;
    const unsigned ldsw = (unsigned)wid * 1024u;
    const int aoff = lds_byte(wr * 64 + fr, fq * 8), boff = lds_byte(wc * 32 + fr, fq * 8);
#define PG8_SA(b, h) (((b) * 2 + (h)) * HTB)
#define PG8_SB(b, h) ((4 + (b) * 2 + (h)) * HTB)
#define PG8_STAGE(bufoff, gbase, voff) do { _Pragma("unroll") for (int _i = 0; _i < 2; ++_i) \
        __builtin_amdgcn_global_load_lds((const unsigned*)((const char*)(gbase) + (voff)[_i]), (PG8_LAS unsigned*)(lds + (bufoff) + ldsw + _i * 8192), 16, 0, 0); } while (0)
#define PG8_LDA(dst, b, h) do { _Pragma("unroll") for (int m = 0; m < 4; ++m) _Pragma("unroll") for (int k = 0; k < 2; ++k) dst[m][k] = *(const PG8_LAS bf16x8*)(lds + PG8_SA(b, h) + aoff + m * 2048 + k * 1024); } while (0)
#define PG8_LDB(dst, b, h) do { _Pragma("unroll") for (int n = 0; n < 2; ++n) _Pragma("unroll") for (int k = 0; k < 2; ++k) dst[n][k] = *(const PG8_LAS bf16x8*)(lds + PG8_SB(b, h) + boff + n * 2048 + k * 1024); } while (0)
#define PG8_MMA(ai, bj, At, Bt) do { __builtin_amdgcn_s_setprio(1); _Pragma("unroll") for (int m = 0; m < 4; ++m) _Pragma("unroll") for (int n = 0; n < 2; ++n) _Pragma("unroll") for (int k = 0; k < 2; ++k) \
        acc[ai][bj][m][n] = __builtin_amdgcn_mfma_f32_16x16x32_bf16(Bt[n][k], At[m][k], acc[ai][bj][m][n], 0, 0, 0); __builtin_amdgcn_s_setprio(0); } while (0)
#define PG8_WAIT_V(n) asm volatile("s_waitcnt vmcnt(" #n ")" ::: "memory")
#define PG8_WAIT_L(n) asm volatile("s_waitcnt lgkmcnt(" #n ")" ::: "memory")
#define PG8_BAR __builtin_amdgcn_s_barrier()
#define PG8_SCHED __builtin_amdgcn_sched_barrier(0)
    Unit cur, nxt; int ui = 0;
    if (!S.next(0, cur)) return;
    f32x4 acc[2][2][4][2];
#pragma unroll
    for (int a = 0; a < 2; ++a)
#pragma unroll
        for (int b = 0; b < 2; ++b)
#pragma unroll
            for (int m = 0; m < 4; ++m)
#pragma unroll
                for (int n = 0; n < 2; ++n) acc[a][b][m][n] = (f32x4){0.f, 0.f, 0.f, 0.f};
    bf16x8 At[4][2], B0[2][2], B1[2][2];
    const char* cA = (const char*)g.A + (size_t)cur.pm * tstepA; const char* cB = (const char*)g.Bt + (size_t)cur.pn * tstepB;
    S.a_ready(cur);
    if constexpr (SP2) {
        PG8_STAGE(PG8_SB(0, 0), cB, voffB); PG8_STAGE(PG8_SB(0, 1), cB + hstepB, voffB); PG8_STAGE(PG8_SA(0, 0), cA, voffA); PG8_STAGE(PG8_SA(0, 1), cA + hstepA, voffA);
        if (wr == 1) PG8_BAR;
        PG8_WAIT_V(2); PG8_BAR;
        PG8_STAGE(PG8_SB(1, 0), cB + kstep, voffB); PG8_STAGE(PG8_SA(1, 0), cA + kstep, voffA); PG8_STAGE(PG8_SB(1, 1), cB + hstepB + kstep, voffB);
        PG8_WAIT_V(6); PG8_BAR;
    } else {
        PG8_STAGE(PG8_SB(0, 0), cB, voffB); PG8_STAGE(PG8_SA(0, 0), cA, voffA); PG8_STAGE(PG8_SB(0, 1), cB + hstepB, voffB); PG8_STAGE(PG8_SA(0, 1), cA + hstepA, voffA);
        if (wr == 1) PG8_BAR;
        PG8_WAIT_V(4); PG8_BAR;
        PG8_STAGE(PG8_SB(1, 0), cB + kstep, voffB); PG8_STAGE(PG8_SA(1, 0), cA + kstep, voffA); PG8_STAGE(PG8_SB(1, 1), cB + hstepB + kstep, voffB);
        PG8_WAIT_V(6); PG8_BAR;
    }
    for (;;) {
        const bool has_next = S.next(ui + 1, nxt);
        const char* nA = has_next ? (const char*)g.A + (size_t)nxt.pm * tstepA : cA; const char* nB = has_next ? (const char*)g.Bt + (size_t)nxt.pn * tstepB : cB;
        for (int t = 0; t < nt; t += 2) {
            const bool last = (t == nt - 2);
            const char* a1 = cA + (size_t)(t + 1) * kstep;
            const char* a2 = last ? nA : cA + (size_t)(t + 2) * kstep; const char* b2 = last ? nB : cB + (size_t)(t + 2) * kstep;
            const char* a3 = a2 + kstep; const char* b3 = b2 + kstep;
            if (last && has_next) S.a_ready(nxt);
            if constexpr (SP2) {
            PG8_LDB(B0, 0, 0); PG8_LDB(B1, 0, 1); PG8_SCHED; PG8_LDA(At, 0, 0); PG8_STAGE(PG8_SA(1, 1), a1 + hstepA, voffA);
            PG8_WAIT_V(8); PG8_WAIT_L(0); PG8_BAR; PG8_MMA(0, 0, At, B0); PG8_MMA(0, 1, At, B1); PG8_BAR; PG8_SCHED;
            PG8_LDA(At, 0, 1); PG8_STAGE(PG8_SB(0, 0), b2, voffB); PG8_STAGE(PG8_SB(0, 1), b2 + hstepB, voffB); PG8_STAGE(PG8_SA(0, 0), a2, voffA);
            PG8_WAIT_V(8); PG8_WAIT_L(0); PG8_BAR; PG8_MMA(1, 0, At, B0); PG8_MMA(1, 1, At, B1); PG8_BAR; PG8_SCHED;
            PG8_LDB(B0, 1, 0); PG8_LDB(B1, 1, 1); PG8_SCHED; PG8_LDA(At, 1, 0); PG8_STAGE(PG8_SA(0, 1), a2 + hstepA, voffA);
            PG8_WAIT_V(8); PG8_WAIT_L(0); PG8_BAR; PG8_MMA(0, 0, At, B0); PG8_MMA(0, 1, At, B1); PG8_BAR; PG8_SCHED;
            PG8_LDA(At, 1, 1); PG8_STAGE(PG8_SB(1, 0), b3, voffB); PG8_STAGE(PG8_SB(1, 1), b3 + hstepB, voffB); PG8_STAGE(PG8_SA(1, 0), a3, voffA);
            PG8_WAIT_V(8); PG8_WAIT_L(0); PG8_BAR; PG8_MMA(1, 0, At, B0); PG8_MMA(1, 1, At, B1); PG8_BAR; PG8_SCHED;
            } else {
            PG8_LDB(B0, 0, 0); PG8_SCHED; PG8_LDA(At, 0, 0); PG8_STAGE(PG8_SA(1, 1), a1 + hstepA, voffA);
            PG8_WAIT_L(8); PG8_BAR; PG8_WAIT_L(0); PG8_MMA(0, 0, At, B0); PG8_BAR; PG8_SCHED;
            PG8_LDB(B1, 0, 1); PG8_STAGE(PG8_SB(0, 0), b2, voffB);
            PG8_BAR; PG8_WAIT_L(0); PG8_MMA(0, 1, At, B1); PG8_BAR;
            PG8_LDA(At, 0, 1); PG8_STAGE(PG8_SA(0, 0), a2, voffA);
            PG8_BAR; PG8_WAIT_L(0); PG8_MMA(1, 0, At, B0); PG8_BAR; PG8_SCHED;
            PG8_STAGE(PG8_SB(0, 1), b2 + hstepB, voffB);
            PG8_WAIT_V(6); PG8_BAR; PG8_MMA(1, 1, At, B1); PG8_BAR;
            PG8_LDB(B0, 1, 0); PG8_SCHED; PG8_LDA(At, 1, 0); PG8_STAGE(PG8_SA(0, 1), a2 + hstepA, voffA);
            PG8_WAIT_L(8); PG8_BAR; PG8_WAIT_L(0); PG8_MMA(0, 0, At, B0); PG8_BAR; PG8_SCHED;
            PG8_LDB(B1, 1, 1); PG8_STAGE(PG8_SB(1, 0), b3, voffB);
            PG8_BAR; PG8_WAIT_L(0); PG8_MMA(0, 1, At, B1); PG8_BAR;
            PG8_LDA(At, 1, 1); PG8_STAGE(PG8_SA(1, 0), a3, voffA);
            PG8_BAR; PG8_WAIT_L(0); PG8_MMA(1, 0, At, B0); PG8_BAR; PG8_SCHED;
            PG8_STAGE(PG8_SB(1, 1), b3 + hstepB, voffB);
            PG8_WAIT_V(6); PG8_BAR; PG8_MMA(1, 1, At, B1); PG8_BAR;
            }
        }
        if constexpr (ALIGN_EPI) { if (wr == 0) PG8_BAR; }
        if constexpr (!Epi::AFTER_DRAIN) { E(acc, cur, wr, wc, fr, fq); S.done(cur); }
        if (!has_next) break;
#pragma unroll
        for (int a = 0; a < 2; ++a)
#pragma unroll
            for (int b = 0; b < 2; ++b)
#pragma unroll
                for (int m = 0; m < 4; ++m)
#pragma unroll
                    for (int n = 0; n < 2; ++n) acc[a][b][m][n] = (f32x4){0.f, 0.f, 0.f, 0.f};
        cur = nxt; cA = nA; cB = nB; ++ui;
        if constexpr (ALIGN_EPI) { if (wr == 1) PG8_BAR; }
    }
    PG8_WAIT_V(0);
    if constexpr (!ALIGN_EPI) { if (wr == 0) PG8_BAR; }
    PG8_BAR;
    if constexpr (Epi::AFTER_DRAIN) { E.fused(acc, cur, wr, wc, fr, fq, lds, wid, lane); S.done(cur); }
#undef PG8_SA
#undef PG8_SB
#undef PG8_STAGE
#undef PG8_LDA
#undef PG8_LDB
#undef PG8_MMA
#undef PG8_WAIT_V
#undef PG8_WAIT_L
#undef PG8_BAR
#undef PG8_SCHED
}
}

#include <hip/hip_bf16.h>
#include <cmath>
namespace attn_body {
using bf16=__hip_bfloat16;
using bf16x8=__attribute__((ext_vector_type(8)))short;
using s16x4=__attribute__((ext_vector_type(4)))short;
using f32x16=__attribute__((ext_vector_type(16)))float;
using u32x4=__attribute__((ext_vector_type(4)))unsigned;
constexpr int SEQ=4096,D=64,DM=1024,OPITCH=2048;
constexpr int NW=8,QBLK=32,QB=QBLK*NW,KVBLK=64,NQB=SEQ/QB;
constexpr int ATTN_PITCH=DM, ATTN_UNIT_ROWS=QB;
__device__ __forceinline__ int crow(int r,int hi){return (r&3)+8*(r>>2)+4*hi;}
#define SBAR() __builtin_amdgcn_sched_barrier(0)
__device__ __forceinline__ void cmask(f32x16&p0,f32x16&p1,int jb,int qrel,int hi){
  const float NEG=-INFINITY; int kb=64*jb+4*hi;
  #pragma unroll
  for(int r=0;r<16;++r){int kv=kb+(r&3)+8*(r>>2); if(kv>qrel)p0[r]=NEG; if(kv+32>qrel)p1[r]=NEG;}
}

constexpr int NSLOT=3, SLOTB=8192;
constexpr int LDS_K=0, LDS_V=NSLOT*SLOTB, LDS_WS=2*NSLOT*SLOTB, LDS_OST=LDS_WS+NW*64*4, LDS_BYTES=LDS_OST+NW*4096;
constexpr float C2=0.125f*1.4426950408889634f;
__device__ __forceinline__ void glds16(const void*gsrc,unsigned lds_dst){unsigned keep;
  asm volatile("s_mov_b32 %0, m0\n\ts_mov_b32 m0, %2\n\ts_nop 0\n\tglobal_load_lds_dwordx4 %1, off\n\ts_mov_b32 m0, %0":"=&s"(keep):"v"(gsrc),"s"(lds_dst):"memory");}
__device__ __forceinline__ float max3f(float a,float b,float c){float r;asm("v_max3_f32 %0, %1, %2, %3":"=v"(r):"v"(a),"v"(b),"v"(c));return r;}
__device__ __forceinline__ float max2f(float a,float b){float r;asm("v_max_f32_e32 %0, %1, %2":"=v"(r):"v"(a),"v"(b));return r;}
__device__ __forceinline__ float fadd_s(float a,float b){float r;asm("v_add_f32_e32 %0, %1, %2":"=v"(r):"v"(a),"v"(b));return r;}
__device__ __forceinline__ float fsub_s(float a,float b){float r;asm("v_sub_f32_e32 %0, %1, %2":"=v"(r):"v"(a),"v"(b));return r;}
typedef float f32x2_t __attribute__((ext_vector_type(2))); typedef __bf16 bf16x2_t __attribute__((ext_vector_type(2)));
__device__ __forceinline__ unsigned cvtpk_s(float lo,float hi){f32x2_t v={lo,hi};bf16x2_t b=__builtin_convertvector(v,bf16x2_t);return __builtin_bit_cast(unsigned,b);}
#define WAIT_BAR(N) asm volatile("s_waitcnt vmcnt(" #N ") lgkmcnt(0)\n\ts_barrier":::"memory")

__device__ __forceinline__ f32x16 mfma_z(bf16x8 a_,bf16x8 b_){ f32x16 d_; asm volatile("s_nop 1\n\tv_mfma_f32_32x32x16_bf16 %0, %1, %2, 0":"=&v"(d_):"v"(a_),"v"(b_)); return d_; }
__device__ __forceinline__ void qkt(f32x16&p0,f32x16&p1,const char*Kslot,const bf16x8*qr,int r32,int hi){
  const char*kb=Kslot+hi*1024+r32*16;
  #pragma unroll
  for(int d0=0;d0<4;++d0){
    const bf16x8 b0=*reinterpret_cast<const bf16x8*>(kb+d0*2048);
    const bf16x8 b1=*reinterpret_cast<const bf16x8*>(kb+d0*2048+512);
    if(d0==0){f32x16 z0=f32x16{},z1=f32x16{};asm volatile("":"+v"(z0),"+v"(z1));
      p0=__builtin_amdgcn_mfma_f32_32x32x16_bf16(b0,qr[0],z0,0,0,0);p1=__builtin_amdgcn_mfma_f32_32x32x16_bf16(b1,qr[0],z1,0,0,0);}
    else{p0=__builtin_amdgcn_mfma_f32_32x32x16_bf16(b0,qr[d0],p0,0,0,0);p1=__builtin_amdgcn_mfma_f32_32x32x16_bf16(b1,qr[d0],p1,0,0,0);}}
}
typedef __attribute__((address_space(3))) const char* lds_cptr;
typedef short v4i16_t __attribute__((ext_vector_type(4)));
__device__ __forceinline__ void kload8(bf16x8*kf,lds_cptr kp){
  kf[0]=*(const __attribute__((address_space(3))) bf16x8*)(kp);      kf[1]=*(const __attribute__((address_space(3))) bf16x8*)(kp+512);
  kf[2]=*(const __attribute__((address_space(3))) bf16x8*)(kp+2048); kf[3]=*(const __attribute__((address_space(3))) bf16x8*)(kp+2560);
  kf[4]=*(const __attribute__((address_space(3))) bf16x8*)(kp+4096); kf[5]=*(const __attribute__((address_space(3))) bf16x8*)(kp+4608);
  kf[6]=*(const __attribute__((address_space(3))) bf16x8*)(kp+6144); kf[7]=*(const __attribute__((address_space(3))) bf16x8*)(kp+6656);
}
__device__ __forceinline__ void kload2(bf16x8*kf,lds_cptr kp,int j){ kf[2*j]=*(const __attribute__((address_space(3))) bf16x8*)(kp+j*2048); kf[2*j+1]=*(const __attribute__((address_space(3))) bf16x8*)(kp+j*2048+512); }
__device__ __forceinline__ s16x4 vtr(lds_cptr p){ return __builtin_bit_cast(s16x4,__builtin_amdgcn_ds_read_tr16_b64_v4i16((__attribute__((address_space(3))) v4i16_t*)p)); }
__device__ __forceinline__ float rowmax(const f32x16&p0,const f32x16&p1){
  float a=max3f(p0[0],p0[1],p1[0]),b=max3f(p0[2],p0[3],p1[1]);a=max3f(a,p1[2],p1[3]);
  #pragma unroll
  for(int r=4;r<16;r+=4){a=max3f(a,p0[r],p0[r+1]);b=max3f(b,p0[r+2],p0[r+3]);a=max3f(a,p1[r],p1[r+1]);b=max3f(b,p1[r+2],p1[r+3]);}
  const float m=max2f(a,b);
  auto rr=__builtin_amdgcn_permlane32_swap(__float_as_uint(m),__float_as_uint(m),false,false);
  return max2f(__uint_as_float(rr[0]),__uint_as_float(rr[1]));
}
__device__ __forceinline__ void pv(f32x16*o,int vb,bf16x8 pa0,bf16x8 pa1,bf16x8 pa2,bf16x8 pa3){
  #pragma unroll
  for(int d0=0;d0<2;++d0){s16x4 lo[4],hi[4];
    #pragma unroll
    for(int ks=0;ks<4;++ks){
      asm volatile("ds_read_b64_tr_b16 %0,%1 offset:%c2":"=&v"(lo[ks]):"v"(vb),"i"(d0*4096+ks*1024):"memory");
      asm volatile("ds_read_b64_tr_b16 %0,%1 offset:%c2":"=&v"(hi[ks]):"v"(vb),"i"(d0*4096+ks*1024+512):"memory");}
    asm volatile("s_waitcnt lgkmcnt(0)":::"memory");SBAR();
    #define PK(k) (bf16x8){lo[k][0],lo[k][1],lo[k][2],lo[k][3],hi[k][0],hi[k][1],hi[k][2],hi[k][3]}
    o[d0]=__builtin_amdgcn_mfma_f32_32x32x16_bf16(pa0,PK(0),o[d0],0,0,0);
    o[d0]=__builtin_amdgcn_mfma_f32_32x32x16_bf16(pa1,PK(1),o[d0],0,0,0);
    o[d0]=__builtin_amdgcn_mfma_f32_32x32x16_bf16(pa2,PK(2),o[d0],0,0,0);
    o[d0]=__builtin_amdgcn_mfma_f32_32x32x16_bf16(pa3,PK(3),o[d0],0,0,0);
    #undef PK
  }
}

#ifndef ATTN_STORE16
#define ATTN_STORE16(p,v) (*(u32x4*)(p)=(v))
#endif
template<int THRL> __device__ __forceinline__ void attn_unit(int qb,const bf16*Qh,const bf16*__restrict__ Kh,const bf16*__restrict__ Vh,bf16*Oh,char*shm,const int tid_in){
  const int tid=tid_in,lane=tid&63,r32=lane&31,hi=lane>>5; const int wid=__builtin_amdgcn_readfirstlane(tid>>6);
  const int q0=qb*QB;
  const bf16*Qw=Qh+(long)(q0+wid*QBLK)*DM;
  const unsigned lds0=(unsigned)(uintptr_t)shm;
  float*wsf=(float*)(shm+LDS_WS)+wid*64;
  const bf16*ksrc=Kh+(long)lane*DM+wid*8;
  const bf16*vsrc=Vh+(long)(16*(wid&3)+(lane>>2))*DM+(wid>>2)*32+(lane&3)*8;
  const unsigned kdst=lds0+LDS_K+wid*1024, vdst=lds0+LDS_V+wid*1024;
  #define DMA_K(t,slot) glds16(ksrc+(long)(t)*KVBLK*DM,(unsigned)__builtin_amdgcn_readfirstlane(kdst+(slot)))
  #define DMA_V(t,slot) glds16(vsrc+(long)(t)*KVBLK*DM,(unsigned)__builtin_amdgcn_readfirstlane(vdst+(slot)))
  const int vb0=(int)(lds0+LDS_V)+((lane>>4)&1)*32+(lane&3)*8+(4*hi+((lane&15)>>2))*64;
  const char*Kbase=shm+LDS_K; bf16x8 kf[8];
  const lds_cptr shm3=(lds_cptr)shm; const lds_cptr kp0=shm3+LDS_K+hi*1024+r32*16; const lds_cptr vp0=shm3+LDS_V+((lane>>4)&1)*32+(lane&3)*8+(4*hi+((lane&15)>>2))*64;
  const int NT=(q0+QB)/KVBLK;
  DMA_K(0,0);DMA_V(0,0);DMA_K(1,SLOTB);
  bf16x8 qr[4];
  #pragma unroll
  for(int d0=0;d0<4;++d0)qr[d0]=*reinterpret_cast<const bf16x8*>(&Qw[(long)r32*DM+d0*16+hi*8]);
  float mhat=0.f,l_reg=0.f;f32x16 o[2];o[0]=f32x16{};o[1]=f32x16{};
  const int qrel=wid*QBLK+r32;
  #define CMASK(P0,P1,t) do{int jb_=(t)-(NT-4); if(jb_>=0)cmask(P0,P1,jb_,qrel,hi);}while(0)
  bool resc=false;
  #define START(P0,P1) do{ const float rm=rowmax(P0,P1); resc=false; \
    { const float dl=rm; mhat=fadd_s(mhat,dl); \
      _Pragma("unroll") for(int r=0;r<16;++r){P0[r]=fsub_s(P0[r],dl);P1[r]=fsub_s(P1[r],dl);} \
      } \
    _Pragma("unroll") for(int r=0;r<16;++r)P0[r]=__builtin_amdgcn_exp2f(P0[r]); }while(0)
  #define RESC() do{ if(resc){ asm volatile("s_waitcnt lgkmcnt(0)":::"memory"); \
      _Pragma("unroll") for(int d_=0;d_<2;++d_) _Pragma("unroll") for(int r=0;r<16;++r)o[d_][r]*=wsf[crow(r,hi)]; } }while(0)
  f32x16 pA0,pA1,pB0,pB1;
  int sl_prev=0,sl_cur=0,sl_next=SLOTB;
  #define ROT() do{sl_prev=sl_cur;sl_cur=sl_next;sl_next=(sl_next==(NSLOT-1)*SLOTB)?0:sl_next+SLOTB;}while(0)
  DMA_K(2,2*SLOTB);
  WAIT_BAR(3);
  qkt(pA0,pA1,Kbase,qr,r32,hi);asm volatile("s_nop 15\n\ts_nop 7":"+v"(pA0),"+v"(pA1));CMASK(pA0,pA1,0);
  START(pA0,pA1);
  _Pragma("unroll") for(int r=0;r<16;++r)pA1[r]=__builtin_amdgcn_exp2f(pA1[r]);
  WAIT_BAR(0);
  DMA_K(3,0);DMA_V(1,SLOTB);
  ROT();
  kload8(kf,kp0+sl_cur);
  WAIT_BAR(2);
  s16x4 vlo[8],vhi[8]; u32x4 pw0,pw1,pw2,pw3;
  #define PKW(P,B) cvtpk_s(P[B],P[B+1])
  #define PAF(k) __builtin_bit_cast(bf16x8,pw##k)
  #define VFR(i) (bf16x8){vlo[i][0],vlo[i][1],vlo[i][2],vlo[i][3],vhi[i][0],vhi[i][1],vhi[i][2],vhi[i][3]}
  #define PIN(x) asm volatile("":"+v"(x))
  #define MX3(a,b,c) __builtin_fmaxf(__builtin_fmaxf((a),(b)),(c))
  #define GAPA(MF,A0,A1,A2,A3,W0,W1,PW) do{ MF; sacc+=A0; sacc+=A1; sacc+=A2; sacc+=A3; PIN(sacc); W0; W1; PIN(PW); SBAR(); }while(0)
  #define EX(v) __builtin_amdgcn_exp2f(v)
  #define GAPB(MF,X,B) do{ MF; X[B]=EX(fsub_s(X[B],mhat)); X[B+1]=EX(fsub_s(X[B+1],mhat)); X[B+2]=EX(fsub_s(X[B+2],mhat)); X[B+3]=EX(fsub_s(X[B+3],mhat)); PIN(X); SBAR(); }while(0)
  #define VRD(i) do{ vlo[i]=vtr(vp_+(((i)>>2)*4096+((i)&3)*1024)); vhi[i]=vtr(vp_+(((i)>>2)*4096+((i)&3)*1024+512)); }while(0)
  #define KRD(G,j) do{ if(G){ kload2(kf,kp0+sl_next,j); SBAR(); } }while(0)
  #define STEP(C0,C1,P0,P1,t,GK,GV,GL) do{ SBAR(); \
    const lds_cptr vp_=vp0+sl_prev; \
    VRD(0); SBAR(); float sacc=(P0[0]+P0[1]); \
    GAPA(C0=mfma_z(kf[0],qr[0]), P0[2],P0[3],P0[4],P0[5],     pw0[0]=PKW(P0,0), pw0[1]=PKW(P0,2), pw0); \
    VRD(4); SBAR(); GAPA(C1=mfma_z(kf[1],qr[0]), P0[6],P0[7],P0[8],P0[9],     pw0[2]=PKW(P0,4), pw0[3]=PKW(P0,6), pw0); \
    VRD(1); SBAR(); GAPA(C0=__builtin_amdgcn_mfma_f32_32x32x16_bf16(kf[2],qr[1],C0,0,0,0),   P0[10],P0[11],P0[12],P0[13], pw1[0]=PKW(P0,8), pw1[1]=PKW(P0,10), pw1); \
    VRD(5); SBAR(); GAPA(C1=__builtin_amdgcn_mfma_f32_32x32x16_bf16(kf[3],qr[1],C1,0,0,0),   P0[14],P0[15],P1[0],P1[1],   pw1[2]=PKW(P0,12),pw1[3]=PKW(P0,14), pw1); \
    VRD(2); SBAR(); GAPA(C0=__builtin_amdgcn_mfma_f32_32x32x16_bf16(kf[4],qr[2],C0,0,0,0),   P1[2],P1[3],P1[4],P1[5],     pw2[0]=PKW(P1,0), pw2[1]=PKW(P1,2), pw2); \
    VRD(6); SBAR(); GAPA(C1=__builtin_amdgcn_mfma_f32_32x32x16_bf16(kf[5],qr[2],C1,0,0,0),   P1[6],P1[7],P1[8],P1[9],     pw2[2]=PKW(P1,4), pw2[3]=PKW(P1,6), pw2); \
    VRD(3); SBAR(); GAPA(C0=__builtin_amdgcn_mfma_f32_32x32x16_bf16(kf[6],qr[3],C0,0,0,0),   P1[10],P1[11],P1[12],P1[13], pw3[0]=PKW(P1,8), pw3[1]=PKW(P1,10), pw3); \
    VRD(7); SBAR(); GAPA(C1=__builtin_amdgcn_mfma_f32_32x32x16_bf16(kf[7],qr[3],C1,0,0,0),   P1[14],P1[15],0.f,0.f,       pw3[2]=PKW(P1,12),pw3[3]=PKW(P1,14), pw3); \
    l_reg+=sacc; \
    if(GK){DMA_K((t)+3,sl_cur);} if(GV){DMA_V((t)+1,sl_next);} \
    CMASK(C0,C1,t); \
    { float a=MX3(C0[0],C0[1],C1[0]),b=MX3(C0[2],C0[3],C1[1]); a=MX3(a,C1[2],C1[3]); \
      _Pragma("unroll") for(int r=4;r<16;r+=4){a=MX3(a,C0[r],C0[r+1]);b=MX3(b,C0[r+2],C0[r+3]);a=MX3(a,C1[r],C1[r+1]);b=MX3(b,C1[r+2],C1[r+3]);} \
      float rm=__builtin_fmaxf(a,b); { auto rr=__builtin_amdgcn_permlane32_swap(__float_as_uint(rm),__float_as_uint(rm),false,false); rm=__builtin_fmaxf(__uint_as_float(rr[0]),__uint_as_float(rr[1])); } \
      resc=false; \
      const float rel=rm-mhat; \
      if(__builtin_expect(__any(rel>(float)THRL),0)){ const float dl=__builtin_fmaxf(rel,0.f); mhat+=dl; \
        const float f=__builtin_amdgcn_exp2f(-dl); l_reg*=f; if(hi==0)wsf[r32]=f; resc=true; } } \
    SBAR(); \
    GAPB(o[0]=__builtin_amdgcn_mfma_f32_32x32x16_bf16(PAF(0),VFR(0),o[0],0,0,0), C0,0); \
    GAPB(o[1]=__builtin_amdgcn_mfma_f32_32x32x16_bf16(PAF(0),VFR(4),o[1],0,0,0), C0,4); \
    KRD(GL,0); GAPB(o[0]=__builtin_amdgcn_mfma_f32_32x32x16_bf16(PAF(1),VFR(1),o[0],0,0,0), C0,8); \
    KRD(GL,1); GAPB(o[1]=__builtin_amdgcn_mfma_f32_32x32x16_bf16(PAF(1),VFR(5),o[1],0,0,0), C0,12); \
    KRD(GL,2); GAPB(o[0]=__builtin_amdgcn_mfma_f32_32x32x16_bf16(PAF(2),VFR(2),o[0],0,0,0), C1,0); \
    KRD(GL,3); GAPB(o[1]=__builtin_amdgcn_mfma_f32_32x32x16_bf16(PAF(2),VFR(6),o[1],0,0,0), C1,4); \
    GAPB(o[0]=__builtin_amdgcn_mfma_f32_32x32x16_bf16(PAF(3),VFR(3),o[0],0,0,0), C1,8); \
    GAPB(o[1]=__builtin_amdgcn_mfma_f32_32x32x16_bf16(PAF(3),VFR(7),o[1],0,0,0), C1,12); \
    }while(0)
  int t=1;
  #undef CMASK
  #define CMASK(P0,P1,t) do{}while(0)
  for(;t+5<NT;t+=2){
    STEP(pB0,pB1,pA0,pA1,t,true,true,true);     WAIT_BAR(2); RESC(); ROT();
    STEP(pA0,pA1,pB0,pB1,t+1,true,true,true);   WAIT_BAR(2); RESC(); ROT();
  }
  #undef CMASK
  #define CMASK(P0,P1,t) do{int jb_=(t)-(NT-4); if(jb_>=0)cmask(P0,P1,jb_,qrel,hi);}while(0)
  #define ENDW(tt) do{ if((tt)+3<NT){WAIT_BAR(2);} else if((tt)+2<NT){WAIT_BAR(1);} else {WAIT_BAR(0);} }while(0)
  for(;t+1<NT;t+=2){
    STEP(pB0,pB1,pA0,pA1,t,(t+3<NT),(t+1<NT),(t+1<NT));       ENDW(t);   RESC(); ROT();
    STEP(pA0,pA1,pB0,pB1,t+1,(t+4<NT),(t+2<NT),(t+2<NT));     ENDW(t+1); RESC(); ROT();
  }
  STEP(pB0,pB1,pA0,pA1,NT-1,false,false,false); RESC();
  { float sacc=pB0[0]+pB0[1]; _Pragma("unroll") for(int r=2;r<16;++r)sacc+=pB0[r]; _Pragma("unroll") for(int r=0;r<16;++r)sacc+=pB1[r]; l_reg+=sacc;
    pw0=(u32x4){PKW(pB0,0),PKW(pB0,2),PKW(pB0,4),PKW(pB0,6)};pw1=(u32x4){PKW(pB0,8),PKW(pB0,10),PKW(pB0,12),PKW(pB0,14)};pw2=(u32x4){PKW(pB1,0),PKW(pB1,2),PKW(pB1,4),PKW(pB1,6)};pw3=(u32x4){PKW(pB1,8),PKW(pB1,10),PKW(pB1,12),PKW(pB1,14)};
    SBAR(); pv(o,vb0+sl_cur,PAF(0),PAF(1),PAF(2),PAF(3)); }
  #undef PKW
  #undef PAF
  #undef VFR
  #undef PIN
  #undef MX3
  #undef GAPA
  #undef GAPB
  #undef EX
  #undef VRD
  #undef KRD
  #undef STEP
  #undef ENDW
  l_reg+=__uint_as_float((unsigned)__builtin_amdgcn_ds_bpermute((lane^32)<<2,(int)__float_as_uint(l_reg)));
  if(hi==0)wsf[32+r32]=l_reg;asm volatile("s_waitcnt lgkmcnt(0)":::"memory");
  float rli[16];
  #pragma unroll
  for(int r=0;r<16;++r)rli[r]=__builtin_amdgcn_rcpf(wsf[32+crow(r,hi)]);
  bf16*Ow=Oh+(long)(q0+wid*QBLK)*OPITCH;
  { bf16*stg=(bf16*)(shm+LDS_OST)+wid*2048;
    #pragma unroll
    for(int r=0;r<16;++r){const int orow=crow(r,hi);
      #pragma unroll
      for(int d0=0;d0<2;++d0)stg[orow*64+d0*32+r32]=__float2bfloat16(o[d0][r]*rli[r]);}
    asm volatile("s_waitcnt lgkmcnt(0)":::"memory");
    #pragma unroll
    for(int i=0;i<4;++i){const int row=i*8+(lane>>3),ch=lane&7; const u32x4 v=*(const u32x4*)(stg+row*64+ch*8); ATTN_STORE16(Ow+(long)row*OPITCH+ch*8,v);} }
  asm volatile("s_waitcnt lgkmcnt(0)\n\ts_barrier":::"memory");
  #undef DMA_K
  #undef DMA_V
  #undef CMASK
  #undef START
  #undef RESC
  #undef ROT
}

__device__ __forceinline__ float rowmax_cv(const f32x16&p0,const f32x16&p1){
  float a=__builtin_fmaxf(p0[0],p1[0]);
  #pragma unroll
  for(int r=1;r<16;++r){a=__builtin_fmaxf(a,p0[r]);a=__builtin_fmaxf(a,p1[r]);}
  auto rr=__builtin_amdgcn_permlane32_swap(__float_as_uint(a),__float_as_uint(a),false,false);
  return __builtin_fmaxf(__uint_as_float(rr[0]),__uint_as_float(rr[1]));
}
__device__ __forceinline__ void attn_unit_simple(int qb,const bf16*Qh,const bf16*__restrict__ Kh,const bf16*__restrict__ Vh,bf16*Oh,char*shm,const int tid_in){
  const int tid=tid_in,lane=tid&63,r32=lane&31,hi=lane>>5; const int wid=__builtin_amdgcn_readfirstlane(tid>>6);
  const int q0=qb*QB;
  const bf16*Qw=Qh+(long)(q0+wid*QBLK)*DM;
  const unsigned lds0=(unsigned)(uintptr_t)shm;
  float*wsf=(float*)(shm+LDS_WS)+wid*64;
  const bf16*ksrc=Kh+(long)lane*DM+wid*8;
  const bf16*vsrc=Vh+(long)(16*(wid&3)+(lane>>2))*DM+(wid>>2)*32+(lane&3)*8;
  u32x4*kdstp=(u32x4*)(shm+LDS_K+wid*1024+lane*16); u32x4*vdstp=(u32x4*)(shm+LDS_V+wid*1024+lane*16);
  const int vb0=(int)(lds0+LDS_V)+((lane>>4)&1)*32+(lane&3)*8+(4*hi+((lane&15)>>2))*64;
  const char*Kbase=shm+LDS_K;
  const int NT=(q0+QB)/KVBLK;
  bf16x8 qr[4];
  #pragma unroll
  for(int d0=0;d0<4;++d0)qr[d0]=*reinterpret_cast<const bf16x8*>(&Qw[(long)r32*DM+d0*16+hi*8]);
  float m_run=-1e30f,l_reg=0.f; f32x16 o[2]; o[0]=f32x16{}; o[1]=f32x16{};
  const int qrel=wid*QBLK+r32;
  u32x4 kreg=*(const u32x4*)ksrc, vreg=*(const u32x4*)vsrc;
  for(int t=0;t<NT;++t){
    *kdstp=kreg; *vdstp=vreg;
    if(t+1<NT){ kreg=*(const u32x4*)(ksrc+(long)(t+1)*KVBLK*DM); vreg=*(const u32x4*)(vsrc+(long)(t+1)*KVBLK*DM); }
    __syncthreads();
    f32x16 p0,p1;
    qkt(p0,p1,Kbase,qr,r32,hi);
    { const int jb=t-(NT-4); if(jb>=0){ const float NEG=-INFINITY; const int kb=64*jb+4*hi;
        #pragma unroll
        for(int r=0;r<16;++r){const int kv=kb+(r&3)+8*(r>>2); if(kv>qrel)p0[r]=NEG; if(kv+32>qrel)p1[r]=NEG;} } }
    const float rm=rowmax_cv(p0,p1);
    const float mn=__builtin_fmaxf(m_run,rm); const float alpha=__builtin_amdgcn_exp2f(m_run-mn); m_run=mn;
    float sacc=0.f;
    #pragma unroll
    for(int r=0;r<16;++r){p0[r]=__builtin_amdgcn_exp2f(p0[r]-mn);p1[r]=__builtin_amdgcn_exp2f(p1[r]-mn);sacc+=p0[r]+p1[r];}
    l_reg=l_reg*alpha+sacc;
    if(hi==0)wsf[r32]=alpha;
    asm volatile("s_waitcnt lgkmcnt(0)":::"memory");
    #pragma unroll
    for(int d_=0;d_<2;++d_)
      #pragma unroll
      for(int r=0;r<16;++r)o[d_][r]*=wsf[crow(r,hi)];
    u32x4 pw0,pw1,pw2,pw3;
    #define PKW2(P,B) cvtpk_s(P[B],P[B+1])
    pw0=(u32x4){PKW2(p0,0),PKW2(p0,2),PKW2(p0,4),PKW2(p0,6)};pw1=(u32x4){PKW2(p0,8),PKW2(p0,10),PKW2(p0,12),PKW2(p0,14)};
    pw2=(u32x4){PKW2(p1,0),PKW2(p1,2),PKW2(p1,4),PKW2(p1,6)};pw3=(u32x4){PKW2(p1,8),PKW2(p1,10),PKW2(p1,12),PKW2(p1,14)};
    #undef PKW2
    pv(o,vb0,__builtin_bit_cast(bf16x8,pw0),__builtin_bit_cast(bf16x8,pw1),__builtin_bit_cast(bf16x8,pw2),__builtin_bit_cast(bf16x8,pw3));
    asm volatile("s_waitcnt lgkmcnt(0)":::"memory");
    __syncthreads();
  }
  l_reg+=__uint_as_float((unsigned)__builtin_amdgcn_ds_bpermute((lane^32)<<2,(int)__float_as_uint(l_reg)));
  if(hi==0)wsf[32+r32]=l_reg;asm volatile("s_waitcnt lgkmcnt(0)":::"memory");
  float rli[16];
  #pragma unroll
  for(int r=0;r<16;++r)rli[r]=__builtin_amdgcn_rcpf(wsf[32+crow(r,hi)]);
  bf16*Ow=Oh+(long)(q0+wid*QBLK)*OPITCH;
  { bf16*stg=(bf16*)(shm+LDS_OST)+wid*2048;
    #pragma unroll
    for(int r=0;r<16;++r){const int orow=crow(r,hi);
      #pragma unroll
      for(int d0=0;d0<2;++d0)stg[orow*64+d0*32+r32]=__float2bfloat16(o[d0][r]*rli[r]);}
    asm volatile("s_waitcnt lgkmcnt(0)":::"memory");
    #pragma unroll
    for(int i=0;i<4;++i){const int row=i*8+(lane>>3),ch=lane&7; const u32x4 v=*(const u32x4*)(stg+row*64+ch*8); ATTN_STORE16(Ow+(long)row*OPITCH+ch*8,v);} }
  asm volatile("s_waitcnt vmcnt(0) lgkmcnt(0)":::"memory");
  __syncthreads();
}

constexpr int DA_SLOT=32768, DA_V=16384, DA_WS=98304, DA_ROWS=128;
__device__ __forceinline__ f32x16 mfma_c(bf16x8 a_,bf16x8 b_,const f32x16&c_){ f32x16 d_; asm volatile("s_nop 1\n\tv_mfma_f32_32x32x16_bf16 %0, %1, %2, %3":"=&v"(d_):"v"(a_),"v"(b_),"v"(c_)); return d_; }
template<int THRL> __device__ __forceinline__ void dattn_unit(int qblk,const bf16*Qb,const bf16*__restrict__ Kb,const bf16*__restrict__ Vb,bf16*Yb,float lam,const float*gsub,float gscale,char*shm,const int tid_in){
  const int tid=tid_in,lane=tid&63,r32=lane&31,hi=lane>>5; const int wid=__builtin_amdgcn_readfirstlane(tid>>6);
  const int c=wid>>2, rg=wid&3;
  const int q0=qblk*DA_ROWS; const int NT=(q0+DA_ROWS)/KVBLK;
  const bf16*Qw=Qb+c*64+(long)(q0+rg*32)*DM;
  const unsigned lds0=(unsigned)(uintptr_t)shm; const lds_cptr shm3=(lds_cptr)shm;
  float*wsf=(float*)(shm+DA_WS)+wid*64;
  const int pk0=2*wid;
  const bf16*ksrc0=Kb+(pk0>>3)*64+(long)lane*DM+(pk0&7)*8;
  const unsigned kdst0=lds0+(pk0>>3)*8192+(pk0&7)*1024;
  const bf16*vsrc0=Vb+(long)(16*(pk0&3)+(lane>>2))*DM+(pk0>>2)*32+(lane&3)*8;
  const unsigned vdst0=lds0+DA_V+pk0*1024;
  #define DA_RFL(x) ((unsigned)__builtin_amdgcn_readfirstlane((int)(x)))
  #define DA_DMA(t,so) do{ const long to_=(long)(t)*KVBLK*DM; \
      glds16(ksrc0+to_,DA_RFL(kdst0+(so))); glds16(ksrc0+to_+8,DA_RFL(kdst0+(so)+1024)); \
      glds16(vsrc0+to_,DA_RFL(vdst0+(so))); glds16(vsrc0+to_+16*DM,DA_RFL(vdst0+(so)+1024)); }while(0)
  const lds_cptr kp0=shm3+c*8192+hi*1024+r32*16;
  const lds_cptr vp0=shm3+DA_V+((lane>>4)&1)*32+(lane&3)*8+(4*hi+((lane&15)>>2))*64;
  bf16x8 qr[4];
  #pragma unroll
  DA_DMA(0,0); if(NT>1){ DA_DMA(1,DA_SLOT); }
  #pragma unroll
  for(int d0=0;d0<4;++d0)qr[d0]=*reinterpret_cast<const bf16x8*>(&Qw[(long)r32*DM+d0*16+hi*8]);
  asm volatile("":"+v"(qr[0]),"+v"(qr[1]),"+v"(qr[2]),"+v"(qr[3]));
  float mhat=0.f,l_reg=0.f; f32x16 o[4]; o[0]=f32x16{}; o[1]=f32x16{}; o[2]=f32x16{}; o[3]=f32x16{};
  f32x16 negm;
  #pragma unroll
  for(int r=0;r<16;++r)negm[r]=0.f;
  const int qrel=rg*32+r32;
  int slot=0;
  for(int t=0;t<NT;++t){
    if(t+1<NT){ asm volatile("s_waitcnt vmcnt(4) lgkmcnt(0)\n\ts_barrier":::"memory"); } else { asm volatile("s_waitcnt vmcnt(0) lgkmcnt(0)\n\ts_barrier":::"memory"); }
    if(t+2<NT){ int s2=slot+2*DA_SLOT; if(s2>=3*DA_SLOT)s2-=3*DA_SLOT; DA_DMA(t+2,s2); }
    const lds_cptr kp=kp0+slot;
    f32x16 p0,p1;
    { const bf16x8 k0=*(const __attribute__((address_space(3))) bf16x8*)(kp), k1=*(const __attribute__((address_space(3))) bf16x8*)(kp+512);
      p0=mfma_c(k0,qr[0],negm); p1=mfma_c(k1,qr[0],negm); }
    #pragma unroll
    for(int d0=1;d0<4;++d0){ const bf16x8 k0=*(const __attribute__((address_space(3))) bf16x8*)(kp+d0*2048), k1=*(const __attribute__((address_space(3))) bf16x8*)(kp+d0*2048+512);
      p0=__builtin_amdgcn_mfma_f32_32x32x16_bf16(k0,qr[d0],p0,0,0,0); p1=__builtin_amdgcn_mfma_f32_32x32x16_bf16(k1,qr[d0],p1,0,0,0); }
    { const int jb=t-(NT-2); if(jb>=0){ const float NEG=-INFINITY; const int kb=64*jb+4*hi;
        #pragma unroll
        for(int r=0;r<16;++r){const int kv=kb+(r&3)+8*(r>>2); if(kv>qrel)p0[r]=NEG; if(kv+32>qrel)p1[r]=NEG;} } }
    float rm=__builtin_fmaxf(p0[0],p1[0]);
    #pragma unroll
    for(int r=1;r<16;++r){rm=__builtin_fmaxf(rm,p0[r]);rm=__builtin_fmaxf(rm,p1[r]);}
    rm=__builtin_fmaxf(rm,__uint_as_float((unsigned)__builtin_amdgcn_ds_bpermute((lane^32)<<2,(int)__float_as_uint(rm))));
    if(t==0){
      mhat=rm;
      #pragma unroll
      for(int r=0;r<16;++r){p0[r]-=rm;p1[r]-=rm;negm[r]=-rm;}
    } else if(__any(rm>(float)THRL)){
      const float dl=__builtin_fmaxf(rm,0.f); const float f=__builtin_amdgcn_exp2f(-dl); mhat+=dl; l_reg*=f;
      #pragma unroll
      for(int r=0;r<16;++r){p0[r]-=dl;p1[r]-=dl;negm[r]=-mhat;}
      if(hi==0)wsf[r32]=f;
      asm volatile("s_waitcnt lgkmcnt(0)":::"memory");
      #pragma unroll
      for(int d_=0;d_<4;++d_)
        #pragma unroll
        for(int r=0;r<16;++r)o[d_][r]*=wsf[crow(r,hi)];
    }
    float sacc=0.f;
    #pragma unroll
    for(int r=0;r<16;++r){p0[r]=__builtin_amdgcn_exp2f(p0[r]);p1[r]=__builtin_amdgcn_exp2f(p1[r]);sacc+=p0[r]+p1[r];}
    l_reg+=sacc;
    u32x4 pw0,pw1,pw2,pw3;
    pw0=(u32x4){cvtpk_s(p0[0],p0[1]),cvtpk_s(p0[2],p0[3]),cvtpk_s(p0[4],p0[5]),cvtpk_s(p0[6],p0[7])}; pw1=(u32x4){cvtpk_s(p0[8],p0[9]),cvtpk_s(p0[10],p0[11]),cvtpk_s(p0[12],p0[13]),cvtpk_s(p0[14],p0[15])};
    pw2=(u32x4){cvtpk_s(p1[0],p1[1]),cvtpk_s(p1[2],p1[3]),cvtpk_s(p1[4],p1[5]),cvtpk_s(p1[6],p1[7])}; pw3=(u32x4){cvtpk_s(p1[8],p1[9]),cvtpk_s(p1[10],p1[11]),cvtpk_s(p1[12],p1[13]),cvtpk_s(p1[14],p1[15])};
    const lds_cptr vp=vp0+slot;
    #pragma unroll
    for(int d0=0;d0<4;++d0){
      #define DA_VF(ks) ({ const s16x4 lo_=vtr(vp+d0*4096+(ks)*1024), hi_=vtr(vp+d0*4096+(ks)*1024+512); (bf16x8){lo_[0],lo_[1],lo_[2],lo_[3],hi_[0],hi_[1],hi_[2],hi_[3]}; })
      o[d0]=__builtin_amdgcn_mfma_f32_32x32x16_bf16(__builtin_bit_cast(bf16x8,pw0),DA_VF(0),o[d0],0,0,0);
      o[d0]=__builtin_amdgcn_mfma_f32_32x32x16_bf16(__builtin_bit_cast(bf16x8,pw1),DA_VF(1),o[d0],0,0,0);
      o[d0]=__builtin_amdgcn_mfma_f32_32x32x16_bf16(__builtin_bit_cast(bf16x8,pw2),DA_VF(2),o[d0],0,0,0);
      o[d0]=__builtin_amdgcn_mfma_f32_32x32x16_bf16(__builtin_bit_cast(bf16x8,pw3),DA_VF(3),o[d0],0,0,0);
      #undef DA_VF
    }
    slot+=DA_SLOT; if(slot>=3*DA_SLOT)slot=0;
  }
  int lane_e=lane; asm volatile("":"+v"(lane_e)); const int r32e=lane_e&31, hie=lane_e>>5;
  l_reg+=__uint_as_float((unsigned)__builtin_amdgcn_ds_bpermute((lane^32)<<2,(int)__float_as_uint(l_reg)));
  asm volatile("s_waitcnt vmcnt(0) lgkmcnt(0)\n\ts_barrier":::"memory");
  if(hie==0)wsf[32+r32e]=l_reg; asm volatile("s_waitcnt lgkmcnt(0)":::"memory");
  float rli[16];
  #pragma unroll
  for(int r=0;r<16;++r)rli[r]=__builtin_amdgcn_rcpf(wsf[32+crow(r,hie)]);
  float*st2=(float*)shm+rg*4096;
  if(c==1){
    #pragma unroll
    for(int d0=0;d0<4;++d0)
      #pragma unroll
      for(int r=0;r<16;++r)st2[crow(r,hie)*128+d0*32+r32e]=lam*o[d0][r]*rli[r];
  }
  asm volatile("s_waitcnt lgkmcnt(0)\n\ts_barrier":::"memory");
  if(c==0){
    float ssq[16];
    #pragma unroll
    for(int r=0;r<16;++r){ float a_=0.f;
      #pragma unroll
      for(int d0=0;d0<4;++d0){ const float x_=o[d0][r]*rli[r]-st2[crow(r,hie)*128+d0*32+r32e]; o[d0][r]=x_; a_+=x_*x_; }
      a_+=__uint_as_float((unsigned)__builtin_amdgcn_ds_swizzle((int)__float_as_uint(a_),(1<<10)|0x1f)); a_+=__uint_as_float((unsigned)__builtin_amdgcn_ds_swizzle((int)__float_as_uint(a_),(2<<10)|0x1f));
      a_+=__uint_as_float((unsigned)__builtin_amdgcn_ds_swizzle((int)__float_as_uint(a_),(4<<10)|0x1f)); a_+=__uint_as_float((unsigned)__builtin_amdgcn_ds_swizzle((int)__float_as_uint(a_),(8<<10)|0x1f));
      a_+=__uint_as_float((unsigned)__builtin_amdgcn_ds_swizzle((int)__float_as_uint(a_),(16<<10)|0x1f));
      ssq[r]=1.0f/__builtin_sqrtf(a_*(1.0f/128.0f)+1e-5f); }
    float g4[4];
    #pragma unroll
    for(int d0=0;d0<4;++d0)g4[d0]=gsub[d0*32+r32e]*gscale;
    bf16*stg=(bf16*)(shm+65536)+rg*4096;
    #pragma unroll
    for(int r=0;r<16;++r)
      #pragma unroll
      for(int d0=0;d0<4;++d0)stg[crow(r,hie)*128+d0*32+r32e]=__float2bfloat16(o[d0][r]*ssq[r]*g4[d0]);
    asm volatile("s_waitcnt lgkmcnt(0)":::"memory");
    bf16*Yw=Yb+(long)(q0+rg*32)*DM;
    #pragma unroll
    for(int i=0;i<8;++i){const int row=i*4+(lane_e>>4),ch=lane_e&15; const u32x4 v=*(const u32x4*)(stg+row*128+ch*8); *(u32x4*)(Yw+(long)row*DM+ch*8)=v;}
  }
  asm volatile("s_waitcnt vmcnt(0) lgkmcnt(0)\n\ts_barrier":::"memory");
  #undef DA_DMA
  #undef DA_RFL
}
#ifndef DB_VPRE
#define DB_VPRE 0
#endif
#ifndef DB_FILLX
#define DB_FILLX 1
#endif
template<int THRL> __device__ __forceinline__ void dattn2_unit(int qblk,const bf16*Qb,const bf16*__restrict__ Kb,const bf16*__restrict__ Vb,bf16*Yb,float lam,const float*gsub,float gscale,char*shm,const int tid_in){
  const int tid=tid_in,lane=tid&63,r32=lane&31,hi=lane>>5; const int wid=__builtin_amdgcn_readfirstlane(tid>>6);
  const int c=wid>>2, rg=wid&3;
  const int q0=qblk*DA_ROWS; const int NT=(q0+DA_ROWS)/KVBLK;
  const bf16*Qw=Qb+c*64+(long)(q0+rg*32)*DM;
  const unsigned lds0=(unsigned)(uintptr_t)shm; const lds_cptr shm3=(lds_cptr)shm;
  const int pk0=2*wid;
  const bf16*ksrc0=Kb+(pk0>>3)*64+(long)((pk0&7)*8+(lane>>3))*DM+((lane&7)^((lane>>3)&7))*8;
  const unsigned kdst0=lds0+(pk0>>3)*8192+(pk0&7)*1024;
  const bf16*vsrc0=Vb+(long)(16*(pk0&3)+(lane>>2))*DM+(pk0>>2)*32+(lane&3)*8;
  const unsigned vdst0=lds0+DA_V+pk0*1024;
  #define DB_RFL(x) ((unsigned)__builtin_amdgcn_readfirstlane((int)(x)))
  #define DB_DMA(t,so) do{ const long to_=(long)(t)*KVBLK*DM; \
      glds16(ksrc0+to_,DB_RFL(kdst0+(so))); glds16(ksrc0+to_+8*DM,DB_RFL(kdst0+(so)+1024)); \
      glds16(vsrc0+to_,DB_RFL(vdst0+(so))); glds16(vsrc0+to_+16*DM,DB_RFL(vdst0+(so)+1024)); }while(0)
  #define DB_SLOT(t) (((t)&3)*DA_SLOT)
  const lds_cptr kp0=shm3+c*8192+r32*128+((hi^(r32&7))*16);
  #define DB_KLD(kf_,kp_,d0) do{ const lds_cptr a_=(lds_cptr)(size_t)(((unsigned)(size_t)(kp_))^((unsigned)(d0)<<5)); kf_[2*(d0)]=*(const __attribute__((address_space(3))) bf16x8*)(a_); kf_[2*(d0)+1]=*(const __attribute__((address_space(3))) bf16x8*)(a_+4096); }while(0)
  const lds_cptr vp0=shm3+DA_V+((lane>>4)&1)*32+(lane&3)*8+(4*hi+((lane&15)>>2))*64;
  bf16x8 qr[4];
  DB_DMA(0,0); DB_DMA(1,DA_SLOT);
  #pragma unroll
  for(int d0=0;d0<4;++d0)qr[d0]=*reinterpret_cast<const bf16x8*>(&Qw[(long)r32*DM+d0*16+hi*8]);
  asm volatile("":"+v"(qr[0]),"+v"(qr[1]),"+v"(qr[2]),"+v"(qr[3]));
  float mref=0.f,l_reg=0.f; f32x16 o[4]; o[0]=f32x16{}; o[1]=f32x16{}; o[2]=f32x16{}; o[3]=f32x16{};
  f32x16 p0,p1; u32x4 pw0,pw1,pw2,pw3; s16x4 va[8],vb[8];
  #pragma unroll
  for(int r=0;r<16;++r){ p0[r]=0.f; p1[r]=0.f; }
  asm volatile("":"+v"(p0),"+v"(p1));
  const int qrel=rg*32+r32;
  #define DB_WAITT(u) do{ if((u)+1<NT){ asm volatile("s_waitcnt vmcnt(4)":::"memory"); } else { asm volatile("s_waitcnt vmcnt(0)":::"memory"); } }while(0)
  #define DB_ISSUE(u) do{ if((u)<NT){ DB_DMA((u),DB_SLOT(u)); } }while(0)
  #define DB_BAR() asm volatile("s_waitcnt lgkmcnt(0)\n\ts_barrier":::"memory")
  #define DB_BARP() asm volatile("s_waitcnt lgkmcnt(0)\n\ts_barrier":"+v"(p0),"+v"(p1)::"memory")
  #define DB_VLD(x,vp_,d0) do{ _Pragma("unroll") for(int ks_=0;ks_<4;++ks_){ x[2*ks_]=vtr((vp_)+(d0)*4096+ks_*1024); x[2*ks_+1]=vtr((vp_)+(d0)*4096+ks_*1024+512); } }while(0)
  #define DB_VF(x,ks) ((bf16x8){x[2*(ks)][0],x[2*(ks)][1],x[2*(ks)][2],x[2*(ks)][3],x[2*(ks)+1][0],x[2*(ks)+1][1],x[2*(ks)+1][2],x[2*(ks)+1][3]})
  #define DB_PVM(x,d0) do{ o[d0]=__builtin_amdgcn_mfma_f32_32x32x16_bf16(DB_VF(x,0),__builtin_bit_cast(bf16x8,pw0),o[d0],0,0,0); o[d0]=__builtin_amdgcn_mfma_f32_32x32x16_bf16(DB_VF(x,1),__builtin_bit_cast(bf16x8,pw1),o[d0],0,0,0); \
      o[d0]=__builtin_amdgcn_mfma_f32_32x32x16_bf16(DB_VF(x,2),__builtin_bit_cast(bf16x8,pw2),o[d0],0,0,0); o[d0]=__builtin_amdgcn_mfma_f32_32x32x16_bf16(DB_VF(x,3),__builtin_bit_cast(bf16x8,pw3),o[d0],0,0,0); }while(0)
  #define DB_QKM(kf_) do{ p0=__builtin_amdgcn_mfma_f32_32x32x16_bf16(kf_[0],qr[0],p0,0,0,0); p1=__builtin_amdgcn_mfma_f32_32x32x16_bf16(kf_[1],qr[0],p1,0,0,0); \
      _Pragma("unroll") for(int d0_=1;d0_<4;++d0_){ p0=__builtin_amdgcn_mfma_f32_32x32x16_bf16(kf_[2*d0_],qr[d0_],p0,0,0,0); p1=__builtin_amdgcn_mfma_f32_32x32x16_bf16(kf_[2*d0_+1],qr[d0_],p1,0,0,0); } }while(0)
  #define DB_FILL() do{ float nm_=-mref; asm volatile("":"+v"(nm_)); _Pragma("unroll") for(int r=0;r<16;++r){ p0[r]=nm_; p1[r]=nm_; } }while(0)
  #define DB_M(tp,tq) do{ const lds_cptr vp_=vp0+DB_SLOT(tp); const lds_cptr kp_=kp0+DB_SLOT(tq); bf16x8 kf_[8]; \
      if(!DB_VPRE){ DB_VLD(va,vp_,0); DB_VLD(vb,vp_,1); SBAR(); } DB_PVM(va,0); DB_VLD(va,vp_,2); SBAR(); \
      DB_PVM(vb,1); DB_VLD(vb,vp_,3); SBAR(); \
      DB_PVM(va,2); DB_KLD(kf_,kp_,0); DB_KLD(kf_,kp_,1); SBAR(); \
      DB_PVM(vb,3); DB_KLD(kf_,kp_,2); DB_KLD(kf_,kp_,3); SBAR(); \
      if(!DB_FILLX){ DB_FILL(); } DB_QKM(kf_); }while(0)
  #define DB_QK0(tq) do{ const lds_cptr kp_=kp0+DB_SLOT(tq); bf16x8 kf_[8]; DB_KLD(kf_,kp_,0); DB_KLD(kf_,kp_,1); DB_KLD(kf_,kp_,2); DB_KLD(kf_,kp_,3); SBAR(); DB_QKM(kf_); }while(0)
  #define DB_PVL(tp) do{ const lds_cptr vp_=vp0+DB_SLOT(tp); if(!DB_VPRE){ DB_VLD(va,vp_,0); DB_VLD(vb,vp_,1); SBAR(); } DB_PVM(va,0); DB_VLD(va,vp_,2); SBAR(); DB_PVM(vb,1); DB_VLD(vb,vp_,3); SBAR(); DB_PVM(va,2); SBAR(); DB_PVM(vb,3); }while(0)
  #define DB_X(tt,FIRST) do{ { const int jb_=(tt)-(NT-2); if(jb_>=0){ cmask(p0,p1,jb_,qrel,hi); } } \
      const float rm_=rowmax(p0,p1); \
      if(FIRST){ mref=rm_; _Pragma("unroll") for(int r=0;r<16;++r){ p0[r]-=rm_; p1[r]-=rm_; } } \
      else if(__any(rm_>(float)THRL)){ const float dl_=__builtin_fmaxf(rm_,0.f); const float f_=__builtin_amdgcn_exp2f(-dl_); mref+=dl_; l_reg*=f_; \
        _Pragma("unroll") for(int r=0;r<16;++r){ p0[r]-=dl_; p1[r]-=dl_; } \
        _Pragma("unroll") for(int d_=0;d_<4;++d_) _Pragma("unroll") for(int r=0;r<16;++r){ float x_=o[d_][r]; asm volatile("v_mul_f32_e32 %0, %0, %1":"+v"(x_):"v"(f_)); o[d_][r]=x_; } } \
      float sacc_=0.f; _Pragma("unroll") for(int r=0;r<16;++r){ p0[r]=__builtin_amdgcn_exp2f(p0[r]); p1[r]=__builtin_amdgcn_exp2f(p1[r]); sacc_+=p0[r]+p1[r]; } l_reg+=sacc_; \
      pw0=(u32x4){cvtpk_s(p0[0],p0[1]),cvtpk_s(p0[2],p0[3]),cvtpk_s(p0[4],p0[5]),cvtpk_s(p0[6],p0[7])}; pw1=(u32x4){cvtpk_s(p0[8],p0[9]),cvtpk_s(p0[10],p0[11]),cvtpk_s(p0[12],p0[13]),cvtpk_s(p0[14],p0[15])}; \
      pw2=(u32x4){cvtpk_s(p1[0],p1[1]),cvtpk_s(p1[2],p1[3]),cvtpk_s(p1[4],p1[5]),cvtpk_s(p1[6],p1[7])}; pw3=(u32x4){cvtpk_s(p1[8],p1[9]),cvtpk_s(p1[10],p1[11]),cvtpk_s(p1[12],p1[13]),cvtpk_s(p1[14],p1[15])}; \
      if(DB_VPRE){ const lds_cptr vq_=vp0+DB_SLOT(tt); DB_VLD(va,vq_,0); DB_VLD(vb,vq_,1); } if(DB_FILLX){ DB_FILL(); } }while(0)
  DB_WAITT(0);
  if(c==1){ DB_BAR(); DB_ISSUE(2); }
  DB_BAR();
  DB_QK0(0);
  if(c==1){ DB_WAITT(1); } DB_BARP(); DB_ISSUE(2+c);
  DB_X(0,true);
  for(int t=1;t<NT;++t){
    if(c==0){ DB_WAITT(t); } DB_BAR();
    DB_M(t-1,t);
    if(c==1){ DB_WAITT(t+1); } DB_BARP(); DB_ISSUE(t+2+c);
    DB_X(t,false);
  }
  DB_BAR(); DB_PVL(NT-1);
  if(c==0){ DB_BAR(); }
  int lane_e=lane; asm volatile("":"+v"(lane_e)); const int r32e=lane_e&31, hie=lane_e>>5;
  l_reg+=__uint_as_float((unsigned)__builtin_amdgcn_ds_bpermute((lane_e^32)<<2,(int)__float_as_uint(l_reg)));
  asm volatile("s_waitcnt vmcnt(0) lgkmcnt(0)\n\ts_barrier":::"memory");
  const float rl=__builtin_amdgcn_rcpf(l_reg);
  float*st2=(float*)shm+rg*4096+lane_e;
  if(c==1){ const float s_=lam*rl;
    #pragma unroll
    for(int d0=0;d0<4;++d0)
      #pragma unroll
      for(int r=0;r<16;++r)st2[(d0*16+r)*64]=o[d0][r]*s_;
  }
  asm volatile("s_waitcnt lgkmcnt(0)\n\ts_barrier":::"memory");
  if(c==0){
    float a_=0.f;
    #pragma unroll
    for(int d0=0;d0<4;++d0)
      #pragma unroll
      for(int r=0;r<16;++r){ const float x_=o[d0][r]*rl-st2[(d0*16+r)*64]; o[d0][r]=x_; a_+=x_*x_; }
    a_+=__uint_as_float((unsigned)__builtin_amdgcn_ds_bpermute((lane_e^32)<<2,(int)__float_as_uint(a_)));
    const float rs=gscale/__builtin_sqrtf(a_*(1.0f/128.0f)+1e-5f);
    char*stg=shm+65536+rg*(32*272)+r32e*272+hie*8;
    #pragma unroll
    for(int d0=0;d0<4;++d0)
      #pragma unroll
      for(int g=0;g<4;++g){ const float4 gv=*reinterpret_cast<const float4*>(gsub+d0*32+8*g+4*hie);
        uint2 w_; w_.x=cvtpk_s(o[d0][4*g]*rs*gv.x,o[d0][4*g+1]*rs*gv.y); w_.y=cvtpk_s(o[d0][4*g+2]*rs*gv.z,o[d0][4*g+3]*rs*gv.w);
        *reinterpret_cast<uint2*>(stg+(d0*32+8*g)*2)=w_; }
    asm volatile("s_waitcnt lgkmcnt(0)":::"memory");
    bf16*Yw=Yb+(long)(q0+rg*32)*DM; const char*stb=shm+65536+rg*(32*272);
    #pragma unroll
    for(int i=0;i<8;++i){const int row=i*4+(lane_e>>4),ch=lane_e&15; const u32x4 v=*(const u32x4*)(stb+row*272+ch*16); *(u32x4*)(Yw+(long)row*DM+ch*8)=v;}
  }
  asm volatile("s_waitcnt vmcnt(0) lgkmcnt(0)\n\ts_barrier":::"memory");
  #undef DB_RFL
  #undef DB_KLD
  #undef DB_DMA
  #undef DB_SLOT
  #undef DB_WAITT
  #undef DB_ISSUE
  #undef DB_BARP
  #undef DB_BAR
  #undef DB_VLD
  #undef DB_VF
  #undef DB_PVM
  #undef DB_QKM
  #undef DB_M
  #undef DB_QK0
  #undef DB_PVL
  #undef DB_X
}
constexpr int ATTN_LDS_BYTES=LDS_BYTES;
#undef SBAR
#undef WAIT_BAR
}

#define GAS __attribute__((address_space(1)))
#define LAS __attribute__((address_space(3)))
typedef unsigned short bf16;
typedef unsigned v4u __attribute__((ext_vector_type(4)));
typedef float f32x4 __attribute__((ext_vector_type(4)));
typedef short bf16x8 __attribute__((ext_vector_type(8)));
typedef GAS unsigned gu32;
typedef GAS unsigned long long gu64;
#define RLX_AGENT __ATOMIC_RELAXED, __HIP_MEMORY_SCOPE_AGENT
#define LDS_WAIT() asm volatile("s_waitcnt lgkmcnt(0)" ::: "memory")
#define VM_WAIT() asm volatile("s_waitcnt vmcnt(0)" ::: "memory")
__device__ __forceinline__ unsigned long long rt() { return __builtin_amdgcn_s_memrealtime(); }
__device__ __forceinline__ unsigned f2bf(float f) { unsigned u = __builtin_bit_cast(unsigned, f); return (u + 0x7fffu + ((u >> 16) & 1u)) >> 16; }
__device__ __forceinline__ unsigned pk2(float lo, float hi) { return f2bf(lo) | (f2bf(hi) << 16); }

#define XB_TMO      128
#define XB_XCNT(j)  (256  + 64 * (j))
#define XB_XSUB(j)  (1280 + 64 * (j))
#define XB_XGEN(j)  (2304 + 64 * (j))
#define XB_TOP      3328
#define XB_TOPGEN   3392
#define XCD_BAR_WORDS 3456
#define XB_SPIN_CAP (1u << 26)

__device__ __forceinline__ unsigned xb_ld(unsigned* p)              { return __hip_atomic_load(p, __ATOMIC_RELAXED, __HIP_MEMORY_SCOPE_AGENT); }
__device__ __forceinline__ unsigned xb_add(unsigned* p, unsigned v) { return __hip_atomic_fetch_add(p, v, __ATOMIC_RELAXED, __HIP_MEMORY_SCOPE_AGENT); }
__device__ __forceinline__ unsigned xb_xcc_id() { return (unsigned)__builtin_amdgcn_s_getreg((3 << 11) | 20) & 0xFu; }
#define XB_SPIN(cond, bar) do { unsigned _sp = 0; while (cond) { __builtin_amdgcn_s_sleep(1); \
    if ((++_sp & 255u) == 0u) { if (xb_ld(&(bar)[XB_TMO])) break; if (_sp > XB_SPIN_CAP) { atomicAdd(&(bar)[XB_TMO], 1u); break; } } } } while (0)

struct XcdBarrier {
    unsigned* bar; unsigned x;
    volatile LAS unsigned* st;
};

__device__ __forceinline__ XcdBarrier xcd_barrier_post(unsigned* bar, volatile LAS unsigned* st, const int tid) {
    XcdBarrier b; b.bar = bar; b.x = xb_xcc_id(); b.st = st;
    if (tid == 0) (void)xb_add(&bar[XB_XCNT(b.x)], 1u);
    return b;
}
__device__ __forceinline__ void xcd_barrier_complete(unsigned* bar, unsigned x, unsigned& nloc, unsigned& nx) {
    const unsigned G = gridDim.x * gridDim.y * gridDim.z;
    unsigned sum, cnt, mine, sp = 0u;
    for (;;) {
        sum = 0u; cnt = 0u; mine = 0u;
#pragma unroll
        for (unsigned j = 0; j < 16; ++j) { const unsigned c = xb_ld(&bar[XB_XCNT(j)]); sum += c; cnt += (c > 0u) ? 1u : 0u; mine = (j == x) ? c : mine; }
        if (sum == G) break;
        __builtin_amdgcn_s_sleep(1);
        if ((++sp & 255u) == 0u) { if (xb_ld(&bar[XB_TMO])) break; if (sp > XB_SPIN_CAP) { atomicAdd(&bar[XB_TMO], 1u); break; } }
    }
    nloc = mine > 0u ? mine : 1u; nx = cnt > 0u ? cnt : 1u;
}

__device__ __forceinline__ void xcd_barrier(const XcdBarrier& b, const int tid) {
    asm volatile("s_waitcnt vmcnt(0)" ::: "memory");
    __syncthreads();
    if (tid == 0) {
        unsigned* bar = b.bar;
        __builtin_amdgcn_s_waitcnt(0);
        unsigned nloc = b.st[0], nx = b.st[1];
        if (nloc == 0u) { xcd_barrier_complete(bar, b.x, nloc, nx); b.st[0] = nloc; b.st[1] = nx; }
        const unsigned old = xb_add(&bar[XB_XSUB(b.x)], 1u);
        const unsigned gen = old / nloc;
        if (old + 1u == (gen + 1u) * nloc) {
            __builtin_amdgcn_fence(__ATOMIC_RELEASE, "agent");
            asm volatile("s_waitcnt vmcnt(0)" ::: "memory");
            const unsigned og = xb_add(&bar[XB_TOP], 1u);
            const unsigned tg = og / nx;
            if (og + 1u == (tg + 1u) * nx) xb_add(&bar[XB_TOPGEN], 1u);
            else XB_SPIN(xb_ld(&bar[XB_TOPGEN]) == tg, bar);
            __builtin_amdgcn_fence(__ATOMIC_ACQUIRE, "agent");
            xb_add(&bar[XB_XGEN(b.x)], 1u);
            asm volatile("s_waitcnt vmcnt(0)" ::: "memory");
        } else {
            XB_SPIN(xb_ld(&bar[XB_XGEN(b.x)]) == gen, bar);
            __builtin_amdgcn_fence(__ATOMIC_ACQUIRE, "agent");
            asm volatile("s_waitcnt vmcnt(0)" ::: "memory");
        }
    }
    __syncthreads();
}

constexpr int NWAVES = 8;
constexpr int NTOK = 65536, NH = 32768, DMODEL = 1024, SEQLEN = 4096, INCOLS = 5632, DFF = 2816, NEXP = 8;
constexpr int MOE_PANELS_MAX = 264;
constexpr float EPS_NORM = 1e-6f, EPS_SUBLN = 1e-5f;

constexpr size_t MiB = 1u << 20;
constexpr size_t WS_CTL = 0, CTL_ZERO_BYTES = 1 * MiB;
constexpr size_t WS_WIN = 1 * MiB;
constexpr size_t WS_WGLU = 23 * MiB;
constexpr size_t WS_WPS = 24 * MiB;
constexpr size_t WS_WPA = 26 * MiB;
constexpr size_t WS_WOUT = 30 * MiB;
constexpr size_t WS_WDGU = 34 * MiB;
constexpr size_t WS_WDD = 45 * MiB;
constexpr size_t WS_WMGU = 51 * MiB;
constexpr size_t WS_WMD = 139 * MiB;
constexpr size_t WS_TZF = 183 * MiB;
constexpr size_t WS_EM = 223 * MiB;
constexpr size_t WS_ROPE = 239 * MiB;
constexpr size_t WS_ROUTE = 255 * MiB;
constexpr size_t WS_ACT = 260 * MiB;
constexpr size_t WS_END = 960 * MiB;
constexpr size_t A_HB = 0, A_UBUF = 64 * MiB, A_SLOC = 104 * MiB, A_Q = 120 * MiB, A_K = 184 * MiB, A_V = 248 * MiB, A_SGS = 312 * MiB, A_SGA = 376 * MiB, A_YA = 440 * MiB, A_YA2 = 472 * MiB, A_OV = 504 * MiB, A_YB = 632 * MiB;
constexpr size_t A_H2 = 0, A_FA = 64 * MiB;
constexpr size_t A_H2M = 632 * MiB, A_H2G = 0, A_AG = 132 * MiB, A_YG = 0;
constexpr size_t A_XB = 504 * MiB;
static_assert(A_UBUF == pg8::EA_U && A_Q == pg8::EA_Q && A_K == pg8::EA_K && A_V == pg8::EA_V && A_SGS == pg8::EA_SGS && A_SGA == pg8::EA_SGA, "EpiIn offsets");
static_assert(A_YB + 64 * MiB <= WS_END - WS_ACT && A_YA2 + 32 * MiB <= A_XB && A_XB + 128 * MiB <= A_YB && A_AG + 363 * MiB <= A_XB && A_H2G + 132 * MiB <= A_AG && A_H2M >= A_XB + 128 * MiB && A_H2M + 64 * MiB <= WS_END - WS_ACT && A_FA + 176 * MiB <= A_XB, "act map");
constexpr size_t R_E = 0, R_W = 256 * 1024, R_S = 512 * 1024, R_CNT = 768 * 1024;
constexpr int CW_BAR = 4096;

constexpr int RING_OFF = 0, RING_BYTES = 131072;
constexpr int LDSCTL_OFF = RING_BYTES, MISC_OFF = LDSCTL_OFF + 320;
constexpr int LDS_BYTES = 147456;

constexpr int PTR_OFF = LDSCTL_OFF + 1024;
struct Args { const void* in[31]; float* out; unsigned char* ws; };
__device__ __forceinline__ unsigned long long ldp64(LAS unsigned char* L, int slot) {
    const unsigned long long v = ((volatile LAS unsigned long long*)(L + PTR_OFF))[slot];
    const unsigned lo = __builtin_amdgcn_readfirstlane((unsigned)v), hi = __builtin_amdgcn_readfirstlane((unsigned)(v >> 32));
    return ((unsigned long long)hi << 32) | lo;
}
#define LDP(T, slot) ((T*)(GAS T*)(uintptr_t)ldp64(L, (slot)))

#define SWZ_XOR(k) (((k) << 10) | 0x1f)
#define swz_xor(v, pat) __builtin_bit_cast(float, __builtin_amdgcn_ds_swizzle(__builtin_bit_cast(int, (float)(v)), (pat)))
__device__ __forceinline__ float wave_sum(float v) {
#define WS_DPP(x, ctrl) __builtin_bit_cast(float, __builtin_amdgcn_update_dpp(0, __builtin_bit_cast(int, (float)(x)), (ctrl), 0xf, 0xf, false))
    v += WS_DPP(v, 0xB1); v += WS_DPP(v, 0x4E); v += WS_DPP(v, 0x141); v += WS_DPP(v, 0x140);
#undef WS_DPP
    const float r0 = __builtin_bit_cast(float, __builtin_amdgcn_readlane(__builtin_bit_cast(int, v), 0)), r1 = __builtin_bit_cast(float, __builtin_amdgcn_readlane(__builtin_bit_cast(int, v), 16));
    const float r2 = __builtin_bit_cast(float, __builtin_amdgcn_readlane(__builtin_bit_cast(int, v), 32)), r3 = __builtin_bit_cast(float, __builtin_amdgcn_readlane(__builtin_bit_cast(int, v), 48));
    return (r0 + r1) + (r2 + r3);
}
__device__ __forceinline__ void tr_item(const float* W, int ldw, int K, bf16* WTn0, int k0, int srccol, LAS float* scr, int lane) {
    float wv[32];
#pragma unroll
    for (int i = 0; i < 32; ++i) wv[i] = W[(size_t)(k0 + 2 * i + (lane >> 5)) * ldw + srccol];
#pragma unroll
    for (int i = 0; i < 32; ++i) scr[(2 * i + (lane >> 5)) * 33 + (lane & 31)] = wv[i];
    LDS_WAIT(); asm volatile("" ::: "memory");
    const int c = lane & 7;
#pragma unroll
    for (int j = 0; j < 4; ++j) { const int n = (lane >> 3) + 8 * j; const LAS float* s = scr + (8 * c) * 33 + n;
        v4u o; o.x = pk2(s[0 * 33], s[1 * 33]); o.y = pk2(s[2 * 33], s[3 * 33]); o.z = pk2(s[4 * 33], s[5 * 33]); o.w = pk2(s[6 * 33], s[7 * 33]);
        *(GAS v4u*)(WTn0 + (size_t)n * K + k0 + 8 * c) = o; }
    LDS_WAIT(); asm volatile("" ::: "memory");
}
__device__ __forceinline__ int win_orig(int n) { if (n < 512 || n >= 2560) return n; const int i = n & 63; return (n & ~63) + 16 * ((i >> 5) & 1) + 4 * ((i >> 3) & 3) + (i & 3) + 32 * ((i >> 2) & 1); }
__device__ __forceinline__ void tr_plain(const float* W, int K, int N, bf16* WT, int item, LAS float* scr, int lane) {
    const int nblk = N / 32, kb = item / nblk, nb = item % nblk;
    tr_item(W, N, K, WT + (size_t)(32 * nb) * K, 64 * kb, 32 * nb + (lane & 31), scr, lane);
}
__device__ __forceinline__ void tr_win(const float* W, bf16* WT, int item, LAS float* scr, int lane) {
    const int nblk = INCOLS / 32, kb = item / nblk, nb = item % nblk;
    tr_item(W, INCOLS, DMODEL, WT + (size_t)(32 * nb) * DMODEL, 64 * kb, win_orig(32 * nb + (lane & 31)), scr, lane);
}
__device__ __forceinline__ void tr_gu(const float* Wg, const float* Wu, bf16* WT, int item, LAS float* scr, int lane) {
    const int nblk = INCOLS / 32, kb = item / nblk, nb = item % nblk; const int n0 = 32 * nb, pn = n0 >> 8, r = n0 & 255;
    const float* W = r < 128 ? Wg : Wu; const int col = pn * 128 + (r & 127) + (lane & 31);
    tr_item(W, DFF, DMODEL, WT + (size_t)n0 * DMODEL, 64 * kb, col, scr, lane);
}
struct S5In { const float *lam_re, *lam_im, *log_dt, *b_re, *b_im, *c_re, *c_im, *dd; };
__device__ __forceinline__ v4u pack8f(const float* v) { v4u o; o.x = pk2(v[0], v[1]); o.y = pk2(v[2], v[3]); o.z = pk2(v[4], v[5]); o.w = pk2(v[6], v[7]); return o; }
__device__ __forceinline__ void s5_item(LAS unsigned char* L, int tid, const S5In& P, int lg, int d, bf16* TZF, bf16* EM) {
    LAS float* sm = (LAS float*)(L);
    LAS float *s_fr = sm, *s_fi = sm + 64, *s_apr = sm + 128, *s_api = sm + 192, *BBr = sm + 256, *BBi = sm + 1280, *CAr = sm + 2304, *CAi = sm + 3328, *Kd = sm + 4352;
    if (tid < 64) {
        const int p = tid;
        const float dt = expf(P.log_dt[lg]);
        const float lr = P.lam_re[lg * 64 + p], li = P.lam_im[lg * 64 + p];
        const float mag = expf(lr * dt); float sn, cs; sincosf(li * dt, &sn, &cs);
        const float ar = mag * cs, ai = mag * sn;
        const float den = lr * lr + li * li, nr = ar - 1.0f, ni = ai;
        s_fr[p] = (nr * lr + ni * li) / den; s_fi[p] = (ni * lr - nr * li) / den;
        const float fd = (float)d; const float magd = expf(fd * lr * dt); float snd, csd; sincosf(fd * li * dt, &snd, &csd);
        s_apr[p] = magd * csd; s_api[p] = magd * snd;
    }
    __syncthreads();
    for (int idx = tid; idx < 1024; idx += 512) {
        { const int p = idx >> 4; const float br = P.b_re[(size_t)lg * 1024 + idx], bi = P.b_im[(size_t)lg * 1024 + idx]; const float fr_ = s_fr[p], fi_ = s_fi[p];
          BBr[idx] = fr_ * br - fi_ * bi; BBi[idx] = fr_ * bi + fi_ * br; }
        { const int p = idx & 63; const float cr = P.c_re[(size_t)lg * 1024 + idx], ci = P.c_im[(size_t)lg * 1024 + idx]; const float ar_ = s_apr[p], ai_ = s_api[p];
          CAr[idx] = cr * ar_ - ci * ai_; CAi[idx] = cr * ai_ + ci * ar_; }
    }
    __syncthreads();
    if (d <= 31 && tid < 256) { const int j = tid >> 4, jp = tid & 15; float acc = 0.f;
        for (int p = 0; p < 64; ++p) acc += CAr[j * 64 + p] * BBr[p * 16 + jp] - CAi[j * 64 + p] * BBi[p * 16 + jp];
        if (d == 0 && j == jp) acc += P.dd[lg * 16 + j];
        Kd[tid] = acc; }
    __syncthreads();
    bf16* TZ = TZF + (size_t)lg * 512 * 640; bf16* EE = EM + (size_t)lg * 256 * 512;
    if (d <= 31) {
        const int cnt = (32 - d) * 16;
        for (int idx = tid; idx < cnt; idx += 512) { const int tt = idx >> 4, j = idx & 15; float v[16];
#pragma unroll
            for (int q = 0; q < 16; ++q) v[q] = Kd[j * 16 + q];
            bf16* dst = TZ + (size_t)((d + tt) * 16 + j) * 640 + tt * 16;
            *(GAS v4u*)dst = pack8f(v); *(GAS v4u*)(dst + 8) = pack8f(v + 8);
            if (d >= 1) { bf16* dz = TZ + (size_t)(tt * 16 + j) * 640 + (d + tt) * 16; const v4u z = {0u, 0u, 0u, 0u}; *(GAS v4u*)dz = z; *(GAS v4u*)(dz + 8) = z; } }
        if (tid < 128) { const int ri = tid >> 6, p = tid & 63; const float ar_ = s_apr[p], ai_ = s_api[p]; float v[16];
#pragma unroll
            for (int q = 0; q < 16; ++q) { const float br = BBr[p * 16 + q], bi = BBi[p * 16 + q]; v[q] = ri == 0 ? (ar_ * br - ai_ * bi) : (ar_ * bi + ai_ * br); }
            bf16* dst = EE + (size_t)tid * 512 + (31 - d) * 16; *(GAS v4u*)dst = pack8f(v); *(GAS v4u*)(dst + 8) = pack8f(v + 8);
        } else if (tid < 256) { bf16* dz = EE + (size_t)tid * 512 + (31 - d) * 16; const v4u z = {0u, 0u, 0u, 0u}; *(GAS v4u*)dz = z; *(GAS v4u*)(dz + 8) = z; }
    }
    if (d >= 1 && tid < 256) { const int j = tid >> 4, ri = (tid >> 3) & 1, pc = tid & 7; float v[8];
#pragma unroll
        for (int q = 0; q < 8; ++q) v[q] = ri == 0 ? CAr[j * 64 + pc * 8 + q] : -CAi[j * 64 + pc * 8 + q];
        *(GAS v4u*)(TZ + (size_t)((d - 1) * 16 + j) * 640 + 512 + ri * 64 + pc * 8) = pack8f(v); }
    __syncthreads();
}
__device__ __forceinline__ void norm_rows4(const float* x0, size_t xstep, const f32x4 (&g)[4], bf16* o0, size_t ostep, int lane) {
    f32x4 h[4][4];
#pragma unroll
    for (int r = 0; r < 4; ++r) { const GAS f32x4* xr = (const GAS f32x4*)(x0 + r * xstep) + lane;
#pragma unroll
        for (int j = 0; j < 4; ++j) h[r][j] = xr[64 * j]; }
#pragma unroll
    for (int r = 0; r < 4; ++r) { float s2 = 0.f;
#pragma unroll
        for (int j = 0; j < 4; ++j) s2 += (h[r][j].x * h[r][j].x + h[r][j].y * h[r][j].y) + (h[r][j].z * h[r][j].z + h[r][j].w * h[r][j].w);
        const float rs = 1.0f / sqrtf(wave_sum(s2) * (1.0f / DMODEL) + EPS_NORM);
        GAS unsigned long long* o8 = (GAS unsigned long long*)(o0 + r * ostep) + lane;
#pragma unroll
        for (int j = 0; j < 4; ++j) { const f32x4 v = h[r][j] * rs * g[j]; o8[64 * j] = (unsigned long long)pk2(v.x, v.y) | ((unsigned long long)pk2(v.z, v.w) << 32); } }
}
__device__ __forceinline__ f32x4 bf4_f32(unsigned long long a) { const unsigned lo = (unsigned)a, hi = (unsigned)(a >> 32); f32x4 r; r.x = __uint_as_float(lo << 16); r.y = __uint_as_float(lo & 0xffff0000u); r.z = __uint_as_float(hi << 16); r.w = __uint_as_float(hi & 0xffff0000u); return r; }
__device__ __forceinline__ void norm_rows4b(const bf16* x0, size_t xstep, const f32x4 (&g)[4], bf16* o0, size_t ostep, int lane) {
    unsigned long long hb[4][4];
#pragma unroll
    for (int r = 0; r < 4; ++r) { const GAS unsigned long long* xr = (const GAS unsigned long long*)(x0 + r * xstep) + lane;
#pragma unroll
        for (int j = 0; j < 4; ++j) hb[r][j] = xr[64 * j]; }
#pragma unroll
    for (int r = 0; r < 4; ++r) { float s2 = 0.f; f32x4 h[4];
#pragma unroll
        for (int j = 0; j < 4; ++j) { h[j] = bf4_f32(hb[r][j]); s2 += (h[j].x * h[j].x + h[j].y * h[j].y) + (h[j].z * h[j].z + h[j].w * h[j].w); }
        const float rs = 1.0f / sqrtf(wave_sum(s2) * (1.0f / DMODEL) + EPS_NORM);
        GAS unsigned long long* o8 = (GAS unsigned long long*)(o0 + r * ostep) + lane;
#pragma unroll
        for (int j = 0; j < 4; ++j) { const f32x4 v = h[j] * rs * g[j]; o8[64 * j] = (unsigned long long)pk2(v.x, v.y) | ((unsigned long long)pk2(v.z, v.w) << 32); } }
}
__device__ __forceinline__ void norm_row(const float* xrow, const float* gain, bf16* orow, int lane, f32x4 (&hn)[4]) {
    const GAS f32x4* xr = (const GAS f32x4*)xrow + lane; const GAS f32x4* gr = (const GAS f32x4*)gain + lane;
    float s2 = 0.f;
#pragma unroll
    for (int j = 0; j < 4; ++j) { hn[j] = xr[64 * j]; s2 += (hn[j].x * hn[j].x + hn[j].y * hn[j].y) + (hn[j].z * hn[j].z + hn[j].w * hn[j].w); }
    const float rs = 1.0f / sqrtf(wave_sum(s2) * (1.0f / DMODEL) + EPS_NORM);
    GAS unsigned long long* o8 = (GAS unsigned long long*)orow + lane;
#pragma unroll
    for (int j = 0; j < 4; ++j) { const f32x4 g = gr[64 * j]; hn[j] = hn[j] * rs * g;
        o8[64 * j] = (unsigned long long)pk2(hn[j].x, hn[j].y) | ((unsigned long long)pk2(hn[j].z, hn[j].w) << 32); }
}

__global__ void __launch_bounds__(NWAVES * 64, 2) trunk_fwd(Args args) {
    extern __shared__ __attribute__((aligned(16))) unsigned char lds[];
    const int WAVE = __builtin_amdgcn_readfirstlane((int)threadIdx.x >> 6);
#define MYTID() ({ int l_; asm volatile("v_mbcnt_lo_u32_b32 %0, -1, 0\n\tv_mbcnt_hi_u32_b32 %0, -1, %0" : "=v"(l_)); WAVE * 64 + l_; })
    LAS unsigned char* const L0 = (LAS unsigned char*)lds;
#define OPQ LAS unsigned char* L = L0; asm volatile("" : "+s"(L))
    OPQ;
    {
        const int tid0 = MYTID();
        for (int u = tid0; u < (LDS_BYTES - LDSCTL_OFF) / 4; u += NWAVES * 64) ((LAS unsigned*)(L + LDSCTL_OFF))[u] = 0u;
        __syncthreads();
        if (tid0 == 0) {
#pragma unroll
            for (int k = 0; k < 31; ++k) ((LAS unsigned long long*)(L + PTR_OFF))[k] = (unsigned long long)(uintptr_t)args.in[k];
            ((LAS unsigned long long*)(L + PTR_OFF))[31] = (unsigned long long)(uintptr_t)args.out;
            ((LAS unsigned long long*)(L + PTR_OFF))[32] = (unsigned long long)(uintptr_t)args.ws; }
        __syncthreads();
    }
    { XcdBarrier b0 = xcd_barrier_post((unsigned*)(LDP(unsigned char, 32) + WS_CTL) + CW_BAR, (volatile LAS unsigned*)(L + MISC_OFF) + 8, MYTID()); (void)b0; }
#define GRID_BAR() do { OPQ; XcdBarrier b_; b_.bar = (unsigned*)(LDP(unsigned char, 32) + WS_CTL) + CW_BAR; b_.x = xb_xcc_id(); b_.st = (volatile LAS unsigned*)(L + MISC_OFF) + 8; xcd_barrier(b_, MYTID()); } while (0)
#define LQ() ({ int l_ = l; asm volatile("" : "+s"(l_)); l_; })
#define TID_SETUP OPQ; int wave_ = WAVE; asm volatile("" : "+s"(wave_)); const int wave = wave_; const int tid = MYTID(), lane = tid & 63; const int G = gridDim.x; const int vcu = ((int)blockIdx.x % 8) * (G / 8) + (int)blockIdx.x / 8; const int gw = vcu * NWAVES + wave, NGW = G * NWAVES; (void)lane; (void)gw; (void)NGW; (void)tid
#define WSP(T, off) ((T*)(LDP(unsigned char, 32) + (off)))
#define ACTP(T, off) ((T*)(LDP(unsigned char, 32) + WS_ACT + (off)))

    {
        TID_SETUP;
        LAS float* scr = (LAS float*)(L + RING_OFF + wave * 16384);
        constexpr int I_WIN = 16 * 176, I_GLU = 8 * 16, I_PS = 8 * 32, I_PA = 16 * 32, I_OUT = 16 * 32, I_GU = 16 * 176, I_DN = 44 * 32;
        constexpr int I_LAYER = I_WIN + I_GLU + I_PS + I_PA + I_OUT;
        constexpr int NITEMS = 2 * I_LAYER + I_GU + I_DN + 8 * I_GU + 8 * I_DN;
        for (int it = gw; it < NITEMS; it += NGW) {
            int r = it;
            if (r < 2 * I_LAYER) { const int l = r / I_LAYER; r -= l * I_LAYER;
                if (r < I_WIN) { tr_win(LDP(const float, 3) + (size_t)l * DMODEL * INCOLS, WSP(bf16, WS_WIN) + (size_t)l * INCOLS * DMODEL, r, scr, lane); continue; } r -= I_WIN;
                if (r < I_GLU) { tr_plain(LDP(const float, 12) + (size_t)l * 512 * 512, 512, 512, WSP(bf16, WS_WGLU) + (size_t)l * 512 * 512, r, scr, lane); continue; } r -= I_GLU;
                if (r < I_PS) { tr_plain(LDP(const float, 19) + (size_t)l * 512 * 1024, 512, 1024, WSP(bf16, WS_WPS) + (size_t)l * 1024 * 512, r, scr, lane); continue; } r -= I_PS;
                if (r < I_PA) { tr_plain(LDP(const float, 20) + (size_t)l * 1024 * 1024, 1024, 1024, WSP(bf16, WS_WPA) + (size_t)l * 1024 * 1024, r, scr, lane); continue; } r -= I_PA;
                tr_plain(LDP(const float, 21) + (size_t)l * 1024 * 1024, 1024, 1024, WSP(bf16, WS_WOUT) + (size_t)l * 1024 * 1024, r, scr, lane); continue; }
            r -= 2 * I_LAYER;
            if (r < I_GU) { tr_gu(LDP(const float, 23), LDP(const float, 24), WSP(bf16, WS_WDGU), r, scr, lane); continue; } r -= I_GU;
            if (r < I_DN) { tr_plain(LDP(const float, 25), DFF, DMODEL, WSP(bf16, WS_WDD), r, scr, lane); continue; } r -= I_DN;
            if (r < 8 * I_GU) { const int e = r / I_GU; r -= e * I_GU; tr_gu(LDP(const float, 27) + (size_t)e * DMODEL * DFF, LDP(const float, 28) + (size_t)e * DMODEL * DFF, WSP(bf16, WS_WMGU) + (size_t)e * INCOLS * DMODEL, r, scr, lane); continue; } r -= 8 * I_GU;
            { const int e = r / I_DN; r -= e * I_DN; tr_plain(LDP(const float, 29) + (size_t)e * DFF * DMODEL, DFF, DMODEL, WSP(bf16, WS_WMD) + (size_t)e * DMODEL * DFF, r, scr, lane); }
        }
        __syncthreads();
        { S5In s5p; s5p.lam_re = LDP(const float, 4); s5p.lam_im = LDP(const float, 5); s5p.log_dt = LDP(const float, 6); s5p.b_re = LDP(const float, 7); s5p.b_im = LDP(const float, 8);
          s5p.c_re = LDP(const float, 9); s5p.c_im = LDP(const float, 10); s5p.dd = LDP(const float, 11);
          for (int it = vcu; it < 2 * 32 * 33; it += G) s5_item(L, tid, s5p, it / 33, it % 33, WSP(bf16, WS_TZF), WSP(bf16, WS_EM)); }
        { const int* positions = LDP(const int, 1); float* ROPE = WSP(float, WS_ROPE);
          for (int idx = vcu * (NWAVES * 64) + tid; idx < NTOK * 32; idx += G * NWAVES * 64) { const int n = idx >> 5, fi = idx & 31;
            const float invf = powf(10000.0f, -(float)(2 * fi) / 64.0f); const float ang = (float)positions[n] * invf; float sn, cs; sincosf(ang, &sn, &cs);
            ROPE[(size_t)n * 64 + fi] = cs; ROPE[(size_t)n * 64 + 32 + fi] = sn; } }
    }
    GRID_BAR();

    for (int l = 0; l < 2; ++l) {
        for (int half = 0; half < 2; ++half) {
            const int tokbase = half * NH;
            { TID_SETUP; const float* xsrc = LDP(const float, 0); const bf16* XB = ACTP(const bf16, A_XB); const float* gain = LDP(const float, 2) + l * DMODEL; bf16* HB = ACTP(bf16, A_HB);
              f32x4 gq[4];
#pragma unroll
              for (int j = 0; j < 4; ++j) gq[j] = ((const GAS f32x4*)gain + lane)[64 * j];
              if (LQ() == 0) { for (int m = gw; m < NH; m += 4 * NGW) norm_rows4(xsrc + (size_t)(tokbase + m) * DMODEL, (size_t)NGW * DMODEL, gq, HB + (size_t)m * DMODEL, (size_t)NGW * DMODEL, lane); }
              else { for (int m = gw; m < NH; m += 4 * NGW) norm_rows4b(XB + (size_t)(tokbase + m) * DMODEL, (size_t)NGW * DMODEL, gq, HB + (size_t)m * DMODEL, (size_t)NGW * DMODEL, lane); } }
            GRID_BAR();
            { OPQ; pg8::Gemm g{ACTP(bf16, A_HB), WSP(bf16, WS_WIN) + (size_t)l * INCOLS * DMODEL, DMODEL, DMODEL, DMODEL}; pg8::SchedPlain S; S.init(NH / 256, INCOLS / 256, gridDim.x, (int)blockIdx.x);
              pg8::EpiIn E{ACTP(unsigned char, 0), WSP(const float, WS_ROPE), tokbase};
              pg8::gemm_phase<pg8::EpiIn, pg8::SchedPlain, true, true>(L0 + RING_OFF, g, S, E, MYTID()); }
            GRID_BAR();
            { OPQ; pg8::Gemm g{ACTP(bf16, A_UBUF), WSP(bf16, WS_EM) + (size_t)l * 32 * 256 * 512, 640, 512, 512}; pg8::SchedS5 S; S.init(1, gridDim.x, (int)blockIdx.x);
              pg8::EpiSloc E{ACTP(float, A_SLOC)};
              pg8::gemm_phase<pg8::EpiSloc, pg8::SchedS5, true, true>(L0 + RING_OFF, g, S, E, MYTID()); }
            GRID_BAR();
            { TID_SETUP;
              if (wave == 0) {
                const int id = vcu * 64 + lane;
                if (id < 8 * 32 * 64) { const int bl = id >> 11, g = (id >> 6) & 31, p = id & 63; const int lg = l * 32 + g;
                    const float dt = expf(LDP(const float, 6)[lg]); const float lr = LDP(const float, 4)[lg * 64 + p], li = LDP(const float, 5)[lg * 64 + p];
                    const float magT = expf(32.0f * lr * dt); float snT, csT; sincosf(32.0f * li * dt, &snT, &csT); const float aTr = magT * csT, aTi = magT * snT;
                    float sr = 0.f, si = 0.f; const size_t row0 = (size_t)g * 1024 + (size_t)bl * 128;
                    const float* sl = ACTP(const float, A_SLOC) + row0 * 128 + p; bf16* ub = ACTP(bf16, A_UBUF) + row0 * 640 + 512 + p;
                    for (int c0 = 0; c0 < 128; c0 += 8) { float lr_[8], li_[8];
#pragma unroll
                        for (int q = 0; q < 8; ++q) { lr_[q] = sl[(size_t)(c0 + q) * 128]; li_[q] = sl[(size_t)(c0 + q) * 128 + 64]; }
#pragma unroll
                        for (int q = 0; q < 8; ++q) { ub[(size_t)(c0 + q) * 640] = (bf16)f2bf(sr); ub[(size_t)(c0 + q) * 640 + 64] = (bf16)f2bf(si);
                            const float nr_ = aTr * sr - aTi * si + lr_[q], ni_ = aTr * si + aTi * sr + li_[q]; sr = nr_; si = ni_; } } }
              } }
            GRID_BAR();
            { OPQ; pg8::Gemm g{ACTP(bf16, A_UBUF), WSP(bf16, WS_TZF) + (size_t)l * 32 * 512 * 640, 640, 640, 640}; pg8::SchedS5 S; S.init(2, gridDim.x, (int)blockIdx.x);
              pg8::EpiYa E{ACTP(bf16, A_YA)};
              pg8::gemm_phase<pg8::EpiYa, pg8::SchedS5, true, true>(L0 + RING_OFF, g, S, E, MYTID()); }
            GRID_BAR();
            { OPQ; pg8::Gemm g{ACTP(bf16, A_YA), WSP(bf16, WS_WGLU) + (size_t)l * 512 * 512, 512, 512, 512}; pg8::SchedPlain S; S.init(NH / 256, 2, gridDim.x, (int)blockIdx.x);
              pg8::EpiGlu E{ACTP(bf16, A_YA), ACTP(bf16, A_YA2), LDP(const float, 13) + l * 512};
              pg8::gemm_phase<pg8::EpiGlu, pg8::SchedPlain, true, true>(L0 + RING_OFF, g, S, E, MYTID()); }
            GRID_BAR();
            {
                TID_SETUP;
                int lq = l; asm volatile("" : "+s"(lq));
                const float lam_init = 0.8f - 0.6f * expf(-0.3f * (float)lq);
                const float p1 = wave_sum(LDP(const float, 14)[lq * 64 + lane] * LDP(const float, 15)[lq * 64 + lane]), p2 = wave_sum(LDP(const float, 16)[lq * 64 + lane] * LDP(const float, 17)[lq * 64 + lane]);
                float lam_v = expf(p1) - expf(p2) + lam_init, gsc_v = 1.0f - lam_init; asm volatile("" : "+v"(lam_v), "+v"(gsc_v));
                const int lam_i = __builtin_amdgcn_readfirstlane(__builtin_bit_cast(int, lam_v)), gsc_i = __builtin_amdgcn_readfirstlane(__builtin_bit_cast(int, gsc_v));
                const float lam = __builtin_bit_cast(float, lam_i), gsc = __builtin_bit_cast(float, gsc_i);
                for (int i = 0; i < 8; ++i) {
                    OPQ; const int bh = (i >> 1) * 16 + (vcu >> 4); const int j = vcu & 15; const int qblk = (i & 1) ? 31 - j : j;
                    const int b = bh >> 3, h = bh & 7; const size_t rb = (size_t)b * SEQLEN;
                    attn_body::dattn2_unit<8>(qblk, (const attn_body::bf16*)(ACTP(bf16, A_Q) + rb * 1024 + h * 128), (const attn_body::bf16*)(ACTP(bf16, A_K) + rb * 1024 + h * 128),
                                             (const attn_body::bf16*)(ACTP(bf16, A_V) + rb * 1024 + h * 128), (attn_body::bf16*)(ACTP(bf16, A_YB) + rb * 1024 + h * 128),
                                             lam, LDP(const float, 18) + lq * 128, gsc, (char*)lds + RING_OFF, MYTID());
                }
            }
            GRID_BAR();
            { OPQ; pg8::Gemm g{ACTP(bf16, A_YA2), WSP(bf16, WS_WPS) + (size_t)l * 1024 * 512, 512, 512, 512}; pg8::SchedPlain S; S.init(NH / 256, 4, gridDim.x, (int)blockIdx.x);
              pg8::EpiGate<0> E{ACTP(bf16, A_SGS), nullptr};
              pg8::gemm_phase<pg8::EpiGate<0>, pg8::SchedPlain, true, true>(L0 + RING_OFF, g, S, E, MYTID()); }
            GRID_BAR();
            { OPQ; pg8::Gemm g{ACTP(bf16, A_YB), WSP(bf16, WS_WPA) + (size_t)l * 1024 * 1024, 1024, 1024, 1024}; pg8::SchedPlain S; S.init(NH / 256, 4, gridDim.x, (int)blockIdx.x);
              pg8::EpiGate<1> E{ACTP(bf16, A_SGA), ACTP(bf16, A_SGS)};
              pg8::gemm_phase<pg8::EpiGate<1>, pg8::SchedPlain, true, true>(L0 + RING_OFF, g, S, E, MYTID()); }
            GRID_BAR();
            { OPQ; pg8::Gemm g{ACTP(bf16, A_SGA), WSP(bf16, WS_WOUT) + (size_t)l * 1024 * 1024, 1024, 1024, 1024}; pg8::SchedPlain S; S.init(NH / 256, 4, gridDim.x, (int)blockIdx.x);
              pg8::EpiRes E{(LQ() == 0) ? LDP(const float, 0) : (const float*)nullptr, ACTP(bf16, A_XB), tokbase};
              pg8::gemm_phase<pg8::EpiRes, pg8::SchedPlain, true, true>(L0 + RING_OFF, g, S, E, MYTID()); }
            GRID_BAR();
            if (LQ() == 0) {
                { TID_SETUP; const bf16* xs = ACTP(const bf16, A_XB); const float* gain = LDP(const float, 22); bf16* H2 = ACTP(bf16, A_H2);
                  f32x4 gq[4];
#pragma unroll
                  for (int j = 0; j < 4; ++j) gq[j] = ((const GAS f32x4*)gain + lane)[64 * j];
                  for (int m = gw; m < NH; m += 4 * NGW) norm_rows4b(xs + (size_t)(tokbase + m) * DMODEL, (size_t)NGW * DMODEL, gq, H2 + (size_t)m * DMODEL, (size_t)NGW * DMODEL, lane); }
                GRID_BAR();
                { OPQ; pg8::Gemm g{ACTP(bf16, A_H2), WSP(bf16, WS_WDGU), 1024, 1024, 1024}; pg8::SchedPlain S; S.init(NH / 256, 22, gridDim.x, (int)blockIdx.x);
                  pg8::EpiSwi E{ACTP(bf16, A_FA)};
                  pg8::gemm_phase<pg8::EpiSwi, pg8::SchedPlain, true, true>(L0 + RING_OFF, g, S, E, MYTID()); }
                GRID_BAR();
                { OPQ; pg8::Gemm g{ACTP(bf16, A_FA), WSP(bf16, WS_WDD), 2816, 2816, 2816}; pg8::SchedPlain S; S.init(NH / 256, 4, gridDim.x, (int)blockIdx.x);
                  pg8::EpiRes E{(const float*)nullptr, ACTP(bf16, A_XB), tokbase};
                  pg8::gemm_phase<pg8::EpiRes, pg8::SchedPlain, true, true>(L0 + RING_OFF, g, S, E, MYTID()); }
                GRID_BAR();
            } else {
                {
                    TID_SETUP;
                    LAS float* rwT = (LAS float*)(L);
                    LAS unsigned* cntL = (LAS unsigned*)(L + 32768);
                    { const float* router_w = LDP(const float, 26); for (int idx = tid; idx < 8192; idx += NWAVES * 64) { const int k = idx >> 3, e = idx & 7; rwT[e * 1024 + k] = router_w[idx]; } }
                    if (tid < 8) cntL[tid] = 0u;
                    __syncthreads();
                    const bf16* xs = ACTP(const bf16, A_XB); const float* gain = LDP(const float, 22) + DMODEL; bf16* H2 = ACTP(bf16, A_H2M);
                    unsigned* RT_E = WSP(unsigned, WS_ROUTE + R_E); float* RT_W = WSP(float, WS_ROUTE + R_W);
                    f32x4 gq[4];
#pragma unroll
                    for (int j = 0; j < 4; ++j) gq[j] = ((const GAS f32x4*)gain + lane)[64 * j];
                    for (int i2 = 0; i2 < 16; i2 += 4) { f32x4 xv[4][4];
#pragma unroll
                      for (int u = 0; u < 4; ++u) { const GAS unsigned long long* xr = (const GAS unsigned long long*)(xs + (size_t)(tokbase + vcu * 128 + wave * 16 + i2 + u) * DMODEL) + lane;
#pragma unroll
                        for (int j = 0; j < 4; ++j) xv[u][j] = bf4_f32(xr[64 * j]); }
#pragma unroll
                      for (int u = 0; u < 4; ++u) { const int row = vcu * 128 + wave * 16 + i2 + u;
                        f32x4 hn[4]; { float s2 = 0.f;
#pragma unroll
                            for (int j = 0; j < 4; ++j) s2 += (xv[u][j].x * xv[u][j].x + xv[u][j].y * xv[u][j].y) + (xv[u][j].z * xv[u][j].z + xv[u][j].w * xv[u][j].w);
                            const float rs = 1.0f / sqrtf(wave_sum(s2) * (1.0f / DMODEL) + EPS_NORM);
                            GAS unsigned long long* o8 = (GAS unsigned long long*)(H2 + (size_t)row * DMODEL) + lane;
#pragma unroll
                            for (int j = 0; j < 4; ++j) { hn[j] = xv[u][j] * rs * gq[j]; o8[64 * j] = (unsigned long long)pk2(hn[j].x, hn[j].y) | ((unsigned long long)pk2(hn[j].z, hn[j].w) << 32); } }
                        float lg[8];
#pragma unroll
                        for (int e = 0; e < 8; ++e) { float a = 0.f;
#pragma unroll
                            for (int j = 0; j < 4; ++j) { const f32x4 w = *(const LAS f32x4*)(rwT + e * 1024 + 4 * lane + 256 * j); a += (hn[j].x * w.x + hn[j].y * w.y) + (hn[j].z * w.z + hn[j].w * w.w); }
                            lg[e] = wave_sum(a); }
                        if (lane == 0) { int e1 = 0; float v1 = lg[0];
#pragma unroll
                            for (int e = 1; e < 8; ++e) if (lg[e] > v1) { v1 = lg[e]; e1 = e; }
                            int e2 = -1; float v2 = -INFINITY;
#pragma unroll
                            for (int e = 0; e < 8; ++e) if (e != e1 && lg[e] > v2) { v2 = lg[e]; e2 = e; }
                            if (e2 < 0) e2 = (e1 == 0) ? 1 : 0;
                            const float ex = expf(v2 - v1); const float w1 = 1.0f / (1.0f + ex), w2 = ex / (1.0f + ex);
                            RT_E[row] = (unsigned)e1 | ((unsigned)e2 << 8); RT_W[2 * row] = w1; RT_W[2 * row + 1] = w2;
                            __hip_atomic_fetch_add(cntL + e1, 1u, __ATOMIC_RELAXED, __HIP_MEMORY_SCOPE_WORKGROUP); __hip_atomic_fetch_add(cntL + e2, 1u, __ATOMIC_RELAXED, __HIP_MEMORY_SCOPE_WORKGROUP); }
                      }
                    }
                    __syncthreads();
                    if (tid < 8) WSP(unsigned, WS_ROUTE + R_CNT)[vcu * 8 + tid] = cntL[tid];
                }
                GRID_BAR();
                {
                    TID_SETUP;
                    volatile LAS unsigned* MISC = (volatile LAS unsigned*)(L + MISC_OFF);
                    LAS unsigned* tab = (LAS unsigned*)(L);
                    LAS unsigned* tot = (LAS unsigned*)(L + 8192);
                    LAS unsigned* off = (LAS unsigned*)(L + 8192 + 64);
                    LAS unsigned* wcn = (LAS unsigned*)(L + 8192 + 128);
                    LAS unsigned* slt = (LAS unsigned*)(L + 8192 + 512);
                    const unsigned* RT_CNT = WSP(const unsigned, WS_ROUTE + R_CNT); const unsigned* RT_E = WSP(const unsigned, WS_ROUTE + R_E); int* RT_S = WSP(int, WS_ROUTE + R_S);
                    const bf16* H2 = ACTP(const bf16, A_H2M); bf16* H2G = ACTP(bf16, A_H2G);
                    if (tid < 256) { const GAS v4u* src = (const GAS v4u*)(RT_CNT + tid * 8); const v4u a = src[0], b = src[1];
                        tab[tid * 8 + 0] = a.x; tab[tid * 8 + 1] = a.y; tab[tid * 8 + 2] = a.z; tab[tid * 8 + 3] = a.w; tab[tid * 8 + 4] = b.x; tab[tid * 8 + 5] = b.y; tab[tid * 8 + 6] = b.z; tab[tid * 8 + 7] = b.w; }
                    __syncthreads();
                    if (tid < 8) { tot[tid] = 0u; off[tid] = 0u; }
                    __syncthreads();
                    { const int e = tid & 7, b0 = (tid >> 3) * 4; unsigned t = 0, o = 0;
#pragma unroll
                      for (int q = 0; q < 4; ++q) { const unsigned c = tab[(b0 + q) * 8 + e]; t += c; if (b0 + q < vcu) o += c; }
                      __hip_atomic_fetch_add(tot + e, t, __ATOMIC_RELAXED, __HIP_MEMORY_SCOPE_WORKGROUP); __hip_atomic_fetch_add(off + e, o, __ATOMIC_RELAXED, __HIP_MEMORY_SCOPE_WORKGROUP); }
                    __syncthreads();
                    if (tid == 0) { unsigned sp = 0; for (int e = 0; e < 8; ++e) { MISC[16 + e] = sp; sp += (tot[e] + 255u) >> 8; } MISC[24] = sp; }
                    __syncthreads();
                    int my_e = 0, my_rank = 0;
                    if (tid < 256) { const int row = vcu * 128 + (tid >> 1); const unsigned ee = RT_E[row]; my_e = (tid & 1) ? (int)((ee >> 8) & 255u) : (int)(ee & 255u);
#pragma unroll
                        for (int e = 0; e < 8; ++e) { const unsigned long long mask = __ballot(my_e == e); if (my_e == e) my_rank = __popcll(mask & ((1ull << lane) - 1ull)); if (lane == 0) wcn[wave * 8 + e] = (unsigned)__popcll(mask); } }
                    __syncthreads();
                    if (tid < 256) { unsigned pre = 0; for (int w = 0; w < wave; ++w) pre += wcn[w * 8 + my_e];
                        const unsigned slot = MISC[16 + my_e] * 256u + off[my_e] + pre + (unsigned)my_rank;
                        RT_S[(vcu * 128 + (tid >> 1)) * 2 + (tid & 1)] = (int)slot; slt[tid] = slot; }
                    __syncthreads();
                    for (int i = 0; i < 32; i += 4) { v4u a[4], b[4];
#pragma unroll
                        for (int u = 0; u < 4; ++u) { const int id = wave * 32 + i + u; const GAS v4u* src = (const GAS v4u*)(H2 + (size_t)(vcu * 128 + (id >> 1)) * DMODEL) + lane * 2; a[u] = src[0]; b[u] = src[1]; }
#pragma unroll
                        for (int u = 0; u < 4; ++u) { const unsigned slot = slt[wave * 32 + i + u]; GAS v4u* dst = (GAS v4u*)(H2G + (size_t)slot * DMODEL) + lane * 2; dst[0] = a[u]; dst[1] = b[u]; } }
                    if (vcu < 8) { const unsigned e = (unsigned)vcu; const unsigned r0 = MISC[16 + e] * 256u + tot[e], r1 = MISC[17 + e] * 256u; const v4u z = {0u, 0u, 0u, 0u};
                        for (unsigned r = r0 + (unsigned)wave; r < r1; r += NWAVES) { GAS v4u* dst = (GAS v4u*)(H2G + (size_t)r * DMODEL) + lane * 2; dst[0] = z; dst[1] = z; } }
                }
                GRID_BAR();
#define MOE_SCHED(S, NN) do { volatile LAS unsigned* MISC = (volatile LAS unsigned*)(L + MISC_OFF); S.nn = (NN); \
        S.sp1 = __builtin_amdgcn_readfirstlane((int)MISC[17]); S.sp2 = __builtin_amdgcn_readfirstlane((int)MISC[18]); S.sp3 = __builtin_amdgcn_readfirstlane((int)MISC[19]); S.sp4 = __builtin_amdgcn_readfirstlane((int)MISC[20]); \
        S.sp5 = __builtin_amdgcn_readfirstlane((int)MISC[21]); S.sp6 = __builtin_amdgcn_readfirstlane((int)MISC[22]); S.sp7 = __builtin_amdgcn_readfirstlane((int)MISC[23]); \
        S.so.init(__builtin_amdgcn_readfirstlane((int)MISC[24]), (NN), gridDim.x, (int)blockIdx.x); } while (0)
                { OPQ; pg8::SchedMoe S; MOE_SCHED(S, 22);
                  pg8::Gemm g{ACTP(bf16, A_H2G), WSP(bf16, WS_WMGU), 1024, 1024, 1024}; pg8::EpiSwi E{ACTP(bf16, A_AG)};
                  pg8::gemm_phase<pg8::EpiSwi, pg8::SchedMoe, true, true>(L0 + RING_OFF, g, S, E, MYTID()); }
                GRID_BAR();
                { OPQ; pg8::SchedMoe S; MOE_SCHED(S, 4);
                  pg8::Gemm g{ACTP(bf16, A_AG), WSP(bf16, WS_WMD), 2816, 2816, 2816}; pg8::EpiBf E{ACTP(bf16, A_YG)};
                  pg8::gemm_phase<pg8::EpiBf, pg8::SchedMoe, true, true>(L0 + RING_OFF, g, S, E, MYTID()); }
                GRID_BAR();
                {
                    TID_SETUP;
                    const int* RT_S = WSP(const int, WS_ROUTE + R_S); const float* RT_W = WSP(const float, WS_ROUTE + R_W); float* xo = LDP(float, 31); const bf16* XBc = ACTP(const bf16, A_XB); const bf16* YG = ACTP(const bf16, A_YG);
                    const GAS f32x4* gr = (const GAS f32x4*)LDP(const float, 30) + lane;
                    f32x4 gq[4];
#pragma unroll
                    for (int j = 0; j < 4; ++j) gq[j] = gr[64 * j];
                    for (int m = gw; m < NH; m += 4 * NGW) {
                        int s1[4], s2[4]; float w1[4], w2[4];
#pragma unroll
                        for (int r = 0; r < 4; ++r) { const int mm = m + r * NGW; s1[r] = RT_S[2 * mm]; s2[r] = RT_S[2 * mm + 1]; w1[r] = RT_W[2 * mm]; w2[r] = RT_W[2 * mm + 1]; }
                        f32x4 xa[4][4]; unsigned long long ya[4][4], yb[4][4];
#pragma unroll
                        for (int r = 0; r < 4; ++r) { const GAS unsigned long long* xr = (const GAS unsigned long long*)(XBc + (size_t)(tokbase + m + r * NGW) * DMODEL) + lane;
                            const GAS unsigned long long* y1 = (const GAS unsigned long long*)(YG + (size_t)s1[r] * DMODEL) + lane; const GAS unsigned long long* y2 = (const GAS unsigned long long*)(YG + (size_t)s2[r] * DMODEL) + lane;
#pragma unroll
                            for (int j = 0; j < 4; ++j) { xa[r][j] = bf4_f32(xr[64 * j]); ya[r][j] = y1[64 * j]; yb[r][j] = y2[64 * j]; } }
#pragma unroll
                        for (int r = 0; r < 4; ++r) { float sq = 0.f;
#pragma unroll
                            for (int j = 0; j < 4; ++j) { const unsigned long long a = ya[r][j], b = yb[r][j]; f32x4 x4 = xa[r][j];
                                const unsigned alo = (unsigned)a, ahi = (unsigned)(a >> 32), blo = (unsigned)b, bhi = (unsigned)(b >> 32);
                                x4.x += w1[r] * __uint_as_float(alo << 16) + w2[r] * __uint_as_float(blo << 16); x4.y += w1[r] * __uint_as_float(alo & 0xffff0000u) + w2[r] * __uint_as_float(blo & 0xffff0000u);
                                x4.z += w1[r] * __uint_as_float(ahi << 16) + w2[r] * __uint_as_float(bhi << 16); x4.w += w1[r] * __uint_as_float(ahi & 0xffff0000u) + w2[r] * __uint_as_float(bhi & 0xffff0000u);
                                xa[r][j] = x4; sq += (x4.x * x4.x + x4.y * x4.y) + (x4.z * x4.z + x4.w * x4.w); }
                            const float rs = 1.0f / sqrtf(wave_sum(sq) * (1.0f / DMODEL) + EPS_NORM);
                            GAS f32x4* xw = (GAS f32x4*)(xo + (size_t)(tokbase + m + r * NGW) * DMODEL) + lane;
#pragma unroll
                            for (int j = 0; j < 4; ++j) xw[64 * j] = xa[r][j] * rs * gq[j]; }
                    }
                }
                GRID_BAR();
            }
        }
    }
#undef GRID_BAR
#undef TID_SETUP
#undef LQ
#undef MYTID
#undef OPQ
#undef WSP
#undef ACTP
#undef MOE_SCHED
}

extern "C" void kernel_launch(void* const* d_in, const int* in_sizes, int n_in, void* d_out, int out_size, void* d_ws, size_t ws_size, hipStream_t stream) {
    static int grid = 0;
    if (grid == 0) {
        if (n_in != 31 || in_sizes[0] != NTOK * DMODEL || out_size != NTOK * DMODEL || ws_size < WS_END) {
            fprintf(stderr, "kernel_launch: unexpected shapes: n_in %d in0 %d out %d ws %zu (need %zu); nothing launched\n", n_in, n_in > 0 ? in_sizes[0] : -1, out_size, ws_size, (size_t)WS_END); grid = -1; return; }
        int dev = 0, cus = 0, per_cu = 0;
        if (hipGetDevice(&dev) != hipSuccess || hipDeviceGetAttribute(&cus, hipDeviceAttributeMultiprocessorCount, dev) != hipSuccess) { grid = -1; return; }
        if (hipFuncSetAttribute((const void*)trunk_fwd, hipFuncAttributeMaxDynamicSharedMemorySize, LDS_BYTES) != hipSuccess) { fprintf(stderr, "kernel_launch: hipFuncSetAttribute failed\n"); grid = -1; return; }
        if (hipOccupancyMaxActiveBlocksPerMultiprocessor(&per_cu, (const void*)trunk_fwd, NWAVES * 64, LDS_BYTES) != hipSuccess || per_cu < 1)
            fprintf(stderr, "kernel_launch: note: occupancy query reports %d workgroups per CU\n", per_cu);
        (void)hipGetLastError();
        grid = 256;
        if (cus < 256) { fprintf(stderr, "kernel_launch: device has %d CUs, need 256; nothing launched\n", cus); grid = -1; return; }
    }
    if (grid < 0) return;
    if (hipMemsetAsync((char*)d_ws + WS_CTL, 0, CTL_ZERO_BYTES, stream) != hipSuccess) return;
    Args a{};
    for (int i = 0; i < 31; ++i) a.in[i] = d_in[i];
    a.out = (float*)d_out; a.ws = (unsigned char*)d_ws;
    hipLaunchKernelGGL(trunk_fwd, dim3(grid), dim3(NWAVES * 64), LDS_BYTES, stream, a);
}
```

```cpp
#include <hip/hip_runtime.h>
#include <hip/hip_bf16.h>
#include <cstdio>
#include <cstdint>
#include <cmath>
namespace pg8 {
#define PG8_LAS __attribute__((address_space(3)))
typedef unsigned short bf16_t;
typedef short bf16x8 __attribute__((ext_vector_type(8)));
typedef float f32x4 __attribute__((ext_vector_type(4)));
typedef unsigned u32x4 __attribute__((ext_vector_type(4)));
constexpr int BM = 256, BK = 64, HALF = 128, HTB = HALF * BK * 2  , STAGE_BYTES = 8 * HTB, NXCD = 8, WGM = 8;

__host__ __device__ __forceinline__ int lds_byte(int r, int c) { const int st = (r >> 4) * 2 + (c >> 5), rr = r & 15, cc = c & 31, ob = rr * 64 + cc * 2; return st * 1024 + (ob ^ (((ob >> 9) & 1) << 5)); }
__host__ __device__ __forceinline__ void stage_rc(int b, int& R, int& C) { const int st = b / 1024, sb = b % 1024, swz = sb ^ (((sb >> 9) & 1) << 5); R = (st >> 1) * 16 + swz / 64; C = (st & 1) * 32 + (swz % 64) / 2; }
__host__ __device__ __forceinline__ int perm32(int rho) { const int n = rho >> 4, i = rho & 15; return 8 * (i >> 2) + 4 * n + (i & 3); }

struct Unit { int pm, pn; };
struct Gemm { const bf16_t* A; const bf16_t* Bt; int lda, ldb, K; const unsigned* rowidx = nullptr; };

struct StaticOrder {
    int nM, nN, nwg, G, c;
    __host__ __device__ void init(int nM_, int nN_, int G_, int c_) { nM = nM_; nN = nN_; nwg = nM * nN; G = G_; c = c_; }
    __host__ __device__ bool next(int i, Unit& u) const {
        const long L = (long)i * G + c; if (L >= nwg) return false;
        int wgid = (int)L; { const int q = nwg / NXCD, r = nwg % NXCD, xcd = wgid % NXCD, off = wgid / NXCD; wgid = (xcd < r ? xcd * (q + 1) : r * (q + 1) + (xcd - r) * q) + off; }
        const int nig = WGM * nN, gid = wgid / nig, fm = gid * WGM, gsz = (nM - fm) < WGM ? (nM - fm) : WGM;
        u.pm = fm + ((wgid % nig) % gsz); u.pn = (wgid % nig) / gsz; return true;
    }
    __device__ __forceinline__ void a_ready(const Unit&) const {}
    __device__ __forceinline__ void done(const Unit&) const {}
};


struct SchedPlain {
    StaticOrder so;
    __device__ __forceinline__ void init(int nM, int nN, int G, int c) { so.init(nM, nN, G, c); }
    __device__ __forceinline__ bool next(int i, Unit& u) const { return so.next(i, u); }
    __device__ __forceinline__ void a_ready(const Unit&) const {}
    __device__ __forceinline__ void done(const Unit&) const {}
};
struct SchedS5 {
    StaticOrder so; int nng;
    __device__ __forceinline__ void init(int nng_, int G, int c) { nng = nng_; so.init(128, nng_, G, c); }
    __device__ __forceinline__ bool next(int i, Unit& u) const { if (!so.next(i, u)) return false; u.pn = (u.pm >> 2) * nng + u.pn; return true; }
    __device__ __forceinline__ void a_ready(const Unit&) const {}
    __device__ __forceinline__ void done(const Unit&) const {}
};
struct SchedMoe {
    StaticOrder so; int nn; int sp1, sp2, sp3, sp4, sp5, sp6, sp7;
    __device__ __forceinline__ bool next(int i, Unit& u) const {
        if (!so.next(i, u)) return false;
        const int pm = u.pm; const int e = (pm >= sp1) + (pm >= sp2) + (pm >= sp3) + (pm >= sp4) + (pm >= sp5) + (pm >= sp6) + (pm >= sp7);
        u.pn = e * nn + u.pn; return true;
    }
    __device__ __forceinline__ void a_ready(const Unit&) const {}
    __device__ __forceinline__ void done(const Unit&) const {}
};

typedef float f32x2c_t __attribute__((ext_vector_type(2))); typedef __bf16 bf16x2c_t __attribute__((ext_vector_type(2)));
__device__ __forceinline__ unsigned cvt_pk_bf16(float lo, float hi) { f32x2c_t v = {lo, hi}; bf16x2c_t b = __builtin_convertvector(v, bf16x2c_t); return __builtin_bit_cast(unsigned, b); }
__device__ __forceinline__ u32x4 pack8(const f32x4 a, const f32x4 b) { u32x4 w; w.x = cvt_pk_bf16(a[0], a[1]); w.y = cvt_pk_bf16(a[2], a[3]); w.z = cvt_pk_bf16(b[0], b[1]); w.w = cvt_pk_bf16(b[2], b[3]); return w; }
__device__ __forceinline__ void unpack8(const u32x4 w, f32x4& a, f32x4& b) {
    a[0] = __uint_as_float(w.x << 16); a[1] = __uint_as_float(w.x & 0xffff0000u); a[2] = __uint_as_float(w.y << 16); a[3] = __uint_as_float(w.y & 0xffff0000u);
    b[0] = __uint_as_float(w.z << 16); b[1] = __uint_as_float(w.z & 0xffff0000u); b[2] = __uint_as_float(w.w << 16); b[3] = __uint_as_float(w.w & 0xffff0000u); }
__device__ __forceinline__ float sigm(float z) { return __builtin_amdgcn_rcpf(1.0f + __builtin_amdgcn_exp2f(-1.4426950408889634f * z)); }
__device__ __forceinline__ f32x4 sigm4(const f32x4 z) { f32x4 r; r[0] = sigm(z[0]); r[1] = sigm(z[1]); r[2] = sigm(z[2]); r[3] = sigm(z[3]); return r; }
__device__ __forceinline__ float gelu_t(float x) { const float u = 1.5957691216057308f * (x + 0.044715f * x * x * x); return x * sigm(u); }
__device__ __forceinline__ f32x4 gelu4(const f32x4 z) { f32x4 r; r[0] = gelu_t(z[0]); r[1] = gelu_t(z[1]); r[2] = gelu_t(z[2]); r[3] = gelu_t(z[3]); return r; }
constexpr size_t EA_U = (size_t)64 << 20, EA_Q = (size_t)120 << 20, EA_K = (size_t)184 << 20, EA_V = (size_t)248 << 20, EA_SGS = (size_t)312 << 20, EA_SGA = (size_t)376 << 20;
constexpr float QSCALE = 0.125f * 1.4426950408889634f;

struct EpiIn {
    static constexpr bool PERM = true, AFTER_DRAIN = false;
    unsigned char* act; const float* rope; int tokbase;
    __device__ __forceinline__ void operator()(const f32x4 (&acc)[2][2][4][2], const Unit& u, int wr, int wc, int fr_in, int fq_in) const {
        int fr = fr_in, fq = fq_in; asm volatile("" : "+v"(fr), "+v"(fq));
        const int pn = u.pn, rowb = u.pm * BM + wr * 64 + fr, cow = wc * 32 + fq * 8;
        if (pn < 2) {
#pragma unroll
            for (int ai = 0; ai < 2; ++ai)
#pragma unroll
                for (int m = 0; m < 4; ++m) { const int row = rowb + ai * HALF + m * 16;
#pragma unroll
                    for (int bj = 0; bj < 2; ++bj) { const int c = pn * 256 + bj * HALF + cow; const int g = c >> 4, jj = c & 15;
                        bf16_t* dst = (bf16_t*)(act + EA_U) + ((size_t)(g * 1024 + (row >> 5)) * 640 + (row & 31) * 16 + jj);
                        *(u32x4*)dst = pack8(acc[ai][bj][m][0], acc[ai][bj][m][1]); } }
        } else if (pn < 10) {
            const bool isq = pn < 6; bf16_t* base = (bf16_t*)(act + (isq ? EA_Q : EA_K)); const int colt = (isq ? pn - 2 : pn - 6) * 256; const float sc = isq ? QSCALE : 1.0f;
            const int dlo = 16 * (wc & 1) + 4 * fq;
#pragma unroll
            for (int ai = 0; ai < 2; ++ai) { f32x4 csq[4], snq[4];
#pragma unroll
                for (int m = 0; m < 4; ++m) { const float* tr = rope + (size_t)(tokbase + rowb + ai * HALF + m * 16) * 64 + dlo; csq[m] = *(const f32x4*)tr; snq[m] = *(const f32x4*)(tr + 32); }
#pragma unroll
                for (int m = 0; m < 4; ++m) { const int row = rowb + ai * HALF + m * 16; const f32x4 cs = csq[m], sn = snq[m];
#pragma unroll
                    for (int bj = 0; bj < 2; ++bj) { const f32x4 v0 = acc[ai][bj][m][0], v1 = acc[ai][bj][m][1];
                        const f32x4 o0 = (v0 * cs - v1 * sn) * sc, o1 = (v1 * cs + v0 * sn) * sc;
                        *(u32x4*)(base + (size_t)row * 1024 + colt + bj * HALF + cow) = pack8(o0, o1); } } }
        } else if (pn < 14) {
            const int colt = (pn - 10) * 256;
#pragma unroll
            for (int ai = 0; ai < 2; ++ai)
#pragma unroll
                for (int m = 0; m < 4; ++m) { const int row = rowb + ai * HALF + m * 16;
#pragma unroll
                    for (int bj = 0; bj < 2; ++bj) *(u32x4*)((bf16_t*)(act + EA_V) + (size_t)row * 1024 + colt + bj * HALF + cow) = pack8(acc[ai][bj][m][0], acc[ai][bj][m][1]); }
        } else {
            bf16_t* base = (bf16_t*)(act + (pn < 18 ? EA_SGS : EA_SGA)); const int colt = (pn < 18 ? pn - 14 : pn - 18) * 256;
#pragma unroll
            for (int ai = 0; ai < 2; ++ai)
#pragma unroll
                for (int m = 0; m < 4; ++m) { const int row = rowb + ai * HALF + m * 16;
#pragma unroll
                    for (int bj = 0; bj < 2; ++bj) *(u32x4*)(base + (size_t)row * 1024 + colt + bj * HALF + cow) = pack8(sigm4(acc[ai][bj][m][0]), sigm4(acc[ai][bj][m][1])); }
        }
    }
};
struct EpiSloc {
    static constexpr bool PERM = false, AFTER_DRAIN = false;
    float* S;
    __device__ __forceinline__ void operator()(const f32x4 (&acc)[2][2][4][2], const Unit& u, int wr, int wc, int fr_in, int fq_in) const {
        int fr = fr_in, fq = fq_in; asm volatile("" : "+v"(fr), "+v"(fq));
        const int rowb = u.pm * BM + wr * 64 + fr, col0 = wc * 32 + 4 * fq;
#pragma unroll
        for (int ai = 0; ai < 2; ++ai)
#pragma unroll
            for (int m = 0; m < 4; ++m) { float* rowp = S + (size_t)(rowb + ai * HALF + m * 16) * 128 + col0;
#pragma unroll
                for (int n = 0; n < 2; ++n) *(f32x4*)(rowp + n * 16) = acc[ai][0][m][n]; }
    }
};
struct EpiYa {
    static constexpr bool PERM = true, AFTER_DRAIN = false;
    bf16_t* YA;
    __device__ __forceinline__ void operator()(const f32x4 (&acc)[2][2][4][2], const Unit& u, int wr, int wc, int fr_in, int fq_in) const {
        int fr = fr_in, fq = fq_in; asm volatile("" : "+v"(fr), "+v"(fq));
        const int g = u.pm >> 2, pni = u.pn & 1; const int rowb = (u.pm & 3) * BM + wr * 64 + fr; const int jj = 8 * (fq & 1);
#pragma unroll
        for (int ai = 0; ai < 2; ++ai)
#pragma unroll
            for (int m = 0; m < 4; ++m) { const int R = rowb + ai * HALF + m * 16;
#pragma unroll
                for (int bj = 0; bj < 2; ++bj) { const int t = pni * 16 + bj * 8 + wc * 2 + (fq >> 1);
                    *(u32x4*)(YA + (size_t)(R * 32 + t) * 512 + g * 16 + jj) = pack8(gelu4(acc[ai][bj][m][0]), gelu4(acc[ai][bj][m][1])); } }
    }
};
struct EpiGlu {
    static constexpr bool PERM = true, AFTER_DRAIN = false;
    const bf16_t* YA; bf16_t* O; const float* bias;
    __device__ __forceinline__ void operator()(const f32x4 (&acc)[2][2][4][2], const Unit& u, int wr, int wc, int fr_in, int fq_in) const {
        int fr = fr_in, fq = fq_in; asm volatile("" : "+v"(fr), "+v"(fq));
        const int rowb = u.pm * BM + wr * 64 + fr, col0 = u.pn * BM + wc * 32 + 8 * fq;
        f32x4 bv[2][2];
#pragma unroll
        for (int bj = 0; bj < 2; ++bj)
#pragma unroll
            for (int n = 0; n < 2; ++n) bv[bj][n] = *(const f32x4*)(bias + col0 + bj * HALF + 4 * n);
#pragma unroll
        for (int ai = 0; ai < 2; ++ai) { u32x4 yq[4][2];
#pragma unroll
            for (int m = 0; m < 4; ++m)
#pragma unroll
                for (int bj = 0; bj < 2; ++bj) yq[m][bj] = *(const u32x4*)(YA + (size_t)(rowb + ai * HALF + m * 16) * 512 + col0 + bj * HALF);
#pragma unroll
            for (int m = 0; m < 4; ++m) { const size_t off = (size_t)(rowb + ai * HALF + m * 16) * 512 + col0;
#pragma unroll
                for (int bj = 0; bj < 2; ++bj) { f32x4 y0, y1; unpack8(yq[m][bj], y0, y1);
                    *(u32x4*)(O + off + bj * HALF) = pack8(y0 * sigm4(acc[ai][bj][m][0] + bv[bj][0]), y1 * sigm4(acc[ai][bj][m][1] + bv[bj][1])); } } }
    }
};
template <int MODE> struct EpiGate {
    static constexpr bool PERM = true, AFTER_DRAIN = false;
    bf16_t* G; const bf16_t* T0;
    __device__ __forceinline__ void operator()(const f32x4 (&acc)[2][2][4][2], const Unit& u, int wr, int wc, int fr_in, int fq_in) const {
        int fr = fr_in, fq = fq_in; asm volatile("" : "+v"(fr), "+v"(fq));
        const int rowb = u.pm * BM + wr * 64 + fr, col0 = u.pn * BM + wc * 32 + 8 * fq;
        u32x4 gA[4], tA[4], gB[4], tB[4];
#define EG_LOAD(ai, bj, gq, tq) do { _Pragma("unroll") for (int m = 0; m < 4; ++m) { const size_t off = (size_t)(rowb + (ai) * HALF + m * 16) * 1024 + col0 + (bj) * HALF; gq[m] = *(const u32x4*)(G + off); if (MODE == 1) tq[m] = *(const u32x4*)(T0 + off); } } while (0)
#define EG_STORE(ai, bj, gq, tq) do { _Pragma("unroll") for (int m = 0; m < 4; ++m) { const size_t off = (size_t)(rowb + (ai) * HALF + m * 16) * 1024 + col0 + (bj) * HALF; f32x4 g0, g1; unpack8(gq[m], g0, g1); \
            f32x4 o0 = g0 * acc[ai][bj][m][0], o1 = g1 * acc[ai][bj][m][1]; if (MODE == 1) { f32x4 t0, t1; unpack8(tq[m], t0, t1); o0 += t0; o1 += t1; } *(u32x4*)(G + off) = pack8(o0, o1); } } while (0)
        if (MODE == 0) { EG_LOAD(0, 0, gA, tA); EG_LOAD(0, 1, gB, tB); EG_STORE(0, 0, gA, tA); EG_LOAD(1, 0, gA, tA); EG_STORE(0, 1, gB, tB); EG_LOAD(1, 1, gB, tB); EG_STORE(1, 0, gA, tA); EG_STORE(1, 1, gB, tB); }
        else { EG_LOAD(0, 0, gA, tA); EG_STORE(0, 0, gA, tA); EG_LOAD(0, 1, gA, tA); EG_STORE(0, 1, gA, tA); EG_LOAD(1, 0, gA, tA); EG_STORE(1, 0, gA, tA); EG_LOAD(1, 1, gA, tA); EG_STORE(1, 1, gA, tA); }
#undef EG_LOAD
#undef EG_STORE
    }
};
struct EpiRes {
    static constexpr bool PERM = true, AFTER_DRAIN = false;
    const float* xin32; bf16_t* xb; int tokbase;
    __device__ __forceinline__ void operator()(const f32x4 (&acc)[2][2][4][2], const Unit& u, int wr, int wc, int fr_in, int fq_in) const {
        int fr = fr_in, fq = fq_in; asm volatile("" : "+v"(fr), "+v"(fq));
        const int rowb = tokbase + u.pm * BM + wr * 64 + fr, col0 = u.pn * BM + wc * 32 + 8 * fq;
        const bool f32in = xin32 != nullptr;
        if (f32in) { f32x4 xA[4][2], xB[4][2];
#define ER_LOAD(ai, bj, xq) do { _Pragma("unroll") for (int m = 0; m < 4; ++m) { const size_t off = (size_t)(rowb + (ai) * HALF + m * 16) * 1024 + col0 + (bj) * HALF; xq[m][0] = *(const f32x4*)(xin32 + off); xq[m][1] = *(const f32x4*)(xin32 + off + 4); } } while (0)
#define ER_STORE(ai, bj, xq) do { _Pragma("unroll") for (int m = 0; m < 4; ++m) *(u32x4*)(xb + (size_t)(rowb + (ai) * HALF + m * 16) * 1024 + col0 + (bj) * HALF) = pack8(xq[m][0] + acc[ai][bj][m][0], xq[m][1] + acc[ai][bj][m][1]); } while (0)
            ER_LOAD(0, 0, xA); ER_STORE(0, 0, xA); ER_LOAD(0, 1, xA); ER_STORE(0, 1, xA); ER_LOAD(1, 0, xA); ER_STORE(1, 0, xA); ER_LOAD(1, 1, xA); ER_STORE(1, 1, xA); (void)xB;
#undef ER_LOAD
#undef ER_STORE
        } else { u32x4 wA[4], wB[4];
#define ER_LOAD(ai, bj, xw) do { _Pragma("unroll") for (int m = 0; m < 4; ++m) xw[m] = *(const u32x4*)(xb + (size_t)(rowb + (ai) * HALF + m * 16) * 1024 + col0 + (bj) * HALF); } while (0)
#define ER_STORE(ai, bj, xw) do { _Pragma("unroll") for (int m = 0; m < 4; ++m) { f32x4 x0, x1; unpack8(xw[m], x0, x1); *(u32x4*)(xb + (size_t)(rowb + (ai) * HALF + m * 16) * 1024 + col0 + (bj) * HALF) = pack8(x0 + acc[ai][bj][m][0], x1 + acc[ai][bj][m][1]); } } while (0)
            ER_LOAD(0, 0, wA); ER_LOAD(0, 1, wB); ER_STORE(0, 0, wA); ER_LOAD(1, 0, wA); ER_STORE(0, 1, wB); ER_LOAD(1, 1, wB); ER_STORE(1, 0, wA); ER_STORE(1, 1, wB);
#undef ER_LOAD
#undef ER_STORE
        }
    }
};
struct EpiSwi {
    static constexpr bool PERM = true, AFTER_DRAIN = false;
    bf16_t* O;
    __device__ __forceinline__ void operator()(const f32x4 (&acc)[2][2][4][2], const Unit& u, int wr, int wc, int fr_in, int fq_in) const {
        int fr = fr_in, fq = fq_in; asm volatile("" : "+v"(fr), "+v"(fq));
        const int rowb = u.pm * BM + wr * 64 + fr, col0 = (u.pn % 22) * HALF + wc * 32 + 8 * fq;
#pragma unroll
        for (int ai = 0; ai < 2; ++ai)
#pragma unroll
            for (int m = 0; m < 4; ++m) { const f32x4 g0 = acc[ai][0][m][0], g1 = acc[ai][0][m][1];
                *(u32x4*)(O + (size_t)(rowb + ai * HALF + m * 16) * 2816 + col0) = pack8(g0 * sigm4(g0) * acc[ai][1][m][0], g1 * sigm4(g1) * acc[ai][1][m][1]); }
    }
};
struct EpiBf {
    static constexpr bool PERM = true, AFTER_DRAIN = false;
    bf16_t* O;
    __device__ __forceinline__ void operator()(const f32x4 (&acc)[2][2][4][2], const Unit& u, int wr, int wc, int fr_in, int fq_in) const {
        int fr = fr_in, fq = fq_in; asm volatile("" : "+v"(fr), "+v"(fq));
        const int rowb = u.pm * BM + wr * 64 + fr, col0 = (u.pn & 3) * BM + wc * 32 + 8 * fq;
#pragma unroll
        for (int ai = 0; ai < 2; ++ai)
#pragma unroll
            for (int m = 0; m < 4; ++m)
#pragma unroll
                for (int bj = 0; bj < 2; ++bj) *(u32x4*)(O + (size_t)(rowb + ai * HALF + m * 16) * 1024 + col0 + bj * HALF) = pack8(acc[ai][bj][m][0], acc[ai][bj][m][1]);
    }
};

template <class Epi, class Sched, bool ALIGN_EPI = false, bool SP2 = false, bool GATHER = false>
__device__ __forceinline__ void gemm_phase(PG8_LAS unsigned char* lds, const Gemm g, const Sched& S, const Epi& E, const int tid_in) {
    const int tid = tid_in, wid = __builtin_amdgcn_readfirstlane(tid >> 6), lane = tid & 63, wr = wid >> 2, wc = wid & 3, fr = lane & 15, fq = lane >> 4;
    const int K = g.K, nt = K / BK;
    unsigned voffA[2], voffB[2];
#pragma unroll
    for (int i = 0; i < 2; ++i) { int R, C; stage_rc(tid * 16 + i * 8192, R, C); const int Rb = Epi::PERM ? ((R & ~31) + perm32(R & 31)) : R;
        voffA[i] = (unsigned)(R * g.lda + C) * 2u; voffB[i] = (unsigned)(Rb * g.ldb + C) * 2u; }
    unsigned vc0[2] = {0u, 0u}, vc1[2] = {0u, 0u}, vn0[2] = {0u, 0u}, vn1[2] = {0u, 0u};
#define PG8_GLOAD(U, o0, o1) do { _Pragma("unroll") for (int i_ = 0; i_ < 2; ++i_) { int R_, C_; stage_rc(tid * 16 + i_ * 8192, R_, C_); \
        o0[i_] = (unsigned)(g.rowidx[(U).pm * 256 + R_] * (unsigned)(g.lda * 2) + (unsigned)(C_ * 2)); o1[i_] = (unsigned)(g.rowidx[(U).pm * 256 + 128 + R_] * (unsigned)(g.lda * 2) + (unsigned)(C_ * 2)); } } while (0)
    const size_t kstep = (size_t)(BK * 2);
    const size_t hstepA = (size_t)HALF * g.lda * 2, hstepB = (size_t)HALF * g.ldb * 2;
    const size_t tstepA = 2 * hstepA, tstepB = 2 * hstepB;
    const unsigned ldsw = (unsigned)wid * 1024u;
    const int aoff = lds_byte(wr * 64 + fr, fq * 8), boff = lds_byte(wc * 32 + fr, fq * 8);
#define PG8_SA(b, h) (((b) * 2 + (h)) * HTB)
#define PG8_SB(b, h) ((4 + (b) * 2 + (h)) * HTB)
#define PG8_STAGE(bufoff, gbase, voff) do { _Pragma("unroll") for (int _i = 0; _i < 2; ++_i) \
        __builtin_amdgcn_global_load_lds((const unsigned*)((const char*)(gbase) + (voff)[_i]), (PG8_LAS unsigned*)(lds + (bufoff) + ldsw + _i * 8192), 16, 0, 0); } while (0)
#define PG8_LDA(dst, b, h) do { _Pragma("unroll") for (int m = 0; m < 4; ++m) _Pragma("unroll") for (int k = 0; k < 2; ++k) dst[m][k] = *(const PG8_LAS bf16x8*)(lds + PG8_SA(b, h) + aoff + m * 2048 + k * 1024); } while (0)
#define PG8_LDB(dst, b, h) do { _Pragma("unroll") for (int n = 0; n < 2; ++n) _Pragma("unroll") for (int k = 0; k < 2; ++k) dst[n][k] = *(const PG8_LAS bf16x8*)(lds + PG8_SB(b, h) + boff + n * 2048 + k * 1024); } while (0)
#define PG8_MMA(ai, bj, At, Bt) do { __builtin_amdgcn_s_setprio(1); _Pragma("unroll") for (int m = 0; m < 4; ++m) _Pragma("unroll") for (int n = 0; n < 2; ++n) _Pragma("unroll") for (int k = 0; k < 2; ++k) \
        acc[ai][bj][m][n] = __builtin_amdgcn_mfma_f32_16x16x32_bf16(Bt[n][k], At[m][k], acc[ai][bj][m][n], 0, 0, 0); __builtin_amdgcn_s_setprio(0); } while (0)
#define PG8_WAIT_V(n) asm volatile("s_waitcnt vmcnt(" #n ")" ::: "memory")
#define PG8_WAIT_L(n) asm volatile("s_waitcnt lgkmcnt(" #n ")" ::: "memory")
#define PG8_BAR __builtin_amdgcn_s_barrier()
#define PG8_SCHED __builtin_amdgcn_sched_barrier(0)
    Unit cur, nxt; int ui = 0;
    if (!S.next(0, cur)) return;
    f32x4 acc[2][2][4][2];
#pragma unroll
    for (int a = 0; a < 2; ++a)
#pragma unroll
        for (int b = 0; b < 2; ++b)
#pragma unroll
            for (int m = 0; m < 4; ++m)
#pragma unroll
                for (int n = 0; n < 2; ++n) acc[a][b][m][n] = (f32x4){0.f, 0.f, 0.f, 0.f};
    bf16x8 At[4][2], B0[2][2], B1[2][2];
    const char* cA = (const char*)g.A + (GATHER ? (size_t)0 : (size_t)cur.pm * tstepA); const char* cB = (const char*)g.Bt + (size_t)cur.pn * tstepB;
    S.a_ready(cur);
    if constexpr (GATHER) { PG8_GLOAD(cur, vc0, vc1); }
#define PG8_STAGE_A(bufoff, gbase, h, V0, V1) do { if constexpr (GATHER) { if (h) PG8_STAGE(bufoff, gbase, V1); else PG8_STAGE(bufoff, gbase, V0); } else { PG8_STAGE(bufoff, (gbase) + ((h) ? hstepA : (size_t)0), voffA); } } while (0)
    if constexpr (SP2) {
        PG8_STAGE(PG8_SB(0, 0), cB, voffB); PG8_STAGE(PG8_SB(0, 1), cB + hstepB, voffB); PG8_STAGE_A(PG8_SA(0, 0), cA, 0, vc0, vc1); PG8_STAGE_A(PG8_SA(0, 1), cA, 1, vc0, vc1);
        if (wr == 1) PG8_BAR;
        PG8_WAIT_V(2); PG8_BAR;
        PG8_STAGE(PG8_SB(1, 0), cB + kstep, voffB); PG8_STAGE_A(PG8_SA(1, 0), cA + kstep, 0, vc0, vc1); PG8_STAGE(PG8_SB(1, 1), cB + hstepB + kstep, voffB);
        PG8_WAIT_V(6); PG8_BAR;
    } else {
        PG8_STAGE(PG8_SB(0, 0), cB, voffB); PG8_STAGE(PG8_SA(0, 0), cA, voffA); PG8_STAGE(PG8_SB(0, 1), cB + hstepB, voffB); PG8_STAGE(PG8_SA(0, 1), cA + hstepA, voffA);
        if (wr == 1) PG8_BAR;
        PG8_WAIT_V(4); PG8_BAR;
        PG8_STAGE(PG8_SB(1, 0), cB + kstep, voffB); PG8_STAGE(PG8_SA(1, 0), cA + kstep, voffA); PG8_STAGE(PG8_SB(1, 1), cB + hstepB + kstep, voffB);
        PG8_WAIT_V(6); PG8_BAR;
    }
    for (;;) {
        const bool has_next = S.next(ui + 1, nxt);
        if constexpr (GATHER) { if (has_next) { PG8_GLOAD(nxt, vn0, vn1);
            *(PG8_LAS u32x4*)(lds + 135168 + tid * 16) = (u32x4){vn0[0], vn0[1], vn1[0], vn1[1]}; } }
        const char* nA = (has_next && !GATHER) ? (const char*)g.A + (size_t)nxt.pm * tstepA : cA; const char* nB = has_next ? (const char*)g.Bt + (size_t)nxt.pn * tstepB : cB;
        for (int t = 0; t < nt; t += 2) {
            const bool last = (t == nt - 2);
            const char* a1 = cA + (size_t)(t + 1) * kstep;
            const char* a2 = last ? nA : cA + (size_t)(t + 2) * kstep; const char* b2 = last ? nB : cB + (size_t)(t + 2) * kstep;
            const char* a3 = a2 + kstep; const char* b3 = b2 + kstep;
            if (last && has_next) S.a_ready(nxt);
            if constexpr (SP2) {
            PG8_LDB(B0, 0, 0); PG8_LDB(B1, 0, 1); PG8_SCHED; PG8_LDA(At, 0, 0); PG8_STAGE_A(PG8_SA(1, 1), a1, 1, vc0, vc1);
            if constexpr (GATHER) { if (last && has_next) { const u32x4 pv_ = *(const PG8_LAS u32x4*)(lds + 135168 + tid * 16); vc0[0] = pv_.x; vc0[1] = pv_.y; vc1[0] = pv_.z; vc1[1] = pv_.w; } }
            PG8_WAIT_V(8); PG8_WAIT_L(0); PG8_BAR; PG8_MMA(0, 0, At, B0); PG8_MMA(0, 1, At, B1); PG8_BAR; PG8_SCHED;
            PG8_LDA(At, 0, 1); PG8_STAGE(PG8_SB(0, 0), b2, voffB); PG8_STAGE(PG8_SB(0, 1), b2 + hstepB, voffB); PG8_STAGE_A(PG8_SA(0, 0), a2, 0, vc0, vc1);
            PG8_WAIT_V(8); PG8_WAIT_L(0); PG8_BAR; PG8_MMA(1, 0, At, B0); PG8_MMA(1, 1, At, B1); PG8_BAR; PG8_SCHED;
            PG8_LDB(B0, 1, 0); PG8_LDB(B1, 1, 1); PG8_SCHED; PG8_LDA(At, 1, 0); PG8_STAGE_A(PG8_SA(0, 1), a2, 1, vc0, vc1);
            PG8_WAIT_V(8); PG8_WAIT_L(0); PG8_BAR; PG8_MMA(0, 0, At, B0); PG8_MMA(0, 1, At, B1); PG8_BAR; PG8_SCHED;
            PG8_LDA(At, 1, 1); PG8_STAGE(PG8_SB(1, 0), b3, voffB); PG8_STAGE(PG8_SB(1, 1), b3 + hstepB, voffB); PG8_STAGE_A(PG8_SA(1, 0), a3, 0, vc0, vc1);
            PG8_WAIT_V(8); PG8_WAIT_L(0); PG8_BAR; PG8_MMA(1, 0, At, B0); PG8_MMA(1, 1, At, B1); PG8_BAR; PG8_SCHED;
            } else {
            PG8_LDB(B0, 0, 0); PG8_SCHED; PG8_LDA(At, 0, 0); PG8_STAGE(PG8_SA(1, 1), a1 + hstepA, voffA);
            PG8_WAIT_L(8); PG8_BAR; PG8_WAIT_L(0); PG8_MMA(0, 0, At, B0); PG8_BAR; PG8_SCHED;
            PG8_LDB(B1, 0, 1); PG8_STAGE(PG8_SB(0, 0), b2, voffB);
            PG8_BAR; PG8_WAIT_L(0); PG8_MMA(0, 1, At, B1); PG8_BAR;
            PG8_LDA(At, 0, 1); PG8_STAGE(PG8_SA(0, 0), a2, voffA);
            PG8_BAR; PG8_WAIT_L(0); PG8_MMA(1, 0, At, B0); PG8_BAR; PG8_SCHED;
            PG8_STAGE(PG8_SB(0, 1), b2 + hstepB, voffB);
            PG8_WAIT_V(6); PG8_BAR; PG8_MMA(1, 1, At, B1); PG8_BAR;
            PG8_LDB(B0, 1, 0); PG8_SCHED; PG8_LDA(At, 1, 0); PG8_STAGE(PG8_SA(0, 1), a2 + hstepA, voffA);
            PG8_WAIT_L(8); PG8_BAR; PG8_WAIT_L(0); PG8_MMA(0, 0, At, B0); PG8_BAR; PG8_SCHED;
            PG8_LDB(B1, 1, 1); PG8_STAGE(PG8_SB(1, 0), b3, voffB);
            PG8_BAR; PG8_WAIT_L(0); PG8_MMA(0, 1, At, B1); PG8_BAR;
            PG8_LDA(At, 1, 1); PG8_STAGE(PG8_SA(1, 0), a3, voffA);
            PG8_BAR; PG8_WAIT_L(0); PG8_MMA(1, 0, At, B0); PG8_BAR; PG8_SCHED;
            PG8_STAGE(PG8_SB(1, 1), b3 + hstepB, voffB);
            PG8_WAIT_V(6); PG8_BAR; PG8_MMA(1, 1, At, B1); PG8_BAR;
            }
        }
        if constexpr (ALIGN_EPI) { if (wr == 0) PG8_BAR; }
        if constexpr (!Epi::AFTER_DRAIN) { E(acc, cur, wr, wc, fr, fq); S.done(cur); }
        if (!has_next) break;
#pragma unroll
        for (int a = 0; a < 2; ++a)
#pragma unroll
            for (int b = 0; b < 2; ++b)
#pragma unroll
                for (int m = 0; m < 4; ++m)
#pragma unroll
                    for (int n = 0; n < 2; ++n) acc[a][b][m][n] = (f32x4){0.f, 0.f, 0.f, 0.f};
        cur = nxt; cA = nA; cB = nB; ++ui;
        if constexpr (ALIGN_EPI) { if (wr == 1) PG8_BAR; }
    }
    PG8_WAIT_V(0);
    if constexpr (!ALIGN_EPI) { if (wr == 0) PG8_BAR; }
    PG8_BAR;
    if constexpr (Epi::AFTER_DRAIN) { E.fused(acc, cur, wr, wc, fr, fq, lds, wid, lane); S.done(cur); }
#undef PG8_SA
#undef PG8_SB
#undef PG8_STAGE
#undef PG8_STAGE_A
#undef PG8_GLOAD
#undef PG8_LDA
#undef PG8_LDB
#undef PG8_MMA
#undef PG8_WAIT_V
#undef PG8_WAIT_L
#undef PG8_BAR
#undef PG8_SCHED
}
}

#include <hip/hip_bf16.h>
#include <cmath>
namespace attn_body {
using bf16=__hip_bfloat16;
using bf16x8=__attribute__((ext_vector_type(8)))short;
using s16x4=__attribute__((ext_vector_type(4)))short;
using f32x16=__attribute__((ext_vector_type(16)))float;
using u32x4=__attribute__((ext_vector_type(4)))unsigned;
constexpr int SEQ=4096,D=64,DM=1024,OPITCH=2048;
constexpr int NW=8,QBLK=32,QB=QBLK*NW,KVBLK=64,NQB=SEQ/QB;
constexpr int ATTN_PITCH=DM, ATTN_UNIT_ROWS=QB;
__device__ __forceinline__ int crow(int r,int hi){return (r&3)+8*(r>>2)+4*hi;}
#define SBAR() __builtin_amdgcn_sched_barrier(0)
__device__ __forceinline__ void cmask(f32x16&p0,f32x16&p1,int jb,int qrel,int hi){
  const float NEG=-INFINITY; int kb=64*jb+4*hi;
  #pragma unroll
  for(int r=0;r<16;++r){int kv=kb+(r&3)+8*(r>>2); if(kv>qrel)p0[r]=NEG; if(kv+32>qrel)p1[r]=NEG;}
}

constexpr int NSLOT=3, SLOTB=8192;
constexpr int LDS_K=0, LDS_V=NSLOT*SLOTB, LDS_WS=2*NSLOT*SLOTB, LDS_OST=LDS_WS+NW*64*4, LDS_BYTES=LDS_OST+NW*4096;
constexpr float C2=0.125f*1.4426950408889634f;
__device__ __forceinline__ void glds16(const void*gsrc,unsigned lds_dst){unsigned keep;
  asm volatile("s_mov_b32 %0, m0\n\ts_mov_b32 m0, %2\n\ts_nop 0\n\tglobal_load_lds_dwordx4 %1, off\n\ts_mov_b32 m0, %0":"=&s"(keep):"v"(gsrc),"s"(lds_dst):"memory");}
__device__ __forceinline__ float max3f(float a,float b,float c){float r;asm("v_max3_f32 %0, %1, %2, %3":"=v"(r):"v"(a),"v"(b),"v"(c));return r;}
__device__ __forceinline__ float max2f(float a,float b){float r;asm("v_max_f32_e32 %0, %1, %2":"=v"(r):"v"(a),"v"(b));return r;}
__device__ __forceinline__ float fadd_s(float a,float b){float r;asm("v_add_f32_e32 %0, %1, %2":"=v"(r):"v"(a),"v"(b));return r;}
__device__ __forceinline__ float fsub_s(float a,float b){float r;asm("v_sub_f32_e32 %0, %1, %2":"=v"(r):"v"(a),"v"(b));return r;}
typedef float f32x2_t __attribute__((ext_vector_type(2))); typedef __bf16 bf16x2_t __attribute__((ext_vector_type(2)));
__device__ __forceinline__ unsigned cvtpk_s(float lo,float hi){f32x2_t v={lo,hi};bf16x2_t b=__builtin_convertvector(v,bf16x2_t);return __builtin_bit_cast(unsigned,b);}
#define WAIT_BAR(N) asm volatile("s_waitcnt vmcnt(" #N ") lgkmcnt(0)\n\ts_barrier":::"memory")

__device__ __forceinline__ f32x16 mfma_z(bf16x8 a_,bf16x8 b_){ f32x16 d_; asm volatile("s_nop 1\n\tv_mfma_f32_32x32x16_bf16 %0, %1, %2, 0":"=&v"(d_):"v"(a_),"v"(b_)); return d_; }
__device__ __forceinline__ void qkt(f32x16&p0,f32x16&p1,const char*Kslot,const bf16x8*qr,int r32,int hi){
  const char*kb=Kslot+hi*1024+r32*16;
  #pragma unroll
  for(int d0=0;d0<4;++d0){
    const bf16x8 b0=*reinterpret_cast<const bf16x8*>(kb+d0*2048);
    const bf16x8 b1=*reinterpret_cast<const bf16x8*>(kb+d0*2048+512);
    if(d0==0){f32x16 z0=f32x16{},z1=f32x16{};asm volatile("":"+v"(z0),"+v"(z1));
      p0=__builtin_amdgcn_mfma_f32_32x32x16_bf16(b0,qr[0],z0,0,0,0);p1=__builtin_amdgcn_mfma_f32_32x32x16_bf16(b1,qr[0],z1,0,0,0);}
    else{p0=__builtin_amdgcn_mfma_f32_32x32x16_bf16(b0,qr[d0],p0,0,0,0);p1=__builtin_amdgcn_mfma_f32_32x32x16_bf16(b1,qr[d0],p1,0,0,0);}}
}
typedef __attribute__((address_space(3))) const char* lds_cptr;
typedef short v4i16_t __attribute__((ext_vector_type(4)));
__device__ __forceinline__ void kload8(bf16x8*kf,lds_cptr kp){
  kf[0]=*(const __attribute__((address_space(3))) bf16x8*)(kp);      kf[1]=*(const __attribute__((address_space(3))) bf16x8*)(kp+512);
  kf[2]=*(const __attribute__((address_space(3))) bf16x8*)(kp+2048); kf[3]=*(const __attribute__((address_space(3))) bf16x8*)(kp+2560);
  kf[4]=*(const __attribute__((address_space(3))) bf16x8*)(kp+4096); kf[5]=*(const __attribute__((address_space(3))) bf16x8*)(kp+4608);
  kf[6]=*(const __attribute__((address_space(3))) bf16x8*)(kp+6144); kf[7]=*(const __attribute__((address_space(3))) bf16x8*)(kp+6656);
}
__device__ __forceinline__ void kload2(bf16x8*kf,lds_cptr kp,int j){ kf[2*j]=*(const __attribute__((address_space(3))) bf16x8*)(kp+j*2048); kf[2*j+1]=*(const __attribute__((address_space(3))) bf16x8*)(kp+j*2048+512); }
__device__ __forceinline__ s16x4 vtr(lds_cptr p){ return __builtin_bit_cast(s16x4,__builtin_amdgcn_ds_read_tr16_b64_v4i16((__attribute__((address_space(3))) v4i16_t*)p)); }
__device__ __forceinline__ float rowmax(const f32x16&p0,const f32x16&p1){
  float a=max3f(p0[0],p0[1],p1[0]),b=max3f(p0[2],p0[3],p1[1]);a=max3f(a,p1[2],p1[3]);
  #pragma unroll
  for(int r=4;r<16;r+=4){a=max3f(a,p0[r],p0[r+1]);b=max3f(b,p0[r+2],p0[r+3]);a=max3f(a,p1[r],p1[r+1]);b=max3f(b,p1[r+2],p1[r+3]);}
  const float m=max2f(a,b);
  auto rr=__builtin_amdgcn_permlane32_swap(__float_as_uint(m),__float_as_uint(m),false,false);
  return max2f(__uint_as_float(rr[0]),__uint_as_float(rr[1]));
}
__device__ __forceinline__ void pv(f32x16*o,int vb,bf16x8 pa0,bf16x8 pa1,bf16x8 pa2,bf16x8 pa3){
  #pragma unroll
  for(int d0=0;d0<2;++d0){s16x4 lo[4],hi[4];
    #pragma unroll
    for(int ks=0;ks<4;++ks){
      asm volatile("ds_read_b64_tr_b16 %0,%1 offset:%c2":"=&v"(lo[ks]):"v"(vb),"i"(d0*4096+ks*1024):"memory");
      asm volatile("ds_read_b64_tr_b16 %0,%1 offset:%c2":"=&v"(hi[ks]):"v"(vb),"i"(d0*4096+ks*1024+512):"memory");}
    asm volatile("s_waitcnt lgkmcnt(0)":::"memory");SBAR();
    #define PK(k) (bf16x8){lo[k][0],lo[k][1],lo[k][2],lo[k][3],hi[k][0],hi[k][1],hi[k][2],hi[k][3]}
    o[d0]=__builtin_amdgcn_mfma_f32_32x32x16_bf16(pa0,PK(0),o[d0],0,0,0);
    o[d0]=__builtin_amdgcn_mfma_f32_32x32x16_bf16(pa1,PK(1),o[d0],0,0,0);
    o[d0]=__builtin_amdgcn_mfma_f32_32x32x16_bf16(pa2,PK(2),o[d0],0,0,0);
    o[d0]=__builtin_amdgcn_mfma_f32_32x32x16_bf16(pa3,PK(3),o[d0],0,0,0);
    #undef PK
  }
}

#ifndef ATTN_STORE16
#define ATTN_STORE16(p,v) (*(u32x4*)(p)=(v))
#endif
template<int THRL> __device__ __forceinline__ void attn_unit(int qb,const bf16*Qh,const bf16*__restrict__ Kh,const bf16*__restrict__ Vh,bf16*Oh,char*shm,const int tid_in){
  const int tid=tid_in,lane=tid&63,r32=lane&31,hi=lane>>5; const int wid=__builtin_amdgcn_readfirstlane(tid>>6);
  const int q0=qb*QB;
  const bf16*Qw=Qh+(long)(q0+wid*QBLK)*DM;
  const unsigned lds0=(unsigned)(uintptr_t)shm;
  float*wsf=(float*)(shm+LDS_WS)+wid*64;
  const bf16*ksrc=Kh+(long)lane*DM+wid*8;
  const bf16*vsrc=Vh+(long)(16*(wid&3)+(lane>>2))*DM+(wid>>2)*32+(lane&3)*8;
  const unsigned kdst=lds0+LDS_K+wid*1024, vdst=lds0+LDS_V+wid*1024;
  #define DMA_K(t,slot) glds16(ksrc+(long)(t)*KVBLK*DM,(unsigned)__builtin_amdgcn_readfirstlane(kdst+(slot)))
  #define DMA_V(t,slot) glds16(vsrc+(long)(t)*KVBLK*DM,(unsigned)__builtin_amdgcn_readfirstlane(vdst+(slot)))
  const int vb0=(int)(lds0+LDS_V)+((lane>>4)&1)*32+(lane&3)*8+(4*hi+((lane&15)>>2))*64;
  const char*Kbase=shm+LDS_K; bf16x8 kf[8];
  const lds_cptr shm3=(lds_cptr)shm; const lds_cptr kp0=shm3+LDS_K+hi*1024+r32*16; const lds_cptr vp0=shm3+LDS_V+((lane>>4)&1)*32+(lane&3)*8+(4*hi+((lane&15)>>2))*64;
  const int NT=(q0+QB)/KVBLK;
  DMA_K(0,0);DMA_V(0,0);DMA_K(1,SLOTB);
  bf16x8 qr[4];
  #pragma unroll
  for(int d0=0;d0<4;++d0)qr[d0]=*reinterpret_cast<const bf16x8*>(&Qw[(long)r32*DM+d0*16+hi*8]);
  float mhat=0.f,l_reg=0.f;f32x16 o[2];o[0]=f32x16{};o[1]=f32x16{};
  const int qrel=wid*QBLK+r32;
  #define CMASK(P0,P1,t) do{int jb_=(t)-(NT-4); if(jb_>=0)cmask(P0,P1,jb_,qrel,hi);}while(0)
  bool resc=false;
  #define START(P0,P1) do{ const float rm=rowmax(P0,P1); resc=false; \
    { const float dl=rm; mhat=fadd_s(mhat,dl); \
      _Pragma("unroll") for(int r=0;r<16;++r){P0[r]=fsub_s(P0[r],dl);P1[r]=fsub_s(P1[r],dl);} \
      } \
    _Pragma("unroll") for(int r=0;r<16;++r)P0[r]=__builtin_amdgcn_exp2f(P0[r]); }while(0)
  #define RESC() do{ if(resc){ asm volatile("s_waitcnt lgkmcnt(0)":::"memory"); \
      _Pragma("unroll") for(int d_=0;d_<2;++d_) _Pragma("unroll") for(int r=0;r<16;++r)o[d_][r]*=wsf[crow(r,hi)]; } }while(0)
  f32x16 pA0,pA1,pB0,pB1;
  int sl_prev=0,sl_cur=0,sl_next=SLOTB;
  #define ROT() do{sl_prev=sl_cur;sl_cur=sl_next;sl_next=(sl_next==(NSLOT-1)*SLOTB)?0:sl_next+SLOTB;}while(0)
  DMA_K(2,2*SLOTB);
  WAIT_BAR(3);
  qkt(pA0,pA1,Kbase,qr,r32,hi);asm volatile("s_nop 15\n\ts_nop 7":"+v"(pA0),"+v"(pA1));CMASK(pA0,pA1,0);
  START(pA0,pA1);
  _Pragma("unroll") for(int r=0;r<16;++r)pA1[r]=__builtin_amdgcn_exp2f(pA1[r]);
  WAIT_BAR(0);
  DMA_K(3,0);DMA_V(1,SLOTB);
  ROT();
  kload8(kf,kp0+sl_cur);
  WAIT_BAR(2);
  s16x4 vlo[8],vhi[8]; u32x4 pw0,pw1,pw2,pw3;
  #define PKW(P,B) cvtpk_s(P[B],P[B+1])
  #define PAF(k) __builtin_bit_cast(bf16x8,pw##k)
  #define VFR(i) (bf16x8){vlo[i][0],vlo[i][1],vlo[i][2],vlo[i][3],vhi[i][0],vhi[i][1],vhi[i][2],vhi[i][3]}
  #define PIN(x) asm volatile("":"+v"(x))
  #define MX3(a,b,c) __builtin_fmaxf(__builtin_fmaxf((a),(b)),(c))
  #define GAPA(MF,A0,A1,A2,A3,W0,W1,PW) do{ MF; sacc+=A0; sacc+=A1; sacc+=A2; sacc+=A3; PIN(sacc); W0; W1; PIN(PW); SBAR(); }while(0)
  #define EX(v) __builtin_amdgcn_exp2f(v)
  #define GAPB(MF,X,B) do{ MF; X[B]=EX(fsub_s(X[B],mhat)); X[B+1]=EX(fsub_s(X[B+1],mhat)); X[B+2]=EX(fsub_s(X[B+2],mhat)); X[B+3]=EX(fsub_s(X[B+3],mhat)); PIN(X); SBAR(); }while(0)
  #define VRD(i) do{ vlo[i]=vtr(vp_+(((i)>>2)*4096+((i)&3)*1024)); vhi[i]=vtr(vp_+(((i)>>2)*4096+((i)&3)*1024+512)); }while(0)
  #define KRD(G,j) do{ if(G){ kload2(kf,kp0+sl_next,j); SBAR(); } }while(0)
  #define STEP(C0,C1,P0,P1,t,GK,GV,GL) do{ SBAR(); \
    const lds_cptr vp_=vp0+sl_prev; \
    VRD(0); SBAR(); float sacc=(P0[0]+P0[1]); \
    GAPA(C0=mfma_z(kf[0],qr[0]), P0[2],P0[3],P0[4],P0[5],     pw0[0]=PKW(P0,0), pw0[1]=PKW(P0,2), pw0); \
    VRD(4); SBAR(); GAPA(C1=mfma_z(kf[1],qr[0]), P0[6],P0[7],P0[8],P0[9],     pw0[2]=PKW(P0,4), pw0[3]=PKW(P0,6), pw0); \
    VRD(1); SBAR(); GAPA(C0=__builtin_amdgcn_mfma_f32_32x32x16_bf16(kf[2],qr[1],C0,0,0,0),   P0[10],P0[11],P0[12],P0[13], pw1[0]=PKW(P0,8), pw1[1]=PKW(P0,10), pw1); \
    VRD(5); SBAR(); GAPA(C1=__builtin_amdgcn_mfma_f32_32x32x16_bf16(kf[3],qr[1],C1,0,0,0),   P0[14],P0[15],P1[0],P1[1],   pw1[2]=PKW(P0,12),pw1[3]=PKW(P0,14), pw1); \
    VRD(2); SBAR(); GAPA(C0=__builtin_amdgcn_mfma_f32_32x32x16_bf16(kf[4],qr[2],C0,0,0,0),   P1[2],P1[3],P1[4],P1[5],     pw2[0]=PKW(P1,0), pw2[1]=PKW(P1,2), pw2); \
    VRD(6); SBAR(); GAPA(C1=__builtin_amdgcn_mfma_f32_32x32x16_bf16(kf[5],qr[2],C1,0,0,0),   P1[6],P1[7],P1[8],P1[9],     pw2[2]=PKW(P1,4), pw2[3]=PKW(P1,6), pw2); \
    VRD(3); SBAR(); GAPA(C0=__builtin_amdgcn_mfma_f32_32x32x16_bf16(kf[6],qr[3],C0,0,0,0),   P1[10],P1[11],P1[12],P1[13], pw3[0]=PKW(P1,8), pw3[1]=PKW(P1,10), pw3); \
    VRD(7); SBAR(); GAPA(C1=__builtin_amdgcn_mfma_f32_32x32x16_bf16(kf[7],qr[3],C1,0,0,0),   P1[14],P1[15],0.f,0.f,       pw3[2]=PKW(P1,12),pw3[3]=PKW(P1,14), pw3); \
    l_reg+=sacc; \
    if(GK){DMA_K((t)+3,sl_cur);} if(GV){DMA_V((t)+1,sl_next);} \
    CMASK(C0,C1,t); \
    { float a=MX3(C0[0],C0[1],C1[0]),b=MX3(C0[2],C0[3],C1[1]); a=MX3(a,C1[2],C1[3]); \
      _Pragma("unroll") for(int r=4;r<16;r+=4){a=MX3(a,C0[r],C0[r+1]);b=MX3(b,C0[r+2],C0[r+3]);a=MX3(a,C1[r],C1[r+1]);b=MX3(b,C1[r+2],C1[r+3]);} \
      float rm=__builtin_fmaxf(a,b); { auto rr=__builtin_amdgcn_permlane32_swap(__float_as_uint(rm),__float_as_uint(rm),false,false); rm=__builtin_fmaxf(__uint_as_float(rr[0]),__uint_as_float(rr[1])); } \
      resc=false; \
      const float rel=rm-mhat; \
      if(__builtin_expect(__any(rel>(float)THRL),0)){ const float dl=__builtin_fmaxf(rel,0.f); mhat+=dl; \
        const float f=__builtin_amdgcn_exp2f(-dl); l_reg*=f; if(hi==0)wsf[r32]=f; resc=true; } } \
    SBAR(); \
    GAPB(o[0]=__builtin_amdgcn_mfma_f32_32x32x16_bf16(PAF(0),VFR(0),o[0],0,0,0), C0,0); \
    GAPB(o[1]=__builtin_amdgcn_mfma_f32_32x32x16_bf16(PAF(0),VFR(4),o[1],0,0,0), C0,4); \
    KRD(GL,0); GAPB(o[0]=__builtin_amdgcn_mfma_f32_32x32x16_bf16(PAF(1),VFR(1),o[0],0,0,0), C0,8); \
    KRD(GL,1); GAPB(o[1]=__builtin_amdgcn_mfma_f32_32x32x16_bf16(PAF(1),VFR(5),o[1],0,0,0), C0,12); \
    KRD(GL,2); GAPB(o[0]=__builtin_amdgcn_mfma_f32_32x32x16_bf16(PAF(2),VFR(2),o[0],0,0,0), C1,0); \
    KRD(GL,3); GAPB(o[1]=__builtin_amdgcn_mfma_f32_32x32x16_bf16(PAF(2),VFR(6),o[1],0,0,0), C1,4); \
    GAPB(o[0]=__builtin_amdgcn_mfma_f32_32x32x16_bf16(PAF(3),VFR(3),o[0],0,0,0), C1,8); \
    GAPB(o[1]=__builtin_amdgcn_mfma_f32_32x32x16_bf16(PAF(3),VFR(7),o[1],0,0,0), C1,12); \
    }while(0)
  int t=1;
  #undef CMASK
  #define CMASK(P0,P1,t) do{}while(0)
  for(;t+5<NT;t+=2){
    STEP(pB0,pB1,pA0,pA1,t,true,true,true);     WAIT_BAR(2); RESC(); ROT();
    STEP(pA0,pA1,pB0,pB1,t+1,true,true,true);   WAIT_BAR(2); RESC(); ROT();
  }
  #undef CMASK
  #define CMASK(P0,P1,t) do{int jb_=(t)-(NT-4); if(jb_>=0)cmask(P0,P1,jb_,qrel,hi);}while(0)
  #define ENDW(tt) do{ if((tt)+3<NT){WAIT_BAR(2);} else if((tt)+2<NT){WAIT_BAR(1);} else {WAIT_BAR(0);} }while(0)
  for(;t+1<NT;t+=2){
    STEP(pB0,pB1,pA0,pA1,t,(t+3<NT),(t+1<NT),(t+1<NT));       ENDW(t);   RESC(); ROT();
    STEP(pA0,pA1,pB0,pB1,t+1,(t+4<NT),(t+2<NT),(t+2<NT));     ENDW(t+1); RESC(); ROT();
  }
  STEP(pB0,pB1,pA0,pA1,NT-1,false,false,false); RESC();
  { float sacc=pB0[0]+pB0[1]; _Pragma("unroll") for(int r=2;r<16;++r)sacc+=pB0[r]; _Pragma("unroll") for(int r=0;r<16;++r)sacc+=pB1[r]; l_reg+=sacc;
    pw0=(u32x4){PKW(pB0,0),PKW(pB0,2),PKW(pB0,4),PKW(pB0,6)};pw1=(u32x4){PKW(pB0,8),PKW(pB0,10),PKW(pB0,12),PKW(pB0,14)};pw2=(u32x4){PKW(pB1,0),PKW(pB1,2),PKW(pB1,4),PKW(pB1,6)};pw3=(u32x4){PKW(pB1,8),PKW(pB1,10),PKW(pB1,12),PKW(pB1,14)};
    SBAR(); pv(o,vb0+sl_cur,PAF(0),PAF(1),PAF(2),PAF(3)); }
  #undef PKW
  #undef PAF
  #undef VFR
  #undef PIN
  #undef MX3
  #undef GAPA
  #undef GAPB
  #undef EX
  #undef VRD
  #undef KRD
  #undef STEP
  #undef ENDW
  l_reg+=__uint_as_float((unsigned)__builtin_amdgcn_ds_bpermute((lane^32)<<2,(int)__float_as_uint(l_reg)));
  if(hi==0)wsf[32+r32]=l_reg;asm volatile("s_waitcnt lgkmcnt(0)":::"memory");
  float rli[16];
  #pragma unroll
  for(int r=0;r<16;++r)rli[r]=__builtin_amdgcn_rcpf(wsf[32+crow(r,hi)]);
  bf16*Ow=Oh+(long)(q0+wid*QBLK)*OPITCH;
  { bf16*stg=(bf16*)(shm+LDS_OST)+wid*2048;
    #pragma unroll
    for(int r=0;r<16;++r){const int orow=crow(r,hi);
      #pragma unroll
      for(int d0=0;d0<2;++d0)stg[orow*64+d0*32+r32]=__float2bfloat16(o[d0][r]*rli[r]);}
    asm volatile("s_waitcnt lgkmcnt(0)":::"memory");
    #pragma unroll
    for(int i=0;i<4;++i){const int row=i*8+(lane>>3),ch=lane&7; const u32x4 v=*(const u32x4*)(stg+row*64+ch*8); ATTN_STORE16(Ow+(long)row*OPITCH+ch*8,v);} }
  asm volatile("s_waitcnt lgkmcnt(0)\n\ts_barrier":::"memory");
  #undef DMA_K
  #undef DMA_V
  #undef CMASK
  #undef START
  #undef RESC
  #undef ROT
}

__device__ __forceinline__ float rowmax_cv(const f32x16&p0,const f32x16&p1){
  float a=__builtin_fmaxf(p0[0],p1[0]);
  #pragma unroll
  for(int r=1;r<16;++r){a=__builtin_fmaxf(a,p0[r]);a=__builtin_fmaxf(a,p1[r]);}
  auto rr=__builtin_amdgcn_permlane32_swap(__float_as_uint(a),__float_as_uint(a),false,false);
  return __builtin_fmaxf(__uint_as_float(rr[0]),__uint_as_float(rr[1]));
}
__device__ __forceinline__ void attn_unit_simple(int qb,const bf16*Qh,const bf16*__restrict__ Kh,const bf16*__restrict__ Vh,bf16*Oh,char*shm,const int tid_in){
  const int tid=tid_in,lane=tid&63,r32=lane&31,hi=lane>>5; const int wid=__builtin_amdgcn_readfirstlane(tid>>6);
  const int q0=qb*QB;
  const bf16*Qw=Qh+(long)(q0+wid*QBLK)*DM;
  const unsigned lds0=(unsigned)(uintptr_t)shm;
  float*wsf=(float*)(shm+LDS_WS)+wid*64;
  const bf16*ksrc=Kh+(long)lane*DM+wid*8;
  const bf16*vsrc=Vh+(long)(16*(wid&3)+(lane>>2))*DM+(wid>>2)*32+(lane&3)*8;
  u32x4*kdstp=(u32x4*)(shm+LDS_K+wid*1024+lane*16); u32x4*vdstp=(u32x4*)(shm+LDS_V+wid*1024+lane*16);
  const int vb0=(int)(lds0+LDS_V)+((lane>>4)&1)*32+(lane&3)*8+(4*hi+((lane&15)>>2))*64;
  const char*Kbase=shm+LDS_K;
  const int NT=(q0+QB)/KVBLK;
  bf16x8 qr[4];
  #pragma unroll
  for(int d0=0;d0<4;++d0)qr[d0]=*reinterpret_cast<const bf16x8*>(&Qw[(long)r32*DM+d0*16+hi*8]);
  float m_run=-1e30f,l_reg=0.f; f32x16 o[2]; o[0]=f32x16{}; o[1]=f32x16{};
  const int qrel=wid*QBLK+r32;
  u32x4 kreg=*(const u32x4*)ksrc, vreg=*(const u32x4*)vsrc;
  for(int t=0;t<NT;++t){
    *kdstp=kreg; *vdstp=vreg;
    if(t+1<NT){ kreg=*(const u32x4*)(ksrc+(long)(t+1)*KVBLK*DM); vreg=*(const u32x4*)(vsrc+(long)(t+1)*KVBLK*DM); }
    __syncthreads();
    f32x16 p0,p1;
    qkt(p0,p1,Kbase,qr,r32,hi);
    { const int jb=t-(NT-4); if(jb>=0){ const float NEG=-INFINITY; const int kb=64*jb+4*hi;
        #pragma unroll
        for(int r=0;r<16;++r){const int kv=kb+(r&3)+8*(r>>2); if(kv>qrel)p0[r]=NEG; if(kv+32>qrel)p1[r]=NEG;} } }
    const float rm=rowmax_cv(p0,p1);
    const float mn=__builtin_fmaxf(m_run,rm); const float alpha=__builtin_amdgcn_exp2f(m_run-mn); m_run=mn;
    float sacc=0.f;
    #pragma unroll
    for(int r=0;r<16;++r){p0[r]=__builtin_amdgcn_exp2f(p0[r]-mn);p1[r]=__builtin_amdgcn_exp2f(p1[r]-mn);sacc+=p0[r]+p1[r];}
    l_reg=l_reg*alpha+sacc;
    if(hi==0)wsf[r32]=alpha;
    asm volatile("s_waitcnt lgkmcnt(0)":::"memory");
    #pragma unroll
    for(int d_=0;d_<2;++d_)
      #pragma unroll
      for(int r=0;r<16;++r)o[d_][r]*=wsf[crow(r,hi)];
    u32x4 pw0,pw1,pw2,pw3;
    #define PKW2(P,B) cvtpk_s(P[B],P[B+1])
    pw0=(u32x4){PKW2(p0,0),PKW2(p0,2),PKW2(p0,4),PKW2(p0,6)};pw1=(u32x4){PKW2(p0,8),PKW2(p0,10),PKW2(p0,12),PKW2(p0,14)};
    pw2=(u32x4){PKW2(p1,0),PKW2(p1,2),PKW2(p1,4),PKW2(p1,6)};pw3=(u32x4){PKW2(p1,8),PKW2(p1,10),PKW2(p1,12),PKW2(p1,14)};
    #undef PKW2
    pv(o,vb0,__builtin_bit_cast(bf16x8,pw0),__builtin_bit_cast(bf16x8,pw1),__builtin_bit_cast(bf16x8,pw2),__builtin_bit_cast(bf16x8,pw3));
    asm volatile("s_waitcnt lgkmcnt(0)":::"memory");
    __syncthreads();
  }
  l_reg+=__uint_as_float((unsigned)__builtin_amdgcn_ds_bpermute((lane^32)<<2,(int)__float_as_uint(l_reg)));
  if(hi==0)wsf[32+r32]=l_reg;asm volatile("s_waitcnt lgkmcnt(0)":::"memory");
  float rli[16];
  #pragma unroll
  for(int r=0;r<16;++r)rli[r]=__builtin_amdgcn_rcpf(wsf[32+crow(r,hi)]);
  bf16*Ow=Oh+(long)(q0+wid*QBLK)*OPITCH;
  { bf16*stg=(bf16*)(shm+LDS_OST)+wid*2048;
    #pragma unroll
    for(int r=0;r<16;++r){const int orow=crow(r,hi);
      #pragma unroll
      for(int d0=0;d0<2;++d0)stg[orow*64+d0*32+r32]=__float2bfloat16(o[d0][r]*rli[r]);}
    asm volatile("s_waitcnt lgkmcnt(0)":::"memory");
    #pragma unroll
    for(int i=0;i<4;++i){const int row=i*8+(lane>>3),ch=lane&7; const u32x4 v=*(const u32x4*)(stg+row*64+ch*8); ATTN_STORE16(Ow+(long)row*OPITCH+ch*8,v);} }
  asm volatile("s_waitcnt vmcnt(0) lgkmcnt(0)":::"memory");
  __syncthreads();
}

constexpr int DA_SLOT=32768, DA_V=16384, DA_WS=98304, DA_ROWS=128;
__device__ __forceinline__ f32x16 mfma_c(bf16x8 a_,bf16x8 b_,const f32x16&c_){ f32x16 d_; asm volatile("s_nop 1\n\tv_mfma_f32_32x32x16_bf16 %0, %1, %2, %3":"=&v"(d_):"v"(a_),"v"(b_),"v"(c_)); return d_; }
template<int THRL> __device__ __forceinline__ void dattn_unit(int qblk,const bf16*Qb,const bf16*__restrict__ Kb,const bf16*__restrict__ Vb,bf16*Yb,float lam,const float*gsub,float gscale,char*shm,const int tid_in){
  const int tid=tid_in,lane=tid&63,r32=lane&31,hi=lane>>5; const int wid=__builtin_amdgcn_readfirstlane(tid>>6);
  const int c=wid>>2, rg=wid&3;
  const int q0=qblk*DA_ROWS; const int NT=(q0+DA_ROWS)/KVBLK;
  const bf16*Qw=Qb+c*64+(long)(q0+rg*32)*DM;
  const unsigned lds0=(unsigned)(uintptr_t)shm; const lds_cptr shm3=(lds_cptr)shm;
  float*wsf=(float*)(shm+DA_WS)+wid*64;
  const int pk0=2*wid;
  const bf16*ksrc0=Kb+(pk0>>3)*64+(long)lane*DM+(pk0&7)*8;
  const unsigned kdst0=lds0+(pk0>>3)*8192+(pk0&7)*1024;
  const bf16*vsrc0=Vb+(long)(16*(pk0&3)+(lane>>2))*DM+(pk0>>2)*32+(lane&3)*8;
  const unsigned vdst0=lds0+DA_V+pk0*1024;
  #define DA_RFL(x) ((unsigned)__builtin_amdgcn_readfirstlane((int)(x)))
  #define DA_DMA(t,so) do{ const long to_=(long)(t)*KVBLK*DM; \
      glds16(ksrc0+to_,DA_RFL(kdst0+(so))); glds16(ksrc0+to_+8,DA_RFL(kdst0+(so)+1024)); \
      glds16(vsrc0+to_,DA_RFL(vdst0+(so))); glds16(vsrc0+to_+16*DM,DA_RFL(vdst0+(so)+1024)); }while(0)
  const lds_cptr kp0=shm3+c*8192+hi*1024+r32*16;
  const lds_cptr vp0=shm3+DA_V+((lane>>4)&1)*32+(lane&3)*8+(4*hi+((lane&15)>>2))*64;
  bf16x8 qr[4];
  #pragma unroll
  DA_DMA(0,0); if(NT>1){ DA_DMA(1,DA_SLOT); }
  #pragma unroll
  for(int d0=0;d0<4;++d0)qr[d0]=*reinterpret_cast<const bf16x8*>(&Qw[(long)r32*DM+d0*16+hi*8]);
  asm volatile("":"+v"(qr[0]),"+v"(qr[1]),"+v"(qr[2]),"+v"(qr[3]));
  float mhat=0.f,l_reg=0.f; f32x16 o[4]; o[0]=f32x16{}; o[1]=f32x16{}; o[2]=f32x16{}; o[3]=f32x16{};
  f32x16 negm;
  #pragma unroll
  for(int r=0;r<16;++r)negm[r]=0.f;
  const int qrel=rg*32+r32;
  int slot=0;
  for(int t=0;t<NT;++t){
    if(t+1<NT){ asm volatile("s_waitcnt vmcnt(4) lgkmcnt(0)\n\ts_barrier":::"memory"); } else { asm volatile("s_waitcnt vmcnt(0) lgkmcnt(0)\n\ts_barrier":::"memory"); }
    if(t+2<NT){ int s2=slot+2*DA_SLOT; if(s2>=3*DA_SLOT)s2-=3*DA_SLOT; DA_DMA(t+2,s2); }
    const lds_cptr kp=kp0+slot;
    f32x16 p0,p1;
    { const bf16x8 k0=*(const __attribute__((address_space(3))) bf16x8*)(kp), k1=*(const __attribute__((address_space(3))) bf16x8*)(kp+512);
      p0=mfma_c(k0,qr[0],negm); p1=mfma_c(k1,qr[0],negm); }
    #pragma unroll
    for(int d0=1;d0<4;++d0){ const bf16x8 k0=*(const __attribute__((address_space(3))) bf16x8*)(kp+d0*2048), k1=*(const __attribute__((address_space(3))) bf16x8*)(kp+d0*2048+512);
      p0=__builtin_amdgcn_mfma_f32_32x32x16_bf16(k0,qr[d0],p0,0,0,0); p1=__builtin_amdgcn_mfma_f32_32x32x16_bf16(k1,qr[d0],p1,0,0,0); }
    { const int jb=t-(NT-2); if(jb>=0){ const float NEG=-INFINITY; const int kb=64*jb+4*hi;
        #pragma unroll
        for(int r=0;r<16;++r){const int kv=kb+(r&3)+8*(r>>2); if(kv>qrel)p0[r]=NEG; if(kv+32>qrel)p1[r]=NEG;} } }
    float rm=__builtin_fmaxf(p0[0],p1[0]);
    #pragma unroll
    for(int r=1;r<16;++r){rm=__builtin_fmaxf(rm,p0[r]);rm=__builtin_fmaxf(rm,p1[r]);}
    rm=__builtin_fmaxf(rm,__uint_as_float((unsigned)__builtin_amdgcn_ds_bpermute((lane^32)<<2,(int)__float_as_uint(rm))));
    if(t==0){
      mhat=rm;
      #pragma unroll
      for(int r=0;r<16;++r){p0[r]-=rm;p1[r]-=rm;negm[r]=-rm;}
    } else if(__any(rm>(float)THRL)){
      const float dl=__builtin_fmaxf(rm,0.f); const float f=__builtin_amdgcn_exp2f(-dl); mhat+=dl; l_reg*=f;
      #pragma unroll
      for(int r=0;r<16;++r){p0[r]-=dl;p1[r]-=dl;negm[r]=-mhat;}
      if(hi==0)wsf[r32]=f;
      asm volatile("s_waitcnt lgkmcnt(0)":::"memory");
      #pragma unroll
      for(int d_=0;d_<4;++d_)
        #pragma unroll
        for(int r=0;r<16;++r)o[d_][r]*=wsf[crow(r,hi)];
    }
    float sacc=0.f;
    #pragma unroll
    for(int r=0;r<16;++r){p0[r]=__builtin_amdgcn_exp2f(p0[r]);p1[r]=__builtin_amdgcn_exp2f(p1[r]);sacc+=p0[r]+p1[r];}
    l_reg+=sacc;
    u32x4 pw0,pw1,pw2,pw3;
    pw0=(u32x4){cvtpk_s(p0[0],p0[1]),cvtpk_s(p0[2],p0[3]),cvtpk_s(p0[4],p0[5]),cvtpk_s(p0[6],p0[7])}; pw1=(u32x4){cvtpk_s(p0[8],p0[9]),cvtpk_s(p0[10],p0[11]),cvtpk_s(p0[12],p0[13]),cvtpk_s(p0[14],p0[15])};
    pw2=(u32x4){cvtpk_s(p1[0],p1[1]),cvtpk_s(p1[2],p1[3]),cvtpk_s(p1[4],p1[5]),cvtpk_s(p1[6],p1[7])}; pw3=(u32x4){cvtpk_s(p1[8],p1[9]),cvtpk_s(p1[10],p1[11]),cvtpk_s(p1[12],p1[13]),cvtpk_s(p1[14],p1[15])};
    const lds_cptr vp=vp0+slot;
    #pragma unroll
    for(int d0=0;d0<4;++d0){
      #define DA_VF(ks) ({ const s16x4 lo_=vtr(vp+d0*4096+(ks)*1024), hi_=vtr(vp+d0*4096+(ks)*1024+512); (bf16x8){lo_[0],lo_[1],lo_[2],lo_[3],hi_[0],hi_[1],hi_[2],hi_[3]}; })
      o[d0]=__builtin_amdgcn_mfma_f32_32x32x16_bf16(__builtin_bit_cast(bf16x8,pw0),DA_VF(0),o[d0],0,0,0);
      o[d0]=__builtin_amdgcn_mfma_f32_32x32x16_bf16(__builtin_bit_cast(bf16x8,pw1),DA_VF(1),o[d0],0,0,0);
      o[d0]=__builtin_amdgcn_mfma_f32_32x32x16_bf16(__builtin_bit_cast(bf16x8,pw2),DA_VF(2),o[d0],0,0,0);
      o[d0]=__builtin_amdgcn_mfma_f32_32x32x16_bf16(__builtin_bit_cast(bf16x8,pw3),DA_VF(3),o[d0],0,0,0);
      #undef DA_VF
    }
    slot+=DA_SLOT; if(slot>=3*DA_SLOT)slot=0;
  }
  int lane_e=lane; asm volatile("":"+v"(lane_e)); const int r32e=lane_e&31, hie=lane_e>>5;
  l_reg+=__uint_as_float((unsigned)__builtin_amdgcn_ds_bpermute((lane^32)<<2,(int)__float_as_uint(l_reg)));
  asm volatile("s_waitcnt vmcnt(0) lgkmcnt(0)\n\ts_barrier":::"memory");
  if(hie==0)wsf[32+r32e]=l_reg; asm volatile("s_waitcnt lgkmcnt(0)":::"memory");
  float rli[16];
  #pragma unroll
  for(int r=0;r<16;++r)rli[r]=__builtin_amdgcn_rcpf(wsf[32+crow(r,hie)]);
  float*st2=(float*)shm+rg*4096;
  if(c==1){
    #pragma unroll
    for(int d0=0;d0<4;++d0)
      #pragma unroll
      for(int r=0;r<16;++r)st2[crow(r,hie)*128+d0*32+r32e]=lam*o[d0][r]*rli[r];
  }
  asm volatile("s_waitcnt lgkmcnt(0)\n\ts_barrier":::"memory");
  if(c==0){
    float ssq[16];
    #pragma unroll
    for(int r=0;r<16;++r){ float a_=0.f;
      #pragma unroll
      for(int d0=0;d0<4;++d0){ const float x_=o[d0][r]*rli[r]-st2[crow(r,hie)*128+d0*32+r32e]; o[d0][r]=x_; a_+=x_*x_; }
      a_+=__uint_as_float((unsigned)__builtin_amdgcn_ds_swizzle((int)__float_as_uint(a_),(1<<10)|0x1f)); a_+=__uint_as_float((unsigned)__builtin_amdgcn_ds_swizzle((int)__float_as_uint(a_),(2<<10)|0x1f));
      a_+=__uint_as_float((unsigned)__builtin_amdgcn_ds_swizzle((int)__float_as_uint(a_),(4<<10)|0x1f)); a_+=__uint_as_float((unsigned)__builtin_amdgcn_ds_swizzle((int)__float_as_uint(a_),(8<<10)|0x1f));
      a_+=__uint_as_float((unsigned)__builtin_amdgcn_ds_swizzle((int)__float_as_uint(a_),(16<<10)|0x1f));
      ssq[r]=1.0f/__builtin_sqrtf(a_*(1.0f/128.0f)+1e-5f); }
    float g4[4];
    #pragma unroll
    for(int d0=0;d0<4;++d0)g4[d0]=gsub[d0*32+r32e]*gscale;
    bf16*stg=(bf16*)(shm+65536)+rg*4096;
    #pragma unroll
    for(int r=0;r<16;++r)
      #pragma unroll
      for(int d0=0;d0<4;++d0)stg[crow(r,hie)*128+d0*32+r32e]=__float2bfloat16(o[d0][r]*ssq[r]*g4[d0]);
    asm volatile("s_waitcnt lgkmcnt(0)":::"memory");
    bf16*Yw=Yb+(long)(q0+rg*32)*DM;
    #pragma unroll
    for(int i=0;i<8;++i){const int row=i*4+(lane_e>>4),ch=lane_e&15; const u32x4 v=*(const u32x4*)(stg+row*128+ch*8); *(u32x4*)(Yw+(long)row*DM+ch*8)=v;}
  }
  asm volatile("s_waitcnt vmcnt(0) lgkmcnt(0)\n\ts_barrier":::"memory");
  #undef DA_DMA
  #undef DA_RFL
}
#ifndef DB_VPRE
#define DB_VPRE 0
#endif
#ifndef DB_FILLX
#define DB_FILLX 1
#endif
template<int THRL> __device__ __forceinline__ void dattn2_unit(int qblk,const bf16*Qb,const bf16*__restrict__ Kb,const bf16*__restrict__ Vb,bf16*Yb,float lam,const float*gsub,float gscale,char*shm,const int tid_in){
  const int tid=tid_in,lane=tid&63,r32=lane&31,hi=lane>>5; const int wid=__builtin_amdgcn_readfirstlane(tid>>6);
  const int c=wid>>2, rg=wid&3;
  const int q0=qblk*DA_ROWS; const int NT=(q0+DA_ROWS)/KVBLK;
  const bf16*Qw=Qb+c*64+(long)(q0+rg*32)*DM;
  const unsigned lds0=(unsigned)(uintptr_t)shm; const lds_cptr shm3=(lds_cptr)shm;
  const int pk0=2*wid;
  const bf16*ksrc0=Kb+(pk0>>3)*64+(long)((pk0&7)*8+(lane>>3))*DM+((lane&7)^((lane>>3)&7))*8;
  const unsigned kdst0=lds0+(pk0>>3)*8192+(pk0&7)*1024;
  const bf16*vsrc0=Vb+(long)(16*(pk0&3)+(lane>>2))*DM+(pk0>>2)*32+(lane&3)*8;
  const unsigned vdst0=lds0+DA_V+pk0*1024;
  #define DB_RFL(x) ((unsigned)__builtin_amdgcn_readfirstlane((int)(x)))
  #define DB_DMA(t,so) do{ const long to_=(long)(t)*KVBLK*DM; \
      glds16(ksrc0+to_,DB_RFL(kdst0+(so))); glds16(ksrc0+to_+8*DM,DB_RFL(kdst0+(so)+1024)); \
      glds16(vsrc0+to_,DB_RFL(vdst0+(so))); glds16(vsrc0+to_+16*DM,DB_RFL(vdst0+(so)+1024)); }while(0)
  #define DB_SLOT(t) (((t)&3)*DA_SLOT)
  const lds_cptr kp0=shm3+c*8192+r32*128+((hi^(r32&7))*16);
  #define DB_KLD(kf_,kp_,d0) do{ const lds_cptr a_=(lds_cptr)(size_t)(((unsigned)(size_t)(kp_))^((unsigned)(d0)<<5)); kf_[2*(d0)]=*(const __attribute__((address_space(3))) bf16x8*)(a_); kf_[2*(d0)+1]=*(const __attribute__((address_space(3))) bf16x8*)(a_+4096); }while(0)
  const lds_cptr vp0=shm3+DA_V+((lane>>4)&1)*32+(lane&3)*8+(4*hi+((lane&15)>>2))*64;
  bf16x8 qr[4];
  DB_DMA(0,0); DB_DMA(1,DA_SLOT);
  #pragma unroll
  for(int d0=0;d0<4;++d0)qr[d0]=*reinterpret_cast<const bf16x8*>(&Qw[(long)r32*DM+d0*16+hi*8]);
  asm volatile("":"+v"(qr[0]),"+v"(qr[1]),"+v"(qr[2]),"+v"(qr[3]));
  float mref=0.f,l_reg=0.f; f32x16 o[4]; o[0]=f32x16{}; o[1]=f32x16{}; o[2]=f32x16{}; o[3]=f32x16{};
  f32x16 p0,p1; u32x4 pw0,pw1,pw2,pw3; s16x4 va[8],vb[8];
  #pragma unroll
  for(int r=0;r<16;++r){ p0[r]=0.f; p1[r]=0.f; }
  asm volatile("":"+v"(p0),"+v"(p1));
  const int qrel=rg*32+r32;
  #define DB_WAITT(u) do{ if((u)+1<NT){ asm volatile("s_waitcnt vmcnt(4)":::"memory"); } else { asm volatile("s_waitcnt vmcnt(0)":::"memory"); } }while(0)
  #define DB_ISSUE(u) do{ if((u)<NT){ DB_DMA((u),DB_SLOT(u)); } }while(0)
  #define DB_BAR() asm volatile("s_waitcnt lgkmcnt(0)\n\ts_barrier":::"memory")
  #define DB_BARP() asm volatile("s_waitcnt lgkmcnt(0)\n\ts_barrier":"+v"(p0),"+v"(p1)::"memory")
  #define DB_VLD(x,vp_,d0) do{ _Pragma("unroll") for(int ks_=0;ks_<4;++ks_){ x[2*ks_]=vtr((vp_)+(d0)*4096+ks_*1024); x[2*ks_+1]=vtr((vp_)+(d0)*4096+ks_*1024+512); } }while(0)
  #define DB_VF(x,ks) ((bf16x8){x[2*(ks)][0],x[2*(ks)][1],x[2*(ks)][2],x[2*(ks)][3],x[2*(ks)+1][0],x[2*(ks)+1][1],x[2*(ks)+1][2],x[2*(ks)+1][3]})
  #define DB_PVM(x,d0) do{ o[d0]=__builtin_amdgcn_mfma_f32_32x32x16_bf16(DB_VF(x,0),__builtin_bit_cast(bf16x8,pw0),o[d0],0,0,0); o[d0]=__builtin_amdgcn_mfma_f32_32x32x16_bf16(DB_VF(x,1),__builtin_bit_cast(bf16x8,pw1),o[d0],0,0,0); \
      o[d0]=__builtin_amdgcn_mfma_f32_32x32x16_bf16(DB_VF(x,2),__builtin_bit_cast(bf16x8,pw2),o[d0],0,0,0); o[d0]=__builtin_amdgcn_mfma_f32_32x32x16_bf16(DB_VF(x,3),__builtin_bit_cast(bf16x8,pw3),o[d0],0,0,0); }while(0)
  #define DB_QKM(kf_) do{ p0=__builtin_amdgcn_mfma_f32_32x32x16_bf16(kf_[0],qr[0],p0,0,0,0); p1=__builtin_amdgcn_mfma_f32_32x32x16_bf16(kf_[1],qr[0],p1,0,0,0); \
      _Pragma("unroll") for(int d0_=1;d0_<4;++d0_){ p0=__builtin_amdgcn_mfma_f32_32x32x16_bf16(kf_[2*d0_],qr[d0_],p0,0,0,0); p1=__builtin_amdgcn_mfma_f32_32x32x16_bf16(kf_[2*d0_+1],qr[d0_],p1,0,0,0); } }while(0)
  #define DB_FILL() do{ float nm_=-mref; asm volatile("":"+v"(nm_)); _Pragma("unroll") for(int r=0;r<16;++r){ p0[r]=nm_; p1[r]=nm_; } }while(0)
  #define DB_M(tp,tq) do{ const lds_cptr vp_=vp0+DB_SLOT(tp); const lds_cptr kp_=kp0+DB_SLOT(tq); bf16x8 kf_[8]; \
      if(!DB_VPRE){ DB_VLD(va,vp_,0); DB_VLD(vb,vp_,1); SBAR(); } DB_PVM(va,0); DB_VLD(va,vp_,2); SBAR(); \
      DB_PVM(vb,1); DB_VLD(vb,vp_,3); SBAR(); \
      DB_PVM(va,2); DB_KLD(kf_,kp_,0); DB_KLD(kf_,kp_,1); SBAR(); \
      DB_PVM(vb,3); DB_KLD(kf_,kp_,2); DB_KLD(kf_,kp_,3); SBAR(); \
      if(!DB_FILLX){ DB_FILL(); } DB_QKM(kf_); }while(0)
  #define DB_QK0(tq) do{ const lds_cptr kp_=kp0+DB_SLOT(tq); bf16x8 kf_[8]; DB_KLD(kf_,kp_,0); DB_KLD(kf_,kp_,1); DB_KLD(kf_,kp_,2); DB_KLD(kf_,kp_,3); SBAR(); DB_QKM(kf_); }while(0)
  #define DB_PVL(tp) do{ const lds_cptr vp_=vp0+DB_SLOT(tp); if(!DB_VPRE){ DB_VLD(va,vp_,0); DB_VLD(vb,vp_,1); SBAR(); } DB_PVM(va,0); DB_VLD(va,vp_,2); SBAR(); DB_PVM(vb,1); DB_VLD(vb,vp_,3); SBAR(); DB_PVM(va,2); SBAR(); DB_PVM(vb,3); }while(0)
  #define DB_X(tt,FIRST) do{ { const int jb_=(tt)-(NT-2); if(jb_>=0){ cmask(p0,p1,jb_,qrel,hi); } } \
      const float rm_=rowmax(p0,p1); \
      if(FIRST){ mref=rm_; _Pragma("unroll") for(int r=0;r<16;++r){ p0[r]-=rm_; p1[r]-=rm_; } } \
      else if(__any(rm_>(float)THRL)){ const float dl_=__builtin_fmaxf(rm_,0.f); const float f_=__builtin_amdgcn_exp2f(-dl_); mref+=dl_; l_reg*=f_; \
        _Pragma("unroll") for(int r=0;r<16;++r){ p0[r]-=dl_; p1[r]-=dl_; } \
        _Pragma("unroll") for(int d_=0;d_<4;++d_) _Pragma("unroll") for(int r=0;r<16;++r){ float x_=o[d_][r]; asm volatile("v_mul_f32_e32 %0, %0, %1":"+v"(x_):"v"(f_)); o[d_][r]=x_; } } \
      float sacc_=0.f; _Pragma("unroll") for(int r=0;r<16;++r){ p0[r]=__builtin_amdgcn_exp2f(p0[r]); p1[r]=__builtin_amdgcn_exp2f(p1[r]); sacc_+=p0[r]+p1[r]; } l_reg+=sacc_; \
      pw0=(u32x4){cvtpk_s(p0[0],p0[1]),cvtpk_s(p0[2],p0[3]),cvtpk_s(p0[4],p0[5]),cvtpk_s(p0[6],p0[7])}; pw1=(u32x4){cvtpk_s(p0[8],p0[9]),cvtpk_s(p0[10],p0[11]),cvtpk_s(p0[12],p0[13]),cvtpk_s(p0[14],p0[15])}; \
      pw2=(u32x4){cvtpk_s(p1[0],p1[1]),cvtpk_s(p1[2],p1[3]),cvtpk_s(p1[4],p1[5]),cvtpk_s(p1[6],p1[7])}; pw3=(u32x4){cvtpk_s(p1[8],p1[9]),cvtpk_s(p1[10],p1[11]),cvtpk_s(p1[12],p1[13]),cvtpk_s(p1[14],p1[15])}; \
      if(DB_VPRE){ const lds_cptr vq_=vp0+DB_SLOT(tt); DB_VLD(va,vq_,0); DB_VLD(vb,vq_,1); } if(DB_FILLX){ DB_FILL(); } }while(0)
  DB_WAITT(0);
  if(c==1){ DB_BAR(); DB_ISSUE(2); }
  DB_BAR();
  DB_QK0(0);
  if(c==1){ DB_WAITT(1); } DB_BARP(); DB_ISSUE(2+c);
  DB_X(0,true);
  for(int t=1;t<NT;++t){
    if(c==0){ DB_WAITT(t); } DB_BAR();
    DB_M(t-1,t);
    if(c==1){ DB_WAITT(t+1); } DB_BARP(); DB_ISSUE(t+2+c);
    DB_X(t,false);
  }
  DB_BAR(); DB_PVL(NT-1);
  if(c==0){ DB_BAR(); }
  int lane_e=lane; asm volatile("":"+v"(lane_e)); const int r32e=lane_e&31, hie=lane_e>>5;
  l_reg+=__uint_as_float((unsigned)__builtin_amdgcn_ds_bpermute((lane_e^32)<<2,(int)__float_as_uint(l_reg)));
  asm volatile("s_waitcnt vmcnt(0) lgkmcnt(0)\n\ts_barrier":::"memory");
  const float rl=__builtin_amdgcn_rcpf(l_reg);
  float*st2=(float*)shm+rg*4096+lane_e;
  if(c==1){ const float s_=lam*rl;
    #pragma unroll
    for(int d0=0;d0<4;++d0)
      #pragma unroll
      for(int r=0;r<16;++r)st2[(d0*16+r)*64]=o[d0][r]*s_;
  }
  asm volatile("s_waitcnt lgkmcnt(0)\n\ts_barrier":::"memory");
  if(c==0){
    float a_=0.f;
    #pragma unroll
    for(int d0=0;d0<4;++d0)
      #pragma unroll
      for(int r=0;r<16;++r){ const float x_=o[d0][r]*rl-st2[(d0*16+r)*64]; o[d0][r]=x_; a_+=x_*x_; }
    a_+=__uint_as_float((unsigned)__builtin_amdgcn_ds_bpermute((lane_e^32)<<2,(int)__float_as_uint(a_)));
    const float rs=gscale/__builtin_sqrtf(a_*(1.0f/128.0f)+1e-5f);
    char*stg=shm+65536+rg*(32*272)+r32e*272+hie*8;
    #pragma unroll
    for(int d0=0;d0<4;++d0)
      #pragma unroll
      for(int g=0;g<4;++g){ const float4 gv=*reinterpret_cast<const float4*>(gsub+d0*32+8*g+4*hie);
        uint2 w_; w_.x=cvtpk_s(o[d0][4*g]*rs*gv.x,o[d0][4*g+1]*rs*gv.y); w_.y=cvtpk_s(o[d0][4*g+2]*rs*gv.z,o[d0][4*g+3]*rs*gv.w);
        *reinterpret_cast<uint2*>(stg+(d0*32+8*g)*2)=w_; }
    asm volatile("s_waitcnt lgkmcnt(0)":::"memory");
    bf16*Yw=Yb+(long)(q0+rg*32)*DM; const char*stb=shm+65536+rg*(32*272);
    #pragma unroll
    for(int i=0;i<8;++i){const int row=i*4+(lane_e>>4),ch=lane_e&15; const u32x4 v=*(const u32x4*)(stb+row*272+ch*16); *(u32x4*)(Yw+(long)row*DM+ch*8)=v;}
  }
  asm volatile("s_waitcnt vmcnt(0) lgkmcnt(0)\n\ts_barrier":::"memory");
  #undef DB_RFL
  #undef DB_KLD
  #undef DB_DMA
  #undef DB_SLOT
  #undef DB_WAITT
  #undef DB_ISSUE
  #undef DB_BARP
  #undef DB_BAR
  #undef DB_VLD
  #undef DB_VF
  #undef DB_PVM
  #undef DB_QKM
  #undef DB_M
  #undef DB_QK0
  #undef DB_PVL
  #undef DB_X
}
constexpr int ATTN_LDS_BYTES=LDS_BYTES;
#undef SBAR
#undef WAIT_BAR
}

#define GAS __attribute__((address_space(1)))
#define LAS __attribute__((address_space(3)))
typedef unsigned short bf16;
typedef unsigned v4u __attribute__((ext_vector_type(4)));
typedef float f32x4 __attribute__((ext_vector_type(4)));
typedef short bf16x8 __attribute__((ext_vector_type(8)));
typedef GAS unsigned gu32;
typedef GAS unsigned long long gu64;
#define RLX_AGENT __ATOMIC_RELAXED, __HIP_MEMORY_SCOPE_AGENT
#define LDS_WAIT() asm volatile("s_waitcnt lgkmcnt(0)" ::: "memory")
#define VM_WAIT() asm volatile("s_waitcnt vmcnt(0)" ::: "memory")
__device__ __forceinline__ unsigned long long rt() { return __builtin_amdgcn_s_memrealtime(); }
__device__ __forceinline__ unsigned f2bf(float f) { unsigned u = __builtin_bit_cast(unsigned, f); return (u + 0x7fffu + ((u >> 16) & 1u)) >> 16; }
__device__ __forceinline__ unsigned pk2(float lo, float hi) { return f2bf(lo) | (f2bf(hi) << 16); }

#define XB_TMO      128
#define XB_XCNT(j)  (256  + 64 * (j))
#define XB_XSUB(j)  (1280 + 64 * (j))
#define XB_XGEN(j)  (2304 + 64 * (j))
#define XB_TOP      3328
#define XB_TOPGEN   3392
#define XCD_BAR_WORDS 3456
#define XB_SPIN_CAP (1u << 26)

__device__ __forceinline__ unsigned xb_ld(unsigned* p)              { return __hip_atomic_load(p, __ATOMIC_RELAXED, __HIP_MEMORY_SCOPE_AGENT); }
__device__ __forceinline__ unsigned xb_add(unsigned* p, unsigned v) { return __hip_atomic_fetch_add(p, v, __ATOMIC_RELAXED, __HIP_MEMORY_SCOPE_AGENT); }
__device__ __forceinline__ unsigned xb_xcc_id() { return (unsigned)__builtin_amdgcn_s_getreg((3 << 11) | 20) & 0xFu; }
#define XB_SPIN(cond, bar) do { unsigned _sp = 0; while (cond) { __builtin_amdgcn_s_sleep(1); \
    if ((++_sp & 255u) == 0u) { if (xb_ld(&(bar)[XB_TMO])) break; if (_sp > XB_SPIN_CAP) { atomicAdd(&(bar)[XB_TMO], 1u); break; } } } } while (0)

struct XcdBarrier {
    unsigned* bar; unsigned x;
    volatile LAS unsigned* st;
};

__device__ __forceinline__ XcdBarrier xcd_barrier_post(unsigned* bar, volatile LAS unsigned* st, const int tid) {
    XcdBarrier b; b.bar = bar; b.x = xb_xcc_id(); b.st = st;
    if (tid == 0) (void)xb_add(&bar[XB_XCNT(b.x)], 1u);
    return b;
}
__device__ __forceinline__ void xcd_barrier_complete(unsigned* bar, unsigned x, unsigned& nloc, unsigned& nx) {
    const unsigned G = gridDim.x * gridDim.y * gridDim.z;
    unsigned sum, cnt, mine, sp = 0u;
    for (;;) {
        sum = 0u; cnt = 0u; mine = 0u;
#pragma unroll
        for (unsigned j = 0; j < 16; ++j) { const unsigned c = xb_ld(&bar[XB_XCNT(j)]); sum += c; cnt += (c > 0u) ? 1u : 0u; mine = (j == x) ? c : mine; }
        if (sum == G) break;
        __builtin_amdgcn_s_sleep(1);
        if ((++sp & 255u) == 0u) { if (xb_ld(&bar[XB_TMO])) break; if (sp > XB_SPIN_CAP) { atomicAdd(&bar[XB_TMO], 1u); break; } }
    }
    nloc = mine > 0u ? mine : 1u; nx = cnt > 0u ? cnt : 1u;
}

__device__ __forceinline__ void xcd_barrier(const XcdBarrier& b, const int tid) {
    asm volatile("s_waitcnt vmcnt(0)" ::: "memory");
    __syncthreads();
    if (tid == 0) {
        unsigned* bar = b.bar;
        __builtin_amdgcn_s_waitcnt(0);
        unsigned nloc = b.st[0], nx = b.st[1];
        if (nloc == 0u) { xcd_barrier_complete(bar, b.x, nloc, nx); b.st[0] = nloc; b.st[1] = nx; }
        const unsigned old = xb_add(&bar[XB_XSUB(b.x)], 1u);
        const unsigned gen = old / nloc;
        if (old + 1u == (gen + 1u) * nloc) {
            __builtin_amdgcn_fence(__ATOMIC_RELEASE, "agent");
            asm volatile("s_waitcnt vmcnt(0)" ::: "memory");
            const unsigned og = xb_add(&bar[XB_TOP], 1u);
            const unsigned tg = og / nx;
            if (og + 1u == (tg + 1u) * nx) xb_add(&bar[XB_TOPGEN], 1u);
            else XB_SPIN(xb_ld(&bar[XB_TOPGEN]) == tg, bar);
            __builtin_amdgcn_fence(__ATOMIC_ACQUIRE, "agent");
            xb_add(&bar[XB_XGEN(b.x)], 1u);
            asm volatile("s_waitcnt vmcnt(0)" ::: "memory");
        } else {
            XB_SPIN(xb_ld(&bar[XB_XGEN(b.x)]) == gen, bar);
            __builtin_amdgcn_fence(__ATOMIC_ACQUIRE, "agent");
            asm volatile("s_waitcnt vmcnt(0)" ::: "memory");
        }
    }
    __syncthreads();
}

constexpr int NWAVES = 8;
constexpr int NTOK = 65536, NH = 32768, DMODEL = 1024, SEQLEN = 4096, INCOLS = 5632, DFF = 2816, NEXP = 8;
constexpr int MOE_PANELS_MAX = 264;
constexpr float EPS_NORM = 1e-6f, EPS_SUBLN = 1e-5f;

constexpr size_t MiB = 1u << 20;
constexpr size_t WS_CTL = 0, CTL_ZERO_BYTES = 1 * MiB;
constexpr size_t WS_WIN = 1 * MiB;
constexpr size_t WS_WGLU = 23 * MiB;
constexpr size_t WS_WPS = 24 * MiB;
constexpr size_t WS_WPA = 26 * MiB;
constexpr size_t WS_WOUT = 30 * MiB;
constexpr size_t WS_WDGU = 34 * MiB;
constexpr size_t WS_WDD = 45 * MiB;
constexpr size_t WS_WMGU = 51 * MiB;
constexpr size_t WS_WMD = 139 * MiB;
constexpr size_t WS_TZF = 183 * MiB;
constexpr size_t WS_EM = 223 * MiB;
constexpr size_t WS_ROPE = 239 * MiB;
constexpr size_t WS_ROUTE = 255 * MiB;
constexpr size_t WS_ACT = 260 * MiB;
constexpr size_t WS_END = 960 * MiB;
constexpr size_t A_HB = 0, A_UBUF = 64 * MiB, A_SLOC = 104 * MiB, A_Q = 120 * MiB, A_K = 184 * MiB, A_V = 248 * MiB, A_SGS = 312 * MiB, A_SGA = 376 * MiB, A_YA = 440 * MiB, A_YA2 = 472 * MiB, A_OV = 504 * MiB, A_YB = 632 * MiB;
constexpr size_t A_H2 = 0, A_FA = 64 * MiB;
constexpr size_t A_H2M = 632 * MiB, A_H2G = 0, A_AG = 132 * MiB, A_YG = 0;
constexpr size_t A_XB = 504 * MiB;
static_assert(A_UBUF == pg8::EA_U && A_Q == pg8::EA_Q && A_K == pg8::EA_K && A_V == pg8::EA_V && A_SGS == pg8::EA_SGS && A_SGA == pg8::EA_SGA, "EpiIn offsets");
static_assert(A_YB + 64 * MiB <= WS_END - WS_ACT && A_YA2 + 32 * MiB <= A_XB && A_XB + 128 * MiB <= A_YB && A_AG + 363 * MiB <= A_XB && A_H2G + 132 * MiB <= A_AG && A_H2M >= A_XB + 128 * MiB && A_H2M + 64 * MiB <= WS_END - WS_ACT && A_FA + 176 * MiB <= A_XB, "act map");
constexpr size_t R_E = 0, R_W = 256 * 1024, R_S = 512 * 1024, R_CNT = 768 * 1024, R_ROW = 1024 * 1024;
constexpr int CW_BAR = 4096;

constexpr int RING_OFF = 0, RING_BYTES = 131072;
constexpr int LDSCTL_OFF = RING_BYTES, MISC_OFF = LDSCTL_OFF + 320;
constexpr int LDS_BYTES = 147456;

constexpr int PTR_OFF = LDSCTL_OFF + 1024;
struct Args { const void* in[31]; float* out; unsigned char* ws; };
__device__ __forceinline__ unsigned long long ldp64(LAS unsigned char* L, int slot) {
    const unsigned long long v = ((volatile LAS unsigned long long*)(L + PTR_OFF))[slot];
    const unsigned lo = __builtin_amdgcn_readfirstlane((unsigned)v), hi = __builtin_amdgcn_readfirstlane((unsigned)(v >> 32));
    return ((unsigned long long)hi << 32) | lo;
}
#define LDP(T, slot) ((T*)(GAS T*)(uintptr_t)ldp64(L, (slot)))

#define SWZ_XOR(k) (((k) << 10) | 0x1f)
#define swz_xor(v, pat) __builtin_bit_cast(float, __builtin_amdgcn_ds_swizzle(__builtin_bit_cast(int, (float)(v)), (pat)))
__device__ __forceinline__ float wave_sum(float v) {
#define WS_DPP(x, ctrl) __builtin_bit_cast(float, __builtin_amdgcn_update_dpp(0, __builtin_bit_cast(int, (float)(x)), (ctrl), 0xf, 0xf, false))
    v += WS_DPP(v, 0xB1); v += WS_DPP(v, 0x4E); v += WS_DPP(v, 0x141); v += WS_DPP(v, 0x140);
#undef WS_DPP
    const float r0 = __builtin_bit_cast(float, __builtin_amdgcn_readlane(__builtin_bit_cast(int, v), 0)), r1 = __builtin_bit_cast(float, __builtin_amdgcn_readlane(__builtin_bit_cast(int, v), 16));
    const float r2 = __builtin_bit_cast(float, __builtin_amdgcn_readlane(__builtin_bit_cast(int, v), 32)), r3 = __builtin_bit_cast(float, __builtin_amdgcn_readlane(__builtin_bit_cast(int, v), 48));
    return (r0 + r1) + (r2 + r3);
}
__device__ __forceinline__ void tr_item(const float* W, int ldw, int K, bf16* WTn0, int k0, int srccol, LAS float* scr, int lane) {
    float wv[32];
#pragma unroll
    for (int i = 0; i < 32; ++i) wv[i] = W[(size_t)(k0 + 2 * i + (lane >> 5)) * ldw + srccol];
#pragma unroll
    for (int i = 0; i < 32; ++i) scr[(2 * i + (lane >> 5)) * 33 + (lane & 31)] = wv[i];
    LDS_WAIT(); asm volatile("" ::: "memory");
    const int c = lane & 7;
#pragma unroll
    for (int j = 0; j < 4; ++j) { const int n = (lane >> 3) + 8 * j; const LAS float* s = scr + (8 * c) * 33 + n;
        v4u o; o.x = pk2(s[0 * 33], s[1 * 33]); o.y = pk2(s[2 * 33], s[3 * 33]); o.z = pk2(s[4 * 33], s[5 * 33]); o.w = pk2(s[6 * 33], s[7 * 33]);
        *(GAS v4u*)(WTn0 + (size_t)n * K + k0 + 8 * c) = o; }
    LDS_WAIT(); asm volatile("" ::: "memory");
}
__device__ __forceinline__ int win_orig(int n) { if (n < 512 || n >= 2560) return n; const int i = n & 63; return (n & ~63) + 16 * ((i >> 5) & 1) + 4 * ((i >> 3) & 3) + (i & 3) + 32 * ((i >> 2) & 1); }
__device__ __forceinline__ void tr_plain(const float* W, int K, int N, bf16* WT, int item, LAS float* scr, int lane) {
    const int nblk = N / 32, kb = item / nblk, nb = item % nblk;
    tr_item(W, N, K, WT + (size_t)(32 * nb) * K, 64 * kb, 32 * nb + (lane & 31), scr, lane);
}
__device__ __forceinline__ void tr_win(const float* W, bf16* WT, int item, LAS float* scr, int lane) {
    const int nblk = INCOLS / 32, kb = item / nblk, nb = item % nblk;
    tr_item(W, INCOLS, DMODEL, WT + (size_t)(32 * nb) * DMODEL, 64 * kb, win_orig(32 * nb + (lane & 31)), scr, lane);
}
__device__ __forceinline__ void tr_gu(const float* Wg, const float* Wu, bf16* WT, int item, LAS float* scr, int lane) {
    const int nblk = INCOLS / 32, kb = item / nblk, nb = item % nblk; const int n0 = 32 * nb, pn = n0 >> 8, r = n0 & 255;
    const float* W = r < 128 ? Wg : Wu; const int col = pn * 128 + (r & 127) + (lane & 31);
    tr_item(W, DFF, DMODEL, WT + (size_t)n0 * DMODEL, 64 * kb, col, scr, lane);
}
struct S5In { const float *lam_re, *lam_im, *log_dt, *b_re, *b_im, *c_re, *c_im, *dd; };
__device__ __forceinline__ v4u pack8f(const float* v) { v4u o; o.x = pk2(v[0], v[1]); o.y = pk2(v[2], v[3]); o.z = pk2(v[4], v[5]); o.w = pk2(v[6], v[7]); return o; }
__device__ __forceinline__ void s5_item(LAS unsigned char* L, int tid, const S5In& P, int lg, int d, bf16* TZF, bf16* EM) {
    LAS float* sm = (LAS float*)(L);
    LAS float *s_fr = sm, *s_fi = sm + 64, *s_apr = sm + 128, *s_api = sm + 192, *BBr = sm + 256, *BBi = sm + 1280, *CAr = sm + 2304, *CAi = sm + 3328, *Kd = sm + 4352;
    if (tid < 64) {
        const int p = tid;
        const float dt = expf(P.log_dt[lg]);
        const float lr = P.lam_re[lg * 64 + p], li = P.lam_im[lg * 64 + p];
        const float mag = expf(lr * dt); float sn, cs; sincosf(li * dt, &sn, &cs);
        const float ar = mag * cs, ai = mag * sn;
        const float den = lr * lr + li * li, nr = ar - 1.0f, ni = ai;
        s_fr[p] = (nr * lr + ni * li) / den; s_fi[p] = (ni * lr - nr * li) / den;
        const float fd = (float)d; const float magd = expf(fd * lr * dt); float snd, csd; sincosf(fd * li * dt, &snd, &csd);
        s_apr[p] = magd * csd; s_api[p] = magd * snd;
    }
    __syncthreads();
    for (int idx = tid; idx < 1024; idx += 512) {
        { const int p = idx >> 4; const float br = P.b_re[(size_t)lg * 1024 + idx], bi = P.b_im[(size_t)lg * 1024 + idx]; const float fr_ = s_fr[p], fi_ = s_fi[p];
          BBr[idx] = fr_ * br - fi_ * bi; BBi[idx] = fr_ * bi + fi_ * br; }
        { const int p = idx & 63; const float cr = P.c_re[(size_t)lg * 1024 + idx], ci = P.c_im[(size_t)lg * 1024 + idx]; const float ar_ = s_apr[p], ai_ = s_api[p];
          CAr[idx] = cr * ar_ - ci * ai_; CAi[idx] = cr * ai_ + ci * ar_; }
    }
    __syncthreads();
    if (d <= 31 && tid < 256) { const int j = tid >> 4, jp = tid & 15; float acc = 0.f;
        for (int p = 0; p < 64; ++p) acc += CAr[j * 64 + p] * BBr[p * 16 + jp] - CAi[j * 64 + p] * BBi[p * 16 + jp];
        if (d == 0 && j == jp) acc += P.dd[lg * 16 + j];
        Kd[tid] = acc; }
    __syncthreads();
    bf16* TZ = TZF + (size_t)lg * 512 * 640; bf16* EE = EM + (size_t)lg * 256 * 512;
    if (d <= 31) {
        const int cnt = (32 - d) * 16;
        for (int idx = tid; idx < cnt; idx += 512) { const int tt = idx >> 4, j = idx & 15; float v[16];
#pragma unroll
            for (int q = 0; q < 16; ++q) v[q] = Kd[j * 16 + q];
            bf16* dst = TZ + (size_t)((d + tt) * 16 + j) * 640 + tt * 16;
            *(GAS v4u*)dst = pack8f(v); *(GAS v4u*)(dst + 8) = pack8f(v + 8);
            if (d >= 1) { bf16* dz = TZ + (size_t)(tt * 16 + j) * 640 + (d + tt) * 16; const v4u z = {0u, 0u, 0u, 0u}; *(GAS v4u*)dz = z; *(GAS v4u*)(dz + 8) = z; } }
        if (tid < 128) { const int ri = tid >> 6, p = tid & 63; const float ar_ = s_apr[p], ai_ = s_api[p]; float v[16];
#pragma unroll
            for (int q = 0; q < 16; ++q) { const float br = BBr[p * 16 + q], bi = BBi[p * 16 + q]; v[q] = ri == 0 ? (ar_ * br - ai_ * bi) : (ar_ * bi + ai_ * br); }
            bf16* dst = EE + (size_t)tid * 512 + (31 - d) * 16; *(GAS v4u*)dst = pack8f(v); *(GAS v4u*)(dst + 8) = pack8f(v + 8);
        } else if (tid < 256) { bf16* dz = EE + (size_t)tid * 512 + (31 - d) * 16; const v4u z = {0u, 0u, 0u, 0u}; *(GAS v4u*)dz = z; *(GAS v4u*)(dz + 8) = z; }
    }
    if (d >= 1 && tid < 256) { const int j = tid >> 4, ri = (tid >> 3) & 1, pc = tid & 7; float v[8];
#pragma unroll
        for (int q = 0; q < 8; ++q) v[q] = ri == 0 ? CAr[j * 64 + pc * 8 + q] : -CAi[j * 64 + pc * 8 + q];
        *(GAS v4u*)(TZ + (size_t)((d - 1) * 16 + j) * 640 + 512 + ri * 64 + pc * 8) = pack8f(v); }
    __syncthreads();
}
__device__ __forceinline__ void norm_rows4(const float* x0, size_t xstep, const f32x4 (&g)[4], bf16* o0, size_t ostep, int lane) {
    f32x4 h[4][4];
#pragma unroll
    for (int r = 0; r < 4; ++r) { const GAS f32x4* xr = (const GAS f32x4*)(x0 + r * xstep) + lane;
#pragma unroll
        for (int j = 0; j < 4; ++j) h[r][j] = xr[64 * j]; }
#pragma unroll
    for (int r = 0; r < 4; ++r) { float s2 = 0.f;
#pragma unroll
        for (int j = 0; j < 4; ++j) s2 += (h[r][j].x * h[r][j].x + h[r][j].y * h[r][j].y) + (h[r][j].z * h[r][j].z + h[r][j].w * h[r][j].w);
        const float rs = 1.0f / sqrtf(wave_sum(s2) * (1.0f / DMODEL) + EPS_NORM);
        GAS unsigned long long* o8 = (GAS unsigned long long*)(o0 + r * ostep) + lane;
#pragma unroll
        for (int j = 0; j < 4; ++j) { const f32x4 v = h[r][j] * rs * g[j]; o8[64 * j] = (unsigned long long)pk2(v.x, v.y) | ((unsigned long long)pk2(v.z, v.w) << 32); } }
}
__device__ __forceinline__ f32x4 bf4_f32(unsigned long long a) { const unsigned lo = (unsigned)a, hi = (unsigned)(a >> 32); f32x4 r; r.x = __uint_as_float(lo << 16); r.y = __uint_as_float(lo & 0xffff0000u); r.z = __uint_as_float(hi << 16); r.w = __uint_as_float(hi & 0xffff0000u); return r; }
__device__ __forceinline__ void norm_rows4b(const bf16* x0, size_t xstep, const f32x4 (&g)[4], bf16* o0, size_t ostep, int lane) {
    unsigned long long hb[4][4];
#pragma unroll
    for (int r = 0; r < 4; ++r) { const GAS unsigned long long* xr = (const GAS unsigned long long*)(x0 + r * xstep) + lane;
#pragma unroll
        for (int j = 0; j < 4; ++j) hb[r][j] = xr[64 * j]; }
#pragma unroll
    for (int r = 0; r < 4; ++r) { float s2 = 0.f; f32x4 h[4];
#pragma unroll
        for (int j = 0; j < 4; ++j) { h[j] = bf4_f32(hb[r][j]); s2 += (h[j].x * h[j].x + h[j].y * h[j].y) + (h[j].z * h[j].z + h[j].w * h[j].w); }
        const float rs = 1.0f / sqrtf(wave_sum(s2) * (1.0f / DMODEL) + EPS_NORM);
        GAS unsigned long long* o8 = (GAS unsigned long long*)(o0 + r * ostep) + lane;
#pragma unroll
        for (int j = 0; j < 4; ++j) { const f32x4 v = h[j] * rs * g[j]; o8[64 * j] = (unsigned long long)pk2(v.x, v.y) | ((unsigned long long)pk2(v.z, v.w) << 32); } }
}
__device__ __forceinline__ void norm_row(const float* xrow, const float* gain, bf16* orow, int lane, f32x4 (&hn)[4]) {
    const GAS f32x4* xr = (const GAS f32x4*)xrow + lane; const GAS f32x4* gr = (const GAS f32x4*)gain + lane;
    float s2 = 0.f;
#pragma unroll
    for (int j = 0; j < 4; ++j) { hn[j] = xr[64 * j]; s2 += (hn[j].x * hn[j].x + hn[j].y * hn[j].y) + (hn[j].z * hn[j].z + hn[j].w * hn[j].w); }
    const float rs = 1.0f / sqrtf(wave_sum(s2) * (1.0f / DMODEL) + EPS_NORM);
    GAS unsigned long long* o8 = (GAS unsigned long long*)orow + lane;
#pragma unroll
    for (int j = 0; j < 4; ++j) { const f32x4 g = gr[64 * j]; hn[j] = hn[j] * rs * g;
        o8[64 * j] = (unsigned long long)pk2(hn[j].x, hn[j].y) | ((unsigned long long)pk2(hn[j].z, hn[j].w) << 32); }
}

__global__ void __launch_bounds__(NWAVES * 64, 2) trunk_fwd(Args args) {
    extern __shared__ __attribute__((aligned(16))) unsigned char lds[];
    const int WAVE = __builtin_amdgcn_readfirstlane((int)threadIdx.x >> 6);
#define MYTID() ({ int l_; asm volatile("v_mbcnt_lo_u32_b32 %0, -1, 0\n\tv_mbcnt_hi_u32_b32 %0, -1, %0" : "=v"(l_)); WAVE * 64 + l_; })
    LAS unsigned char* const L0 = (LAS unsigned char*)lds;
#define OPQ LAS unsigned char* L = L0; asm volatile("" : "+s"(L))
    OPQ;
    {
        const int tid0 = MYTID();
        for (int u = tid0; u < (LDS_BYTES - LDSCTL_OFF) / 4; u += NWAVES * 64) ((LAS unsigned*)(L + LDSCTL_OFF))[u] = 0u;
        __syncthreads();
        if (tid0 == 0) {
#pragma unroll
            for (int k = 0; k < 31; ++k) ((LAS unsigned long long*)(L + PTR_OFF))[k] = (unsigned long long)(uintptr_t)args.in[k];
            ((LAS unsigned long long*)(L + PTR_OFF))[31] = (unsigned long long)(uintptr_t)args.out;
            ((LAS unsigned long long*)(L + PTR_OFF))[32] = (unsigned long long)(uintptr_t)args.ws; }
        __syncthreads();
    }
    { XcdBarrier b0 = xcd_barrier_post((unsigned*)(LDP(unsigned char, 32) + WS_CTL) + CW_BAR, (volatile LAS unsigned*)(L + MISC_OFF) + 8, MYTID()); (void)b0; }
#define GRID_BAR() do { OPQ; XcdBarrier b_; b_.bar = (unsigned*)(LDP(unsigned char, 32) + WS_CTL) + CW_BAR; b_.x = xb_xcc_id(); b_.st = (volatile LAS unsigned*)(L + MISC_OFF) + 8; xcd_barrier(b_, MYTID()); } while (0)
#define LQ() ({ int l_ = l; asm volatile("" : "+s"(l_)); l_; })
#define TID_SETUP OPQ; int wave_ = WAVE; asm volatile("" : "+s"(wave_)); const int wave = wave_; const int tid = MYTID(), lane = tid & 63; const int G = gridDim.x; const int vcu = ((int)blockIdx.x % 8) * (G / 8) + (int)blockIdx.x / 8; const int gw = vcu * NWAVES + wave, NGW = G * NWAVES; (void)lane; (void)gw; (void)NGW; (void)tid
#define WSP(T, off) ((T*)(LDP(unsigned char, 32) + (off)))
#define ACTP(T, off) ((T*)(LDP(unsigned char, 32) + WS_ACT + (off)))

    {
        TID_SETUP;
        LAS float* scr = (LAS float*)(L + RING_OFF + wave * 16384);
        constexpr int I_WIN = 16 * 176, I_GLU = 8 * 16, I_PS = 8 * 32, I_PA = 16 * 32, I_OUT = 16 * 32, I_GU = 16 * 176, I_DN = 44 * 32;
        constexpr int I_LAYER = I_WIN + I_GLU + I_PS + I_PA + I_OUT;
        constexpr int NITEMS = 2 * I_LAYER + I_GU + I_DN + 8 * I_GU + 8 * I_DN;
        for (int it = gw; it < NITEMS; it += NGW) {
            int r = it;
            if (r < 2 * I_LAYER) { const int l = r / I_LAYER; r -= l * I_LAYER;
                if (r < I_WIN) { tr_win(LDP(const float, 3) + (size_t)l * DMODEL * INCOLS, WSP(bf16, WS_WIN) + (size_t)l * INCOLS * DMODEL, r, scr, lane); continue; } r -= I_WIN;
                if (r < I_GLU) { tr_plain(LDP(const float, 12) + (size_t)l * 512 * 512, 512, 512, WSP(bf16, WS_WGLU) + (size_t)l * 512 * 512, r, scr, lane); continue; } r -= I_GLU;
                if (r < I_PS) { tr_plain(LDP(const float, 19) + (size_t)l * 512 * 1024, 512, 1024, WSP(bf16, WS_WPS) + (size_t)l * 1024 * 512, r, scr, lane); continue; } r -= I_PS;
                if (r < I_PA) { tr_plain(LDP(const float, 20) + (size_t)l * 1024 * 1024, 1024, 1024, WSP(bf16, WS_WPA) + (size_t)l * 1024 * 1024, r, scr, lane); continue; } r -= I_PA;
                tr_plain(LDP(const float, 21) + (size_t)l * 1024 * 1024, 1024, 1024, WSP(bf16, WS_WOUT) + (size_t)l * 1024 * 1024, r, scr, lane); continue; }
            r -= 2 * I_LAYER;
            if (r < I_GU) { tr_gu(LDP(const float, 23), LDP(const float, 24), WSP(bf16, WS_WDGU), r, scr, lane); continue; } r -= I_GU;
            if (r < I_DN) { tr_plain(LDP(const float, 25), DFF, DMODEL, WSP(bf16, WS_WDD), r, scr, lane); continue; } r -= I_DN;
            if (r < 8 * I_GU) { const int e = r / I_GU; r -= e * I_GU; tr_gu(LDP(const float, 27) + (size_t)e * DMODEL * DFF, LDP(const float, 28) + (size_t)e * DMODEL * DFF, WSP(bf16, WS_WMGU) + (size_t)e * INCOLS * DMODEL, r, scr, lane); continue; } r -= 8 * I_GU;
            { const int e = r / I_DN; r -= e * I_DN; tr_plain(LDP(const float, 29) + (size_t)e * DFF * DMODEL, DFF, DMODEL, WSP(bf16, WS_WMD) + (size_t)e * DMODEL * DFF, r, scr, lane); }
        }
        __syncthreads();
        { S5In s5p; s5p.lam_re = LDP(const float, 4); s5p.lam_im = LDP(const float, 5); s5p.log_dt = LDP(const float, 6); s5p.b_re = LDP(const float, 7); s5p.b_im = LDP(const float, 8);
          s5p.c_re = LDP(const float, 9); s5p.c_im = LDP(const float, 10); s5p.dd = LDP(const float, 11);
          for (int it = vcu; it < 2 * 32 * 33; it += G) s5_item(L, tid, s5p, it / 33, it % 33, WSP(bf16, WS_TZF), WSP(bf16, WS_EM)); }
        { const int* positions = LDP(const int, 1); float* ROPE = WSP(float, WS_ROPE);
          for (int idx = vcu * (NWAVES * 64) + tid; idx < NTOK * 32; idx += G * NWAVES * 64) { const int n = idx >> 5, fi = idx & 31;
            const float invf = powf(10000.0f, -(float)(2 * fi) / 64.0f); const float ang = (float)positions[n] * invf; float sn, cs; sincosf(ang, &sn, &cs);
            ROPE[(size_t)n * 64 + fi] = cs; ROPE[(size_t)n * 64 + 32 + fi] = sn; } }
    }
    GRID_BAR();

    for (int l = 0; l < 2; ++l) {
        for (int half = 0; half < 2; ++half) {
            const int tokbase = half * NH;
            { TID_SETUP; const float* xsrc = LDP(const float, 0); const bf16* XB = ACTP(const bf16, A_XB); const float* gain = LDP(const float, 2) + l * DMODEL; bf16* HB = ACTP(bf16, A_HB);
              f32x4 gq[4];
#pragma unroll
              for (int j = 0; j < 4; ++j) gq[j] = ((const GAS f32x4*)gain + lane)[64 * j];
              if (LQ() == 0) { for (int m = gw; m < NH; m += 4 * NGW) norm_rows4(xsrc + (size_t)(tokbase + m) * DMODEL, (size_t)NGW * DMODEL, gq, HB + (size_t)m * DMODEL, (size_t)NGW * DMODEL, lane); }
              else { for (int m = gw; m < NH; m += 4 * NGW) norm_rows4b(XB + (size_t)(tokbase + m) * DMODEL, (size_t)NGW * DMODEL, gq, HB + (size_t)m * DMODEL, (size_t)NGW * DMODEL, lane); } }
            GRID_BAR();
            { OPQ; pg8::Gemm g{ACTP(bf16, A_HB), WSP(bf16, WS_WIN) + (size_t)l * INCOLS * DMODEL, DMODEL, DMODEL, DMODEL}; pg8::SchedPlain S; S.init(NH / 256, INCOLS / 256, gridDim.x, (int)blockIdx.x);
              pg8::EpiIn E{ACTP(unsigned char, 0), WSP(const float, WS_ROPE), tokbase};
              pg8::gemm_phase<pg8::EpiIn, pg8::SchedPlain, true, true>(L0 + RING_OFF, g, S, E, MYTID()); }
            GRID_BAR();
            { OPQ; pg8::Gemm g{ACTP(bf16, A_UBUF), WSP(bf16, WS_EM) + (size_t)l * 32 * 256 * 512, 640, 512, 512}; pg8::SchedS5 S; S.init(1, gridDim.x, (int)blockIdx.x);
              pg8::EpiSloc E{ACTP(float, A_SLOC)};
              pg8::gemm_phase<pg8::EpiSloc, pg8::SchedS5, true, true>(L0 + RING_OFF, g, S, E, MYTID()); }
            GRID_BAR();
            { TID_SETUP;
              if (wave == 0) {
                const int id = vcu * 64 + lane;
                if (id < 8 * 32 * 64) { const int bl = id >> 11, g = (id >> 6) & 31, p = id & 63; const int lg = l * 32 + g;
                    const float dt = expf(LDP(const float, 6)[lg]); const float lr = LDP(const float, 4)[lg * 64 + p], li = LDP(const float, 5)[lg * 64 + p];
                    const float magT = expf(32.0f * lr * dt); float snT, csT; sincosf(32.0f * li * dt, &snT, &csT); const float aTr = magT * csT, aTi = magT * snT;
                    float sr = 0.f, si = 0.f; const size_t row0 = (size_t)g * 1024 + (size_t)bl * 128;
                    const float* sl = ACTP(const float, A_SLOC) + row0 * 128 + p; bf16* ub = ACTP(bf16, A_UBUF) + row0 * 640 + 512 + p;
                    for (int c0 = 0; c0 < 128; c0 += 8) { float lr_[8], li_[8];
#pragma unroll
                        for (int q = 0; q < 8; ++q) { lr_[q] = sl[(size_t)(c0 + q) * 128]; li_[q] = sl[(size_t)(c0 + q) * 128 + 64]; }
#pragma unroll
                        for (int q = 0; q < 8; ++q) { ub[(size_t)(c0 + q) * 640] = (bf16)f2bf(sr); ub[(size_t)(c0 + q) * 640 + 64] = (bf16)f2bf(si);
                            const float nr_ = aTr * sr - aTi * si + lr_[q], ni_ = aTr * si + aTi * sr + li_[q]; sr = nr_; si = ni_; } } }
              } }
            GRID_BAR();
            { OPQ; pg8::Gemm g{ACTP(bf16, A_UBUF), WSP(bf16, WS_TZF) + (size_t)l * 32 * 512 * 640, 640, 640, 640}; pg8::SchedS5 S; S.init(2, gridDim.x, (int)blockIdx.x);
              pg8::EpiYa E{ACTP(bf16, A_YA)};
              pg8::gemm_phase<pg8::EpiYa, pg8::SchedS5, true, true>(L0 + RING_OFF, g, S, E, MYTID()); }
            GRID_BAR();
            { OPQ; pg8::Gemm g{ACTP(bf16, A_YA), WSP(bf16, WS_WGLU) + (size_t)l * 512 * 512, 512, 512, 512}; pg8::SchedPlain S; S.init(NH / 256, 2, gridDim.x, (int)blockIdx.x);
              pg8::EpiGlu E{ACTP(bf16, A_YA), ACTP(bf16, A_YA2), LDP(const float, 13) + l * 512};
              pg8::gemm_phase<pg8::EpiGlu, pg8::SchedPlain, true, true>(L0 + RING_OFF, g, S, E, MYTID()); }
            GRID_BAR();
            {
                TID_SETUP;
                int lq = l; asm volatile("" : "+s"(lq));
                const float lam_init = 0.8f - 0.6f * expf(-0.3f * (float)lq);
                const float p1 = wave_sum(LDP(const float, 14)[lq * 64 + lane] * LDP(const float, 15)[lq * 64 + lane]), p2 = wave_sum(LDP(const float, 16)[lq * 64 + lane] * LDP(const float, 17)[lq * 64 + lane]);
                float lam_v = expf(p1) - expf(p2) + lam_init, gsc_v = 1.0f - lam_init; asm volatile("" : "+v"(lam_v), "+v"(gsc_v));
                const int lam_i = __builtin_amdgcn_readfirstlane(__builtin_bit_cast(int, lam_v)), gsc_i = __builtin_amdgcn_readfirstlane(__builtin_bit_cast(int, gsc_v));
                const float lam = __builtin_bit_cast(float, lam_i), gsc = __builtin_bit_cast(float, gsc_i);
                for (int i = 0; i < 8; ++i) {
                    OPQ; const int bh = (i >> 1) * 16 + (vcu >> 4); const int j = vcu & 15; const int qblk = (i & 1) ? 31 - j : j;
                    const int b = bh >> 3, h = bh & 7; const size_t rb = (size_t)b * SEQLEN;
                    attn_body::dattn2_unit<8>(qblk, (const attn_body::bf16*)(ACTP(bf16, A_Q) + rb * 1024 + h * 128), (const attn_body::bf16*)(ACTP(bf16, A_K) + rb * 1024 + h * 128),
                                             (const attn_body::bf16*)(ACTP(bf16, A_V) + rb * 1024 + h * 128), (attn_body::bf16*)(ACTP(bf16, A_YB) + rb * 1024 + h * 128),
                                             lam, LDP(const float, 18) + lq * 128, gsc, (char*)lds + RING_OFF, MYTID());
                }
            }
            GRID_BAR();
            { OPQ; pg8::Gemm g{ACTP(bf16, A_YA2), WSP(bf16, WS_WPS) + (size_t)l * 1024 * 512, 512, 512, 512}; pg8::SchedPlain S; S.init(NH / 256, 4, gridDim.x, (int)blockIdx.x);
              pg8::EpiGate<0> E{ACTP(bf16, A_SGS), nullptr};
              pg8::gemm_phase<pg8::EpiGate<0>, pg8::SchedPlain, true, true>(L0 + RING_OFF, g, S, E, MYTID()); }
            GRID_BAR();
            { OPQ; pg8::Gemm g{ACTP(bf16, A_YB), WSP(bf16, WS_WPA) + (size_t)l * 1024 * 1024, 1024, 1024, 1024}; pg8::SchedPlain S; S.init(NH / 256, 4, gridDim.x, (int)blockIdx.x);
              pg8::EpiGate<1> E{ACTP(bf16, A_SGA), ACTP(bf16, A_SGS)};
              pg8::gemm_phase<pg8::EpiGate<1>, pg8::SchedPlain, true, true>(L0 + RING_OFF, g, S, E, MYTID()); }
            GRID_BAR();
            { OPQ; pg8::Gemm g{ACTP(bf16, A_SGA), WSP(bf16, WS_WOUT) + (size_t)l * 1024 * 1024, 1024, 1024, 1024}; pg8::SchedPlain S; S.init(NH / 256, 4, gridDim.x, (int)blockIdx.x);
              pg8::EpiRes E{(LQ() == 0) ? LDP(const float, 0) : (const float*)nullptr, ACTP(bf16, A_XB), tokbase};
              pg8::gemm_phase<pg8::EpiRes, pg8::SchedPlain, true, true>(L0 + RING_OFF, g, S, E, MYTID()); }
            GRID_BAR();
            if (LQ() == 0) {
                { TID_SETUP; const bf16* xs = ACTP(const bf16, A_XB); const float* gain = LDP(const float, 22); bf16* H2 = ACTP(bf16, A_H2);
                  f32x4 gq[4];
#pragma unroll
                  for (int j = 0; j < 4; ++j) gq[j] = ((const GAS f32x4*)gain + lane)[64 * j];
                  for (int m = gw; m < NH; m += 4 * NGW) norm_rows4b(xs + (size_t)(tokbase + m) * DMODEL, (size_t)NGW * DMODEL, gq, H2 + (size_t)m * DMODEL, (size_t)NGW * DMODEL, lane); }
                GRID_BAR();
                { OPQ; pg8::Gemm g{ACTP(bf16, A_H2), WSP(bf16, WS_WDGU), 1024, 1024, 1024}; pg8::SchedPlain S; S.init(NH / 256, 22, gridDim.x, (int)blockIdx.x);
                  pg8::EpiSwi E{ACTP(bf16, A_FA)};
                  pg8::gemm_phase<pg8::EpiSwi, pg8::SchedPlain, true, true>(L0 + RING_OFF, g, S, E, MYTID()); }
                GRID_BAR();
                { OPQ; pg8::Gemm g{ACTP(bf16, A_FA), WSP(bf16, WS_WDD), 2816, 2816, 2816}; pg8::SchedPlain S; S.init(NH / 256, 4, gridDim.x, (int)blockIdx.x);
                  pg8::EpiRes E{(const float*)nullptr, ACTP(bf16, A_XB), tokbase};
                  pg8::gemm_phase<pg8::EpiRes, pg8::SchedPlain, true, true>(L0 + RING_OFF, g, S, E, MYTID()); }
                GRID_BAR();
            } else {
                {
                    TID_SETUP;
                    LAS float* rwT = (LAS float*)(L);
                    LAS unsigned* cntL = (LAS unsigned*)(L + 32768);
                    { const float* router_w = LDP(const float, 26); for (int idx = tid; idx < 8192; idx += NWAVES * 64) { const int k = idx >> 3, e = idx & 7; rwT[e * 1024 + k] = router_w[idx]; } }
                    if (tid < 8) cntL[tid] = 0u;
                    __syncthreads();
                    const bf16* xs = ACTP(const bf16, A_XB); const float* gain = LDP(const float, 22) + DMODEL; bf16* H2 = ACTP(bf16, A_H2M);
                    unsigned* RT_E = WSP(unsigned, WS_ROUTE + R_E); float* RT_W = WSP(float, WS_ROUTE + R_W);
                    f32x4 gq[4];
#pragma unroll
                    for (int j = 0; j < 4; ++j) gq[j] = ((const GAS f32x4*)gain + lane)[64 * j];
                    for (int i2 = 0; i2 < 16; i2 += 4) { f32x4 xv[4][4];
#pragma unroll
                      for (int u = 0; u < 4; ++u) { const GAS unsigned long long* xr = (const GAS unsigned long long*)(xs + (size_t)(tokbase + vcu * 128 + wave * 16 + i2 + u) * DMODEL) + lane;
#pragma unroll
                        for (int j = 0; j < 4; ++j) xv[u][j] = bf4_f32(xr[64 * j]); }
#pragma unroll
                      for (int u = 0; u < 4; ++u) { const int row = vcu * 128 + wave * 16 + i2 + u;
                        f32x4 hn[4]; { float s2 = 0.f;
#pragma unroll
                            for (int j = 0; j < 4; ++j) s2 += (xv[u][j].x * xv[u][j].x + xv[u][j].y * xv[u][j].y) + (xv[u][j].z * xv[u][j].z + xv[u][j].w * xv[u][j].w);
                            const float rs = 1.0f / sqrtf(wave_sum(s2) * (1.0f / DMODEL) + EPS_NORM);
                            GAS unsigned long long* o8 = (GAS unsigned long long*)(H2 + (size_t)row * DMODEL) + lane;
#pragma unroll
                            for (int j = 0; j < 4; ++j) { hn[j] = xv[u][j] * rs * gq[j]; o8[64 * j] = (unsigned long long)pk2(hn[j].x, hn[j].y) | ((unsigned long long)pk2(hn[j].z, hn[j].w) << 32); } }
                        float lg[8];
#pragma unroll
                        for (int e = 0; e < 8; ++e) { float a = 0.f;
#pragma unroll
                            for (int j = 0; j < 4; ++j) { const f32x4 w = *(const LAS f32x4*)(rwT + e * 1024 + 4 * lane + 256 * j); a += (hn[j].x * w.x + hn[j].y * w.y) + (hn[j].z * w.z + hn[j].w * w.w); }
                            lg[e] = wave_sum(a); }
                        if (lane == 0) { int e1 = 0; float v1 = lg[0];
#pragma unroll
                            for (int e = 1; e < 8; ++e) if (lg[e] > v1) { v1 = lg[e]; e1 = e; }
                            int e2 = -1; float v2 = -INFINITY;
#pragma unroll
                            for (int e = 0; e < 8; ++e) if (e != e1 && lg[e] > v2) { v2 = lg[e]; e2 = e; }
                            if (e2 < 0) e2 = (e1 == 0) ? 1 : 0;
                            const float ex = expf(v2 - v1); const float w1 = 1.0f / (1.0f + ex), w2 = ex / (1.0f + ex);
                            RT_E[row] = (unsigned)e1 | ((unsigned)e2 << 8); RT_W[2 * row] = w1; RT_W[2 * row + 1] = w2;
                            __hip_atomic_fetch_add(cntL + e1, 1u, __ATOMIC_RELAXED, __HIP_MEMORY_SCOPE_WORKGROUP); __hip_atomic_fetch_add(cntL + e2, 1u, __ATOMIC_RELAXED, __HIP_MEMORY_SCOPE_WORKGROUP); }
                      }
                    }
                    __syncthreads();
                    if (tid < 8) WSP(unsigned, WS_ROUTE + R_CNT)[vcu * 8 + tid] = cntL[tid];
                }
                GRID_BAR();
                {
                    TID_SETUP;
                    volatile LAS unsigned* MISC = (volatile LAS unsigned*)(L + MISC_OFF);
                    LAS unsigned* tab = (LAS unsigned*)(L);
                    LAS unsigned* tot = (LAS unsigned*)(L + 8192);
                    LAS unsigned* off = (LAS unsigned*)(L + 8192 + 64);
                    LAS unsigned* wcn = (LAS unsigned*)(L + 8192 + 128);
                    LAS unsigned* slt = (LAS unsigned*)(L + 8192 + 512);
                    const unsigned* RT_CNT = WSP(const unsigned, WS_ROUTE + R_CNT); const unsigned* RT_E = WSP(const unsigned, WS_ROUTE + R_E); int* RT_S = WSP(int, WS_ROUTE + R_S);
                    unsigned* RT_ROW = WSP(unsigned, WS_ROUTE + R_ROW);
                    if (tid < 256) { const GAS v4u* src = (const GAS v4u*)(RT_CNT + tid * 8); const v4u a = src[0], b = src[1];
                        tab[tid * 8 + 0] = a.x; tab[tid * 8 + 1] = a.y; tab[tid * 8 + 2] = a.z; tab[tid * 8 + 3] = a.w; tab[tid * 8 + 4] = b.x; tab[tid * 8 + 5] = b.y; tab[tid * 8 + 6] = b.z; tab[tid * 8 + 7] = b.w; }
                    __syncthreads();
                    if (tid < 8) { tot[tid] = 0u; off[tid] = 0u; }
                    __syncthreads();
                    { const int e = tid & 7, b0 = (tid >> 3) * 4; unsigned t = 0, o = 0;
#pragma unroll
                      for (int q = 0; q < 4; ++q) { const unsigned c = tab[(b0 + q) * 8 + e]; t += c; if (b0 + q < vcu) o += c; }
                      __hip_atomic_fetch_add(tot + e, t, __ATOMIC_RELAXED, __HIP_MEMORY_SCOPE_WORKGROUP); __hip_atomic_fetch_add(off + e, o, __ATOMIC_RELAXED, __HIP_MEMORY_SCOPE_WORKGROUP); }
                    __syncthreads();
                    if (tid == 0) { unsigned sp = 0; for (int e = 0; e < 8; ++e) { MISC[16 + e] = sp; sp += (tot[e] + 255u) >> 8; } MISC[24] = sp; }
                    __syncthreads();
                    int my_e = 0, my_rank = 0;
                    if (tid < 256) { const int row = vcu * 128 + (tid >> 1); const unsigned ee = RT_E[row]; my_e = (tid & 1) ? (int)((ee >> 8) & 255u) : (int)(ee & 255u);
#pragma unroll
                        for (int e = 0; e < 8; ++e) { const unsigned long long mask = __ballot(my_e == e); if (my_e == e) my_rank = __popcll(mask & ((1ull << lane) - 1ull)); if (lane == 0) wcn[wave * 8 + e] = (unsigned)__popcll(mask); } }
                    __syncthreads();
                    if (tid < 256) { unsigned pre = 0; for (int w = 0; w < wave; ++w) pre += wcn[w * 8 + my_e];
                        const unsigned slot = MISC[16 + my_e] * 256u + off[my_e] + pre + (unsigned)my_rank;
                        RT_S[(vcu * 128 + (tid >> 1)) * 2 + (tid & 1)] = (int)slot; RT_ROW[slot] = (unsigned)(vcu * 128 + (tid >> 1)); }
                    if (vcu < 8) { const unsigned e = (unsigned)vcu; const unsigned r0 = MISC[16 + e] * 256u + tot[e], r1 = MISC[17 + e] * 256u;
                        for (unsigned r = r0 + (unsigned)tid; r < r1; r += NWAVES * 64) RT_ROW[r] = (unsigned)NH; }
                    if (vcu == 8 && tid < 128) { unsigned zz = 0u; asm volatile("" : "+v"(zz)); const v4u z = {zz, zz, zz, zz}; ((GAS v4u*)(ACTP(bf16, A_H2M) + (size_t)NH * DMODEL))[tid] = z; }
                }
                GRID_BAR();
#define MOE_SCHED(S, NN) do { volatile LAS unsigned* MISC = (volatile LAS unsigned*)(L + MISC_OFF); S.nn = (NN); \
        S.sp1 = __builtin_amdgcn_readfirstlane((int)MISC[17]); S.sp2 = __builtin_amdgcn_readfirstlane((int)MISC[18]); S.sp3 = __builtin_amdgcn_readfirstlane((int)MISC[19]); S.sp4 = __builtin_amdgcn_readfirstlane((int)MISC[20]); \
        S.sp5 = __builtin_amdgcn_readfirstlane((int)MISC[21]); S.sp6 = __builtin_amdgcn_readfirstlane((int)MISC[22]); S.sp7 = __builtin_amdgcn_readfirstlane((int)MISC[23]); \
        S.so.init(__builtin_amdgcn_readfirstlane((int)MISC[24]), (NN), gridDim.x, (int)blockIdx.x); } while (0)
                { OPQ; pg8::SchedMoe S; MOE_SCHED(S, 22);
                  pg8::Gemm g{ACTP(bf16, A_H2M), WSP(bf16, WS_WMGU), 1024, 1024, 1024, WSP(const unsigned, WS_ROUTE + R_ROW)}; pg8::EpiSwi E{ACTP(bf16, A_AG)};
                  pg8::gemm_phase<pg8::EpiSwi, pg8::SchedMoe, true, true, true>(L0 + RING_OFF, g, S, E, MYTID()); }
                GRID_BAR();
                { OPQ; pg8::SchedMoe S; MOE_SCHED(S, 4);
                  pg8::Gemm g{ACTP(bf16, A_AG), WSP(bf16, WS_WMD), 2816, 2816, 2816}; pg8::EpiBf E{ACTP(bf16, A_YG)};
                  pg8::gemm_phase<pg8::EpiBf, pg8::SchedMoe, true, true>(L0 + RING_OFF, g, S, E, MYTID()); }
                GRID_BAR();
                {
                    TID_SETUP;
                    const int* RT_S = WSP(const int, WS_ROUTE + R_S); const float* RT_W = WSP(const float, WS_ROUTE + R_W); float* xo = LDP(float, 31); const bf16* XBc = ACTP(const bf16, A_XB); const bf16* YG = ACTP(const bf16, A_YG);
                    const GAS f32x4* gr = (const GAS f32x4*)LDP(const float, 30) + lane;
                    f32x4 gq[4];
#pragma unroll
                    for (int j = 0; j < 4; ++j) gq[j] = gr[64 * j];
                    for (int m = gw; m < NH; m += 4 * NGW) {
                        int s1[4], s2[4]; float w1[4], w2[4];
#pragma unroll
                        for (int r = 0; r < 4; ++r) { const int mm = m + r * NGW; s1[r] = RT_S[2 * mm]; s2[r] = RT_S[2 * mm + 1]; w1[r] = RT_W[2 * mm]; w2[r] = RT_W[2 * mm + 1]; }
                        f32x4 xa[4][4]; unsigned long long ya[4][4], yb[4][4];
#pragma unroll
                        for (int r = 0; r < 4; ++r) { const GAS unsigned long long* xr = (const GAS unsigned long long*)(XBc + (size_t)(tokbase + m + r * NGW) * DMODEL) + lane;
                            const GAS unsigned long long* y1 = (const GAS unsigned long long*)(YG + (size_t)s1[r] * DMODEL) + lane; const GAS unsigned long long* y2 = (const GAS unsigned long long*)(YG + (size_t)s2[r] * DMODEL) + lane;
#pragma unroll
                            for (int j = 0; j < 4; ++j) { xa[r][j] = bf4_f32(xr[64 * j]); ya[r][j] = y1[64 * j]; yb[r][j] = y2[64 * j]; } }
#pragma unroll
                        for (int r = 0; r < 4; ++r) { float sq = 0.f;
#pragma unroll
                            for (int j = 0; j < 4; ++j) { const unsigned long long a = ya[r][j], b = yb[r][j]; f32x4 x4 = xa[r][j];
                                const unsigned alo = (unsigned)a, ahi = (unsigned)(a >> 32), blo = (unsigned)b, bhi = (unsigned)(b >> 32);
                                x4.x += w1[r] * __uint_as_float(alo << 16) + w2[r] * __uint_as_float(blo << 16); x4.y += w1[r] * __uint_as_float(alo & 0xffff0000u) + w2[r] * __uint_as_float(blo & 0xffff0000u);
                                x4.z += w1[r] * __uint_as_float(ahi << 16) + w2[r] * __uint_as_float(bhi << 16); x4.w += w1[r] * __uint_as_float(ahi & 0xffff0000u) + w2[r] * __uint_as_float(bhi & 0xffff0000u);
                                xa[r][j] = x4; sq += (x4.x * x4.x + x4.y * x4.y) + (x4.z * x4.z + x4.w * x4.w); }
                            const float rs = 1.0f / sqrtf(wave_sum(sq) * (1.0f / DMODEL) + EPS_NORM);
                            GAS f32x4* xw = (GAS f32x4*)(xo + (size_t)(tokbase + m + r * NGW) * DMODEL) + lane;
#pragma unroll
                            for (int j = 0; j < 4; ++j) xw[64 * j] = xa[r][j] * rs * gq[j]; }
                    }
                }
                GRID_BAR();
            }
        }
    }
#undef GRID_BAR
#undef TID_SETUP
#undef LQ
#undef MYTID
#undef OPQ
#undef WSP
#undef ACTP
#undef MOE_SCHED
}

extern "C" void kernel_launch(void* const* d_in, const int* in_sizes, int n_in, void* d_out, int out_size, void* d_ws, size_t ws_size, hipStream_t stream) {
    static int grid = 0;
    if (grid == 0) {
        if (n_in != 31 || in_sizes[0] != NTOK * DMODEL || out_size != NTOK * DMODEL || ws_size < WS_END) {
            fprintf(stderr, "kernel_launch: unexpected shapes: n_in %d in0 %d out %d ws %zu (need %zu); nothing launched\n", n_in, n_in > 0 ? in_sizes[0] : -1, out_size, ws_size, (size_t)WS_END); grid = -1; return; }
        int dev = 0, cus = 0, per_cu = 0;
        if (hipGetDevice(&dev) != hipSuccess || hipDeviceGetAttribute(&cus, hipDeviceAttributeMultiprocessorCount, dev) != hipSuccess) { grid = -1; return; }
        if (hipFuncSetAttribute((const void*)trunk_fwd, hipFuncAttributeMaxDynamicSharedMemorySize, LDS_BYTES) != hipSuccess) { fprintf(stderr, "kernel_launch: hipFuncSetAttribute failed\n"); grid = -1; return; }
        if (hipOccupancyMaxActiveBlocksPerMultiprocessor(&per_cu, (const void*)trunk_fwd, NWAVES * 64, LDS_BYTES) != hipSuccess || per_cu < 1)
            fprintf(stderr, "kernel_launch: note: occupancy query reports %d workgroups per CU\n", per_cu);
        (void)hipGetLastError();
        grid = 256;
        if (cus < 256) { fprintf(stderr, "kernel_launch: device has %d CUs, need 256; nothing launched\n", cus); grid = -1; return; }
    }
    if (grid < 0) return;
    if (hipMemsetAsync((char*)d_ws + WS_CTL, 0, CTL_ZERO_BYTES, stream) != hipSuccess) return;
    Args a{};
    for (int i = 0; i < 31; ++i) a.in[i] = d_in[i];
    a.out = (float*)d_out; a.ws = (unsigned char*)d_ws;
    hipLaunchKernelGGL(trunk_fwd, dim3(grid), dim3(NWAVES * 64), LDS_BYTES, stream, a);
}
```

```cpp
#include <hip/hip_runtime.h>
#include <hip/hip_bf16.h>
#include <cstdio>
#include <cstdint>
#include <cmath>
namespace pg8 {
#define PG8_LAS __attribute__((address_space(3)))
typedef unsigned short bf16_t;
typedef short bf16x8 __attribute__((ext_vector_type(8)));
typedef float f32x4 __attribute__((ext_vector_type(4)));
typedef unsigned u32x4 __attribute__((ext_vector_type(4)));
constexpr int BM = 256, BK = 64, HALF = 128, HTB = HALF * BK * 2  , STAGE_BYTES = 8 * HTB, NXCD = 8, WGM = 8;

__host__ __device__ __forceinline__ int lds_byte(int r, int c) { const int st = (r >> 4) * 2 + (c >> 5), rr = r & 15, cc = c & 31, ob = rr * 64 + cc * 2; return st * 1024 + (ob ^ (((ob >> 9) & 1) << 5)); }
__host__ __device__ __forceinline__ void stage_rc(int b, int& R, int& C) { const int st = b / 1024, sb = b % 1024, swz = sb ^ (((sb >> 9) & 1) << 5); R = (st >> 1) * 16 + swz / 64; C = (st & 1) * 32 + (swz % 64) / 2; }
__host__ __device__ __forceinline__ int perm32(int rho) { const int n = rho >> 4, i = rho & 15; return 8 * (i >> 2) + 4 * n + (i & 3); }

struct Unit { int pm, pn; };
struct Gemm { const bf16_t* A; const bf16_t* Bt; int lda, ldb, K; const unsigned* rowidx = nullptr; };

struct StaticOrder {
    int nM, nN, nwg, G, c;
    __host__ __device__ void init(int nM_, int nN_, int G_, int c_) { nM = nM_; nN = nN_; nwg = nM * nN; G = G_; c = c_; }
    __host__ __device__ bool next(int i, Unit& u) const {
        const long L = (long)i * G + c; if (L >= nwg) return false;
        int wgid = (int)L; { const int q = nwg / NXCD, r = nwg % NXCD, xcd = wgid % NXCD, off = wgid / NXCD; wgid = (xcd < r ? xcd * (q + 1) : r * (q + 1) + (xcd - r) * q) + off; }
        const int nig = WGM * nN, gid = wgid / nig, fm = gid * WGM, gsz = (nM - fm) < WGM ? (nM - fm) : WGM;
        u.pm = fm + ((wgid % nig) % gsz); u.pn = (wgid % nig) / gsz; return true;
    }
    __device__ __forceinline__ void a_ready(const Unit&) const {}
    __device__ __forceinline__ void done(const Unit&) const {}
};


struct SchedPlain {
    StaticOrder so;
    __device__ __forceinline__ void init(int nM, int nN, int G, int c) { so.init(nM, nN, G, c); }
    __device__ __forceinline__ bool next(int i, Unit& u) const { return so.next(i, u); }
    __device__ __forceinline__ void a_ready(const Unit&) const {}
    __device__ __forceinline__ void done(const Unit&) const {}
};
struct SchedS5 {
    StaticOrder so; int nng;
    __device__ __forceinline__ void init(int nng_, int G, int c) { nng = nng_; so.init(128, nng_, G, c); }
    __device__ __forceinline__ bool next(int i, Unit& u) const { if (!so.next(i, u)) return false; u.pn = (u.pm >> 2) * nng + u.pn; return true; }
    __device__ __forceinline__ void a_ready(const Unit&) const {}
    __device__ __forceinline__ void done(const Unit&) const {}
};
struct SchedMoe {
    StaticOrder so; int nn; int sp1, sp2, sp3, sp4, sp5, sp6, sp7;
    __device__ __forceinline__ bool next(int i, Unit& u) const {
        if (!so.next(i, u)) return false;
        const int pm = u.pm; const int e = (pm >= sp1) + (pm >= sp2) + (pm >= sp3) + (pm >= sp4) + (pm >= sp5) + (pm >= sp6) + (pm >= sp7);
        u.pn = e * nn + u.pn; return true;
    }
    __device__ __forceinline__ void a_ready(const Unit&) const {}
    __device__ __forceinline__ void done(const Unit&) const {}
};

struct SchedOne {
    Unit u; bool has;
    __device__ __forceinline__ bool next(int i, Unit& o) const { if (i != 0 || !has) return false; o = u; return true; }
    __device__ __forceinline__ void a_ready(const Unit&) const {}
    __device__ __forceinline__ void done(const Unit&) const {}
};

typedef float f32x2c_t __attribute__((ext_vector_type(2))); typedef __bf16 bf16x2c_t __attribute__((ext_vector_type(2)));
__device__ __forceinline__ unsigned cvt_pk_bf16(float lo, float hi) { f32x2c_t v = {lo, hi}; bf16x2c_t b = __builtin_convertvector(v, bf16x2c_t); return __builtin_bit_cast(unsigned, b); }
__device__ __forceinline__ u32x4 pack8(const f32x4 a, const f32x4 b) { u32x4 w; w.x = cvt_pk_bf16(a[0], a[1]); w.y = cvt_pk_bf16(a[2], a[3]); w.z = cvt_pk_bf16(b[0], b[1]); w.w = cvt_pk_bf16(b[2], b[3]); return w; }
__device__ __forceinline__ void unpack8(const u32x4 w, f32x4& a, f32x4& b) {
    a[0] = __uint_as_float(w.x << 16); a[1] = __uint_as_float(w.x & 0xffff0000u); a[2] = __uint_as_float(w.y << 16); a[3] = __uint_as_float(w.y & 0xffff0000u);
    b[0] = __uint_as_float(w.z << 16); b[1] = __uint_as_float(w.z & 0xffff0000u); b[2] = __uint_as_float(w.w << 16); b[3] = __uint_as_float(w.w & 0xffff0000u); }
__device__ __forceinline__ float sigm(float z) { return __builtin_amdgcn_rcpf(1.0f + __builtin_amdgcn_exp2f(-1.4426950408889634f * z)); }
__device__ __forceinline__ f32x4 sigm4(const f32x4 z) { f32x4 r; r[0] = sigm(z[0]); r[1] = sigm(z[1]); r[2] = sigm(z[2]); r[3] = sigm(z[3]); return r; }
__device__ __forceinline__ float gelu_t(float x) { const float u = 1.5957691216057308f * (x + 0.044715f * x * x * x); return x * sigm(u); }
__device__ __forceinline__ f32x4 gelu4(const f32x4 z) { f32x4 r; r[0] = gelu_t(z[0]); r[1] = gelu_t(z[1]); r[2] = gelu_t(z[2]); r[3] = gelu_t(z[3]); return r; }
constexpr size_t EA_U = (size_t)64 << 20, EA_Q = (size_t)120 << 20, EA_K = (size_t)184 << 20, EA_V = (size_t)248 << 20, EA_SGS = (size_t)312 << 20, EA_SGA = (size_t)376 << 20;
constexpr float QSCALE = 0.125f * 1.4426950408889634f;

struct EpiIn {
    static constexpr bool PERM = true, AFTER_DRAIN = false;
    unsigned char* act; const float* rope; int tokbase;
    __device__ __forceinline__ void operator()(const f32x4 (&acc)[2][2][4][2], const Unit& u, int wr, int wc, int fr_in, int fq_in) const {
        int fr = fr_in, fq = fq_in; asm volatile("" : "+v"(fr), "+v"(fq));
        const int pn = u.pn, rowb = u.pm * BM + wr * 64 + fr, cow = wc * 32 + fq * 8;
        if (pn < 2) {
#pragma unroll
            for (int ai = 0; ai < 2; ++ai)
#pragma unroll
                for (int m = 0; m < 4; ++m) { const int row = rowb + ai * HALF + m * 16;
#pragma unroll
                    for (int bj = 0; bj < 2; ++bj) { const int c = pn * 256 + bj * HALF + cow; const int g = c >> 4, jj = c & 15;
                        bf16_t* dst = (bf16_t*)(act + EA_U) + ((size_t)(g * 1024 + (row >> 5)) * 640 + (row & 31) * 16 + jj);
                        *(u32x4*)dst = pack8(acc[ai][bj][m][0], acc[ai][bj][m][1]); } }
        } else if (pn < 10) {
            const bool isq = pn < 6; bf16_t* base = (bf16_t*)(act + (isq ? EA_Q : EA_K)); const int colt = (isq ? pn - 2 : pn - 6) * 256; const float sc = isq ? QSCALE : 1.0f;
            const int dlo = 16 * (wc & 1) + 4 * fq;
#pragma unroll
            for (int ai = 0; ai < 2; ++ai) { f32x4 csq[4], snq[4];
#pragma unroll
                for (int m = 0; m < 4; ++m) { const float* tr = rope + (size_t)(tokbase + rowb + ai * HALF + m * 16) * 64 + dlo; csq[m] = *(const f32x4*)tr; snq[m] = *(const f32x4*)(tr + 32); }
#pragma unroll
                for (int m = 0; m < 4; ++m) { const int row = rowb + ai * HALF + m * 16; const f32x4 cs = csq[m], sn = snq[m];
#pragma unroll
                    for (int bj = 0; bj < 2; ++bj) { const f32x4 v0 = acc[ai][bj][m][0], v1 = acc[ai][bj][m][1];
                        const f32x4 o0 = (v0 * cs - v1 * sn) * sc, o1 = (v1 * cs + v0 * sn) * sc;
                        *(u32x4*)(base + (size_t)row * 1024 + colt + bj * HALF + cow) = pack8(o0, o1); } } }
        } else if (pn < 14) {
            const int colt = (pn - 10) * 256;
#pragma unroll
            for (int ai = 0; ai < 2; ++ai)
#pragma unroll
                for (int m = 0; m < 4; ++m) { const int row = rowb + ai * HALF + m * 16;
#pragma unroll
                    for (int bj = 0; bj < 2; ++bj) *(u32x4*)((bf16_t*)(act + EA_V) + (size_t)row * 1024 + colt + bj * HALF + cow) = pack8(acc[ai][bj][m][0], acc[ai][bj][m][1]); }
        } else {
            bf16_t* base = (bf16_t*)(act + (pn < 18 ? EA_SGS : EA_SGA)); const int colt = (pn < 18 ? pn - 14 : pn - 18) * 256;
#pragma unroll
            for (int ai = 0; ai < 2; ++ai)
#pragma unroll
                for (int m = 0; m < 4; ++m) { const int row = rowb + ai * HALF + m * 16;
#pragma unroll
                    for (int bj = 0; bj < 2; ++bj) *(u32x4*)(base + (size_t)row * 1024 + colt + bj * HALF + cow) = pack8(sigm4(acc[ai][bj][m][0]), sigm4(acc[ai][bj][m][1])); }
        }
    }
};
struct EpiSloc {
    static constexpr bool PERM = false, AFTER_DRAIN = false;
    float* S;
    __device__ __forceinline__ void operator()(const f32x4 (&acc)[2][2][4][2], const Unit& u, int wr, int wc, int fr_in, int fq_in) const {
        int fr = fr_in, fq = fq_in; asm volatile("" : "+v"(fr), "+v"(fq));
        const int rowb = u.pm * BM + wr * 64 + fr, col0 = wc * 32 + 4 * fq;
#pragma unroll
        for (int ai = 0; ai < 2; ++ai)
#pragma unroll
            for (int m = 0; m < 4; ++m) { float* rowp = S + (size_t)(rowb + ai * HALF + m * 16) * 128 + col0;
#pragma unroll
                for (int n = 0; n < 2; ++n) *(f32x4*)(rowp + n * 16) = acc[ai][0][m][n]; }
    }
};
struct EpiYa {
    static constexpr bool PERM = true, AFTER_DRAIN = false;
    bf16_t* YA;
    __device__ __forceinline__ void operator()(const f32x4 (&acc)[2][2][4][2], const Unit& u, int wr, int wc, int fr_in, int fq_in) const {
        int fr = fr_in, fq = fq_in; asm volatile("" : "+v"(fr), "+v"(fq));
        const int g = u.pm >> 2, pni = u.pn & 1; const int rowb = (u.pm & 3) * BM + wr * 64 + fr; const int jj = 8 * (fq & 1);
#pragma unroll
        for (int ai = 0; ai < 2; ++ai)
#pragma unroll
            for (int m = 0; m < 4; ++m) { const int R = rowb + ai * HALF + m * 16;
#pragma unroll
                for (int bj = 0; bj < 2; ++bj) { const int t = pni * 16 + bj * 8 + wc * 2 + (fq >> 1);
                    *(u32x4*)(YA + (size_t)(R * 32 + t) * 512 + g * 16 + jj) = pack8(gelu4(acc[ai][bj][m][0]), gelu4(acc[ai][bj][m][1])); } }
    }
};
struct EpiGlu {
    static constexpr bool PERM = true, AFTER_DRAIN = false;
    const bf16_t* YA; bf16_t* O; const float* bias;
    __device__ __forceinline__ void operator()(const f32x4 (&acc)[2][2][4][2], const Unit& u, int wr, int wc, int fr_in, int fq_in) const {
        int fr = fr_in, fq = fq_in; asm volatile("" : "+v"(fr), "+v"(fq));
        const int rowb = u.pm * BM + wr * 64 + fr, col0 = u.pn * BM + wc * 32 + 8 * fq;
        f32x4 bv[2][2];
#pragma unroll
        for (int bj = 0; bj < 2; ++bj)
#pragma unroll
            for (int n = 0; n < 2; ++n) bv[bj][n] = *(const f32x4*)(bias + col0 + bj * HALF + 4 * n);
#pragma unroll
        for (int ai = 0; ai < 2; ++ai) { u32x4 yq[4][2];
#pragma unroll
            for (int m = 0; m < 4; ++m)
#pragma unroll
                for (int bj = 0; bj < 2; ++bj) yq[m][bj] = *(const u32x4*)(YA + (size_t)(rowb + ai * HALF + m * 16) * 512 + col0 + bj * HALF);
#pragma unroll
            for (int m = 0; m < 4; ++m) { const size_t off = (size_t)(rowb + ai * HALF + m * 16) * 512 + col0;
#pragma unroll
                for (int bj = 0; bj < 2; ++bj) { f32x4 y0, y1; unpack8(yq[m][bj], y0, y1);
                    *(u32x4*)(O + off + bj * HALF) = pack8(y0 * sigm4(acc[ai][bj][m][0] + bv[bj][0]), y1 * sigm4(acc[ai][bj][m][1] + bv[bj][1])); } } }
    }
};
template <int MODE> struct EpiGate {
    static constexpr bool PERM = true, AFTER_DRAIN = false;
    bf16_t* G; const bf16_t* T0;
    __device__ __forceinline__ void operator()(const f32x4 (&acc)[2][2][4][2], const Unit& u, int wr, int wc, int fr_in, int fq_in) const {
        int fr = fr_in, fq = fq_in; asm volatile("" : "+v"(fr), "+v"(fq));
        const int rowb = u.pm * BM + wr * 64 + fr, col0 = u.pn * BM + wc * 32 + 8 * fq;
        u32x4 gA[4], tA[4], gB[4], tB[4];
#define EG_LOAD(ai, bj, gq, tq) do { _Pragma("unroll") for (int m = 0; m < 4; ++m) { const size_t off = (size_t)(rowb + (ai) * HALF + m * 16) * 1024 + col0 + (bj) * HALF; gq[m] = *(const u32x4*)(G + off); if (MODE == 1) tq[m] = *(const u32x4*)(T0 + off); } } while (0)
#define EG_STORE(ai, bj, gq, tq) do { _Pragma("unroll") for (int m = 0; m < 4; ++m) { const size_t off = (size_t)(rowb + (ai) * HALF + m * 16) * 1024 + col0 + (bj) * HALF; f32x4 g0, g1; unpack8(gq[m], g0, g1); \
            f32x4 o0 = g0 * acc[ai][bj][m][0], o1 = g1 * acc[ai][bj][m][1]; if (MODE == 1) { f32x4 t0, t1; unpack8(tq[m], t0, t1); o0 += t0; o1 += t1; } *(u32x4*)(G + off) = pack8(o0, o1); } } while (0)
        if (MODE == 0) { EG_LOAD(0, 0, gA, tA); EG_LOAD(0, 1, gB, tB); EG_STORE(0, 0, gA, tA); EG_LOAD(1, 0, gA, tA); EG_STORE(0, 1, gB, tB); EG_LOAD(1, 1, gB, tB); EG_STORE(1, 0, gA, tA); EG_STORE(1, 1, gB, tB); }
        else { EG_LOAD(0, 0, gA, tA); EG_STORE(0, 0, gA, tA); EG_LOAD(0, 1, gA, tA); EG_STORE(0, 1, gA, tA); EG_LOAD(1, 0, gA, tA); EG_STORE(1, 0, gA, tA); EG_LOAD(1, 1, gA, tA); EG_STORE(1, 1, gA, tA); }
#undef EG_LOAD
#undef EG_STORE
    }
};
struct EpiPart {
    static constexpr bool PERM = false, AFTER_DRAIN = false;
    float* P;
    __device__ __forceinline__ void operator()(const f32x4 (&acc)[2][2][4][2], const Unit& u, int wr, int wc, int fr_in, int fq_in) const {
        int fr = fr_in, fq = fq_in; asm volatile("" : "+v"(fr), "+v"(fq));
        (void)u; const int rowb = wr * 64 + fr, col0 = wc * 32 + 4 * fq;
#pragma unroll
        for (int ai = 0; ai < 2; ++ai)
#pragma unroll
            for (int m = 0; m < 4; ++m) { float* rowp = P + (size_t)(rowb + ai * HALF + m * 16) * 256 + col0;
#pragma unroll
                for (int bj = 0; bj < 2; ++bj)
#pragma unroll
                    for (int n = 0; n < 2; ++n) *(f32x4*)(rowp + bj * HALF + n * 16) = acc[ai][bj][m][n]; }
    }
};
struct EpiRes {
    static constexpr bool PERM = true, AFTER_DRAIN = false;
    const float* xin32; bf16_t* xb; int tokbase;
    __device__ __forceinline__ void operator()(const f32x4 (&acc)[2][2][4][2], const Unit& u, int wr, int wc, int fr_in, int fq_in) const {
        int fr = fr_in, fq = fq_in; asm volatile("" : "+v"(fr), "+v"(fq));
        const int rowb = tokbase + u.pm * BM + wr * 64 + fr, col0 = u.pn * BM + wc * 32 + 8 * fq;
        const bool f32in = xin32 != nullptr;
        if (f32in) { f32x4 xA[4][2], xB[4][2];
#define ER_LOAD(ai, bj, xq) do { _Pragma("unroll") for (int m = 0; m < 4; ++m) { const size_t off = (size_t)(rowb + (ai) * HALF + m * 16) * 1024 + col0 + (bj) * HALF; xq[m][0] = *(const f32x4*)(xin32 + off); xq[m][1] = *(const f32x4*)(xin32 + off + 4); } } while (0)
#define ER_STORE(ai, bj, xq) do { _Pragma("unroll") for (int m = 0; m < 4; ++m) *(u32x4*)(xb + (size_t)(rowb + (ai) * HALF + m * 16) * 1024 + col0 + (bj) * HALF) = pack8(xq[m][0] + acc[ai][bj][m][0], xq[m][1] + acc[ai][bj][m][1]); } while (0)
            ER_LOAD(0, 0, xA); ER_STORE(0, 0, xA); ER_LOAD(0, 1, xA); ER_STORE(0, 1, xA); ER_LOAD(1, 0, xA); ER_STORE(1, 0, xA); ER_LOAD(1, 1, xA); ER_STORE(1, 1, xA); (void)xB;
#undef ER_LOAD
#undef ER_STORE
        } else { u32x4 wA[4], wB[4];
#define ER_LOAD(ai, bj, xw) do { _Pragma("unroll") for (int m = 0; m < 4; ++m) xw[m] = *(const u32x4*)(xb + (size_t)(rowb + (ai) * HALF + m * 16) * 1024 + col0 + (bj) * HALF); } while (0)
#define ER_STORE(ai, bj, xw) do { _Pragma("unroll") for (int m = 0; m < 4; ++m) { f32x4 x0, x1; unpack8(xw[m], x0, x1); *(u32x4*)(xb + (size_t)(rowb + (ai) * HALF + m * 16) * 1024 + col0 + (bj) * HALF) = pack8(x0 + acc[ai][bj][m][0], x1 + acc[ai][bj][m][1]); } } while (0)
            ER_LOAD(0, 0, wA); ER_LOAD(0, 1, wB); ER_STORE(0, 0, wA); ER_LOAD(1, 0, wA); ER_STORE(0, 1, wB); ER_LOAD(1, 1, wB); ER_STORE(1, 0, wA); ER_STORE(1, 1, wB);
#undef ER_LOAD
#undef ER_STORE
        }
    }
};
struct EpiSwi {
    static constexpr bool PERM = true, AFTER_DRAIN = false;
    bf16_t* O;
    __device__ __forceinline__ void operator()(const f32x4 (&acc)[2][2][4][2], const Unit& u, int wr, int wc, int fr_in, int fq_in) const {
        int fr = fr_in, fq = fq_in; asm volatile("" : "+v"(fr), "+v"(fq));
        const int rowb = u.pm * BM + wr * 64 + fr, col0 = (u.pn % 22) * HALF + wc * 32 + 8 * fq;
#pragma unroll
        for (int ai = 0; ai < 2; ++ai)
#pragma unroll
            for (int m = 0; m < 4; ++m) { const f32x4 g0 = acc[ai][0][m][0], g1 = acc[ai][0][m][1];
                *(u32x4*)(O + (size_t)(rowb + ai * HALF + m * 16) * 2816 + col0) = pack8(g0 * sigm4(g0) * acc[ai][1][m][0], g1 * sigm4(g1) * acc[ai][1][m][1]); }
    }
};
struct EpiBf {
    static constexpr bool PERM = true, AFTER_DRAIN = false;
    bf16_t* O;
    __device__ __forceinline__ void operator()(const f32x4 (&acc)[2][2][4][2], const Unit& u, int wr, int wc, int fr_in, int fq_in) const {
        int fr = fr_in, fq = fq_in; asm volatile("" : "+v"(fr), "+v"(fq));
        const int rowb = u.pm * BM + wr * 64 + fr, col0 = (u.pn & 3) * BM + wc * 32 + 8 * fq;
#pragma unroll
        for (int ai = 0; ai < 2; ++ai)
#pragma unroll
            for (int m = 0; m < 4; ++m)
#pragma unroll
                for (int bj = 0; bj < 2; ++bj) *(u32x4*)(O + (size_t)(rowb + ai * HALF + m * 16) * 1024 + col0 + bj * HALF) = pack8(acc[ai][bj][m][0], acc[ai][bj][m][1]);
    }
};

template <class Epi, class Sched, bool ALIGN_EPI = false, bool SP2 = false, bool GATHER = false>
__device__ __forceinline__ void gemm_phase(PG8_LAS unsigned char* lds, const Gemm g, const Sched& S, const Epi& E, const int tid_in) {
    const int tid = tid_in, wid = __builtin_amdgcn_readfirstlane(tid >> 6), lane = tid & 63, wr = wid >> 2, wc = wid & 3, fr = lane & 15, fq = lane >> 4;
    const int K = g.K, nt = K / BK;
    unsigned voffA[2], voffB[2];
#pragma unroll
    for (int i = 0; i < 2; ++i) { int R, C; stage_rc(tid * 16 + i * 8192, R, C); const int Rb = Epi::PERM ? ((R & ~31) + perm32(R & 31)) : R;
        voffA[i] = (unsigned)(R * g.lda + C) * 2u; voffB[i] = (unsigned)(Rb * g.ldb + C) * 2u; }
    unsigned vc0[2] = {0u, 0u}, vc1[2] = {0u, 0u}, vn0[2] = {0u, 0u}, vn1[2] = {0u, 0u};
#define PG8_GLOAD(U, o0, o1) do { _Pragma("unroll") for (int i_ = 0; i_ < 2; ++i_) { int R_, C_; stage_rc(tid * 16 + i_ * 8192, R_, C_); \
        o0[i_] = (unsigned)(g.rowidx[(U).pm * 256 + R_] * (unsigned)(g.lda * 2) + (unsigned)(C_ * 2)); o1[i_] = (unsigned)(g.rowidx[(U).pm * 256 + 128 + R_] * (unsigned)(g.lda * 2) + (unsigned)(C_ * 2)); } } while (0)
    const size_t kstep = (size_t)(BK * 2);
    const size_t hstepA = (size_t)HALF * g.lda * 2, hstepB = (size_t)HALF * g.ldb * 2;
    const size_t tstepA = 2 * hstepA, tstepB = 2 * hstepB;
    const unsigned ldsw = (unsigned)wid * 1024u;
    const int aoff = lds_byte(wr * 64 + fr, fq * 8), boff = lds_byte(wc * 32 + fr, fq * 8);
#define PG8_SA(b, h) (((b) * 2 + (h)) * HTB)
#define PG8_SB(b, h) ((4 + (b) * 2 + (h)) * HTB)
#define PG8_STAGE(bufoff, gbase, voff) do { _Pragma("unroll") for (int _i = 0; _i < 2; ++_i) \
        __builtin_amdgcn_global_load_lds((const unsigned*)((const char*)(gbase) + (voff)[_i]), (PG8_LAS unsigned*)(lds + (bufoff) + ldsw + _i * 8192), 16, 0, 0); } while (0)
#define PG8_LDA(dst, b, h) do { _Pragma("unroll") for (int m = 0; m < 4; ++m) _Pragma("unroll") for (int k = 0; k < 2; ++k) dst[m][k] = *(const PG8_LAS bf16x8*)(lds + PG8_SA(b, h) + aoff + m * 2048 + k * 1024); } while (0)
#define PG8_LDB(dst, b, h) do { _Pragma("unroll") for (int n = 0; n < 2; ++n) _Pragma("unroll") for (int k = 0; k < 2; ++k) dst[n][k] = *(const PG8_LAS bf16x8*)(lds + PG8_SB(b, h) + boff + n * 2048 + k * 1024); } while (0)
#define PG8_MMA(ai, bj, At, Bt) do { __builtin_amdgcn_s_setprio(1); _Pragma("unroll") for (int m = 0; m < 4; ++m) _Pragma("unroll") for (int n = 0; n < 2; ++n) _Pragma("unroll") for (int k = 0; k < 2; ++k) \
        acc[ai][bj][m][n] = __builtin_amdgcn_mfma_f32_16x16x32_bf16(Bt[n][k], At[m][k], acc[ai][bj][m][n], 0, 0, 0); __builtin_amdgcn_s_setprio(0); } while (0)
#define PG8_WAIT_V(n) asm volatile("s_waitcnt vmcnt(" #n ")" ::: "memory")
#define PG8_WAIT_L(n) asm volatile("s_waitcnt lgkmcnt(" #n ")" ::: "memory")
#define PG8_BAR __builtin_amdgcn_s_barrier()
#define PG8_SCHED __builtin_amdgcn_sched_barrier(0)
    Unit cur, nxt; int ui = 0;
    if (!S.next(0, cur)) return;
    f32x4 acc[2][2][4][2];
#pragma unroll
    for (int a = 0; a < 2; ++a)
#pragma unroll
        for (int b = 0; b < 2; ++b)
#pragma unroll
            for (int m = 0; m < 4; ++m)
#pragma unroll
                for (int n = 0; n < 2; ++n) acc[a][b][m][n] = (f32x4){0.f, 0.f, 0.f, 0.f};
    bf16x8 At[4][2], B0[2][2], B1[2][2];
    const char* cA = (const char*)g.A + (GATHER ? (size_t)0 : (size_t)cur.pm * tstepA); const char* cB = (const char*)g.Bt + (size_t)cur.pn * tstepB;
    S.a_ready(cur);
    if constexpr (GATHER) { PG8_GLOAD(cur, vc0, vc1); }
#define PG8_STAGE_A(bufoff, gbase, h, V0, V1) do { if constexpr (GATHER) { if (h) PG8_STAGE(bufoff, gbase, V1); else PG8_STAGE(bufoff, gbase, V0); } else { PG8_STAGE(bufoff, (gbase) + ((h) ? hstepA : (size_t)0), voffA); } } while (0)
    if constexpr (SP2) {
        PG8_STAGE(PG8_SB(0, 0), cB, voffB); PG8_STAGE(PG8_SB(0, 1), cB + hstepB, voffB); PG8_STAGE_A(PG8_SA(0, 0), cA, 0, vc0, vc1); PG8_STAGE_A(PG8_SA(0, 1), cA, 1, vc0, vc1);
        if (wr == 1) PG8_BAR;
        PG8_WAIT_V(2); PG8_BAR;
        PG8_STAGE(PG8_SB(1, 0), cB + kstep, voffB); PG8_STAGE_A(PG8_SA(1, 0), cA + kstep, 0, vc0, vc1); PG8_STAGE(PG8_SB(1, 1), cB + hstepB + kstep, voffB);
        PG8_WAIT_V(6); PG8_BAR;
    } else {
        PG8_STAGE(PG8_SB(0, 0), cB, voffB); PG8_STAGE(PG8_SA(0, 0), cA, voffA); PG8_STAGE(PG8_SB(0, 1), cB + hstepB, voffB); PG8_STAGE(PG8_SA(0, 1), cA + hstepA, voffA);
        if (wr == 1) PG8_BAR;
        PG8_WAIT_V(4); PG8_BAR;
        PG8_STAGE(PG8_SB(1, 0), cB + kstep, voffB); PG8_STAGE(PG8_SA(1, 0), cA + kstep, voffA); PG8_STAGE(PG8_SB(1, 1), cB + hstepB + kstep, voffB);
        PG8_WAIT_V(6); PG8_BAR;
    }
    for (;;) {
        const bool has_next = S.next(ui + 1, nxt);
        if constexpr (GATHER) { if (has_next) { PG8_GLOAD(nxt, vn0, vn1);
            *(PG8_LAS u32x4*)(lds + 135168 + tid * 16) = (u32x4){vn0[0], vn0[1], vn1[0], vn1[1]}; } }
        const char* nA = (has_next && !GATHER) ? (const char*)g.A + (size_t)nxt.pm * tstepA : cA; const char* nB = has_next ? (const char*)g.Bt + (size_t)nxt.pn * tstepB : cB;
        for (int t = 0; t < nt; t += 2) {
            const bool last = (t == nt - 2);
            const char* a1 = cA + (size_t)(t + 1) * kstep;
            const char* a2 = last ? nA : cA + (size_t)(t + 2) * kstep; const char* b2 = last ? nB : cB + (size_t)(t + 2) * kstep;
            const char* a3 = a2 + kstep; const char* b3 = b2 + kstep;
            if (last && has_next) S.a_ready(nxt);
            if constexpr (SP2) {
            PG8_LDB(B0, 0, 0); PG8_LDB(B1, 0, 1); PG8_SCHED; PG8_LDA(At, 0, 0); PG8_STAGE_A(PG8_SA(1, 1), a1, 1, vc0, vc1);
            if constexpr (GATHER) { if (last && has_next) { const u32x4 pv_ = *(const PG8_LAS u32x4*)(lds + 135168 + tid * 16); vc0[0] = pv_.x; vc0[1] = pv_.y; vc1[0] = pv_.z; vc1[1] = pv_.w; } }
            PG8_WAIT_V(8); PG8_WAIT_L(0); PG8_BAR; PG8_MMA(0, 0, At, B0); PG8_MMA(0, 1, At, B1); PG8_BAR; PG8_SCHED;
            PG8_LDA(At, 0, 1); PG8_STAGE(PG8_SB(0, 0), b2, voffB); PG8_STAGE(PG8_SB(0, 1), b2 + hstepB, voffB); PG8_STAGE_A(PG8_SA(0, 0), a2, 0, vc0, vc1);
            PG8_WAIT_V(8); PG8_WAIT_L(0); PG8_BAR; PG8_MMA(1, 0, At, B0); PG8_MMA(1, 1, At, B1); PG8_BAR; PG8_SCHED;
            PG8_LDB(B0, 1, 0); PG8_LDB(B1, 1, 1); PG8_SCHED; PG8_LDA(At, 1, 0); PG8_STAGE_A(PG8_SA(0, 1), a2, 1, vc0, vc1);
            PG8_WAIT_V(8); PG8_WAIT_L(0); PG8_BAR; PG8_MMA(0, 0, At, B0); PG8_MMA(0, 1, At, B1); PG8_BAR; PG8_SCHED;
            PG8_LDA(At, 1, 1); PG8_STAGE(PG8_SB(1, 0), b3, voffB); PG8_STAGE(PG8_SB(1, 1), b3 + hstepB, voffB); PG8_STAGE_A(PG8_SA(1, 0), a3, 0, vc0, vc1);
            PG8_WAIT_V(8); PG8_WAIT_L(0); PG8_BAR; PG8_MMA(1, 0, At, B0); PG8_MMA(1, 1, At, B1); PG8_BAR; PG8_SCHED;
            } else {
            PG8_LDB(B0, 0, 0); PG8_SCHED; PG8_LDA(At, 0, 0); PG8_STAGE(PG8_SA(1, 1), a1 + hstepA, voffA);
            PG8_WAIT_L(8); PG8_BAR; PG8_WAIT_L(0); PG8_MMA(0, 0, At, B0); PG8_BAR; PG8_SCHED;
            PG8_LDB(B1, 0, 1); PG8_STAGE(PG8_SB(0, 0), b2, voffB);
            PG8_BAR; PG8_WAIT_L(0); PG8_MMA(0, 1, At, B1); PG8_BAR;
            PG8_LDA(At, 0, 1); PG8_STAGE(PG8_SA(0, 0), a2, voffA);
            PG8_BAR; PG8_WAIT_L(0); PG8_MMA(1, 0, At, B0); PG8_BAR; PG8_SCHED;
            PG8_STAGE(PG8_SB(0, 1), b2 + hstepB, voffB);
            PG8_WAIT_V(6); PG8_BAR; PG8_MMA(1, 1, At, B1); PG8_BAR;
            PG8_LDB(B0, 1, 0); PG8_SCHED; PG8_LDA(At, 1, 0); PG8_STAGE(PG8_SA(0, 1), a2 + hstepA, voffA);
            PG8_WAIT_L(8); PG8_BAR; PG8_WAIT_L(0); PG8_MMA(0, 0, At, B0); PG8_BAR; PG8_SCHED;
            PG8_LDB(B1, 1, 1); PG8_STAGE(PG8_SB(1, 0), b3, voffB);
            PG8_BAR; PG8_WAIT_L(0); PG8_MMA(0, 1, At, B1); PG8_BAR;
            PG8_LDA(At, 1, 1); PG8_STAGE(PG8_SA(1, 0), a3, voffA);
            PG8_BAR; PG8_WAIT_L(0); PG8_MMA(1, 0, At, B0); PG8_BAR; PG8_SCHED;
            PG8_STAGE(PG8_SB(1, 1), b3 + hstepB, voffB);
            PG8_WAIT_V(6); PG8_BAR; PG8_MMA(1, 1, At, B1); PG8_BAR;
            }
        }
        if constexpr (ALIGN_EPI) { if (wr == 0) PG8_BAR; }
        if constexpr (!Epi::AFTER_DRAIN) { E(acc, cur, wr, wc, fr, fq); S.done(cur); }
        if (!has_next) break;
#pragma unroll
        for (int a = 0; a < 2; ++a)
#pragma unroll
            for (int b = 0; b < 2; ++b)
#pragma unroll
                for (int m = 0; m < 4; ++m)
#pragma unroll
                    for (int n = 0; n < 2; ++n) acc[a][b][m][n] = (f32x4){0.f, 0.f, 0.f, 0.f};
        cur = nxt; cA = nA; cB = nB; ++ui;
        if constexpr (ALIGN_EPI) { if (wr == 1) PG8_BAR; }
    }
    PG8_WAIT_V(0);
    if constexpr (!ALIGN_EPI) { if (wr == 0) PG8_BAR; }
    PG8_BAR;
    if constexpr (Epi::AFTER_DRAIN) { E.fused(acc, cur, wr, wc, fr, fq, lds, wid, lane); S.done(cur); }
#undef PG8_SA
#undef PG8_SB
#undef PG8_STAGE
#undef PG8_STAGE_A
#undef PG8_GLOAD
#undef PG8_LDA
#undef PG8_LDB
#undef PG8_MMA
#undef PG8_WAIT_V
#undef PG8_WAIT_L
#undef PG8_BAR
#undef PG8_SCHED
}
}

#include <hip/hip_bf16.h>
#include <cmath>
namespace attn_body {
using bf16=__hip_bfloat16;
using bf16x8=__attribute__((ext_vector_type(8)))short;
using s16x4=__attribute__((ext_vector_type(4)))short;
using f32x16=__attribute__((ext_vector_type(16)))float;
using u32x4=__attribute__((ext_vector_type(4)))unsigned;
constexpr int SEQ=4096,D=64,DM=1024,OPITCH=2048;
constexpr int NW=8,QBLK=32,QB=QBLK*NW,KVBLK=64,NQB=SEQ/QB;
constexpr int ATTN_PITCH=DM, ATTN_UNIT_ROWS=QB;
__device__ __forceinline__ int crow(int r,int hi){return (r&3)+8*(r>>2)+4*hi;}
#define SBAR() __builtin_amdgcn_sched_barrier(0)
__device__ __forceinline__ void cmask(f32x16&p0,f32x16&p1,int jb,int qrel,int hi){
  const float NEG=-INFINITY; int kb=64*jb+4*hi;
  #pragma unroll
  for(int r=0;r<16;++r){int kv=kb+(r&3)+8*(r>>2); if(kv>qrel)p0[r]=NEG; if(kv+32>qrel)p1[r]=NEG;}
}

constexpr int NSLOT=3, SLOTB=8192;
constexpr int LDS_K=0, LDS_V=NSLOT*SLOTB, LDS_WS=2*NSLOT*SLOTB, LDS_OST=LDS_WS+NW*64*4, LDS_BYTES=LDS_OST+NW*4096;
constexpr float C2=0.125f*1.4426950408889634f;
__device__ __forceinline__ void glds16(const void*gsrc,unsigned lds_dst){unsigned keep;
  asm volatile("s_mov_b32 %0, m0\n\ts_mov_b32 m0, %2\n\ts_nop 0\n\tglobal_load_lds_dwordx4 %1, off\n\ts_mov_b32 m0, %0":"=&s"(keep):"v"(gsrc),"s"(lds_dst):"memory");}
__device__ __forceinline__ float max3f(float a,float b,float c){float r;asm("v_max3_f32 %0, %1, %2, %3":"=v"(r):"v"(a),"v"(b),"v"(c));return r;}
__device__ __forceinline__ float max2f(float a,float b){float r;asm("v_max_f32_e32 %0, %1, %2":"=v"(r):"v"(a),"v"(b));return r;}
__device__ __forceinline__ float fadd_s(float a,float b){float r;asm("v_add_f32_e32 %0, %1, %2":"=v"(r):"v"(a),"v"(b));return r;}
__device__ __forceinline__ float fsub_s(float a,float b){float r;asm("v_sub_f32_e32 %0, %1, %2":"=v"(r):"v"(a),"v"(b));return r;}
typedef float f32x2_t __attribute__((ext_vector_type(2))); typedef __bf16 bf16x2_t __attribute__((ext_vector_type(2)));
__device__ __forceinline__ unsigned cvtpk_s(float lo,float hi){f32x2_t v={lo,hi};bf16x2_t b=__builtin_convertvector(v,bf16x2_t);return __builtin_bit_cast(unsigned,b);}
#define WAIT_BAR(N) asm volatile("s_waitcnt vmcnt(" #N ") lgkmcnt(0)\n\ts_barrier":::"memory")

__device__ __forceinline__ f32x16 mfma_z(bf16x8 a_,bf16x8 b_){ f32x16 d_; asm volatile("s_nop 1\n\tv_mfma_f32_32x32x16_bf16 %0, %1, %2, 0":"=&v"(d_):"v"(a_),"v"(b_)); return d_; }
__device__ __forceinline__ void qkt(f32x16&p0,f32x16&p1,const char*Kslot,const bf16x8*qr,int r32,int hi){
  const char*kb=Kslot+hi*1024+r32*16;
  #pragma unroll
  for(int d0=0;d0<4;++d0){
    const bf16x8 b0=*reinterpret_cast<const bf16x8*>(kb+d0*2048);
    const bf16x8 b1=*reinterpret_cast<const bf16x8*>(kb+d0*2048+512);
    if(d0==0){f32x16 z0=f32x16{},z1=f32x16{};asm volatile("":"+v"(z0),"+v"(z1));
      p0=__builtin_amdgcn_mfma_f32_32x32x16_bf16(b0,qr[0],z0,0,0,0);p1=__builtin_amdgcn_mfma_f32_32x32x16_bf16(b1,qr[0],z1,0,0,0);}
    else{p0=__builtin_amdgcn_mfma_f32_32x32x16_bf16(b0,qr[d0],p0,0,0,0);p1=__builtin_amdgcn_mfma_f32_32x32x16_bf16(b1,qr[d0],p1,0,0,0);}}
}
typedef __attribute__((address_space(3))) const char* lds_cptr;
typedef short v4i16_t __attribute__((ext_vector_type(4)));
__device__ __forceinline__ void kload8(bf16x8*kf,lds_cptr kp){
  kf[0]=*(const __attribute__((address_space(3))) bf16x8*)(kp);      kf[1]=*(const __attribute__((address_space(3))) bf16x8*)(kp+512);
  kf[2]=*(const __attribute__((address_space(3))) bf16x8*)(kp+2048); kf[3]=*(const __attribute__((address_space(3))) bf16x8*)(kp+2560);
  kf[4]=*(const __attribute__((address_space(3))) bf16x8*)(kp+4096); kf[5]=*(const __attribute__((address_space(3))) bf16x8*)(kp+4608);
  kf[6]=*(const __attribute__((address_space(3))) bf16x8*)(kp+6144); kf[7]=*(const __attribute__((address_space(3))) bf16x8*)(kp+6656);
}
__device__ __forceinline__ void kload2(bf16x8*kf,lds_cptr kp,int j){ kf[2*j]=*(const __attribute__((address_space(3))) bf16x8*)(kp+j*2048); kf[2*j+1]=*(const __attribute__((address_space(3))) bf16x8*)(kp+j*2048+512); }
__device__ __forceinline__ s16x4 vtr(lds_cptr p){ return __builtin_bit_cast(s16x4,__builtin_amdgcn_ds_read_tr16_b64_v4i16((__attribute__((address_space(3))) v4i16_t*)p)); }
__device__ __forceinline__ float rowmax(const f32x16&p0,const f32x16&p1){
  float a=max3f(p0[0],p0[1],p1[0]),b=max3f(p0[2],p0[3],p1[1]);a=max3f(a,p1[2],p1[3]);
  #pragma unroll
  for(int r=4;r<16;r+=4){a=max3f(a,p0[r],p0[r+1]);b=max3f(b,p0[r+2],p0[r+3]);a=max3f(a,p1[r],p1[r+1]);b=max3f(b,p1[r+2],p1[r+3]);}
  const float m=max2f(a,b);
  auto rr=__builtin_amdgcn_permlane32_swap(__float_as_uint(m),__float_as_uint(m),false,false);
  return max2f(__uint_as_float(rr[0]),__uint_as_float(rr[1]));
}
__device__ __forceinline__ void pv(f32x16*o,int vb,bf16x8 pa0,bf16x8 pa1,bf16x8 pa2,bf16x8 pa3){
  #pragma unroll
  for(int d0=0;d0<2;++d0){s16x4 lo[4],hi[4];
    #pragma unroll
    for(int ks=0;ks<4;++ks){
      asm volatile("ds_read_b64_tr_b16 %0,%1 offset:%c2":"=&v"(lo[ks]):"v"(vb),"i"(d0*4096+ks*1024):"memory");
      asm volatile("ds_read_b64_tr_b16 %0,%1 offset:%c2":"=&v"(hi[ks]):"v"(vb),"i"(d0*4096+ks*1024+512):"memory");}
    asm volatile("s_waitcnt lgkmcnt(0)":::"memory");SBAR();
    #define PK(k) (bf16x8){lo[k][0],lo[k][1],lo[k][2],lo[k][3],hi[k][0],hi[k][1],hi[k][2],hi[k][3]}
    o[d0]=__builtin_amdgcn_mfma_f32_32x32x16_bf16(pa0,PK(0),o[d0],0,0,0);
    o[d0]=__builtin_amdgcn_mfma_f32_32x32x16_bf16(pa1,PK(1),o[d0],0,0,0);
    o[d0]=__builtin_amdgcn_mfma_f32_32x32x16_bf16(pa2,PK(2),o[d0],0,0,0);
    o[d0]=__builtin_amdgcn_mfma_f32_32x32x16_bf16(pa3,PK(3),o[d0],0,0,0);
    #undef PK
  }
}

#ifndef ATTN_STORE16
#define ATTN_STORE16(p,v) (*(u32x4*)(p)=(v))
#endif
template<int THRL> __device__ __forceinline__ void attn_unit(int qb,const bf16*Qh,const bf16*__restrict__ Kh,const bf16*__restrict__ Vh,bf16*Oh,char*shm,const int tid_in){
  const int tid=tid_in,lane=tid&63,r32=lane&31,hi=lane>>5; const int wid=__builtin_amdgcn_readfirstlane(tid>>6);
  const int q0=qb*QB;
  const bf16*Qw=Qh+(long)(q0+wid*QBLK)*DM;
  const unsigned lds0=(unsigned)(uintptr_t)shm;
  float*wsf=(float*)(shm+LDS_WS)+wid*64;
  const bf16*ksrc=Kh+(long)lane*DM+wid*8;
  const bf16*vsrc=Vh+(long)(16*(wid&3)+(lane>>2))*DM+(wid>>2)*32+(lane&3)*8;
  const unsigned kdst=lds0+LDS_K+wid*1024, vdst=lds0+LDS_V+wid*1024;
  #define DMA_K(t,slot) glds16(ksrc+(long)(t)*KVBLK*DM,(unsigned)__builtin_amdgcn_readfirstlane(kdst+(slot)))
  #define DMA_V(t,slot) glds16(vsrc+(long)(t)*KVBLK*DM,(unsigned)__builtin_amdgcn_readfirstlane(vdst+(slot)))
  const int vb0=(int)(lds0+LDS_V)+((lane>>4)&1)*32+(lane&3)*8+(4*hi+((lane&15)>>2))*64;
  const char*Kbase=shm+LDS_K; bf16x8 kf[8];
  const lds_cptr shm3=(lds_cptr)shm; const lds_cptr kp0=shm3+LDS_K+hi*1024+r32*16; const lds_cptr vp0=shm3+LDS_V+((lane>>4)&1)*32+(lane&3)*8+(4*hi+((lane&15)>>2))*64;
  const int NT=(q0+QB)/KVBLK;
  DMA_K(0,0);DMA_V(0,0);DMA_K(1,SLOTB);
  bf16x8 qr[4];
  #pragma unroll
  for(int d0=0;d0<4;++d0)qr[d0]=*reinterpret_cast<const bf16x8*>(&Qw[(long)r32*DM+d0*16+hi*8]);
  float mhat=0.f,l_reg=0.f;f32x16 o[2];o[0]=f32x16{};o[1]=f32x16{};
  const int qrel=wid*QBLK+r32;
  #define CMASK(P0,P1,t) do{int jb_=(t)-(NT-4); if(jb_>=0)cmask(P0,P1,jb_,qrel,hi);}while(0)
  bool resc=false;
  #define START(P0,P1) do{ const float rm=rowmax(P0,P1); resc=false; \
    { const float dl=rm; mhat=fadd_s(mhat,dl); \
      _Pragma("unroll") for(int r=0;r<16;++r){P0[r]=fsub_s(P0[r],dl);P1[r]=fsub_s(P1[r],dl);} \
      } \
    _Pragma("unroll") for(int r=0;r<16;++r)P0[r]=__builtin_amdgcn_exp2f(P0[r]); }while(0)
  #define RESC() do{ if(resc){ asm volatile("s_waitcnt lgkmcnt(0)":::"memory"); \
      _Pragma("unroll") for(int d_=0;d_<2;++d_) _Pragma("unroll") for(int r=0;r<16;++r)o[d_][r]*=wsf[crow(r,hi)]; } }while(0)
  f32x16 pA0,pA1,pB0,pB1;
  int sl_prev=0,sl_cur=0,sl_next=SLOTB;
  #define ROT() do{sl_prev=sl_cur;sl_cur=sl_next;sl_next=(sl_next==(NSLOT-1)*SLOTB)?0:sl_next+SLOTB;}while(0)
  DMA_K(2,2*SLOTB);
  WAIT_BAR(3);
  qkt(pA0,pA1,Kbase,qr,r32,hi);asm volatile("s_nop 15\n\ts_nop 7":"+v"(pA0),"+v"(pA1));CMASK(pA0,pA1,0);
  START(pA0,pA1);
  _Pragma("unroll") for(int r=0;r<16;++r)pA1[r]=__builtin_amdgcn_exp2f(pA1[r]);
  WAIT_BAR(0);
  DMA_K(3,0);DMA_V(1,SLOTB);
  ROT();
  kload8(kf,kp0+sl_cur);
  WAIT_BAR(2);
  s16x4 vlo[8],vhi[8]; u32x4 pw0,pw1,pw2,pw3;
  #define PKW(P,B) cvtpk_s(P[B],P[B+1])
  #define PAF(k) __builtin_bit_cast(bf16x8,pw##k)
  #define VFR(i) (bf16x8){vlo[i][0],vlo[i][1],vlo[i][2],vlo[i][3],vhi[i][0],vhi[i][1],vhi[i][2],vhi[i][3]}
  #define PIN(x) asm volatile("":"+v"(x))
  #define MX3(a,b,c) __builtin_fmaxf(__builtin_fmaxf((a),(b)),(c))
  #define GAPA(MF,A0,A1,A2,A3,W0,W1,PW) do{ MF; sacc+=A0; sacc+=A1; sacc+=A2; sacc+=A3; PIN(sacc); W0; W1; PIN(PW); SBAR(); }while(0)
  #define EX(v) __builtin_amdgcn_exp2f(v)
  #define GAPB(MF,X,B) do{ MF; X[B]=EX(fsub_s(X[B],mhat)); X[B+1]=EX(fsub_s(X[B+1],mhat)); X[B+2]=EX(fsub_s(X[B+2],mhat)); X[B+3]=EX(fsub_s(X[B+3],mhat)); PIN(X); SBAR(); }while(0)
  #define VRD(i) do{ vlo[i]=vtr(vp_+(((i)>>2)*4096+((i)&3)*1024)); vhi[i]=vtr(vp_+(((i)>>2)*4096+((i)&3)*1024+512)); }while(0)
  #define KRD(G,j) do{ if(G){ kload2(kf,kp0+sl_next,j); SBAR(); } }while(0)
  #define STEP(C0,C1,P0,P1,t,GK,GV,GL) do{ SBAR(); \
    const lds_cptr vp_=vp0+sl_prev; \
    VRD(0); SBAR(); float sacc=(P0[0]+P0[1]); \
    GAPA(C0=mfma_z(kf[0],qr[0]), P0[2],P0[3],P0[4],P0[5],     pw0[0]=PKW(P0,0), pw0[1]=PKW(P0,2), pw0); \
    VRD(4); SBAR(); GAPA(C1=mfma_z(kf[1],qr[0]), P0[6],P0[7],P0[8],P0[9],     pw0[2]=PKW(P0,4), pw0[3]=PKW(P0,6), pw0); \
    VRD(1); SBAR(); GAPA(C0=__builtin_amdgcn_mfma_f32_32x32x16_bf16(kf[2],qr[1],C0,0,0,0),   P0[10],P0[11],P0[12],P0[13], pw1[0]=PKW(P0,8), pw1[1]=PKW(P0,10), pw1); \
    VRD(5); SBAR(); GAPA(C1=__builtin_amdgcn_mfma_f32_32x32x16_bf16(kf[3],qr[1],C1,0,0,0),   P0[14],P0[15],P1[0],P1[1],   pw1[2]=PKW(P0,12),pw1[3]=PKW(P0,14), pw1); \
    VRD(2); SBAR(); GAPA(C0=__builtin_amdgcn_mfma_f32_32x32x16_bf16(kf[4],qr[2],C0,0,0,0),   P1[2],P1[3],P1[4],P1[5],     pw2[0]=PKW(P1,0), pw2[1]=PKW(P1,2), pw2); \
    VRD(6); SBAR(); GAPA(C1=__builtin_amdgcn_mfma_f32_32x32x16_bf16(kf[5],qr[2],C1,0,0,0),   P1[6],P1[7],P1[8],P1[9],     pw2[2]=PKW(P1,4), pw2[3]=PKW(P1,6), pw2); \
    VRD(3); SBAR(); GAPA(C0=__builtin_amdgcn_mfma_f32_32x32x16_bf16(kf[6],qr[3],C0,0,0,0),   P1[10],P1[11],P1[12],P1[13], pw3[0]=PKW(P1,8), pw3[1]=PKW(P1,10), pw3); \
    VRD(7); SBAR(); GAPA(C1=__builtin_amdgcn_mfma_f32_32x32x16_bf16(kf[7],qr[3],C1,0,0,0),   P1[14],P1[15],0.f,0.f,       pw3[2]=PKW(P1,12),pw3[3]=PKW(P1,14), pw3); \
    l_reg+=sacc; \
    if(GK){DMA_K((t)+3,sl_cur);} if(GV){DMA_V((t)+1,sl_next);} \
    CMASK(C0,C1,t); \
    { float a=MX3(C0[0],C0[1],C1[0]),b=MX3(C0[2],C0[3],C1[1]); a=MX3(a,C1[2],C1[3]); \
      _Pragma("unroll") for(int r=4;r<16;r+=4){a=MX3(a,C0[r],C0[r+1]);b=MX3(b,C0[r+2],C0[r+3]);a=MX3(a,C1[r],C1[r+1]);b=MX3(b,C1[r+2],C1[r+3]);} \
      float rm=__builtin_fmaxf(a,b); { auto rr=__builtin_amdgcn_permlane32_swap(__float_as_uint(rm),__float_as_uint(rm),false,false); rm=__builtin_fmaxf(__uint_as_float(rr[0]),__uint_as_float(rr[1])); } \
      resc=false; \
      const float rel=rm-mhat; \
      if(__builtin_expect(__any(rel>(float)THRL),0)){ const float dl=__builtin_fmaxf(rel,0.f); mhat+=dl; \
        const float f=__builtin_amdgcn_exp2f(-dl); l_reg*=f; if(hi==0)wsf[r32]=f; resc=true; } } \
    SBAR(); \
    GAPB(o[0]=__builtin_amdgcn_mfma_f32_32x32x16_bf16(PAF(0),VFR(0),o[0],0,0,0), C0,0); \
    GAPB(o[1]=__builtin_amdgcn_mfma_f32_32x32x16_bf16(PAF(0),VFR(4),o[1],0,0,0), C0,4); \
    KRD(GL,0); GAPB(o[0]=__builtin_amdgcn_mfma_f32_32x32x16_bf16(PAF(1),VFR(1),o[0],0,0,0), C0,8); \
    KRD(GL,1); GAPB(o[1]=__builtin_amdgcn_mfma_f32_32x32x16_bf16(PAF(1),VFR(5),o[1],0,0,0), C0,12); \
    KRD(GL,2); GAPB(o[0]=__builtin_amdgcn_mfma_f32_32x32x16_bf16(PAF(2),VFR(2),o[0],0,0,0), C1,0); \
    KRD(GL,3); GAPB(o[1]=__builtin_amdgcn_mfma_f32_32x32x16_bf16(PAF(2),VFR(6),o[1],0,0,0), C1,4); \
    GAPB(o[0]=__builtin_amdgcn_mfma_f32_32x32x16_bf16(PAF(3),VFR(3),o[0],0,0,0), C1,8); \
    GAPB(o[1]=__builtin_amdgcn_mfma_f32_32x32x16_bf16(PAF(3),VFR(7),o[1],0,0,0), C1,12); \
    }while(0)
  int t=1;
  #undef CMASK
  #define CMASK(P0,P1,t) do{}while(0)
  for(;t+5<NT;t+=2){
    STEP(pB0,pB1,pA0,pA1,t,true,true,true);     WAIT_BAR(2); RESC(); ROT();
    STEP(pA0,pA1,pB0,pB1,t+1,true,true,true);   WAIT_BAR(2); RESC(); ROT();
  }
  #undef CMASK
  #define CMASK(P0,P1,t) do{int jb_=(t)-(NT-4); if(jb_>=0)cmask(P0,P1,jb_,qrel,hi);}while(0)
  #define ENDW(tt) do{ if((tt)+3<NT){WAIT_BAR(2);} else if((tt)+2<NT){WAIT_BAR(1);} else {WAIT_BAR(0);} }while(0)
  for(;t+1<NT;t+=2){
    STEP(pB0,pB1,pA0,pA1,t,(t+3<NT),(t+1<NT),(t+1<NT));       ENDW(t);   RESC(); ROT();
    STEP(pA0,pA1,pB0,pB1,t+1,(t+4<NT),(t+2<NT),(t+2<NT));     ENDW(t+1); RESC(); ROT();
  }
  STEP(pB0,pB1,pA0,pA1,NT-1,false,false,false); RESC();
  { float sacc=pB0[0]+pB0[1]; _Pragma("unroll") for(int r=2;r<16;++r)sacc+=pB0[r]; _Pragma("unroll") for(int r=0;r<16;++r)sacc+=pB1[r]; l_reg+=sacc;
    pw0=(u32x4){PKW(pB0,0),PKW(pB0,2),PKW(pB0,4),PKW(pB0,6)};pw1=(u32x4){PKW(pB0,8),PKW(pB0,10),PKW(pB0,12),PKW(pB0,14)};pw2=(u32x4){PKW(pB1,0),PKW(pB1,2),PKW(pB1,4),PKW(pB1,6)};pw3=(u32x4){PKW(pB1,8),PKW(pB1,10),PKW(pB1,12),PKW(pB1,14)};
    SBAR(); pv(o,vb0+sl_cur,PAF(0),PAF(1),PAF(2),PAF(3)); }
  #undef PKW
  #undef PAF
  #undef VFR
  #undef PIN
  #undef MX3
  #undef GAPA
  #undef GAPB
  #undef EX
  #undef VRD
  #undef KRD
  #undef STEP
  #undef ENDW
  l_reg+=__uint_as_float((unsigned)__builtin_amdgcn_ds_bpermute((lane^32)<<2,(int)__float_as_uint(l_reg)));
  if(hi==0)wsf[32+r32]=l_reg;asm volatile("s_waitcnt lgkmcnt(0)":::"memory");
  float rli[16];
  #pragma unroll
  for(int r=0;r<16;++r)rli[r]=__builtin_amdgcn_rcpf(wsf[32+crow(r,hi)]);
  bf16*Ow=Oh+(long)(q0+wid*QBLK)*OPITCH;
  { bf16*stg=(bf16*)(shm+LDS_OST)+wid*2048;
    #pragma unroll
    for(int r=0;r<16;++r){const int orow=crow(r,hi);
      #pragma unroll
      for(int d0=0;d0<2;++d0)stg[orow*64+d0*32+r32]=__float2bfloat16(o[d0][r]*rli[r]);}
    asm volatile("s_waitcnt lgkmcnt(0)":::"memory");
    #pragma unroll
    for(int i=0;i<4;++i){const int row=i*8+(lane>>3),ch=lane&7; const u32x4 v=*(const u32x4*)(stg+row*64+ch*8); ATTN_STORE16(Ow+(long)row*OPITCH+ch*8,v);} }
  asm volatile("s_waitcnt lgkmcnt(0)\n\ts_barrier":::"memory");
  #undef DMA_K
  #undef DMA_V
  #undef CMASK
  #undef START
  #undef RESC
  #undef ROT
}

__device__ __forceinline__ float rowmax_cv(const f32x16&p0,const f32x16&p1){
  float a=__builtin_fmaxf(p0[0],p1[0]);
  #pragma unroll
  for(int r=1;r<16;++r){a=__builtin_fmaxf(a,p0[r]);a=__builtin_fmaxf(a,p1[r]);}
  auto rr=__builtin_amdgcn_permlane32_swap(__float_as_uint(a),__float_as_uint(a),false,false);
  return __builtin_fmaxf(__uint_as_float(rr[0]),__uint_as_float(rr[1]));
}
__device__ __forceinline__ void attn_unit_simple(int qb,const bf16*Qh,const bf16*__restrict__ Kh,const bf16*__restrict__ Vh,bf16*Oh,char*shm,const int tid_in){
  const int tid=tid_in,lane=tid&63,r32=lane&31,hi=lane>>5; const int wid=__builtin_amdgcn_readfirstlane(tid>>6);
  const int q0=qb*QB;
  const bf16*Qw=Qh+(long)(q0+wid*QBLK)*DM;
  const unsigned lds0=(unsigned)(uintptr_t)shm;
  float*wsf=(float*)(shm+LDS_WS)+wid*64;
  const bf16*ksrc=Kh+(long)lane*DM+wid*8;
  const bf16*vsrc=Vh+(long)(16*(wid&3)+(lane>>2))*DM+(wid>>2)*32+(lane&3)*8;
  u32x4*kdstp=(u32x4*)(shm+LDS_K+wid*1024+lane*16); u32x4*vdstp=(u32x4*)(shm+LDS_V+wid*1024+lane*16);
  const int vb0=(int)(lds0+LDS_V)+((lane>>4)&1)*32+(lane&3)*8+(4*hi+((lane&15)>>2))*64;
  const char*Kbase=shm+LDS_K;
  const int NT=(q0+QB)/KVBLK;
  bf16x8 qr[4];
  #pragma unroll
  for(int d0=0;d0<4;++d0)qr[d0]=*reinterpret_cast<const bf16x8*>(&Qw[(long)r32*DM+d0*16+hi*8]);
  float m_run=-1e30f,l_reg=0.f; f32x16 o[2]; o[0]=f32x16{}; o[1]=f32x16{};
  const int qrel=wid*QBLK+r32;
  u32x4 kreg=*(const u32x4*)ksrc, vreg=*(const u32x4*)vsrc;
  for(int t=0;t<NT;++t){
    *kdstp=kreg; *vdstp=vreg;
    if(t+1<NT){ kreg=*(const u32x4*)(ksrc+(long)(t+1)*KVBLK*DM); vreg=*(const u32x4*)(vsrc+(long)(t+1)*KVBLK*DM); }
    __syncthreads();
    f32x16 p0,p1;
    qkt(p0,p1,Kbase,qr,r32,hi);
    { const int jb=t-(NT-4); if(jb>=0){ const float NEG=-INFINITY; const int kb=64*jb+4*hi;
        #pragma unroll
        for(int r=0;r<16;++r){const int kv=kb+(r&3)+8*(r>>2); if(kv>qrel)p0[r]=NEG; if(kv+32>qrel)p1[r]=NEG;} } }
    const float rm=rowmax_cv(p0,p1);
    const float mn=__builtin_fmaxf(m_run,rm); const float alpha=__builtin_amdgcn_exp2f(m_run-mn); m_run=mn;
    float sacc=0.f;
    #pragma unroll
    for(int r=0;r<16;++r){p0[r]=__builtin_amdgcn_exp2f(p0[r]-mn);p1[r]=__builtin_amdgcn_exp2f(p1[r]-mn);sacc+=p0[r]+p1[r];}
    l_reg=l_reg*alpha+sacc;
    if(hi==0)wsf[r32]=alpha;
    asm volatile("s_waitcnt lgkmcnt(0)":::"memory");
    #pragma unroll
    for(int d_=0;d_<2;++d_)
      #pragma unroll
      for(int r=0;r<16;++r)o[d_][r]*=wsf[crow(r,hi)];
    u32x4 pw0,pw1,pw2,pw3;
    #define PKW2(P,B) cvtpk_s(P[B],P[B+1])
    pw0=(u32x4){PKW2(p0,0),PKW2(p0,2),PKW2(p0,4),PKW2(p0,6)};pw1=(u32x4){PKW2(p0,8),PKW2(p0,10),PKW2(p0,12),PKW2(p0,14)};
    pw2=(u32x4){PKW2(p1,0),PKW2(p1,2),PKW2(p1,4),PKW2(p1,6)};pw3=(u32x4){PKW2(p1,8),PKW2(p1,10),PKW2(p1,12),PKW2(p1,14)};
    #undef PKW2
    pv(o,vb0,__builtin_bit_cast(bf16x8,pw0),__builtin_bit_cast(bf16x8,pw1),__builtin_bit_cast(bf16x8,pw2),__builtin_bit_cast(bf16x8,pw3));
    asm volatile("s_waitcnt lgkmcnt(0)":::"memory");
    __syncthreads();
  }
  l_reg+=__uint_as_float((unsigned)__builtin_amdgcn_ds_bpermute((lane^32)<<2,(int)__float_as_uint(l_reg)));
  if(hi==0)wsf[32+r32]=l_reg;asm volatile("s_waitcnt lgkmcnt(0)":::"memory");
  float rli[16];
  #pragma unroll
  for(int r=0;r<16;++r)rli[r]=__builtin_amdgcn_rcpf(wsf[32+crow(r,hi)]);
  bf16*Ow=Oh+(long)(q0+wid*QBLK)*OPITCH;
  { bf16*stg=(bf16*)(shm+LDS_OST)+wid*2048;
    #pragma unroll
    for(int r=0;r<16;++r){const int orow=crow(r,hi);
      #pragma unroll
      for(int d0=0;d0<2;++d0)stg[orow*64+d0*32+r32]=__float2bfloat16(o[d0][r]*rli[r]);}
    asm volatile("s_waitcnt lgkmcnt(0)":::"memory");
    #pragma unroll
    for(int i=0;i<4;++i){const int row=i*8+(lane>>3),ch=lane&7; const u32x4 v=*(const u32x4*)(stg+row*64+ch*8); ATTN_STORE16(Ow+(long)row*OPITCH+ch*8,v);} }
  asm volatile("s_waitcnt vmcnt(0) lgkmcnt(0)":::"memory");
  __syncthreads();
}

constexpr int DA_SLOT=32768, DA_V=16384, DA_WS=98304, DA_ROWS=128;
__device__ __forceinline__ f32x16 mfma_c(bf16x8 a_,bf16x8 b_,const f32x16&c_){ f32x16 d_; asm volatile("s_nop 1\n\tv_mfma_f32_32x32x16_bf16 %0, %1, %2, %3":"=&v"(d_):"v"(a_),"v"(b_),"v"(c_)); return d_; }
template<int THRL> __device__ __forceinline__ void dattn_unit(int qblk,const bf16*Qb,const bf16*__restrict__ Kb,const bf16*__restrict__ Vb,bf16*Yb,float lam,const float*gsub,float gscale,char*shm,const int tid_in){
  const int tid=tid_in,lane=tid&63,r32=lane&31,hi=lane>>5; const int wid=__builtin_amdgcn_readfirstlane(tid>>6);
  const int c=wid>>2, rg=wid&3;
  const int q0=qblk*DA_ROWS; const int NT=(q0+DA_ROWS)/KVBLK;
  const bf16*Qw=Qb+c*64+(long)(q0+rg*32)*DM;
  const unsigned lds0=(unsigned)(uintptr_t)shm; const lds_cptr shm3=(lds_cptr)shm;
  float*wsf=(float*)(shm+DA_WS)+wid*64;
  const int pk0=2*wid;
  const bf16*ksrc0=Kb+(pk0>>3)*64+(long)lane*DM+(pk0&7)*8;
  const unsigned kdst0=lds0+(pk0>>3)*8192+(pk0&7)*1024;
  const bf16*vsrc0=Vb+(long)(16*(pk0&3)+(lane>>2))*DM+(pk0>>2)*32+(lane&3)*8;
  const unsigned vdst0=lds0+DA_V+pk0*1024;
  #define DA_RFL(x) ((unsigned)__builtin_amdgcn_readfirstlane((int)(x)))
  #define DA_DMA(t,so) do{ const long to_=(long)(t)*KVBLK*DM; \
      glds16(ksrc0+to_,DA_RFL(kdst0+(so))); glds16(ksrc0+to_+8,DA_RFL(kdst0+(so)+1024)); \
      glds16(vsrc0+to_,DA_RFL(vdst0+(so))); glds16(vsrc0+to_+16*DM,DA_RFL(vdst0+(so)+1024)); }while(0)
  const lds_cptr kp0=shm3+c*8192+hi*1024+r32*16;
  const lds_cptr vp0=shm3+DA_V+((lane>>4)&1)*32+(lane&3)*8+(4*hi+((lane&15)>>2))*64;
  bf16x8 qr[4];
  #pragma unroll
  DA_DMA(0,0); if(NT>1){ DA_DMA(1,DA_SLOT); }
  #pragma unroll
  for(int d0=0;d0<4;++d0)qr[d0]=*reinterpret_cast<const bf16x8*>(&Qw[(long)r32*DM+d0*16+hi*8]);
  asm volatile("":"+v"(qr[0]),"+v"(qr[1]),"+v"(qr[2]),"+v"(qr[3]));
  float mhat=0.f,l_reg=0.f; f32x16 o[4]; o[0]=f32x16{}; o[1]=f32x16{}; o[2]=f32x16{}; o[3]=f32x16{};
  f32x16 negm;
  #pragma unroll
  for(int r=0;r<16;++r)negm[r]=0.f;
  const int qrel=rg*32+r32;
  int slot=0;
  for(int t=0;t<NT;++t){
    if(t+1<NT){ asm volatile("s_waitcnt vmcnt(4) lgkmcnt(0)\n\ts_barrier":::"memory"); } else { asm volatile("s_waitcnt vmcnt(0) lgkmcnt(0)\n\ts_barrier":::"memory"); }
    if(t+2<NT){ int s2=slot+2*DA_SLOT; if(s2>=3*DA_SLOT)s2-=3*DA_SLOT; DA_DMA(t+2,s2); }
    const lds_cptr kp=kp0+slot;
    f32x16 p0,p1;
    { const bf16x8 k0=*(const __attribute__((address_space(3))) bf16x8*)(kp), k1=*(const __attribute__((address_space(3))) bf16x8*)(kp+512);
      p0=mfma_c(k0,qr[0],negm); p1=mfma_c(k1,qr[0],negm); }
    #pragma unroll
    for(int d0=1;d0<4;++d0){ const bf16x8 k0=*(const __attribute__((address_space(3))) bf16x8*)(kp+d0*2048), k1=*(const __attribute__((address_space(3))) bf16x8*)(kp+d0*2048+512);
      p0=__builtin_amdgcn_mfma_f32_32x32x16_bf16(k0,qr[d0],p0,0,0,0); p1=__builtin_amdgcn_mfma_f32_32x32x16_bf16(k1,qr[d0],p1,0,0,0); }
    { const int jb=t-(NT-2); if(jb>=0){ const float NEG=-INFINITY; const int kb=64*jb+4*hi;
        #pragma unroll
        for(int r=0;r<16;++r){const int kv=kb+(r&3)+8*(r>>2); if(kv>qrel)p0[r]=NEG; if(kv+32>qrel)p1[r]=NEG;} } }
    float rm=__builtin_fmaxf(p0[0],p1[0]);
    #pragma unroll
    for(int r=1;r<16;++r){rm=__builtin_fmaxf(rm,p0[r]);rm=__builtin_fmaxf(rm,p1[r]);}
    rm=__builtin_fmaxf(rm,__uint_as_float((unsigned)__builtin_amdgcn_ds_bpermute((lane^32)<<2,(int)__float_as_uint(rm))));
    if(t==0){
      mhat=rm;
      #pragma unroll
      for(int r=0;r<16;++r){p0[r]-=rm;p1[r]-=rm;negm[r]=-rm;}
    } else if(__any(rm>(float)THRL)){
      const float dl=__builtin_fmaxf(rm,0.f); const float f=__builtin_amdgcn_exp2f(-dl); mhat+=dl; l_reg*=f;
      #pragma unroll
      for(int r=0;r<16;++r){p0[r]-=dl;p1[r]-=dl;negm[r]=-mhat;}
      if(hi==0)wsf[r32]=f;
      asm volatile("s_waitcnt lgkmcnt(0)":::"memory");
      #pragma unroll
      for(int d_=0;d_<4;++d_)
        #pragma unroll
        for(int r=0;r<16;++r)o[d_][r]*=wsf[crow(r,hi)];
    }
    float sacc=0.f;
    #pragma unroll
    for(int r=0;r<16;++r){p0[r]=__builtin_amdgcn_exp2f(p0[r]);p1[r]=__builtin_amdgcn_exp2f(p1[r]);sacc+=p0[r]+p1[r];}
    l_reg+=sacc;
    u32x4 pw0,pw1,pw2,pw3;
    pw0=(u32x4){cvtpk_s(p0[0],p0[1]),cvtpk_s(p0[2],p0[3]),cvtpk_s(p0[4],p0[5]),cvtpk_s(p0[6],p0[7])}; pw1=(u32x4){cvtpk_s(p0[8],p0[9]),cvtpk_s(p0[10],p0[11]),cvtpk_s(p0[12],p0[13]),cvtpk_s(p0[14],p0[15])};
    pw2=(u32x4){cvtpk_s(p1[0],p1[1]),cvtpk_s(p1[2],p1[3]),cvtpk_s(p1[4],p1[5]),cvtpk_s(p1[6],p1[7])}; pw3=(u32x4){cvtpk_s(p1[8],p1[9]),cvtpk_s(p1[10],p1[11]),cvtpk_s(p1[12],p1[13]),cvtpk_s(p1[14],p1[15])};
    const lds_cptr vp=vp0+slot;
    #pragma unroll
    for(int d0=0;d0<4;++d0){
      #define DA_VF(ks) ({ const s16x4 lo_=vtr(vp+d0*4096+(ks)*1024), hi_=vtr(vp+d0*4096+(ks)*1024+512); (bf16x8){lo_[0],lo_[1],lo_[2],lo_[3],hi_[0],hi_[1],hi_[2],hi_[3]}; })
      o[d0]=__builtin_amdgcn_mfma_f32_32x32x16_bf16(__builtin_bit_cast(bf16x8,pw0),DA_VF(0),o[d0],0,0,0);
      o[d0]=__builtin_amdgcn_mfma_f32_32x32x16_bf16(__builtin_bit_cast(bf16x8,pw1),DA_VF(1),o[d0],0,0,0);
      o[d0]=__builtin_amdgcn_mfma_f32_32x32x16_bf16(__builtin_bit_cast(bf16x8,pw2),DA_VF(2),o[d0],0,0,0);
      o[d0]=__builtin_amdgcn_mfma_f32_32x32x16_bf16(__builtin_bit_cast(bf16x8,pw3),DA_VF(3),o[d0],0,0,0);
      #undef DA_VF
    }
    slot+=DA_SLOT; if(slot>=3*DA_SLOT)slot=0;
  }
  int lane_e=lane; asm volatile("":"+v"(lane_e)); const int r32e=lane_e&31, hie=lane_e>>5;
  l_reg+=__uint_as_float((unsigned)__builtin_amdgcn_ds_bpermute((lane^32)<<2,(int)__float_as_uint(l_reg)));
  asm volatile("s_waitcnt vmcnt(0) lgkmcnt(0)\n\ts_barrier":::"memory");
  if(hie==0)wsf[32+r32e]=l_reg; asm volatile("s_waitcnt lgkmcnt(0)":::"memory");
  float rli[16];
  #pragma unroll
  for(int r=0;r<16;++r)rli[r]=__builtin_amdgcn_rcpf(wsf[32+crow(r,hie)]);
  float*st2=(float*)shm+rg*4096;
  if(c==1){
    #pragma unroll
    for(int d0=0;d0<4;++d0)
      #pragma unroll
      for(int r=0;r<16;++r)st2[crow(r,hie)*128+d0*32+r32e]=lam*o[d0][r]*rli[r];
  }
  asm volatile("s_waitcnt lgkmcnt(0)\n\ts_barrier":::"memory");
  if(c==0){
    float ssq[16];
    #pragma unroll
    for(int r=0;r<16;++r){ float a_=0.f;
      #pragma unroll
      for(int d0=0;d0<4;++d0){ const float x_=o[d0][r]*rli[r]-st2[crow(r,hie)*128+d0*32+r32e]; o[d0][r]=x_; a_+=x_*x_; }
      a_+=__uint_as_float((unsigned)__builtin_amdgcn_ds_swizzle((int)__float_as_uint(a_),(1<<10)|0x1f)); a_+=__uint_as_float((unsigned)__builtin_amdgcn_ds_swizzle((int)__float_as_uint(a_),(2<<10)|0x1f));
      a_+=__uint_as_float((unsigned)__builtin_amdgcn_ds_swizzle((int)__float_as_uint(a_),(4<<10)|0x1f)); a_+=__uint_as_float((unsigned)__builtin_amdgcn_ds_swizzle((int)__float_as_uint(a_),(8<<10)|0x1f));
      a_+=__uint_as_float((unsigned)__builtin_amdgcn_ds_swizzle((int)__float_as_uint(a_),(16<<10)|0x1f));
      ssq[r]=1.0f/__builtin_sqrtf(a_*(1.0f/128.0f)+1e-5f); }
    float g4[4];
    #pragma unroll
    for(int d0=0;d0<4;++d0)g4[d0]=gsub[d0*32+r32e]*gscale;
    bf16*stg=(bf16*)(shm+65536)+rg*4096;
    #pragma unroll
    for(int r=0;r<16;++r)
      #pragma unroll
      for(int d0=0;d0<4;++d0)stg[crow(r,hie)*128+d0*32+r32e]=__float2bfloat16(o[d0][r]*ssq[r]*g4[d0]);
    asm volatile("s_waitcnt lgkmcnt(0)":::"memory");
    bf16*Yw=Yb+(long)(q0+rg*32)*DM;
    #pragma unroll
    for(int i=0;i<8;++i){const int row=i*4+(lane_e>>4),ch=lane_e&15; const u32x4 v=*(const u32x4*)(stg+row*128+ch*8); *(u32x4*)(Yw+(long)row*DM+ch*8)=v;}
  }
  asm volatile("s_waitcnt vmcnt(0) lgkmcnt(0)\n\ts_barrier":::"memory");
  #undef DA_DMA
  #undef DA_RFL
}
#ifndef DB_VPRE
#define DB_VPRE 0
#endif
#ifndef DB_FILLX
#define DB_FILLX 0
#endif
template<int THRL> __device__ __forceinline__ void dattn2_unit(int qblk,const bf16*Qb,const bf16*__restrict__ Kb,const bf16*__restrict__ Vb,bf16*Yb,float lam,const float*gsub,float gscale,char*shm,const int tid_in){
  const int tid=tid_in,lane=tid&63,r32=lane&31,hi=lane>>5; const int wid=__builtin_amdgcn_readfirstlane(tid>>6);
  const int c=wid>>2, rg=wid&3;
  const int q0=qblk*DA_ROWS; const int NT=(q0+DA_ROWS)/KVBLK;
  const bf16*Qw=Qb+c*64+(long)(q0+rg*32)*DM;
  const unsigned lds0=(unsigned)(uintptr_t)shm; const lds_cptr shm3=(lds_cptr)shm;
  const int pk0=2*wid;
  const bf16*ksrc0=Kb+(pk0>>3)*64+(long)((pk0&7)*8+(lane>>3))*DM+((lane&7)^((lane>>3)&7))*8;
  const unsigned kdst0=lds0+(pk0>>3)*8192+(pk0&7)*1024;
  const bf16*vsrc0=Vb+(long)(16*(pk0&3)+(lane>>2))*DM+(pk0>>2)*32+(lane&3)*8;
  const unsigned vdst0=lds0+DA_V+pk0*1024;
  #define DB_RFL(x) ((unsigned)__builtin_amdgcn_readfirstlane((int)(x)))
  #define DB_DMA(t,so) do{ const long to_=(long)(t)*KVBLK*DM; \
      glds16(ksrc0+to_,DB_RFL(kdst0+(so))); glds16(ksrc0+to_+8*DM,DB_RFL(kdst0+(so)+1024)); \
      glds16(vsrc0+to_,DB_RFL(vdst0+(so))); glds16(vsrc0+to_+16*DM,DB_RFL(vdst0+(so)+1024)); }while(0)
  #define DB_SLOT(t) (((t)&3)*DA_SLOT)
  const lds_cptr kp0=shm3+c*8192+r32*128+((hi^(r32&7))*16);
  #define DB_KLD(kf_,kp_,d0) do{ const lds_cptr a_=(lds_cptr)(size_t)(((unsigned)(size_t)(kp_))^((unsigned)(d0)<<5)); kf_[2*(d0)]=*(const __attribute__((address_space(3))) bf16x8*)(a_); kf_[2*(d0)+1]=*(const __attribute__((address_space(3))) bf16x8*)(a_+4096); }while(0)
  const lds_cptr vp0=shm3+DA_V+((lane>>4)&1)*32+(lane&3)*8+(4*hi+((lane&15)>>2))*64;
  bf16x8 qr[4];
  DB_DMA(0,0); DB_DMA(1,DA_SLOT);
  #pragma unroll
  for(int d0=0;d0<4;++d0)qr[d0]=*reinterpret_cast<const bf16x8*>(&Qw[(long)r32*DM+d0*16+hi*8]);
  asm volatile("":"+v"(qr[0]),"+v"(qr[1]),"+v"(qr[2]),"+v"(qr[3]));
  float mref=0.f,l_reg=0.f; f32x16 o[4]; o[0]=f32x16{}; o[1]=f32x16{}; o[2]=f32x16{}; o[3]=f32x16{};
  f32x16 p0,p1; u32x4 pw0,pw1,pw2,pw3; s16x4 va[8],vb[8];
  #pragma unroll
  for(int r=0;r<16;++r){ p0[r]=0.f; p1[r]=0.f; }
  asm volatile("":"+v"(p0),"+v"(p1));
  const int qrel=rg*32+r32;
  #define DB_WAITT(u) do{ if((u)+1<NT){ asm volatile("s_waitcnt vmcnt(4)":::"memory"); } else { asm volatile("s_waitcnt vmcnt(0)":::"memory"); } }while(0)
  #define DB_ISSUE(u) do{ if((u)<NT){ DB_DMA((u),DB_SLOT(u)); } }while(0)
  #define DB_BAR() asm volatile("s_waitcnt lgkmcnt(0)\n\ts_barrier":::"memory")
  #define DB_BARP() asm volatile("s_waitcnt lgkmcnt(0)\n\ts_barrier":"+v"(p0),"+v"(p1)::"memory")
  #define DB_VLD(x,vp_,d0) do{ _Pragma("unroll") for(int ks_=0;ks_<4;++ks_){ x[2*ks_]=vtr((vp_)+(d0)*4096+ks_*1024); x[2*ks_+1]=vtr((vp_)+(d0)*4096+ks_*1024+512); } }while(0)
  #define DB_VF(x,ks) ((bf16x8){x[2*(ks)][0],x[2*(ks)][1],x[2*(ks)][2],x[2*(ks)][3],x[2*(ks)+1][0],x[2*(ks)+1][1],x[2*(ks)+1][2],x[2*(ks)+1][3]})
  #define DB_PVM(x,d0) do{ o[d0]=__builtin_amdgcn_mfma_f32_32x32x16_bf16(DB_VF(x,0),__builtin_bit_cast(bf16x8,pw0),o[d0],0,0,0); o[d0]=__builtin_amdgcn_mfma_f32_32x32x16_bf16(DB_VF(x,1),__builtin_bit_cast(bf16x8,pw1),o[d0],0,0,0); \
      o[d0]=__builtin_amdgcn_mfma_f32_32x32x16_bf16(DB_VF(x,2),__builtin_bit_cast(bf16x8,pw2),o[d0],0,0,0); o[d0]=__builtin_amdgcn_mfma_f32_32x32x16_bf16(DB_VF(x,3),__builtin_bit_cast(bf16x8,pw3),o[d0],0,0,0); }while(0)
  #define DB_QKM(kf_) do{ p0=__builtin_amdgcn_mfma_f32_32x32x16_bf16(kf_[0],qr[0],p0,0,0,0); p1=__builtin_amdgcn_mfma_f32_32x32x16_bf16(kf_[1],qr[0],p1,0,0,0); \
      _Pragma("unroll") for(int d0_=1;d0_<4;++d0_){ p0=__builtin_amdgcn_mfma_f32_32x32x16_bf16(kf_[2*d0_],qr[d0_],p0,0,0,0); p1=__builtin_amdgcn_mfma_f32_32x32x16_bf16(kf_[2*d0_+1],qr[d0_],p1,0,0,0); } }while(0)
  #define DB_FILL() do{ float nm_=-mref; asm volatile("":"+v"(nm_)); _Pragma("unroll") for(int r=0;r<16;++r){ p0[r]=nm_; p1[r]=nm_; } }while(0)
  #define DB_M(tp,tq) do{ const lds_cptr vp_=vp0+DB_SLOT(tp); const lds_cptr kp_=kp0+DB_SLOT(tq); bf16x8 kf_[8]; \
      if(!DB_VPRE){ DB_VLD(va,vp_,0); DB_VLD(vb,vp_,1); SBAR(); } DB_PVM(va,0); DB_VLD(va,vp_,2); SBAR(); \
      DB_PVM(vb,1); DB_VLD(vb,vp_,3); SBAR(); \
      DB_PVM(va,2); DB_KLD(kf_,kp_,0); DB_KLD(kf_,kp_,1); SBAR(); \
      DB_PVM(vb,3); DB_KLD(kf_,kp_,2); DB_KLD(kf_,kp_,3); SBAR(); \
      if(!DB_FILLX){ DB_FILL(); } DB_QKM(kf_); }while(0)
  #define DB_QK0(tq) do{ const lds_cptr kp_=kp0+DB_SLOT(tq); bf16x8 kf_[8]; DB_KLD(kf_,kp_,0); DB_KLD(kf_,kp_,1); DB_KLD(kf_,kp_,2); DB_KLD(kf_,kp_,3); SBAR(); DB_QKM(kf_); }while(0)
  #define DB_PVL(tp) do{ const lds_cptr vp_=vp0+DB_SLOT(tp); if(!DB_VPRE){ DB_VLD(va,vp_,0); DB_VLD(vb,vp_,1); SBAR(); } DB_PVM(va,0); DB_VLD(va,vp_,2); SBAR(); DB_PVM(vb,1); DB_VLD(vb,vp_,3); SBAR(); DB_PVM(va,2); SBAR(); DB_PVM(vb,3); }while(0)
  #define DB_X(tt,FIRST) do{ { const int jb_=(tt)-(NT-2); if(jb_>=0){ cmask(p0,p1,jb_,qrel,hi); } } \
      const float rm_=rowmax(p0,p1); \
      if(FIRST){ mref=rm_; _Pragma("unroll") for(int r=0;r<16;++r){ p0[r]-=rm_; p1[r]-=rm_; } } \
      else if(__any(rm_>(float)THRL)){ const float dl_=__builtin_fmaxf(rm_,0.f); const float f_=__builtin_amdgcn_exp2f(-dl_); mref+=dl_; l_reg*=f_; \
        _Pragma("unroll") for(int r=0;r<16;++r){ p0[r]-=dl_; p1[r]-=dl_; } \
        _Pragma("unroll") for(int d_=0;d_<4;++d_) _Pragma("unroll") for(int r=0;r<16;++r){ float x_=o[d_][r]; asm volatile("v_mul_f32_e32 %0, %0, %1":"+v"(x_):"v"(f_)); o[d_][r]=x_; } } \
      float sacc_=0.f; _Pragma("unroll") for(int r=0;r<16;++r){ p0[r]=__builtin_amdgcn_exp2f(p0[r]); p1[r]=__builtin_amdgcn_exp2f(p1[r]); sacc_+=p0[r]+p1[r]; } l_reg+=sacc_; \
      pw0=(u32x4){cvtpk_s(p0[0],p0[1]),cvtpk_s(p0[2],p0[3]),cvtpk_s(p0[4],p0[5]),cvtpk_s(p0[6],p0[7])}; pw1=(u32x4){cvtpk_s(p0[8],p0[9]),cvtpk_s(p0[10],p0[11]),cvtpk_s(p0[12],p0[13]),cvtpk_s(p0[14],p0[15])}; \
      pw2=(u32x4){cvtpk_s(p1[0],p1[1]),cvtpk_s(p1[2],p1[3]),cvtpk_s(p1[4],p1[5]),cvtpk_s(p1[6],p1[7])}; pw3=(u32x4){cvtpk_s(p1[8],p1[9]),cvtpk_s(p1[10],p1[11]),cvtpk_s(p1[12],p1[13]),cvtpk_s(p1[14],p1[15])}; \
      if(DB_VPRE){ const lds_cptr vq_=vp0+DB_SLOT(tt); DB_VLD(va,vq_,0); DB_VLD(vb,vq_,1); } if(DB_FILLX){ DB_FILL(); } }while(0)
  DB_WAITT(0);
  if(c==1){ DB_BAR(); DB_ISSUE(2); }
  DB_BAR();
  DB_QK0(0);
  if(c==1){ DB_WAITT(1); } DB_BARP(); DB_ISSUE(2+c);
  DB_X(0,true);
  for(int t=1;t<NT;++t){
    if(c==0){ DB_WAITT(t); } DB_BAR();
    DB_M(t-1,t);
    if(c==1){ DB_WAITT(t+1); } DB_BARP(); DB_ISSUE(t+2+c);
    DB_X(t,false);
  }
  DB_BAR(); DB_PVL(NT-1);
  if(c==0){ DB_BAR(); }
  int lane_e=lane; asm volatile("":"+v"(lane_e)); const int r32e=lane_e&31, hie=lane_e>>5;
  l_reg+=__uint_as_float((unsigned)__builtin_amdgcn_ds_bpermute((lane_e^32)<<2,(int)__float_as_uint(l_reg)));
  asm volatile("s_waitcnt vmcnt(0) lgkmcnt(0)\n\ts_barrier":::"memory");
  const float rl=__builtin_amdgcn_rcpf(l_reg);
  float*st2=(float*)shm+rg*4096+lane_e;
  if(c==1){ const float s_=lam*rl;
    #pragma unroll
    for(int d0=0;d0<4;++d0)
      #pragma unroll
      for(int r=0;r<16;++r)st2[(d0*16+r)*64]=o[d0][r]*s_;
  }
  asm volatile("s_waitcnt lgkmcnt(0)\n\ts_barrier":::"memory");
  if(c==0){
    float a_=0.f;
    #pragma unroll
    for(int d0=0;d0<4;++d0)
      #pragma unroll
      for(int r=0;r<16;++r){ const float x_=o[d0][r]*rl-st2[(d0*16+r)*64]; o[d0][r]=x_; a_+=x_*x_; }
    a_+=__uint_as_float((unsigned)__builtin_amdgcn_ds_bpermute((lane_e^32)<<2,(int)__float_as_uint(a_)));
    const float rs=gscale/__builtin_sqrtf(a_*(1.0f/128.0f)+1e-5f);
    char*stg=shm+65536+rg*(32*272)+r32e*272+hie*8;
    #pragma unroll
    for(int d0=0;d0<4;++d0)
      #pragma unroll
      for(int g=0;g<4;++g){ const float4 gv=*reinterpret_cast<const float4*>(gsub+d0*32+8*g+4*hie);
        uint2 w_; w_.x=cvtpk_s(o[d0][4*g]*rs*gv.x,o[d0][4*g+1]*rs*gv.y); w_.y=cvtpk_s(o[d0][4*g+2]*rs*gv.z,o[d0][4*g+3]*rs*gv.w);
        *reinterpret_cast<uint2*>(stg+(d0*32+8*g)*2)=w_; }
    asm volatile("s_waitcnt lgkmcnt(0)":::"memory");
    bf16*Yw=Yb+(long)(q0+rg*32)*DM; const char*stb=shm+65536+rg*(32*272);
    #pragma unroll
    for(int i=0;i<8;++i){const int row=i*4+(lane_e>>4),ch=lane_e&15; const u32x4 v=*(const u32x4*)(stb+row*272+ch*16); *(u32x4*)(Yw+(long)row*DM+ch*8)=v;}
  }
  asm volatile("s_waitcnt vmcnt(0) lgkmcnt(0)\n\ts_barrier":::"memory");
  #undef DB_RFL
  #undef DB_KLD
  #undef DB_DMA
  #undef DB_SLOT
  #undef DB_WAITT
  #undef DB_ISSUE
  #undef DB_BARP
  #undef DB_BAR
  #undef DB_VLD
  #undef DB_VF
  #undef DB_PVM
  #undef DB_QKM
  #undef DB_M
  #undef DB_QK0
  #undef DB_PVL
  #undef DB_X
}
constexpr int ATTN_LDS_BYTES=LDS_BYTES;
#undef SBAR
#undef WAIT_BAR
}

#define GAS __attribute__((address_space(1)))
#define LAS __attribute__((address_space(3)))
typedef unsigned short bf16;
typedef unsigned v4u __attribute__((ext_vector_type(4)));
typedef float f32x4 __attribute__((ext_vector_type(4)));
typedef short bf16x8 __attribute__((ext_vector_type(8)));
typedef GAS unsigned gu32;
typedef GAS unsigned long long gu64;
#define RLX_AGENT __ATOMIC_RELAXED, __HIP_MEMORY_SCOPE_AGENT
#define LDS_WAIT() asm volatile("s_waitcnt lgkmcnt(0)" ::: "memory")
#define VM_WAIT() asm volatile("s_waitcnt vmcnt(0)" ::: "memory")
__device__ __forceinline__ unsigned long long rt() { return __builtin_amdgcn_s_memrealtime(); }
__device__ __forceinline__ unsigned f2bf(float f) { unsigned u = __builtin_bit_cast(unsigned, f); return (u + 0x7fffu + ((u >> 16) & 1u)) >> 16; }
__device__ __forceinline__ unsigned pk2(float lo, float hi) { return f2bf(lo) | (f2bf(hi) << 16); }

#define XB_TMO      128
#define XB_XCNT(j)  (256  + 64 * (j))
#define XB_XSUB(j)  (1280 + 64 * (j))
#define XB_XGEN(j)  (2304 + 64 * (j))
#define XB_TOP      3328
#define XB_TOPGEN   3392
#define XCD_BAR_WORDS 3456
#define XB_SPIN_CAP (1u << 26)

__device__ __forceinline__ unsigned xb_ld(unsigned* p)              { return __hip_atomic_load(p, __ATOMIC_RELAXED, __HIP_MEMORY_SCOPE_AGENT); }
__device__ __forceinline__ unsigned xb_add(unsigned* p, unsigned v) { return __hip_atomic_fetch_add(p, v, __ATOMIC_RELAXED, __HIP_MEMORY_SCOPE_AGENT); }
__device__ __forceinline__ unsigned xb_xcc_id() { return (unsigned)__builtin_amdgcn_s_getreg((3 << 11) | 20) & 0xFu; }
#define XB_SPIN(cond, bar) do { unsigned _sp = 0; while (cond) { __builtin_amdgcn_s_sleep(1); \
    if ((++_sp & 255u) == 0u) { if (xb_ld(&(bar)[XB_TMO])) break; if (_sp > XB_SPIN_CAP) { atomicAdd(&(bar)[XB_TMO], 1u); break; } } } } while (0)

struct XcdBarrier {
    unsigned* bar; unsigned x;
    volatile LAS unsigned* st;
};

__device__ __forceinline__ XcdBarrier xcd_barrier_post(unsigned* bar, volatile LAS unsigned* st, const int tid) {
    XcdBarrier b; b.bar = bar; b.x = xb_xcc_id(); b.st = st;
    if (tid == 0) (void)xb_add(&bar[XB_XCNT(b.x)], 1u);
    return b;
}
__device__ __forceinline__ void xcd_barrier_complete(unsigned* bar, unsigned x, unsigned& nloc, unsigned& nx) {
    const unsigned G = gridDim.x * gridDim.y * gridDim.z;
    unsigned sum, cnt, mine, sp = 0u;
    for (;;) {
        sum = 0u; cnt = 0u; mine = 0u;
#pragma unroll
        for (unsigned j = 0; j < 16; ++j) { const unsigned c = xb_ld(&bar[XB_XCNT(j)]); sum += c; cnt += (c > 0u) ? 1u : 0u; mine = (j == x) ? c : mine; }
        if (sum == G) break;
        __builtin_amdgcn_s_sleep(1);
        if ((++sp & 255u) == 0u) { if (xb_ld(&bar[XB_TMO])) break; if (sp > XB_SPIN_CAP) { atomicAdd(&bar[XB_TMO], 1u); break; } }
    }
    nloc = mine > 0u ? mine : 1u; nx = cnt > 0u ? cnt : 1u;
}

__device__ __forceinline__ void xcd_barrier(const XcdBarrier& b, const int tid) {
    asm volatile("s_waitcnt vmcnt(0)" ::: "memory");
    __syncthreads();
    if (tid == 0) {
        unsigned* bar = b.bar;
        __builtin_amdgcn_s_waitcnt(0);
        unsigned nloc = b.st[0], nx = b.st[1];
        if (nloc == 0u) { xcd_barrier_complete(bar, b.x, nloc, nx); b.st[0] = nloc; b.st[1] = nx; }
        const unsigned old = xb_add(&bar[XB_XSUB(b.x)], 1u);
        const unsigned gen = old / nloc;
        if (old + 1u == (gen + 1u) * nloc) {
            __builtin_amdgcn_fence(__ATOMIC_RELEASE, "agent");
            asm volatile("s_waitcnt vmcnt(0)" ::: "memory");
            const unsigned og = xb_add(&bar[XB_TOP], 1u);
            const unsigned tg = og / nx;
            if (og + 1u == (tg + 1u) * nx) xb_add(&bar[XB_TOPGEN], 1u);
            else XB_SPIN(xb_ld(&bar[XB_TOPGEN]) == tg, bar);
            __builtin_amdgcn_fence(__ATOMIC_ACQUIRE, "agent");
            xb_add(&bar[XB_XGEN(b.x)], 1u);
            asm volatile("s_waitcnt vmcnt(0)" ::: "memory");
        } else {
            XB_SPIN(xb_ld(&bar[XB_XGEN(b.x)]) == gen, bar);
            __builtin_amdgcn_fence(__ATOMIC_ACQUIRE, "agent");
            asm volatile("s_waitcnt vmcnt(0)" ::: "memory");
        }
    }
    __syncthreads();
}

constexpr int NWAVES = 8;
constexpr int NTOK = 65536, NH = 32768, DMODEL = 1024, SEQLEN = 4096, INCOLS = 5632, DFF = 2816, NEXP = 8;
constexpr int MOE_PANELS_MAX = 264;
constexpr float EPS_NORM = 1e-6f, EPS_SUBLN = 1e-5f;

constexpr size_t MiB = 1u << 20;
constexpr size_t WS_CTL = 0, CTL_ZERO_BYTES = 1 * MiB;
constexpr size_t WS_WIN = 1 * MiB;
constexpr size_t WS_WGLU = 23 * MiB;
constexpr size_t WS_WPS = 24 * MiB;
constexpr size_t WS_WPA = 26 * MiB;
constexpr size_t WS_WOUT = 30 * MiB;
constexpr size_t WS_WDGU = 34 * MiB;
constexpr size_t WS_WDD = 45 * MiB;
constexpr size_t WS_WMGU = 51 * MiB;
constexpr size_t WS_WMD = 139 * MiB;
constexpr size_t WS_TZF = 183 * MiB;
constexpr size_t WS_EM = 223 * MiB;
constexpr size_t WS_ROPE = 239 * MiB;
constexpr size_t WS_ROUTE = 255 * MiB;
constexpr size_t WS_ACT = 260 * MiB;
constexpr size_t WS_END = 960 * MiB;
constexpr size_t A_HB = 0, A_UBUF = 64 * MiB, A_SLOC = 104 * MiB, A_Q = 120 * MiB, A_K = 184 * MiB, A_V = 248 * MiB, A_SGS = 312 * MiB, A_SGA = 376 * MiB, A_YA = 440 * MiB, A_YA2 = 472 * MiB, A_OV = 504 * MiB, A_YB = 632 * MiB;
constexpr size_t A_H2 = 0, A_FA = 64 * MiB;
constexpr size_t A_H2M = 632 * MiB, A_H2G = 0, A_AG = 132 * MiB, A_YG = 0;
constexpr size_t A_XB = 504 * MiB;
static_assert(A_UBUF == pg8::EA_U && A_Q == pg8::EA_Q && A_K == pg8::EA_K && A_V == pg8::EA_V && A_SGS == pg8::EA_SGS && A_SGA == pg8::EA_SGA, "EpiIn offsets");
static_assert(A_YB + 64 * MiB <= WS_END - WS_ACT && A_YA2 + 32 * MiB <= A_XB && A_XB + 128 * MiB <= A_YB && A_AG + 363 * MiB <= A_XB && A_H2G + 132 * MiB <= A_AG && A_H2M >= A_XB + 128 * MiB && A_H2M + 64 * MiB <= WS_END - WS_ACT && A_FA + 176 * MiB <= A_XB, "act map");
constexpr size_t R_E = 0, R_W = 256 * 1024, R_S = 512 * 1024, R_CNT = 768 * 1024, R_ROW = 1024 * 1024;
constexpr int CW_BAR = 4096;

constexpr int RING_OFF = 0, RING_BYTES = 131072;
constexpr int LDSCTL_OFF = RING_BYTES, MISC_OFF = LDSCTL_OFF + 320;
constexpr int LDS_BYTES = 147456;

constexpr int PTR_OFF = LDSCTL_OFF + 1024;
struct Args { const void* in[31]; float* out; unsigned char* ws; };
__device__ __forceinline__ unsigned long long ldp64(LAS unsigned char* L, int slot) {
    const unsigned long long v = ((volatile LAS unsigned long long*)(L + PTR_OFF))[slot];
    const unsigned lo = __builtin_amdgcn_readfirstlane((unsigned)v), hi = __builtin_amdgcn_readfirstlane((unsigned)(v >> 32));
    return ((unsigned long long)hi << 32) | lo;
}
#define LDP(T, slot) ((T*)(GAS T*)(uintptr_t)ldp64(L, (slot)))

#define SWZ_XOR(k) (((k) << 10) | 0x1f)
#define swz_xor(v, pat) __builtin_bit_cast(float, __builtin_amdgcn_ds_swizzle(__builtin_bit_cast(int, (float)(v)), (pat)))
__device__ __forceinline__ float wave_sum(float v) {
#define WS_DPP(x, ctrl) __builtin_bit_cast(float, __builtin_amdgcn_update_dpp(0, __builtin_bit_cast(int, (float)(x)), (ctrl), 0xf, 0xf, false))
    v += WS_DPP(v, 0xB1); v += WS_DPP(v, 0x4E); v += WS_DPP(v, 0x141); v += WS_DPP(v, 0x140);
#undef WS_DPP
    const float r0 = __builtin_bit_cast(float, __builtin_amdgcn_readlane(__builtin_bit_cast(int, v), 0)), r1 = __builtin_bit_cast(float, __builtin_amdgcn_readlane(__builtin_bit_cast(int, v), 16));
    const float r2 = __builtin_bit_cast(float, __builtin_amdgcn_readlane(__builtin_bit_cast(int, v), 32)), r3 = __builtin_bit_cast(float, __builtin_amdgcn_readlane(__builtin_bit_cast(int, v), 48));
    return (r0 + r1) + (r2 + r3);
}
__device__ __forceinline__ void tr_item(const float* W, int ldw, int K, bf16* WTn0, int k0, int srccol, LAS float* scr, int lane) {
    float wv[32];
#pragma unroll
    for (int i = 0; i < 32; ++i) wv[i] = W[(size_t)(k0 + 2 * i + (lane >> 5)) * ldw + srccol];
#pragma unroll
    for (int i = 0; i < 32; ++i) scr[(2 * i + (lane >> 5)) * 33 + (lane & 31)] = wv[i];
    LDS_WAIT(); asm volatile("" ::: "memory");
    const int c = lane & 7;
#pragma unroll
    for (int j = 0; j < 4; ++j) { const int n = (lane >> 3) + 8 * j; const LAS float* s = scr + (8 * c) * 33 + n;
        v4u o; o.x = pk2(s[0 * 33], s[1 * 33]); o.y = pk2(s[2 * 33], s[3 * 33]); o.z = pk2(s[4 * 33], s[5 * 33]); o.w = pk2(s[6 * 33], s[7 * 33]);
        *(GAS v4u*)(WTn0 + (size_t)n * K + k0 + 8 * c) = o; }
    LDS_WAIT(); asm volatile("" ::: "memory");
}
__device__ __forceinline__ int win_orig(int n) { if (n < 512 || n >= 2560) return n; const int i = n & 63; return (n & ~63) + 16 * ((i >> 5) & 1) + 4 * ((i >> 3) & 3) + (i & 3) + 32 * ((i >> 2) & 1); }
__device__ __forceinline__ void tr_plain(const float* W, int K, int N, bf16* WT, int item, LAS float* scr, int lane) {
    const int nblk = N / 32, kb = item / nblk, nb = item % nblk;
    tr_item(W, N, K, WT + (size_t)(32 * nb) * K, 64 * kb, 32 * nb + (lane & 31), scr, lane);
}
__device__ __forceinline__ void tr_win(const float* W, bf16* WT, int item, LAS float* scr, int lane) {
    const int nblk = INCOLS / 32, kb = item / nblk, nb = item % nblk;
    tr_item(W, INCOLS, DMODEL, WT + (size_t)(32 * nb) * DMODEL, 64 * kb, win_orig(32 * nb + (lane & 31)), scr, lane);
}
__device__ __forceinline__ void tr_gu(const float* Wg, const float* Wu, bf16* WT, int item, LAS float* scr, int lane) {
    const int nblk = INCOLS / 32, kb = item / nblk, nb = item % nblk; const int n0 = 32 * nb, pn = n0 >> 8, r = n0 & 255;
    const float* W = r < 128 ? Wg : Wu; const int col = pn * 128 + (r & 127) + (lane & 31);
    tr_item(W, DFF, DMODEL, WT + (size_t)n0 * DMODEL, 64 * kb, col, scr, lane);
}
struct TrD { const float* W; bf16* WTn0; int ldw, K, k0, srccol; };
__device__ __forceinline__ TrD trd_plain(const float* W, int K, int N, bf16* WT, int item, int lane) { const int nblk = N / 32, kb = item / nblk, nb = item % nblk; return TrD{W, WT + (size_t)(32 * nb) * K, N, K, 64 * kb, 32 * nb + (lane & 31)}; }
__device__ __forceinline__ TrD trd_win(const float* W, bf16* WT, int item, int lane) { const int nblk = INCOLS / 32, kb = item / nblk, nb = item % nblk; return TrD{W, WT + (size_t)(32 * nb) * DMODEL, INCOLS, DMODEL, 64 * kb, win_orig(32 * nb + (lane & 31))}; }
__device__ __forceinline__ TrD trd_gu(const float* Wg, const float* Wu, bf16* WT, int item, int lane) { const int nblk = INCOLS / 32, kb = item / nblk, nb = item % nblk; const int n0 = 32 * nb, pn = n0 >> 8, r = n0 & 255;
    return TrD{r < 128 ? Wg : Wu, WT + (size_t)n0 * DMODEL, DFF, DMODEL, 64 * kb, pn * 128 + (r & 127) + (lane & 31)}; }
__device__ __forceinline__ void tr_ld(const TrD& d, int lane, float (&wv)[32]) {
#pragma unroll
    for (int i = 0; i < 32; ++i) wv[i] = d.W[(size_t)(d.k0 + 2 * i + (lane >> 5)) * d.ldw + d.srccol];
}
__device__ __forceinline__ void tr_st(const TrD& d, const float (&wv)[32], LAS float* scr, int lane) {
#pragma unroll
    for (int i = 0; i < 32; ++i) scr[(2 * i + (lane >> 5)) * 33 + (lane & 31)] = wv[i];
    LDS_WAIT(); asm volatile("" ::: "memory");
    const int c = lane & 7;
#pragma unroll
    for (int j = 0; j < 4; ++j) { const int n = (lane >> 3) + 8 * j; const LAS float* s = scr + (8 * c) * 33 + n;
        v4u o; o.x = pk2(s[0 * 33], s[1 * 33]); o.y = pk2(s[2 * 33], s[3 * 33]); o.z = pk2(s[4 * 33], s[5 * 33]); o.w = pk2(s[6 * 33], s[7 * 33]);
        *(GAS v4u*)(d.WTn0 + (size_t)n * d.K + d.k0 + 8 * c) = o; }
    LDS_WAIT(); asm volatile("" ::: "memory");
}
struct S5In { const float *lam_re, *lam_im, *log_dt, *b_re, *b_im, *c_re, *c_im, *dd; };
__device__ __forceinline__ v4u pack8f(const float* v) { v4u o; o.x = pk2(v[0], v[1]); o.y = pk2(v[2], v[3]); o.z = pk2(v[4], v[5]); o.w = pk2(v[6], v[7]); return o; }
__device__ __forceinline__ void s5_item(LAS unsigned char* L, int tid, const S5In& P, int lg, int d, bf16* TZF, bf16* EM) {
    LAS float* sm = (LAS float*)(L);
    LAS float *s_fr = sm, *s_fi = sm + 64, *s_apr = sm + 128, *s_api = sm + 192, *BBr = sm + 256, *BBi = sm + 1280, *CAr = sm + 2304, *CAi = sm + 3328, *Kd = sm + 4352;
    if (tid < 64) {
        const int p = tid;
        const float dt = expf(P.log_dt[lg]);
        const float lr = P.lam_re[lg * 64 + p], li = P.lam_im[lg * 64 + p];
        const float mag = expf(lr * dt); float sn, cs; sincosf(li * dt, &sn, &cs);
        const float ar = mag * cs, ai = mag * sn;
        const float den = lr * lr + li * li, nr = ar - 1.0f, ni = ai;
        s_fr[p] = (nr * lr + ni * li) / den; s_fi[p] = (ni * lr - nr * li) / den;
        const float fd = (float)d; const float magd = expf(fd * lr * dt); float snd, csd; sincosf(fd * li * dt, &snd, &csd);
        s_apr[p] = magd * csd; s_api[p] = magd * snd;
    }
    __syncthreads();
    for (int idx = tid; idx < 1024; idx += 512) {
        { const int p = idx >> 4; const float br = P.b_re[(size_t)lg * 1024 + idx], bi = P.b_im[(size_t)lg * 1024 + idx]; const float fr_ = s_fr[p], fi_ = s_fi[p];
          BBr[idx] = fr_ * br - fi_ * bi; BBi[idx] = fr_ * bi + fi_ * br; }
        { const int p = idx & 63; const float cr = P.c_re[(size_t)lg * 1024 + idx], ci = P.c_im[(size_t)lg * 1024 + idx]; const float ar_ = s_apr[p], ai_ = s_api[p];
          CAr[idx] = cr * ar_ - ci * ai_; CAi[idx] = cr * ai_ + ci * ar_; }
    }
    __syncthreads();
    if (d <= 31 && tid < 256) { const int j = tid >> 4, jp = tid & 15; float acc = 0.f;
        for (int p = 0; p < 64; ++p) acc += CAr[j * 64 + p] * BBr[p * 16 + jp] - CAi[j * 64 + p] * BBi[p * 16 + jp];
        if (d == 0 && j == jp) acc += P.dd[lg * 16 + j];
        Kd[tid] = acc; }
    __syncthreads();
    bf16* TZ = TZF + (size_t)lg * 512 * 640; bf16* EE = EM + (size_t)lg * 256 * 512;
    if (d <= 31) {
        const int cnt = (32 - d) * 16;
        for (int idx = tid; idx < cnt; idx += 512) { const int tt = idx >> 4, j = idx & 15; float v[16];
#pragma unroll
            for (int q = 0; q < 16; ++q) v[q] = Kd[j * 16 + q];
            bf16* dst = TZ + (size_t)((d + tt) * 16 + j) * 640 + tt * 16;
            *(GAS v4u*)dst = pack8f(v); *(GAS v4u*)(dst + 8) = pack8f(v + 8);
            if (d >= 1) { bf16* dz = TZ + (size_t)(tt * 16 + j) * 640 + (d + tt) * 16; const v4u z = {0u, 0u, 0u, 0u}; *(GAS v4u*)dz = z; *(GAS v4u*)(dz + 8) = z; } }
        if (tid < 128) { const int ri = tid >> 6, p = tid & 63; const float ar_ = s_apr[p], ai_ = s_api[p]; float v[16];
#pragma unroll
            for (int q = 0; q < 16; ++q) { const float br = BBr[p * 16 + q], bi = BBi[p * 16 + q]; v[q] = ri == 0 ? (ar_ * br - ai_ * bi) : (ar_ * bi + ai_ * br); }
            bf16* dst = EE + (size_t)tid * 512 + (31 - d) * 16; *(GAS v4u*)dst = pack8f(v); *(GAS v4u*)(dst + 8) = pack8f(v + 8);
        } else if (tid < 256) { bf16* dz = EE + (size_t)tid * 512 + (31 - d) * 16; const v4u z = {0u, 0u, 0u, 0u}; *(GAS v4u*)dz = z; *(GAS v4u*)(dz + 8) = z; }
    }
    if (d >= 1 && tid < 256) { const int j = tid >> 4, ri = (tid >> 3) & 1, pc = tid & 7; float v[8];
#pragma unroll
        for (int q = 0; q < 8; ++q) v[q] = ri == 0 ? CAr[j * 64 + pc * 8 + q] : -CAi[j * 64 + pc * 8 + q];
        *(GAS v4u*)(TZ + (size_t)((d - 1) * 16 + j) * 640 + 512 + ri * 64 + pc * 8) = pack8f(v); }
    __syncthreads();
}
__device__ __forceinline__ void norm_rows4(const float* x0, size_t xstep, const f32x4 (&g)[4], bf16* o0, size_t ostep, int lane) {
    f32x4 h[4][4];
#pragma unroll
    for (int r = 0; r < 4; ++r) { const GAS f32x4* xr = (const GAS f32x4*)(x0 + r * xstep) + lane;
#pragma unroll
        for (int j = 0; j < 4; ++j) h[r][j] = xr[64 * j]; }
#pragma unroll
    for (int r = 0; r < 4; ++r) { float s2 = 0.f;
#pragma unroll
        for (int j = 0; j < 4; ++j) s2 += (h[r][j].x * h[r][j].x + h[r][j].y * h[r][j].y) + (h[r][j].z * h[r][j].z + h[r][j].w * h[r][j].w);
        const float rs = 1.0f / sqrtf(wave_sum(s2) * (1.0f / DMODEL) + EPS_NORM);
        GAS unsigned long long* o8 = (GAS unsigned long long*)(o0 + r * ostep) + lane;
#pragma unroll
        for (int j = 0; j < 4; ++j) { const f32x4 v = h[r][j] * rs * g[j]; o8[64 * j] = (unsigned long long)pk2(v.x, v.y) | ((unsigned long long)pk2(v.z, v.w) << 32); } }
}
__device__ __forceinline__ f32x4 bf4_f32(unsigned long long a) { const unsigned lo = (unsigned)a, hi = (unsigned)(a >> 32); f32x4 r; r.x = __uint_as_float(lo << 16); r.y = __uint_as_float(lo & 0xffff0000u); r.z = __uint_as_float(hi << 16); r.w = __uint_as_float(hi & 0xffff0000u); return r; }
__device__ __forceinline__ void norm_rows4b(const bf16* x0, size_t xstep, const f32x4 (&g)[4], bf16* o0, size_t ostep, int lane) {
    unsigned long long hb[4][4];
#pragma unroll
    for (int r = 0; r < 4; ++r) { const GAS unsigned long long* xr = (const GAS unsigned long long*)(x0 + r * xstep) + lane;
#pragma unroll
        for (int j = 0; j < 4; ++j) hb[r][j] = xr[64 * j]; }
#pragma unroll
    for (int r = 0; r < 4; ++r) { float s2 = 0.f; f32x4 h[4];
#pragma unroll
        for (int j = 0; j < 4; ++j) { h[j] = bf4_f32(hb[r][j]); s2 += (h[j].x * h[j].x + h[j].y * h[j].y) + (h[j].z * h[j].z + h[j].w * h[j].w); }
        const float rs = 1.0f / sqrtf(wave_sum(s2) * (1.0f / DMODEL) + EPS_NORM);
        GAS unsigned long long* o8 = (GAS unsigned long long*)(o0 + r * ostep) + lane;
#pragma unroll
        for (int j = 0; j < 4; ++j) { const f32x4 v = h[j] * rs * g[j]; o8[64 * j] = (unsigned long long)pk2(v.x, v.y) | ((unsigned long long)pk2(v.z, v.w) << 32); } }
}
__device__ __forceinline__ void norm_row(const float* xrow, const float* gain, bf16* orow, int lane, f32x4 (&hn)[4]) {
    const GAS f32x4* xr = (const GAS f32x4*)xrow + lane; const GAS f32x4* gr = (const GAS f32x4*)gain + lane;
    float s2 = 0.f;
#pragma unroll
    for (int j = 0; j < 4; ++j) { hn[j] = xr[64 * j]; s2 += (hn[j].x * hn[j].x + hn[j].y * hn[j].y) + (hn[j].z * hn[j].z + hn[j].w * hn[j].w); }
    const float rs = 1.0f / sqrtf(wave_sum(s2) * (1.0f / DMODEL) + EPS_NORM);
    GAS unsigned long long* o8 = (GAS unsigned long long*)orow + lane;
#pragma unroll
    for (int j = 0; j < 4; ++j) { const f32x4 g = gr[64 * j]; hn[j] = hn[j] * rs * g;
        o8[64 * j] = (unsigned long long)pk2(hn[j].x, hn[j].y) | ((unsigned long long)pk2(hn[j].z, hn[j].w) << 32); }
}

__global__ void __launch_bounds__(NWAVES * 64, 2) trunk_fwd(Args args) {
    extern __shared__ __attribute__((aligned(16))) unsigned char lds[];
    const int WAVE = __builtin_amdgcn_readfirstlane((int)threadIdx.x >> 6);
#define MYTID() ({ int l_; asm volatile("v_mbcnt_lo_u32_b32 %0, -1, 0\n\tv_mbcnt_hi_u32_b32 %0, -1, %0" : "=v"(l_)); WAVE * 64 + l_; })
    LAS unsigned char* const L0 = (LAS unsigned char*)lds;
#define OPQ LAS unsigned char* L = L0; asm volatile("" : "+s"(L))
    OPQ;
    {
        const int tid0 = MYTID();
        for (int u = tid0; u < (LDS_BYTES - LDSCTL_OFF) / 4; u += NWAVES * 64) ((LAS unsigned*)(L + LDSCTL_OFF))[u] = 0u;
        __syncthreads();
        if (tid0 == 0) {
#pragma unroll
            for (int k = 0; k < 31; ++k) ((LAS unsigned long long*)(L + PTR_OFF))[k] = (unsigned long long)(uintptr_t)args.in[k];
            ((LAS unsigned long long*)(L + PTR_OFF))[31] = (unsigned long long)(uintptr_t)args.out;
            ((LAS unsigned long long*)(L + PTR_OFF))[32] = (unsigned long long)(uintptr_t)args.ws; }
        __syncthreads();
    }
    { XcdBarrier b0 = xcd_barrier_post((unsigned*)(LDP(unsigned char, 32) + WS_CTL) + CW_BAR, (volatile LAS unsigned*)(L + MISC_OFF) + 8, MYTID()); (void)b0; }
#define GRID_BAR() do { OPQ; XcdBarrier b_; b_.bar = (unsigned*)(LDP(unsigned char, 32) + WS_CTL) + CW_BAR; b_.x = xb_xcc_id(); b_.st = (volatile LAS unsigned*)(L + MISC_OFF) + 8; xcd_barrier(b_, MYTID()); } while (0)
#define LQ() ({ int l_ = l; asm volatile("" : "+s"(l_)); l_; })
#define TID_SETUP OPQ; int wave_ = WAVE; asm volatile("" : "+s"(wave_)); const int wave = wave_; const int tid = MYTID(), lane = tid & 63; const int G = gridDim.x; const int vcu = ((int)blockIdx.x % 8) * (G / 8) + (int)blockIdx.x / 8; const int gw = vcu * NWAVES + wave, NGW = G * NWAVES; (void)lane; (void)gw; (void)NGW; (void)tid
#define WSP(T, off) ((T*)(LDP(unsigned char, 32) + (off)))
#define ACTP(T, off) ((T*)(LDP(unsigned char, 32) + WS_ACT + (off)))

    {
        TID_SETUP;
        LAS float* scr = (LAS float*)(L + RING_OFF + wave * 16384);
        constexpr int I_WIN = 16 * 176, I_GLU = 8 * 16, I_PS = 8 * 32, I_PA = 16 * 32, I_OUT = 16 * 32, I_GU = 16 * 176, I_DN = 44 * 32;
        constexpr int I_LAYER = I_WIN + I_GLU + I_PS + I_PA + I_OUT;
        constexpr int NITEMS = 2 * I_LAYER + I_GU + I_DN + 8 * I_GU + 8 * I_DN;
        auto desc = [&](int it) -> TrD {
            int r = it;
            if (r < 2 * I_LAYER) { const int l = r / I_LAYER; r -= l * I_LAYER;
                if (r < I_WIN) return trd_win(LDP(const float, 3) + (size_t)l * DMODEL * INCOLS, WSP(bf16, WS_WIN) + (size_t)l * INCOLS * DMODEL, r, lane); r -= I_WIN;
                if (r < I_GLU) return trd_plain(LDP(const float, 12) + (size_t)l * 512 * 512, 512, 512, WSP(bf16, WS_WGLU) + (size_t)l * 512 * 512, r, lane); r -= I_GLU;
                if (r < I_PS) return trd_plain(LDP(const float, 19) + (size_t)l * 512 * 1024, 512, 1024, WSP(bf16, WS_WPS) + (size_t)l * 1024 * 512, r, lane); r -= I_PS;
                if (r < I_PA) return trd_plain(LDP(const float, 20) + (size_t)l * 1024 * 1024, 1024, 1024, WSP(bf16, WS_WPA) + (size_t)l * 1024 * 1024, r, lane); r -= I_PA;
                return trd_plain(LDP(const float, 21) + (size_t)l * 1024 * 1024, 1024, 1024, WSP(bf16, WS_WOUT) + (size_t)l * 1024 * 1024, r, lane); }
            r -= 2 * I_LAYER;
            if (r < I_GU) return trd_gu(LDP(const float, 23), LDP(const float, 24), WSP(bf16, WS_WDGU), r, lane); r -= I_GU;
            if (r < I_DN) return trd_plain(LDP(const float, 25), DFF, DMODEL, WSP(bf16, WS_WDD), r, lane); r -= I_DN;
            if (r < 8 * I_GU) { const int e = r / I_GU; r -= e * I_GU; return trd_gu(LDP(const float, 27) + (size_t)e * DMODEL * DFF, LDP(const float, 28) + (size_t)e * DMODEL * DFF, WSP(bf16, WS_WMGU) + (size_t)e * INCOLS * DMODEL, r, lane); } r -= 8 * I_GU;
            { const int e = r / I_DN; r -= e * I_DN; return trd_plain(LDP(const float, 29) + (size_t)e * DFF * DMODEL, DFF, DMODEL, WSP(bf16, WS_WMD) + (size_t)e * DMODEL * DFF, r, lane); }
        };
        if (gw < NITEMS) {
            TrD cur = desc(gw); float wa[32]; tr_ld(cur, lane, wa);
            for (int it = gw; it < NITEMS; it += NGW) {
                const int itn = (it + NGW < NITEMS) ? it + NGW : it;
                const TrD nxt = desc(itn); float wb[32]; tr_ld(nxt, lane, wb);
                tr_st(cur, wa, scr, lane);
#pragma unroll
                for (int i = 0; i < 32; ++i) wa[i] = wb[i];
                cur = nxt; }
        }
        __syncthreads();
        { S5In s5p; s5p.lam_re = LDP(const float, 4); s5p.lam_im = LDP(const float, 5); s5p.log_dt = LDP(const float, 6); s5p.b_re = LDP(const float, 7); s5p.b_im = LDP(const float, 8);
          s5p.c_re = LDP(const float, 9); s5p.c_im = LDP(const float, 10); s5p.dd = LDP(const float, 11);
          for (int it = vcu; it < 2 * 32 * 33; it += G) s5_item(L, tid, s5p, it / 33, it % 33, WSP(bf16, WS_TZF), WSP(bf16, WS_EM)); }
        { const int* positions = LDP(const int, 1); float* ROPE = WSP(float, WS_ROPE);
          for (int idx = vcu * (NWAVES * 64) + tid; idx < NTOK * 32; idx += G * NWAVES * 64) { const int n = idx >> 5, fi = idx & 31;
            const float invf = powf(10000.0f, -(float)(2 * fi) / 64.0f); const float ang = (float)positions[n] * invf; float sn, cs; sincosf(ang, &sn, &cs);
            ROPE[(size_t)n * 64 + fi] = cs; ROPE[(size_t)n * 64 + 32 + fi] = sn; } }
    }
    __syncthreads();

    for (int l = 0; l < 2; ++l) {
        for (int half = 0; half < 2; ++half) {
            const int tokbase = half * NH;
            { TID_SETUP; const float* xsrc = LDP(const float, 0); const bf16* XB = ACTP(const bf16, A_XB); const float* gain = LDP(const float, 2) + l * DMODEL; bf16* HB = ACTP(bf16, A_HB);
              f32x4 gq[4];
#pragma unroll
              for (int j = 0; j < 4; ++j) gq[j] = ((const GAS f32x4*)gain + lane)[64 * j];
              if (LQ() == 0) { for (int m = gw; m < NH; m += 4 * NGW) norm_rows4(xsrc + (size_t)(tokbase + m) * DMODEL, (size_t)NGW * DMODEL, gq, HB + (size_t)m * DMODEL, (size_t)NGW * DMODEL, lane); }
              else { for (int m = gw; m < NH; m += 4 * NGW) norm_rows4b(XB + (size_t)(tokbase + m) * DMODEL, (size_t)NGW * DMODEL, gq, HB + (size_t)m * DMODEL, (size_t)NGW * DMODEL, lane); } }
            GRID_BAR();
            { OPQ; pg8::Gemm g{ACTP(bf16, A_HB), WSP(bf16, WS_WIN) + (size_t)l * INCOLS * DMODEL, DMODEL, DMODEL, DMODEL}; pg8::SchedPlain S; S.init(NH / 256, INCOLS / 256, gridDim.x, (int)blockIdx.x);
              pg8::EpiIn E{ACTP(unsigned char, 0), WSP(const float, WS_ROPE), tokbase};
              pg8::gemm_phase<pg8::EpiIn, pg8::SchedPlain, true, true>(L0 + RING_OFF, g, S, E, MYTID()); }
            GRID_BAR();
            { OPQ; pg8::Gemm g{ACTP(bf16, A_UBUF), WSP(bf16, WS_EM) + (size_t)l * 32 * 256 * 512, 640, 512, 512}; pg8::SchedS5 S; S.init(1, gridDim.x, (int)blockIdx.x);
              pg8::EpiSloc E{ACTP(float, A_SLOC)};
              pg8::gemm_phase<pg8::EpiSloc, pg8::SchedS5, true, true>(L0 + RING_OFF, g, S, E, MYTID()); }
            GRID_BAR();
            { TID_SETUP;
              const int bl = vcu >> 5, g = vcu & 31; const int lg = l * 32 + g;
              const float dt = expf(LDP(const float, 6)[lg]); const float lr = LDP(const float, 4)[lg * 64 + lane], li = LDP(const float, 5)[lg * 64 + lane];
              const float magT = expf(32.0f * lr * dt); float snT, csT; sincosf(32.0f * li * dt, &snT, &csT); const float aTr = magT * csT, aTi = magT * snT;
              const float magS = expf(512.0f * lr * dt); float snS, csS; sincosf(512.0f * li * dt, &snS, &csS); const float aSr = magS * csS, aSi = magS * snS;
              const size_t row0 = (size_t)g * 1024 + (size_t)bl * 128 + (size_t)wave * 16;
              const float* sl = ACTP(const float, A_SLOC) + row0 * 128 + lane; bf16* ub = ACTP(bf16, A_UBUF) + row0 * 640 + 512 + lane;
              float xr[16], xi[16];
#pragma unroll
              for (int q = 0; q < 16; ++q) { xr[q] = sl[(size_t)q * 128]; xi[q] = sl[(size_t)q * 128 + 64]; }
              float pr[16], pi[16], sr = 0.f, si = 0.f;
#pragma unroll
              for (int q = 0; q < 16; ++q) { pr[q] = sr; pi[q] = si; const float nr_ = aTr * sr - aTi * si + xr[q], ni_ = aTr * si + aTi * sr + xi[q]; sr = nr_; si = ni_; }
              LAS float* ex = (LAS float*)(L);
              ex[wave * 128 + lane] = sr; ex[wave * 128 + 64 + lane] = si;
              __syncthreads();
              float cr = 0.f, ci = 0.f;
              for (int j = 0; j < wave; ++j) { const float er = ex[j * 128 + lane], ei = ex[j * 128 + 64 + lane]; const float nr_ = aSr * cr - aSi * ci + er, ni_ = aSr * ci + aSi * cr + ei; cr = nr_; ci = ni_; }
              float wr_ = 1.f, wi_ = 0.f;
#pragma unroll
              for (int q = 0; q < 16; ++q) { const float vr = pr[q] + (wr_ * cr - wi_ * ci), vi = pi[q] + (wr_ * ci + wi_ * cr);
                  ub[(size_t)q * 640] = (bf16)f2bf(vr); ub[(size_t)q * 640 + 64] = (bf16)f2bf(vi);
                  const float nw = wr_ * aTr - wi_ * aTi, ni2 = wr_ * aTi + wi_ * aTr; wr_ = nw; wi_ = ni2; }
            }
            GRID_BAR();
            { OPQ; pg8::Gemm g{ACTP(bf16, A_UBUF), WSP(bf16, WS_TZF) + (size_t)l * 32 * 512 * 640, 640, 640, 640}; pg8::SchedS5 S; S.init(2, gridDim.x, (int)blockIdx.x);
              pg8::EpiYa E{ACTP(bf16, A_YA)};
              pg8::gemm_phase<pg8::EpiYa, pg8::SchedS5, true, true>(L0 + RING_OFF, g, S, E, MYTID()); }
            GRID_BAR();
            { OPQ; pg8::Gemm g{ACTP(bf16, A_YA), WSP(bf16, WS_WGLU) + (size_t)l * 512 * 512, 512, 512, 512}; pg8::SchedPlain S; S.init(NH / 256, 2, gridDim.x, (int)blockIdx.x);
              pg8::EpiGlu E{ACTP(bf16, A_YA), ACTP(bf16, A_YA2), LDP(const float, 13) + l * 512};
              pg8::gemm_phase<pg8::EpiGlu, pg8::SchedPlain, true, true>(L0 + RING_OFF, g, S, E, MYTID()); }
            __syncthreads();
            {
                TID_SETUP;
                int lq = l; asm volatile("" : "+s"(lq));
                const float lam_init = 0.8f - 0.6f * expf(-0.3f * (float)lq);
                const float p1 = wave_sum(LDP(const float, 14)[lq * 64 + lane] * LDP(const float, 15)[lq * 64 + lane]), p2 = wave_sum(LDP(const float, 16)[lq * 64 + lane] * LDP(const float, 17)[lq * 64 + lane]);
                float lam_v = expf(p1) - expf(p2) + lam_init, gsc_v = 1.0f - lam_init; asm volatile("" : "+v"(lam_v), "+v"(gsc_v));
                const int lam_i = __builtin_amdgcn_readfirstlane(__builtin_bit_cast(int, lam_v)), gsc_i = __builtin_amdgcn_readfirstlane(__builtin_bit_cast(int, gsc_v));
                const float lam = __builtin_bit_cast(float, lam_i), gsc = __builtin_bit_cast(float, gsc_i);
                for (int i = 0; i < 8; ++i) {
                    OPQ; const int bh = (i >> 1) * 16 + (vcu >> 4); const int j = vcu & 15; const int qblk = (i & 1) ? 31 - j : j;
                    const int b = bh >> 3, h = bh & 7; const size_t rb = (size_t)b * SEQLEN;
                    attn_body::dattn2_unit<8>(qblk, (const attn_body::bf16*)(ACTP(bf16, A_Q) + rb * 1024 + h * 128), (const attn_body::bf16*)(ACTP(bf16, A_K) + rb * 1024 + h * 128),
                                             (const attn_body::bf16*)(ACTP(bf16, A_V) + rb * 1024 + h * 128), (attn_body::bf16*)(ACTP(bf16, A_YB) + rb * 1024 + h * 128),
                                             lam, LDP(const float, 18) + lq * 128, gsc, (char*)lds + RING_OFF, MYTID());
                }
            }
            GRID_BAR();
            { OPQ; pg8::Gemm g{ACTP(bf16, A_YA2), WSP(bf16, WS_WPS) + (size_t)l * 1024 * 512, 512, 512, 512}; pg8::SchedPlain S; S.init(NH / 256, 4, gridDim.x, (int)blockIdx.x);
              pg8::EpiGate<0> E{ACTP(bf16, A_SGS), nullptr};
              pg8::gemm_phase<pg8::EpiGate<0>, pg8::SchedPlain, true, true>(L0 + RING_OFF, g, S, E, MYTID()); }
            __syncthreads();
            { OPQ; pg8::Gemm g{ACTP(bf16, A_YB), WSP(bf16, WS_WPA) + (size_t)l * 1024 * 1024, 1024, 1024, 1024}; pg8::SchedPlain S; S.init(NH / 256, 4, gridDim.x, (int)blockIdx.x);
              pg8::EpiGate<1> E{ACTP(bf16, A_SGA), ACTP(bf16, A_SGS)};
              pg8::gemm_phase<pg8::EpiGate<1>, pg8::SchedPlain, true, true>(L0 + RING_OFF, g, S, E, MYTID()); }
            GRID_BAR();
            { OPQ; pg8::Gemm g{ACTP(bf16, A_SGA), WSP(bf16, WS_WOUT) + (size_t)l * 1024 * 1024, 1024, 1024, 1024}; pg8::SchedPlain S; S.init(NH / 256, 4, gridDim.x, (int)blockIdx.x);
              pg8::EpiRes E{(LQ() == 0) ? LDP(const float, 0) : (const float*)nullptr, ACTP(bf16, A_XB), tokbase};
              pg8::gemm_phase<pg8::EpiRes, pg8::SchedPlain, true, true>(L0 + RING_OFF, g, S, E, MYTID()); }
            GRID_BAR();
            if (LQ() == 0) {
                { TID_SETUP; const bf16* xs = ACTP(const bf16, A_XB); const float* gain = LDP(const float, 22); bf16* H2 = ACTP(bf16, A_H2);
                  f32x4 gq[4];
#pragma unroll
                  for (int j = 0; j < 4; ++j) gq[j] = ((const GAS f32x4*)gain + lane)[64 * j];
                  for (int m = gw; m < NH; m += 4 * NGW) norm_rows4b(xs + (size_t)(tokbase + m) * DMODEL, (size_t)NGW * DMODEL, gq, H2 + (size_t)m * DMODEL, (size_t)NGW * DMODEL, lane); }
                GRID_BAR();
                { OPQ; pg8::Gemm g{ACTP(bf16, A_H2), WSP(bf16, WS_WDGU), 1024, 1024, 1024}; pg8::SchedPlain S; S.init(NH / 256, 22, gridDim.x, (int)blockIdx.x);
                  pg8::EpiSwi E{ACTP(bf16, A_FA)};
                  pg8::gemm_phase<pg8::EpiSwi, pg8::SchedPlain, true, true>(L0 + RING_OFF, g, S, E, MYTID()); }
                GRID_BAR();
                { OPQ; pg8::Gemm g{ACTP(bf16, A_FA), WSP(bf16, WS_WDD), 2816, 2816, 2816}; pg8::SchedPlain S; S.init(NH / 256, 4, gridDim.x, (int)blockIdx.x);
                  pg8::EpiRes E{(const float*)nullptr, ACTP(bf16, A_XB), tokbase};
                  pg8::gemm_phase<pg8::EpiRes, pg8::SchedPlain, true, true>(L0 + RING_OFF, g, S, E, MYTID()); }
                GRID_BAR();
            } else {
                {
                    TID_SETUP;
                    LAS float* rwT = (LAS float*)(L);
                    LAS unsigned* cntL = (LAS unsigned*)(L + 32768);
                    { const float* router_w = LDP(const float, 26); for (int idx = tid; idx < 8192; idx += NWAVES * 64) { const int k = idx >> 3, e = idx & 7; rwT[e * 1024 + k] = router_w[idx]; } }
                    if (tid < 8) cntL[tid] = 0u;
                    __syncthreads();
                    const bf16* xs = ACTP(const bf16, A_XB); const float* gain = LDP(const float, 22) + DMODEL; bf16* H2 = ACTP(bf16, A_H2M);
                    unsigned* RT_E = WSP(unsigned, WS_ROUTE + R_E); float* RT_W = WSP(float, WS_ROUTE + R_W);
                    f32x4 gq[4];
#pragma unroll
                    for (int j = 0; j < 4; ++j) gq[j] = ((const GAS f32x4*)gain + lane)[64 * j];
                    unsigned long long xq[4][4];
#pragma unroll
                    for (int u = 0; u < 4; ++u) { const GAS unsigned long long* xr = (const GAS unsigned long long*)(xs + (size_t)(tokbase + vcu * 128 + wave * 16 + u) * DMODEL) + lane;
#pragma unroll
                      for (int j = 0; j < 4; ++j) xq[u][j] = xr[64 * j]; }
                    for (int i2 = 0; i2 < 16; i2 += 4) { f32x4 xv[4][4];
#pragma unroll
                      for (int u = 0; u < 4; ++u)
#pragma unroll
                        for (int j = 0; j < 4; ++j) xv[u][j] = bf4_f32(xq[u][j]);
                      { const int in_ = (i2 + 4 < 16) ? i2 + 4 : 12;
#pragma unroll
                        for (int u = 0; u < 4; ++u) { const GAS unsigned long long* xr = (const GAS unsigned long long*)(xs + (size_t)(tokbase + vcu * 128 + wave * 16 + in_ + u) * DMODEL) + lane;
#pragma unroll
                          for (int j = 0; j < 4; ++j) xq[u][j] = xr[64 * j]; } }
#pragma unroll
                      for (int u = 0; u < 4; ++u) { const int row = vcu * 128 + wave * 16 + i2 + u;
                        f32x4 hn[4]; { float s2 = 0.f;
#pragma unroll
                            for (int j = 0; j < 4; ++j) s2 += (xv[u][j].x * xv[u][j].x + xv[u][j].y * xv[u][j].y) + (xv[u][j].z * xv[u][j].z + xv[u][j].w * xv[u][j].w);
                            const float rs = 1.0f / sqrtf(wave_sum(s2) * (1.0f / DMODEL) + EPS_NORM);
                            GAS unsigned long long* o8 = (GAS unsigned long long*)(H2 + (size_t)row * DMODEL) + lane;
#pragma unroll
                            for (int j = 0; j < 4; ++j) { hn[j] = xv[u][j] * rs * gq[j]; o8[64 * j] = (unsigned long long)pk2(hn[j].x, hn[j].y) | ((unsigned long long)pk2(hn[j].z, hn[j].w) << 32); } }
                        float lg[8];
#pragma unroll
                        for (int e = 0; e < 8; ++e) { float a = 0.f;
#pragma unroll
                            for (int j = 0; j < 4; ++j) { const f32x4 w = *(const LAS f32x4*)(rwT + e * 1024 + 4 * lane + 256 * j); a += (hn[j].x * w.x + hn[j].y * w.y) + (hn[j].z * w.z + hn[j].w * w.w); }
                            lg[e] = wave_sum(a); }
                        if (lane == 0) { int e1 = 0; float v1 = lg[0];
#pragma unroll
                            for (int e = 1; e < 8; ++e) if (lg[e] > v1) { v1 = lg[e]; e1 = e; }
                            int e2 = -1; float v2 = -INFINITY;
#pragma unroll
                            for (int e = 0; e < 8; ++e) if (e != e1 && lg[e] > v2) { v2 = lg[e]; e2 = e; }
                            if (e2 < 0) e2 = (e1 == 0) ? 1 : 0;
                            const float ex = expf(v2 - v1); const float w1 = 1.0f / (1.0f + ex), w2 = ex / (1.0f + ex);
                            RT_E[row] = (unsigned)e1 | ((unsigned)e2 << 8); RT_W[2 * row] = w1; RT_W[2 * row + 1] = w2;
                            __hip_atomic_fetch_add(cntL + e1, 1u, __ATOMIC_RELAXED, __HIP_MEMORY_SCOPE_WORKGROUP); __hip_atomic_fetch_add(cntL + e2, 1u, __ATOMIC_RELAXED, __HIP_MEMORY_SCOPE_WORKGROUP); }
                      }
                    }
                    __syncthreads();
                    if (tid < 8) WSP(unsigned, WS_ROUTE + R_CNT)[vcu * 8 + tid] = cntL[tid];
                }
                GRID_BAR();
                {
                    TID_SETUP;
                    volatile LAS unsigned* MISC = (volatile LAS unsigned*)(L + MISC_OFF);
                    LAS unsigned* tab = (LAS unsigned*)(L);
                    LAS unsigned* tot = (LAS unsigned*)(L + 8192);
                    LAS unsigned* off = (LAS unsigned*)(L + 8192 + 64);
                    LAS unsigned* wcn = (LAS unsigned*)(L + 8192 + 128);
                    LAS unsigned* slt = (LAS unsigned*)(L + 8192 + 512);
                    const unsigned* RT_CNT = WSP(const unsigned, WS_ROUTE + R_CNT); const unsigned* RT_E = WSP(const unsigned, WS_ROUTE + R_E); int* RT_S = WSP(int, WS_ROUTE + R_S);
                    unsigned* RT_ROW = WSP(unsigned, WS_ROUTE + R_ROW);
                    if (tid < 256) { const GAS v4u* src = (const GAS v4u*)(RT_CNT + tid * 8); const v4u a = src[0], b = src[1];
                        tab[tid * 8 + 0] = a.x; tab[tid * 8 + 1] = a.y; tab[tid * 8 + 2] = a.z; tab[tid * 8 + 3] = a.w; tab[tid * 8 + 4] = b.x; tab[tid * 8 + 5] = b.y; tab[tid * 8 + 6] = b.z; tab[tid * 8 + 7] = b.w; }
                    __syncthreads();
                    if (tid < 8) { tot[tid] = 0u; off[tid] = 0u; }
                    __syncthreads();
                    { const int e = tid & 7, b0 = (tid >> 3) * 4; unsigned t = 0, o = 0;
#pragma unroll
                      for (int q = 0; q < 4; ++q) { const unsigned c = tab[(b0 + q) * 8 + e]; t += c; if (b0 + q < vcu) o += c; }
                      __hip_atomic_fetch_add(tot + e, t, __ATOMIC_RELAXED, __HIP_MEMORY_SCOPE_WORKGROUP); __hip_atomic_fetch_add(off + e, o, __ATOMIC_RELAXED, __HIP_MEMORY_SCOPE_WORKGROUP); }
                    __syncthreads();
                    if (tid == 0) { unsigned sp = 0; for (int e = 0; e < 8; ++e) { MISC[16 + e] = sp; sp += (tot[e] + 255u) >> 8; } MISC[24] = sp; }
                    __syncthreads();
                    int my_e = 0, my_rank = 0;
                    if (tid < 256) { const int row = vcu * 128 + (tid >> 1); const unsigned ee = RT_E[row]; my_e = (tid & 1) ? (int)((ee >> 8) & 255u) : (int)(ee & 255u);
#pragma unroll
                        for (int e = 0; e < 8; ++e) { const unsigned long long mask = __ballot(my_e == e); if (my_e == e) my_rank = __popcll(mask & ((1ull << lane) - 1ull)); if (lane == 0) wcn[wave * 8 + e] = (unsigned)__popcll(mask); } }
                    __syncthreads();
                    if (tid < 256) { unsigned pre = 0; for (int w = 0; w < wave; ++w) pre += wcn[w * 8 + my_e];
                        const unsigned slot = MISC[16 + my_e] * 256u + off[my_e] + pre + (unsigned)my_rank;
                        RT_S[(vcu * 128 + (tid >> 1)) * 2 + (tid & 1)] = (int)slot; RT_ROW[slot] = (unsigned)(vcu * 128 + (tid >> 1)); }
                    if (vcu < 8) { const unsigned e = (unsigned)vcu; const unsigned r0 = MISC[16 + e] * 256u + tot[e], r1 = MISC[17 + e] * 256u;
                        for (unsigned r = r0 + (unsigned)tid; r < r1; r += NWAVES * 64) RT_ROW[r] = (unsigned)NH; }
                    if (vcu == 8 && tid < 128) { unsigned zz = 0u; asm volatile("" : "+v"(zz)); const v4u z = {zz, zz, zz, zz}; ((GAS v4u*)(ACTP(bf16, A_H2M) + (size_t)NH * DMODEL))[tid] = z; }
                }
                GRID_BAR();
#define MOE_SCHED(S, NN) do { volatile LAS unsigned* MISC = (volatile LAS unsigned*)(L + MISC_OFF); S.nn = (NN); \
        S.sp1 = __builtin_amdgcn_readfirstlane((int)MISC[17]); S.sp2 = __builtin_amdgcn_readfirstlane((int)MISC[18]); S.sp3 = __builtin_amdgcn_readfirstlane((int)MISC[19]); S.sp4 = __builtin_amdgcn_readfirstlane((int)MISC[20]); \
        S.sp5 = __builtin_amdgcn_readfirstlane((int)MISC[21]); S.sp6 = __builtin_amdgcn_readfirstlane((int)MISC[22]); S.sp7 = __builtin_amdgcn_readfirstlane((int)MISC[23]); \
        S.so.init(__builtin_amdgcn_readfirstlane((int)MISC[24]), (NN), gridDim.x, (int)blockIdx.x); } while (0)
                { OPQ; pg8::SchedMoe S; MOE_SCHED(S, 22);
                  pg8::Gemm g{ACTP(bf16, A_H2M), WSP(bf16, WS_WMGU), 1024, 1024, 1024, WSP(const unsigned, WS_ROUTE + R_ROW)}; pg8::EpiSwi E{ACTP(bf16, A_AG)};
                  pg8::gemm_phase<pg8::EpiSwi, pg8::SchedMoe, true, true, true>(L0 + RING_OFF, g, S, E, MYTID()); }
                GRID_BAR();
                { OPQ; pg8::SchedMoe S; MOE_SCHED(S, 4);
                  if (S.so.nM > 256) { S.so.nM = 256; S.so.nwg = 1024; }
                  pg8::Gemm g{ACTP(bf16, A_AG), WSP(bf16, WS_WMD), 2816, 2816, 2816}; pg8::EpiBf E{ACTP(bf16, A_YG)};
                  pg8::gemm_phase<pg8::EpiBf, pg8::SchedMoe, true, true>(L0 + RING_OFF, g, S, E, MYTID()); }
                { OPQ; volatile LAS unsigned* MISC = (volatile LAS unsigned*)(L + MISC_OFF);
                  const int NR = __builtin_amdgcn_readfirstlane((int)MISC[24]); const int LT = (NR > 256 ? NR - 256 : 0) * 4; const int ns = (LT <= 23) ? 11 : 2; const int Ks = 2816 / ns;
                  const int k = (int)blockIdx.x; pg8::SchedOne S; S.has = k < LT * ns;
                  const int lt = S.has ? k / ns : 0, sl = S.has ? k % ns : 0; const int panel = 256 + (lt >> 2);
                  int e = 0;
#pragma unroll
                  for (int j = 1; j < 8; ++j) e += (panel >= __builtin_amdgcn_readfirstlane((int)MISC[16 + j])) ? 1 : 0;
                  S.u.pm = panel; S.u.pn = e * 4 + (lt & 3);
                  pg8::Gemm g{ACTP(bf16, A_AG) + (size_t)sl * Ks, WSP(bf16, WS_WMD) + (size_t)sl * Ks, 2816, 2816, Ks}; pg8::EpiPart E{ACTP(float, A_H2M) + (size_t)k * 65536};
                  pg8::gemm_phase<pg8::EpiPart, pg8::SchedOne, true, true>(L0 + RING_OFF, g, S, E, MYTID()); }
                GRID_BAR();
                { TID_SETUP; volatile LAS unsigned* MISC = (volatile LAS unsigned*)(L + MISC_OFF);
                  const int NR = __builtin_amdgcn_readfirstlane((int)MISC[24]); const int LT = (NR > 256 ? NR - 256 : 0) * 4; const int ns = (LT <= 23) ? 11 : 2;
                  const float* PART = ACTP(const float, A_H2M); bf16* YG = ACTP(bf16, A_YG);
                  for (int v = vcu * (NWAVES * 64) + tid; v < LT * 16384; v += G * NWAVES * 64) { const int lt = v >> 14, rem = v & 16383, r = rem >> 6, c4 = rem & 63;
                      f32x4 a = {0.f, 0.f, 0.f, 0.f};
                      for (int s = 0; s < ns; ++s) a += *(const GAS f32x4*)(PART + ((size_t)(lt * ns + s) * 65536 + (size_t)r * 256 + c4 * 4));
                      *(GAS unsigned long long*)(YG + (size_t)((256 + (lt >> 2)) * 256 + r) * DMODEL + (lt & 3) * 256 + c4 * 4) = (unsigned long long)pk2(a.x, a.y) | ((unsigned long long)pk2(a.z, a.w) << 32); } }
                GRID_BAR();
                {
                    TID_SETUP;
                    const int* RT_S = WSP(const int, WS_ROUTE + R_S); const float* RT_W = WSP(const float, WS_ROUTE + R_W); float* xo = LDP(float, 31); const bf16* XBc = ACTP(const bf16, A_XB); const bf16* YG = ACTP(const bf16, A_YG);
                    const GAS f32x4* gr = (const GAS f32x4*)LDP(const float, 30) + lane;
                    f32x4 gq[4];
#pragma unroll
                    for (int j = 0; j < 4; ++j) gq[j] = gr[64 * j];
                    for (int m = gw; m < NH; m += 4 * NGW) {
                        int s1[4], s2[4]; float w1[4], w2[4];
#pragma unroll
                        for (int r = 0; r < 4; ++r) { const int mm = m + r * NGW; s1[r] = RT_S[2 * mm]; s2[r] = RT_S[2 * mm + 1]; w1[r] = RT_W[2 * mm]; w2[r] = RT_W[2 * mm + 1]; }
                        f32x4 xa[4][4]; unsigned long long ya[4][4], yb[4][4];
#pragma unroll
                        for (int r = 0; r < 4; ++r) { const GAS unsigned long long* xr = (const GAS unsigned long long*)(XBc + (size_t)(tokbase + m + r * NGW) * DMODEL) + lane;
                            const GAS unsigned long long* y1 = (const GAS unsigned long long*)(YG + (size_t)s1[r] * DMODEL) + lane; const GAS unsigned long long* y2 = (const GAS unsigned long long*)(YG + (size_t)s2[r] * DMODEL) + lane;
#pragma unroll
                            for (int j = 0; j < 4; ++j) { xa[r][j] = bf4_f32(xr[64 * j]); ya[r][j] = y1[64 * j]; yb[r][j] = y2[64 * j]; } }
#pragma unroll
                        for (int r = 0; r < 4; ++r) { float sq = 0.f;
#pragma unroll
                            for (int j = 0; j < 4; ++j) { const unsigned long long a = ya[r][j], b = yb[r][j]; f32x4 x4 = xa[r][j];
                                const unsigned alo = (unsigned)a, ahi = (unsigned)(a >> 32), blo = (unsigned)b, bhi = (unsigned)(b >> 32);
                                x4.x += w1[r] * __uint_as_float(alo << 16) + w2[r] * __uint_as_float(blo << 16); x4.y += w1[r] * __uint_as_float(alo & 0xffff0000u) + w2[r] * __uint_as_float(blo & 0xffff0000u);
                                x4.z += w1[r] * __uint_as_float(ahi << 16) + w2[r] * __uint_as_float(bhi << 16); x4.w += w1[r] * __uint_as_float(ahi & 0xffff0000u) + w2[r] * __uint_as_float(bhi & 0xffff0000u);
                                xa[r][j] = x4; sq += (x4.x * x4.x + x4.y * x4.y) + (x4.z * x4.z + x4.w * x4.w); }
                            const float rs = 1.0f / sqrtf(wave_sum(sq) * (1.0f / DMODEL) + EPS_NORM);
                            GAS f32x4* xw = (GAS f32x4*)(xo + (size_t)(tokbase + m + r * NGW) * DMODEL) + lane;
#pragma unroll
                            for (int j = 0; j < 4; ++j) xw[64 * j] = xa[r][j] * rs * gq[j]; }
                    }
                }
                GRID_BAR();
            }
        }
    }
#undef GRID_BAR
#undef TID_SETUP
#undef LQ
#undef MYTID
#undef OPQ
#undef WSP
#undef ACTP
#undef MOE_SCHED
}

extern "C" void kernel_launch(void* const* d_in, const int* in_sizes, int n_in, void* d_out, int out_size, void* d_ws, size_t ws_size, hipStream_t stream) {
    static int grid = 0;
    if (grid == 0) {
        if (n_in != 31 || in_sizes[0] != NTOK * DMODEL || out_size != NTOK * DMODEL || ws_size < WS_END) {
            fprintf(stderr, "kernel_launch: unexpected shapes: n_in %d in0 %d out %d ws %zu (need %zu); nothing launched\n", n_in, n_in > 0 ? in_sizes[0] : -1, out_size, ws_size, (size_t)WS_END); grid = -1; return; }
        int dev = 0, cus = 0, per_cu = 0;
        if (hipGetDevice(&dev) != hipSuccess || hipDeviceGetAttribute(&cus, hipDeviceAttributeMultiprocessorCount, dev) != hipSuccess) { grid = -1; return; }
        if (hipFuncSetAttribute((const void*)trunk_fwd, hipFuncAttributeMaxDynamicSharedMemorySize, LDS_BYTES) != hipSuccess) { fprintf(stderr, "kernel_launch: hipFuncSetAttribute failed\n"); grid = -1; return; }
        if (hipOccupancyMaxActiveBlocksPerMultiprocessor(&per_cu, (const void*)trunk_fwd, NWAVES * 64, LDS_BYTES) != hipSuccess || per_cu < 1)
            fprintf(stderr, "kernel_launch: note: occupancy query reports %d workgroups per CU\n", per_cu);
        (void)hipGetLastError();
        grid = 256;
        if (cus < 256) { fprintf(stderr, "kernel_launch: device has %d CUs, need 256; nothing launched\n", cus); grid = -1; return; }
    }
    if (grid < 0) return;
    if (hipMemsetAsync((char*)d_ws + WS_CTL, 0, CTL_ZERO_BYTES, stream) != hipSuccess) return;
    Args a{};
    for (int i = 0; i < 31; ++i) a.in[i] = d_in[i];
    a.out = (float*)d_out; a.ws = (unsigned char*)d_ws;
    hipLaunchKernelGGL(trunk_fwd, dim3(grid), dim3(NWAVES * 64), LDS_BYTES, stream, a);
}
```
